# Optimizing an MI355X kernel written in HIP

```python
import math
import jax
import jax.numpy as jnp
from jax import lax
import numpy as np

D_MODEL = 1024
BATCH = 4
SEQ = 8192
DEPTH = 2

NORM_EPS = 1e-6
NEG_INF = -1e30
TOP_BONUS = 1e9
NUM_BUCKETS = 32
T5_MAX_DISTANCE = 128
NSA_HEADS = 8
NSA_KV_GROUPS = 2
NSA_HEAD_DIM = 64
CMP_LEN = 32
CMP_STRIDE = 16
SEL_BLOCK = 64
SEL_TOPK = 16
WINDOW = 512
NSA_Q_BLOCK = 128
NSA_WIDTH = NSA_HEADS * NSA_HEAD_DIM
NSA_KV_WIDTH = NSA_KV_GROUPS * NSA_HEAD_DIM
N_NSA_BRANCH = 3
GLA_HEADS = 4
GLA_KEY_DIM = 64
GLA_VAL_DIM = 128
GLA_GATE_RANK = 16
GLA_GATE_TAU = 16.0
GLA_CHUNK = 64
MOBA_HEADS = 8
MOBA_HEAD_DIM = 64
MOBA_BLOCK = 256
MOBA_TOPK = 3
MOBA_Q_BLOCK = 32
MOBA_WIDTH = MOBA_HEADS * MOBA_HEAD_DIM
N_BRANCHES = 3
FFN_HIDDEN = ((8 * D_MODEL + 3 * 256 - 1) // (3 * 256)) * 256
SPLIT_SIZES = (
    NSA_WIDTH,
    NSA_KV_WIDTH, NSA_KV_WIDTH,
    NSA_KV_WIDTH, NSA_KV_WIDTH,
    NSA_KV_WIDTH, NSA_KV_WIDTH,
    NSA_HEADS * N_NSA_BRANCH,
    GLA_HEADS * GLA_KEY_DIM, GLA_HEADS * GLA_KEY_DIM, GLA_HEADS * GLA_VAL_DIM, GLA_HEADS * GLA_VAL_DIM, GLA_GATE_RANK,
    MOBA_WIDTH, MOBA_WIDTH, MOBA_WIDTH,
    N_BRANCHES * D_MODEL,
)
D_IN = sum(SPLIT_SIZES)

kernel_name = 'hybrid_nsa_gla_moba_block'


def rmsnorm(x, w):
    xf = x.astype(jnp.float32)
    y = xf * lax.rsqrt(jnp.mean(xf * xf, axis=-1, keepdims=True) + NORM_EPS)
    return (y * w.astype(jnp.float32)).astype(x.dtype)


def t5_bucket(dist):
    n = jnp.maximum(dist, 0)
    max_exact = NUM_BUCKETS // 2
    log_ratio = jnp.log(jnp.maximum(n, 1).astype(jnp.float32) / max_exact) / math.log(T5_MAX_DISTANCE / max_exact)
    large = max_exact + (log_ratio * (NUM_BUCKETS - max_exact)).astype(jnp.int32)
    return jnp.where(n < max_exact, n, jnp.minimum(large, NUM_BUCKETS - 1))


def masked_softmax(s, mask):
    s = jnp.where(mask, s.astype(jnp.float32), NEG_INF)
    m = jnp.max(s, axis=-1, keepdims=True)
    e = jnp.where(mask, jnp.exp(s - m), 0.0)
    return e / jnp.maximum(jnp.sum(e, axis=-1, keepdims=True), 1e-20)


def split_heads(t, n_heads):
    b, s, _ = t.shape
    return t.reshape(b, s, n_heads, -1).transpose(0, 2, 1, 3)


def compress(t, pe, w1, w2):
    b, g, s, d = t.shape
    ratio = CMP_LEN // CMP_STRIDE
    n_cmp = (s - CMP_LEN) // CMP_STRIDE + 1
    pieces = t.reshape(b, g, s // CMP_STRIDE, CMP_STRIDE, d)
    blocks = jnp.concatenate([pieces[:, :, m:m + n_cmp] for m in range(ratio)], axis=3)
    flat = (blocks + pe).reshape(b, g, n_cmp, CMP_LEN * d)
    return jax.nn.gelu(flat @ w1) @ w2


def nsa_mixer(q, kc, vc, ks, vs, kw, vw, gates, rel_a, pe_k, pe_v, ck_w1, ck_w2, cv_w1, cv_w2):
    b, s, _ = q.shape
    G, R, dk = NSA_KV_GROUPS, NSA_HEADS // NSA_KV_GROUPS, NSA_HEAD_DIM
    qh = q.reshape(b, s, G, R, dk).transpose(0, 2, 3, 1, 4) * dk ** -0.5
    gh = jax.nn.sigmoid(gates).reshape(b, s, G, R, N_NSA_BRANCH).transpose(0, 2, 3, 1, 4)
    kc, vc, ks, vs, kw, vw = [split_heads(t, G) for t in (kc, vc, ks, vs, kw, vw)]
    k_cmp = compress(kc, pe_k, ck_w1, ck_w2)
    v_cmp = compress(vc, pe_v, cv_w1, cv_w2)
    n_cmp = k_cmp.shape[2]
    cmp_end = jnp.arange(n_cmp) * CMP_STRIDE + CMP_LEN - 1
    cmp_start = cmp_end - (CMP_LEN - 1)
    n_sb = s // SEL_BLOCK
    n_sel = min(SEL_TOPK, n_sb)
    sb_start = jnp.arange(n_sb) * SEL_BLOCK
    overlap = ((cmp_start[:, None] < sb_start[None, :] + SEL_BLOCK) & (cmp_end[:, None] >= sb_start[None, :])).astype(jnp.float32)
    ks_blk = ks.reshape(b, G, n_sb, SEL_BLOCK, dk)
    vs_blk = vs.reshape(b, G, n_sb, SEL_BLOCK, dk)
    pad = ((0, 0), (0, 0), (WINDOW, 0), (0, 0))
    kw_pad = jnp.pad(kw, pad)
    vw_pad = jnp.pad(vw, pad)
    rel_g = rel_a.reshape(NUM_BUCKETS, G, R)
    bi = jnp.arange(b)[:, None, None, None]
    gi = jnp.arange(G)[None, :, None, None]
    Q = NSA_Q_BLOCK

    def chunk(c):
        t0 = c * Q
        tpos = t0 + jnp.arange(Q)
        qc = lax.dynamic_slice_in_dim(qh, t0, Q, axis=3)
        gc = lax.dynamic_slice_in_dim(gh, t0, Q, axis=3)
        d_cmp = tpos[:, None] - cmp_end[None, :]
        b_cmp = rel_a[t5_bucket(d_cmp)].reshape(Q, n_cmp, G, R).transpose(2, 3, 0, 1)
        s_cmp = jnp.einsum('bgrqd,bgnd->bgrqn', qc, k_cmp) + b_cmp
        p_cmp = masked_softmax(s_cmp, d_cmp >= 0)
        o_cmp = jnp.einsum('bgrqn,bgnd->bgrqd', p_cmp.astype(v_cmp.dtype), v_cmp)
        imp = jnp.einsum('bgrqn,ns->bgqs', p_cmp, overlap)
        cur = tpos // SEL_BLOCK
        sb = jnp.arange(n_sb)[None, :]
        forced = (sb == 0) | (sb == cur[:, None]) | (sb == cur[:, None] - 1)
        imp = jnp.where(forced, TOP_BONUS, jnp.where(sb <= cur[:, None], imp, NEG_INF))
        _, idx = lax.top_k(imp, n_sel)
        k_sel = ks_blk[bi, gi, idx].reshape(b, G, Q, n_sel * SEL_BLOCK, dk)
        v_sel = vs_blk[bi, gi, idx].reshape(b, G, Q, n_sel * SEL_BLOCK, dk)
        kpos = (idx[..., None] * SEL_BLOCK + jnp.arange(SEL_BLOCK)).reshape(b, G, Q, n_sel * SEL_BLOCK)
        d_sel = tpos[None, None, :, None] - kpos
        b_sel = jnp.moveaxis(rel_g[t5_bucket(d_sel), gi], -1, 2)
        s_sel = jnp.einsum('bgrqd,bgqkd->bgrqk', qc, k_sel) + b_sel
        p_sel = masked_softmax(s_sel, (d_sel >= 0)[:, :, None])
        o_sel = jnp.einsum('bgrqk,bgqkd->bgrqd', p_sel.astype(v_sel.dtype), v_sel)
        k_w = lax.dynamic_slice_in_dim(kw_pad, t0, Q + WINDOW, axis=2)
        v_w = lax.dynamic_slice_in_dim(vw_pad, t0, Q + WINDOW, axis=2)
        wpos = t0 - WINDOW + jnp.arange(Q + WINDOW)
        d_w = tpos[:, None] - wpos[None, :]
        m_w = (d_w >= 0) & (d_w < WINDOW) & (wpos[None, :] >= 0)
        b_w = rel_a[t5_bucket(d_w)].reshape(Q, Q + WINDOW, G, R).transpose(2, 3, 0, 1)
        s_w = jnp.einsum('bgrqd,bgkd->bgrqk', qc, k_w) + b_w
        p_w = masked_softmax(s_w, m_w)
        o_w = jnp.einsum('bgrqk,bgkd->bgrqd', p_w.astype(v_w.dtype), v_w)
        return gc[..., 0:1] * o_cmp + gc[..., 1:2] * o_sel + gc[..., 2:3] * o_w

    out = lax.map(chunk, jnp.arange(s // Q))
    return out.transpose(1, 0, 4, 2, 3, 5).reshape(b, s, NSA_WIDTH)


def gla_mixer(q, k, v, log_a, r, norm_w):
    b, s, _ = q.shape
    H, DK, DV, C = GLA_HEADS, GLA_KEY_DIM, GLA_VAL_DIM, GLA_CHUNK
    n_c = s // C

    def to_chunks(t, d):
        return t.reshape(b, n_c, C, H, d).transpose(1, 0, 3, 2, 4).astype(jnp.float32)

    qc = to_chunks(q * DK ** -0.5, DK)
    kc = to_chunks(k, DK)
    vc = to_chunks(v, DV)
    gc = to_chunks(log_a, DK)
    causal = jnp.tril(jnp.ones((C, C), dtype=bool))[:, :, None]

    def step(state, inp):
        qi, ki, vi, gi = inp
        bcum = jnp.cumsum(gi, axis=2)
        o_inter = jnp.einsum('bhcd,bhde->bhce', qi * jnp.exp(bcum), state)
        diff = bcum[:, :, :, None, :] - bcum[:, :, None, :, :]
        decay = jnp.exp(jnp.where(causal, diff, NEG_INF))
        attn = jnp.einsum('bhid,bhjd,bhijd->bhij', qi, ki, decay)
        o_intra = jnp.einsum('bhij,bhje->bhie', attn, vi)
        b_last = bcum[:, :, -1:, :]
        new_state = state * jnp.exp(b_last[:, :, 0, :])[..., None] + jnp.einsum('bhcd,bhce->bhde', ki * jnp.exp(b_last - bcum), vi)
        return new_state, o_inter + o_intra

    state0 = jnp.zeros((b, H, DK, DV), jnp.float32)
    _, o = lax.scan(step, state0, (qc, kc, vc, gc))
    o = o.transpose(1, 0, 3, 2, 4).reshape(b, s, H, DV)
    o = rmsnorm(o, norm_w) * jax.nn.silu(r.reshape(b, s, H, DV).astype(jnp.float32))
    return o.reshape(b, s, H * DV).astype(r.dtype)


def moba_mixer(q, k, v, rel_c):
    b, s, _ = q.shape
    H, dh, Q = MOBA_HEADS, MOBA_HEAD_DIM, MOBA_Q_BLOCK
    qh = split_heads(q, H) * dh ** -0.5
    kh = split_heads(k, H)
    vh = split_heads(v, H)
    n_blk = -(-s // MOBA_BLOCK)
    pad = ((0, 0), (0, 0), (0, n_blk * MOBA_BLOCK - s), (0, 0))
    kp = jnp.pad(kh, pad)
    vp = jnp.pad(vh, pad)
    k_blk = kp.reshape(b, H, n_blk, MOBA_BLOCK, dh)
    v_blk = vp.reshape(b, H, n_blk, MOBA_BLOCK, dh)
    k_mean = jnp.mean(k_blk.astype(jnp.float32), axis=3)
    n_top = min(MOBA_TOPK, n_blk)
    ks_len = n_top * MOBA_BLOCK
    bi = jnp.arange(b)[:, None, None, None]
    hi = jnp.arange(H)[None, :, None, None]

    def chunk(c):
        t0 = c * Q
        tpos = t0 + jnp.arange(Q)
        qb = lax.dynamic_slice_in_dim(qh, t0, Q, axis=2)
        cur = t0 // MOBA_BLOCK
        score = jnp.einsum('bhqd,bhnd->bhqn', qb.astype(jnp.float32), k_mean)
        score = jnp.where(jnp.arange(n_blk) < cur, score, NEG_INF)
        _, idx = lax.top_k(score, n_top)
        sel_valid = idx < cur
        k_sel = k_blk[bi, hi, idx].reshape(b, H, Q, ks_len, dh)
        v_sel = v_blk[bi, hi, idx].reshape(b, H, Q, ks_len, dh)
        kpos = (idx[..., None] * MOBA_BLOCK + jnp.arange(MOBA_BLOCK)).reshape(b, H, Q, ks_len)
        s_sel = jnp.einsum('bhqd,bhqkd->bhqk', qb, k_sel) + rel_c[t5_bucket(tpos[None, None, :, None] - kpos), hi]
        m_sel = jnp.repeat(sel_valid, MOBA_BLOCK, axis=-1)
        k_own = lax.dynamic_slice_in_dim(kp, cur * MOBA_BLOCK, MOBA_BLOCK, axis=2)
        v_own = lax.dynamic_slice_in_dim(vp, cur * MOBA_BLOCK, MOBA_BLOCK, axis=2)
        d_own = tpos[:, None] - (cur * MOBA_BLOCK + jnp.arange(MOBA_BLOCK))[None, :]
        s_own = jnp.einsum('bhqd,bhkd->bhqk', qb, k_own) + rel_c[t5_bucket(d_own)].transpose(2, 0, 1)
        m_own = jnp.broadcast_to(d_own >= 0, (b, H, Q, MOBA_BLOCK))
        p = masked_softmax(jnp.concatenate([s_sel, s_own], axis=-1), jnp.concatenate([m_sel, m_own], axis=-1)).astype(v.dtype)
        return jnp.einsum('bhqk,bhqkd->bhqd', p[..., :ks_len], v_sel) + jnp.einsum('bhqk,bhkd->bhqd', p[..., ks_len:], v_own)

    out = lax.map(chunk, jnp.arange(s // Q))
    return out.transpose(1, 0, 3, 2, 4).reshape(b, s, MOBA_WIDTH)


def setup_inputs(seed: int = 0) -> dict:
    key = jax.random.key(seed)
    ks = jax.random.split(key, 22)
    L, dk = DEPTH, NSA_HEAD_DIM

    def nrm(k, shape, scale):
        return jax.random.normal(k, shape, jnp.float32) * scale

    return {
        'x': nrm(ks[0], (BATCH, SEQ, D_MODEL), 1.0),
        'rel_bias': nrm(ks[1], (NUM_BUCKETS, NSA_HEADS + MOBA_HEADS), 0.2),
        'norm_mix_pre': 1.0 + nrm(ks[2], (L, D_MODEL), 0.02),
        'norm_mix_post': 1.0 + nrm(ks[3], (L, D_MODEL), 0.02),
        'norm_ffn_pre': 1.0 + nrm(ks[4], (L, D_MODEL), 0.02),
        'norm_ffn_post': 1.0 + nrm(ks[5], (L, D_MODEL), 0.02),
        'w_in': nrm(ks[6], (L, D_MODEL, D_IN), D_MODEL ** -0.5),
        'nsa_pe_k': nrm(ks[7], (L, CMP_LEN, dk), 0.1),
        'nsa_pe_v': nrm(ks[8], (L, CMP_LEN, dk), 0.1),
        'nsa_cmp_k_w1': nrm(ks[9], (L, CMP_LEN * dk, dk), (CMP_LEN * dk) ** -0.5),
        'nsa_cmp_k_w2': nrm(ks[10], (L, dk, dk), dk ** -0.5),
        'nsa_cmp_v_w1': nrm(ks[11], (L, CMP_LEN * dk, dk), (CMP_LEN * dk) ** -0.5),
        'nsa_cmp_v_w2': nrm(ks[12], (L, dk, dk), dk ** -0.5),
        'gla_gate_w2': nrm(ks[13], (L, GLA_GATE_RANK, GLA_HEADS * GLA_KEY_DIM), GLA_GATE_RANK ** -0.5),
        'gla_gate_b': nrm(ks[14], (L, GLA_HEADS * GLA_KEY_DIM), 0.1),
        'gla_norm': 1.0 + nrm(ks[15], (L, GLA_VAL_DIM), 0.02),
        'w_branch_a': nrm(ks[16], (L, NSA_WIDTH, D_MODEL), NSA_WIDTH ** -0.5),
        'w_branch_b': nrm(ks[17], (L, GLA_HEADS * GLA_VAL_DIM, D_MODEL), (GLA_HEADS * GLA_VAL_DIM) ** -0.5),
        'w_branch_c': nrm(ks[18], (L, MOBA_WIDTH, D_MODEL), MOBA_WIDTH ** -0.5),
        'w_out': nrm(ks[19], (L, D_MODEL, D_MODEL), D_MODEL ** -0.5),
        'w_ffn_in': nrm(ks[20], (L, D_MODEL, 2 * FFN_HIDDEN), D_MODEL ** -0.5),
        'w_ffn_out': nrm(ks[21], (L, FFN_HIDDEN, D_MODEL), FFN_HIDDEN ** -0.5),
    }


def reference(x, rel_bias, norm_mix_pre, norm_mix_post, norm_ffn_pre, norm_ffn_post, w_in,
              nsa_pe_k, nsa_pe_v, nsa_cmp_k_w1, nsa_cmp_k_w2, nsa_cmp_v_w1, nsa_cmp_v_w2,
              gla_gate_w2, gla_gate_b, gla_norm, w_branch_a, w_branch_b, w_branch_c, w_out,
              w_ffn_in, w_ffn_out):
    b, s, _ = x.shape
    split_points = np.cumsum(SPLIT_SIZES)[:-1].tolist()
    rel_a = rel_bias[:, :NSA_HEADS]
    rel_c = rel_bias[:, NSA_HEADS:]
    for layer in range(DEPTH):
        h = rmsnorm(x, norm_mix_pre[layer])
        (a_q, a_kc, a_vc, a_ks, a_vs, a_kw, a_vw, a_g,
         b_q, b_k, b_v, b_r, b_lr, c_q, c_k, c_v, mg) = jnp.split(h @ w_in[layer], split_points, axis=-1)
        o_a = nsa_mixer(a_q, a_kc, a_vc, a_ks, a_vs, a_kw, a_vw, a_g, rel_a,
                        nsa_pe_k[layer], nsa_pe_v[layer], nsa_cmp_k_w1[layer], nsa_cmp_k_w2[layer],
                        nsa_cmp_v_w1[layer], nsa_cmp_v_w2[layer])
        log_a = jax.nn.log_sigmoid((b_lr @ gla_gate_w2[layer] + gla_gate_b[layer]).astype(jnp.float32)) / GLA_GATE_TAU
        o_b = gla_mixer(b_q, b_k, b_v, log_a, b_r, gla_norm[layer])
        o_c = moba_mixer(c_q, c_k, c_v, rel_c)
        g = jax.nn.sigmoid(mg).reshape(b, s, N_BRANCHES, D_MODEL)
        merged = (g[:, :, 0] * (o_a @ w_branch_a[layer])
                  + g[:, :, 1] * (o_b @ w_branch_b[layer])
                  + g[:, :, 2] * (o_c @ w_branch_c[layer]))
        x = x + rmsnorm(merged @ w_out[layer], norm_mix_post[layer])
        h = rmsnorm(x, norm_ffn_pre[layer])
        gate, up = jnp.split(h @ w_ffn_in[layer], 2, axis=-1)
        x = x + rmsnorm((jax.nn.silu(gate) * up) @ w_ffn_out[layer], norm_ffn_post[layer])
    return x
```

```cpp
#include <hip/hip_runtime.h>
#include <cstdio>
#include <cstdint>
#include <cmath>
namespace pg8 {
#define PG8_LAS __attribute__((address_space(3)))
typedef unsigned short bf16_t;
typedef short bf16x8 __attribute__((ext_vector_type(8)));
typedef float f32x4 __attribute__((ext_vector_type(4)));
typedef unsigned u32x4 __attribute__((ext_vector_type(4)));
constexpr int BM = 256, BK = 64, HALF = 128, HTB = HALF * BK * 2  , STAGE_BYTES = 8 * HTB, NXCD = 8, WGM = 8;

__host__ __device__ __forceinline__ int lds_byte(int r, int c) { const int st = (r >> 4) * 2 + (c >> 5), rr = r & 15, cc = c & 31, ob = rr * 64 + cc * 2; return st * 1024 + (ob ^ (((ob >> 9) & 1) << 5)); }
__host__ __device__ __forceinline__ void stage_rc(int b, int& R, int& C) { const int st = b / 1024, sb = b % 1024, swz = sb ^ (((sb >> 9) & 1) << 5); R = (st >> 1) * 16 + swz / 64; C = (st & 1) * 32 + (swz % 64) / 2; }
__host__ __device__ __forceinline__ int perm32(int rho) { const int n = rho >> 4, i = rho & 15; return 8 * (i >> 2) + 4 * n + (i & 3); }

struct Unit { int pm, pn; };
struct Gemm { const bf16_t* A; const bf16_t* Bt; int M, N, K, lda; };

struct StaticOrder {
    int nM, nN, nwg, G, c;
    __host__ __device__ void init(int M, int N, int G_, int c_) { nM = M / BM; nN = N / BM; nwg = nM * nN; G = G_; c = c_; }
    __host__ __device__ bool next(int i, Unit& u) const {
        const long L = (long)i * G + c; if (L >= nwg) return false;
        int wgid = (int)L; { const int q = nwg / NXCD, r = nwg % NXCD, xcd = wgid % NXCD, off = wgid / NXCD; wgid = (xcd < r ? xcd * (q + 1) : r * (q + 1) + (xcd - r) * q) + off; }
        const int nig = WGM * nN, gid = wgid / nig, fm = gid * WGM, gsz = (nM - fm) < WGM ? (nM - fm) : WGM;
        u.pm = fm + ((wgid % nig) % gsz); u.pn = (wgid % nig) / gsz; return true;
    }
    __device__ __forceinline__ void a_ready(const Unit&) const {}
    __device__ __forceinline__ void done(const Unit&) const {}
};

__device__ __forceinline__ unsigned cvt_pk_bf16(float lo, float hi) { unsigned r; asm volatile("v_cvt_pk_bf16_f32 %0, %1, %2" : "=v"(r) : "v"(lo), "v"(hi)); return r; }
typedef float f32x2 __attribute__((ext_vector_type(2)));
constexpr int YP_ = 4392;
constexpr float C2_ = 0.125f * 1.4426950408889634f;
__device__ __forceinline__ float sigmoidf_(float v) { return 1.f / (1.f + __expf(-v)); }
struct EpiInProj {
    static constexpr bool PERM = true, AFTER_DRAIN = false;
    bf16_t* Y; unsigned char* G8;
    __device__ __forceinline__ void operator()(const f32x4 (&acc)[2][2][4][2], const Unit& u, int wr, int wc, int fr, int fq) const {
        const int row0 = u.pm * BM + wr * 64 + fr, colt = u.pn * BM, cin = wc * 32 + 8 * fq;
        if (u.pn < 18) {
            float sc = 1.f; if (u.pn < 2 || u.pn == 5 || u.pn == 6) sc = C2_; else if (u.pn == 11) sc = 0.125f;
#pragma unroll
            for (int ai = 0; ai < 2; ++ai)
#pragma unroll
                for (int m = 0; m < 4; ++m) { bf16_t* rowp = Y + (size_t)(row0 + ai * HALF + m * 16) * YP_;
#pragma unroll
                    for (int bj = 0; bj < 2; ++bj) { const int col = colt + cin + bj * HALF;
                        if (col + 8 <= YP_) { const f32x4 v0 = acc[ai][bj][m][0] * sc, v1 = acc[ai][bj][m][1] * sc; u32x4 w;
                            w.x = cvt_pk_bf16(v0[0], v0[1]); w.y = cvt_pk_bf16(v0[2], v0[3]); w.z = cvt_pk_bf16(v1[0], v1[1]); w.w = cvt_pk_bf16(v1[2], v1[3]);
                            *(u32x4*)(rowp + col) = w; } } }
        } else {
#pragma unroll
            for (int ai = 0; ai < 2; ++ai)
#pragma unroll
                for (int m = 0; m < 4; ++m) { unsigned char* rowp = G8 + (size_t)(row0 + ai * HALF + m * 16) * 3072 + (colt - 4608) + cin;
#pragma unroll
                    for (int bj = 0; bj < 2; ++bj) { const f32x4 v0 = acc[ai][bj][m][0], v1 = acc[ai][bj][m][1]; unsigned lo = 0u, hi = 0u;
#pragma unroll
                        for (int e = 0; e < 4; ++e) { lo |= (unsigned)(sigmoidf_(v0[e]) * 255.f + 0.5f) << (8 * e); hi |= (unsigned)(sigmoidf_(v1[e]) * 255.f + 0.5f) << (8 * e); }
                        typedef unsigned u32x2 __attribute__((ext_vector_type(2))); u32x2 w; w.x = lo; w.y = hi; *(u32x2*)(rowp + bj * HALF) = w; } }
        }
    }
};
template <int I> struct EpiMerge {
    static constexpr bool PERM = true, AFTER_DRAIN = false;
    bf16_t* Mg; const unsigned char* G8;
    __device__ __forceinline__ void operator()(const f32x4 (&acc)[2][2][4][2], const Unit& u, int wr, int wc, int fr, int fq) const {
        const int row0 = u.pm * BM + wr * 64 + fr, col0 = u.pn * BM + wc * 32 + 8 * fq;
#pragma unroll
        for (int ai = 0; ai < 2; ++ai)
#pragma unroll
            for (int m = 0; m < 4; ++m) { const size_t row = (size_t)(row0 + ai * HALF + m * 16);
#pragma unroll
                for (int bj = 0; bj < 2; ++bj) { const int col = col0 + bj * HALF;
                    typedef unsigned u32x2 __attribute__((ext_vector_type(2)));
                    const u32x2 gw = *(const u32x2*)(G8 + row * 3072 + I * 1024 + col);
                    float v[8];
#pragma unroll
                    for (int e = 0; e < 4; ++e) { v[e] = acc[ai][bj][m][0][e] * ((float)((gw.x >> (8 * e)) & 255u) * (1.f / 255.f)); v[4 + e] = acc[ai][bj][m][1][e] * ((float)((gw.y >> (8 * e)) & 255u) * (1.f / 255.f)); }
                    bf16_t* p = Mg + row * 1024 + col;
                    if (I > 0) { const u32x4 o = *(const u32x4*)p;
                        v[0] += __uint_as_float(o.x << 16); v[1] += __uint_as_float(o.x & 0xffff0000u); v[2] += __uint_as_float(o.y << 16); v[3] += __uint_as_float(o.y & 0xffff0000u);
                        v[4] += __uint_as_float(o.z << 16); v[5] += __uint_as_float(o.z & 0xffff0000u); v[6] += __uint_as_float(o.w << 16); v[7] += __uint_as_float(o.w & 0xffff0000u); }
                    u32x4 w; w.x = cvt_pk_bf16(v[0], v[1]); w.y = cvt_pk_bf16(v[2], v[3]); w.z = cvt_pk_bf16(v[4], v[5]); w.w = cvt_pk_bf16(v[6], v[7]);
                    *(u32x4*)p = w; } }
    }
};
struct EpiF32 {
    static constexpr bool PERM = true, AFTER_DRAIN = false;
    float* O; int ldc;
    __device__ __forceinline__ void operator()(const f32x4 (&acc)[2][2][4][2], const Unit& u, int wr, int wc, int fr, int fq) const {
        const int row0 = u.pm * BM + wr * 64 + fr, col0 = u.pn * BM + wc * 32 + 8 * fq;
#pragma unroll
        for (int ai = 0; ai < 2; ++ai)
#pragma unroll
            for (int m = 0; m < 4; ++m) { float* rowp = O + (size_t)(row0 + ai * HALF + m * 16) * ldc + col0;
#pragma unroll
                for (int bj = 0; bj < 2; ++bj) { *(f32x4*)(rowp + bj * HALF) = acc[ai][bj][m][0]; *(f32x4*)(rowp + bj * HALF + 4) = acc[ai][bj][m][1]; } }
    }
};
struct EpiSwiglu {
    static constexpr bool PERM = true, AFTER_DRAIN = false;
    bf16_t* Act; int ldc;
    __device__ __forceinline__ void operator()(const f32x4 (&acc)[2][2][4][2], const Unit& u, int wr, int wc, int fr, int fq) const {
        const int row0 = u.pm * BM + wr * 64 + fr, col0 = u.pn * HALF + wc * 32 + 8 * fq;
#pragma unroll
        for (int ai = 0; ai < 2; ++ai)
#pragma unroll
            for (int m = 0; m < 4; ++m) { bf16_t* p = Act + (size_t)(row0 + ai * HALF + m * 16) * ldc + col0; float v[8];
#pragma unroll
                for (int e = 0; e < 4; ++e) { const float g0 = acc[ai][0][m][0][e], g1 = acc[ai][0][m][1][e];
                    v[e] = g0 * sigmoidf_(g0) * acc[ai][1][m][0][e]; v[4 + e] = g1 * sigmoidf_(g1) * acc[ai][1][m][1][e]; }
                u32x4 w; w.x = cvt_pk_bf16(v[0], v[1]); w.y = cvt_pk_bf16(v[2], v[3]); w.z = cvt_pk_bf16(v[4], v[5]); w.w = cvt_pk_bf16(v[6], v[7]);
                *(u32x4*)p = w; }
    }
};
template <class Epi, class Sched, bool ALIGN_EPI = false, bool SP2 = false>
__device__ __forceinline__ void gemm_phase(PG8_LAS unsigned char* lds, const Gemm g, const Sched& S, const Epi& E) {
    const int tid = threadIdx.x, wid = __builtin_amdgcn_readfirstlane(tid >> 6), lane = tid & 63, wr = wid >> 2, wc = wid & 3, fr = lane & 15, fq = lane >> 4;
    const int K = g.K, nt = K / BK;
    unsigned voffA[2], voffB[2];
#pragma unroll
    for (int i = 0; i < 2; ++i) { int R, C; stage_rc(tid * 16 + i * 8192, R, C); const int Rb = Epi::PERM ? ((R & ~31) + perm32(R & 31)) : R;
        voffA[i] = (unsigned)(R * g.lda + C) * 2u; voffB[i] = (unsigned)(Rb * K + C) * 2u; }
    const size_t kstep = (size_t)(BK * 2);
    const size_t hstepB = (size_t)HALF * K * 2, hstepA = (size_t)HALF * g.lda * 2;
    const size_t tstepA = 2 * hstepA, tstepB = 2 * hstepB;
    const unsigned ldsw = (unsigned)wid * 1024u;
    const int aoff = lds_byte(wr * 64 + fr, fq * 8), boff = lds_byte(wc * 32 + fr, fq * 8);
#define PG8_SA(b, h) (((b) * 2 + (h)) * HTB)
#define PG8_SB(b, h) ((4 + (b) * 2 + (h)) * HTB)
#define PG8_STAGE(bufoff, gbase, voff) do { _Pragma("unroll") for (int _i = 0; _i < 2; ++_i) \
        __builtin_amdgcn_global_load_lds((const unsigned*)((const char*)(gbase) + (voff)[_i]), (PG8_LAS unsigned*)(lds + (bufoff) + ldsw + _i * 8192), 16, 0, 0); } while (0)
#define PG8_LDA(dst, b, h) do { _Pragma("unroll") for (int m = 0; m < 4; ++m) _Pragma("unroll") for (int k = 0; k < 2; ++k) dst[m][k] = *(const PG8_LAS bf16x8*)(lds + PG8_SA(b, h) + aoff + m * 2048 + k * 1024); } while (0)
#define PG8_LDB(dst, b, h) do { _Pragma("unroll") for (int n = 0; n < 2; ++n) _Pragma("unroll") for (int k = 0; k < 2; ++k) dst[n][k] = *(const PG8_LAS bf16x8*)(lds + PG8_SB(b, h) + boff + n * 2048 + k * 1024); } while (0)
#define PG8_MMA(ai, bj, At, Bt) do { __builtin_amdgcn_s_setprio(1); _Pragma("unroll") for (int m = 0; m < 4; ++m) _Pragma("unroll") for (int n = 0; n < 2; ++n) _Pragma("unroll") for (int k = 0; k < 2; ++k) \
        acc[ai][bj][m][n] = __builtin_amdgcn_mfma_f32_16x16x32_bf16(Bt[n][k], At[m][k], acc[ai][bj][m][n], 0, 0, 0); __builtin_amdgcn_s_setprio(0); } while (0)
#define PG8_WAIT_V(n) asm volatile("s_waitcnt vmcnt(" #n ")" ::: "memory")
#define PG8_WAIT_L(n) asm volatile("s_waitcnt lgkmcnt(" #n ")" ::: "memory")
#define PG8_BAR __builtin_amdgcn_s_barrier()
#define PG8_SCHED __builtin_amdgcn_sched_barrier(0)
    Unit cur, nxt; int ui = 0;
    if (!S.next(0, cur)) return;
    f32x4 acc[2][2][4][2];
#pragma unroll
    for (int a = 0; a < 2; ++a)
#pragma unroll
        for (int b = 0; b < 2; ++b)
#pragma unroll
            for (int m = 0; m < 4; ++m)
#pragma unroll
                for (int n = 0; n < 2; ++n) acc[a][b][m][n] = (f32x4){0.f, 0.f, 0.f, 0.f};
    bf16x8 At[4][2], B0[2][2], B1[2][2];
    const char* cA = (const char*)g.A + (size_t)cur.pm * tstepA; const char* cB = (const char*)g.Bt + (size_t)cur.pn * tstepB;
    S.a_ready(cur);
    if constexpr (SP2) {
        PG8_STAGE(PG8_SB(0, 0), cB, voffB); PG8_STAGE(PG8_SB(0, 1), cB + hstepB, voffB); PG8_STAGE(PG8_SA(0, 0), cA, voffA); PG8_STAGE(PG8_SA(0, 1), cA + hstepA, voffA);
        if (wr == 1) PG8_BAR;
        PG8_WAIT_V(2); PG8_BAR;
        PG8_STAGE(PG8_SB(1, 0), cB + kstep, voffB); PG8_STAGE(PG8_SA(1, 0), cA + kstep, voffA); PG8_STAGE(PG8_SB(1, 1), cB + hstepB + kstep, voffB);
        PG8_WAIT_V(6); PG8_BAR;
    } else {
        PG8_STAGE(PG8_SB(0, 0), cB, voffB); PG8_STAGE(PG8_SA(0, 0), cA, voffA); PG8_STAGE(PG8_SB(0, 1), cB + hstepB, voffB); PG8_STAGE(PG8_SA(0, 1), cA + hstepA, voffA);
        if (wr == 1) PG8_BAR;
        PG8_WAIT_V(4); PG8_BAR;
        PG8_STAGE(PG8_SB(1, 0), cB + kstep, voffB); PG8_STAGE(PG8_SA(1, 0), cA + kstep, voffA); PG8_STAGE(PG8_SB(1, 1), cB + hstepB + kstep, voffB);
        PG8_WAIT_V(6); PG8_BAR;
    }
    for (;;) {
        const bool has_next = S.next(ui + 1, nxt);
        const char* nA = has_next ? (const char*)g.A + (size_t)nxt.pm * tstepA : cA; const char* nB = has_next ? (const char*)g.Bt + (size_t)nxt.pn * tstepB : cB;
        for (int t = 0; t < nt; t += 2) {
            const bool last = (t == nt - 2);
            const char* a1 = cA + (size_t)(t + 1) * kstep;
            const char* a2 = last ? nA : cA + (size_t)(t + 2) * kstep; const char* b2 = last ? nB : cB + (size_t)(t + 2) * kstep;
            const char* a3 = a2 + kstep; const char* b3 = b2 + kstep;
            if (last && has_next) S.a_ready(nxt);
            if constexpr (SP2) {
            PG8_LDB(B0, 0, 0); PG8_LDB(B1, 0, 1); PG8_SCHED; PG8_LDA(At, 0, 0); PG8_STAGE(PG8_SA(1, 1), a1 + hstepA, voffA);
            PG8_WAIT_V(8); PG8_WAIT_L(0); PG8_BAR; PG8_MMA(0, 0, At, B0); PG8_MMA(0, 1, At, B1); PG8_BAR; PG8_SCHED;
            PG8_LDA(At, 0, 1); PG8_STAGE(PG8_SB(0, 0), b2, voffB); PG8_STAGE(PG8_SB(0, 1), b2 + hstepB, voffB); PG8_STAGE(PG8_SA(0, 0), a2, voffA);
            PG8_WAIT_V(8); PG8_WAIT_L(0); PG8_BAR; PG8_MMA(1, 0, At, B0); PG8_MMA(1, 1, At, B1); PG8_BAR; PG8_SCHED;
            PG8_LDB(B0, 1, 0); PG8_LDB(B1, 1, 1); PG8_SCHED; PG8_LDA(At, 1, 0); PG8_STAGE(PG8_SA(0, 1), a2 + hstepA, voffA);
            PG8_WAIT_V(8); PG8_WAIT_L(0); PG8_BAR; PG8_MMA(0, 0, At, B0); PG8_MMA(0, 1, At, B1); PG8_BAR; PG8_SCHED;
            PG8_LDA(At, 1, 1); PG8_STAGE(PG8_SB(1, 0), b3, voffB); PG8_STAGE(PG8_SB(1, 1), b3 + hstepB, voffB); PG8_STAGE(PG8_SA(1, 0), a3, voffA);
            PG8_WAIT_V(8); PG8_WAIT_L(0); PG8_BAR; PG8_MMA(1, 0, At, B0); PG8_MMA(1, 1, At, B1); PG8_BAR; PG8_SCHED;
            } else {
            PG8_LDB(B0, 0, 0); PG8_SCHED; PG8_LDA(At, 0, 0); PG8_STAGE(PG8_SA(1, 1), a1 + hstepA, voffA);
            PG8_WAIT_L(8); PG8_BAR; PG8_WAIT_L(0); PG8_MMA(0, 0, At, B0); PG8_BAR; PG8_SCHED;
            PG8_LDB(B1, 0, 1); PG8_STAGE(PG8_SB(0, 0), b2, voffB);
            PG8_BAR; PG8_WAIT_L(0); PG8_MMA(0, 1, At, B1); PG8_BAR;
            PG8_LDA(At, 0, 1); PG8_STAGE(PG8_SA(0, 0), a2, voffA);
            PG8_BAR; PG8_WAIT_L(0); PG8_MMA(1, 0, At, B0); PG8_BAR; PG8_SCHED;
            PG8_STAGE(PG8_SB(0, 1), b2 + hstepB, voffB);
            PG8_WAIT_V(6); PG8_BAR; PG8_MMA(1, 1, At, B1); PG8_BAR;
            PG8_LDB(B0, 1, 0); PG8_SCHED; PG8_LDA(At, 1, 0); PG8_STAGE(PG8_SA(0, 1), a2 + hstepA, voffA);
            PG8_WAIT_L(8); PG8_BAR; PG8_WAIT_L(0); PG8_MMA(0, 0, At, B0); PG8_BAR; PG8_SCHED;
            PG8_LDB(B1, 1, 1); PG8_STAGE(PG8_SB(1, 0), b3, voffB);
            PG8_BAR; PG8_WAIT_L(0); PG8_MMA(0, 1, At, B1); PG8_BAR;
            PG8_LDA(At, 1, 1); PG8_STAGE(PG8_SA(1, 0), a3, voffA);
            PG8_BAR; PG8_WAIT_L(0); PG8_MMA(1, 0, At, B0); PG8_BAR; PG8_SCHED;
            PG8_STAGE(PG8_SB(1, 1), b3 + hstepB, voffB);
            PG8_WAIT_V(6); PG8_BAR; PG8_MMA(1, 1, At, B1); PG8_BAR;
            }
        }
        if constexpr (ALIGN_EPI) { if (wr == 0) PG8_BAR; }
        if constexpr (!Epi::AFTER_DRAIN) { E(acc, cur, wr, wc, fr, fq); S.done(cur); }
        if (!has_next) break;
#pragma unroll
        for (int a = 0; a < 2; ++a)
#pragma unroll
            for (int b = 0; b < 2; ++b)
#pragma unroll
                for (int m = 0; m < 4; ++m)
#pragma unroll
                    for (int n = 0; n < 2; ++n) acc[a][b][m][n] = (f32x4){0.f, 0.f, 0.f, 0.f};
        cur = nxt; cA = nA; cB = nB; ++ui;
        if constexpr (ALIGN_EPI) { if (wr == 1) PG8_BAR; }
    }
    PG8_WAIT_V(0);
    if constexpr (!ALIGN_EPI) { if (wr == 0) PG8_BAR; }
    PG8_BAR;
    if constexpr (Epi::AFTER_DRAIN) { E.fused(acc, cur, wr, wc, fr, fq, lds, wid, lane); S.done(cur); }
#undef PG8_SA
#undef PG8_SB
#undef PG8_STAGE
#undef PG8_LDA
#undef PG8_LDB
#undef PG8_MMA
#undef PG8_WAIT_V
#undef PG8_WAIT_L
#undef PG8_BAR
#undef PG8_SCHED
}
}
constexpr int NWAVES = 8;
constexpr int B_ = 4, S_ = 8192, DM = 1024, M_ = B_ * S_, DIN = 7464, FF = 2816, NL = 2;
constexpr int YP = pg8::YP_;
constexpr float C2 = pg8::C2_, LOG2E = 1.4426950408889634f;
constexpr float NORM_EPS = 1e-6f;
constexpr int Y_AQ = 0, Y_AKC = 512, Y_AVC = 640, Y_AKS = 768, Y_AVS = 896, Y_AKW = 1024, Y_AVW = 1152, Y_CQ = 1280, Y_CK = 1792, Y_CV = 2304,
              Y_BQ = 2816, Y_BK = 3072, Y_BV = 3328, Y_BR = 3840, Y_AG = 4352, Y_BLR = 4376;
constexpr int NIN = 7680;
constexpr size_t MiB = 1u << 20;
constexpr size_t WS_CTL = 0, CTL_ZERO_BYTES = 1 * MiB;
constexpr size_t WS_WIN = 1 * MiB, WS_WA = 16 * MiB, WS_WB = 17 * MiB, WS_WC = 18 * MiB, WS_WO = 19 * MiB, WS_WF1 = 21 * MiB, WS_WF2 = 32 * MiB;
constexpr size_t WS_H = 40 * MiB;
constexpr size_t WS_Y = 104 * MiB;
constexpr size_t WS_G8 = 379 * MiB;
constexpr size_t WS_ACT = WS_Y + 128 * MiB;
constexpr size_t WS_SM = 475 * MiB;
constexpr size_t WS_KCMP = WS_SM, WS_VCMP = WS_SM + 1 * MiB, WS_KMEAN = WS_SM + 2 * MiB;
constexpr size_t WS_GA = WS_SM + 3 * MiB;
constexpr size_t WS_END = 512 * MiB;
static_assert(WS_GA + (size_t)M_ * 256 * 4 <= WS_END && WS_Y + (size_t)M_ * YP * 2 <= WS_G8 && WS_G8 + (size_t)M_ * 3072 <= WS_SM, "ws map");
static_assert(WS_ACT + (size_t)M_ * FF * 2 <= WS_SM && WS_WF2 + (size_t)DM * FF * 2 <= WS_H, "ws map 2");
constexpr int CW_BAR = 4096;
constexpr int RING_OFF = 0, RING_BYTES = 131072;
constexpr int LDSCTL_OFF = RING_BYTES, MISC_OFF = LDSCTL_OFF + 320;
constexpr int LDS_BYTES = 147456;

#define GAS __attribute__((address_space(1)))
#define LAS __attribute__((address_space(3)))
typedef unsigned short bf16;
typedef unsigned v4u __attribute__((ext_vector_type(4)));
typedef float f32x4 __attribute__((ext_vector_type(4)));
typedef short bf16x8 __attribute__((ext_vector_type(8)));
typedef GAS unsigned gu32;
typedef GAS unsigned long long gu64;
#define RLX_AGENT __ATOMIC_RELAXED, __HIP_MEMORY_SCOPE_AGENT
#define LDS_WAIT() asm volatile("s_waitcnt lgkmcnt(0)" ::: "memory")
#define VM_WAIT() asm volatile("s_waitcnt vmcnt(0)" ::: "memory")
__device__ __forceinline__ unsigned long long rt() { return __builtin_amdgcn_s_memrealtime(); }
__device__ __forceinline__ unsigned f2bf(float f) { unsigned u = __builtin_bit_cast(unsigned, f); return (u + 0x7fffu + ((u >> 16) & 1u)) >> 16; }
__device__ __forceinline__ unsigned pk2(float lo, float hi) { return f2bf(lo) | (f2bf(hi) << 16); }

__device__ __forceinline__ float bf2f(bf16 h) { return __uint_as_float((unsigned)h << 16); }
__device__ __forceinline__ float sigm(float v) { return 1.f / (1.f + __expf(-v)); }
#define WFENCE() asm volatile("s_waitcnt lgkmcnt(0)" ::: "memory")

#define XB_TMO      128
#define XB_XCNT(j)  (256  + 64 * (j))
#define XB_XSUB(j)  (1280 + 64 * (j))
#define XB_XGEN(j)  (2304 + 64 * (j))
#define XB_TOP      3328
#define XB_TOPGEN   3392
#define XCD_BAR_WORDS 3456
#define XB_SPIN_CAP (1u << 18)

__device__ __forceinline__ unsigned xb_ld(unsigned* p)              { return __hip_atomic_load(p, __ATOMIC_RELAXED, __HIP_MEMORY_SCOPE_AGENT); }
__device__ __forceinline__ unsigned xb_add(unsigned* p, unsigned v) { return __hip_atomic_fetch_add(p, v, __ATOMIC_RELAXED, __HIP_MEMORY_SCOPE_AGENT); }
__device__ __forceinline__ unsigned xb_xcc_id() { return (unsigned)__builtin_amdgcn_s_getreg((3 << 11) | 20) & 0xFu; }
#define XB_SPIN(cond, bar) do { unsigned _sp = 0; while (cond) { __builtin_amdgcn_s_sleep(1); \
    if ((++_sp & 255u) == 0u) { if (xb_ld(&(bar)[XB_TMO])) break; if (_sp > XB_SPIN_CAP) { atomicAdd(&(bar)[XB_TMO], 1u); break; } } } } while (0)

struct XcdBarrier {
    unsigned* bar; unsigned x;
    volatile LAS unsigned* st;
};

__device__ __forceinline__ XcdBarrier xcd_barrier_post(unsigned* bar, volatile LAS unsigned* st) {
    XcdBarrier b; b.bar = bar; b.x = xb_xcc_id(); b.st = st;
    if (threadIdx.x == 0) (void)xb_add(&bar[XB_XCNT(b.x)], 1u);
    return b;
}
__device__ __forceinline__ void xcd_barrier_complete(unsigned* bar, unsigned x, unsigned& nloc, unsigned& nx) {
    const unsigned G = gridDim.x * gridDim.y * gridDim.z;
    unsigned sum, cnt, mine, sp = 0u;
    for (;;) {
        sum = 0u; cnt = 0u; mine = 0u;
#pragma unroll
        for (unsigned j = 0; j < 16; ++j) { const unsigned c = xb_ld(&bar[XB_XCNT(j)]); sum += c; cnt += (c > 0u) ? 1u : 0u; mine = (j == x) ? c : mine; }
        if (sum == G) break;
        __builtin_amdgcn_s_sleep(1);
        if ((++sp & 255u) == 0u) { if (xb_ld(&bar[XB_TMO])) break; if (sp > XB_SPIN_CAP) { atomicAdd(&bar[XB_TMO], 1u); break; } }
    }
    nloc = mine > 0u ? mine : 1u; nx = cnt > 0u ? cnt : 1u;
}

__device__ __forceinline__ void xcd_barrier(const XcdBarrier& b) {
    asm volatile("s_waitcnt vmcnt(0)" ::: "memory");
    __syncthreads();
    if (threadIdx.x == 0) {
        unsigned* bar = b.bar;
        __builtin_amdgcn_s_waitcnt(0);
        unsigned nloc = b.st[0], nx = b.st[1];
        if (nloc == 0u) { xcd_barrier_complete(bar, b.x, nloc, nx); b.st[0] = nloc; b.st[1] = nx; }
        const unsigned old = xb_add(&bar[XB_XSUB(b.x)], 1u);
        const unsigned gen = old / nloc;
        if (old + 1u == (gen + 1u) * nloc) {
            __builtin_amdgcn_fence(__ATOMIC_RELEASE, "agent");
            asm volatile("s_waitcnt vmcnt(0)" ::: "memory");
            const unsigned og = xb_add(&bar[XB_TOP], 1u);
            const unsigned tg = og / nx;
            if (og + 1u == (tg + 1u) * nx) xb_add(&bar[XB_TOPGEN], 1u);
            else XB_SPIN(xb_ld(&bar[XB_TOPGEN]) == tg, bar);
            __builtin_amdgcn_fence(__ATOMIC_ACQUIRE, "agent");
            xb_add(&bar[XB_XGEN(b.x)], 1u);
            asm volatile("s_waitcnt vmcnt(0)" ::: "memory");
        } else {
            XB_SPIN(xb_ld(&bar[XB_XGEN(b.x)]) == gen, bar);
            __builtin_amdgcn_fence(__ATOMIC_ACQUIRE, "agent");
            asm volatile("s_waitcnt vmcnt(0)" ::: "memory");
        }
    }
    __syncthreads();
}


struct Frame {
    LAS unsigned char* lds;
    volatile LAS unsigned* MISC;
    gu32* ctl;
    int tid, lane, wave, G;
};
__device__ __forceinline__ float wave_sum(float v) {
#pragma unroll
    for (int o = 1; o < 64; o <<= 1) v += __shfl_xor(v, o);
    return v;
}
__device__ __forceinline__ float wave_max(float v) {
#pragma unroll
    for (int o = 1; o < 64; o <<= 1) v = fmaxf(v, __shfl_xor(v, o));
    return v;
}
__device__ __forceinline__ int t5_bucket(int d) {
    if (d < 16) return d < 0 ? 0 : d;
    int b = 16;
    b += (d >= 19); b += (d >= 21); b += (d >= 24); b += (d >= 27); b += (d >= 31); b += (d >= 35); b += (d >= 40); b += (d >= 46);
    b += (d >= 52); b += (d >= 59); b += (d >= 67); b += (d >= 77); b += (d >= 87); b += (d >= 99); b += (d >= 113);
    return b;
}
template <class CM> __device__ __forceinline__ void tr_item(const float* W, int Nsrc, int K, bf16* WT, int item, int nblk, CM cm, LAS float* scr, int lane) {
    const int kb = item / nblk, nb = item % nblk, k0 = 64 * kb, n0 = 32 * nb;
    const int sc = cm(n0 + (lane & 31));
#pragma unroll 8
    for (int i = 0; i < 32; ++i) { const int kk = 2 * i + (lane >> 5); scr[kk * 33 + (lane & 31)] = sc >= 0 ? W[(size_t)(k0 + kk) * Nsrc + sc] : 0.f; }
    LDS_WAIT(); asm volatile("" ::: "memory");
    const int c = lane & 7;
#pragma unroll
    for (int j = 0; j < 4; ++j) { const int n = (lane >> 3) + 8 * j; const LAS float* s = scr + (8 * c) * 33 + n;
        v4u o; o.x = pk2(s[0 * 33], s[1 * 33]); o.y = pk2(s[2 * 33], s[3 * 33]); o.z = pk2(s[4 * 33], s[5 * 33]); o.w = pk2(s[6 * 33], s[7 * 33]);
        *(GAS v4u*)(WT + (size_t)(n0 + n) * K + k0 + 8 * c) = o; }
    LDS_WAIT(); asm volatile("" ::: "memory");
}
struct CmId { __device__ __forceinline__ int operator()(int n) const { return n; } };
struct CmWin { __device__ __forceinline__ int operator()(int n) const {
    if (n < 1280) return n;
    if (n < 2816) return n - 1280 + 2856;
    if (n < 4352) return n - 2816 + 1304;
    if (n < 4376) return n - 4352 + 1280;
    if (n < 4392) return n - 4376 + 2840;
    if (n < 4608) return -1;
    return n - 4608 + 4392; } };
struct CmFfn { __device__ __forceinline__ int operator()(int c) const { const int p = c >> 8, r = c & 255; return r < 128 ? 128 * p + r : FF + 128 * p + (r - 128); } };

struct Args { const float* in[22]; float* out; unsigned char* ws; int ph_lo, ph_hi; };

__device__ __forceinline__ void phase_weights(Frame& F, const Args& a, int l) {
    LAS float* scr = (LAS float*)(F.lds + RING_OFF + F.wave * 16384);
    const int gw = blockIdx.x * NWAVES + F.wave, NGW = F.G * NWAVES;
    unsigned char* ws = a.ws;
    constexpr int I_IN = 16 * (NIN / 32), I_BR = 8 * 32, I_O = 16 * 32, I_F1 = 16 * (2 * FF / 32), I_F2 = (FF / 64) * 32;
    constexpr int NIT = I_IN + 3 * I_BR + I_O + I_F1 + I_F2;
    for (int it = gw; it < NIT; it += NGW) {
        int r = it;
        if (r < I_IN) { tr_item(a.in[6] + (size_t)l * DM * DIN, DIN, DM, (bf16*)(ws + WS_WIN), r, NIN / 32, CmWin(), scr, F.lane); continue; } r -= I_IN;
        if (r < I_BR) { tr_item(a.in[16] + (size_t)l * 512 * DM, DM, 512, (bf16*)(ws + WS_WA), r, 32, CmId(), scr, F.lane); continue; } r -= I_BR;
        if (r < I_BR) { tr_item(a.in[17] + (size_t)l * 512 * DM, DM, 512, (bf16*)(ws + WS_WB), r, 32, CmId(), scr, F.lane); continue; } r -= I_BR;
        if (r < I_BR) { tr_item(a.in[18] + (size_t)l * 512 * DM, DM, 512, (bf16*)(ws + WS_WC), r, 32, CmId(), scr, F.lane); continue; } r -= I_BR;
        if (r < I_O) { tr_item(a.in[19] + (size_t)l * DM * DM, DM, DM, (bf16*)(ws + WS_WO), r, 32, CmId(), scr, F.lane); continue; } r -= I_O;
        if (r < I_F1) { tr_item(a.in[20] + (size_t)l * DM * 2 * FF, 2 * FF, DM, (bf16*)(ws + WS_WF1), r, 2 * FF / 32, CmFfn(), scr, F.lane); continue; } r -= I_F1;
        tr_item(a.in[21] + (size_t)l * FF * DM, DM, FF, (bf16*)(ws + WS_WF2), r, 32, CmId(), scr, F.lane);
    }
}
__device__ __forceinline__ void phase_norm0(Frame& F, const float* x, const float* w, bf16* H) {
    const int gw = blockIdx.x * NWAVES + F.wave, NGW = F.G * NWAVES;
    for (int m = gw; m < M_; m += NGW) {
        const f32x4* xr = (const f32x4*)(x + (size_t)m * DM) + F.lane; f32x4 v[4]; float s = 0.f;
#pragma unroll
        for (int j = 0; j < 4; ++j) { v[j] = xr[64 * j]; s += v[j].x * v[j].x + v[j].y * v[j].y + v[j].z * v[j].z + v[j].w * v[j].w; }
        const float r = rsqrtf(wave_sum(s) * (1.f / DM) + NORM_EPS);
        unsigned long long* o8 = (unsigned long long*)(H + (size_t)m * DM) + F.lane;
#pragma unroll
        for (int j = 0; j < 4; ++j) { const f32x4 wv = ((const f32x4*)w)[F.lane + 64 * j];
            o8[64 * j] = (unsigned long long)pk2(v[j].x * r * wv.x, v[j].y * r * wv.y) | ((unsigned long long)pk2(v[j].z * r * wv.z, v[j].w * r * wv.w) << 32); }
    }
}
__device__ __forceinline__ void phase_resid(Frame& F, const float* y, const float* xin, float* xout, const float* wpost, const float* wpre, bf16* hout) {
    const int gw = blockIdx.x * NWAVES + F.wave, NGW = F.G * NWAVES;
    for (int m = gw; m < M_; m += NGW) {
        const f32x4* yr = (const f32x4*)(y + (size_t)m * DM) + F.lane; const f32x4* xr = (const f32x4*)(xin + (size_t)m * DM) + F.lane;
        f32x4 v[4], xv[4]; float s = 0.f;
#pragma unroll
        for (int j = 0; j < 4; ++j) { v[j] = yr[64 * j]; xv[j] = xr[64 * j]; s += v[j].x * v[j].x + v[j].y * v[j].y + v[j].z * v[j].z + v[j].w * v[j].w; }
        const float r = rsqrtf(wave_sum(s) * (1.f / DM) + NORM_EPS); float s2 = 0.f;
        f32x4* xo = (f32x4*)(xout + (size_t)m * DM) + F.lane;
#pragma unroll
        for (int j = 0; j < 4; ++j) { const f32x4 wv = ((const f32x4*)wpost)[F.lane + 64 * j]; f32x4 n;
            n.x = xv[j].x + v[j].x * r * wv.x; n.y = xv[j].y + v[j].y * r * wv.y; n.z = xv[j].z + v[j].z * r * wv.z; n.w = xv[j].w + v[j].w * r * wv.w;
            xo[64 * j] = n; v[j] = n; s2 += n.x * n.x + n.y * n.y + n.z * n.z + n.w * n.w; }
        if (hout) { const float r2 = rsqrtf(wave_sum(s2) * (1.f / DM) + NORM_EPS);
            unsigned long long* o8 = (unsigned long long*)(hout + (size_t)m * DM) + F.lane;
#pragma unroll
            for (int j = 0; j < 4; ++j) { const f32x4 wv = ((const f32x4*)wpre)[F.lane + 64 * j];
                o8[64 * j] = (unsigned long long)pk2(v[j].x * r2 * wv.x, v[j].y * r2 * wv.y) | ((unsigned long long)pk2(v[j].z * r2 * wv.z, v[j].w * r2 * wv.w) << 32); } }
    }
}
__device__ __forceinline__ void unpack8(const v4u w, float (&k)[8]) {
    k[0] = __uint_as_float(w.x << 16); k[1] = __uint_as_float(w.x & 0xffff0000u); k[2] = __uint_as_float(w.y << 16); k[3] = __uint_as_float(w.y & 0xffff0000u);
    k[4] = __uint_as_float(w.z << 16); k[5] = __uint_as_float(w.z & 0xffff0000u); k[6] = __uint_as_float(w.w << 16); k[7] = __uint_as_float(w.w & 0xffff0000u);
}
__device__ __forceinline__ void dot4(const LAS float* qs, const bf16* kr, float (&d)[4]) {
    d[0] = d[1] = d[2] = d[3] = 0.f;
#pragma unroll 1
    for (int c = 0; c < 8; ++c) { asm volatile("" ::: "memory"); const v4u w = ((const v4u*)kr)[c]; float k[8]; unpack8(w, k);
#pragma unroll
        for (int e = 0; e < 8; ++e) { const int dd = c * 8 + e;
#pragma unroll
            for (int h = 0; h < 4; ++h) d[h] += qs[h * 64 + dd] * k[e]; } }
}
__device__ __forceinline__ float dot1(const LAS float* qs, const bf16* kr) {
    float d = 0.f;
#pragma unroll
    for (int c = 0; c < 8; ++c) { const v4u w = ((const v4u*)kr)[c]; float k[8]; unpack8(w, k);
#pragma unroll
        for (int e = 0; e < 8; ++e) d += qs[c * 8 + e] * k[e]; }
    return d;
}
__device__ __forceinline__ float gelu_tanh(float x) { const float u = 0.7978845608028654f * (x + 0.044715f * x * x * x); return 0.5f * x * (1.f + tanhf(u)); }

__device__ __forceinline__ void phase2_naive(Frame& F, const Args& a, int l) {
    const int gw = blockIdx.x * NWAVES + F.wave, NGW = F.G * NWAVES, lane = F.lane;
    const bf16* Y = (const bf16*)(a.ws + WS_Y);
    LAS float* scr = (LAS float*)(F.lds + RING_OFF + F.wave * 16384);
    for (int t = gw; t < 2 * 8 * 511; t += NGW) {
        const int kv = t / (8 * 511), r = t % (8 * 511), bg = r / 511, n = r % 511, b = bg >> 1, g = bg & 1;
        const float* pe = a.in[kv ? 8 : 7] + (size_t)l * 32 * 64; const float* w1 = a.in[kv ? 11 : 9] + (size_t)l * 2048 * 64; const float* w2 = a.in[kv ? 12 : 10] + (size_t)l * 64 * 64;
        const bf16* src = Y + ((size_t)b * S_ + 16 * n) * YP + (kv ? Y_AVC : Y_AKC) + g * 64;
        float acc = 0.f;
        for (int pos = 0; pos < 32; ++pos) {
            const float xin = bf2f(src[(size_t)pos * YP + lane]) + pe[pos * 64 + lane];
            scr[lane] = xin; WFENCE();
#pragma unroll 8
            for (int d = 0; d < 64; ++d) acc += scr[d] * w1[(size_t)(pos * 64 + d) * 64 + lane];
            WFENCE();
        }
        const float hdn = gelu_tanh(acc);
        scr[lane] = hdn; WFENCE();
        float o = 0.f;
#pragma unroll 8
        for (int j = 0; j < 64; ++j) o += scr[j] * w2[j * 64 + lane];
        WFENCE();
        bf16* dst = (bf16*)(a.ws + (kv ? WS_VCMP : WS_KCMP)) + ((size_t)bg * 512 + n) * 64;
        dst[lane] = (bf16)f2bf(o);
    }
    for (int t = gw; t < 4 * 8 * 32; t += NGW) {
        const int blk = t & 31, h = (t >> 5) & 7, b = t >> 8;
        const bf16* src = Y + ((size_t)b * S_ + blk * 256) * YP + Y_CK + h * 64 + lane; float s = 0.f;
        for (int i = 0; i < 256; ++i) s += bf2f(src[(size_t)i * YP]);
        ((float*)(a.ws + WS_KMEAN))[(size_t)t * 64 + lane] = s * (1.f / 256.f);
    }
    {
        const float* w2 = a.in[13] + (size_t)l * 16 * 256; const float* bias = a.in[14] + (size_t)l * 256; float* GA = (float*)(a.ws + WS_GA);
        const long NT = (long)M_ * 256, stride = (long)F.G * 512;
        for (long i = (long)blockIdx.x * 512 + F.tid; i < NT; i += stride) {
            const int c = (int)(i & 255); const size_t row = (size_t)(i >> 8);
            float z = bias[c];
#pragma unroll
            for (int r = 0; r < 16; ++r) z += bf2f(Y[row * YP + Y_BLR + r]) * w2[r * 256 + c];
            const float ls = -(fmaxf(-z, 0.f) + log1pf(__expf(-fabsf(z))));
            GA[i] = __expf(ls * (1.f / 16.f));
        }
    }
}
__device__ __forceinline__ void gla_scan_naive(Frame& F, const Args& a) {
    const bf16* Y = (const bf16*)(a.ws + WS_Y); const float* GA = (const float*)(a.ws + WS_GA); float* O32 = (float*)(a.ws + WS_H);
    const int lane = F.lane;
    for (int task = blockIdx.x; task < 256; task += F.G) {
        const int eg = task & 15, h = (task >> 4) & 3, b = task >> 6, e = eg * 8 + F.wave;
        float Sst = 0.f;
        for (int t0 = 0; t0 < S_; t0 += 8) {
            float av[8], kv[8], qv[8], vv[8];
#pragma unroll
            for (int j = 0; j < 8; ++j) { const size_t row = (size_t)b * S_ + t0 + j;
                av[j] = GA[row * 256 + h * 64 + lane]; kv[j] = bf2f(Y[row * YP + Y_BK + h * 64 + lane]); qv[j] = bf2f(Y[row * YP + Y_BQ + h * 64 + lane]); vv[j] = bf2f(Y[row * YP + Y_BV + h * 128 + e]); }
#pragma unroll
            for (int j = 0; j < 8; ++j) { Sst = av[j] * Sst + kv[j] * vv[j]; const float o = wave_sum(qv[j] * Sst);
                if (lane == 0) O32[((size_t)b * S_ + t0 + j) * 512 + h * 128 + e] = o; }
        }
    }
}
__device__ __forceinline__ void nsa_naive(Frame& F, const Args& a) {
    const int gw = blockIdx.x * NWAVES + F.wave, NGW = F.G * NWAVES, lane = F.lane;
    bf16* Y = (bf16*)(a.ws + WS_Y); const float* rel = a.in[1];
    LAS float* scr = (LAS float*)(F.lds + RING_OFF + F.wave * 16384);
    LAS float* qs = scr; LAS float* sc = scr + 256; LAS float* s2 = scr + 256 + 2048;
    for (int task = gw; task < 8 * S_; task += NGW) {
        const int q = task & (S_ - 1), bg = task >> 13, g = bg & 1, b = bg >> 1;
        const size_t row = (size_t)b * S_ + q; bf16* Yr = Y + row * YP;
#pragma unroll
        for (int h = 0; h < 4; ++h) qs[h * 64 + lane] = bf2f(Yr[Y_AQ + (g * 4 + h) * 64 + lane]);
        float gt[4][3];
#pragma unroll
        for (int h = 0; h < 4; ++h)
#pragma unroll
            for (int br = 0; br < 3; ++br) gt[h][br] = sigm(bf2f(Yr[Y_AG + (g * 4 + h) * 3 + br]));
        WFENCE();
        const int cur = q >> 6, ncv = q >= 31 ? ((q - 31) >> 4) + 1 : 0;
        const bf16* KC = (const bf16*)(a.ws + WS_KCMP) + (size_t)bg * 512 * 64; const bf16* VC = (const bf16*)(a.ws + WS_VCMP) + (size_t)bg * 512 * 64;
        float mx[4] = {-1e30f, -1e30f, -1e30f, -1e30f};
        for (int i = 0; i < 8; ++i) { const int n = lane + 64 * i;
            if (n < ncv) { float d[4]; dot4(qs, KC + (size_t)n * 64, d); const int bk = t5_bucket(q - (16 * n + 31));
#pragma unroll
                for (int h = 0; h < 4; ++h) { const float s = d[h] + rel[bk * 16 + g * 4 + h] * LOG2E; sc[h * 512 + n] = s; mx[h] = fmaxf(mx[h], s); } }
            else {
#pragma unroll
                for (int h = 0; h < 4; ++h) sc[h * 512 + n] = 0.f; } }
        float ls[4] = {0.f, 0.f, 0.f, 0.f};
#pragma unroll
        for (int h = 0; h < 4; ++h) mx[h] = wave_max(mx[h]);
        WFENCE();
        for (int i = 0; i < 8; ++i) { const int n = lane + 64 * i;
            if (n < ncv) {
#pragma unroll
                for (int h = 0; h < 4; ++h) { const float e = exp2f(sc[h * 512 + n] - mx[h]); sc[h * 512 + n] = e; ls[h] += e; } } }
#pragma unroll
        for (int h = 0; h < 4; ++h) ls[h] = 1.f / fmaxf(wave_sum(ls[h]), 1e-20f);
        for (int i = 0; i < 8; ++i) { const int n = lane + 64 * i;
            if (n < ncv) {
#pragma unroll
                for (int h = 0; h < 4; ++h) sc[h * 512 + n] *= ls[h]; } }
        WFENCE();
        float v0, v1;
        { float t[2];
#pragma unroll
          for (int jj = 0; jj < 2; ++jj) { const int j = lane + 64 * jj; float v = 0.f;
              for (int n = 4 * j - 1; n <= 4 * j + 3; ++n) if (n >= 0 && n < 511) v += (sc[n] + sc[512 + n]) + (sc[1024 + n] + sc[1536 + n]);
              const bool forced = (j == 0) || (j == cur) || (j == cur - 1);
              t[jj] = forced ? 1e9f : (j <= cur ? v : -1e30f); }
          v0 = t[0]; v1 = t[1]; }
        bool sel0 = false, sel1 = false;
        for (int it = 0; it < 16; ++it) {
            const float c0 = sel0 ? -INFINITY : v0, c1 = sel1 ? -INFINITY : v1;
            const float mxv = wave_max(fmaxf(c0, c1));
            const unsigned long long m0 = __ballot(!sel0 && v0 == mxv);
            if (m0) { const int idx = __builtin_ctzll(m0); if (lane == idx) sel0 = true; }
            else { const unsigned long long m1 = __ballot(!sel1 && v1 == mxv); const int idx = m1 ? __builtin_ctzll(m1) : -1; if (lane == idx) sel1 = true; }
        }
        sel0 = sel0 && (lane <= cur); sel1 = sel1 && (lane + 64 <= cur);
        const unsigned long long sm0 = __ballot(sel0), sm1 = __ballot(sel1);
        float oc[4] = {0.f, 0.f, 0.f, 0.f};
        for (int n = 0; n < ncv; ++n) { const float vv = bf2f(VC[(size_t)n * 64 + lane]);
#pragma unroll
            for (int h = 0; h < 4; ++h) oc[h] += sc[h * 512 + n] * vv; }
        float ms[4] = {-1e30f, -1e30f, -1e30f, -1e30f}, lsel[4] = {0.f, 0.f, 0.f, 0.f}, os[4] = {0.f, 0.f, 0.f, 0.f};
        for (int j = 0; j <= cur; ++j) {
            const bool on = j < 64 ? ((sm0 >> j) & 1ull) : ((sm1 >> (j - 64)) & 1ull);
            if (!on) continue;
            const int kpos = 64 * j + lane; const bool valid = kpos <= q;
            float d[4]; dot4(qs, Y + ((size_t)b * S_ + kpos) * YP + Y_AKS + g * 64, d);
            const int bk = t5_bucket(q - kpos);
            WFENCE();
#pragma unroll
            for (int h = 0; h < 4; ++h) { const float s = valid ? d[h] + rel[bk * 16 + g * 4 + h] * LOG2E : -1e30f;
                const float mn = fmaxf(ms[h], wave_max(s)); const float p = valid ? exp2f(s - mn) : 0.f; s2[h * 64 + lane] = p;
                const float scl = exp2f(ms[h] - mn); lsel[h] = lsel[h] * scl + wave_sum(p); os[h] *= scl; ms[h] = mn; }
            WFENCE();
            const bf16* vb = Y + ((size_t)b * S_ + 64 * j) * YP + Y_AVS + g * 64 + lane;
            for (int kk = 0; kk < 64; ++kk) { const float vv = bf2f(vb[(size_t)kk * YP]);
#pragma unroll
                for (int h = 0; h < 4; ++h) os[h] += s2[h * 64 + kk] * vv; }
        }
        float mw[4] = {-1e30f, -1e30f, -1e30f, -1e30f}, lw[4] = {0.f, 0.f, 0.f, 0.f}, ow[4] = {0.f, 0.f, 0.f, 0.f};
        for (int c = 0; c < 8; ++c) {
            if (q - 64 * c < 0) break;
            const int dist = 64 * c + lane, kpos = q - dist; const bool valid = kpos >= 0;
            float d[4]; dot4(qs, Y + ((size_t)b * S_ + (valid ? kpos : 0)) * YP + Y_AKW + g * 64, d);
            const int bk = t5_bucket(dist);
            WFENCE();
#pragma unroll
            for (int h = 0; h < 4; ++h) { const float s = valid ? d[h] + rel[bk * 16 + g * 4 + h] * LOG2E : -1e30f;
                const float mn = fmaxf(mw[h], wave_max(s)); const float p = valid ? exp2f(s - mn) : 0.f; s2[h * 64 + lane] = p;
                const float scl = exp2f(mw[h] - mn); lw[h] = lw[h] * scl + wave_sum(p); ow[h] *= scl; mw[h] = mn; }
            WFENCE();
            for (int kk = 0; kk < 64; ++kk) { const int kp = q - 64 * c - kk; if (kp < 0) break;
                const float vv = bf2f(Y[((size_t)b * S_ + kp) * YP + Y_AVW + g * 64 + lane]);
#pragma unroll
                for (int h = 0; h < 4; ++h) ow[h] += s2[h * 64 + kk] * vv; }
        }
        WFENCE();
#pragma unroll
        for (int h = 0; h < 4; ++h) { const float o = gt[h][0] * oc[h] + gt[h][1] * os[h] / fmaxf(lsel[h], 1e-20f) + gt[h][2] * ow[h] / fmaxf(lw[h], 1e-20f);
            Yr[Y_AQ + (g * 4 + h) * 64 + lane] = (bf16)f2bf(o); }
    }
}
__device__ __forceinline__ void moba_naive(Frame& F, const Args& a) {
    const int gw = blockIdx.x * NWAVES + F.wave, NGW = F.G * NWAVES, lane = F.lane;
    bf16* Y = (bf16*)(a.ws + WS_Y); const float* rel = a.in[1]; const float* KM = (const float*)(a.ws + WS_KMEAN);
    LAS float* scr = (LAS float*)(F.lds + RING_OFF + F.wave * 16384);
    LAS float* qs = scr; LAS float* s2 = scr + 64;
    for (int task = gw; task < 32 * S_; task += NGW) {
        const int q = task & (S_ - 1), bh = task >> 13, h = bh & 7, b = bh >> 3;
        const size_t row = (size_t)b * S_ + q; bf16* Yr = Y + row * YP;
        WFENCE();
        qs[lane] = bf2f(Yr[Y_CQ + h * 64 + lane]);
        WFENCE();
        const int cur = q >> 8;
        float gs = -1e30f;
        if (lane < 32 && lane < cur) { const float* km = KM + ((size_t)bh * 32 + lane) * 64; float d = 0.f;
            for (int dd = 0; dd < 64; ++dd) d += qs[dd] * km[dd];
            gs = d; }
        if (lane >= 32) gs = -INFINITY;
        bool sel = false;
        for (int it = 0; it < 3; ++it) { const float c = sel ? -INFINITY : gs; const float mxv = wave_max(c);
            const unsigned long long m0 = __ballot(!sel && lane < 32 && gs == mxv); const int idx = m0 ? __builtin_ctzll(m0) : -1; if (lane == idx) sel = true; }
        sel = sel && (lane < cur);
        const unsigned smask = (unsigned)__ballot(sel);
        float mr = -1e30f, lr = 0.f, o = 0.f;
        for (int j = 0; j <= cur; ++j) {
            const bool own = (j == cur);
            if (!own && !((smask >> j) & 1u)) continue;
            for (int c = 0; c < 4; ++c) {
                const int kpos = 256 * j + 64 * c + lane; const bool valid = kpos <= q;
                if (256 * j + 64 * c > q) break;
                const float d = dot1(qs, Y + ((size_t)b * S_ + kpos) * YP + Y_CK + h * 64);
                const int bk = t5_bucket(q - kpos);
                const float s = valid ? d + rel[bk * 16 + 8 + h] * LOG2E : -1e30f;
                const float mn = fmaxf(mr, wave_max(s)); const float p = valid ? exp2f(s - mn) : 0.f;
                WFENCE(); s2[lane] = p; WFENCE();
                const float scl = exp2f(mr - mn); lr = lr * scl + wave_sum(p); o *= scl; mr = mn;
                const bf16* vb = Y + ((size_t)b * S_ + 256 * j + 64 * c) * YP + Y_CV + h * 64 + lane;
                for (int kk = 0; kk < 64; ++kk) o += s2[kk] * bf2f(vb[(size_t)kk * YP]);
            }
        }
        Yr[Y_CQ + h * 64 + lane] = (bf16)f2bf(o / fmaxf(lr, 1e-20f));
    }
}
__device__ __forceinline__ void gla_out_naive(Frame& F, const Args& a, int l) {
    const int gw = blockIdx.x * NWAVES + F.wave, NGW = F.G * NWAVES, lane = F.lane;
    bf16* Y = (bf16*)(a.ws + WS_Y); const float* O32 = (const float*)(a.ws + WS_H); const float* nw = a.in[15] + (size_t)l * 128;
    for (int t = gw; t < M_ * 4; t += NGW) {
        const int h = t & 3; const size_t row = (size_t)(t >> 2);
        const float o0 = O32[row * 512 + h * 128 + lane], o1 = O32[row * 512 + h * 128 + 64 + lane];
        const float r = rsqrtf(wave_sum(o0 * o0 + o1 * o1) * (1.f / 128.f) + NORM_EPS);
        bf16* yr = Y + row * YP + Y_BR + h * 128;
        const float r0 = bf2f(yr[lane]), r1 = bf2f(yr[64 + lane]);
        yr[lane] = (bf16)f2bf(o0 * r * nw[lane] * (r0 * sigm(r0))); yr[64 + lane] = (bf16)f2bf(o1 * r * nw[64 + lane] * (r1 * sigm(r1)));
    }
}

constexpr int PPL = 11, NPH = NL * PPL;
#define IN(k) (lo <= (k) && (k) < hi)
#define SEAM(k) do { if (IN(k) && IN((k) + 1)) xcd_barrier(bar); } while (0)
template <int l> __device__ __forceinline__ void layer_body(Frame& F, const Args& args, const XcdBarrier& bar, const int lo, const int hi) {
    unsigned char* ws = args.ws;
    bf16* H = (bf16*)(ws + WS_H); bf16* Y = (bf16*)(ws + WS_Y); unsigned char* G8 = ws + WS_G8;
    float* Yf = (float*)(ws + WS_Y); bf16* ACT = (bf16*)(ws + WS_ACT);
    constexpr int p0 = l * PPL;
    const float* xin = l == 0 ? args.in[0] : args.out;
    if (IN(p0 + 0)) { phase_weights(F, args, l); if (l == 0) phase_norm0(F, args.in[0], args.in[2], H); SEAM(p0 + 0); }
    if (IN(p0 + 1)) {
        pg8::Gemm g{H, (const bf16*)(ws + WS_WIN), M_, NIN, DM, DM}; pg8::StaticOrder So; So.init(M_, NIN, F.G, (int)blockIdx.x);
        pg8::EpiInProj E{Y, G8};
        pg8::gemm_phase<pg8::EpiInProj, pg8::StaticOrder, true, true>(F.lds + RING_OFF, g, So, E);
        SEAM(p0 + 1);
    }
    if (IN(p0 + 2)) { phase2_naive(F, args, l); SEAM(p0 + 2); }
    if (IN(p0 + 3)) { gla_scan_naive(F, args); nsa_naive(F, args); moba_naive(F, args); SEAM(p0 + 3); }
    if (IN(p0 + 4)) { gla_out_naive(F, args, l); SEAM(p0 + 4); }
    if (IN(p0 + 5)) {
        pg8::StaticOrder So; So.init(M_, DM, F.G, (int)blockIdx.x);
        { pg8::Gemm g{Y + Y_AQ, (const bf16*)(ws + WS_WA), M_, DM, 512, YP}; pg8::EpiMerge<0> E{H, G8}; pg8::gemm_phase<pg8::EpiMerge<0>, pg8::StaticOrder, true, true>(F.lds + RING_OFF, g, So, E); }
        __syncthreads();
        { pg8::Gemm g{Y + Y_BR, (const bf16*)(ws + WS_WB), M_, DM, 512, YP}; pg8::EpiMerge<1> E{H, G8}; pg8::gemm_phase<pg8::EpiMerge<1>, pg8::StaticOrder, true, true>(F.lds + RING_OFF, g, So, E); }
        __syncthreads();
        { pg8::Gemm g{Y + Y_CQ, (const bf16*)(ws + WS_WC), M_, DM, 512, YP}; pg8::EpiMerge<2> E{H, G8}; pg8::gemm_phase<pg8::EpiMerge<2>, pg8::StaticOrder, true, true>(F.lds + RING_OFF, g, So, E); }
        SEAM(p0 + 5);
    }
    if (IN(p0 + 6)) {
        pg8::Gemm g{H, (const bf16*)(ws + WS_WO), M_, DM, DM, DM}; pg8::StaticOrder So; So.init(M_, DM, F.G, (int)blockIdx.x);
        pg8::EpiF32 E{Yf, DM}; pg8::gemm_phase<pg8::EpiF32, pg8::StaticOrder, true, true>(F.lds + RING_OFF, g, So, E);
        SEAM(p0 + 6);
    }
    if (IN(p0 + 7)) { phase_resid(F, Yf, xin, args.out, args.in[3] + (size_t)l * DM, args.in[4] + (size_t)l * DM, H); SEAM(p0 + 7); }
    if (IN(p0 + 8)) {
        pg8::Gemm g{H, (const bf16*)(ws + WS_WF1), M_, 2 * FF, DM, DM}; pg8::StaticOrder So; So.init(M_, 2 * FF, F.G, (int)blockIdx.x);
        pg8::EpiSwiglu E{ACT, FF}; pg8::gemm_phase<pg8::EpiSwiglu, pg8::StaticOrder, true, true>(F.lds + RING_OFF, g, So, E);
        SEAM(p0 + 8);
    }
    if (IN(p0 + 9)) {
        pg8::Gemm g{ACT, (const bf16*)(ws + WS_WF2), M_, DM, FF, FF}; pg8::StaticOrder So; So.init(M_, DM, F.G, (int)blockIdx.x);
        pg8::EpiF32 E{Yf, DM}; pg8::gemm_phase<pg8::EpiF32, pg8::StaticOrder, true, true>(F.lds + RING_OFF, g, So, E);
        SEAM(p0 + 9);
    }
    if (IN(p0 + 10)) { phase_resid(F, Yf, args.out, args.out, args.in[5] + (size_t)l * DM, l + 1 < NL ? args.in[2] + (size_t)(l + 1) * DM : nullptr, l + 1 < NL ? H : nullptr); SEAM(p0 + 10); }
}
__global__ void __launch_bounds__(NWAVES * 64, 2) mk_fwd(Args args) {
    extern __shared__ __attribute__((aligned(16))) unsigned char lds[];
    Frame F;
    F.lds = (LAS unsigned char*)lds; F.MISC = (volatile LAS unsigned*)(F.lds + MISC_OFF);
    F.tid = threadIdx.x; F.lane = F.tid & 63; F.wave = __builtin_amdgcn_readfirstlane(F.tid >> 6); F.G = gridDim.x;
    F.ctl = (gu32*)(args.ws + WS_CTL);
    for (int u = F.tid; u < (LDS_BYTES - LDSCTL_OFF) / 4; u += NWAVES * 64) ((LAS unsigned*)(F.lds + LDSCTL_OFF))[u] = 0u;
    __syncthreads();
    const int lo = args.ph_lo, hi = args.ph_hi;
    XcdBarrier bar; bar.bar = (unsigned*)(F.ctl + CW_BAR); bar.x = 0; bar.st = nullptr;
    if (hi - lo > 1) bar = xcd_barrier_post((unsigned*)(F.ctl + CW_BAR), F.MISC + 8);
    layer_body<0>(F, args, bar, lo, hi);
    layer_body<1>(F, args, bar, lo, hi);
}
#undef IN
#undef SEAM

#ifndef MK_ONE_LAUNCH
#define MK_ONE_LAUNCH 0
#endif
extern "C" void kernel_launch(void* const* d_in, const int* in_sizes, int n_in, void* d_out, int out_size, void* d_ws, size_t ws_size, hipStream_t stream) {
    static int grid = 0;
    if (grid == 0) {
        if (n_in != 22 || out_size != M_ * DM || ws_size < WS_END) { fprintf(stderr, "kernel_launch: unexpected sizes (n_in %d out %d ws %zu)\n", n_in, out_size, ws_size); grid = -1; return; }
        int dev = 0, cus = 0;
        if (hipGetDevice(&dev) != hipSuccess || hipDeviceGetAttribute(&cus, hipDeviceAttributeMultiprocessorCount, dev) != hipSuccess) { grid = -1; return; }
        if (hipFuncSetAttribute((const void*)mk_fwd, hipFuncAttributeMaxDynamicSharedMemorySize, LDS_BYTES) != hipSuccess) { grid = -1; return; }
        (void)hipGetLastError();
        grid = cus;
    }
    if (grid < 0) return;
    if (hipMemsetAsync((char*)d_ws + WS_CTL, 0, CTL_ZERO_BYTES, stream) != hipSuccess) return;
    Args a{};
    for (int i = 0; i < 22; ++i) a.in[i] = (const float*)d_in[i];
    a.out = (float*)d_out; a.ws = (unsigned char*)d_ws;
#if MK_ONE_LAUNCH
    a.ph_lo = 0; a.ph_hi = NPH;
    hipLaunchKernelGGL(mk_fwd, dim3(grid), dim3(NWAVES * 64), LDS_BYTES, stream, a);
#else
    for (int p = 0; p < NPH; ++p) { a.ph_lo = p; a.ph_hi = p + 1; hipLaunchKernelGGL(mk_fwd, dim3(grid), dim3(NWAVES * 64), LDS_BYTES, stream, a); }
#endif
}
```

```cpp
#include <hip/hip_runtime.h>
#include <cstdio>
#include <cstdint>
#include <cmath>
namespace pg8 {
#define PG8_LAS __attribute__((address_space(3)))
typedef unsigned short bf16_t;
typedef short bf16x8 __attribute__((ext_vector_type(8)));
typedef float f32x4 __attribute__((ext_vector_type(4)));
typedef unsigned u32x4 __attribute__((ext_vector_type(4)));
constexpr int BM = 256, BK = 64, HALF = 128, HTB = HALF * BK * 2  , STAGE_BYTES = 8 * HTB, NXCD = 8, WGM = 8;

__host__ __device__ __forceinline__ int lds_byte(int r, int c) { const int st = (r >> 4) * 2 + (c >> 5), rr = r & 15, cc = c & 31, ob = rr * 64 + cc * 2; return st * 1024 + (ob ^ (((ob >> 9) & 1) << 5)); }
__host__ __device__ __forceinline__ void stage_rc(int b, int& R, int& C) { const int st = b / 1024, sb = b % 1024, swz = sb ^ (((sb >> 9) & 1) << 5); R = (st >> 1) * 16 + swz / 64; C = (st & 1) * 32 + (swz % 64) / 2; }
__host__ __device__ __forceinline__ int perm32(int rho) { const int n = rho >> 4, i = rho & 15; return 8 * (i >> 2) + 4 * n + (i & 3); }

struct Unit { int pm, pn; };
struct Gemm { const bf16_t* A; const bf16_t* Bt; int M, N, K, lda; };

struct StaticOrder {
    int nM, nN, nwg, G, c;
    __host__ __device__ void init(int M, int N, int G_, int c_) { nM = M / BM; nN = N / BM; nwg = nM * nN; G = G_; c = c_; }
    __host__ __device__ bool next(int i, Unit& u) const {
        const long L = (long)i * G + c; if (L >= nwg) return false;
        int wgid = (int)L; { const int q = nwg / NXCD, r = nwg % NXCD, xcd = wgid % NXCD, off = wgid / NXCD; wgid = (xcd < r ? xcd * (q + 1) : r * (q + 1) + (xcd - r) * q) + off; }
        const int nig = WGM * nN, gid = wgid / nig, fm = gid * WGM, gsz = (nM - fm) < WGM ? (nM - fm) : WGM;
        u.pm = fm + ((wgid % nig) % gsz); u.pn = (wgid % nig) / gsz; return true;
    }
    __device__ __forceinline__ void a_ready(const Unit&) const {}
    __device__ __forceinline__ void done(const Unit&) const {}
};

__device__ __forceinline__ unsigned cvt_pk_bf16(float lo, float hi) { unsigned r; asm volatile("v_cvt_pk_bf16_f32 %0, %1, %2" : "=v"(r) : "v"(lo), "v"(hi)); return r; }
typedef float f32x2 __attribute__((ext_vector_type(2)));
constexpr int YP_ = 4392;
constexpr float C2_ = 0.125f * 1.4426950408889634f;
__device__ __forceinline__ float sigmoidf_(float v) { return 1.f / (1.f + __expf(-v)); }
struct EpiInProj {
    static constexpr bool PERM = true, AFTER_DRAIN = false;
    bf16_t* Y; unsigned char* G8;
    __device__ __forceinline__ void operator()(const f32x4 (&acc)[2][2][4][2], const Unit& u, int wr, int wc, int fr, int fq) const {
        const int row0 = u.pm * BM + wr * 64 + fr, colt = u.pn * BM, cin = wc * 32 + 8 * fq;
        if (u.pn < 18) {
            float sc = 1.f; if (u.pn < 2 || u.pn == 5 || u.pn == 6) sc = C2_; else if (u.pn == 11) sc = 0.125f;
#pragma unroll
            for (int ai = 0; ai < 2; ++ai)
#pragma unroll
                for (int m = 0; m < 4; ++m) { bf16_t* rowp = Y + (size_t)(row0 + ai * HALF + m * 16) * YP_;
#pragma unroll
                    for (int bj = 0; bj < 2; ++bj) { const int col = colt + cin + bj * HALF;
                        if (col + 8 <= YP_) { const f32x4 v0 = acc[ai][bj][m][0] * sc, v1 = acc[ai][bj][m][1] * sc; u32x4 w;
                            w.x = cvt_pk_bf16(v0[0], v0[1]); w.y = cvt_pk_bf16(v0[2], v0[3]); w.z = cvt_pk_bf16(v1[0], v1[1]); w.w = cvt_pk_bf16(v1[2], v1[3]);
                            *(u32x4*)(rowp + col) = w; } } }
        } else {
#pragma unroll
            for (int ai = 0; ai < 2; ++ai)
#pragma unroll
                for (int m = 0; m < 4; ++m) { unsigned char* rowp = G8 + (size_t)(row0 + ai * HALF + m * 16) * 3072 + (colt - 4608) + cin;
#pragma unroll
                    for (int bj = 0; bj < 2; ++bj) { const f32x4 v0 = acc[ai][bj][m][0], v1 = acc[ai][bj][m][1]; unsigned lo = 0u, hi = 0u;
#pragma unroll
                        for (int e = 0; e < 4; ++e) { lo |= (unsigned)(sigmoidf_(v0[e]) * 255.f + 0.5f) << (8 * e); hi |= (unsigned)(sigmoidf_(v1[e]) * 255.f + 0.5f) << (8 * e); }
                        typedef unsigned u32x2 __attribute__((ext_vector_type(2))); u32x2 w; w.x = lo; w.y = hi; *(u32x2*)(rowp + bj * HALF) = w; } }
        }
    }
};
template <int I> struct EpiMerge {
    static constexpr bool PERM = true, AFTER_DRAIN = false;
    bf16_t* Mg; const unsigned char* G8;
    __device__ __forceinline__ void operator()(const f32x4 (&acc)[2][2][4][2], const Unit& u, int wr, int wc, int fr, int fq) const {
        const int row0 = u.pm * BM + wr * 64 + fr, col0 = u.pn * BM + wc * 32 + 8 * fq;
#pragma unroll
        for (int ai = 0; ai < 2; ++ai)
#pragma unroll
            for (int m = 0; m < 4; ++m) { const size_t row = (size_t)(row0 + ai * HALF + m * 16);
#pragma unroll
                for (int bj = 0; bj < 2; ++bj) { const int col = col0 + bj * HALF;
                    typedef unsigned u32x2 __attribute__((ext_vector_type(2)));
                    const u32x2 gw = *(const u32x2*)(G8 + row * 3072 + I * 1024 + col);
                    float v[8];
#pragma unroll
                    for (int e = 0; e < 4; ++e) { v[e] = acc[ai][bj][m][0][e] * ((float)((gw.x >> (8 * e)) & 255u) * (1.f / 255.f)); v[4 + e] = acc[ai][bj][m][1][e] * ((float)((gw.y >> (8 * e)) & 255u) * (1.f / 255.f)); }
                    bf16_t* p = Mg + row * 1024 + col;
                    if (I > 0) { const u32x4 o = *(const u32x4*)p;
                        v[0] += __uint_as_float(o.x << 16); v[1] += __uint_as_float(o.x & 0xffff0000u); v[2] += __uint_as_float(o.y << 16); v[3] += __uint_as_float(o.y & 0xffff0000u);
                        v[4] += __uint_as_float(o.z << 16); v[5] += __uint_as_float(o.z & 0xffff0000u); v[6] += __uint_as_float(o.w << 16); v[7] += __uint_as_float(o.w & 0xffff0000u); }
                    u32x4 w; w.x = cvt_pk_bf16(v[0], v[1]); w.y = cvt_pk_bf16(v[2], v[3]); w.z = cvt_pk_bf16(v[4], v[5]); w.w = cvt_pk_bf16(v[6], v[7]);
                    *(u32x4*)p = w; } }
    }
};
struct EpiF32 {
    static constexpr bool PERM = true, AFTER_DRAIN = false;
    float* O; int ldc;
    __device__ __forceinline__ void operator()(const f32x4 (&acc)[2][2][4][2], const Unit& u, int wr, int wc, int fr, int fq) const {
        const int row0 = u.pm * BM + wr * 64 + fr, col0 = u.pn * BM + wc * 32 + 8 * fq;
#pragma unroll
        for (int ai = 0; ai < 2; ++ai)
#pragma unroll
            for (int m = 0; m < 4; ++m) { float* rowp = O + (size_t)(row0 + ai * HALF + m * 16) * ldc + col0;
#pragma unroll
                for (int bj = 0; bj < 2; ++bj) { *(f32x4*)(rowp + bj * HALF) = acc[ai][bj][m][0]; *(f32x4*)(rowp + bj * HALF + 4) = acc[ai][bj][m][1]; } }
    }
};
struct EpiSwiglu {
    static constexpr bool PERM = true, AFTER_DRAIN = false;
    bf16_t* Act; int ldc;
    __device__ __forceinline__ void operator()(const f32x4 (&acc)[2][2][4][2], const Unit& u, int wr, int wc, int fr, int fq) const {
        const int row0 = u.pm * BM + wr * 64 + fr, col0 = u.pn * HALF + wc * 32 + 8 * fq;
#pragma unroll
        for (int ai = 0; ai < 2; ++ai)
#pragma unroll
            for (int m = 0; m < 4; ++m) { bf16_t* p = Act + (size_t)(row0 + ai * HALF + m * 16) * ldc + col0; float v[8];
#pragma unroll
                for (int e = 0; e < 4; ++e) { const float g0 = acc[ai][0][m][0][e], g1 = acc[ai][0][m][1][e];
                    v[e] = g0 * sigmoidf_(g0) * acc[ai][1][m][0][e]; v[4 + e] = g1 * sigmoidf_(g1) * acc[ai][1][m][1][e]; }
                u32x4 w; w.x = cvt_pk_bf16(v[0], v[1]); w.y = cvt_pk_bf16(v[2], v[3]); w.z = cvt_pk_bf16(v[4], v[5]); w.w = cvt_pk_bf16(v[6], v[7]);
                *(u32x4*)p = w; }
    }
};
template <class Epi, class Sched, bool ALIGN_EPI = false, bool SP2 = false>
__device__ __forceinline__ void gemm_phase(PG8_LAS unsigned char* lds, const Gemm g, const Sched& S, const Epi& E) {
    const int tid = threadIdx.x, wid = __builtin_amdgcn_readfirstlane(tid >> 6), lane = tid & 63, wr = wid >> 2, wc = wid & 3, fr = lane & 15, fq = lane >> 4;
    const int K = g.K, nt = K / BK;
    unsigned voffA[2], voffB[2];
#pragma unroll
    for (int i = 0; i < 2; ++i) { int R, C; stage_rc(tid * 16 + i * 8192, R, C); const int Rb = Epi::PERM ? ((R & ~31) + perm32(R & 31)) : R;
        voffA[i] = (unsigned)(R * g.lda + C) * 2u; voffB[i] = (unsigned)(Rb * K + C) * 2u; }
    const size_t kstep = (size_t)(BK * 2);
    const size_t hstepB = (size_t)HALF * K * 2, hstepA = (size_t)HALF * g.lda * 2;
    const size_t tstepA = 2 * hstepA, tstepB = 2 * hstepB;
    const unsigned ldsw = (unsigned)wid * 1024u;
    const int aoff = lds_byte(wr * 64 + fr, fq * 8), boff = lds_byte(wc * 32 + fr, fq * 8);
#define PG8_SA(b, h) (((b) * 2 + (h)) * HTB)
#define PG8_SB(b, h) ((4 + (b) * 2 + (h)) * HTB)
#define PG8_STAGE(bufoff, gbase, voff) do { _Pragma("unroll") for (int _i = 0; _i < 2; ++_i) \
        __builtin_amdgcn_global_load_lds((const unsigned*)((const char*)(gbase) + (voff)[_i]), (PG8_LAS unsigned*)(lds + (bufoff) + ldsw + _i * 8192), 16, 0, 0); } while (0)
#define PG8_LDA(dst, b, h) do { _Pragma("unroll") for (int m = 0; m < 4; ++m) _Pragma("unroll") for (int k = 0; k < 2; ++k) dst[m][k] = *(const PG8_LAS bf16x8*)(lds + PG8_SA(b, h) + aoff + m * 2048 + k * 1024); } while (0)
#define PG8_LDB(dst, b, h) do { _Pragma("unroll") for (int n = 0; n < 2; ++n) _Pragma("unroll") for (int k = 0; k < 2; ++k) dst[n][k] = *(const PG8_LAS bf16x8*)(lds + PG8_SB(b, h) + boff + n * 2048 + k * 1024); } while (0)
#define PG8_MMA(ai, bj, At, Bt) do { __builtin_amdgcn_s_setprio(1); _Pragma("unroll") for (int m = 0; m < 4; ++m) _Pragma("unroll") for (int n = 0; n < 2; ++n) _Pragma("unroll") for (int k = 0; k < 2; ++k) \
        acc[ai][bj][m][n] = __builtin_amdgcn_mfma_f32_16x16x32_bf16(Bt[n][k], At[m][k], acc[ai][bj][m][n], 0, 0, 0); __builtin_amdgcn_s_setprio(0); } while (0)
#define PG8_WAIT_V(n) asm volatile("s_waitcnt vmcnt(" #n ")" ::: "memory")
#define PG8_WAIT_L(n) asm volatile("s_waitcnt lgkmcnt(" #n ")" ::: "memory")
#define PG8_BAR __builtin_amdgcn_s_barrier()
#define PG8_SCHED __builtin_amdgcn_sched_barrier(0)
    Unit cur, nxt; int ui = 0;
    if (!S.next(0, cur)) return;
    f32x4 acc[2][2][4][2];
#pragma unroll
    for (int a = 0; a < 2; ++a)
#pragma unroll
        for (int b = 0; b < 2; ++b)
#pragma unroll
            for (int m = 0; m < 4; ++m)
#pragma unroll
                for (int n = 0; n < 2; ++n) acc[a][b][m][n] = (f32x4){0.f, 0.f, 0.f, 0.f};
    bf16x8 At[4][2], B0[2][2], B1[2][2];
    const char* cA = (const char*)g.A + (size_t)cur.pm * tstepA; const char* cB = (const char*)g.Bt + (size_t)cur.pn * tstepB;
    S.a_ready(cur);
    if constexpr (SP2) {
        PG8_STAGE(PG8_SB(0, 0), cB, voffB); PG8_STAGE(PG8_SB(0, 1), cB + hstepB, voffB); PG8_STAGE(PG8_SA(0, 0), cA, voffA); PG8_STAGE(PG8_SA(0, 1), cA + hstepA, voffA);
        if (wr == 1) PG8_BAR;
        PG8_WAIT_V(2); PG8_BAR;
        PG8_STAGE(PG8_SB(1, 0), cB + kstep, voffB); PG8_STAGE(PG8_SA(1, 0), cA + kstep, voffA); PG8_STAGE(PG8_SB(1, 1), cB + hstepB + kstep, voffB);
        PG8_WAIT_V(6); PG8_BAR;
    } else {
        PG8_STAGE(PG8_SB(0, 0), cB, voffB); PG8_STAGE(PG8_SA(0, 0), cA, voffA); PG8_STAGE(PG8_SB(0, 1), cB + hstepB, voffB); PG8_STAGE(PG8_SA(0, 1), cA + hstepA, voffA);
        if (wr == 1) PG8_BAR;
        PG8_WAIT_V(4); PG8_BAR;
        PG8_STAGE(PG8_SB(1, 0), cB + kstep, voffB); PG8_STAGE(PG8_SA(1, 0), cA + kstep, voffA); PG8_STAGE(PG8_SB(1, 1), cB + hstepB + kstep, voffB);
        PG8_WAIT_V(6); PG8_BAR;
    }
    for (;;) {
        const bool has_next = S.next(ui + 1, nxt);
        const char* nA = has_next ? (const char*)g.A + (size_t)nxt.pm * tstepA : cA; const char* nB = has_next ? (const char*)g.Bt + (size_t)nxt.pn * tstepB : cB;
        for (int t = 0; t < nt; t += 2) {
            const bool last = (t == nt - 2);
            const char* a1 = cA + (size_t)(t + 1) * kstep;
            const char* a2 = last ? nA : cA + (size_t)(t + 2) * kstep; const char* b2 = last ? nB : cB + (size_t)(t + 2) * kstep;
            const char* a3 = a2 + kstep; const char* b3 = b2 + kstep;
            if (last && has_next) S.a_ready(nxt);
            if constexpr (SP2) {
            PG8_LDB(B0, 0, 0); PG8_LDB(B1, 0, 1); PG8_SCHED; PG8_LDA(At, 0, 0); PG8_STAGE(PG8_SA(1, 1), a1 + hstepA, voffA);
            PG8_WAIT_V(8); PG8_WAIT_L(0); PG8_BAR; PG8_MMA(0, 0, At, B0); PG8_MMA(0, 1, At, B1); PG8_BAR; PG8_SCHED;
            PG8_LDA(At, 0, 1); PG8_STAGE(PG8_SB(0, 0), b2, voffB); PG8_STAGE(PG8_SB(0, 1), b2 + hstepB, voffB); PG8_STAGE(PG8_SA(0, 0), a2, voffA);
            PG8_WAIT_V(8); PG8_WAIT_L(0); PG8_BAR; PG8_MMA(1, 0, At, B0); PG8_MMA(1, 1, At, B1); PG8_BAR; PG8_SCHED;
            PG8_LDB(B0, 1, 0); PG8_LDB(B1, 1, 1); PG8_SCHED; PG8_LDA(At, 1, 0); PG8_STAGE(PG8_SA(0, 1), a2 + hstepA, voffA);
            PG8_WAIT_V(8); PG8_WAIT_L(0); PG8_BAR; PG8_MMA(0, 0, At, B0); PG8_MMA(0, 1, At, B1); PG8_BAR; PG8_SCHED;
            PG8_LDA(At, 1, 1); PG8_STAGE(PG8_SB(1, 0), b3, voffB); PG8_STAGE(PG8_SB(1, 1), b3 + hstepB, voffB); PG8_STAGE(PG8_SA(1, 0), a3, voffA);
            PG8_WAIT_V(8); PG8_WAIT_L(0); PG8_BAR; PG8_MMA(1, 0, At, B0); PG8_MMA(1, 1, At, B1); PG8_BAR; PG8_SCHED;
            } else {
            PG8_LDB(B0, 0, 0); PG8_SCHED; PG8_LDA(At, 0, 0); PG8_STAGE(PG8_SA(1, 1), a1 + hstepA, voffA);
            PG8_WAIT_L(8); PG8_BAR; PG8_WAIT_L(0); PG8_MMA(0, 0, At, B0); PG8_BAR; PG8_SCHED;
            PG8_LDB(B1, 0, 1); PG8_STAGE(PG8_SB(0, 0), b2, voffB);
            PG8_BAR; PG8_WAIT_L(0); PG8_MMA(0, 1, At, B1); PG8_BAR;
            PG8_LDA(At, 0, 1); PG8_STAGE(PG8_SA(0, 0), a2, voffA);
            PG8_BAR; PG8_WAIT_L(0); PG8_MMA(1, 0, At, B0); PG8_BAR; PG8_SCHED;
            PG8_STAGE(PG8_SB(0, 1), b2 + hstepB, voffB);
            PG8_WAIT_V(6); PG8_BAR; PG8_MMA(1, 1, At, B1); PG8_BAR;
            PG8_LDB(B0, 1, 0); PG8_SCHED; PG8_LDA(At, 1, 0); PG8_STAGE(PG8_SA(0, 1), a2 + hstepA, voffA);
            PG8_WAIT_L(8); PG8_BAR; PG8_WAIT_L(0); PG8_MMA(0, 0, At, B0); PG8_BAR; PG8_SCHED;
            PG8_LDB(B1, 1, 1); PG8_STAGE(PG8_SB(1, 0), b3, voffB);
            PG8_BAR; PG8_WAIT_L(0); PG8_MMA(0, 1, At, B1); PG8_BAR;
            PG8_LDA(At, 1, 1); PG8_STAGE(PG8_SA(1, 0), a3, voffA);
            PG8_BAR; PG8_WAIT_L(0); PG8_MMA(1, 0, At, B0); PG8_BAR; PG8_SCHED;
            PG8_STAGE(PG8_SB(1, 1), b3 + hstepB, voffB);
            PG8_WAIT_V(6); PG8_BAR; PG8_MMA(1, 1, At, B1); PG8_BAR;
            }
        }
        if constexpr (ALIGN_EPI) { if (wr == 0) PG8_BAR; }
        if constexpr (!Epi::AFTER_DRAIN) { E(acc, cur, wr, wc, fr, fq); S.done(cur); }
        if (!has_next) break;
#pragma unroll
        for (int a = 0; a < 2; ++a)
#pragma unroll
            for (int b = 0; b < 2; ++b)
#pragma unroll
                for (int m = 0; m < 4; ++m)
#pragma unroll
                    for (int n = 0; n < 2; ++n) acc[a][b][m][n] = (f32x4){0.f, 0.f, 0.f, 0.f};
        cur = nxt; cA = nA; cB = nB; ++ui;
        if constexpr (ALIGN_EPI) { if (wr == 1) PG8_BAR; }
    }
    PG8_WAIT_V(0);
    if constexpr (!ALIGN_EPI) { if (wr == 0) PG8_BAR; }
    PG8_BAR;
    if constexpr (Epi::AFTER_DRAIN) { E.fused(acc, cur, wr, wc, fr, fq, lds, wid, lane); S.done(cur); }
#undef PG8_SA
#undef PG8_SB
#undef PG8_STAGE
#undef PG8_LDA
#undef PG8_LDB
#undef PG8_MMA
#undef PG8_WAIT_V
#undef PG8_WAIT_L
#undef PG8_BAR
#undef PG8_SCHED
}
}
constexpr int NWAVES = 8;
constexpr int B_ = 4, S_ = 8192, DM = 1024, M_ = B_ * S_, DIN = 7464, FF = 2816, NL = 2;
constexpr int YP = pg8::YP_;
constexpr float C2 = pg8::C2_, LOG2E = 1.4426950408889634f;
constexpr float NORM_EPS = 1e-6f;
constexpr int Y_AQ = 0, Y_AKC = 512, Y_AVC = 640, Y_AKS = 768, Y_AVS = 896, Y_AKW = 1024, Y_AVW = 1152, Y_CQ = 1280, Y_CK = 1792, Y_CV = 2304,
              Y_BQ = 2816, Y_BK = 3072, Y_BV = 3328, Y_BR = 3840, Y_AG = 4352, Y_BLR = 4376;
constexpr int NIN = 7680;
constexpr size_t MiB = 1u << 20;
constexpr size_t WS_CTL = 0, CTL_ZERO_BYTES = 1 * MiB;
constexpr size_t WS_WIN = 1 * MiB, WS_WA = 16 * MiB, WS_WB = 17 * MiB, WS_WC = 18 * MiB, WS_WO = 19 * MiB, WS_WF1 = 21 * MiB, WS_WF2 = 32 * MiB;
constexpr size_t WS_H = 40 * MiB;
constexpr size_t WS_Y = 104 * MiB;
constexpr size_t WS_G8 = 379 * MiB;
constexpr size_t WS_ACT = WS_Y + 128 * MiB;
constexpr size_t WS_SM = 475 * MiB;
constexpr size_t WS_KCMP = WS_SM, WS_VCMP = WS_SM + 1 * MiB, WS_KMEAN = WS_SM + 2 * MiB;
constexpr size_t WS_GA = WS_SM + 3 * MiB;
constexpr size_t WS_END = 512 * MiB;
static_assert(WS_GA + (size_t)M_ * 256 * 4 <= WS_END && WS_Y + (size_t)M_ * YP * 2 <= WS_G8 && WS_G8 + (size_t)M_ * 3072 <= WS_SM, "ws map");
static_assert(WS_ACT + (size_t)M_ * FF * 2 <= WS_SM && WS_WF2 + (size_t)DM * FF * 2 <= WS_H, "ws map 2");
constexpr int CW_BAR = 4096;
constexpr int RING_OFF = 0, RING_BYTES = 131072;
constexpr int LDSCTL_OFF = RING_BYTES, MISC_OFF = LDSCTL_OFF + 320;
constexpr int LDS_BYTES = 147456;

#define GAS __attribute__((address_space(1)))
#define LAS __attribute__((address_space(3)))
typedef unsigned short bf16;
typedef unsigned v4u __attribute__((ext_vector_type(4)));
typedef float f32x4 __attribute__((ext_vector_type(4)));
typedef short bf16x8 __attribute__((ext_vector_type(8)));
typedef GAS unsigned gu32;
typedef GAS unsigned long long gu64;
#define RLX_AGENT __ATOMIC_RELAXED, __HIP_MEMORY_SCOPE_AGENT
#define LDS_WAIT() asm volatile("s_waitcnt lgkmcnt(0)" ::: "memory")
#define VM_WAIT() asm volatile("s_waitcnt vmcnt(0)" ::: "memory")
__device__ __forceinline__ unsigned long long rt() { return __builtin_amdgcn_s_memrealtime(); }
__device__ __forceinline__ unsigned f2bf(float f) { unsigned u = __builtin_bit_cast(unsigned, f); return (u + 0x7fffu + ((u >> 16) & 1u)) >> 16; }
__device__ __forceinline__ unsigned pk2(float lo, float hi) { return f2bf(lo) | (f2bf(hi) << 16); }

__device__ __forceinline__ float bf2f(bf16 h) { return __uint_as_float((unsigned)h << 16); }
__device__ __forceinline__ float sigm(float v) { return 1.f / (1.f + __expf(-v)); }
#define WFENCE() asm volatile("s_waitcnt lgkmcnt(0)" ::: "memory")

#define XB_TMO      128
#define XB_XCNT(j)  (256  + 64 * (j))
#define XB_XSUB(j)  (1280 + 64 * (j))
#define XB_XGEN(j)  (2304 + 64 * (j))
#define XB_TOP      3328
#define XB_TOPGEN   3392
#define XCD_BAR_WORDS 3456
#define XB_SPIN_CAP (1u << 18)

__device__ __forceinline__ unsigned xb_ld(unsigned* p)              { return __hip_atomic_load(p, __ATOMIC_RELAXED, __HIP_MEMORY_SCOPE_AGENT); }
__device__ __forceinline__ unsigned xb_add(unsigned* p, unsigned v) { return __hip_atomic_fetch_add(p, v, __ATOMIC_RELAXED, __HIP_MEMORY_SCOPE_AGENT); }
__device__ __forceinline__ unsigned xb_xcc_id() { return (unsigned)__builtin_amdgcn_s_getreg((3 << 11) | 20) & 0xFu; }
#define XB_SPIN(cond, bar) do { unsigned _sp = 0; while (cond) { __builtin_amdgcn_s_sleep(1); \
    if ((++_sp & 255u) == 0u) { if (xb_ld(&(bar)[XB_TMO])) break; if (_sp > XB_SPIN_CAP) { atomicAdd(&(bar)[XB_TMO], 1u); break; } } } } while (0)

struct XcdBarrier {
    unsigned* bar; unsigned x;
    volatile LAS unsigned* st;
};

__device__ __forceinline__ XcdBarrier xcd_barrier_post(unsigned* bar, volatile LAS unsigned* st) {
    XcdBarrier b; b.bar = bar; b.x = xb_xcc_id(); b.st = st;
    if (threadIdx.x == 0) (void)xb_add(&bar[XB_XCNT(b.x)], 1u);
    return b;
}
__device__ __forceinline__ void xcd_barrier_complete(unsigned* bar, unsigned x, unsigned& nloc, unsigned& nx) {
    const unsigned G = gridDim.x * gridDim.y * gridDim.z;
    unsigned sum, cnt, mine, sp = 0u;
    for (;;) {
        sum = 0u; cnt = 0u; mine = 0u;
#pragma unroll
        for (unsigned j = 0; j < 16; ++j) { const unsigned c = xb_ld(&bar[XB_XCNT(j)]); sum += c; cnt += (c > 0u) ? 1u : 0u; mine = (j == x) ? c : mine; }
        if (sum == G) break;
        __builtin_amdgcn_s_sleep(1);
        if ((++sp & 255u) == 0u) { if (xb_ld(&bar[XB_TMO])) break; if (sp > XB_SPIN_CAP) { atomicAdd(&bar[XB_TMO], 1u); break; } }
    }
    nloc = mine > 0u ? mine : 1u; nx = cnt > 0u ? cnt : 1u;
}

__device__ __forceinline__ void xcd_barrier(const XcdBarrier& b) {
    asm volatile("s_waitcnt vmcnt(0)" ::: "memory");
    __syncthreads();
    if (threadIdx.x == 0) {
        unsigned* bar = b.bar;
        __builtin_amdgcn_s_waitcnt(0);
        unsigned nloc = b.st[0], nx = b.st[1];
        if (nloc == 0u) { xcd_barrier_complete(bar, b.x, nloc, nx); b.st[0] = nloc; b.st[1] = nx; }
        const unsigned old = xb_add(&bar[XB_XSUB(b.x)], 1u);
        const unsigned gen = old / nloc;
        if (old + 1u == (gen + 1u) * nloc) {
            __builtin_amdgcn_fence(__ATOMIC_RELEASE, "agent");
            asm volatile("s_waitcnt vmcnt(0)" ::: "memory");
            const unsigned og = xb_add(&bar[XB_TOP], 1u);
            const unsigned tg = og / nx;
            if (og + 1u == (tg + 1u) * nx) xb_add(&bar[XB_TOPGEN], 1u);
            else XB_SPIN(xb_ld(&bar[XB_TOPGEN]) == tg, bar);
            __builtin_amdgcn_fence(__ATOMIC_ACQUIRE, "agent");
            xb_add(&bar[XB_XGEN(b.x)], 1u);
            asm volatile("s_waitcnt vmcnt(0)" ::: "memory");
        } else {
            XB_SPIN(xb_ld(&bar[XB_XGEN(b.x)]) == gen, bar);
            __builtin_amdgcn_fence(__ATOMIC_ACQUIRE, "agent");
            asm volatile("s_waitcnt vmcnt(0)" ::: "memory");
        }
    }
    __syncthreads();
}


struct Frame {
    LAS unsigned char* lds;
    volatile LAS unsigned* MISC;
    gu32* ctl;
    int tid, lane, wave, G;
};
__device__ __forceinline__ float wave_sum(float v) {
#pragma unroll
    for (int o = 1; o < 64; o <<= 1) v += __shfl_xor(v, o);
    return v;
}
__device__ __forceinline__ float wave_max(float v) {
#pragma unroll
    for (int o = 1; o < 64; o <<= 1) v = fmaxf(v, __shfl_xor(v, o));
    return v;
}
__device__ __forceinline__ int t5_bucket(int d) {
    if (d < 16) return d < 0 ? 0 : d;
    int b = 16;
    b += (d >= 19); b += (d >= 21); b += (d >= 24); b += (d >= 27); b += (d >= 31); b += (d >= 35); b += (d >= 40); b += (d >= 46);
    b += (d >= 52); b += (d >= 59); b += (d >= 67); b += (d >= 77); b += (d >= 87); b += (d >= 99); b += (d >= 113);
    return b;
}
template <class CM> __device__ __forceinline__ void tr_item(const float* W, int Nsrc, int K, bf16* WT, int item, int nblk, CM cm, LAS float* scr, int lane) {
    const int kb = item / nblk, nb = item % nblk, k0 = 64 * kb, n0 = 32 * nb;
    const int sc = cm(n0 + (lane & 31));
#pragma unroll 8
    for (int i = 0; i < 32; ++i) { const int kk = 2 * i + (lane >> 5); scr[kk * 33 + (lane & 31)] = sc >= 0 ? W[(size_t)(k0 + kk) * Nsrc + sc] : 0.f; }
    LDS_WAIT(); asm volatile("" ::: "memory");
    const int c = lane & 7;
#pragma unroll
    for (int j = 0; j < 4; ++j) { const int n = (lane >> 3) + 8 * j; const LAS float* s = scr + (8 * c) * 33 + n;
        v4u o; o.x = pk2(s[0 * 33], s[1 * 33]); o.y = pk2(s[2 * 33], s[3 * 33]); o.z = pk2(s[4 * 33], s[5 * 33]); o.w = pk2(s[6 * 33], s[7 * 33]);
        *(GAS v4u*)(WT + (size_t)(n0 + n) * K + k0 + 8 * c) = o; }
    LDS_WAIT(); asm volatile("" ::: "memory");
}
struct CmId { __device__ __forceinline__ int operator()(int n) const { return n; } };
struct CmWin { __device__ __forceinline__ int operator()(int n) const {
    if (n < 1280) return n;
    if (n < 2816) return n - 1280 + 2856;
    if (n < 4352) return n - 2816 + 1304;
    if (n < 4376) return n - 4352 + 1280;
    if (n < 4392) return n - 4376 + 2840;
    if (n < 4608) return -1;
    return n - 4608 + 4392; } };
struct CmFfn { __device__ __forceinline__ int operator()(int c) const { const int p = c >> 8, r = c & 255; return r < 128 ? 128 * p + r : FF + 128 * p + (r - 128); } };

struct Args { const float* in[22]; float* out; unsigned char* ws; int ph_lo, ph_hi; };

__device__ __forceinline__ void phase_weights(Frame& F, const Args& a, int l) {
    LAS float* scr = (LAS float*)(F.lds + RING_OFF + F.wave * 16384);
    const int gw = blockIdx.x * NWAVES + F.wave, NGW = F.G * NWAVES;
    unsigned char* ws = a.ws;
    constexpr int I_IN = 16 * (NIN / 32), I_BR = 8 * 32, I_O = 16 * 32, I_F1 = 16 * (2 * FF / 32), I_F2 = (FF / 64) * 32;
    constexpr int NIT = I_IN + 3 * I_BR + I_O + I_F1 + I_F2;
    for (int it = gw; it < NIT; it += NGW) {
        int r = it;
        if (r < I_IN) { tr_item(a.in[6] + (size_t)l * DM * DIN, DIN, DM, (bf16*)(ws + WS_WIN), r, NIN / 32, CmWin(), scr, F.lane); continue; } r -= I_IN;
        if (r < I_BR) { tr_item(a.in[16] + (size_t)l * 512 * DM, DM, 512, (bf16*)(ws + WS_WA), r, 32, CmId(), scr, F.lane); continue; } r -= I_BR;
        if (r < I_BR) { tr_item(a.in[17] + (size_t)l * 512 * DM, DM, 512, (bf16*)(ws + WS_WB), r, 32, CmId(), scr, F.lane); continue; } r -= I_BR;
        if (r < I_BR) { tr_item(a.in[18] + (size_t)l * 512 * DM, DM, 512, (bf16*)(ws + WS_WC), r, 32, CmId(), scr, F.lane); continue; } r -= I_BR;
        if (r < I_O) { tr_item(a.in[19] + (size_t)l * DM * DM, DM, DM, (bf16*)(ws + WS_WO), r, 32, CmId(), scr, F.lane); continue; } r -= I_O;
        if (r < I_F1) { tr_item(a.in[20] + (size_t)l * DM * 2 * FF, 2 * FF, DM, (bf16*)(ws + WS_WF1), r, 2 * FF / 32, CmFfn(), scr, F.lane); continue; } r -= I_F1;
        tr_item(a.in[21] + (size_t)l * FF * DM, DM, FF, (bf16*)(ws + WS_WF2), r, 32, CmId(), scr, F.lane);
    }
}
__device__ __forceinline__ void phase_norm0(Frame& F, const float* x, const float* w, bf16* H) {
    const int gw = blockIdx.x * NWAVES + F.wave, NGW = F.G * NWAVES;
    for (int m = gw; m < M_; m += NGW) {
        const f32x4* xr = (const f32x4*)(x + (size_t)m * DM) + F.lane; f32x4 v[4]; float s = 0.f;
#pragma unroll
        for (int j = 0; j < 4; ++j) { v[j] = xr[64 * j]; s += v[j].x * v[j].x + v[j].y * v[j].y + v[j].z * v[j].z + v[j].w * v[j].w; }
        const float r = rsqrtf(wave_sum(s) * (1.f / DM) + NORM_EPS);
        unsigned long long* o8 = (unsigned long long*)(H + (size_t)m * DM) + F.lane;
#pragma unroll
        for (int j = 0; j < 4; ++j) { const f32x4 wv = ((const f32x4*)w)[F.lane + 64 * j];
            o8[64 * j] = (unsigned long long)pk2(v[j].x * r * wv.x, v[j].y * r * wv.y) | ((unsigned long long)pk2(v[j].z * r * wv.z, v[j].w * r * wv.w) << 32); }
    }
}
__device__ __forceinline__ void phase_resid(Frame& F, const float* y, const float* xin, float* xout, const float* wpost, const float* wpre, bf16* hout) {
    const int gw = blockIdx.x * NWAVES + F.wave, NGW = F.G * NWAVES;
    for (int m = gw; m < M_; m += NGW) {
        const f32x4* yr = (const f32x4*)(y + (size_t)m * DM) + F.lane; const f32x4* xr = (const f32x4*)(xin + (size_t)m * DM) + F.lane;
        f32x4 v[4], xv[4]; float s = 0.f;
#pragma unroll
        for (int j = 0; j < 4; ++j) { v[j] = yr[64 * j]; xv[j] = xr[64 * j]; s += v[j].x * v[j].x + v[j].y * v[j].y + v[j].z * v[j].z + v[j].w * v[j].w; }
        const float r = rsqrtf(wave_sum(s) * (1.f / DM) + NORM_EPS); float s2 = 0.f;
        f32x4* xo = (f32x4*)(xout + (size_t)m * DM) + F.lane;
#pragma unroll
        for (int j = 0; j < 4; ++j) { const f32x4 wv = ((const f32x4*)wpost)[F.lane + 64 * j]; f32x4 n;
            n.x = xv[j].x + v[j].x * r * wv.x; n.y = xv[j].y + v[j].y * r * wv.y; n.z = xv[j].z + v[j].z * r * wv.z; n.w = xv[j].w + v[j].w * r * wv.w;
            xo[64 * j] = n; v[j] = n; s2 += n.x * n.x + n.y * n.y + n.z * n.z + n.w * n.w; }
        if (hout) { const float r2 = rsqrtf(wave_sum(s2) * (1.f / DM) + NORM_EPS);
            unsigned long long* o8 = (unsigned long long*)(hout + (size_t)m * DM) + F.lane;
#pragma unroll
            for (int j = 0; j < 4; ++j) { const f32x4 wv = ((const f32x4*)wpre)[F.lane + 64 * j];
                o8[64 * j] = (unsigned long long)pk2(v[j].x * r2 * wv.x, v[j].y * r2 * wv.y) | ((unsigned long long)pk2(v[j].z * r2 * wv.z, v[j].w * r2 * wv.w) << 32); } }
    }
}
__device__ __forceinline__ void unpack8(const v4u w, float (&k)[8]) {
    k[0] = __uint_as_float(w.x << 16); k[1] = __uint_as_float(w.x & 0xffff0000u); k[2] = __uint_as_float(w.y << 16); k[3] = __uint_as_float(w.y & 0xffff0000u);
    k[4] = __uint_as_float(w.z << 16); k[5] = __uint_as_float(w.z & 0xffff0000u); k[6] = __uint_as_float(w.w << 16); k[7] = __uint_as_float(w.w & 0xffff0000u);
}
__device__ __forceinline__ void dot4(const LAS float* qs, const bf16* kr, float (&d)[4]) {
    d[0] = d[1] = d[2] = d[3] = 0.f;
#pragma unroll 1
    for (int c = 0; c < 8; ++c) { asm volatile("" ::: "memory"); const v4u w = ((const v4u*)kr)[c]; float k[8]; unpack8(w, k);
#pragma unroll
        for (int e = 0; e < 8; ++e) { const int dd = c * 8 + e;
#pragma unroll
            for (int h = 0; h < 4; ++h) d[h] += qs[h * 64 + dd] * k[e]; } }
}
__device__ __forceinline__ float dot1(const LAS float* qs, const bf16* kr) {
    float d = 0.f;
#pragma unroll
    for (int c = 0; c < 8; ++c) { const v4u w = ((const v4u*)kr)[c]; float k[8]; unpack8(w, k);
#pragma unroll
        for (int e = 0; e < 8; ++e) d += qs[c * 8 + e] * k[e]; }
    return d;
}
__device__ __forceinline__ float gelu_tanh(float x) { const float u = 0.7978845608028654f * (x + 0.044715f * x * x * x); return 0.5f * x * (1.f + tanhf(u)); }

__device__ __forceinline__ void phase2_naive(Frame& F, const Args& a, int l) {
    const int gw = blockIdx.x * NWAVES + F.wave, NGW = F.G * NWAVES, lane = F.lane;
    const bf16* Y = (const bf16*)(a.ws + WS_Y);
    LAS float* scr = (LAS float*)(F.lds + RING_OFF + F.wave * 16384);
    for (int t = gw; t < 2 * 8 * 511; t += NGW) {
        const int kv = t / (8 * 511), r = t % (8 * 511), bg = r / 511, n = r % 511, b = bg >> 1, g = bg & 1;
        const float* pe = a.in[kv ? 8 : 7] + (size_t)l * 32 * 64; const float* w1 = a.in[kv ? 11 : 9] + (size_t)l * 2048 * 64; const float* w2 = a.in[kv ? 12 : 10] + (size_t)l * 64 * 64;
        const bf16* src = Y + ((size_t)b * S_ + 16 * n) * YP + (kv ? Y_AVC : Y_AKC) + g * 64;
        float acc = 0.f;
        for (int pos = 0; pos < 32; ++pos) {
            const float xin = bf2f(src[(size_t)pos * YP + lane]) + pe[pos * 64 + lane];
            scr[lane] = xin; WFENCE();
#pragma unroll 8
            for (int d = 0; d < 64; ++d) acc += scr[d] * w1[(size_t)(pos * 64 + d) * 64 + lane];
            WFENCE();
        }
        const float hdn = gelu_tanh(acc);
        scr[lane] = hdn; WFENCE();
        float o = 0.f;
#pragma unroll 8
        for (int j = 0; j < 64; ++j) o += scr[j] * w2[j * 64 + lane];
        WFENCE();
        bf16* dst = (bf16*)(a.ws + (kv ? WS_VCMP : WS_KCMP)) + ((size_t)bg * 512 + n) * 64;
        dst[lane] = (bf16)f2bf(o);
    }
    for (int t = gw; t < 4 * 8 * 32; t += NGW) {
        const int blk = t & 31, h = (t >> 5) & 7, b = t >> 8;
        const bf16* src = Y + ((size_t)b * S_ + blk * 256) * YP + Y_CK + h * 64 + lane; float s = 0.f;
        for (int i = 0; i < 256; ++i) s += bf2f(src[(size_t)i * YP]);
        ((float*)(a.ws + WS_KMEAN))[(size_t)t * 64 + lane] = s * (1.f / 256.f);
    }
    {
        const float* w2 = a.in[13] + (size_t)l * 16 * 256; const float* bias = a.in[14] + (size_t)l * 256; float* GA = (float*)(a.ws + WS_GA);
        const long NT = (long)M_ * 256, stride = (long)F.G * 512;
        for (long i = (long)blockIdx.x * 512 + F.tid; i < NT; i += stride) {
            const int c = (int)(i & 255); const size_t row = (size_t)(i >> 8);
            float z = bias[c];
#pragma unroll
            for (int r = 0; r < 16; ++r) z += bf2f(Y[row * YP + Y_BLR + r]) * w2[r * 256 + c];
            const float ls = -(fmaxf(-z, 0.f) + log1pf(__expf(-fabsf(z))));
            GA[i] = __expf(ls * (1.f / 16.f));
        }
    }
}
__device__ __forceinline__ void gla_scan_naive(Frame& F, const Args& a) {
    const bf16* Y = (const bf16*)(a.ws + WS_Y); const float* GA = (const float*)(a.ws + WS_GA); float* O32 = (float*)(a.ws + WS_H);
    const int lane = F.lane;
    for (int task = blockIdx.x; task < 256; task += F.G) {
        const int eg = task & 15, h = (task >> 4) & 3, b = task >> 6, e = eg * 8 + F.wave;
        float Sst = 0.f;
        for (int t0 = 0; t0 < S_; t0 += 8) {
            float av[8], kv[8], qv[8], vv[8];
#pragma unroll
            for (int j = 0; j < 8; ++j) { const size_t row = (size_t)b * S_ + t0 + j;
                av[j] = GA[row * 256 + h * 64 + lane]; kv[j] = bf2f(Y[row * YP + Y_BK + h * 64 + lane]); qv[j] = bf2f(Y[row * YP + Y_BQ + h * 64 + lane]); vv[j] = bf2f(Y[row * YP + Y_BV + h * 128 + e]); }
#pragma unroll
            for (int j = 0; j < 8; ++j) { Sst = av[j] * Sst + kv[j] * vv[j]; const float o = wave_sum(qv[j] * Sst);
                if (lane == 0) O32[((size_t)b * S_ + t0 + j) * 512 + h * 128 + e] = o; }
        }
    }
}
__device__ __forceinline__ void nsa_naive(Frame& F, const Args& a) {
    const int gw = blockIdx.x * NWAVES + F.wave, NGW = F.G * NWAVES, lane = F.lane;
    bf16* Y = (bf16*)(a.ws + WS_Y); const float* rel = a.in[1];
    LAS float* scr = (LAS float*)(F.lds + RING_OFF + F.wave * 16384);
    LAS float* qs = scr; LAS float* sc = scr + 256; LAS float* s2 = scr + 256 + 2048;
    for (int task = gw; task < 8 * S_; task += NGW) {
        const int q = task & (S_ - 1), bg = task >> 13, g = bg & 1, b = bg >> 1;
        const size_t row = (size_t)b * S_ + q; bf16* Yr = Y + row * YP;
#pragma unroll
        for (int h = 0; h < 4; ++h) qs[h * 64 + lane] = bf2f(Yr[Y_AQ + (g * 4 + h) * 64 + lane]);
        float gt[4][3];
#pragma unroll
        for (int h = 0; h < 4; ++h)
#pragma unroll
            for (int br = 0; br < 3; ++br) gt[h][br] = sigm(bf2f(Yr[Y_AG + (g * 4 + h) * 3 + br]));
        WFENCE();
        const int cur = q >> 6, ncv = q >= 31 ? ((q - 31) >> 4) + 1 : 0;
        const bf16* KC = (const bf16*)(a.ws + WS_KCMP) + (size_t)bg * 512 * 64; const bf16* VC = (const bf16*)(a.ws + WS_VCMP) + (size_t)bg * 512 * 64;
        float mx[4] = {-1e30f, -1e30f, -1e30f, -1e30f};
        for (int i = 0; i < 8; ++i) { const int n = lane + 64 * i;
            if (n < ncv) { float d[4]; dot4(qs, KC + (size_t)n * 64, d); const int bk = t5_bucket(q - (16 * n + 31));
#pragma unroll
                for (int h = 0; h < 4; ++h) { const float s = d[h] + rel[bk * 16 + g * 4 + h] * LOG2E; sc[h * 512 + n] = s; mx[h] = fmaxf(mx[h], s); } }
            else {
#pragma unroll
                for (int h = 0; h < 4; ++h) sc[h * 512 + n] = 0.f; } }
        float ls[4] = {0.f, 0.f, 0.f, 0.f};
#pragma unroll
        for (int h = 0; h < 4; ++h) mx[h] = wave_max(mx[h]);
        WFENCE();
        for (int i = 0; i < 8; ++i) { const int n = lane + 64 * i;
            if (n < ncv) {
#pragma unroll
                for (int h = 0; h < 4; ++h) { const float e = exp2f(sc[h * 512 + n] - mx[h]); sc[h * 512 + n] = e; ls[h] += e; } } }
#pragma unroll
        for (int h = 0; h < 4; ++h) ls[h] = 1.f / fmaxf(wave_sum(ls[h]), 1e-20f);
        for (int i = 0; i < 8; ++i) { const int n = lane + 64 * i;
            if (n < ncv) {
#pragma unroll
                for (int h = 0; h < 4; ++h) sc[h * 512 + n] *= ls[h]; } }
        WFENCE();
        float v0, v1;
        { float t[2];
#pragma unroll
          for (int jj = 0; jj < 2; ++jj) { const int j = lane + 64 * jj; float v = 0.f;
              for (int n = 4 * j - 1; n <= 4 * j + 3; ++n) if (n >= 0 && n < 511) v += (sc[n] + sc[512 + n]) + (sc[1024 + n] + sc[1536 + n]);
              const bool forced = (j == 0) || (j == cur) || (j == cur - 1);
              t[jj] = forced ? 1e9f : (j <= cur ? v : -1e30f); }
          v0 = t[0]; v1 = t[1]; }
        bool sel0 = false, sel1 = false;
        for (int it = 0; it < 16; ++it) {
            const float c0 = sel0 ? -INFINITY : v0, c1 = sel1 ? -INFINITY : v1;
            const float mxv = wave_max(fmaxf(c0, c1));
            const unsigned long long m0 = __ballot(!sel0 && v0 == mxv);
            if (m0) { const int idx = __builtin_ctzll(m0); if (lane == idx) sel0 = true; }
            else { const unsigned long long m1 = __ballot(!sel1 && v1 == mxv); const int idx = m1 ? __builtin_ctzll(m1) : -1; if (lane == idx) sel1 = true; }
        }
        sel0 = sel0 && (lane <= cur); sel1 = sel1 && (lane + 64 <= cur);
        const unsigned long long sm0 = __ballot(sel0), sm1 = __ballot(sel1);
        float oc[4] = {0.f, 0.f, 0.f, 0.f};
        for (int n = 0; n < ncv; ++n) { const float vv = bf2f(VC[(size_t)n * 64 + lane]);
#pragma unroll
            for (int h = 0; h < 4; ++h) oc[h] += sc[h * 512 + n] * vv; }
        float ms[4] = {-1e30f, -1e30f, -1e30f, -1e30f}, lsel[4] = {0.f, 0.f, 0.f, 0.f}, os[4] = {0.f, 0.f, 0.f, 0.f};
        for (int j = 0; j <= cur; ++j) {
            const bool on = j < 64 ? ((sm0 >> j) & 1ull) : ((sm1 >> (j - 64)) & 1ull);
            if (!on) continue;
            const int kpos = 64 * j + lane; const bool valid = kpos <= q;
            float d[4]; dot4(qs, Y + ((size_t)b * S_ + kpos) * YP + Y_AKS + g * 64, d);
            const int bk = t5_bucket(q - kpos);
            WFENCE();
#pragma unroll
            for (int h = 0; h < 4; ++h) { const float s = valid ? d[h] + rel[bk * 16 + g * 4 + h] * LOG2E : -1e30f;
                const float mn = fmaxf(ms[h], wave_max(s)); const float p = valid ? exp2f(s - mn) : 0.f; s2[h * 64 + lane] = p;
                const float scl = exp2f(ms[h] - mn); lsel[h] = lsel[h] * scl + wave_sum(p); os[h] *= scl; ms[h] = mn; }
            WFENCE();
            const bf16* vb = Y + ((size_t)b * S_ + 64 * j) * YP + Y_AVS + g * 64 + lane;
            for (int kk = 0; kk < 64; ++kk) { const float vv = bf2f(vb[(size_t)kk * YP]);
#pragma unroll
                for (int h = 0; h < 4; ++h) os[h] += s2[h * 64 + kk] * vv; }
        }
        float mw[4] = {-1e30f, -1e30f, -1e30f, -1e30f}, lw[4] = {0.f, 0.f, 0.f, 0.f}, ow[4] = {0.f, 0.f, 0.f, 0.f};
        for (int c = 0; c < 8; ++c) {
            if (q - 64 * c < 0) break;
            const int dist = 64 * c + lane, kpos = q - dist; const bool valid = kpos >= 0;
            float d[4]; dot4(qs, Y + ((size_t)b * S_ + (valid ? kpos : 0)) * YP + Y_AKW + g * 64, d);
            const int bk = t5_bucket(dist);
            WFENCE();
#pragma unroll
            for (int h = 0; h < 4; ++h) { const float s = valid ? d[h] + rel[bk * 16 + g * 4 + h] * LOG2E : -1e30f;
                const float mn = fmaxf(mw[h], wave_max(s)); const float p = valid ? exp2f(s - mn) : 0.f; s2[h * 64 + lane] = p;
                const float scl = exp2f(mw[h] - mn); lw[h] = lw[h] * scl + wave_sum(p); ow[h] *= scl; mw[h] = mn; }
            WFENCE();
            for (int kk = 0; kk < 64; ++kk) { const int kp = q - 64 * c - kk; if (kp < 0) break;
                const float vv = bf2f(Y[((size_t)b * S_ + kp) * YP + Y_AVW + g * 64 + lane]);
#pragma unroll
                for (int h = 0; h < 4; ++h) ow[h] += s2[h * 64 + kk] * vv; }
        }
        WFENCE();
#pragma unroll
        for (int h = 0; h < 4; ++h) { const float o = gt[h][0] * oc[h] + gt[h][1] * os[h] / fmaxf(lsel[h], 1e-20f) + gt[h][2] * ow[h] / fmaxf(lw[h], 1e-20f);
            Yr[Y_AQ + (g * 4 + h) * 64 + lane] = (bf16)f2bf(o); }
    }
}
__device__ __forceinline__ void moba_naive(Frame& F, const Args& a) {
    const int gw = blockIdx.x * NWAVES + F.wave, NGW = F.G * NWAVES, lane = F.lane;
    bf16* Y = (bf16*)(a.ws + WS_Y); const float* rel = a.in[1]; const float* KM = (const float*)(a.ws + WS_KMEAN);
    LAS float* scr = (LAS float*)(F.lds + RING_OFF + F.wave * 16384);
    LAS float* qs = scr; LAS float* s2 = scr + 64;
    for (int task = gw; task < 32 * S_; task += NGW) {
        const int q = task & (S_ - 1), bh = task >> 13, h = bh & 7, b = bh >> 3;
        const size_t row = (size_t)b * S_ + q; bf16* Yr = Y + row * YP;
        WFENCE();
        qs[lane] = bf2f(Yr[Y_CQ + h * 64 + lane]);
        WFENCE();
        const int cur = q >> 8;
        float gs = -1e30f;
        if (lane < 32 && lane < cur) { const float* km = KM + ((size_t)bh * 32 + lane) * 64; float d = 0.f;
            for (int dd = 0; dd < 64; ++dd) d += qs[dd] * km[dd];
            gs = d; }
        if (lane >= 32) gs = -INFINITY;
        bool sel = false;
        for (int it = 0; it < 3; ++it) { const float c = sel ? -INFINITY : gs; const float mxv = wave_max(c);
            const unsigned long long m0 = __ballot(!sel && lane < 32 && gs == mxv); const int idx = m0 ? __builtin_ctzll(m0) : -1; if (lane == idx) sel = true; }
        sel = sel && (lane < cur);
        const unsigned smask = (unsigned)__ballot(sel);
        float mr = -1e30f, lr = 0.f, o = 0.f;
        for (int j = 0; j <= cur; ++j) {
            const bool own = (j == cur);
            if (!own && !((smask >> j) & 1u)) continue;
            for (int c = 0; c < 4; ++c) {
                const int kpos = 256 * j + 64 * c + lane; const bool valid = kpos <= q;
                if (256 * j + 64 * c > q) break;
                const float d = dot1(qs, Y + ((size_t)b * S_ + kpos) * YP + Y_CK + h * 64);
                const int bk = t5_bucket(q - kpos);
                const float s = valid ? d + rel[bk * 16 + 8 + h] * LOG2E : -1e30f;
                const float mn = fmaxf(mr, wave_max(s)); const float p = valid ? exp2f(s - mn) : 0.f;
                WFENCE(); s2[lane] = p; WFENCE();
                const float scl = exp2f(mr - mn); lr = lr * scl + wave_sum(p); o *= scl; mr = mn;
                const bf16* vb = Y + ((size_t)b * S_ + 256 * j + 64 * c) * YP + Y_CV + h * 64 + lane;
                for (int kk = 0; kk < 64; ++kk) o += s2[kk] * bf2f(vb[(size_t)kk * YP]);
            }
        }
        Yr[Y_CQ + h * 64 + lane] = (bf16)f2bf(o / fmaxf(lr, 1e-20f));
    }
}
__device__ __forceinline__ void gla_out_naive(Frame& F, const Args& a, int l) {
    const int gw = blockIdx.x * NWAVES + F.wave, NGW = F.G * NWAVES, lane = F.lane;
    bf16* Y = (bf16*)(a.ws + WS_Y); const float* O32 = (const float*)(a.ws + WS_H); const float* nw = a.in[15] + (size_t)l * 128;
    for (int t = gw; t < M_ * 4; t += NGW) {
        const int h = t & 3; const size_t row = (size_t)(t >> 2);
        const float o0 = O32[row * 512 + h * 128 + lane], o1 = O32[row * 512 + h * 128 + 64 + lane];
        const float r = rsqrtf(wave_sum(o0 * o0 + o1 * o1) * (1.f / 128.f) + NORM_EPS);
        bf16* yr = Y + row * YP + Y_BR + h * 128;
        const float r0 = bf2f(yr[lane]), r1 = bf2f(yr[64 + lane]);
        yr[lane] = (bf16)f2bf(o0 * r * nw[lane] * (r0 * sigm(r0))); yr[64 + lane] = (bf16)f2bf(o1 * r * nw[64 + lane] * (r1 * sigm(r1)));
    }
}

constexpr int PPL = 11, NPH = NL * PPL;
#define IN(k) (lo <= (k) && (k) < hi)
#define SEAM(k) do { if (IN(k) && IN((k) + 1)) xcd_barrier(bar); } while (0)
template <int l> __device__ __forceinline__ void layer_body(Frame& F, const Args& args, const XcdBarrier& bar, const int lo, const int hi) {
    unsigned char* ws = args.ws;
    bf16* H = (bf16*)(ws + WS_H); bf16* Y = (bf16*)(ws + WS_Y); unsigned char* G8 = ws + WS_G8;
    float* Yf = (float*)(ws + WS_Y); bf16* ACT = (bf16*)(ws + WS_ACT);
    constexpr int p0 = l * PPL;
    const float* xin = l == 0 ? args.in[0] : args.out;
    if (IN(p0 + 0)) { phase_weights(F, args, l); if (l == 0) phase_norm0(F, args.in[0], args.in[2], H); SEAM(p0 + 0); }
    if (IN(p0 + 1)) {
        pg8::Gemm g{H, (const bf16*)(ws + WS_WIN), M_, NIN, DM, DM}; pg8::StaticOrder So; So.init(M_, NIN, F.G, (int)blockIdx.x);
        pg8::EpiInProj E{Y, G8};
        pg8::gemm_phase<pg8::EpiInProj, pg8::StaticOrder, true, true>(F.lds + RING_OFF, g, So, E);
        SEAM(p0 + 1);
    }
    if (IN(p0 + 2)) { phase2_naive(F, args, l); SEAM(p0 + 2); }
    if (IN(p0 + 3)) { gla_scan_naive(F, args); nsa_naive(F, args); moba_naive(F, args); SEAM(p0 + 3); }
    if (IN(p0 + 4)) { gla_out_naive(F, args, l); SEAM(p0 + 4); }
    if (IN(p0 + 5)) {
        pg8::StaticOrder So; So.init(M_, DM, F.G, (int)blockIdx.x);
        { pg8::Gemm g{Y + Y_AQ, (const bf16*)(ws + WS_WA), M_, DM, 512, YP}; pg8::EpiMerge<0> E{H, G8}; pg8::gemm_phase<pg8::EpiMerge<0>, pg8::StaticOrder, true, true>(F.lds + RING_OFF, g, So, E); }
        __syncthreads();
        { pg8::Gemm g{Y + Y_BR, (const bf16*)(ws + WS_WB), M_, DM, 512, YP}; pg8::EpiMerge<1> E{H, G8}; pg8::gemm_phase<pg8::EpiMerge<1>, pg8::StaticOrder, true, true>(F.lds + RING_OFF, g, So, E); }
        __syncthreads();
        { pg8::Gemm g{Y + Y_CQ, (const bf16*)(ws + WS_WC), M_, DM, 512, YP}; pg8::EpiMerge<2> E{H, G8}; pg8::gemm_phase<pg8::EpiMerge<2>, pg8::StaticOrder, true, true>(F.lds + RING_OFF, g, So, E); }
        SEAM(p0 + 5);
    }
    if (IN(p0 + 6)) {
        pg8::Gemm g{H, (const bf16*)(ws + WS_WO), M_, DM, DM, DM}; pg8::StaticOrder So; So.init(M_, DM, F.G, (int)blockIdx.x);
        pg8::EpiF32 E{Yf, DM}; pg8::gemm_phase<pg8::EpiF32, pg8::StaticOrder, true, true>(F.lds + RING_OFF, g, So, E);
        SEAM(p0 + 6);
    }
    if (IN(p0 + 7)) { phase_resid(F, Yf, xin, args.out, args.in[3] + (size_t)l * DM, args.in[4] + (size_t)l * DM, H); SEAM(p0 + 7); }
    if (IN(p0 + 8)) {
        pg8::Gemm g{H, (const bf16*)(ws + WS_WF1), M_, 2 * FF, DM, DM}; pg8::StaticOrder So; So.init(M_, 2 * FF, F.G, (int)blockIdx.x);
        pg8::EpiSwiglu E{ACT, FF}; pg8::gemm_phase<pg8::EpiSwiglu, pg8::StaticOrder, true, true>(F.lds + RING_OFF, g, So, E);
        SEAM(p0 + 8);
    }
    if (IN(p0 + 9)) {
        pg8::Gemm g{ACT, (const bf16*)(ws + WS_WF2), M_, DM, FF, FF}; pg8::StaticOrder So; So.init(M_, DM, F.G, (int)blockIdx.x);
        pg8::EpiF32 E{Yf, DM}; pg8::gemm_phase<pg8::EpiF32, pg8::StaticOrder, true, true>(F.lds + RING_OFF, g, So, E);
        SEAM(p0 + 9);
    }
    if (IN(p0 + 10)) { phase_resid(F, Yf, args.out, args.out, args.in[5] + (size_t)l * DM, l + 1 < NL ? args.in[2] + (size_t)(l + 1) * DM : nullptr, l + 1 < NL ? H : nullptr); SEAM(p0 + 10); }
}
__global__ void __launch_bounds__(NWAVES * 64, 2) mk_fwd(Args args) {
    extern __shared__ __attribute__((aligned(16))) unsigned char lds[];
    Frame F;
    F.lds = (LAS unsigned char*)lds; F.MISC = (volatile LAS unsigned*)(F.lds + MISC_OFF);
    F.tid = threadIdx.x; F.lane = F.tid & 63; F.wave = __builtin_amdgcn_readfirstlane(F.tid >> 6); F.G = gridDim.x;
    F.ctl = (gu32*)(args.ws + WS_CTL);
    for (int u = F.tid; u < (LDS_BYTES - LDSCTL_OFF) / 4; u += NWAVES * 64) ((LAS unsigned*)(F.lds + LDSCTL_OFF))[u] = 0u;
    __syncthreads();
    const int lo = args.ph_lo, hi = args.ph_hi;
    XcdBarrier bar; bar.bar = (unsigned*)(F.ctl + CW_BAR); bar.x = 0; bar.st = nullptr;
    if (hi - lo > 1) bar = xcd_barrier_post((unsigned*)(F.ctl + CW_BAR), F.MISC + 8);
    layer_body<0>(F, args, bar, lo, hi);
    layer_body<1>(F, args, bar, lo, hi);
}
#undef IN
#undef SEAM

#ifndef MK_ONE_LAUNCH
#define MK_ONE_LAUNCH 1
#endif
extern "C" void kernel_launch(void* const* d_in, const int* in_sizes, int n_in, void* d_out, int out_size, void* d_ws, size_t ws_size, hipStream_t stream) {
    static int grid = 0;
    if (grid == 0) {
        if (n_in != 22 || out_size != M_ * DM || ws_size < WS_END) { fprintf(stderr, "kernel_launch: unexpected sizes (n_in %d out %d ws %zu)\n", n_in, out_size, ws_size); grid = -1; return; }
        int dev = 0, cus = 0;
        if (hipGetDevice(&dev) != hipSuccess || hipDeviceGetAttribute(&cus, hipDeviceAttributeMultiprocessorCount, dev) != hipSuccess) { grid = -1; return; }
        if (hipFuncSetAttribute((const void*)mk_fwd, hipFuncAttributeMaxDynamicSharedMemorySize, LDS_BYTES) != hipSuccess) { grid = -1; return; }
        (void)hipGetLastError();
        grid = cus;
    }
    if (grid < 0) return;
    if (hipMemsetAsync((char*)d_ws + WS_CTL, 0, CTL_ZERO_BYTES, stream) != hipSuccess) return;
    Args a{};
    for (int i = 0; i < 22; ++i) a.in[i] = (const float*)d_in[i];
    a.out = (float*)d_out; a.ws = (unsigned char*)d_ws;
#if MK_ONE_LAUNCH
    a.ph_lo = 0; a.ph_hi = NPH;
    hipLaunchKernelGGL(mk_fwd, dim3(grid), dim3(NWAVES * 64), LDS_BYTES, stream, a);
#else
    for (int p = 0; p < NPH; ++p) { a.ph_lo = p; a.ph_hi = p + 1; hipLaunchKernelGGL(mk_fwd, dim3(grid), dim3(NWAVES * 64), LDS_BYTES, stream, a); }
#endif
}
```

```cpp
#include <hip/hip_runtime.h>
#include <cstdio>
#include <cstdint>
#include <cmath>
namespace pg8 {
#define PG8_LAS __attribute__((address_space(3)))
typedef unsigned short bf16_t;
typedef short bf16x8 __attribute__((ext_vector_type(8)));
typedef float f32x4 __attribute__((ext_vector_type(4)));
typedef unsigned u32x4 __attribute__((ext_vector_type(4)));
constexpr int BM = 256, BK = 64, HALF = 128, HTB = HALF * BK * 2  , STAGE_BYTES = 8 * HTB, NXCD = 8, WGM = 8;

__host__ __device__ __forceinline__ int lds_byte(int r, int c) { const int st = (r >> 4) * 2 + (c >> 5), rr = r & 15, cc = c & 31, ob = rr * 64 + cc * 2; return st * 1024 + (ob ^ (((ob >> 9) & 1) << 5)); }
__host__ __device__ __forceinline__ void stage_rc(int b, int& R, int& C) { const int st = b / 1024, sb = b % 1024, swz = sb ^ (((sb >> 9) & 1) << 5); R = (st >> 1) * 16 + swz / 64; C = (st & 1) * 32 + (swz % 64) / 2; }
__host__ __device__ __forceinline__ int perm32(int rho) { const int n = rho >> 4, i = rho & 15; return 8 * (i >> 2) + 4 * n + (i & 3); }

struct Unit { int pm, pn; };
struct Gemm { const bf16_t* A; const bf16_t* Bt; int M, N, K, lda; };

struct StaticOrder {
    int nM, nN, nwg, G, c;
    __host__ __device__ void init(int M, int N, int G_, int c_) { nM = M / BM; nN = N / BM; nwg = nM * nN; G = G_; c = c_; }
    __host__ __device__ bool next(int i, Unit& u) const {
        const long L = (long)i * G + c; if (L >= nwg) return false;
        int wgid = (int)L; { const int q = nwg / NXCD, r = nwg % NXCD, xcd = wgid % NXCD, off = wgid / NXCD; wgid = (xcd < r ? xcd * (q + 1) : r * (q + 1) + (xcd - r) * q) + off; }
        const int nig = WGM * nN, gid = wgid / nig, fm = gid * WGM, gsz = (nM - fm) < WGM ? (nM - fm) : WGM;
        u.pm = fm + ((wgid % nig) % gsz); u.pn = (wgid % nig) / gsz; return true;
    }
    __device__ __forceinline__ void a_ready(const Unit&) const {}
    __device__ __forceinline__ void done(const Unit&) const {}
};

__device__ __forceinline__ unsigned cvt_pk_bf16(float lo, float hi) { unsigned r; asm volatile("v_cvt_pk_bf16_f32 %0, %1, %2" : "=v"(r) : "v"(lo), "v"(hi)); return r; }
typedef float f32x2 __attribute__((ext_vector_type(2)));
constexpr int YP_ = 4392;
constexpr float C2_ = 0.125f * 1.4426950408889634f;
__device__ __forceinline__ float sigmoidf_(float v) { return 1.f / (1.f + __expf(-v)); }
struct EpiInProj {
    static constexpr bool PERM = true, AFTER_DRAIN = false;
    bf16_t* Y; unsigned char* G8;
    __device__ __forceinline__ void operator()(const f32x4 (&acc)[2][2][4][2], const Unit& u, int wr, int wc, int fr, int fq) const {
        const int row0 = u.pm * BM + wr * 64 + fr, colt = u.pn * BM, cin = wc * 32 + 8 * fq;
        if (u.pn < 18) {
            float sc = 1.f; if (u.pn < 2 || u.pn == 5 || u.pn == 6) sc = C2_; else if (u.pn == 11) sc = 0.125f;
#pragma unroll
            for (int ai = 0; ai < 2; ++ai)
#pragma unroll
                for (int m = 0; m < 4; ++m) { bf16_t* rowp = Y + (size_t)(row0 + ai * HALF + m * 16) * YP_;
#pragma unroll
                    for (int bj = 0; bj < 2; ++bj) { const int col = colt + cin + bj * HALF;
                        if (col + 8 <= YP_) { const f32x4 v0 = acc[ai][bj][m][0] * sc, v1 = acc[ai][bj][m][1] * sc; u32x4 w;
                            w.x = cvt_pk_bf16(v0[0], v0[1]); w.y = cvt_pk_bf16(v0[2], v0[3]); w.z = cvt_pk_bf16(v1[0], v1[1]); w.w = cvt_pk_bf16(v1[2], v1[3]);
                            *(u32x4*)(rowp + col) = w; } } }
        } else {
#pragma unroll
            for (int ai = 0; ai < 2; ++ai)
#pragma unroll
                for (int m = 0; m < 4; ++m) { unsigned char* rowp = G8 + (size_t)(row0 + ai * HALF + m * 16) * 3072 + (colt - 4608) + cin;
#pragma unroll
                    for (int bj = 0; bj < 2; ++bj) { const f32x4 v0 = acc[ai][bj][m][0], v1 = acc[ai][bj][m][1]; unsigned lo = 0u, hi = 0u;
#pragma unroll
                        for (int e = 0; e < 4; ++e) { lo |= (unsigned)(sigmoidf_(v0[e]) * 255.f + 0.5f) << (8 * e); hi |= (unsigned)(sigmoidf_(v1[e]) * 255.f + 0.5f) << (8 * e); }
                        typedef unsigned u32x2 __attribute__((ext_vector_type(2))); u32x2 w; w.x = lo; w.y = hi; *(u32x2*)(rowp + bj * HALF) = w; } }
        }
    }
};
template <int I> struct EpiMerge {
    static constexpr bool PERM = true, AFTER_DRAIN = false;
    bf16_t* Mg; const unsigned char* G8;
    __device__ __forceinline__ void operator()(const f32x4 (&acc)[2][2][4][2], const Unit& u, int wr, int wc, int fr, int fq) const {
        const int row0 = u.pm * BM + wr * 64 + fr, col0 = u.pn * BM + wc * 32 + 8 * fq;
#pragma unroll
        for (int ai = 0; ai < 2; ++ai)
#pragma unroll
            for (int m = 0; m < 4; ++m) { const size_t row = (size_t)(row0 + ai * HALF + m * 16);
#pragma unroll
                for (int bj = 0; bj < 2; ++bj) { const int col = col0 + bj * HALF;
                    typedef unsigned u32x2 __attribute__((ext_vector_type(2)));
                    const u32x2 gw = *(const u32x2*)(G8 + row * 3072 + I * 1024 + col);
                    float v[8];
#pragma unroll
                    for (int e = 0; e < 4; ++e) { v[e] = acc[ai][bj][m][0][e] * ((float)((gw.x >> (8 * e)) & 255u) * (1.f / 255.f)); v[4 + e] = acc[ai][bj][m][1][e] * ((float)((gw.y >> (8 * e)) & 255u) * (1.f / 255.f)); }
                    bf16_t* p = Mg + row * 1024 + col;
                    if (I > 0) { const u32x4 o = *(const u32x4*)p;
                        v[0] += __uint_as_float(o.x << 16); v[1] += __uint_as_float(o.x & 0xffff0000u); v[2] += __uint_as_float(o.y << 16); v[3] += __uint_as_float(o.y & 0xffff0000u);
                        v[4] += __uint_as_float(o.z << 16); v[5] += __uint_as_float(o.z & 0xffff0000u); v[6] += __uint_as_float(o.w << 16); v[7] += __uint_as_float(o.w & 0xffff0000u); }
                    u32x4 w; w.x = cvt_pk_bf16(v[0], v[1]); w.y = cvt_pk_bf16(v[2], v[3]); w.z = cvt_pk_bf16(v[4], v[5]); w.w = cvt_pk_bf16(v[6], v[7]);
                    *(u32x4*)p = w; } }
    }
};
struct EpiF32 {
    static constexpr bool PERM = true, AFTER_DRAIN = false;
    float* O; int ldc;
    __device__ __forceinline__ void operator()(const f32x4 (&acc)[2][2][4][2], const Unit& u, int wr, int wc, int fr, int fq) const {
        const int row0 = u.pm * BM + wr * 64 + fr, col0 = u.pn * BM + wc * 32 + 8 * fq;
#pragma unroll
        for (int ai = 0; ai < 2; ++ai)
#pragma unroll
            for (int m = 0; m < 4; ++m) { float* rowp = O + (size_t)(row0 + ai * HALF + m * 16) * ldc + col0;
#pragma unroll
                for (int bj = 0; bj < 2; ++bj) { *(f32x4*)(rowp + bj * HALF) = acc[ai][bj][m][0]; *(f32x4*)(rowp + bj * HALF + 4) = acc[ai][bj][m][1]; } }
    }
};
struct EpiSwiglu {
    static constexpr bool PERM = true, AFTER_DRAIN = false;
    bf16_t* Act; int ldc;
    __device__ __forceinline__ void operator()(const f32x4 (&acc)[2][2][4][2], const Unit& u, int wr, int wc, int fr, int fq) const {
        const int row0 = u.pm * BM + wr * 64 + fr, col0 = u.pn * HALF + wc * 32 + 8 * fq;
#pragma unroll
        for (int ai = 0; ai < 2; ++ai)
#pragma unroll
            for (int m = 0; m < 4; ++m) { bf16_t* p = Act + (size_t)(row0 + ai * HALF + m * 16) * ldc + col0; float v[8];
#pragma unroll
                for (int e = 0; e < 4; ++e) { const float g0 = acc[ai][0][m][0][e], g1 = acc[ai][0][m][1][e];
                    v[e] = g0 * sigmoidf_(g0) * acc[ai][1][m][0][e]; v[4 + e] = g1 * sigmoidf_(g1) * acc[ai][1][m][1][e]; }
                u32x4 w; w.x = cvt_pk_bf16(v[0], v[1]); w.y = cvt_pk_bf16(v[2], v[3]); w.z = cvt_pk_bf16(v[4], v[5]); w.w = cvt_pk_bf16(v[6], v[7]);
                *(u32x4*)p = w; }
    }
};
template <class Epi, class Sched, bool ALIGN_EPI = false, bool SP2 = false>
__device__ __forceinline__ void gemm_phase(PG8_LAS unsigned char* lds, const Gemm g, const Sched& S, const Epi& E) {
    const int tid = threadIdx.x, wid = __builtin_amdgcn_readfirstlane(tid >> 6), lane = tid & 63, wr = wid >> 2, wc = wid & 3, fr = lane & 15, fq = lane >> 4;
    const int K = g.K, nt = K / BK;
    unsigned voffA[2], voffB[2];
#pragma unroll
    for (int i = 0; i < 2; ++i) { int R, C; stage_rc(tid * 16 + i * 8192, R, C); const int Rb = Epi::PERM ? ((R & ~31) + perm32(R & 31)) : R;
        voffA[i] = (unsigned)(R * g.lda + C) * 2u; voffB[i] = (unsigned)(Rb * K + C) * 2u; }
    const size_t kstep = (size_t)(BK * 2);
    const size_t hstepB = (size_t)HALF * K * 2, hstepA = (size_t)HALF * g.lda * 2;
    const size_t tstepA = 2 * hstepA, tstepB = 2 * hstepB;
    const unsigned ldsw = (unsigned)wid * 1024u;
    const int aoff = lds_byte(wr * 64 + fr, fq * 8), boff = lds_byte(wc * 32 + fr, fq * 8);
#define PG8_SA(b, h) (((b) * 2 + (h)) * HTB)
#define PG8_SB(b, h) ((4 + (b) * 2 + (h)) * HTB)
#define PG8_STAGE(bufoff, gbase, voff) do { _Pragma("unroll") for (int _i = 0; _i < 2; ++_i) \
        __builtin_amdgcn_global_load_lds((const unsigned*)((const char*)(gbase) + (voff)[_i]), (PG8_LAS unsigned*)(lds + (bufoff) + ldsw + _i * 8192), 16, 0, 0); } while (0)
#define PG8_LDA(dst, b, h) do { _Pragma("unroll") for (int m = 0; m < 4; ++m) _Pragma("unroll") for (int k = 0; k < 2; ++k) dst[m][k] = *(const PG8_LAS bf16x8*)(lds + PG8_SA(b, h) + aoff + m * 2048 + k * 1024); } while (0)
#define PG8_LDB(dst, b, h) do { _Pragma("unroll") for (int n = 0; n < 2; ++n) _Pragma("unroll") for (int k = 0; k < 2; ++k) dst[n][k] = *(const PG8_LAS bf16x8*)(lds + PG8_SB(b, h) + boff + n * 2048 + k * 1024); } while (0)
#define PG8_MMA(ai, bj, At, Bt) do { __builtin_amdgcn_s_setprio(1); _Pragma("unroll") for (int m = 0; m < 4; ++m) _Pragma("unroll") for (int n = 0; n < 2; ++n) _Pragma("unroll") for (int k = 0; k < 2; ++k) \
        acc[ai][bj][m][n] = __builtin_amdgcn_mfma_f32_16x16x32_bf16(Bt[n][k], At[m][k], acc[ai][bj][m][n], 0, 0, 0); __builtin_amdgcn_s_setprio(0); } while (0)
#define PG8_WAIT_V(n) asm volatile("s_waitcnt vmcnt(" #n ")" ::: "memory")
#define PG8_WAIT_L(n) asm volatile("s_waitcnt lgkmcnt(" #n ")" ::: "memory")
#define PG8_BAR __builtin_amdgcn_s_barrier()
#define PG8_SCHED __builtin_amdgcn_sched_barrier(0)
    Unit cur, nxt; int ui = 0;
    if (!S.next(0, cur)) return;
    f32x4 acc[2][2][4][2];
#pragma unroll
    for (int a = 0; a < 2; ++a)
#pragma unroll
        for (int b = 0; b < 2; ++b)
#pragma unroll
            for (int m = 0; m < 4; ++m)
#pragma unroll
                for (int n = 0; n < 2; ++n) acc[a][b][m][n] = (f32x4){0.f, 0.f, 0.f, 0.f};
    bf16x8 At[4][2], B0[2][2], B1[2][2];
    const char* cA = (const char*)g.A + (size_t)cur.pm * tstepA; const char* cB = (const char*)g.Bt + (size_t)cur.pn * tstepB;
    S.a_ready(cur);
    if constexpr (SP2) {
        PG8_STAGE(PG8_SB(0, 0), cB, voffB); PG8_STAGE(PG8_SB(0, 1), cB + hstepB, voffB); PG8_STAGE(PG8_SA(0, 0), cA, voffA); PG8_STAGE(PG8_SA(0, 1), cA + hstepA, voffA);
        if (wr == 1) PG8_BAR;
        PG8_WAIT_V(2); PG8_BAR;
        PG8_STAGE(PG8_SB(1, 0), cB + kstep, voffB); PG8_STAGE(PG8_SA(1, 0), cA + kstep, voffA); PG8_STAGE(PG8_SB(1, 1), cB + hstepB + kstep, voffB);
        PG8_WAIT_V(6); PG8_BAR;
    } else {
        PG8_STAGE(PG8_SB(0, 0), cB, voffB); PG8_STAGE(PG8_SA(0, 0), cA, voffA); PG8_STAGE(PG8_SB(0, 1), cB + hstepB, voffB); PG8_STAGE(PG8_SA(0, 1), cA + hstepA, voffA);
        if (wr == 1) PG8_BAR;
        PG8_WAIT_V(4); PG8_BAR;
        PG8_STAGE(PG8_SB(1, 0), cB + kstep, voffB); PG8_STAGE(PG8_SA(1, 0), cA + kstep, voffA); PG8_STAGE(PG8_SB(1, 1), cB + hstepB + kstep, voffB);
        PG8_WAIT_V(6); PG8_BAR;
    }
    for (;;) {
        const bool has_next = S.next(ui + 1, nxt);
        const char* nA = has_next ? (const char*)g.A + (size_t)nxt.pm * tstepA : cA; const char* nB = has_next ? (const char*)g.Bt + (size_t)nxt.pn * tstepB : cB;
        for (int t = 0; t < nt; t += 2) {
            const bool last = (t == nt - 2);
            const char* a1 = cA + (size_t)(t + 1) * kstep;
            const char* a2 = last ? nA : cA + (size_t)(t + 2) * kstep; const char* b2 = last ? nB : cB + (size_t)(t + 2) * kstep;
            const char* a3 = a2 + kstep; const char* b3 = b2 + kstep;
            if (last && has_next) S.a_ready(nxt);
            if constexpr (SP2) {
            PG8_LDB(B0, 0, 0); PG8_LDB(B1, 0, 1); PG8_SCHED; PG8_LDA(At, 0, 0); PG8_STAGE(PG8_SA(1, 1), a1 + hstepA, voffA);
            PG8_WAIT_V(8); PG8_WAIT_L(0); PG8_BAR; PG8_MMA(0, 0, At, B0); PG8_MMA(0, 1, At, B1); PG8_BAR; PG8_SCHED;
            PG8_LDA(At, 0, 1); PG8_STAGE(PG8_SB(0, 0), b2, voffB); PG8_STAGE(PG8_SB(0, 1), b2 + hstepB, voffB); PG8_STAGE(PG8_SA(0, 0), a2, voffA);
            PG8_WAIT_V(8); PG8_WAIT_L(0); PG8_BAR; PG8_MMA(1, 0, At, B0); PG8_MMA(1, 1, At, B1); PG8_BAR; PG8_SCHED;
            PG8_LDB(B0, 1, 0); PG8_LDB(B1, 1, 1); PG8_SCHED; PG8_LDA(At, 1, 0); PG8_STAGE(PG8_SA(0, 1), a2 + hstepA, voffA);
            PG8_WAIT_V(8); PG8_WAIT_L(0); PG8_BAR; PG8_MMA(0, 0, At, B0); PG8_MMA(0, 1, At, B1); PG8_BAR; PG8_SCHED;
            PG8_LDA(At, 1, 1); PG8_STAGE(PG8_SB(1, 0), b3, voffB); PG8_STAGE(PG8_SB(1, 1), b3 + hstepB, voffB); PG8_STAGE(PG8_SA(1, 0), a3, voffA);
            PG8_WAIT_V(8); PG8_WAIT_L(0); PG8_BAR; PG8_MMA(1, 0, At, B0); PG8_MMA(1, 1, At, B1); PG8_BAR; PG8_SCHED;
            } else {
            PG8_LDB(B0, 0, 0); PG8_SCHED; PG8_LDA(At, 0, 0); PG8_STAGE(PG8_SA(1, 1), a1 + hstepA, voffA);
            PG8_WAIT_L(8); PG8_BAR; PG8_WAIT_L(0); PG8_MMA(0, 0, At, B0); PG8_BAR; PG8_SCHED;
            PG8_LDB(B1, 0, 1); PG8_STAGE(PG8_SB(0, 0), b2, voffB);
            PG8_BAR; PG8_WAIT_L(0); PG8_MMA(0, 1, At, B1); PG8_BAR;
            PG8_LDA(At, 0, 1); PG8_STAGE(PG8_SA(0, 0), a2, voffA);
            PG8_BAR; PG8_WAIT_L(0); PG8_MMA(1, 0, At, B0); PG8_BAR; PG8_SCHED;
            PG8_STAGE(PG8_SB(0, 1), b2 + hstepB, voffB);
            PG8_WAIT_V(6); PG8_BAR; PG8_MMA(1, 1, At, B1); PG8_BAR;
            PG8_LDB(B0, 1, 0); PG8_SCHED; PG8_LDA(At, 1, 0); PG8_STAGE(PG8_SA(0, 1), a2 + hstepA, voffA);
            PG8_WAIT_L(8); PG8_BAR; PG8_WAIT_L(0); PG8_MMA(0, 0, At, B0); PG8_BAR; PG8_SCHED;
            PG8_LDB(B1, 1, 1); PG8_STAGE(PG8_SB(1, 0), b3, voffB);
            PG8_BAR; PG8_WAIT_L(0); PG8_MMA(0, 1, At, B1); PG8_BAR;
            PG8_LDA(At, 1, 1); PG8_STAGE(PG8_SA(1, 0), a3, voffA);
            PG8_BAR; PG8_WAIT_L(0); PG8_MMA(1, 0, At, B0); PG8_BAR; PG8_SCHED;
            PG8_STAGE(PG8_SB(1, 1), b3 + hstepB, voffB);
            PG8_WAIT_V(6); PG8_BAR; PG8_MMA(1, 1, At, B1); PG8_BAR;
            }
        }
        if constexpr (ALIGN_EPI) { if (wr == 0) PG8_BAR; }
        if constexpr (!Epi::AFTER_DRAIN) { E(acc, cur, wr, wc, fr, fq); S.done(cur); }
        if (!has_next) break;
#pragma unroll
        for (int a = 0; a < 2; ++a)
#pragma unroll
            for (int b = 0; b < 2; ++b)
#pragma unroll
                for (int m = 0; m < 4; ++m)
#pragma unroll
                    for (int n = 0; n < 2; ++n) acc[a][b][m][n] = (f32x4){0.f, 0.f, 0.f, 0.f};
        cur = nxt; cA = nA; cB = nB; ++ui;
        if constexpr (ALIGN_EPI) { if (wr == 1) PG8_BAR; }
    }
    PG8_WAIT_V(0);
    if constexpr (!ALIGN_EPI) { if (wr == 0) PG8_BAR; }
    PG8_BAR;
    if constexpr (Epi::AFTER_DRAIN) { E.fused(acc, cur, wr, wc, fr, fq, lds, wid, lane); S.done(cur); }
#undef PG8_SA
#undef PG8_SB
#undef PG8_STAGE
#undef PG8_LDA
#undef PG8_LDB
#undef PG8_MMA
#undef PG8_WAIT_V
#undef PG8_WAIT_L
#undef PG8_BAR
#undef PG8_SCHED
}
}
namespace attn {
using bf16=unsigned short;
using bf16x8=__attribute__((ext_vector_type(8)))short;
using s16x4=__attribute__((ext_vector_type(4)))short;
using f32x16=__attribute__((ext_vector_type(16)))float;
using u32x4=__attribute__((ext_vector_type(4)))unsigned;
constexpr int D=64, PITCH=4392, SEQ=8192;
constexpr int NW=8,QBLK=32,QB=QBLK*NW,KVBLK=64;
__device__ __forceinline__ int crow(int r,int hi){return (r&3)+8*(r>>2)+4*hi;}
#define SBAR() __builtin_amdgcn_sched_barrier(0)
using f32x4_=__attribute__((ext_vector_type(4)))float;
__device__ __forceinline__ float bfs(short v){ return __uint_as_float(((unsigned)(unsigned short)v)<<16); }
__device__ __forceinline__ float lo16(unsigned w){ return __uint_as_float(w<<16); }
__device__ __forceinline__ float hi16(unsigned w){ return __uint_as_float(w&0xffff0000u); }
__device__ __forceinline__ bf16 f2b(float f){ unsigned u=__float_as_uint(f); return (bf16)((u+0x7fffu+((u>>16)&1u))>>16); }
__device__ __forceinline__ unsigned pk2b(float lo,float hi){ return (unsigned)f2b(lo)|((unsigned)f2b(hi)<<16); }
constexpr int NSLOT=3, SLOTB=8192;
constexpr int LDS_K=0, LDS_V=NSLOT*SLOTB, LDS_WS=2*NSLOT*SLOTB, LDS_OST=LDS_WS+NW*128*4, LDS_BIAS=LDS_OST+NW*4096, LDS_MSK=LDS_BIAS+512, LDS_KM=LDS_MSK+NW*512, LDS_BYTES=LDS_KM+8192;
constexpr float LOG2E_=1.4426950408889634f;
__device__ __forceinline__ void glds16(const void*gsrc,unsigned lds_dst){unsigned keep;
  asm volatile("s_mov_b32 %0, m0\n\ts_mov_b32 m0, %2\n\ts_nop 0\n\tglobal_load_lds_dwordx4 %1, off\n\ts_mov_b32 m0, %0":"=&s"(keep):"v"(gsrc),"s"(lds_dst):"memory");}
__device__ __forceinline__ float max3f(float a,float b,float c){float r;asm("v_max3_f32 %0, %1, %2, %3":"=v"(r):"v"(a),"v"(b),"v"(c));return r;}
__device__ __forceinline__ float max2f(float a,float b){float r;asm("v_max_f32_e32 %0, %1, %2":"=v"(r):"v"(a),"v"(b));return r;}
__device__ __forceinline__ float fadd_s(float a,float b){float r;asm("v_add_f32_e32 %0, %1, %2":"=v"(r):"v"(a),"v"(b));return r;}
__device__ __forceinline__ float fsub_s(float a,float b){float r;asm("v_sub_f32_e32 %0, %1, %2":"=v"(r):"v"(a),"v"(b));return r;}
typedef float f32x2_t __attribute__((ext_vector_type(2))); typedef __bf16 bf16x2_t __attribute__((ext_vector_type(2)));
__device__ __forceinline__ unsigned cvtpk_s(float lo,float hi){f32x2_t v={lo,hi};bf16x2_t b=__builtin_convertvector(v,bf16x2_t);return __builtin_bit_cast(unsigned,b);}
#define WAIT_BAR(N) asm volatile("s_waitcnt vmcnt(" #N ") lgkmcnt(0)\n\ts_barrier":::"memory")

__device__ __forceinline__ void qkt(f32x16&p0,f32x16&p1,const char*Kslot,const bf16x8*qr,const f32x16&negm,int r32,int hi){
  const char*kb=Kslot+hi*1024+r32*16;
  #pragma unroll
  for(int d0=0;d0<4;++d0){
    const bf16x8 b0=*reinterpret_cast<const bf16x8*>(kb+d0*2048);
    const bf16x8 b1=*reinterpret_cast<const bf16x8*>(kb+d0*2048+512);
    if(d0==0){p0=__builtin_amdgcn_mfma_f32_32x32x16_bf16(b0,qr[0],negm,0,0,0);p1=__builtin_amdgcn_mfma_f32_32x32x16_bf16(b1,qr[0],negm,0,0,0);}
    else{p0=__builtin_amdgcn_mfma_f32_32x32x16_bf16(b0,qr[d0],p0,0,0,0);p1=__builtin_amdgcn_mfma_f32_32x32x16_bf16(b1,qr[d0],p1,0,0,0);}}
}
typedef __attribute__((address_space(3))) const char* lds_cptr;
typedef short v4i16_t __attribute__((ext_vector_type(4)));
__device__ __forceinline__ void kload8(bf16x8*kf,lds_cptr kp){
  kf[0]=*(const __attribute__((address_space(3))) bf16x8*)(kp);      kf[1]=*(const __attribute__((address_space(3))) bf16x8*)(kp+512);
  kf[2]=*(const __attribute__((address_space(3))) bf16x8*)(kp+2048); kf[3]=*(const __attribute__((address_space(3))) bf16x8*)(kp+2560);
  kf[4]=*(const __attribute__((address_space(3))) bf16x8*)(kp+4096); kf[5]=*(const __attribute__((address_space(3))) bf16x8*)(kp+4608);
  kf[6]=*(const __attribute__((address_space(3))) bf16x8*)(kp+6144); kf[7]=*(const __attribute__((address_space(3))) bf16x8*)(kp+6656);
}
__device__ __forceinline__ void kload2(bf16x8*kf,lds_cptr kp,int j){ kf[2*j]=*(const __attribute__((address_space(3))) bf16x8*)(kp+j*2048); kf[2*j+1]=*(const __attribute__((address_space(3))) bf16x8*)(kp+j*2048+512); }
__device__ __forceinline__ s16x4 vtr(lds_cptr p){ return __builtin_bit_cast(s16x4,__builtin_amdgcn_ds_read_tr16_b64_v4i16((__attribute__((address_space(3))) v4i16_t*)p)); }
__device__ __forceinline__ float rowmax(const f32x16&p0,const f32x16&p1){
  float a=max3f(p0[0],p0[1],p1[0]),b=max3f(p0[2],p0[3],p1[1]);a=max3f(a,p1[2],p1[3]);
  #pragma unroll
  for(int r=4;r<16;r+=4){a=max3f(a,p0[r],p0[r+1]);b=max3f(b,p0[r+2],p0[r+3]);a=max3f(a,p1[r],p1[r+1]);b=max3f(b,p1[r+2],p1[r+3]);}
  const float m=max2f(a,b);
  auto rr=__builtin_amdgcn_permlane32_swap(__float_as_uint(m),__float_as_uint(m),false,false);
  return max2f(__uint_as_float(rr[0]),__uint_as_float(rr[1]));
}
__device__ __forceinline__ void pv(f32x16*o,int vb,bf16x8 pa0,bf16x8 pa1,bf16x8 pa2,bf16x8 pa3){
  #pragma unroll
  for(int d0=0;d0<2;++d0){s16x4 lo[4],hi[4];
    #pragma unroll
    for(int ks=0;ks<4;++ks){
      asm volatile("ds_read_b64_tr_b16 %0,%1 offset:%c2":"=&v"(lo[ks]):"v"(vb),"i"(d0*4096+ks*1024):"memory");
      asm volatile("ds_read_b64_tr_b16 %0,%1 offset:%c2":"=&v"(hi[ks]):"v"(vb),"i"(d0*4096+ks*1024+512):"memory");}
    asm volatile("s_waitcnt lgkmcnt(0)":::"memory");SBAR();
    #define PK(k) (bf16x8){lo[k][0],lo[k][1],lo[k][2],lo[k][3],hi[k][0],hi[k][1],hi[k][2],hi[k][3]}
    o[d0]=__builtin_amdgcn_mfma_f32_32x32x16_bf16(pa0,PK(0),o[d0],0,0,0);
    o[d0]=__builtin_amdgcn_mfma_f32_32x32x16_bf16(pa1,PK(1),o[d0],0,0,0);
    o[d0]=__builtin_amdgcn_mfma_f32_32x32x16_bf16(pa2,PK(2),o[d0],0,0,0);
    o[d0]=__builtin_amdgcn_mfma_f32_32x32x16_bf16(pa3,PK(3),o[d0],0,0,0);
    #undef PK
  }
}

#ifndef ATTN_STORE16
#define ATTN_STORE16(p,v) (*(u32x4*)(p)=(v))
#endif
struct UArgs {
  const bf16* Qb; const bf16* Kh; const bf16* Vh; bf16* Ob;
  int NT, q0, kt0, hc;
  const float* rel;
  const float* km; int qb;
  const unsigned* selg;
  const bf16* gate; int gcol;
  const bf16* tmp;
};
__device__ __forceinline__ int t5b(int d){ if(d<16)return d<0?0:d; int b=16; b+=(d>=19);b+=(d>=21);b+=(d>=24);b+=(d>=27);b+=(d>=31);b+=(d>=35);b+=(d>=40);b+=(d>=46);b+=(d>=52);b+=(d>=59);b+=(d>=67);b+=(d>=77);b+=(d>=87);b+=(d>=99);b+=(d>=113); return b; }
template<int MODE,int EPI,int THRL> __device__ __forceinline__ void attn_unit(const UArgs&U,char*shm){
  const int tid=threadIdx.x,lane=tid&63,r32=lane&31,hi=lane>>5; const int wid=__builtin_amdgcn_readfirstlane(tid>>6);
  const bf16*Qw=U.Qb+(long)(wid*QBLK)*PITCH;
  const bf16*Kh=U.Kh,*Vh=U.Vh;
  const unsigned lds0=(unsigned)(uintptr_t)shm;
  float*wsf=(float*)(shm+LDS_WS)+wid*128;
  const bf16*ksrc=Kh+(long)lane*PITCH+wid*8;
  const bf16*vsrc=Vh+(long)(16*(wid&3)+(lane>>2))*PITCH+(wid>>2)*32+(lane&3)*8;
  const unsigned kdst=lds0+LDS_K+wid*1024, vdst=lds0+LDS_V+wid*1024;
  #define DMA_K(t,slot) glds16(ksrc+(long)(t)*KVBLK*PITCH,(unsigned)__builtin_amdgcn_readfirstlane(kdst+(slot)))
  #define DMA_V(t,slot) glds16(vsrc+(long)(t)*KVBLK*PITCH,(unsigned)__builtin_amdgcn_readfirstlane(vdst+(slot)))
  const int vb0=(int)(lds0+LDS_V)+((lane>>4)&1)*32+(lane&3)*8+(4*hi+((lane&15)>>2))*64;
  const char*Kbase=shm+LDS_K; bf16x8 kf[8];
  const lds_cptr shm3=(lds_cptr)shm; const lds_cptr kp0=shm3+LDS_K+hi*1024+r32*16; const lds_cptr vp0=shm3+LDS_V+((lane>>4)&1)*32+(lane&3)*8+(4*hi+((lane&15)>>2))*64;
  const int NT=U.NT;
  const int qpos=U.q0+wid*QBLK+r32;
  float*biasT=(float*)(shm+LDS_BIAS);
  if(tid<128) biasT[tid]=(U.rel[t5b(tid)*16+U.hc]-U.rel[31*16+U.hc])*LOG2E_;
  unsigned selw=0u,cw=0u; const unsigned*mskp=(const unsigned*)(shm+LDS_MSK)+wid*128+r32*4;
  if(MODE==0){ ((u32x4*)(shm+LDS_KM))[tid]=((const u32x4*)U.km)[tid]; }
  if(MODE==1){ if(hi==0){ const u32x4 w=*(const u32x4*)(U.selg+(long)(wid*QBLK+r32)*4); *(u32x4*)((unsigned*)(shm+LDS_MSK)+wid*128+r32*4)=w; } }
  asm volatile("s_waitcnt vmcnt(0) lgkmcnt(0)\n\ts_barrier":::"memory");
  bf16x8 qr[4];
  #pragma unroll
  for(int d0=0;d0<4;++d0)qr[d0]=*reinterpret_cast<const bf16x8*>(&Qw[(long)r32*PITCH+d0*16+hi*8]);
  if(MODE==0){
    float v1=-INFINITY,v2=-INFINITY,v3=-INFINITY; int i1=-1,i2=-1,i3=-1;
    for(int n=0;n<U.qb;++n){ const float*km=(const float*)(shm+LDS_KM)+n*64+hi*8; float p=0.f;
      #pragma unroll
      for(int d0=0;d0<4;++d0){ const f32x4_ a=*(const f32x4_*)(km+d0*16), c=*(const f32x4_*)(km+d0*16+4);
        p+=bfs(qr[d0][0])*a[0]+bfs(qr[d0][1])*a[1]+bfs(qr[d0][2])*a[2]+bfs(qr[d0][3])*a[3]+bfs(qr[d0][4])*c[0]+bfs(qr[d0][5])*c[1]+bfs(qr[d0][6])*c[2]+bfs(qr[d0][7])*c[3]; }
      auto rr=__builtin_amdgcn_permlane32_swap(__float_as_uint(p),__float_as_uint(p),false,false); const float sc_=__uint_as_float(rr[0])+__uint_as_float(rr[1]);
      if(sc_>v1){v3=v2;i3=i2;v2=v1;i2=i1;v1=sc_;i1=n;} else if(sc_>v2){v3=v2;i3=i2;v2=sc_;i2=n;} else if(sc_>v3){v3=sc_;i3=n;} }
    if(i1>=0)selw|=1u<<i1; if(i2>=0)selw|=1u<<i2; if(i3>=0)selw|=1u<<i3; selw|=1u<<U.qb; }
  DMA_K(0,0);DMA_V(0,0);DMA_K(1,SLOTB);
  float mhat=0.f,l_reg=0.f;f32x16 o[2];o[0]=f32x16{};o[1]=f32x16{};f32x16 negm=f32x16{};asm volatile("":"+v"(negm));
  #define MASK_FAR(P0,P1,t) do{ bool on_=true; if(MODE==0)on_=((selw>>((t)>>2))&1u)!=0u; if(MODE==1){ if(((t)&31)==0)cw=mskp[(t)>>5]; on_=((cw>>((t)&31))&1u)!=0u; } \
      _Pragma("unroll") for(int r=0;r<16;++r){ P0[r]=on_?P0[r]:-INFINITY; P1[r]=on_?P1[r]:-INFINITY; } }while(0)
  #define MASK_BAND(P0,P1,t) do{ bool on_=true; if(MODE==0)on_=((selw>>((t)>>2))&1u)!=0u; if(MODE==1){ if(((t)&31)==0)cw=mskp[(t)>>5]; on_=((cw>>((t)&31))&1u)!=0u; } \
      const int d0_=qpos-(U.kt0+64*(t)+4*hi); \
      _Pragma("unroll") for(int r=0;r<16;++r){ const int da_=d0_-((r&3)+8*(r>>2)), db_=da_-32; \
        const bool oka_=on_&&da_>=0&&(MODE!=2||da_<512), okb_=on_&&db_>=0&&(MODE!=2||db_<512); \
        const float ba_=biasT[da_<0?0:(da_>127?127:da_)], bb_=biasT[db_<0?0:(db_>127?127:db_)]; \
        P0[r]=oka_?P0[r]+ba_:-INFINITY; P1[r]=okb_?P1[r]+bb_:-INFINITY; \
        if((r&1)==1){ asm volatile("s_waitcnt lgkmcnt(0)":"+v"(P0),"+v"(P1)::"memory"); } } }while(0)
  #define CMASK(P0,P1,t) MASK_BAND(P0,P1,t)
  bool resc=false;
  #define START(P0,P1) do{ const float rm=rowmax(P0,P1); resc=false; \
    { const float dl=rm>-1e30f?rm:0.f; mhat=fadd_s(mhat,dl); \
      _Pragma("unroll") for(int r=0;r<16;++r){P0[r]=fsub_s(P0[r],dl);P1[r]=fsub_s(P1[r],dl);} \
      _Pragma("unroll") for(int r=0;r<16;++r)negm[r]=-mhat; asm volatile("":"+v"(negm)); } \
    _Pragma("unroll") for(int r=0;r<16;++r)P0[r]=__builtin_amdgcn_exp2f(P0[r]); }while(0)
  #define RESC() do{ if(resc){ asm volatile("s_waitcnt lgkmcnt(0)":::"memory"); \
      _Pragma("unroll") for(int d_=0;d_<2;++d_) _Pragma("unroll") for(int r=0;r<16;++r)o[d_][r]*=wsf[crow(r,hi)]; } }while(0)
  f32x16 pA0,pA1,pB0,pB1;
  int sl_prev=0,sl_cur=0,sl_next=SLOTB;
  #define ROT() do{sl_prev=sl_cur;sl_cur=sl_next;sl_next=(sl_next==(NSLOT-1)*SLOTB)?0:sl_next+SLOTB;}while(0)
  DMA_K(2,2*SLOTB);
  WAIT_BAR(3);
  qkt(pA0,pA1,Kbase,qr,negm,r32,hi);asm volatile("s_nop 15\n\ts_nop 7":"+v"(pA0),"+v"(pA1));CMASK(pA0,pA1,0);
  START(pA0,pA1);
  _Pragma("unroll") for(int r=0;r<16;++r)pA1[r]=__builtin_amdgcn_exp2f(pA1[r]);
  WAIT_BAR(0);
  DMA_K(3,0);DMA_V(1,SLOTB);
  ROT();
  kload8(kf,kp0+sl_cur);
  WAIT_BAR(2);
  s16x4 vlo[8],vhi[8]; u32x4 pw0,pw1,pw2,pw3;
  #define PKW(P,B) cvtpk_s(P[B],P[B+1])
  #define PAF(k) __builtin_bit_cast(bf16x8,pw##k)
  #define VFR(i) (bf16x8){vlo[i][0],vlo[i][1],vlo[i][2],vlo[i][3],vhi[i][0],vhi[i][1],vhi[i][2],vhi[i][3]}
  #define PIN(x) asm volatile("":"+v"(x))
  #define MX3(a,b,c) __builtin_fmaxf(__builtin_fmaxf((a),(b)),(c))
  #define GAPA(MF,A0,A1,A2,A3,W0,W1,PW) do{ MF; sacc+=A0; sacc+=A1; sacc+=A2; sacc+=A3; PIN(sacc); W0; W1; PIN(PW); SBAR(); }while(0)
  #define EX(v) __builtin_amdgcn_exp2f(v)
  #define GAPB(MF,X,B) do{ MF; X[B]=EX(X[B]); X[B+1]=EX(X[B+1]); X[B+2]=EX(X[B+2]); X[B+3]=EX(X[B+3]); PIN(X); SBAR(); }while(0)
  #define VRD(i) do{ vlo[i]=vtr(vp_+(((i)>>2)*4096+((i)&3)*1024)); vhi[i]=vtr(vp_+(((i)>>2)*4096+((i)&3)*1024+512)); }while(0)
  #define KRD(G,j) do{ if(G){ kload2(kf,kp0+sl_next,j); SBAR(); } }while(0)
  #define STEP(C0,C1,P0,P1,t,GK,GV,GL) do{ SBAR(); \
    const lds_cptr vp_=vp0+sl_prev; \
    VRD(0); SBAR(); float sacc=(P0[0]+P0[1]); \
    GAPA(C0=__builtin_amdgcn_mfma_f32_32x32x16_bf16(kf[0],qr[0],negm,0,0,0), P0[2],P0[3],P0[4],P0[5],     pw0[0]=PKW(P0,0), pw0[1]=PKW(P0,2), pw0); \
    VRD(4); SBAR(); GAPA(C1=__builtin_amdgcn_mfma_f32_32x32x16_bf16(kf[1],qr[0],negm,0,0,0), P0[6],P0[7],P0[8],P0[9],     pw0[2]=PKW(P0,4), pw0[3]=PKW(P0,6), pw0); \
    VRD(1); SBAR(); GAPA(C0=__builtin_amdgcn_mfma_f32_32x32x16_bf16(kf[2],qr[1],C0,0,0,0),   P0[10],P0[11],P0[12],P0[13], pw1[0]=PKW(P0,8), pw1[1]=PKW(P0,10), pw1); \
    VRD(5); SBAR(); GAPA(C1=__builtin_amdgcn_mfma_f32_32x32x16_bf16(kf[3],qr[1],C1,0,0,0),   P0[14],P0[15],P1[0],P1[1],   pw1[2]=PKW(P0,12),pw1[3]=PKW(P0,14), pw1); \
    VRD(2); SBAR(); GAPA(C0=__builtin_amdgcn_mfma_f32_32x32x16_bf16(kf[4],qr[2],C0,0,0,0),   P1[2],P1[3],P1[4],P1[5],     pw2[0]=PKW(P1,0), pw2[1]=PKW(P1,2), pw2); \
    VRD(6); SBAR(); GAPA(C1=__builtin_amdgcn_mfma_f32_32x32x16_bf16(kf[5],qr[2],C1,0,0,0),   P1[6],P1[7],P1[8],P1[9],     pw2[2]=PKW(P1,4), pw2[3]=PKW(P1,6), pw2); \
    VRD(3); SBAR(); GAPA(C0=__builtin_amdgcn_mfma_f32_32x32x16_bf16(kf[6],qr[3],C0,0,0,0),   P1[10],P1[11],P1[12],P1[13], pw3[0]=PKW(P1,8), pw3[1]=PKW(P1,10), pw3); \
    VRD(7); SBAR(); GAPA(C1=__builtin_amdgcn_mfma_f32_32x32x16_bf16(kf[7],qr[3],C1,0,0,0),   P1[14],P1[15],0.f,0.f,       pw3[2]=PKW(P1,12),pw3[3]=PKW(P1,14), pw3); \
    l_reg+=sacc; \
    if(GK){DMA_K((t)+3,sl_cur);} if(GV){DMA_V((t)+1,sl_next);} \
    CMASK(C0,C1,t); \
    { float a=MX3(C0[0],C0[1],C1[0]),b=MX3(C0[2],C0[3],C1[1]); a=MX3(a,C1[2],C1[3]); \
      _Pragma("unroll") for(int r=4;r<16;r+=4){a=MX3(a,C0[r],C0[r+1]);b=MX3(b,C0[r+2],C0[r+3]);a=MX3(a,C1[r],C1[r+1]);b=MX3(b,C1[r+2],C1[r+3]);} \
      float rm=__builtin_fmaxf(a,b); { auto rr=__builtin_amdgcn_permlane32_swap(__float_as_uint(rm),__float_as_uint(rm),false,false); rm=__builtin_fmaxf(__uint_as_float(rr[0]),__uint_as_float(rr[1])); } \
      resc=false; \
      if(__builtin_expect(__any(rm>(float)THRL),0)){ const float dl=__builtin_fmaxf(rm,0.f); mhat+=dl; \
        _Pragma("unroll") for(int r=0;r<16;++r){C0[r]-=dl;C1[r]-=dl;} \
        _Pragma("unroll") for(int r=0;r<16;++r)negm[r]=-mhat; asm volatile("":"+v"(negm)); \
        const float f=__builtin_amdgcn_exp2f(-dl); l_reg*=f; if(hi==0)wsf[r32]=f; resc=true; } } \
    SBAR(); \
    GAPB(o[0]=__builtin_amdgcn_mfma_f32_32x32x16_bf16(PAF(0),VFR(0),o[0],0,0,0), C0,0); \
    GAPB(o[1]=__builtin_amdgcn_mfma_f32_32x32x16_bf16(PAF(0),VFR(4),o[1],0,0,0), C0,4); \
    KRD(GL,0); GAPB(o[0]=__builtin_amdgcn_mfma_f32_32x32x16_bf16(PAF(1),VFR(1),o[0],0,0,0), C0,8); \
    KRD(GL,1); GAPB(o[1]=__builtin_amdgcn_mfma_f32_32x32x16_bf16(PAF(1),VFR(5),o[1],0,0,0), C0,12); \
    KRD(GL,2); GAPB(o[0]=__builtin_amdgcn_mfma_f32_32x32x16_bf16(PAF(2),VFR(2),o[0],0,0,0), C1,0); \
    KRD(GL,3); GAPB(o[1]=__builtin_amdgcn_mfma_f32_32x32x16_bf16(PAF(2),VFR(6),o[1],0,0,0), C1,4); \
    GAPB(o[0]=__builtin_amdgcn_mfma_f32_32x32x16_bf16(PAF(3),VFR(3),o[0],0,0,0), C1,8); \
    GAPB(o[1]=__builtin_amdgcn_mfma_f32_32x32x16_bf16(PAF(3),VFR(7),o[1],0,0,0), C1,12); \
    }while(0)
  int t=1;
  #undef CMASK
  #define CMASK(P0,P1,t) MASK_FAR(P0,P1,t)
  for(;MODE!=2&&t+7<NT;t+=2){
    STEP(pB0,pB1,pA0,pA1,t,true,true,true);     WAIT_BAR(2); RESC(); ROT();
    STEP(pA0,pA1,pB0,pB1,t+1,true,true,true);   WAIT_BAR(2); RESC(); ROT();
  }
  #undef CMASK
  #define CMASK(P0,P1,t) MASK_BAND(P0,P1,t)
  #define ENDW(tt) do{ if((tt)+3<NT){WAIT_BAR(2);} else if((tt)+2<NT){WAIT_BAR(1);} else {WAIT_BAR(0);} }while(0)
  for(;t+1<NT;t+=2){
    STEP(pB0,pB1,pA0,pA1,t,(t+3<NT),(t+1<NT),(t+1<NT));       ENDW(t);   RESC(); ROT();
    STEP(pA0,pA1,pB0,pB1,t+1,(t+4<NT),(t+2<NT),(t+2<NT));     ENDW(t+1); RESC(); ROT();
  }
  STEP(pB0,pB1,pA0,pA1,NT-1,false,false,false); RESC();
  { float sacc=pB0[0]+pB0[1]; _Pragma("unroll") for(int r=2;r<16;++r)sacc+=pB0[r]; _Pragma("unroll") for(int r=0;r<16;++r)sacc+=pB1[r]; l_reg+=sacc;
    pw0=(u32x4){PKW(pB0,0),PKW(pB0,2),PKW(pB0,4),PKW(pB0,6)};pw1=(u32x4){PKW(pB0,8),PKW(pB0,10),PKW(pB0,12),PKW(pB0,14)};pw2=(u32x4){PKW(pB1,0),PKW(pB1,2),PKW(pB1,4),PKW(pB1,6)};pw3=(u32x4){PKW(pB1,8),PKW(pB1,10),PKW(pB1,12),PKW(pB1,14)};
    SBAR(); pv(o,vb0+sl_cur,PAF(0),PAF(1),PAF(2),PAF(3)); }
  #undef PKW
  #undef PAF
  #undef VFR
  #undef PIN
  #undef MX3
  #undef GAPA
  #undef GAPB
  #undef EX
  #undef VRD
  #undef KRD
  #undef STEP
  #undef ENDW
  {auto rr=__builtin_amdgcn_permlane32_swap(__float_as_uint(l_reg),__float_as_uint(l_reg),false,false);l_reg=__uint_as_float(rr[0])+__uint_as_float(rr[1]);}
  int lane_e=lane; asm volatile("":"+v"(lane_e)); const int r32e=lane_e&31, hie=lane_e>>5;
  float*wsfe=(float*)(shm+LDS_WS)+wid*128;
  if(hie==0){ wsfe[32+r32e]=l_reg; if(EPI!=0){ const float gl=bfs((short)U.gate[(long)(wid*QBLK+r32e)*PITCH+U.gcol]); wsfe[64+r32e]=1.f/(1.f+__expf(-gl)); } }
  asm volatile("s_waitcnt lgkmcnt(0)":::"memory");
  float rli[16];
  #pragma unroll
  for(int r=0;r<16;++r){ rli[r]=__builtin_amdgcn_rcpf(fmaxf(wsfe[32+crow(r,hie)],1e-30f)); if(EPI!=0)rli[r]*=wsfe[64+crow(r,hie)]; }
  bf16*Ow=U.Ob+(long)(wid*QBLK)*PITCH;
  { bf16*stg=(bf16*)(shm+LDS_OST)+wid*2048;
    #pragma unroll
    for(int r=0;r<16;++r){const int orow=crow(r,hie);
      #pragma unroll
      for(int d0=0;d0<2;++d0){ float v=o[d0][r]*rli[r]; if(EPI==2)v+=bfs((short)stg[orow*64+d0*32+r32e]); stg[orow*64+d0*32+r32e]=f2b(v);} }
    asm volatile("s_waitcnt lgkmcnt(0)":::"memory");
    if(EPI!=1){
    #pragma unroll
    for(int i=0;i<4;++i){const int row=i*8+(lane_e>>3),ch=lane_e&7; u32x4 v=*(const u32x4*)(stg+row*64+ch*8);
      if(EPI==2){ const u32x4 t=*(const u32x4*)(U.tmp+(long)(wid*QBLK+row)*512+ch*8);
        v.x=pk2b(lo16(v.x)+lo16(t.x),hi16(v.x)+hi16(t.x)); v.y=pk2b(lo16(v.y)+lo16(t.y),hi16(v.y)+hi16(t.y)); v.z=pk2b(lo16(v.z)+lo16(t.z),hi16(v.z)+hi16(t.z)); v.w=pk2b(lo16(v.w)+lo16(t.w),hi16(v.w)+hi16(t.w)); }
      ATTN_STORE16(Ow+(long)row*PITCH+ch*8,v);} } }
  asm volatile("s_waitcnt lgkmcnt(0)\n\ts_barrier":::"memory");
  #undef DMA_K
  #undef DMA_V
  #undef CMASK
  #undef START
  #undef RESC
  #undef ROT
}
constexpr int ATTN_LDS_BYTES=LDS_BYTES;
#undef SBAR
#undef WAIT_BAR
}

constexpr int NWAVES = 8;
constexpr int B_ = 4, S_ = 8192, DM = 1024, M_ = B_ * S_, DIN = 7464, FF = 2816, NL = 2;
constexpr int YP = pg8::YP_;
constexpr float C2 = pg8::C2_, LOG2E = 1.4426950408889634f;
constexpr float NORM_EPS = 1e-6f;
constexpr int Y_AQ = 0, Y_AKC = 512, Y_AVC = 640, Y_AKS = 768, Y_AVS = 896, Y_AKW = 1024, Y_AVW = 1152, Y_CQ = 1280, Y_CK = 1792, Y_CV = 2304,
              Y_BQ = 2816, Y_BK = 3072, Y_BV = 3328, Y_BR = 3840, Y_AG = 4352, Y_BLR = 4376;
constexpr int NIN = 7680;
constexpr size_t MiB = 1u << 20;
constexpr size_t WS_CTL = 0, CTL_ZERO_BYTES = 1 * MiB;
constexpr size_t WS_WIN = 1 * MiB, WS_WA = 16 * MiB, WS_WB = 17 * MiB, WS_WC = 18 * MiB, WS_WO = 19 * MiB, WS_WF1 = 21 * MiB, WS_WF2 = 32 * MiB;
constexpr size_t WS_H = 40 * MiB;
constexpr size_t WS_Y = 104 * MiB;
constexpr size_t WS_G8 = 379 * MiB;
constexpr size_t WS_ACT = WS_Y + 128 * MiB;
constexpr size_t WS_SM = 475 * MiB;
constexpr size_t WS_KCMP = WS_SM, WS_VCMP = WS_SM + 1 * MiB, WS_KMEAN = WS_SM + 2 * MiB;
constexpr size_t WS_GA = WS_SM + 3 * MiB;
constexpr size_t WS_END = 512 * MiB;
static_assert(WS_GA + (size_t)M_ * 256 * 4 <= WS_END && WS_Y + (size_t)M_ * YP * 2 <= WS_G8 && WS_G8 + (size_t)M_ * 3072 <= WS_SM, "ws map");
static_assert(WS_ACT + (size_t)M_ * FF * 2 <= WS_SM && WS_WF2 + (size_t)DM * FF * 2 <= WS_H, "ws map 2");
constexpr int CW_BAR = 4096;
constexpr int RING_OFF = 0, RING_BYTES = 131072;
constexpr int LDSCTL_OFF = RING_BYTES, MISC_OFF = LDSCTL_OFF + 320;
constexpr int LDS_BYTES = 147456;

#define GAS __attribute__((address_space(1)))
#define LAS __attribute__((address_space(3)))
typedef unsigned short bf16;
typedef unsigned v4u __attribute__((ext_vector_type(4)));
typedef float f32x4 __attribute__((ext_vector_type(4)));
typedef short bf16x8 __attribute__((ext_vector_type(8)));
typedef GAS unsigned gu32;
typedef GAS unsigned long long gu64;
#define RLX_AGENT __ATOMIC_RELAXED, __HIP_MEMORY_SCOPE_AGENT
#define LDS_WAIT() asm volatile("s_waitcnt lgkmcnt(0)" ::: "memory")
#define VM_WAIT() asm volatile("s_waitcnt vmcnt(0)" ::: "memory")
__device__ __forceinline__ unsigned long long rt() { return __builtin_amdgcn_s_memrealtime(); }
__device__ __forceinline__ unsigned f2bf(float f) { unsigned u = __builtin_bit_cast(unsigned, f); return (u + 0x7fffu + ((u >> 16) & 1u)) >> 16; }
__device__ __forceinline__ unsigned pk2(float lo, float hi) { return f2bf(lo) | (f2bf(hi) << 16); }

__device__ __forceinline__ float bf2f(bf16 h) { return __uint_as_float((unsigned)h << 16); }
__device__ __forceinline__ float sigm(float v) { return 1.f / (1.f + __expf(-v)); }
#define WFENCE() asm volatile("s_waitcnt lgkmcnt(0)" ::: "memory")

#define XB_TMO      128
#define XB_XCNT(j)  (256  + 64 * (j))
#define XB_XSUB(j)  (1280 + 64 * (j))
#define XB_XGEN(j)  (2304 + 64 * (j))
#define XB_TOP      3328
#define XB_TOPGEN   3392
#define XCD_BAR_WORDS 3456
#define XB_SPIN_CAP (1u << 18)

__device__ __forceinline__ unsigned xb_ld(unsigned* p)              { return __hip_atomic_load(p, __ATOMIC_RELAXED, __HIP_MEMORY_SCOPE_AGENT); }
__device__ __forceinline__ unsigned xb_add(unsigned* p, unsigned v) { return __hip_atomic_fetch_add(p, v, __ATOMIC_RELAXED, __HIP_MEMORY_SCOPE_AGENT); }
__device__ __forceinline__ unsigned xb_xcc_id() { return (unsigned)__builtin_amdgcn_s_getreg((3 << 11) | 20) & 0xFu; }
#define XB_SPIN(cond, bar) do { unsigned _sp = 0; while (cond) { __builtin_amdgcn_s_sleep(1); \
    if ((++_sp & 255u) == 0u) { if (xb_ld(&(bar)[XB_TMO])) break; if (_sp > XB_SPIN_CAP) { atomicAdd(&(bar)[XB_TMO], 1u); break; } } } } while (0)

struct XcdBarrier {
    unsigned* bar; unsigned x;
    volatile LAS unsigned* st;
};

__device__ __forceinline__ XcdBarrier xcd_barrier_post(unsigned* bar, volatile LAS unsigned* st) {
    XcdBarrier b; b.bar = bar; b.x = xb_xcc_id(); b.st = st;
    if (threadIdx.x == 0) (void)xb_add(&bar[XB_XCNT(b.x)], 1u);
    return b;
}
__device__ __forceinline__ void xcd_barrier_complete(unsigned* bar, unsigned x, unsigned& nloc, unsigned& nx) {
    const unsigned G = gridDim.x * gridDim.y * gridDim.z;
    unsigned sum, cnt, mine, sp = 0u;
    for (;;) {
        sum = 0u; cnt = 0u; mine = 0u;
#pragma unroll
        for (unsigned j = 0; j < 16; ++j) { const unsigned c = xb_ld(&bar[XB_XCNT(j)]); sum += c; cnt += (c > 0u) ? 1u : 0u; mine = (j == x) ? c : mine; }
        if (sum == G) break;
        __builtin_amdgcn_s_sleep(1);
        if ((++sp & 255u) == 0u) { if (xb_ld(&bar[XB_TMO])) break; if (sp > XB_SPIN_CAP) { atomicAdd(&bar[XB_TMO], 1u); break; } }
    }
    nloc = mine > 0u ? mine : 1u; nx = cnt > 0u ? cnt : 1u;
}

__device__ __forceinline__ void xcd_barrier(const XcdBarrier& b) {
    asm volatile("s_waitcnt vmcnt(0)" ::: "memory");
    __syncthreads();
    if (threadIdx.x == 0) {
        unsigned* bar = b.bar;
        __builtin_amdgcn_s_waitcnt(0);
        unsigned nloc = b.st[0], nx = b.st[1];
        if (nloc == 0u) { xcd_barrier_complete(bar, b.x, nloc, nx); b.st[0] = nloc; b.st[1] = nx; }
        const unsigned old = xb_add(&bar[XB_XSUB(b.x)], 1u);
        const unsigned gen = old / nloc;
        if (old + 1u == (gen + 1u) * nloc) {
            __builtin_amdgcn_fence(__ATOMIC_RELEASE, "agent");
            asm volatile("s_waitcnt vmcnt(0)" ::: "memory");
            const unsigned og = xb_add(&bar[XB_TOP], 1u);
            const unsigned tg = og / nx;
            if (og + 1u == (tg + 1u) * nx) xb_add(&bar[XB_TOPGEN], 1u);
            else XB_SPIN(xb_ld(&bar[XB_TOPGEN]) == tg, bar);
            __builtin_amdgcn_fence(__ATOMIC_ACQUIRE, "agent");
            xb_add(&bar[XB_XGEN(b.x)], 1u);
            asm volatile("s_waitcnt vmcnt(0)" ::: "memory");
        } else {
            XB_SPIN(xb_ld(&bar[XB_XGEN(b.x)]) == gen, bar);
            __builtin_amdgcn_fence(__ATOMIC_ACQUIRE, "agent");
            asm volatile("s_waitcnt vmcnt(0)" ::: "memory");
        }
    }
    __syncthreads();
}


struct Frame {
    LAS unsigned char* lds;
    volatile LAS unsigned* MISC;
    gu32* ctl;
    int tid, lane, wave, G;
};
__device__ __forceinline__ float wave_sum(float v) {
#pragma unroll
    for (int o = 1; o < 64; o <<= 1) v += __shfl_xor(v, o);
    return v;
}
__device__ __forceinline__ float wave_max(float v) {
#pragma unroll
    for (int o = 1; o < 64; o <<= 1) v = fmaxf(v, __shfl_xor(v, o));
    return v;
}
__device__ __forceinline__ int t5_bucket(int d) {
    if (d < 16) return d < 0 ? 0 : d;
    int b = 16;
    b += (d >= 19); b += (d >= 21); b += (d >= 24); b += (d >= 27); b += (d >= 31); b += (d >= 35); b += (d >= 40); b += (d >= 46);
    b += (d >= 52); b += (d >= 59); b += (d >= 67); b += (d >= 77); b += (d >= 87); b += (d >= 99); b += (d >= 113);
    return b;
}
template <class CM> __device__ __forceinline__ void tr_item(const float* W, int Nsrc, int K, bf16* WT, int item, int nblk, CM cm, LAS float* scr, int lane) {
    const int kb = item / nblk, nb = item % nblk, k0 = 64 * kb, n0 = 32 * nb;
    const int sc = cm(n0 + (lane & 31));
#pragma unroll 8
    for (int i = 0; i < 32; ++i) { const int kk = 2 * i + (lane >> 5); scr[kk * 33 + (lane & 31)] = sc >= 0 ? W[(size_t)(k0 + kk) * Nsrc + sc] : 0.f; }
    LDS_WAIT(); asm volatile("" ::: "memory");
    const int c = lane & 7;
#pragma unroll
    for (int j = 0; j < 4; ++j) { const int n = (lane >> 3) + 8 * j; const LAS float* s = scr + (8 * c) * 33 + n;
        v4u o; o.x = pk2(s[0 * 33], s[1 * 33]); o.y = pk2(s[2 * 33], s[3 * 33]); o.z = pk2(s[4 * 33], s[5 * 33]); o.w = pk2(s[6 * 33], s[7 * 33]);
        *(GAS v4u*)(WT + (size_t)(n0 + n) * K + k0 + 8 * c) = o; }
    LDS_WAIT(); asm volatile("" ::: "memory");
}
struct CmId { __device__ __forceinline__ int operator()(int n) const { return n; } };
struct CmWin { __device__ __forceinline__ int operator()(int n) const {
    if (n < 1280) return n;
    if (n < 2816) return n - 1280 + 2856;
    if (n < 4352) return n - 2816 + 1304;
    if (n < 4376) return n - 4352 + 1280;
    if (n < 4392) return n - 4376 + 2840;
    if (n < 4608) return -1;
    return n - 4608 + 4392; } };
struct CmFfn { __device__ __forceinline__ int operator()(int c) const { const int p = c >> 8, r = c & 255; return r < 128 ? 128 * p + r : FF + 128 * p + (r - 128); } };

struct Args { const float* in[22]; float* out; unsigned char* ws; int ph_lo, ph_hi; };

__device__ __forceinline__ void phase_weights(Frame& F, const Args& a, int l) {
    LAS float* scr = (LAS float*)(F.lds + RING_OFF + F.wave * 16384);
    const int gw = blockIdx.x * NWAVES + F.wave, NGW = F.G * NWAVES;
    unsigned char* ws = a.ws;
    constexpr int I_IN = 16 * (NIN / 32), I_BR = 8 * 32, I_O = 16 * 32, I_F1 = 16 * (2 * FF / 32), I_F2 = (FF / 64) * 32;
    constexpr int NIT = I_IN + 3 * I_BR + I_O + I_F1 + I_F2;
    for (int it = gw; it < NIT; it += NGW) {
        int r = it;
        if (r < I_IN) { tr_item(a.in[6] + (size_t)l * DM * DIN, DIN, DM, (bf16*)(ws + WS_WIN), r, NIN / 32, CmWin(), scr, F.lane); continue; } r -= I_IN;
        if (r < I_BR) { tr_item(a.in[16] + (size_t)l * 512 * DM, DM, 512, (bf16*)(ws + WS_WA), r, 32, CmId(), scr, F.lane); continue; } r -= I_BR;
        if (r < I_BR) { tr_item(a.in[17] + (size_t)l * 512 * DM, DM, 512, (bf16*)(ws + WS_WB), r, 32, CmId(), scr, F.lane); continue; } r -= I_BR;
        if (r < I_BR) { tr_item(a.in[18] + (size_t)l * 512 * DM, DM, 512, (bf16*)(ws + WS_WC), r, 32, CmId(), scr, F.lane); continue; } r -= I_BR;
        if (r < I_O) { tr_item(a.in[19] + (size_t)l * DM * DM, DM, DM, (bf16*)(ws + WS_WO), r, 32, CmId(), scr, F.lane); continue; } r -= I_O;
        if (r < I_F1) { tr_item(a.in[20] + (size_t)l * DM * 2 * FF, 2 * FF, DM, (bf16*)(ws + WS_WF1), r, 2 * FF / 32, CmFfn(), scr, F.lane); continue; } r -= I_F1;
        tr_item(a.in[21] + (size_t)l * FF * DM, DM, FF, (bf16*)(ws + WS_WF2), r, 32, CmId(), scr, F.lane);
    }
}
__device__ __forceinline__ void phase_norm0(Frame& F, const float* x, const float* w, bf16* H) {
    const int gw = blockIdx.x * NWAVES + F.wave, NGW = F.G * NWAVES;
    for (int m = gw; m < M_; m += NGW) {
        const f32x4* xr = (const f32x4*)(x + (size_t)m * DM) + F.lane; f32x4 v[4]; float s = 0.f;
#pragma unroll
        for (int j = 0; j < 4; ++j) { v[j] = xr[64 * j]; s += v[j].x * v[j].x + v[j].y * v[j].y + v[j].z * v[j].z + v[j].w * v[j].w; }
        const float r = rsqrtf(wave_sum(s) * (1.f / DM) + NORM_EPS);
        unsigned long long* o8 = (unsigned long long*)(H + (size_t)m * DM) + F.lane;
#pragma unroll
        for (int j = 0; j < 4; ++j) { const f32x4 wv = ((const f32x4*)w)[F.lane + 64 * j];
            o8[64 * j] = (unsigned long long)pk2(v[j].x * r * wv.x, v[j].y * r * wv.y) | ((unsigned long long)pk2(v[j].z * r * wv.z, v[j].w * r * wv.w) << 32); }
    }
}
__device__ __forceinline__ void phase_resid(Frame& F, const float* y, const float* xin, float* xout, const float* wpost, const float* wpre, bf16* hout) {
    const int gw = blockIdx.x * NWAVES + F.wave, NGW = F.G * NWAVES;
    for (int m = gw; m < M_; m += NGW) {
        const f32x4* yr = (const f32x4*)(y + (size_t)m * DM) + F.lane; const f32x4* xr = (const f32x4*)(xin + (size_t)m * DM) + F.lane;
        f32x4 v[4], xv[4]; float s = 0.f;
#pragma unroll
        for (int j = 0; j < 4; ++j) { v[j] = yr[64 * j]; xv[j] = xr[64 * j]; s += v[j].x * v[j].x + v[j].y * v[j].y + v[j].z * v[j].z + v[j].w * v[j].w; }
        const float r = rsqrtf(wave_sum(s) * (1.f / DM) + NORM_EPS); float s2 = 0.f;
        f32x4* xo = (f32x4*)(xout + (size_t)m * DM) + F.lane;
#pragma unroll
        for (int j = 0; j < 4; ++j) { const f32x4 wv = ((const f32x4*)wpost)[F.lane + 64 * j]; f32x4 n;
            n.x = xv[j].x + v[j].x * r * wv.x; n.y = xv[j].y + v[j].y * r * wv.y; n.z = xv[j].z + v[j].z * r * wv.z; n.w = xv[j].w + v[j].w * r * wv.w;
            xo[64 * j] = n; v[j] = n; s2 += n.x * n.x + n.y * n.y + n.z * n.z + n.w * n.w; }
        if (hout) { const float r2 = rsqrtf(wave_sum(s2) * (1.f / DM) + NORM_EPS);
            unsigned long long* o8 = (unsigned long long*)(hout + (size_t)m * DM) + F.lane;
#pragma unroll
            for (int j = 0; j < 4; ++j) { const f32x4 wv = ((const f32x4*)wpre)[F.lane + 64 * j];
                o8[64 * j] = (unsigned long long)pk2(v[j].x * r2 * wv.x, v[j].y * r2 * wv.y) | ((unsigned long long)pk2(v[j].z * r2 * wv.z, v[j].w * r2 * wv.w) << 32); } }
    }
}
__device__ __forceinline__ void unpack8(const v4u w, float (&k)[8]) {
    k[0] = __uint_as_float(w.x << 16); k[1] = __uint_as_float(w.x & 0xffff0000u); k[2] = __uint_as_float(w.y << 16); k[3] = __uint_as_float(w.y & 0xffff0000u);
    k[4] = __uint_as_float(w.z << 16); k[5] = __uint_as_float(w.z & 0xffff0000u); k[6] = __uint_as_float(w.w << 16); k[7] = __uint_as_float(w.w & 0xffff0000u);
}
__device__ __forceinline__ void dot4(const LAS float* qs, const bf16* kr, float (&d)[4]) {
    d[0] = d[1] = d[2] = d[3] = 0.f;
#pragma unroll 1
    for (int c = 0; c < 8; ++c) { asm volatile("" ::: "memory"); const v4u w = ((const v4u*)kr)[c]; float k[8]; unpack8(w, k);
#pragma unroll
        for (int e = 0; e < 8; ++e) { const int dd = c * 8 + e;
#pragma unroll
            for (int h = 0; h < 4; ++h) d[h] += qs[h * 64 + dd] * k[e]; } }
}
__device__ __forceinline__ float dot1(const LAS float* qs, const bf16* kr) {
    float d = 0.f;
#pragma unroll
    for (int c = 0; c < 8; ++c) { const v4u w = ((const v4u*)kr)[c]; float k[8]; unpack8(w, k);
#pragma unroll
        for (int e = 0; e < 8; ++e) d += qs[c * 8 + e] * k[e]; }
    return d;
}
__device__ __forceinline__ float gelu_tanh(float x) { const float u = 0.7978845608028654f * (x + 0.044715f * x * x * x); return 0.5f * x * (1.f + tanhf(u)); }

__device__ __forceinline__ void phase2_naive(Frame& F, const Args& a, int l) {
    const int gw = blockIdx.x * NWAVES + F.wave, NGW = F.G * NWAVES, lane = F.lane;
    const bf16* Y = (const bf16*)(a.ws + WS_Y);
    LAS float* scr = (LAS float*)(F.lds + RING_OFF + F.wave * 16384);
    for (int t = gw; t < 2 * 8 * 511; t += NGW) {
        const int kv = t / (8 * 511), r = t % (8 * 511), bg = r / 511, n = r % 511, b = bg >> 1, g = bg & 1;
        const float* pe = a.in[kv ? 8 : 7] + (size_t)l * 32 * 64; const float* w1 = a.in[kv ? 11 : 9] + (size_t)l * 2048 * 64; const float* w2 = a.in[kv ? 12 : 10] + (size_t)l * 64 * 64;
        const bf16* src = Y + ((size_t)b * S_ + 16 * n) * YP + (kv ? Y_AVC : Y_AKC) + g * 64;
        float acc = 0.f;
        for (int pos = 0; pos < 32; ++pos) {
            const float xin = bf2f(src[(size_t)pos * YP + lane]) + pe[pos * 64 + lane];
            scr[lane] = xin; WFENCE();
#pragma unroll 8
            for (int d = 0; d < 64; ++d) acc += scr[d] * w1[(size_t)(pos * 64 + d) * 64 + lane];
            WFENCE();
        }
        const float hdn = gelu_tanh(acc);
        scr[lane] = hdn; WFENCE();
        float o = 0.f;
#pragma unroll 8
        for (int j = 0; j < 64; ++j) o += scr[j] * w2[j * 64 + lane];
        WFENCE();
        bf16* dst = (bf16*)(a.ws + (kv ? WS_VCMP : WS_KCMP)) + ((size_t)bg * 512 + n) * 64;
        dst[lane] = (bf16)f2bf(o);
    }
    for (int t = gw; t < 4 * 8 * 32; t += NGW) {
        const int blk = t & 31, h = (t >> 5) & 7, b = t >> 8;
        const bf16* src = Y + ((size_t)b * S_ + blk * 256) * YP + Y_CK + h * 64 + lane; float s = 0.f;
        for (int i = 0; i < 256; ++i) s += bf2f(src[(size_t)i * YP]);
        ((float*)(a.ws + WS_KMEAN))[(size_t)t * 64 + lane] = s * (1.f / 256.f);
    }
    {
        const float* w2 = a.in[13] + (size_t)l * 16 * 256; const float* bias = a.in[14] + (size_t)l * 256; float* GA = (float*)(a.ws + WS_GA);
        const long NT = (long)M_ * 256, stride = (long)F.G * 512;
        for (long i = (long)blockIdx.x * 512 + F.tid; i < NT; i += stride) {
            const int c = (int)(i & 255); const size_t row = (size_t)(i >> 8);
            float z = bias[c];
#pragma unroll
            for (int r = 0; r < 16; ++r) z += bf2f(Y[row * YP + Y_BLR + r]) * w2[r * 256 + c];
            const float ls = -(fmaxf(-z, 0.f) + log1pf(__expf(-fabsf(z))));
            GA[i] = __expf(ls * (1.f / 16.f));
        }
    }
}
__device__ __forceinline__ void gla_scan_naive(Frame& F, const Args& a) {
    const bf16* Y = (const bf16*)(a.ws + WS_Y); const float* GA = (const float*)(a.ws + WS_GA); float* O32 = (float*)(a.ws + WS_H);
    const int lane = F.lane;
    for (int task = blockIdx.x; task < 256; task += F.G) {
        const int eg = task & 15, h = (task >> 4) & 3, b = task >> 6, e = eg * 8 + F.wave;
        float Sst = 0.f;
        for (int t0 = 0; t0 < S_; t0 += 8) {
            float av[8], kv[8], qv[8], vv[8];
#pragma unroll
            for (int j = 0; j < 8; ++j) { const size_t row = (size_t)b * S_ + t0 + j;
                av[j] = GA[row * 256 + h * 64 + lane]; kv[j] = bf2f(Y[row * YP + Y_BK + h * 64 + lane]); qv[j] = bf2f(Y[row * YP + Y_BQ + h * 64 + lane]); vv[j] = bf2f(Y[row * YP + Y_BV + h * 128 + e]); }
#pragma unroll
            for (int j = 0; j < 8; ++j) { Sst = av[j] * Sst + kv[j] * vv[j]; const float o = wave_sum(qv[j] * Sst);
                if (lane == 0) O32[((size_t)b * S_ + t0 + j) * 512 + h * 128 + e] = o; }
        }
    }
}
__device__ __forceinline__ void nsa_naive(Frame& F, const Args& a) {
    const int gw = blockIdx.x * NWAVES + F.wave, NGW = F.G * NWAVES, lane = F.lane;
    bf16* Y = (bf16*)(a.ws + WS_Y); const float* rel = a.in[1];
    LAS float* scr = (LAS float*)(F.lds + RING_OFF + F.wave * 16384);
    LAS float* qs = scr; LAS float* sc = scr + 256; LAS float* s2 = scr + 256 + 2048;
    for (int task = gw; task < 8 * S_; task += NGW) {
        const int q = task & (S_ - 1), bg = task >> 13, g = bg & 1, b = bg >> 1;
        const size_t row = (size_t)b * S_ + q; bf16* Yr = Y + row * YP;
#pragma unroll
        for (int h = 0; h < 4; ++h) qs[h * 64 + lane] = bf2f(Yr[Y_AQ + (g * 4 + h) * 64 + lane]);
        float gt[4][3];
#pragma unroll
        for (int h = 0; h < 4; ++h)
#pragma unroll
            for (int br = 0; br < 3; ++br) gt[h][br] = sigm(bf2f(Yr[Y_AG + (g * 4 + h) * 3 + br]));
        WFENCE();
        const int cur = q >> 6, ncv = q >= 31 ? ((q - 31) >> 4) + 1 : 0;
        const bf16* KC = (const bf16*)(a.ws + WS_KCMP) + (size_t)bg * 512 * 64; const bf16* VC = (const bf16*)(a.ws + WS_VCMP) + (size_t)bg * 512 * 64;
        float mx[4] = {-1e30f, -1e30f, -1e30f, -1e30f};
        for (int i = 0; i < 8; ++i) { const int n = lane + 64 * i;
            if (n < ncv) { float d[4]; dot4(qs, KC + (size_t)n * 64, d); const int bk = t5_bucket(q - (16 * n + 31));
#pragma unroll
                for (int h = 0; h < 4; ++h) { const float s = d[h] + rel[bk * 16 + g * 4 + h] * LOG2E; sc[h * 512 + n] = s; mx[h] = fmaxf(mx[h], s); } }
            else {
#pragma unroll
                for (int h = 0; h < 4; ++h) sc[h * 512 + n] = 0.f; } }
        float ls[4] = {0.f, 0.f, 0.f, 0.f};
#pragma unroll
        for (int h = 0; h < 4; ++h) mx[h] = wave_max(mx[h]);
        WFENCE();
        for (int i = 0; i < 8; ++i) { const int n = lane + 64 * i;
            if (n < ncv) {
#pragma unroll
                for (int h = 0; h < 4; ++h) { const float e = exp2f(sc[h * 512 + n] - mx[h]); sc[h * 512 + n] = e; ls[h] += e; } } }
#pragma unroll
        for (int h = 0; h < 4; ++h) ls[h] = 1.f / fmaxf(wave_sum(ls[h]), 1e-20f);
        for (int i = 0; i < 8; ++i) { const int n = lane + 64 * i;
            if (n < ncv) {
#pragma unroll
                for (int h = 0; h < 4; ++h) sc[h * 512 + n] *= ls[h]; } }
        WFENCE();
        float v0, v1;
        { float t[2];
#pragma unroll
          for (int jj = 0; jj < 2; ++jj) { const int j = lane + 64 * jj; float v = 0.f;
              for (int n = 4 * j - 1; n <= 4 * j + 3; ++n) if (n >= 0 && n < 511) v += (sc[n] + sc[512 + n]) + (sc[1024 + n] + sc[1536 + n]);
              const bool forced = (j == 0) || (j == cur) || (j == cur - 1);
              t[jj] = forced ? 1e9f : (j <= cur ? v : -1e30f); }
          v0 = t[0]; v1 = t[1]; }
        bool sel0 = false, sel1 = false;
        for (int it = 0; it < 16; ++it) {
            const float c0 = sel0 ? -INFINITY : v0, c1 = sel1 ? -INFINITY : v1;
            const float mxv = wave_max(fmaxf(c0, c1));
            const unsigned long long m0 = __ballot(!sel0 && v0 == mxv);
            if (m0) { const int idx = __builtin_ctzll(m0); if (lane == idx) sel0 = true; }
            else { const unsigned long long m1 = __ballot(!sel1 && v1 == mxv); const int idx = m1 ? __builtin_ctzll(m1) : -1; if (lane == idx) sel1 = true; }
        }
        sel0 = sel0 && (lane <= cur); sel1 = sel1 && (lane + 64 <= cur);
        const unsigned long long sm0 = __ballot(sel0), sm1 = __ballot(sel1);
        float oc[4] = {0.f, 0.f, 0.f, 0.f};
        for (int n = 0; n < ncv; ++n) { const float vv = bf2f(VC[(size_t)n * 64 + lane]);
#pragma unroll
            for (int h = 0; h < 4; ++h) oc[h] += sc[h * 512 + n] * vv; }
        float ms[4] = {-1e30f, -1e30f, -1e30f, -1e30f}, lsel[4] = {0.f, 0.f, 0.f, 0.f}, os[4] = {0.f, 0.f, 0.f, 0.f};
        for (int j = 0; j <= cur; ++j) {
            const bool on = j < 64 ? ((sm0 >> j) & 1ull) : ((sm1 >> (j - 64)) & 1ull);
            if (!on) continue;
            const int kpos = 64 * j + lane; const bool valid = kpos <= q;
            float d[4]; dot4(qs, Y + ((size_t)b * S_ + kpos) * YP + Y_AKS + g * 64, d);
            const int bk = t5_bucket(q - kpos);
            WFENCE();
#pragma unroll
            for (int h = 0; h < 4; ++h) { const float s = valid ? d[h] + rel[bk * 16 + g * 4 + h] * LOG2E : -1e30f;
                const float mn = fmaxf(ms[h], wave_max(s)); const float p = valid ? exp2f(s - mn) : 0.f; s2[h * 64 + lane] = p;
                const float scl = exp2f(ms[h] - mn); lsel[h] = lsel[h] * scl + wave_sum(p); os[h] *= scl; ms[h] = mn; }
            WFENCE();
            const bf16* vb = Y + ((size_t)b * S_ + 64 * j) * YP + Y_AVS + g * 64 + lane;
            for (int kk = 0; kk < 64; ++kk) { const float vv = bf2f(vb[(size_t)kk * YP]);
#pragma unroll
                for (int h = 0; h < 4; ++h) os[h] += s2[h * 64 + kk] * vv; }
        }
        float mw[4] = {-1e30f, -1e30f, -1e30f, -1e30f}, lw[4] = {0.f, 0.f, 0.f, 0.f}, ow[4] = {0.f, 0.f, 0.f, 0.f};
        for (int c = 0; c < 8; ++c) {
            if (q - 64 * c < 0) break;
            const int dist = 64 * c + lane, kpos = q - dist; const bool valid = kpos >= 0;
            float d[4]; dot4(qs, Y + ((size_t)b * S_ + (valid ? kpos : 0)) * YP + Y_AKW + g * 64, d);
            const int bk = t5_bucket(dist);
            WFENCE();
#pragma unroll
            for (int h = 0; h < 4; ++h) { const float s = valid ? d[h] + rel[bk * 16 + g * 4 + h] * LOG2E : -1e30f;
                const float mn = fmaxf(mw[h], wave_max(s)); const float p = valid ? exp2f(s - mn) : 0.f; s2[h * 64 + lane] = p;
                const float scl = exp2f(mw[h] - mn); lw[h] = lw[h] * scl + wave_sum(p); ow[h] *= scl; mw[h] = mn; }
            WFENCE();
            for (int kk = 0; kk < 64; ++kk) { const int kp = q - 64 * c - kk; if (kp < 0) break;
                const float vv = bf2f(Y[((size_t)b * S_ + kp) * YP + Y_AVW + g * 64 + lane]);
#pragma unroll
                for (int h = 0; h < 4; ++h) ow[h] += s2[h * 64 + kk] * vv; }
        }
        WFENCE();
#pragma unroll
        for (int h = 0; h < 4; ++h) { const float o = gt[h][0] * oc[h] + gt[h][1] * os[h] / fmaxf(lsel[h], 1e-20f) + gt[h][2] * ow[h] / fmaxf(lw[h], 1e-20f);
            Yr[Y_AQ + (g * 4 + h) * 64 + lane] = (bf16)f2bf(o); }
    }
}
__device__ __forceinline__ void moba_naive(Frame& F, const Args& a) {
    const int gw = blockIdx.x * NWAVES + F.wave, NGW = F.G * NWAVES, lane = F.lane;
    bf16* Y = (bf16*)(a.ws + WS_Y); const float* rel = a.in[1]; const float* KM = (const float*)(a.ws + WS_KMEAN);
    LAS float* scr = (LAS float*)(F.lds + RING_OFF + F.wave * 16384);
    LAS float* qs = scr; LAS float* s2 = scr + 64;
    for (int task = gw; task < 32 * S_; task += NGW) {
        const int q = task & (S_ - 1), bh = task >> 13, h = bh & 7, b = bh >> 3;
        const size_t row = (size_t)b * S_ + q; bf16* Yr = Y + row * YP;
        WFENCE();
        qs[lane] = bf2f(Yr[Y_CQ + h * 64 + lane]);
        WFENCE();
        const int cur = q >> 8;
        float gs = -1e30f;
        if (lane < 32 && lane < cur) { const float* km = KM + ((size_t)bh * 32 + lane) * 64; float d = 0.f;
            for (int dd = 0; dd < 64; ++dd) d += qs[dd] * km[dd];
            gs = d; }
        if (lane >= 32) gs = -INFINITY;
        bool sel = false;
        for (int it = 0; it < 3; ++it) { const float c = sel ? -INFINITY : gs; const float mxv = wave_max(c);
            const unsigned long long m0 = __ballot(!sel && lane < 32 && gs == mxv); const int idx = m0 ? __builtin_ctzll(m0) : -1; if (lane == idx) sel = true; }
        sel = sel && (lane < cur);
        const unsigned smask = (unsigned)__ballot(sel);
        float mr = -1e30f, lr = 0.f, o = 0.f;
        for (int j = 0; j <= cur; ++j) {
            const bool own = (j == cur);
            if (!own && !((smask >> j) & 1u)) continue;
            for (int c = 0; c < 4; ++c) {
                const int kpos = 256 * j + 64 * c + lane; const bool valid = kpos <= q;
                if (256 * j + 64 * c > q) break;
                const float d = dot1(qs, Y + ((size_t)b * S_ + kpos) * YP + Y_CK + h * 64);
                const int bk = t5_bucket(q - kpos);
                const float s = valid ? d + rel[bk * 16 + 8 + h] * LOG2E : -1e30f;
                const float mn = fmaxf(mr, wave_max(s)); const float p = valid ? exp2f(s - mn) : 0.f;
                WFENCE(); s2[lane] = p; WFENCE();
                const float scl = exp2f(mr - mn); lr = lr * scl + wave_sum(p); o *= scl; mr = mn;
                const bf16* vb = Y + ((size_t)b * S_ + 256 * j + 64 * c) * YP + Y_CV + h * 64 + lane;
                for (int kk = 0; kk < 64; ++kk) o += s2[kk] * bf2f(vb[(size_t)kk * YP]);
            }
        }
        Yr[Y_CQ + h * 64 + lane] = (bf16)f2bf(o / fmaxf(lr, 1e-20f));
    }
}
constexpr int CW_Q = 8192;
__device__ __forceinline__ int next_unit(Frame& F, int k) {
    __syncthreads();
    if (F.tid == 0) F.MISC[16] = __hip_atomic_fetch_add(F.ctl + CW_Q + 64 * k, 1u, RLX_AGENT);
    __syncthreads();
    return (int)F.MISC[16];
}
__device__ __forceinline__ void moba_fast(Frame& F, const Args& a, int qk) {
    bf16* Y = (bf16*)(a.ws + WS_Y); const float* KM = (const float*)(a.ws + WS_KMEAN);
    for (;;) {
        const int u = next_unit(F, qk); if (u >= 1024) break;
        const int qb = 31 - (u >> 5), bh = u & 31, b = bh >> 3, h = bh & 7; const long rowbase = (long)b * S_;
        attn::UArgs U{};
        U.Qb = Y + (rowbase + qb * 256) * YP + Y_CQ + h * 64; U.Kh = Y + rowbase * YP + Y_CK + h * 64; U.Vh = Y + rowbase * YP + Y_CV + h * 64; U.Ob = Y + (rowbase + qb * 256) * YP + Y_CQ + h * 64;
        U.NT = 4 * (qb + 1); U.q0 = qb * 256; U.kt0 = 0; U.hc = 8 + h; U.rel = a.in[1]; U.km = KM + (size_t)bh * 32 * 64; U.qb = qb;
        attn::attn_unit<0, 0, 8>(U, (char*)F.lds + RING_OFF);
    }
}
__device__ __forceinline__ void gla_out_naive(Frame& F, const Args& a, int l) {
    const int gw = blockIdx.x * NWAVES + F.wave, NGW = F.G * NWAVES, lane = F.lane;
    bf16* Y = (bf16*)(a.ws + WS_Y); const float* O32 = (const float*)(a.ws + WS_H); const float* nw = a.in[15] + (size_t)l * 128;
    for (int t = gw; t < M_ * 4; t += NGW) {
        const int h = t & 3; const size_t row = (size_t)(t >> 2);
        const float o0 = O32[row * 512 + h * 128 + lane], o1 = O32[row * 512 + h * 128 + 64 + lane];
        const float r = rsqrtf(wave_sum(o0 * o0 + o1 * o1) * (1.f / 128.f) + NORM_EPS);
        bf16* yr = Y + row * YP + Y_BR + h * 128;
        const float r0 = bf2f(yr[lane]), r1 = bf2f(yr[64 + lane]);
        yr[lane] = (bf16)f2bf(o0 * r * nw[lane] * (r0 * sigm(r0))); yr[64 + lane] = (bf16)f2bf(o1 * r * nw[64 + lane] * (r1 * sigm(r1)));
    }
}

constexpr int PPL = 11, NPH = NL * PPL;
#define IN(k) (lo <= (k) && (k) < hi)
#define SEAM(k) do { if (IN(k) && IN((k) + 1)) xcd_barrier(bar); } while (0)
template <int l> __device__ __forceinline__ void layer_body(Frame& F, const Args& args, const XcdBarrier& bar, const int lo, const int hi) {
    unsigned char* ws = args.ws;
    bf16* H = (bf16*)(ws + WS_H); bf16* Y = (bf16*)(ws + WS_Y); unsigned char* G8 = ws + WS_G8;
    float* Yf = (float*)(ws + WS_Y); bf16* ACT = (bf16*)(ws + WS_ACT);
    constexpr int p0 = l * PPL;
    const float* xin = l == 0 ? args.in[0] : args.out;
    if (IN(p0 + 0)) { phase_weights(F, args, l); if (l == 0) phase_norm0(F, args.in[0], args.in[2], H); SEAM(p0 + 0); }
    if (IN(p0 + 1)) {
        pg8::Gemm g{H, (const bf16*)(ws + WS_WIN), M_, NIN, DM, DM}; pg8::StaticOrder So; So.init(M_, NIN, F.G, (int)blockIdx.x);
        pg8::EpiInProj E{Y, G8};
        pg8::gemm_phase<pg8::EpiInProj, pg8::StaticOrder, true, true>(F.lds + RING_OFF, g, So, E);
        SEAM(p0 + 1);
    }
    if (IN(p0 + 2)) { phase2_naive(F, args, l); SEAM(p0 + 2); }
    if (IN(p0 + 3)) { gla_scan_naive(F, args); nsa_naive(F, args); moba_fast(F, args, l * 4 + 0); SEAM(p0 + 3); }
    if (IN(p0 + 4)) { gla_out_naive(F, args, l); SEAM(p0 + 4); }
    if (IN(p0 + 5)) {
        pg8::StaticOrder So; So.init(M_, DM, F.G, (int)blockIdx.x);
        { pg8::Gemm g{Y + Y_AQ, (const bf16*)(ws + WS_WA), M_, DM, 512, YP}; pg8::EpiMerge<0> E{H, G8}; pg8::gemm_phase<pg8::EpiMerge<0>, pg8::StaticOrder, true, true>(F.lds + RING_OFF, g, So, E); }
        __syncthreads();
        { pg8::Gemm g{Y + Y_BR, (const bf16*)(ws + WS_WB), M_, DM, 512, YP}; pg8::EpiMerge<1> E{H, G8}; pg8::gemm_phase<pg8::EpiMerge<1>, pg8::StaticOrder, true, true>(F.lds + RING_OFF, g, So, E); }
        __syncthreads();
        { pg8::Gemm g{Y + Y_CQ, (const bf16*)(ws + WS_WC), M_, DM, 512, YP}; pg8::EpiMerge<2> E{H, G8}; pg8::gemm_phase<pg8::EpiMerge<2>, pg8::StaticOrder, true, true>(F.lds + RING_OFF, g, So, E); }
        SEAM(p0 + 5);
    }
    if (IN(p0 + 6)) {
        pg8::Gemm g{H, (const bf16*)(ws + WS_WO), M_, DM, DM, DM}; pg8::StaticOrder So; So.init(M_, DM, F.G, (int)blockIdx.x);
        pg8::EpiF32 E{Yf, DM}; pg8::gemm_phase<pg8::EpiF32, pg8::StaticOrder, true, true>(F.lds + RING_OFF, g, So, E);
        SEAM(p0 + 6);
    }
    if (IN(p0 + 7)) { phase_resid(F, Yf, xin, args.out, args.in[3] + (size_t)l * DM, args.in[4] + (size_t)l * DM, H); SEAM(p0 + 7); }
    if (IN(p0 + 8)) {
        pg8::Gemm g{H, (const bf16*)(ws + WS_WF1), M_, 2 * FF, DM, DM}; pg8::StaticOrder So; So.init(M_, 2 * FF, F.G, (int)blockIdx.x);
        pg8::EpiSwiglu E{ACT, FF}; pg8::gemm_phase<pg8::EpiSwiglu, pg8::StaticOrder, true, true>(F.lds + RING_OFF, g, So, E);
        SEAM(p0 + 8);
    }
    if (IN(p0 + 9)) {
        pg8::Gemm g{ACT, (const bf16*)(ws + WS_WF2), M_, DM, FF, FF}; pg8::StaticOrder So; So.init(M_, DM, F.G, (int)blockIdx.x);
        pg8::EpiF32 E{Yf, DM}; pg8::gemm_phase<pg8::EpiF32, pg8::StaticOrder, true, true>(F.lds + RING_OFF, g, So, E);
        SEAM(p0 + 9);
    }
    if (IN(p0 + 10)) { phase_resid(F, Yf, args.out, args.out, args.in[5] + (size_t)l * DM, l + 1 < NL ? args.in[2] + (size_t)(l + 1) * DM : nullptr, l + 1 < NL ? H : nullptr); SEAM(p0 + 10); }
}
__global__ void __launch_bounds__(NWAVES * 64, 2) mk_fwd(Args args) {
    extern __shared__ __attribute__((aligned(16))) unsigned char lds[];
    Frame F;
    F.lds = (LAS unsigned char*)lds; F.MISC = (volatile LAS unsigned*)(F.lds + MISC_OFF);
    F.tid = threadIdx.x; F.lane = F.tid & 63; F.wave = __builtin_amdgcn_readfirstlane(F.tid >> 6); F.G = gridDim.x;
    F.ctl = (gu32*)(args.ws + WS_CTL);
    for (int u = F.tid; u < (LDS_BYTES - LDSCTL_OFF) / 4; u += NWAVES * 64) ((LAS unsigned*)(F.lds + LDSCTL_OFF))[u] = 0u;
    __syncthreads();
    const int lo = args.ph_lo, hi = args.ph_hi;
    XcdBarrier bar; bar.bar = (unsigned*)(F.ctl + CW_BAR); bar.x = 0; bar.st = nullptr;
    if (hi - lo > 1) bar = xcd_barrier_post((unsigned*)(F.ctl + CW_BAR), F.MISC + 8);
    layer_body<0>(F, args, bar, lo, hi);
    layer_body<1>(F, args, bar, lo, hi);
}
#undef IN
#undef SEAM

#ifndef MK_ONE_LAUNCH
#define MK_ONE_LAUNCH 1
#endif
extern "C" void kernel_launch(void* const* d_in, const int* in_sizes, int n_in, void* d_out, int out_size, void* d_ws, size_t ws_size, hipStream_t stream) {
    static int grid = 0;
    if (grid == 0) {
        if (n_in != 22 || out_size != M_ * DM || ws_size < WS_END) { fprintf(stderr, "kernel_launch: unexpected sizes (n_in %d out %d ws %zu)\n", n_in, out_size, ws_size); grid = -1; return; }
        int dev = 0, cus = 0;
        if (hipGetDevice(&dev) != hipSuccess || hipDeviceGetAttribute(&cus, hipDeviceAttributeMultiprocessorCount, dev) != hipSuccess) { grid = -1; return; }
        if (hipFuncSetAttribute((const void*)mk_fwd, hipFuncAttributeMaxDynamicSharedMemorySize, LDS_BYTES) != hipSuccess) { grid = -1; return; }
        (void)hipGetLastError();
        grid = cus;
    }
    if (grid < 0) return;
    if (hipMemsetAsync((char*)d_ws + WS_CTL, 0, CTL_ZERO_BYTES, stream) != hipSuccess) return;
    Args a{};
    for (int i = 0; i < 22; ++i) a.in[i] = (const float*)d_in[i];
    a.out = (float*)d_out; a.ws = (unsigned char*)d_ws;
#if MK_ONE_LAUNCH
    a.ph_lo = 0; a.ph_hi = NPH;
    hipLaunchKernelGGL(mk_fwd, dim3(grid), dim3(NWAVES * 64), LDS_BYTES, stream, a);
#else
    for (int p = 0; p < NPH; ++p) { a.ph_lo = p; a.ph_hi = p + 1; hipLaunchKernelGGL(mk_fwd, dim3(grid), dim3(NWAVES * 64), LDS_BYTES, stream, a); }
#endif
}
```

```cpp
#include <hip/hip_runtime.h>
#include <cstdio>
#include <cstdint>
#include <cmath>
namespace pg8 {
#define PG8_LAS __attribute__((address_space(3)))
typedef unsigned short bf16_t;
typedef short bf16x8 __attribute__((ext_vector_type(8)));
typedef float f32x4 __attribute__((ext_vector_type(4)));
typedef unsigned u32x4 __attribute__((ext_vector_type(4)));
constexpr int BM = 256, BK = 64, HALF = 128, HTB = HALF * BK * 2  , STAGE_BYTES = 8 * HTB, NXCD = 8, WGM = 8;

__host__ __device__ __forceinline__ int lds_byte(int r, int c) { const int st = (r >> 4) * 2 + (c >> 5), rr = r & 15, cc = c & 31, ob = rr * 64 + cc * 2; return st * 1024 + (ob ^ (((ob >> 9) & 1) << 5)); }
__host__ __device__ __forceinline__ void stage_rc(int b, int& R, int& C) { const int st = b / 1024, sb = b % 1024, swz = sb ^ (((sb >> 9) & 1) << 5); R = (st >> 1) * 16 + swz / 64; C = (st & 1) * 32 + (swz % 64) / 2; }
__host__ __device__ __forceinline__ int perm32(int rho) { const int n = rho >> 4, i = rho & 15; return 8 * (i >> 2) + 4 * n + (i & 3); }

struct Unit { int pm, pn; };
struct Gemm { const bf16_t* A; const bf16_t* Bt; int M, N, K, lda; };

struct StaticOrder {
    int nM, nN, nwg, G, c;
    __host__ __device__ void init(int M, int N, int G_, int c_) { nM = M / BM; nN = N / BM; nwg = nM * nN; G = G_; c = c_; }
    __host__ __device__ bool next(int i, Unit& u) const {
        const long L = (long)i * G + c; if (L >= nwg) return false;
        int wgid = (int)L; { const int q = nwg / NXCD, r = nwg % NXCD, xcd = wgid % NXCD, off = wgid / NXCD; wgid = (xcd < r ? xcd * (q + 1) : r * (q + 1) + (xcd - r) * q) + off; }
        const int nig = WGM * nN, gid = wgid / nig, fm = gid * WGM, gsz = (nM - fm) < WGM ? (nM - fm) : WGM;
        u.pm = fm + ((wgid % nig) % gsz); u.pn = (wgid % nig) / gsz; return true;
    }
    __device__ __forceinline__ void a_ready(const Unit&) const {}
    __device__ __forceinline__ void done(const Unit&) const {}
};

__device__ __forceinline__ unsigned cvt_pk_bf16(float lo, float hi) { unsigned r; asm volatile("v_cvt_pk_bf16_f32 %0, %1, %2" : "=v"(r) : "v"(lo), "v"(hi)); return r; }
typedef float f32x2 __attribute__((ext_vector_type(2)));
constexpr int YP_ = 4392;
constexpr float C2_ = 0.125f * 1.4426950408889634f;
__device__ __forceinline__ float sigmoidf_(float v) { return 1.f / (1.f + __expf(-v)); }
struct EpiInProj {
    static constexpr bool PERM = true, AFTER_DRAIN = false;
    bf16_t* Y; unsigned char* G8;
    __device__ __forceinline__ void operator()(const f32x4 (&acc)[2][2][4][2], const Unit& u, int wr, int wc, int fr, int fq) const {
        const int row0 = u.pm * BM + wr * 64 + fr, colt = u.pn * BM, cin = wc * 32 + 8 * fq;
        if (u.pn < 18) {
            float sc = 1.f; if (u.pn < 2 || u.pn == 5 || u.pn == 6) sc = C2_; else if (u.pn == 11) sc = 0.125f;
#pragma unroll
            for (int ai = 0; ai < 2; ++ai)
#pragma unroll
                for (int m = 0; m < 4; ++m) { bf16_t* rowp = Y + (size_t)(row0 + ai * HALF + m * 16) * YP_;
#pragma unroll
                    for (int bj = 0; bj < 2; ++bj) { const int col = colt + cin + bj * HALF;
                        if (col + 8 <= YP_) { const f32x4 v0 = acc[ai][bj][m][0] * sc, v1 = acc[ai][bj][m][1] * sc; u32x4 w;
                            w.x = cvt_pk_bf16(v0[0], v0[1]); w.y = cvt_pk_bf16(v0[2], v0[3]); w.z = cvt_pk_bf16(v1[0], v1[1]); w.w = cvt_pk_bf16(v1[2], v1[3]);
                            *(u32x4*)(rowp + col) = w; } } }
        } else {
#pragma unroll
            for (int ai = 0; ai < 2; ++ai)
#pragma unroll
                for (int m = 0; m < 4; ++m) { unsigned char* rowp = G8 + (size_t)(row0 + ai * HALF + m * 16) * 3072 + (colt - 4608) + cin;
#pragma unroll
                    for (int bj = 0; bj < 2; ++bj) { const f32x4 v0 = acc[ai][bj][m][0], v1 = acc[ai][bj][m][1]; unsigned lo = 0u, hi = 0u;
#pragma unroll
                        for (int e = 0; e < 4; ++e) { lo |= (unsigned)(sigmoidf_(v0[e]) * 255.f + 0.5f) << (8 * e); hi |= (unsigned)(sigmoidf_(v1[e]) * 255.f + 0.5f) << (8 * e); }
                        typedef unsigned u32x2 __attribute__((ext_vector_type(2))); u32x2 w; w.x = lo; w.y = hi; *(u32x2*)(rowp + bj * HALF) = w; } }
        }
    }
};
template <int I> struct EpiMerge {
    static constexpr bool PERM = true, AFTER_DRAIN = false;
    bf16_t* Mg; const unsigned char* G8;
    __device__ __forceinline__ void operator()(const f32x4 (&acc)[2][2][4][2], const Unit& u, int wr, int wc, int fr, int fq) const {
        const int row0 = u.pm * BM + wr * 64 + fr, col0 = u.pn * BM + wc * 32 + 8 * fq;
#pragma unroll
        for (int ai = 0; ai < 2; ++ai)
#pragma unroll
            for (int m = 0; m < 4; ++m) { const size_t row = (size_t)(row0 + ai * HALF + m * 16);
#pragma unroll
                for (int bj = 0; bj < 2; ++bj) { const int col = col0 + bj * HALF;
                    typedef unsigned u32x2 __attribute__((ext_vector_type(2)));
                    const u32x2 gw = *(const u32x2*)(G8 + row * 3072 + I * 1024 + col);
                    float v[8];
#pragma unroll
                    for (int e = 0; e < 4; ++e) { v[e] = acc[ai][bj][m][0][e] * ((float)((gw.x >> (8 * e)) & 255u) * (1.f / 255.f)); v[4 + e] = acc[ai][bj][m][1][e] * ((float)((gw.y >> (8 * e)) & 255u) * (1.f / 255.f)); }
                    bf16_t* p = Mg + row * 1024 + col;
                    if (I > 0) { const u32x4 o = *(const u32x4*)p;
                        v[0] += __uint_as_float(o.x << 16); v[1] += __uint_as_float(o.x & 0xffff0000u); v[2] += __uint_as_float(o.y << 16); v[3] += __uint_as_float(o.y & 0xffff0000u);
                        v[4] += __uint_as_float(o.z << 16); v[5] += __uint_as_float(o.z & 0xffff0000u); v[6] += __uint_as_float(o.w << 16); v[7] += __uint_as_float(o.w & 0xffff0000u); }
                    u32x4 w; w.x = cvt_pk_bf16(v[0], v[1]); w.y = cvt_pk_bf16(v[2], v[3]); w.z = cvt_pk_bf16(v[4], v[5]); w.w = cvt_pk_bf16(v[6], v[7]);
                    *(u32x4*)p = w; } }
    }
};
struct EpiF32 {
    static constexpr bool PERM = true, AFTER_DRAIN = false;
    float* O; int ldc;
    __device__ __forceinline__ void operator()(const f32x4 (&acc)[2][2][4][2], const Unit& u, int wr, int wc, int fr, int fq) const {
        const int row0 = u.pm * BM + wr * 64 + fr, col0 = u.pn * BM + wc * 32 + 8 * fq;
#pragma unroll
        for (int ai = 0; ai < 2; ++ai)
#pragma unroll
            for (int m = 0; m < 4; ++m) { float* rowp = O + (size_t)(row0 + ai * HALF + m * 16) * ldc + col0;
#pragma unroll
                for (int bj = 0; bj < 2; ++bj) { *(f32x4*)(rowp + bj * HALF) = acc[ai][bj][m][0]; *(f32x4*)(rowp + bj * HALF + 4) = acc[ai][bj][m][1]; } }
    }
};
struct EpiSwiglu {
    static constexpr bool PERM = true, AFTER_DRAIN = false;
    bf16_t* Act; int ldc;
    __device__ __forceinline__ void operator()(const f32x4 (&acc)[2][2][4][2], const Unit& u, int wr, int wc, int fr, int fq) const {
        const int row0 = u.pm * BM + wr * 64 + fr, col0 = u.pn * HALF + wc * 32 + 8 * fq;
#pragma unroll
        for (int ai = 0; ai < 2; ++ai)
#pragma unroll
            for (int m = 0; m < 4; ++m) { bf16_t* p = Act + (size_t)(row0 + ai * HALF + m * 16) * ldc + col0; float v[8];
#pragma unroll
                for (int e = 0; e < 4; ++e) { const float g0 = acc[ai][0][m][0][e], g1 = acc[ai][0][m][1][e];
                    v[e] = g0 * sigmoidf_(g0) * acc[ai][1][m][0][e]; v[4 + e] = g1 * sigmoidf_(g1) * acc[ai][1][m][1][e]; }
                u32x4 w; w.x = cvt_pk_bf16(v[0], v[1]); w.y = cvt_pk_bf16(v[2], v[3]); w.z = cvt_pk_bf16(v[4], v[5]); w.w = cvt_pk_bf16(v[6], v[7]);
                *(u32x4*)p = w; }
    }
};
template <class Epi, class Sched, bool ALIGN_EPI = false, bool SP2 = false>
__device__ __forceinline__ void gemm_phase(PG8_LAS unsigned char* lds, const Gemm g, const Sched& S, const Epi& E) {
    const int tid = threadIdx.x, wid = __builtin_amdgcn_readfirstlane(tid >> 6), lane = tid & 63, wr = wid >> 2, wc = wid & 3, fr = lane & 15, fq = lane >> 4;
    const int K = g.K, nt = K / BK;
    unsigned voffA[2], voffB[2];
#pragma unroll
    for (int i = 0; i < 2; ++i) { int R, C; stage_rc(tid * 16 + i * 8192, R, C); const int Rb = Epi::PERM ? ((R & ~31) + perm32(R & 31)) : R;
        voffA[i] = (unsigned)(R * g.lda + C) * 2u; voffB[i] = (unsigned)(Rb * K + C) * 2u; }
    const size_t kstep = (size_t)(BK * 2);
    const size_t hstepB = (size_t)HALF * K * 2, hstepA = (size_t)HALF * g.lda * 2;
    const size_t tstepA = 2 * hstepA, tstepB = 2 * hstepB;
    const unsigned ldsw = (unsigned)wid * 1024u;
    const int aoff = lds_byte(wr * 64 + fr, fq * 8), boff = lds_byte(wc * 32 + fr, fq * 8);
#define PG8_SA(b, h) (((b) * 2 + (h)) * HTB)
#define PG8_SB(b, h) ((4 + (b) * 2 + (h)) * HTB)
#define PG8_STAGE(bufoff, gbase, voff) do { _Pragma("unroll") for (int _i = 0; _i < 2; ++_i) \
        __builtin_amdgcn_global_load_lds((const unsigned*)((const char*)(gbase) + (voff)[_i]), (PG8_LAS unsigned*)(lds + (bufoff) + ldsw + _i * 8192), 16, 0, 0); } while (0)
#define PG8_LDA(dst, b, h) do { _Pragma("unroll") for (int m = 0; m < 4; ++m) _Pragma("unroll") for (int k = 0; k < 2; ++k) dst[m][k] = *(const PG8_LAS bf16x8*)(lds + PG8_SA(b, h) + aoff + m * 2048 + k * 1024); } while (0)
#define PG8_LDB(dst, b, h) do { _Pragma("unroll") for (int n = 0; n < 2; ++n) _Pragma("unroll") for (int k = 0; k < 2; ++k) dst[n][k] = *(const PG8_LAS bf16x8*)(lds + PG8_SB(b, h) + boff + n * 2048 + k * 1024); } while (0)
#define PG8_MMA(ai, bj, At, Bt) do { __builtin_amdgcn_s_setprio(1); _Pragma("unroll") for (int m = 0; m < 4; ++m) _Pragma("unroll") for (int n = 0; n < 2; ++n) _Pragma("unroll") for (int k = 0; k < 2; ++k) \
        acc[ai][bj][m][n] = __builtin_amdgcn_mfma_f32_16x16x32_bf16(Bt[n][k], At[m][k], acc[ai][bj][m][n], 0, 0, 0); __builtin_amdgcn_s_setprio(0); } while (0)
#define PG8_WAIT_V(n) asm volatile("s_waitcnt vmcnt(" #n ")" ::: "memory")
#define PG8_WAIT_L(n) asm volatile("s_waitcnt lgkmcnt(" #n ")" ::: "memory")
#define PG8_BAR __builtin_amdgcn_s_barrier()
#define PG8_SCHED __builtin_amdgcn_sched_barrier(0)
    Unit cur, nxt; int ui = 0;
    if (!S.next(0, cur)) return;
    f32x4 acc[2][2][4][2];
#pragma unroll
    for (int a = 0; a < 2; ++a)
#pragma unroll
        for (int b = 0; b < 2; ++b)
#pragma unroll
            for (int m = 0; m < 4; ++m)
#pragma unroll
                for (int n = 0; n < 2; ++n) acc[a][b][m][n] = (f32x4){0.f, 0.f, 0.f, 0.f};
    bf16x8 At[4][2], B0[2][2], B1[2][2];
    const char* cA = (const char*)g.A + (size_t)cur.pm * tstepA; const char* cB = (const char*)g.Bt + (size_t)cur.pn * tstepB;
    S.a_ready(cur);
    if constexpr (SP2) {
        PG8_STAGE(PG8_SB(0, 0), cB, voffB); PG8_STAGE(PG8_SB(0, 1), cB + hstepB, voffB); PG8_STAGE(PG8_SA(0, 0), cA, voffA); PG8_STAGE(PG8_SA(0, 1), cA + hstepA, voffA);
        if (wr == 1) PG8_BAR;
        PG8_WAIT_V(2); PG8_BAR;
        PG8_STAGE(PG8_SB(1, 0), cB + kstep, voffB); PG8_STAGE(PG8_SA(1, 0), cA + kstep, voffA); PG8_STAGE(PG8_SB(1, 1), cB + hstepB + kstep, voffB);
        PG8_WAIT_V(6); PG8_BAR;
    } else {
        PG8_STAGE(PG8_SB(0, 0), cB, voffB); PG8_STAGE(PG8_SA(0, 0), cA, voffA); PG8_STAGE(PG8_SB(0, 1), cB + hstepB, voffB); PG8_STAGE(PG8_SA(0, 1), cA + hstepA, voffA);
        if (wr == 1) PG8_BAR;
        PG8_WAIT_V(4); PG8_BAR;
        PG8_STAGE(PG8_SB(1, 0), cB + kstep, voffB); PG8_STAGE(PG8_SA(1, 0), cA + kstep, voffA); PG8_STAGE(PG8_SB(1, 1), cB + hstepB + kstep, voffB);
        PG8_WAIT_V(6); PG8_BAR;
    }
    for (;;) {
        const bool has_next = S.next(ui + 1, nxt);
        const char* nA = has_next ? (const char*)g.A + (size_t)nxt.pm * tstepA : cA; const char* nB = has_next ? (const char*)g.Bt + (size_t)nxt.pn * tstepB : cB;
        for (int t = 0; t < nt; t += 2) {
            const bool last = (t == nt - 2);
            const char* a1 = cA + (size_t)(t + 1) * kstep;
            const char* a2 = last ? nA : cA + (size_t)(t + 2) * kstep; const char* b2 = last ? nB : cB + (size_t)(t + 2) * kstep;
            const char* a3 = a2 + kstep; const char* b3 = b2 + kstep;
            if (last && has_next) S.a_ready(nxt);
            if constexpr (SP2) {
            PG8_LDB(B0, 0, 0); PG8_LDB(B1, 0, 1); PG8_SCHED; PG8_LDA(At, 0, 0); PG8_STAGE(PG8_SA(1, 1), a1 + hstepA, voffA);
            PG8_WAIT_V(8); PG8_WAIT_L(0); PG8_BAR; PG8_MMA(0, 0, At, B0); PG8_MMA(0, 1, At, B1); PG8_BAR; PG8_SCHED;
            PG8_LDA(At, 0, 1); PG8_STAGE(PG8_SB(0, 0), b2, voffB); PG8_STAGE(PG8_SB(0, 1), b2 + hstepB, voffB); PG8_STAGE(PG8_SA(0, 0), a2, voffA);
            PG8_WAIT_V(8); PG8_WAIT_L(0); PG8_BAR; PG8_MMA(1, 0, At, B0); PG8_MMA(1, 1, At, B1); PG8_BAR; PG8_SCHED;
            PG8_LDB(B0, 1, 0); PG8_LDB(B1, 1, 1); PG8_SCHED; PG8_LDA(At, 1, 0); PG8_STAGE(PG8_SA(0, 1), a2 + hstepA, voffA);
            PG8_WAIT_V(8); PG8_WAIT_L(0); PG8_BAR; PG8_MMA(0, 0, At, B0); PG8_MMA(0, 1, At, B1); PG8_BAR; PG8_SCHED;
            PG8_LDA(At, 1, 1); PG8_STAGE(PG8_SB(1, 0), b3, voffB); PG8_STAGE(PG8_SB(1, 1), b3 + hstepB, voffB); PG8_STAGE(PG8_SA(1, 0), a3, voffA);
            PG8_WAIT_V(8); PG8_WAIT_L(0); PG8_BAR; PG8_MMA(1, 0, At, B0); PG8_MMA(1, 1, At, B1); PG8_BAR; PG8_SCHED;
            } else {
            PG8_LDB(B0, 0, 0); PG8_SCHED; PG8_LDA(At, 0, 0); PG8_STAGE(PG8_SA(1, 1), a1 + hstepA, voffA);
            PG8_WAIT_L(8); PG8_BAR; PG8_WAIT_L(0); PG8_MMA(0, 0, At, B0); PG8_BAR; PG8_SCHED;
            PG8_LDB(B1, 0, 1); PG8_STAGE(PG8_SB(0, 0), b2, voffB);
            PG8_BAR; PG8_WAIT_L(0); PG8_MMA(0, 1, At, B1); PG8_BAR;
            PG8_LDA(At, 0, 1); PG8_STAGE(PG8_SA(0, 0), a2, voffA);
            PG8_BAR; PG8_WAIT_L(0); PG8_MMA(1, 0, At, B0); PG8_BAR; PG8_SCHED;
            PG8_STAGE(PG8_SB(0, 1), b2 + hstepB, voffB);
            PG8_WAIT_V(6); PG8_BAR; PG8_MMA(1, 1, At, B1); PG8_BAR;
            PG8_LDB(B0, 1, 0); PG8_SCHED; PG8_LDA(At, 1, 0); PG8_STAGE(PG8_SA(0, 1), a2 + hstepA, voffA);
            PG8_WAIT_L(8); PG8_BAR; PG8_WAIT_L(0); PG8_MMA(0, 0, At, B0); PG8_BAR; PG8_SCHED;
            PG8_LDB(B1, 1, 1); PG8_STAGE(PG8_SB(1, 0), b3, voffB);
            PG8_BAR; PG8_WAIT_L(0); PG8_MMA(0, 1, At, B1); PG8_BAR;
            PG8_LDA(At, 1, 1); PG8_STAGE(PG8_SA(1, 0), a3, voffA);
            PG8_BAR; PG8_WAIT_L(0); PG8_MMA(1, 0, At, B0); PG8_BAR; PG8_SCHED;
            PG8_STAGE(PG8_SB(1, 1), b3 + hstepB, voffB);
            PG8_WAIT_V(6); PG8_BAR; PG8_MMA(1, 1, At, B1); PG8_BAR;
            }
        }
        if constexpr (ALIGN_EPI) { if (wr == 0) PG8_BAR; }
        if constexpr (!Epi::AFTER_DRAIN) { E(acc, cur, wr, wc, fr, fq); S.done(cur); }
        if (!has_next) break;
#pragma unroll
        for (int a = 0; a < 2; ++a)
#pragma unroll
            for (int b = 0; b < 2; ++b)
#pragma unroll
                for (int m = 0; m < 4; ++m)
#pragma unroll
                    for (int n = 0; n < 2; ++n) acc[a][b][m][n] = (f32x4){0.f, 0.f, 0.f, 0.f};
        cur = nxt; cA = nA; cB = nB; ++ui;
        if constexpr (ALIGN_EPI) { if (wr == 1) PG8_BAR; }
    }
    PG8_WAIT_V(0);
    if constexpr (!ALIGN_EPI) { if (wr == 0) PG8_BAR; }
    PG8_BAR;
    if constexpr (Epi::AFTER_DRAIN) { E.fused(acc, cur, wr, wc, fr, fq, lds, wid, lane); S.done(cur); }
#undef PG8_SA
#undef PG8_SB
#undef PG8_STAGE
#undef PG8_LDA
#undef PG8_LDB
#undef PG8_MMA
#undef PG8_WAIT_V
#undef PG8_WAIT_L
#undef PG8_BAR
#undef PG8_SCHED
}
}
namespace attn {
using bf16=unsigned short;
using bf16x8=__attribute__((ext_vector_type(8)))short;
using s16x4=__attribute__((ext_vector_type(4)))short;
using f32x16=__attribute__((ext_vector_type(16)))float;
using u32x4=__attribute__((ext_vector_type(4)))unsigned;
constexpr int D=64, PITCH=4392, SEQ=8192;
constexpr int NW=8,QBLK=32,QB=QBLK*NW,KVBLK=64;
__device__ __forceinline__ int crow(int r,int hi){return (r&3)+8*(r>>2)+4*hi;}
#define SBAR() __builtin_amdgcn_sched_barrier(0)
using f32x4_=__attribute__((ext_vector_type(4)))float;
__device__ __forceinline__ float bfs(short v){ return __uint_as_float(((unsigned)(unsigned short)v)<<16); }
__device__ __forceinline__ float lo16(unsigned w){ return __uint_as_float(w<<16); }
__device__ __forceinline__ float hi16(unsigned w){ return __uint_as_float(w&0xffff0000u); }
__device__ __forceinline__ bf16 f2b(float f){ unsigned u=__float_as_uint(f); return (bf16)((u+0x7fffu+((u>>16)&1u))>>16); }
__device__ __forceinline__ unsigned pk2b(float lo,float hi){ return (unsigned)f2b(lo)|((unsigned)f2b(hi)<<16); }
constexpr int NSLOT=3, SLOTB=8192;
constexpr int LDS_K=0, LDS_V=NSLOT*SLOTB, LDS_WS=2*NSLOT*SLOTB, LDS_OST=LDS_WS+NW*128*4, LDS_BIAS=LDS_OST+NW*4096, LDS_MSK=LDS_BIAS+512, LDS_KM=LDS_MSK+NW*512, LDS_BYTES=LDS_KM+8192;
constexpr float LOG2E_=1.4426950408889634f;
__device__ __forceinline__ void glds16(const void*gsrc,unsigned lds_dst){unsigned keep;
  asm volatile("s_mov_b32 %0, m0\n\ts_mov_b32 m0, %2\n\ts_nop 0\n\tglobal_load_lds_dwordx4 %1, off\n\ts_mov_b32 m0, %0":"=&s"(keep):"v"(gsrc),"s"(lds_dst):"memory");}
__device__ __forceinline__ float max3f(float a,float b,float c){float r;asm("v_max3_f32 %0, %1, %2, %3":"=v"(r):"v"(a),"v"(b),"v"(c));return r;}
__device__ __forceinline__ float max2f(float a,float b){float r;asm("v_max_f32_e32 %0, %1, %2":"=v"(r):"v"(a),"v"(b));return r;}
__device__ __forceinline__ float fadd_s(float a,float b){float r;asm("v_add_f32_e32 %0, %1, %2":"=v"(r):"v"(a),"v"(b));return r;}
__device__ __forceinline__ float fsub_s(float a,float b){float r;asm("v_sub_f32_e32 %0, %1, %2":"=v"(r):"v"(a),"v"(b));return r;}
typedef float f32x2_t __attribute__((ext_vector_type(2))); typedef __bf16 bf16x2_t __attribute__((ext_vector_type(2)));
__device__ __forceinline__ unsigned cvtpk_s(float lo,float hi){f32x2_t v={lo,hi};bf16x2_t b=__builtin_convertvector(v,bf16x2_t);return __builtin_bit_cast(unsigned,b);}
#define WAIT_BAR(N) asm volatile("s_waitcnt vmcnt(" #N ") lgkmcnt(0)\n\ts_barrier":::"memory")

__device__ __forceinline__ void qkt(f32x16&p0,f32x16&p1,const char*Kslot,const bf16x8*qr,const f32x16&negm,int r32,int hi){
  const char*kb=Kslot+hi*1024+r32*16;
  #pragma unroll
  for(int d0=0;d0<4;++d0){
    const bf16x8 b0=*reinterpret_cast<const bf16x8*>(kb+d0*2048);
    const bf16x8 b1=*reinterpret_cast<const bf16x8*>(kb+d0*2048+512);
    if(d0==0){p0=__builtin_amdgcn_mfma_f32_32x32x16_bf16(b0,qr[0],negm,0,0,0);p1=__builtin_amdgcn_mfma_f32_32x32x16_bf16(b1,qr[0],negm,0,0,0);}
    else{p0=__builtin_amdgcn_mfma_f32_32x32x16_bf16(b0,qr[d0],p0,0,0,0);p1=__builtin_amdgcn_mfma_f32_32x32x16_bf16(b1,qr[d0],p1,0,0,0);}}
}
typedef __attribute__((address_space(3))) const char* lds_cptr;
typedef short v4i16_t __attribute__((ext_vector_type(4)));
__device__ __forceinline__ void kload8(bf16x8*kf,lds_cptr kp){
  kf[0]=*(const __attribute__((address_space(3))) bf16x8*)(kp);      kf[1]=*(const __attribute__((address_space(3))) bf16x8*)(kp+512);
  kf[2]=*(const __attribute__((address_space(3))) bf16x8*)(kp+2048); kf[3]=*(const __attribute__((address_space(3))) bf16x8*)(kp+2560);
  kf[4]=*(const __attribute__((address_space(3))) bf16x8*)(kp+4096); kf[5]=*(const __attribute__((address_space(3))) bf16x8*)(kp+4608);
  kf[6]=*(const __attribute__((address_space(3))) bf16x8*)(kp+6144); kf[7]=*(const __attribute__((address_space(3))) bf16x8*)(kp+6656);
}
__device__ __forceinline__ void kload2(bf16x8*kf,lds_cptr kp,int j){ kf[2*j]=*(const __attribute__((address_space(3))) bf16x8*)(kp+j*2048); kf[2*j+1]=*(const __attribute__((address_space(3))) bf16x8*)(kp+j*2048+512); }
__device__ __forceinline__ s16x4 vtr(lds_cptr p){ return __builtin_bit_cast(s16x4,__builtin_amdgcn_ds_read_tr16_b64_v4i16((__attribute__((address_space(3))) v4i16_t*)p)); }
__device__ __forceinline__ float rowmax(const f32x16&p0,const f32x16&p1){
  float a=max3f(p0[0],p0[1],p1[0]),b=max3f(p0[2],p0[3],p1[1]);a=max3f(a,p1[2],p1[3]);
  #pragma unroll
  for(int r=4;r<16;r+=4){a=max3f(a,p0[r],p0[r+1]);b=max3f(b,p0[r+2],p0[r+3]);a=max3f(a,p1[r],p1[r+1]);b=max3f(b,p1[r+2],p1[r+3]);}
  const float m=max2f(a,b);
  auto rr=__builtin_amdgcn_permlane32_swap(__float_as_uint(m),__float_as_uint(m),false,false);
  return max2f(__uint_as_float(rr[0]),__uint_as_float(rr[1]));
}
__device__ __forceinline__ void pv(f32x16*o,int vb,bf16x8 pa0,bf16x8 pa1,bf16x8 pa2,bf16x8 pa3){
  #pragma unroll
  for(int d0=0;d0<2;++d0){s16x4 lo[4],hi[4];
    #pragma unroll
    for(int ks=0;ks<4;++ks){
      asm volatile("ds_read_b64_tr_b16 %0,%1 offset:%c2":"=&v"(lo[ks]):"v"(vb),"i"(d0*4096+ks*1024):"memory");
      asm volatile("ds_read_b64_tr_b16 %0,%1 offset:%c2":"=&v"(hi[ks]):"v"(vb),"i"(d0*4096+ks*1024+512):"memory");}
    asm volatile("s_waitcnt lgkmcnt(0)":::"memory");SBAR();
    #define PK(k) (bf16x8){lo[k][0],lo[k][1],lo[k][2],lo[k][3],hi[k][0],hi[k][1],hi[k][2],hi[k][3]}
    o[d0]=__builtin_amdgcn_mfma_f32_32x32x16_bf16(pa0,PK(0),o[d0],0,0,0);
    o[d0]=__builtin_amdgcn_mfma_f32_32x32x16_bf16(pa1,PK(1),o[d0],0,0,0);
    o[d0]=__builtin_amdgcn_mfma_f32_32x32x16_bf16(pa2,PK(2),o[d0],0,0,0);
    o[d0]=__builtin_amdgcn_mfma_f32_32x32x16_bf16(pa3,PK(3),o[d0],0,0,0);
    #undef PK
  }
}

#ifndef ATTN_STORE16
#define ATTN_STORE16(p,v) (*(u32x4*)(p)=(v))
#endif
struct UArgs {
  const bf16* Qb; const bf16* Kh; const bf16* Vh; bf16* Ob;
  int NT, q0, kt0, hc;
  const float* rel;
  const float* km; int qb;
  const unsigned* selg;
  const bf16* gate; int gcol;
  const bf16* tmp;
};
__device__ __forceinline__ int t5b(int d){ if(d<16)return d<0?0:d; int b=16; b+=(d>=19);b+=(d>=21);b+=(d>=24);b+=(d>=27);b+=(d>=31);b+=(d>=35);b+=(d>=40);b+=(d>=46);b+=(d>=52);b+=(d>=59);b+=(d>=67);b+=(d>=77);b+=(d>=87);b+=(d>=99);b+=(d>=113); return b; }
template<int MODE,int EPI,int THRL> __device__ __forceinline__ void attn_unit(const UArgs&U,char*shm){
  const int tid=threadIdx.x,lane=tid&63,r32=lane&31,hi=lane>>5; const int wid=__builtin_amdgcn_readfirstlane(tid>>6);
  const bf16*Qw=U.Qb+(long)(wid*QBLK)*PITCH;
  const bf16*Kh=U.Kh,*Vh=U.Vh;
  const unsigned lds0=(unsigned)(uintptr_t)shm;
  float*wsf=(float*)(shm+LDS_WS)+wid*128;
  const bf16*ksrc=Kh+(long)lane*PITCH+wid*8;
  const bf16*vsrc=Vh+(long)(16*(wid&3)+(lane>>2))*PITCH+(wid>>2)*32+(lane&3)*8;
  const unsigned kdst=lds0+LDS_K+wid*1024, vdst=lds0+LDS_V+wid*1024;
  #define DMA_K(t,slot) glds16(ksrc+(long)(t)*KVBLK*PITCH,(unsigned)__builtin_amdgcn_readfirstlane(kdst+(slot)))
  #define DMA_V(t,slot) glds16(vsrc+(long)(t)*KVBLK*PITCH,(unsigned)__builtin_amdgcn_readfirstlane(vdst+(slot)))
  const int vb0=(int)(lds0+LDS_V)+((lane>>4)&1)*32+(lane&3)*8+(4*hi+((lane&15)>>2))*64;
  const char*Kbase=shm+LDS_K; bf16x8 kf[8];
  const lds_cptr shm3=(lds_cptr)shm; const lds_cptr kp0=shm3+LDS_K+hi*1024+r32*16; const lds_cptr vp0=shm3+LDS_V+((lane>>4)&1)*32+(lane&3)*8+(4*hi+((lane&15)>>2))*64;
  const int NT=U.NT;
  const int qpos=U.q0+wid*QBLK+r32;
  float*biasT=(float*)(shm+LDS_BIAS);
  if(tid<128) biasT[tid]=(U.rel[t5b(tid)*16+U.hc]-U.rel[31*16+U.hc])*LOG2E_;
  unsigned selw=0u,cw=0u; const unsigned*mskp=(const unsigned*)(shm+LDS_MSK)+wid*128+r32*4;
  if(MODE==0){ ((u32x4*)(shm+LDS_KM))[tid]=((const u32x4*)U.km)[tid]; }
  if(MODE==1){ if(hi==0){ const u32x4 w=*(const u32x4*)(U.selg+(long)(wid*QBLK+r32)*4); *(u32x4*)((unsigned*)(shm+LDS_MSK)+wid*128+r32*4)=w; } }
  asm volatile("s_waitcnt vmcnt(0) lgkmcnt(0)\n\ts_barrier":::"memory");
  bf16x8 qr[4];
  #pragma unroll
  for(int d0=0;d0<4;++d0)qr[d0]=*reinterpret_cast<const bf16x8*>(&Qw[(long)r32*PITCH+d0*16+hi*8]);
  if(MODE==0){
    float v1=-INFINITY,v2=-INFINITY,v3=-INFINITY; int i1=-1,i2=-1,i3=-1;
    for(int n=0;n<U.qb;++n){ const float*km=(const float*)(shm+LDS_KM)+n*64+hi*8; float p=0.f;
      #pragma unroll
      for(int d0=0;d0<4;++d0){ const f32x4_ a=*(const f32x4_*)(km+d0*16), c=*(const f32x4_*)(km+d0*16+4);
        p+=bfs(qr[d0][0])*a[0]+bfs(qr[d0][1])*a[1]+bfs(qr[d0][2])*a[2]+bfs(qr[d0][3])*a[3]+bfs(qr[d0][4])*c[0]+bfs(qr[d0][5])*c[1]+bfs(qr[d0][6])*c[2]+bfs(qr[d0][7])*c[3]; }
      auto rr=__builtin_amdgcn_permlane32_swap(__float_as_uint(p),__float_as_uint(p),false,false); const float sc_=__uint_as_float(rr[0])+__uint_as_float(rr[1]);
      if(sc_>v1){v3=v2;i3=i2;v2=v1;i2=i1;v1=sc_;i1=n;} else if(sc_>v2){v3=v2;i3=i2;v2=sc_;i2=n;} else if(sc_>v3){v3=sc_;i3=n;} }
    if(i1>=0)selw|=1u<<i1; if(i2>=0)selw|=1u<<i2; if(i3>=0)selw|=1u<<i3; selw|=1u<<U.qb; }
  DMA_K(0,0);DMA_V(0,0);DMA_K(1,SLOTB);
  float mhat=0.f,l_reg=0.f;f32x16 o[2];o[0]=f32x16{};o[1]=f32x16{};f32x16 negm=f32x16{};asm volatile("":"+v"(negm));
  #define MASK_FAR(P0,P1,t) do{ bool on_=true; if(MODE==0)on_=((selw>>((t)>>2))&1u)!=0u; if(MODE==1){ if(((t)&31)==0)cw=mskp[(t)>>5]; on_=((cw>>((t)&31))&1u)!=0u; } \
      _Pragma("unroll") for(int r=0;r<16;++r){ P0[r]=on_?P0[r]:-INFINITY; P1[r]=on_?P1[r]:-INFINITY; } }while(0)
  #define MASK_BAND(P0,P1,t) do{ bool on_=true; if(MODE==0)on_=((selw>>((t)>>2))&1u)!=0u; if(MODE==1){ if(((t)&31)==0)cw=mskp[(t)>>5]; on_=((cw>>((t)&31))&1u)!=0u; } \
      const int d0_=qpos-(U.kt0+64*(t)+4*hi); \
      _Pragma("unroll") for(int r=0;r<16;++r){ const int da_=d0_-((r&3)+8*(r>>2)), db_=da_-32; \
        const bool oka_=on_&&da_>=0&&(MODE!=2||da_<512), okb_=on_&&db_>=0&&(MODE!=2||db_<512); \
        const float ba_=biasT[da_<0?0:(da_>127?127:da_)], bb_=biasT[db_<0?0:(db_>127?127:db_)]; \
        P0[r]=oka_?P0[r]+ba_:-INFINITY; P1[r]=okb_?P1[r]+bb_:-INFINITY; \
        if((r&1)==1){ asm volatile("s_waitcnt lgkmcnt(0)":"+v"(P0),"+v"(P1)::"memory"); } } }while(0)
  #define CMASK(P0,P1,t) MASK_BAND(P0,P1,t)
  bool resc=false;
  #define START(P0,P1) do{ const float rm=rowmax(P0,P1); resc=false; \
    { const float dl=rm>-1e30f?rm:0.f; mhat=fadd_s(mhat,dl); \
      _Pragma("unroll") for(int r=0;r<16;++r){P0[r]=fsub_s(P0[r],dl);P1[r]=fsub_s(P1[r],dl);} \
      _Pragma("unroll") for(int r=0;r<16;++r)negm[r]=-mhat; asm volatile("":"+v"(negm)); } \
    _Pragma("unroll") for(int r=0;r<16;++r)P0[r]=__builtin_amdgcn_exp2f(P0[r]); }while(0)
  #define RESC() do{ if(resc){ asm volatile("s_waitcnt lgkmcnt(0)":::"memory"); \
      _Pragma("unroll") for(int d_=0;d_<2;++d_) _Pragma("unroll") for(int r=0;r<16;++r)o[d_][r]*=wsf[crow(r,hi)]; } }while(0)
  f32x16 pA0,pA1,pB0,pB1;
  int sl_prev=0,sl_cur=0,sl_next=SLOTB;
  #define ROT() do{sl_prev=sl_cur;sl_cur=sl_next;sl_next=(sl_next==(NSLOT-1)*SLOTB)?0:sl_next+SLOTB;}while(0)
  DMA_K(2,2*SLOTB);
  WAIT_BAR(3);
  qkt(pA0,pA1,Kbase,qr,negm,r32,hi);asm volatile("s_nop 15\n\ts_nop 7":"+v"(pA0),"+v"(pA1));CMASK(pA0,pA1,0);
  START(pA0,pA1);
  _Pragma("unroll") for(int r=0;r<16;++r)pA1[r]=__builtin_amdgcn_exp2f(pA1[r]);
  WAIT_BAR(0);
  DMA_K(3,0);DMA_V(1,SLOTB);
  ROT();
  kload8(kf,kp0+sl_cur);
  WAIT_BAR(2);
  s16x4 vlo[8],vhi[8]; u32x4 pw0,pw1,pw2,pw3;
  #define PKW(P,B) cvtpk_s(P[B],P[B+1])
  #define PAF(k) __builtin_bit_cast(bf16x8,pw##k)
  #define VFR(i) (bf16x8){vlo[i][0],vlo[i][1],vlo[i][2],vlo[i][3],vhi[i][0],vhi[i][1],vhi[i][2],vhi[i][3]}
  #define PIN(x) asm volatile("":"+v"(x))
  #define MX3(a,b,c) __builtin_fmaxf(__builtin_fmaxf((a),(b)),(c))
  #define GAPA(MF,A0,A1,A2,A3,W0,W1,PW) do{ MF; sacc+=A0; sacc+=A1; sacc+=A2; sacc+=A3; PIN(sacc); W0; W1; PIN(PW); SBAR(); }while(0)
  #define EX(v) __builtin_amdgcn_exp2f(v)
  #define GAPB(MF,X,B) do{ MF; X[B]=EX(X[B]); X[B+1]=EX(X[B+1]); X[B+2]=EX(X[B+2]); X[B+3]=EX(X[B+3]); PIN(X); SBAR(); }while(0)
  #define VRD(i) do{ vlo[i]=vtr(vp_+(((i)>>2)*4096+((i)&3)*1024)); vhi[i]=vtr(vp_+(((i)>>2)*4096+((i)&3)*1024+512)); }while(0)
  #define KRD(G,j) do{ if(G){ kload2(kf,kp0+sl_next,j); SBAR(); } }while(0)
  #define STEP(C0,C1,P0,P1,t,GK,GV,GL) do{ SBAR(); \
    const lds_cptr vp_=vp0+sl_prev; \
    VRD(0); SBAR(); float sacc=(P0[0]+P0[1]); \
    GAPA(C0=__builtin_amdgcn_mfma_f32_32x32x16_bf16(kf[0],qr[0],negm,0,0,0), P0[2],P0[3],P0[4],P0[5],     pw0[0]=PKW(P0,0), pw0[1]=PKW(P0,2), pw0); \
    VRD(4); SBAR(); GAPA(C1=__builtin_amdgcn_mfma_f32_32x32x16_bf16(kf[1],qr[0],negm,0,0,0), P0[6],P0[7],P0[8],P0[9],     pw0[2]=PKW(P0,4), pw0[3]=PKW(P0,6), pw0); \
    VRD(1); SBAR(); GAPA(C0=__builtin_amdgcn_mfma_f32_32x32x16_bf16(kf[2],qr[1],C0,0,0,0),   P0[10],P0[11],P0[12],P0[13], pw1[0]=PKW(P0,8), pw1[1]=PKW(P0,10), pw1); \
    VRD(5); SBAR(); GAPA(C1=__builtin_amdgcn_mfma_f32_32x32x16_bf16(kf[3],qr[1],C1,0,0,0),   P0[14],P0[15],P1[0],P1[1],   pw1[2]=PKW(P0,12),pw1[3]=PKW(P0,14), pw1); \
    VRD(2); SBAR(); GAPA(C0=__builtin_amdgcn_mfma_f32_32x32x16_bf16(kf[4],qr[2],C0,0,0,0),   P1[2],P1[3],P1[4],P1[5],     pw2[0]=PKW(P1,0), pw2[1]=PKW(P1,2), pw2); \
    VRD(6); SBAR(); GAPA(C1=__builtin_amdgcn_mfma_f32_32x32x16_bf16(kf[5],qr[2],C1,0,0,0),   P1[6],P1[7],P1[8],P1[9],     pw2[2]=PKW(P1,4), pw2[3]=PKW(P1,6), pw2); \
    VRD(3); SBAR(); GAPA(C0=__builtin_amdgcn_mfma_f32_32x32x16_bf16(kf[6],qr[3],C0,0,0,0),   P1[10],P1[11],P1[12],P1[13], pw3[0]=PKW(P1,8), pw3[1]=PKW(P1,10), pw3); \
    VRD(7); SBAR(); GAPA(C1=__builtin_amdgcn_mfma_f32_32x32x16_bf16(kf[7],qr[3],C1,0,0,0),   P1[14],P1[15],0.f,0.f,       pw3[2]=PKW(P1,12),pw3[3]=PKW(P1,14), pw3); \
    l_reg+=sacc; \
    if(GK){DMA_K((t)+3,sl_cur);} if(GV){DMA_V((t)+1,sl_next);} \
    CMASK(C0,C1,t); \
    { float a=MX3(C0[0],C0[1],C1[0]),b=MX3(C0[2],C0[3],C1[1]); a=MX3(a,C1[2],C1[3]); \
      _Pragma("unroll") for(int r=4;r<16;r+=4){a=MX3(a,C0[r],C0[r+1]);b=MX3(b,C0[r+2],C0[r+3]);a=MX3(a,C1[r],C1[r+1]);b=MX3(b,C1[r+2],C1[r+3]);} \
      float rm=__builtin_fmaxf(a,b); { auto rr=__builtin_amdgcn_permlane32_swap(__float_as_uint(rm),__float_as_uint(rm),false,false); rm=__builtin_fmaxf(__uint_as_float(rr[0]),__uint_as_float(rr[1])); } \
      resc=false; \
      if(__builtin_expect(__any(rm>(float)THRL),0)){ const float dl=__builtin_fmaxf(rm,0.f); mhat+=dl; \
        _Pragma("unroll") for(int r=0;r<16;++r){C0[r]-=dl;C1[r]-=dl;} \
        _Pragma("unroll") for(int r=0;r<16;++r)negm[r]=-mhat; asm volatile("":"+v"(negm)); \
        const float f=__builtin_amdgcn_exp2f(-dl); l_reg*=f; if(hi==0)wsf[r32]=f; resc=true; } } \
    SBAR(); \
    GAPB(o[0]=__builtin_amdgcn_mfma_f32_32x32x16_bf16(PAF(0),VFR(0),o[0],0,0,0), C0,0); \
    GAPB(o[1]=__builtin_amdgcn_mfma_f32_32x32x16_bf16(PAF(0),VFR(4),o[1],0,0,0), C0,4); \
    KRD(GL,0); GAPB(o[0]=__builtin_amdgcn_mfma_f32_32x32x16_bf16(PAF(1),VFR(1),o[0],0,0,0), C0,8); \
    KRD(GL,1); GAPB(o[1]=__builtin_amdgcn_mfma_f32_32x32x16_bf16(PAF(1),VFR(5),o[1],0,0,0), C0,12); \
    KRD(GL,2); GAPB(o[0]=__builtin_amdgcn_mfma_f32_32x32x16_bf16(PAF(2),VFR(2),o[0],0,0,0), C1,0); \
    KRD(GL,3); GAPB(o[1]=__builtin_amdgcn_mfma_f32_32x32x16_bf16(PAF(2),VFR(6),o[1],0,0,0), C1,4); \
    GAPB(o[0]=__builtin_amdgcn_mfma_f32_32x32x16_bf16(PAF(3),VFR(3),o[0],0,0,0), C1,8); \
    GAPB(o[1]=__builtin_amdgcn_mfma_f32_32x32x16_bf16(PAF(3),VFR(7),o[1],0,0,0), C1,12); \
    }while(0)
  int t=1;
  #undef CMASK
  #define CMASK(P0,P1,t) MASK_FAR(P0,P1,t)
  for(;MODE!=2&&t+7<NT;t+=2){
    STEP(pB0,pB1,pA0,pA1,t,true,true,true);     WAIT_BAR(2); RESC(); ROT();
    STEP(pA0,pA1,pB0,pB1,t+1,true,true,true);   WAIT_BAR(2); RESC(); ROT();
  }
  #undef CMASK
  #define CMASK(P0,P1,t) MASK_BAND(P0,P1,t)
  #define ENDW(tt) do{ if((tt)+3<NT){WAIT_BAR(2);} else if((tt)+2<NT){WAIT_BAR(1);} else {WAIT_BAR(0);} }while(0)
  for(;t+1<NT;t+=2){
    STEP(pB0,pB1,pA0,pA1,t,(t+3<NT),(t+1<NT),(t+1<NT));       ENDW(t);   RESC(); ROT();
    STEP(pA0,pA1,pB0,pB1,t+1,(t+4<NT),(t+2<NT),(t+2<NT));     ENDW(t+1); RESC(); ROT();
  }
  STEP(pB0,pB1,pA0,pA1,NT-1,false,false,false); RESC();
  { float sacc=pB0[0]+pB0[1]; _Pragma("unroll") for(int r=2;r<16;++r)sacc+=pB0[r]; _Pragma("unroll") for(int r=0;r<16;++r)sacc+=pB1[r]; l_reg+=sacc;
    pw0=(u32x4){PKW(pB0,0),PKW(pB0,2),PKW(pB0,4),PKW(pB0,6)};pw1=(u32x4){PKW(pB0,8),PKW(pB0,10),PKW(pB0,12),PKW(pB0,14)};pw2=(u32x4){PKW(pB1,0),PKW(pB1,2),PKW(pB1,4),PKW(pB1,6)};pw3=(u32x4){PKW(pB1,8),PKW(pB1,10),PKW(pB1,12),PKW(pB1,14)};
    SBAR(); pv(o,vb0+sl_cur,PAF(0),PAF(1),PAF(2),PAF(3)); }
  #undef PKW
  #undef PAF
  #undef VFR
  #undef PIN
  #undef MX3
  #undef GAPA
  #undef GAPB
  #undef EX
  #undef VRD
  #undef KRD
  #undef STEP
  #undef ENDW
  {auto rr=__builtin_amdgcn_permlane32_swap(__float_as_uint(l_reg),__float_as_uint(l_reg),false,false);l_reg=__uint_as_float(rr[0])+__uint_as_float(rr[1]);}
  int lane_e=lane; asm volatile("":"+v"(lane_e)); const int r32e=lane_e&31, hie=lane_e>>5;
  float*wsfe=(float*)(shm+LDS_WS)+wid*128;
  if(hie==0){ wsfe[32+r32e]=l_reg; if(EPI!=0){ const float gl=bfs((short)U.gate[(long)(wid*QBLK+r32e)*PITCH+U.gcol]); wsfe[64+r32e]=1.f/(1.f+__expf(-gl)); } }
  asm volatile("s_waitcnt lgkmcnt(0)":::"memory");
  float rli[16];
  #pragma unroll
  for(int r=0;r<16;++r){ rli[r]=__builtin_amdgcn_rcpf(fmaxf(wsfe[32+crow(r,hie)],1e-30f)); if(EPI!=0)rli[r]*=wsfe[64+crow(r,hie)]; }
  bf16*Ow=U.Ob+(long)(wid*QBLK)*PITCH;
  { bf16*stg=(bf16*)(shm+LDS_OST)+wid*2048;
    #pragma unroll
    for(int r=0;r<16;++r){const int orow=crow(r,hie);
      #pragma unroll
      for(int d0=0;d0<2;++d0){ float v=o[d0][r]*rli[r]; if(EPI==2)v+=bfs((short)stg[orow*64+d0*32+r32e]); stg[orow*64+d0*32+r32e]=f2b(v);} }
    asm volatile("s_waitcnt lgkmcnt(0)":::"memory");
    if(EPI!=1){
    #pragma unroll
    for(int i=0;i<4;++i){const int row=i*8+(lane_e>>3),ch=lane_e&7; u32x4 v=*(const u32x4*)(stg+row*64+ch*8);
      if(EPI==2){ const u32x4 t=*(const u32x4*)(U.tmp+(long)(wid*QBLK+row)*512+ch*8);
        v.x=pk2b(lo16(v.x)+lo16(t.x),hi16(v.x)+hi16(t.x)); v.y=pk2b(lo16(v.y)+lo16(t.y),hi16(v.y)+hi16(t.y)); v.z=pk2b(lo16(v.z)+lo16(t.z),hi16(v.z)+hi16(t.z)); v.w=pk2b(lo16(v.w)+lo16(t.w),hi16(v.w)+hi16(t.w)); }
      ATTN_STORE16(Ow+(long)row*PITCH+ch*8,v);} } }
  asm volatile("s_waitcnt lgkmcnt(0)\n\ts_barrier":::"memory");
  #undef DMA_K
  #undef DMA_V
  #undef CMASK
  #undef START
  #undef RESC
  #undef ROT
}
constexpr int ATTN_LDS_BYTES=LDS_BYTES;
#undef SBAR
#undef WAIT_BAR
}

constexpr int NWAVES = 8;
constexpr int B_ = 4, S_ = 8192, DM = 1024, M_ = B_ * S_, DIN = 7464, FF = 2816, NL = 2;
constexpr int YP = pg8::YP_;
constexpr float C2 = pg8::C2_, LOG2E = 1.4426950408889634f;
constexpr float NORM_EPS = 1e-6f;
constexpr int Y_AQ = 0, Y_AKC = 512, Y_AVC = 640, Y_AKS = 768, Y_AVS = 896, Y_AKW = 1024, Y_AVW = 1152, Y_CQ = 1280, Y_CK = 1792, Y_CV = 2304,
              Y_BQ = 2816, Y_BK = 3072, Y_BV = 3328, Y_BR = 3840, Y_AG = 4352, Y_BLR = 4376;
constexpr int NIN = 7680;
constexpr size_t MiB = 1u << 20;
constexpr size_t WS_CTL = 0, CTL_ZERO_BYTES = 1 * MiB;
constexpr size_t WS_WIN = 1 * MiB, WS_WA = 16 * MiB, WS_WB = 17 * MiB, WS_WC = 18 * MiB, WS_WO = 19 * MiB, WS_WF1 = 21 * MiB, WS_WF2 = 32 * MiB;
constexpr size_t WS_H = 40 * MiB;
constexpr size_t WS_Y = 104 * MiB;
constexpr size_t WS_G8 = 379 * MiB;
constexpr size_t WS_ACT = WS_Y + 128 * MiB;
constexpr size_t WS_SM = 475 * MiB;
constexpr size_t WS_KCMP = WS_SM, WS_VCMP = WS_SM + 1 * MiB, WS_KMEAN = WS_SM + 2 * MiB;
constexpr size_t WS_GA = WS_SM + 3 * MiB;
constexpr size_t WS_MASK = 38 * MiB;
constexpr size_t WS_OATMP = WS_H;
constexpr size_t WS_O16 = WS_H + 32 * MiB;
constexpr size_t WS_END = 512 * MiB;
static_assert(WS_GA + (size_t)M_ * 256 * 4 <= WS_END && WS_Y + (size_t)M_ * YP * 2 <= WS_G8 && WS_G8 + (size_t)M_ * 3072 <= WS_SM, "ws map");
static_assert(WS_ACT + (size_t)M_ * FF * 2 <= WS_SM && WS_WF2 + (size_t)DM * FF * 2 <= WS_H, "ws map 2");
constexpr int CW_BAR = 4096;
constexpr int RING_OFF = 0, RING_BYTES = 131072;
constexpr int LDSCTL_OFF = RING_BYTES, MISC_OFF = LDSCTL_OFF + 320;
constexpr int LDS_BYTES = 147456;

#define GAS __attribute__((address_space(1)))
#define LAS __attribute__((address_space(3)))
typedef unsigned short bf16;
typedef unsigned v4u __attribute__((ext_vector_type(4)));
typedef float f32x4 __attribute__((ext_vector_type(4)));
typedef short bf16x8 __attribute__((ext_vector_type(8)));
typedef GAS unsigned gu32;
typedef GAS unsigned long long gu64;
#define RLX_AGENT __ATOMIC_RELAXED, __HIP_MEMORY_SCOPE_AGENT
#define LDS_WAIT() asm volatile("s_waitcnt lgkmcnt(0)" ::: "memory")
#define VM_WAIT() asm volatile("s_waitcnt vmcnt(0)" ::: "memory")
__device__ __forceinline__ unsigned long long rt() { return __builtin_amdgcn_s_memrealtime(); }
__device__ __forceinline__ unsigned f2bf(float f) { unsigned u = __builtin_bit_cast(unsigned, f); return (u + 0x7fffu + ((u >> 16) & 1u)) >> 16; }
__device__ __forceinline__ unsigned pk2(float lo, float hi) { return f2bf(lo) | (f2bf(hi) << 16); }

__device__ __forceinline__ float bf2f(bf16 h) { return __uint_as_float((unsigned)h << 16); }
__device__ __forceinline__ float sigm(float v) { return 1.f / (1.f + __expf(-v)); }
#define WFENCE() asm volatile("s_waitcnt lgkmcnt(0)" ::: "memory")

#define XB_TMO      128
#define XB_XCNT(j)  (256  + 64 * (j))
#define XB_XSUB(j)  (1280 + 64 * (j))
#define XB_XGEN(j)  (2304 + 64 * (j))
#define XB_TOP      3328
#define XB_TOPGEN   3392
#define XCD_BAR_WORDS 3456
#define XB_SPIN_CAP (1u << 18)

__device__ __forceinline__ unsigned xb_ld(unsigned* p)              { return __hip_atomic_load(p, __ATOMIC_RELAXED, __HIP_MEMORY_SCOPE_AGENT); }
__device__ __forceinline__ unsigned xb_add(unsigned* p, unsigned v) { return __hip_atomic_fetch_add(p, v, __ATOMIC_RELAXED, __HIP_MEMORY_SCOPE_AGENT); }
__device__ __forceinline__ unsigned xb_xcc_id() { return (unsigned)__builtin_amdgcn_s_getreg((3 << 11) | 20) & 0xFu; }
#define XB_SPIN(cond, bar) do { unsigned _sp = 0; while (cond) { __builtin_amdgcn_s_sleep(1); \
    if ((++_sp & 255u) == 0u) { if (xb_ld(&(bar)[XB_TMO])) break; if (_sp > XB_SPIN_CAP) { atomicAdd(&(bar)[XB_TMO], 1u); break; } } } } while (0)

struct XcdBarrier {
    unsigned* bar; unsigned x;
    volatile LAS unsigned* st;
};

__device__ __forceinline__ XcdBarrier xcd_barrier_post(unsigned* bar, volatile LAS unsigned* st) {
    XcdBarrier b; b.bar = bar; b.x = xb_xcc_id(); b.st = st;
    if (threadIdx.x == 0) (void)xb_add(&bar[XB_XCNT(b.x)], 1u);
    return b;
}
__device__ __forceinline__ void xcd_barrier_complete(unsigned* bar, unsigned x, unsigned& nloc, unsigned& nx) {
    const unsigned G = gridDim.x * gridDim.y * gridDim.z;
    unsigned sum, cnt, mine, sp = 0u;
    for (;;) {
        sum = 0u; cnt = 0u; mine = 0u;
#pragma unroll
        for (unsigned j = 0; j < 16; ++j) { const unsigned c = xb_ld(&bar[XB_XCNT(j)]); sum += c; cnt += (c > 0u) ? 1u : 0u; mine = (j == x) ? c : mine; }
        if (sum == G) break;
        __builtin_amdgcn_s_sleep(1);
        if ((++sp & 255u) == 0u) { if (xb_ld(&bar[XB_TMO])) break; if (sp > XB_SPIN_CAP) { atomicAdd(&bar[XB_TMO], 1u); break; } }
    }
    nloc = mine > 0u ? mine : 1u; nx = cnt > 0u ? cnt : 1u;
}

__device__ __forceinline__ void xcd_barrier(const XcdBarrier& b) {
    asm volatile("s_waitcnt vmcnt(0)" ::: "memory");
    __syncthreads();
    if (threadIdx.x == 0) {
        unsigned* bar = b.bar;
        __builtin_amdgcn_s_waitcnt(0);
        unsigned nloc = b.st[0], nx = b.st[1];
        if (nloc == 0u) { xcd_barrier_complete(bar, b.x, nloc, nx); b.st[0] = nloc; b.st[1] = nx; }
        const unsigned old = xb_add(&bar[XB_XSUB(b.x)], 1u);
        const unsigned gen = old / nloc;
        if (old + 1u == (gen + 1u) * nloc) {
            __builtin_amdgcn_fence(__ATOMIC_RELEASE, "agent");
            asm volatile("s_waitcnt vmcnt(0)" ::: "memory");
            const unsigned og = xb_add(&bar[XB_TOP], 1u);
            const unsigned tg = og / nx;
            if (og + 1u == (tg + 1u) * nx) xb_add(&bar[XB_TOPGEN], 1u);
            else XB_SPIN(xb_ld(&bar[XB_TOPGEN]) == tg, bar);
            __builtin_amdgcn_fence(__ATOMIC_ACQUIRE, "agent");
            xb_add(&bar[XB_XGEN(b.x)], 1u);
            asm volatile("s_waitcnt vmcnt(0)" ::: "memory");
        } else {
            XB_SPIN(xb_ld(&bar[XB_XGEN(b.x)]) == gen, bar);
            __builtin_amdgcn_fence(__ATOMIC_ACQUIRE, "agent");
            asm volatile("s_waitcnt vmcnt(0)" ::: "memory");
        }
    }
    __syncthreads();
}


struct Frame {
    LAS unsigned char* lds;
    volatile LAS unsigned* MISC;
    gu32* ctl;
    int tid, lane, wave, G;
};
__device__ __forceinline__ float wave_sum(float v) {
#pragma unroll
    for (int o = 1; o < 64; o <<= 1) v += __shfl_xor(v, o);
    return v;
}
__device__ __forceinline__ float wave_max(float v) {
#pragma unroll
    for (int o = 1; o < 64; o <<= 1) v = fmaxf(v, __shfl_xor(v, o));
    return v;
}
__device__ __forceinline__ int t5_bucket(int d) {
    if (d < 16) return d < 0 ? 0 : d;
    int b = 16;
    b += (d >= 19); b += (d >= 21); b += (d >= 24); b += (d >= 27); b += (d >= 31); b += (d >= 35); b += (d >= 40); b += (d >= 46);
    b += (d >= 52); b += (d >= 59); b += (d >= 67); b += (d >= 77); b += (d >= 87); b += (d >= 99); b += (d >= 113);
    return b;
}
template <class CM> __device__ __forceinline__ void tr_item(const float* W, int Nsrc, int K, bf16* WT, int item, int nblk, CM cm, LAS float* scr, int lane) {
    const int kb = item / nblk, nb = item % nblk, k0 = 64 * kb, n0 = 32 * nb;
    const int sc = cm(n0 + (lane & 31));
#pragma unroll 8
    for (int i = 0; i < 32; ++i) { const int kk = 2 * i + (lane >> 5); scr[kk * 33 + (lane & 31)] = sc >= 0 ? W[(size_t)(k0 + kk) * Nsrc + sc] : 0.f; }
    LDS_WAIT(); asm volatile("" ::: "memory");
    const int c = lane & 7;
#pragma unroll
    for (int j = 0; j < 4; ++j) { const int n = (lane >> 3) + 8 * j; const LAS float* s = scr + (8 * c) * 33 + n;
        v4u o; o.x = pk2(s[0 * 33], s[1 * 33]); o.y = pk2(s[2 * 33], s[3 * 33]); o.z = pk2(s[4 * 33], s[5 * 33]); o.w = pk2(s[6 * 33], s[7 * 33]);
        *(GAS v4u*)(WT + (size_t)(n0 + n) * K + k0 + 8 * c) = o; }
    LDS_WAIT(); asm volatile("" ::: "memory");
}
struct CmId { __device__ __forceinline__ int operator()(int n) const { return n; } };
struct CmWin { __device__ __forceinline__ int operator()(int n) const {
    if (n < 1280) return n;
    if (n < 2816) return n - 1280 + 2856;
    if (n < 4352) return n - 2816 + 1304;
    if (n < 4376) return n - 4352 + 1280;
    if (n < 4392) return n - 4376 + 2840;
    if (n < 4608) return -1;
    return n - 4608 + 4392; } };
struct CmFfn { __device__ __forceinline__ int operator()(int c) const { const int p = c >> 8, r = c & 255; return r < 128 ? 128 * p + r : FF + 128 * p + (r - 128); } };

struct Args { const float* in[22]; float* out; unsigned char* ws; int ph_lo, ph_hi; };

__device__ __forceinline__ void phase_weights(Frame& F, const Args& a, int l) {
    LAS float* scr = (LAS float*)(F.lds + RING_OFF + F.wave * 16384);
    const int gw = blockIdx.x * NWAVES + F.wave, NGW = F.G * NWAVES;
    unsigned char* ws = a.ws;
    constexpr int I_IN = 16 * (NIN / 32), I_BR = 8 * 32, I_O = 16 * 32, I_F1 = 16 * (2 * FF / 32), I_F2 = (FF / 64) * 32;
    constexpr int NIT = I_IN + 3 * I_BR + I_O + I_F1 + I_F2;
    for (int it = gw; it < NIT; it += NGW) {
        int r = it;
        if (r < I_IN) { tr_item(a.in[6] + (size_t)l * DM * DIN, DIN, DM, (bf16*)(ws + WS_WIN), r, NIN / 32, CmWin(), scr, F.lane); continue; } r -= I_IN;
        if (r < I_BR) { tr_item(a.in[16] + (size_t)l * 512 * DM, DM, 512, (bf16*)(ws + WS_WA), r, 32, CmId(), scr, F.lane); continue; } r -= I_BR;
        if (r < I_BR) { tr_item(a.in[17] + (size_t)l * 512 * DM, DM, 512, (bf16*)(ws + WS_WB), r, 32, CmId(), scr, F.lane); continue; } r -= I_BR;
        if (r < I_BR) { tr_item(a.in[18] + (size_t)l * 512 * DM, DM, 512, (bf16*)(ws + WS_WC), r, 32, CmId(), scr, F.lane); continue; } r -= I_BR;
        if (r < I_O) { tr_item(a.in[19] + (size_t)l * DM * DM, DM, DM, (bf16*)(ws + WS_WO), r, 32, CmId(), scr, F.lane); continue; } r -= I_O;
        if (r < I_F1) { tr_item(a.in[20] + (size_t)l * DM * 2 * FF, 2 * FF, DM, (bf16*)(ws + WS_WF1), r, 2 * FF / 32, CmFfn(), scr, F.lane); continue; } r -= I_F1;
        tr_item(a.in[21] + (size_t)l * FF * DM, DM, FF, (bf16*)(ws + WS_WF2), r, 32, CmId(), scr, F.lane);
    }
}
__device__ __forceinline__ void phase_norm0(Frame& F, const float* x, const float* w, bf16* H) {
    const int gw = blockIdx.x * NWAVES + F.wave, NGW = F.G * NWAVES;
    for (int m = gw; m < M_; m += NGW) {
        const f32x4* xr = (const f32x4*)(x + (size_t)m * DM) + F.lane; f32x4 v[4]; float s = 0.f;
#pragma unroll
        for (int j = 0; j < 4; ++j) { v[j] = xr[64 * j]; s += v[j].x * v[j].x + v[j].y * v[j].y + v[j].z * v[j].z + v[j].w * v[j].w; }
        const float r = rsqrtf(wave_sum(s) * (1.f / DM) + NORM_EPS);
        unsigned long long* o8 = (unsigned long long*)(H + (size_t)m * DM) + F.lane;
#pragma unroll
        for (int j = 0; j < 4; ++j) { const f32x4 wv = ((const f32x4*)w)[F.lane + 64 * j];
            o8[64 * j] = (unsigned long long)pk2(v[j].x * r * wv.x, v[j].y * r * wv.y) | ((unsigned long long)pk2(v[j].z * r * wv.z, v[j].w * r * wv.w) << 32); }
    }
}
__device__ __forceinline__ void phase_resid(Frame& F, const float* y, const float* xin, float* xout, const float* wpost, const float* wpre, bf16* hout) {
    const int gw = blockIdx.x * NWAVES + F.wave, NGW = F.G * NWAVES;
    for (int m = gw; m < M_; m += NGW) {
        const f32x4* yr = (const f32x4*)(y + (size_t)m * DM) + F.lane; const f32x4* xr = (const f32x4*)(xin + (size_t)m * DM) + F.lane;
        f32x4 v[4], xv[4]; float s = 0.f;
#pragma unroll
        for (int j = 0; j < 4; ++j) { v[j] = yr[64 * j]; xv[j] = xr[64 * j]; s += v[j].x * v[j].x + v[j].y * v[j].y + v[j].z * v[j].z + v[j].w * v[j].w; }
        const float r = rsqrtf(wave_sum(s) * (1.f / DM) + NORM_EPS); float s2 = 0.f;
        f32x4* xo = (f32x4*)(xout + (size_t)m * DM) + F.lane;
#pragma unroll
        for (int j = 0; j < 4; ++j) { const f32x4 wv = ((const f32x4*)wpost)[F.lane + 64 * j]; f32x4 n;
            n.x = xv[j].x + v[j].x * r * wv.x; n.y = xv[j].y + v[j].y * r * wv.y; n.z = xv[j].z + v[j].z * r * wv.z; n.w = xv[j].w + v[j].w * r * wv.w;
            xo[64 * j] = n; v[j] = n; s2 += n.x * n.x + n.y * n.y + n.z * n.z + n.w * n.w; }
        if (hout) { const float r2 = rsqrtf(wave_sum(s2) * (1.f / DM) + NORM_EPS);
            unsigned long long* o8 = (unsigned long long*)(hout + (size_t)m * DM) + F.lane;
#pragma unroll
            for (int j = 0; j < 4; ++j) { const f32x4 wv = ((const f32x4*)wpre)[F.lane + 64 * j];
                o8[64 * j] = (unsigned long long)pk2(v[j].x * r2 * wv.x, v[j].y * r2 * wv.y) | ((unsigned long long)pk2(v[j].z * r2 * wv.z, v[j].w * r2 * wv.w) << 32); } }
    }
}
__device__ __forceinline__ void unpack8(const v4u w, float (&k)[8]) {
    k[0] = __uint_as_float(w.x << 16); k[1] = __uint_as_float(w.x & 0xffff0000u); k[2] = __uint_as_float(w.y << 16); k[3] = __uint_as_float(w.y & 0xffff0000u);
    k[4] = __uint_as_float(w.z << 16); k[5] = __uint_as_float(w.z & 0xffff0000u); k[6] = __uint_as_float(w.w << 16); k[7] = __uint_as_float(w.w & 0xffff0000u);
}
__device__ __forceinline__ void dot4(const LAS float* qs, const bf16* kr, float (&d)[4]) {
    d[0] = d[1] = d[2] = d[3] = 0.f;
#pragma unroll 1
    for (int c = 0; c < 8; ++c) { asm volatile("" ::: "memory"); const v4u w = ((const v4u*)kr)[c]; float k[8]; unpack8(w, k);
#pragma unroll
        for (int e = 0; e < 8; ++e) { const int dd = c * 8 + e;
#pragma unroll
            for (int h = 0; h < 4; ++h) d[h] += qs[h * 64 + dd] * k[e]; } }
}
__device__ __forceinline__ float dot1(const LAS float* qs, const bf16* kr) {
    float d = 0.f;
#pragma unroll
    for (int c = 0; c < 8; ++c) { const v4u w = ((const v4u*)kr)[c]; float k[8]; unpack8(w, k);
#pragma unroll
        for (int e = 0; e < 8; ++e) d += qs[c * 8 + e] * k[e]; }
    return d;
}
__device__ __forceinline__ float gelu_tanh(float x) { const float u = 0.7978845608028654f * (x + 0.044715f * x * x * x); return 0.5f * x * (1.f + tanhf(u)); }

__device__ __forceinline__ void phase2_naive(Frame& F, const Args& a, int l) {
    const int gw = blockIdx.x * NWAVES + F.wave, NGW = F.G * NWAVES, lane = F.lane;
    const bf16* Y = (const bf16*)(a.ws + WS_Y);
    LAS float* scr = (LAS float*)(F.lds + RING_OFF + F.wave * 16384);
    for (int t = gw; t < 2 * 8 * 511; t += NGW) {
        const int kv = t / (8 * 511), r = t % (8 * 511), bg = r / 511, n = r % 511, b = bg >> 1, g = bg & 1;
        const float* pe = a.in[kv ? 8 : 7] + (size_t)l * 32 * 64; const float* w1 = a.in[kv ? 11 : 9] + (size_t)l * 2048 * 64; const float* w2 = a.in[kv ? 12 : 10] + (size_t)l * 64 * 64;
        const bf16* src = Y + ((size_t)b * S_ + 16 * n) * YP + (kv ? Y_AVC : Y_AKC) + g * 64;
        float acc = 0.f;
        for (int pos = 0; pos < 32; ++pos) {
            const float xin = bf2f(src[(size_t)pos * YP + lane]) + pe[pos * 64 + lane];
            scr[lane] = xin; WFENCE();
#pragma unroll 8
            for (int d = 0; d < 64; ++d) acc += scr[d] * w1[(size_t)(pos * 64 + d) * 64 + lane];
            WFENCE();
        }
        const float hdn = gelu_tanh(acc);
        scr[lane] = hdn; WFENCE();
        float o = 0.f;
#pragma unroll 8
        for (int j = 0; j < 64; ++j) o += scr[j] * w2[j * 64 + lane];
        WFENCE();
        bf16* dst = (bf16*)(a.ws + (kv ? WS_VCMP : WS_KCMP)) + ((size_t)bg * 512 + n) * 64;
        dst[lane] = (bf16)f2bf(o);
    }
    for (int t = gw; t < 4 * 8 * 32; t += NGW) {
        const int blk = t & 31, h = (t >> 5) & 7, b = t >> 8;
        const bf16* src = Y + ((size_t)b * S_ + blk * 256) * YP + Y_CK + h * 64 + lane; float s = 0.f;
        for (int i = 0; i < 256; ++i) s += bf2f(src[(size_t)i * YP]);
        ((float*)(a.ws + WS_KMEAN))[(size_t)t * 64 + lane] = s * (1.f / 256.f);
    }
    {
        const float* w2 = a.in[13] + (size_t)l * 16 * 256; const float* bias = a.in[14] + (size_t)l * 256; float* GA = (float*)(a.ws + WS_GA);
        const long NT = (long)M_ * 256, stride = (long)F.G * 512;
        for (long i = (long)blockIdx.x * 512 + F.tid; i < NT; i += stride) {
            const int c = (int)(i & 255); const size_t row = (size_t)(i >> 8);
            float z = bias[c];
#pragma unroll
            for (int r = 0; r < 16; ++r) z += bf2f(Y[row * YP + Y_BLR + r]) * w2[r * 256 + c];
            const float ls = -(fmaxf(-z, 0.f) + log1pf(__expf(-fabsf(z))));
            GA[i] = __expf(ls * (1.f / 16.f));
        }
    }
}
__device__ __forceinline__ void gla_scan_naive(Frame& F, const Args& a) {
    const bf16* Y = (const bf16*)(a.ws + WS_Y); const float* GA = (const float*)(a.ws + WS_GA); bf16* O16 = (bf16*)(a.ws + WS_O16);
    const int lane = F.lane;
    for (int task = blockIdx.x; task < 256; task += F.G) {
        const int eg = task & 15, h = (task >> 4) & 3, b = task >> 6, e = eg * 8 + F.wave;
        float Sst = 0.f;
        for (int t0 = 0; t0 < S_; t0 += 8) {
            float av[8], kv[8], qv[8], vv[8];
#pragma unroll
            for (int j = 0; j < 8; ++j) { const size_t row = (size_t)b * S_ + t0 + j;
                av[j] = GA[row * 256 + h * 64 + lane]; kv[j] = bf2f(Y[row * YP + Y_BK + h * 64 + lane]); qv[j] = bf2f(Y[row * YP + Y_BQ + h * 64 + lane]); vv[j] = bf2f(Y[row * YP + Y_BV + h * 128 + e]); }
#pragma unroll
            for (int j = 0; j < 8; ++j) { Sst = av[j] * Sst + kv[j] * vv[j]; const float o = wave_sum(qv[j] * Sst);
                if (lane == 0) O16[((size_t)b * S_ + t0 + j) * 512 + h * 128 + e] = (bf16)f2bf(o); }
        }
    }
}
__device__ __forceinline__ void nsa_cmp_naive(Frame& F, const Args& a) {
    const int gw = blockIdx.x * NWAVES + F.wave, NGW = F.G * NWAVES, lane = F.lane;
    bf16* Y = (bf16*)(a.ws + WS_Y); const float* rel = a.in[1];
    LAS float* scr = (LAS float*)(F.lds + RING_OFF + F.wave * 16384);
    LAS float* qs = scr; LAS float* sc = scr + 256; LAS float* s2 = scr + 256 + 2048;
    for (int task = gw; task < 8 * S_; task += NGW) {
        const int q = task & (S_ - 1), bg = task >> 13, g = bg & 1, b = bg >> 1;
        const size_t row = (size_t)b * S_ + q; bf16* Yr = Y + row * YP;
#pragma unroll
        for (int h = 0; h < 4; ++h) qs[h * 64 + lane] = bf2f(Yr[Y_AQ + (g * 4 + h) * 64 + lane]);
        float gt[4][3];
#pragma unroll
        for (int h = 0; h < 4; ++h)
#pragma unroll
            for (int br = 0; br < 3; ++br) gt[h][br] = sigm(bf2f(Yr[Y_AG + (g * 4 + h) * 3 + br]));
        WFENCE();
        const int cur = q >> 6, ncv = q >= 31 ? ((q - 31) >> 4) + 1 : 0;
        const bf16* KC = (const bf16*)(a.ws + WS_KCMP) + (size_t)bg * 512 * 64; const bf16* VC = (const bf16*)(a.ws + WS_VCMP) + (size_t)bg * 512 * 64;
        float mx[4] = {-1e30f, -1e30f, -1e30f, -1e30f};
        for (int i = 0; i < 8; ++i) { const int n = lane + 64 * i;
            if (n < ncv) { float d[4]; dot4(qs, KC + (size_t)n * 64, d); const int bk = t5_bucket(q - (16 * n + 31));
#pragma unroll
                for (int h = 0; h < 4; ++h) { const float s = d[h] + rel[bk * 16 + g * 4 + h] * LOG2E; sc[h * 512 + n] = s; mx[h] = fmaxf(mx[h], s); } }
            else {
#pragma unroll
                for (int h = 0; h < 4; ++h) sc[h * 512 + n] = 0.f; } }
        float ls[4] = {0.f, 0.f, 0.f, 0.f};
#pragma unroll
        for (int h = 0; h < 4; ++h) mx[h] = wave_max(mx[h]);
        WFENCE();
        for (int i = 0; i < 8; ++i) { const int n = lane + 64 * i;
            if (n < ncv) {
#pragma unroll
                for (int h = 0; h < 4; ++h) { const float e = exp2f(sc[h * 512 + n] - mx[h]); sc[h * 512 + n] = e; ls[h] += e; } } }
#pragma unroll
        for (int h = 0; h < 4; ++h) ls[h] = 1.f / fmaxf(wave_sum(ls[h]), 1e-20f);
        for (int i = 0; i < 8; ++i) { const int n = lane + 64 * i;
            if (n < ncv) {
#pragma unroll
                for (int h = 0; h < 4; ++h) sc[h * 512 + n] *= ls[h]; } }
        WFENCE();
        float v0, v1;
        { float t[2];
#pragma unroll
          for (int jj = 0; jj < 2; ++jj) { const int j = lane + 64 * jj; float v = 0.f;
              for (int n = 4 * j - 1; n <= 4 * j + 3; ++n) if (n >= 0 && n < 511) v += (sc[n] + sc[512 + n]) + (sc[1024 + n] + sc[1536 + n]);
              const bool forced = (j == 0) || (j == cur) || (j == cur - 1);
              t[jj] = forced ? 1e9f : (j <= cur ? v : -1e30f); }
          v0 = t[0]; v1 = t[1]; }
        bool sel0 = false, sel1 = false;
        for (int it = 0; it < 16; ++it) {
            const float c0 = sel0 ? -INFINITY : v0, c1 = sel1 ? -INFINITY : v1;
            const float mxv = wave_max(fmaxf(c0, c1));
            const unsigned long long m0 = __ballot(!sel0 && v0 == mxv);
            if (m0) { const int idx = __builtin_ctzll(m0); if (lane == idx) sel0 = true; }
            else { const unsigned long long m1 = __ballot(!sel1 && v1 == mxv); const int idx = m1 ? __builtin_ctzll(m1) : -1; if (lane == idx) sel1 = true; }
        }
        sel0 = sel0 && (lane <= cur); sel1 = sel1 && (lane + 64 <= cur);
        const unsigned long long sm0 = __ballot(sel0), sm1 = __ballot(sel1);
        float oc[4] = {0.f, 0.f, 0.f, 0.f};
        for (int n = 0; n < ncv; ++n) { const float vv = bf2f(VC[(size_t)n * 64 + lane]);
#pragma unroll
            for (int h = 0; h < 4; ++h) oc[h] += sc[h * 512 + n] * vv; }
        { unsigned* MK = (unsigned*)(a.ws + WS_MASK) + ((size_t)bg * S_ + q) * 4;
          if (lane == 0) { MK[0] = (unsigned)sm0; MK[1] = (unsigned)(sm0 >> 32); MK[2] = (unsigned)sm1; MK[3] = (unsigned)(sm1 >> 32); }
          bf16* T = (bf16*)(a.ws + WS_OATMP) + row * 512;
#pragma unroll
          for (int h = 0; h < 4; ++h) T[(g * 4 + h) * 64 + lane] = (bf16)f2bf(gt[h][0] * oc[h]); }
        WFENCE();
    }
}
__device__ __forceinline__ void nsa_naive(Frame& F, const Args& a) {
    const int gw = blockIdx.x * NWAVES + F.wave, NGW = F.G * NWAVES, lane = F.lane;
    bf16* Y = (bf16*)(a.ws + WS_Y); const float* rel = a.in[1];
    LAS float* scr = (LAS float*)(F.lds + RING_OFF + F.wave * 16384);
    LAS float* qs = scr; LAS float* sc = scr + 256; LAS float* s2 = scr + 256 + 2048;
    for (int task = gw; task < 8 * S_; task += NGW) {
        const int q = task & (S_ - 1), bg = task >> 13, g = bg & 1, b = bg >> 1;
        const size_t row = (size_t)b * S_ + q; bf16* Yr = Y + row * YP;
#pragma unroll
        for (int h = 0; h < 4; ++h) qs[h * 64 + lane] = bf2f(Yr[Y_AQ + (g * 4 + h) * 64 + lane]);
        float gt[4][3];
#pragma unroll
        for (int h = 0; h < 4; ++h)
#pragma unroll
            for (int br = 0; br < 3; ++br) gt[h][br] = sigm(bf2f(Yr[Y_AG + (g * 4 + h) * 3 + br]));
        WFENCE();
        const int cur = q >> 6, ncv = q >= 31 ? ((q - 31) >> 4) + 1 : 0;
        const bf16* KC = (const bf16*)(a.ws + WS_KCMP) + (size_t)bg * 512 * 64; const bf16* VC = (const bf16*)(a.ws + WS_VCMP) + (size_t)bg * 512 * 64;
        float mx[4] = {-1e30f, -1e30f, -1e30f, -1e30f};
        for (int i = 0; i < 8; ++i) { const int n = lane + 64 * i;
            if (n < ncv) { float d[4]; dot4(qs, KC + (size_t)n * 64, d); const int bk = t5_bucket(q - (16 * n + 31));
#pragma unroll
                for (int h = 0; h < 4; ++h) { const float s = d[h] + rel[bk * 16 + g * 4 + h] * LOG2E; sc[h * 512 + n] = s; mx[h] = fmaxf(mx[h], s); } }
            else {
#pragma unroll
                for (int h = 0; h < 4; ++h) sc[h * 512 + n] = 0.f; } }
        float ls[4] = {0.f, 0.f, 0.f, 0.f};
#pragma unroll
        for (int h = 0; h < 4; ++h) mx[h] = wave_max(mx[h]);
        WFENCE();
        for (int i = 0; i < 8; ++i) { const int n = lane + 64 * i;
            if (n < ncv) {
#pragma unroll
                for (int h = 0; h < 4; ++h) { const float e = exp2f(sc[h * 512 + n] - mx[h]); sc[h * 512 + n] = e; ls[h] += e; } } }
#pragma unroll
        for (int h = 0; h < 4; ++h) ls[h] = 1.f / fmaxf(wave_sum(ls[h]), 1e-20f);
        for (int i = 0; i < 8; ++i) { const int n = lane + 64 * i;
            if (n < ncv) {
#pragma unroll
                for (int h = 0; h < 4; ++h) sc[h * 512 + n] *= ls[h]; } }
        WFENCE();
        float v0, v1;
        { float t[2];
#pragma unroll
          for (int jj = 0; jj < 2; ++jj) { const int j = lane + 64 * jj; float v = 0.f;
              for (int n = 4 * j - 1; n <= 4 * j + 3; ++n) if (n >= 0 && n < 511) v += (sc[n] + sc[512 + n]) + (sc[1024 + n] + sc[1536 + n]);
              const bool forced = (j == 0) || (j == cur) || (j == cur - 1);
              t[jj] = forced ? 1e9f : (j <= cur ? v : -1e30f); }
          v0 = t[0]; v1 = t[1]; }
        bool sel0 = false, sel1 = false;
        for (int it = 0; it < 16; ++it) {
            const float c0 = sel0 ? -INFINITY : v0, c1 = sel1 ? -INFINITY : v1;
            const float mxv = wave_max(fmaxf(c0, c1));
            const unsigned long long m0 = __ballot(!sel0 && v0 == mxv);
            if (m0) { const int idx = __builtin_ctzll(m0); if (lane == idx) sel0 = true; }
            else { const unsigned long long m1 = __ballot(!sel1 && v1 == mxv); const int idx = m1 ? __builtin_ctzll(m1) : -1; if (lane == idx) sel1 = true; }
        }
        sel0 = sel0 && (lane <= cur); sel1 = sel1 && (lane + 64 <= cur);
        const unsigned long long sm0 = __ballot(sel0), sm1 = __ballot(sel1);
        float oc[4] = {0.f, 0.f, 0.f, 0.f};
        for (int n = 0; n < ncv; ++n) { const float vv = bf2f(VC[(size_t)n * 64 + lane]);
#pragma unroll
            for (int h = 0; h < 4; ++h) oc[h] += sc[h * 512 + n] * vv; }
        float ms[4] = {-1e30f, -1e30f, -1e30f, -1e30f}, lsel[4] = {0.f, 0.f, 0.f, 0.f}, os[4] = {0.f, 0.f, 0.f, 0.f};
        for (int j = 0; j <= cur; ++j) {
            const bool on = j < 64 ? ((sm0 >> j) & 1ull) : ((sm1 >> (j - 64)) & 1ull);
            if (!on) continue;
            const int kpos = 64 * j + lane; const bool valid = kpos <= q;
            float d[4]; dot4(qs, Y + ((size_t)b * S_ + kpos) * YP + Y_AKS + g * 64, d);
            const int bk = t5_bucket(q - kpos);
            WFENCE();
#pragma unroll
            for (int h = 0; h < 4; ++h) { const float s = valid ? d[h] + rel[bk * 16 + g * 4 + h] * LOG2E : -1e30f;
                const float mn = fmaxf(ms[h], wave_max(s)); const float p = valid ? exp2f(s - mn) : 0.f; s2[h * 64 + lane] = p;
                const float scl = exp2f(ms[h] - mn); lsel[h] = lsel[h] * scl + wave_sum(p); os[h] *= scl; ms[h] = mn; }
            WFENCE();
            const bf16* vb = Y + ((size_t)b * S_ + 64 * j) * YP + Y_AVS + g * 64 + lane;
            for (int kk = 0; kk < 64; ++kk) { const float vv = bf2f(vb[(size_t)kk * YP]);
#pragma unroll
                for (int h = 0; h < 4; ++h) os[h] += s2[h * 64 + kk] * vv; }
        }
        float mw[4] = {-1e30f, -1e30f, -1e30f, -1e30f}, lw[4] = {0.f, 0.f, 0.f, 0.f}, ow[4] = {0.f, 0.f, 0.f, 0.f};
        for (int c = 0; c < 8; ++c) {
            if (q - 64 * c < 0) break;
            const int dist = 64 * c + lane, kpos = q - dist; const bool valid = kpos >= 0;
            float d[4]; dot4(qs, Y + ((size_t)b * S_ + (valid ? kpos : 0)) * YP + Y_AKW + g * 64, d);
            const int bk = t5_bucket(dist);
            WFENCE();
#pragma unroll
            for (int h = 0; h < 4; ++h) { const float s = valid ? d[h] + rel[bk * 16 + g * 4 + h] * LOG2E : -1e30f;
                const float mn = fmaxf(mw[h], wave_max(s)); const float p = valid ? exp2f(s - mn) : 0.f; s2[h * 64 + lane] = p;
                const float scl = exp2f(mw[h] - mn); lw[h] = lw[h] * scl + wave_sum(p); ow[h] *= scl; mw[h] = mn; }
            WFENCE();
            for (int kk = 0; kk < 64; ++kk) { const int kp = q - 64 * c - kk; if (kp < 0) break;
                const float vv = bf2f(Y[((size_t)b * S_ + kp) * YP + Y_AVW + g * 64 + lane]);
#pragma unroll
                for (int h = 0; h < 4; ++h) ow[h] += s2[h * 64 + kk] * vv; }
        }
        WFENCE();
#pragma unroll
        for (int h = 0; h < 4; ++h) { const float o = gt[h][0] * oc[h] + gt[h][1] * os[h] / fmaxf(lsel[h], 1e-20f) + gt[h][2] * ow[h] / fmaxf(lw[h], 1e-20f);
            Yr[Y_AQ + (g * 4 + h) * 64 + lane] = (bf16)f2bf(o); }
    }
}
__device__ __forceinline__ void moba_naive(Frame& F, const Args& a) {
    const int gw = blockIdx.x * NWAVES + F.wave, NGW = F.G * NWAVES, lane = F.lane;
    bf16* Y = (bf16*)(a.ws + WS_Y); const float* rel = a.in[1]; const float* KM = (const float*)(a.ws + WS_KMEAN);
    LAS float* scr = (LAS float*)(F.lds + RING_OFF + F.wave * 16384);
    LAS float* qs = scr; LAS float* s2 = scr + 64;
    for (int task = gw; task < 32 * S_; task += NGW) {
        const int q = task & (S_ - 1), bh = task >> 13, h = bh & 7, b = bh >> 3;
        const size_t row = (size_t)b * S_ + q; bf16* Yr = Y + row * YP;
        WFENCE();
        qs[lane] = bf2f(Yr[Y_CQ + h * 64 + lane]);
        WFENCE();
        const int cur = q >> 8;
        float gs = -1e30f;
        if (lane < 32 && lane < cur) { const float* km = KM + ((size_t)bh * 32 + lane) * 64; float d = 0.f;
            for (int dd = 0; dd < 64; ++dd) d += qs[dd] * km[dd];
            gs = d; }
        if (lane >= 32) gs = -INFINITY;
        bool sel = false;
        for (int it = 0; it < 3; ++it) { const float c = sel ? -INFINITY : gs; const float mxv = wave_max(c);
            const unsigned long long m0 = __ballot(!sel && lane < 32 && gs == mxv); const int idx = m0 ? __builtin_ctzll(m0) : -1; if (lane == idx) sel = true; }
        sel = sel && (lane < cur);
        const unsigned smask = (unsigned)__ballot(sel);
        float mr = -1e30f, lr = 0.f, o = 0.f;
        for (int j = 0; j <= cur; ++j) {
            const bool own = (j == cur);
            if (!own && !((smask >> j) & 1u)) continue;
            for (int c = 0; c < 4; ++c) {
                const int kpos = 256 * j + 64 * c + lane; const bool valid = kpos <= q;
                if (256 * j + 64 * c > q) break;
                const float d = dot1(qs, Y + ((size_t)b * S_ + kpos) * YP + Y_CK + h * 64);
                const int bk = t5_bucket(q - kpos);
                const float s = valid ? d + rel[bk * 16 + 8 + h] * LOG2E : -1e30f;
                const float mn = fmaxf(mr, wave_max(s)); const float p = valid ? exp2f(s - mn) : 0.f;
                WFENCE(); s2[lane] = p; WFENCE();
                const float scl = exp2f(mr - mn); lr = lr * scl + wave_sum(p); o *= scl; mr = mn;
                const bf16* vb = Y + ((size_t)b * S_ + 256 * j + 64 * c) * YP + Y_CV + h * 64 + lane;
                for (int kk = 0; kk < 64; ++kk) o += s2[kk] * bf2f(vb[(size_t)kk * YP]);
            }
        }
        Yr[Y_CQ + h * 64 + lane] = (bf16)f2bf(o / fmaxf(lr, 1e-20f));
    }
}
constexpr int CW_Q = 8192;
__device__ __forceinline__ int next_unit(Frame& F, int k) {
    __syncthreads();
    if (F.tid == 0) F.MISC[16] = __hip_atomic_fetch_add(F.ctl + CW_Q + 64 * k, 1u, RLX_AGENT);
    __syncthreads();
    return (int)F.MISC[16];
}
__device__ __forceinline__ void moba_fast(Frame& F, const Args& a, int qk) {
    bf16* Y = (bf16*)(a.ws + WS_Y); const float* KM = (const float*)(a.ws + WS_KMEAN);
    for (;;) {
        const int u = next_unit(F, qk); if (u >= 1024) break;
        const int qb = 31 - (u >> 5), bh = u & 31, b = bh >> 3, h = bh & 7; const long rowbase = (long)b * S_;
        attn::UArgs U{};
        U.Qb = Y + (rowbase + qb * 256) * YP + Y_CQ + h * 64; U.Kh = Y + rowbase * YP + Y_CK + h * 64; U.Vh = Y + rowbase * YP + Y_CV + h * 64; U.Ob = Y + (rowbase + qb * 256) * YP + Y_CQ + h * 64;
        U.NT = 4 * (qb + 1); U.q0 = qb * 256; U.kt0 = 0; U.hc = 8 + h; U.rel = a.in[1]; U.km = KM + (size_t)bh * 32 * 64; U.qb = qb;
        attn::attn_unit<0, 0, 8>(U, (char*)F.lds + RING_OFF);
    }
}
__device__ __forceinline__ void nsa_fast(Frame& F, const Args& a, int qk) {
    bf16* Y = (bf16*)(a.ws + WS_Y);
    for (;;) {
        const int u = next_unit(F, qk); if (u >= 1024) break;
        const int qb = 31 - (u >> 5), bh = u & 31, b = bh >> 3, h = bh & 7, g = h >> 2; const long rowbase = (long)b * S_; const int q0 = qb * 256;
        attn::UArgs U{};
        U.Qb = Y + (rowbase + q0) * YP + Y_AQ + h * 64; U.Ob = Y + (rowbase + q0) * YP + Y_AQ + h * 64; U.q0 = q0; U.hc = h; U.rel = a.in[1]; U.gate = Y + (rowbase + q0) * YP;
        { const int T0 = 4 * qb - 8 > 0 ? 4 * qb - 8 : 0;
          U.Kh = Y + (rowbase + 64 * T0) * YP + Y_AKW + g * 64; U.Vh = Y + (rowbase + 64 * T0) * YP + Y_AVW + g * 64; U.NT = 4 * qb + 4 - T0; U.kt0 = 64 * T0; U.gcol = Y_AG + h * 3 + 2;
          attn::attn_unit<2, 1, 8>(U, (char*)F.lds + RING_OFF); }
        { U.Kh = Y + rowbase * YP + Y_AKS + g * 64; U.Vh = Y + rowbase * YP + Y_AVS + g * 64; U.NT = 4 * (qb + 1); U.kt0 = 0; U.gcol = Y_AG + h * 3 + 1;
          U.selg = (const unsigned*)(a.ws + WS_MASK) + ((size_t)(b * 2 + g) * S_ + q0) * 4; U.tmp = (const bf16*)(a.ws + WS_OATMP) + (rowbase + q0) * 512 + h * 64;
          attn::attn_unit<1, 2, 8>(U, (char*)F.lds + RING_OFF); }
    }
}
__device__ __forceinline__ void gla_out_naive(Frame& F, const Args& a, int l) {
    const int gw = blockIdx.x * NWAVES + F.wave, NGW = F.G * NWAVES, lane = F.lane;
    bf16* Y = (bf16*)(a.ws + WS_Y); const bf16* O16 = (const bf16*)(a.ws + WS_O16); const float* nw = a.in[15] + (size_t)l * 128;
    for (int t = gw; t < M_ * 4; t += NGW) {
        const int h = t & 3; const size_t row = (size_t)(t >> 2);
        const float o0 = bf2f(O16[row * 512 + h * 128 + lane]), o1 = bf2f(O16[row * 512 + h * 128 + 64 + lane]);
        const float r = rsqrtf(wave_sum(o0 * o0 + o1 * o1) * (1.f / 128.f) + NORM_EPS);
        bf16* yr = Y + row * YP + Y_BR + h * 128;
        const float r0 = bf2f(yr[lane]), r1 = bf2f(yr[64 + lane]);
        yr[lane] = (bf16)f2bf(o0 * r * nw[lane] * (r0 * sigm(r0))); yr[64 + lane] = (bf16)f2bf(o1 * r * nw[64 + lane] * (r1 * sigm(r1)));
    }
}

constexpr int PPL = 11, NPH = NL * PPL;
#define IN(k) (lo <= (k) && (k) < hi)
#define SEAM(k) do { if (IN(k) && IN((k) + 1)) xcd_barrier(bar); } while (0)
template <int l> __device__ __forceinline__ void layer_body(Frame& F, const Args& args, const XcdBarrier& bar, const int lo, const int hi) {
    unsigned char* ws = args.ws;
    bf16* H = (bf16*)(ws + WS_H); bf16* Y = (bf16*)(ws + WS_Y); unsigned char* G8 = ws + WS_G8;
    float* Yf = (float*)(ws + WS_Y); bf16* ACT = (bf16*)(ws + WS_ACT);
    constexpr int p0 = l * PPL;
    const float* xin = l == 0 ? args.in[0] : args.out;
    if (IN(p0 + 0)) { phase_weights(F, args, l); if (l == 0) phase_norm0(F, args.in[0], args.in[2], H); SEAM(p0 + 0); }
    if (IN(p0 + 1)) {
        pg8::Gemm g{H, (const bf16*)(ws + WS_WIN), M_, NIN, DM, DM}; pg8::StaticOrder So; So.init(M_, NIN, F.G, (int)blockIdx.x);
        pg8::EpiInProj E{Y, G8};
        pg8::gemm_phase<pg8::EpiInProj, pg8::StaticOrder, true, true>(F.lds + RING_OFF, g, So, E);
        SEAM(p0 + 1);
    }
    if (IN(p0 + 2)) { phase2_naive(F, args, l); SEAM(p0 + 2); }
    if (IN(p0 + 3)) { gla_scan_naive(F, args); nsa_cmp_naive(F, args); moba_fast(F, args, l * 4 + 0); SEAM(p0 + 3); }
    if (IN(p0 + 4)) { nsa_fast(F, args, l * 4 + 1); gla_out_naive(F, args, l); SEAM(p0 + 4); }
    if (IN(p0 + 5)) {
        pg8::StaticOrder So; So.init(M_, DM, F.G, (int)blockIdx.x);
        { pg8::Gemm g{Y + Y_AQ, (const bf16*)(ws + WS_WA), M_, DM, 512, YP}; pg8::EpiMerge<0> E{H, G8}; pg8::gemm_phase<pg8::EpiMerge<0>, pg8::StaticOrder, true, true>(F.lds + RING_OFF, g, So, E); }
        __syncthreads();
        { pg8::Gemm g{Y + Y_BR, (const bf16*)(ws + WS_WB), M_, DM, 512, YP}; pg8::EpiMerge<1> E{H, G8}; pg8::gemm_phase<pg8::EpiMerge<1>, pg8::StaticOrder, true, true>(F.lds + RING_OFF, g, So, E); }
        __syncthreads();
        { pg8::Gemm g{Y + Y_CQ, (const bf16*)(ws + WS_WC), M_, DM, 512, YP}; pg8::EpiMerge<2> E{H, G8}; pg8::gemm_phase<pg8::EpiMerge<2>, pg8::StaticOrder, true, true>(F.lds + RING_OFF, g, So, E); }
        SEAM(p0 + 5);
    }
    if (IN(p0 + 6)) {
        pg8::Gemm g{H, (const bf16*)(ws + WS_WO), M_, DM, DM, DM}; pg8::StaticOrder So; So.init(M_, DM, F.G, (int)blockIdx.x);
        pg8::EpiF32 E{Yf, DM}; pg8::gemm_phase<pg8::EpiF32, pg8::StaticOrder, true, true>(F.lds + RING_OFF, g, So, E);
        SEAM(p0 + 6);
    }
    if (IN(p0 + 7)) { phase_resid(F, Yf, xin, args.out, args.in[3] + (size_t)l * DM, args.in[4] + (size_t)l * DM, H); SEAM(p0 + 7); }
    if (IN(p0 + 8)) {
        pg8::Gemm g{H, (const bf16*)(ws + WS_WF1), M_, 2 * FF, DM, DM}; pg8::StaticOrder So; So.init(M_, 2 * FF, F.G, (int)blockIdx.x);
        pg8::EpiSwiglu E{ACT, FF}; pg8::gemm_phase<pg8::EpiSwiglu, pg8::StaticOrder, true, true>(F.lds + RING_OFF, g, So, E);
        SEAM(p0 + 8);
    }
    if (IN(p0 + 9)) {
        pg8::Gemm g{ACT, (const bf16*)(ws + WS_WF2), M_, DM, FF, FF}; pg8::StaticOrder So; So.init(M_, DM, F.G, (int)blockIdx.x);
        pg8::EpiF32 E{Yf, DM}; pg8::gemm_phase<pg8::EpiF32, pg8::StaticOrder, true, true>(F.lds + RING_OFF, g, So, E);
        SEAM(p0 + 9);
    }
    if (IN(p0 + 10)) { phase_resid(F, Yf, args.out, args.out, args.in[5] + (size_t)l * DM, l + 1 < NL ? args.in[2] + (size_t)(l + 1) * DM : nullptr, l + 1 < NL ? H : nullptr); SEAM(p0 + 10); }
}
__global__ void __launch_bounds__(NWAVES * 64, 2) mk_fwd(Args args) {
    extern __shared__ __attribute__((aligned(16))) unsigned char lds[];
    Frame F;
    F.lds = (LAS unsigned char*)lds; F.MISC = (volatile LAS unsigned*)(F.lds + MISC_OFF);
    F.tid = threadIdx.x; F.lane = F.tid & 63; F.wave = __builtin_amdgcn_readfirstlane(F.tid >> 6); F.G = gridDim.x;
    F.ctl = (gu32*)(args.ws + WS_CTL);
    for (int u = F.tid; u < (LDS_BYTES - LDSCTL_OFF) / 4; u += NWAVES * 64) ((LAS unsigned*)(F.lds + LDSCTL_OFF))[u] = 0u;
    __syncthreads();
    const int lo = args.ph_lo, hi = args.ph_hi;
    XcdBarrier bar; bar.bar = (unsigned*)(F.ctl + CW_BAR); bar.x = 0; bar.st = nullptr;
    if (hi - lo > 1) bar = xcd_barrier_post((unsigned*)(F.ctl + CW_BAR), F.MISC + 8);
    layer_body<0>(F, args, bar, lo, hi);
    layer_body<1>(F, args, bar, lo, hi);
}
#undef IN
#undef SEAM

#ifndef MK_ONE_LAUNCH
#define MK_ONE_LAUNCH 1
#endif
extern "C" void kernel_launch(void* const* d_in, const int* in_sizes, int n_in, void* d_out, int out_size, void* d_ws, size_t ws_size, hipStream_t stream) {
    static int grid = 0;
    if (grid == 0) {
        if (n_in != 22 || out_size != M_ * DM || ws_size < WS_END) { fprintf(stderr, "kernel_launch: unexpected sizes (n_in %d out %d ws %zu)\n", n_in, out_size, ws_size); grid = -1; return; }
        int dev = 0, cus = 0;
        if (hipGetDevice(&dev) != hipSuccess || hipDeviceGetAttribute(&cus, hipDeviceAttributeMultiprocessorCount, dev) != hipSuccess) { grid = -1; return; }
        if (hipFuncSetAttribute((const void*)mk_fwd, hipFuncAttributeMaxDynamicSharedMemorySize, LDS_BYTES) != hipSuccess) { grid = -1; return; }
        (void)hipGetLastError();
        grid = cus;
    }
    if (grid < 0) return;
    if (hipMemsetAsync((char*)d_ws + WS_CTL, 0, CTL_ZERO_BYTES, stream) != hipSuccess) return;
    Args a{};
    for (int i = 0; i < 22; ++i) a.in[i] = (const float*)d_in[i];
    a.out = (float*)d_out; a.ws = (unsigned char*)d_ws;
#if MK_ONE_LAUNCH
    a.ph_lo = 0; a.ph_hi = NPH;
    hipLaunchKernelGGL(mk_fwd, dim3(grid), dim3(NWAVES * 64), LDS_BYTES, stream, a);
#else
    for (int p = 0; p < NPH; ++p) { a.ph_lo = p; a.ph_hi = p + 1; hipLaunchKernelGGL(mk_fwd, dim3(grid), dim3(NWAVES * 64), LDS_BYTES, stream, a); }
#endif
}
```

```cpp
#include <hip/hip_runtime.h>
#include <cstdio>
#include <cstdint>
#include <cmath>
namespace pg8 {
#define PG8_LAS __attribute__((address_space(3)))
typedef unsigned short bf16_t;
typedef short bf16x8 __attribute__((ext_vector_type(8)));
typedef float f32x4 __attribute__((ext_vector_type(4)));
typedef unsigned u32x4 __attribute__((ext_vector_type(4)));
constexpr int BM = 256, BK = 64, HALF = 128, HTB = HALF * BK * 2  , STAGE_BYTES = 8 * HTB, NXCD = 8, WGM = 8;

__host__ __device__ __forceinline__ int lds_byte(int r, int c) { const int st = (r >> 4) * 2 + (c >> 5), rr = r & 15, cc = c & 31, ob = rr * 64 + cc * 2; return st * 1024 + (ob ^ (((ob >> 9) & 1) << 5)); }
__host__ __device__ __forceinline__ void stage_rc(int b, int& R, int& C) { const int st = b / 1024, sb = b % 1024, swz = sb ^ (((sb >> 9) & 1) << 5); R = (st >> 1) * 16 + swz / 64; C = (st & 1) * 32 + (swz % 64) / 2; }
__host__ __device__ __forceinline__ int perm32(int rho) { const int n = rho >> 4, i = rho & 15; return 8 * (i >> 2) + 4 * n + (i & 3); }

struct Unit { int pm, pn; };
struct Gemm { const bf16_t* A; const bf16_t* Bt; int M, N, K, lda; };

struct StaticOrder {
    int nM, nN, nwg, G, c;
    __host__ __device__ void init(int M, int N, int G_, int c_) { nM = M / BM; nN = N / BM; nwg = nM * nN; G = G_; c = c_; }
    __host__ __device__ bool next(int i, Unit& u) const {
        const long L = (long)i * G + c; if (L >= nwg) return false;
        int wgid = (int)L; { const int q = nwg / NXCD, r = nwg % NXCD, xcd = wgid % NXCD, off = wgid / NXCD; wgid = (xcd < r ? xcd * (q + 1) : r * (q + 1) + (xcd - r) * q) + off; }
        const int nig = WGM * nN, gid = wgid / nig, fm = gid * WGM, gsz = (nM - fm) < WGM ? (nM - fm) : WGM;
        u.pm = fm + ((wgid % nig) % gsz); u.pn = (wgid % nig) / gsz; return true;
    }
    __device__ __forceinline__ void a_ready(const Unit&) const {}
    __device__ __forceinline__ void done(const Unit&) const {}
};

__device__ __forceinline__ unsigned cvt_pk_bf16(float lo, float hi) { unsigned r; asm volatile("v_cvt_pk_bf16_f32 %0, %1, %2" : "=v"(r) : "v"(lo), "v"(hi)); return r; }
typedef float f32x2 __attribute__((ext_vector_type(2)));
constexpr int YP_ = 4392;
constexpr float C2_ = 0.125f * 1.4426950408889634f;
__device__ __forceinline__ float sigmoidf_(float v) { return 1.f / (1.f + __expf(-v)); }
struct EpiInProj {
    static constexpr bool PERM = true, AFTER_DRAIN = false;
    bf16_t* Y; unsigned char* G8;
    __device__ __forceinline__ void operator()(const f32x4 (&acc)[2][2][4][2], const Unit& u, int wr, int wc, int fr, int fq) const {
        const int row0 = u.pm * BM + wr * 64 + fr, colt = u.pn * BM, cin = wc * 32 + 8 * fq;
        if (u.pn < 18) {
            float sc = 1.f; if (u.pn < 2 || u.pn == 5 || u.pn == 6) sc = C2_; else if (u.pn == 11) sc = 0.125f;
#pragma unroll
            for (int ai = 0; ai < 2; ++ai)
#pragma unroll
                for (int m = 0; m < 4; ++m) { bf16_t* rowp = Y + (size_t)(row0 + ai * HALF + m * 16) * YP_;
#pragma unroll
                    for (int bj = 0; bj < 2; ++bj) { const int col = colt + cin + bj * HALF;
                        if (col + 8 <= YP_) { const f32x4 v0 = acc[ai][bj][m][0] * sc, v1 = acc[ai][bj][m][1] * sc; u32x4 w;
                            w.x = cvt_pk_bf16(v0[0], v0[1]); w.y = cvt_pk_bf16(v0[2], v0[3]); w.z = cvt_pk_bf16(v1[0], v1[1]); w.w = cvt_pk_bf16(v1[2], v1[3]);
                            *(u32x4*)(rowp + col) = w; } } }
        } else {
#pragma unroll
            for (int ai = 0; ai < 2; ++ai)
#pragma unroll
                for (int m = 0; m < 4; ++m) { unsigned char* rowp = G8 + (size_t)(row0 + ai * HALF + m * 16) * 3072 + (colt - 4608) + cin;
#pragma unroll
                    for (int bj = 0; bj < 2; ++bj) { const f32x4 v0 = acc[ai][bj][m][0], v1 = acc[ai][bj][m][1]; unsigned lo = 0u, hi = 0u;
#pragma unroll
                        for (int e = 0; e < 4; ++e) { lo |= (unsigned)(sigmoidf_(v0[e]) * 255.f + 0.5f) << (8 * e); hi |= (unsigned)(sigmoidf_(v1[e]) * 255.f + 0.5f) << (8 * e); }
                        typedef unsigned u32x2 __attribute__((ext_vector_type(2))); u32x2 w; w.x = lo; w.y = hi; *(u32x2*)(rowp + bj * HALF) = w; } }
        }
    }
};
template <int I> struct EpiMerge {
    static constexpr bool PERM = true, AFTER_DRAIN = false;
    bf16_t* Mg; const unsigned char* G8;
    __device__ __forceinline__ void operator()(const f32x4 (&acc)[2][2][4][2], const Unit& u, int wr, int wc, int fr, int fq) const {
        const int row0 = u.pm * BM + wr * 64 + fr, col0 = u.pn * BM + wc * 32 + 8 * fq;
#pragma unroll
        for (int ai = 0; ai < 2; ++ai)
#pragma unroll
            for (int m = 0; m < 4; ++m) { const size_t row = (size_t)(row0 + ai * HALF + m * 16);
#pragma unroll
                for (int bj = 0; bj < 2; ++bj) { const int col = col0 + bj * HALF;
                    typedef unsigned u32x2 __attribute__((ext_vector_type(2)));
                    const u32x2 gw = *(const u32x2*)(G8 + row * 3072 + I * 1024 + col);
                    float v[8];
#pragma unroll
                    for (int e = 0; e < 4; ++e) { v[e] = acc[ai][bj][m][0][e] * ((float)((gw.x >> (8 * e)) & 255u) * (1.f / 255.f)); v[4 + e] = acc[ai][bj][m][1][e] * ((float)((gw.y >> (8 * e)) & 255u) * (1.f / 255.f)); }
                    bf16_t* p = Mg + row * 1024 + col;
                    if (I > 0) { const u32x4 o = *(const u32x4*)p;
                        v[0] += __uint_as_float(o.x << 16); v[1] += __uint_as_float(o.x & 0xffff0000u); v[2] += __uint_as_float(o.y << 16); v[3] += __uint_as_float(o.y & 0xffff0000u);
                        v[4] += __uint_as_float(o.z << 16); v[5] += __uint_as_float(o.z & 0xffff0000u); v[6] += __uint_as_float(o.w << 16); v[7] += __uint_as_float(o.w & 0xffff0000u); }
                    u32x4 w; w.x = cvt_pk_bf16(v[0], v[1]); w.y = cvt_pk_bf16(v[2], v[3]); w.z = cvt_pk_bf16(v[4], v[5]); w.w = cvt_pk_bf16(v[6], v[7]);
                    *(u32x4*)p = w; } }
    }
};
struct EpiF32 {
    static constexpr bool PERM = true, AFTER_DRAIN = false;
    float* O; int ldc;
    __device__ __forceinline__ void operator()(const f32x4 (&acc)[2][2][4][2], const Unit& u, int wr, int wc, int fr, int fq) const {
        const int row0 = u.pm * BM + wr * 64 + fr, col0 = u.pn * BM + wc * 32 + 8 * fq;
#pragma unroll
        for (int ai = 0; ai < 2; ++ai)
#pragma unroll
            for (int m = 0; m < 4; ++m) { float* rowp = O + (size_t)(row0 + ai * HALF + m * 16) * ldc + col0;
#pragma unroll
                for (int bj = 0; bj < 2; ++bj) { *(f32x4*)(rowp + bj * HALF) = acc[ai][bj][m][0]; *(f32x4*)(rowp + bj * HALF + 4) = acc[ai][bj][m][1]; } }
    }
};
struct EpiSwiglu {
    static constexpr bool PERM = true, AFTER_DRAIN = false;
    bf16_t* Act; int ldc;
    __device__ __forceinline__ void operator()(const f32x4 (&acc)[2][2][4][2], const Unit& u, int wr, int wc, int fr, int fq) const {
        const int row0 = u.pm * BM + wr * 64 + fr, col0 = u.pn * HALF + wc * 32 + 8 * fq;
#pragma unroll
        for (int ai = 0; ai < 2; ++ai)
#pragma unroll
            for (int m = 0; m < 4; ++m) { bf16_t* p = Act + (size_t)(row0 + ai * HALF + m * 16) * ldc + col0; float v[8];
#pragma unroll
                for (int e = 0; e < 4; ++e) { const float g0 = acc[ai][0][m][0][e], g1 = acc[ai][0][m][1][e];
                    v[e] = g0 * sigmoidf_(g0) * acc[ai][1][m][0][e]; v[4 + e] = g1 * sigmoidf_(g1) * acc[ai][1][m][1][e]; }
                u32x4 w; w.x = cvt_pk_bf16(v[0], v[1]); w.y = cvt_pk_bf16(v[2], v[3]); w.z = cvt_pk_bf16(v[4], v[5]); w.w = cvt_pk_bf16(v[6], v[7]);
                *(u32x4*)p = w; }
    }
};
template <class Epi, class Sched, bool ALIGN_EPI = false, bool SP2 = false>
__device__ __forceinline__ void gemm_phase(PG8_LAS unsigned char* lds, const Gemm g, const Sched& S, const Epi& E) {
    const int tid = threadIdx.x, wid = __builtin_amdgcn_readfirstlane(tid >> 6), lane = tid & 63, wr = wid >> 2, wc = wid & 3, fr = lane & 15, fq = lane >> 4;
    const int K = g.K, nt = K / BK;
    unsigned voffA[2], voffB[2];
#pragma unroll
    for (int i = 0; i < 2; ++i) { int R, C; stage_rc(tid * 16 + i * 8192, R, C); const int Rb = Epi::PERM ? ((R & ~31) + perm32(R & 31)) : R;
        voffA[i] = (unsigned)(R * g.lda + C) * 2u; voffB[i] = (unsigned)(Rb * K + C) * 2u; }
    const size_t kstep = (size_t)(BK * 2);
    const size_t hstepB = (size_t)HALF * K * 2, hstepA = (size_t)HALF * g.lda * 2;
    const size_t tstepA = 2 * hstepA, tstepB = 2 * hstepB;
    const unsigned ldsw = (unsigned)wid * 1024u;
    const int aoff = lds_byte(wr * 64 + fr, fq * 8), boff = lds_byte(wc * 32 + fr, fq * 8);
#define PG8_SA(b, h) (((b) * 2 + (h)) * HTB)
#define PG8_SB(b, h) ((4 + (b) * 2 + (h)) * HTB)
#define PG8_STAGE(bufoff, gbase, voff) do { _Pragma("unroll") for (int _i = 0; _i < 2; ++_i) \
        __builtin_amdgcn_global_load_lds((const unsigned*)((const char*)(gbase) + (voff)[_i]), (PG8_LAS unsigned*)(lds + (bufoff) + ldsw + _i * 8192), 16, 0, 0); } while (0)
#define PG8_LDA(dst, b, h) do { _Pragma("unroll") for (int m = 0; m < 4; ++m) _Pragma("unroll") for (int k = 0; k < 2; ++k) dst[m][k] = *(const PG8_LAS bf16x8*)(lds + PG8_SA(b, h) + aoff + m * 2048 + k * 1024); } while (0)
#define PG8_LDB(dst, b, h) do { _Pragma("unroll") for (int n = 0; n < 2; ++n) _Pragma("unroll") for (int k = 0; k < 2; ++k) dst[n][k] = *(const PG8_LAS bf16x8*)(lds + PG8_SB(b, h) + boff + n * 2048 + k * 1024); } while (0)
#define PG8_MMA(ai, bj, At, Bt) do { __builtin_amdgcn_s_setprio(1); _Pragma("unroll") for (int m = 0; m < 4; ++m) _Pragma("unroll") for (int n = 0; n < 2; ++n) _Pragma("unroll") for (int k = 0; k < 2; ++k) \
        acc[ai][bj][m][n] = __builtin_amdgcn_mfma_f32_16x16x32_bf16(Bt[n][k], At[m][k], acc[ai][bj][m][n], 0, 0, 0); __builtin_amdgcn_s_setprio(0); } while (0)
#define PG8_WAIT_V(n) asm volatile("s_waitcnt vmcnt(" #n ")" ::: "memory")
#define PG8_WAIT_L(n) asm volatile("s_waitcnt lgkmcnt(" #n ")" ::: "memory")
#define PG8_BAR __builtin_amdgcn_s_barrier()
#define PG8_SCHED __builtin_amdgcn_sched_barrier(0)
    Unit cur, nxt; int ui = 0;
    if (!S.next(0, cur)) return;
    f32x4 acc[2][2][4][2];
#pragma unroll
    for (int a = 0; a < 2; ++a)
#pragma unroll
        for (int b = 0; b < 2; ++b)
#pragma unroll
            for (int m = 0; m < 4; ++m)
#pragma unroll
                for (int n = 0; n < 2; ++n) acc[a][b][m][n] = (f32x4){0.f, 0.f, 0.f, 0.f};
    bf16x8 At[4][2], B0[2][2], B1[2][2];
    const char* cA = (const char*)g.A + (size_t)cur.pm * tstepA; const char* cB = (const char*)g.Bt + (size_t)cur.pn * tstepB;
    S.a_ready(cur);
    if constexpr (SP2) {
        PG8_STAGE(PG8_SB(0, 0), cB, voffB); PG8_STAGE(PG8_SB(0, 1), cB + hstepB, voffB); PG8_STAGE(PG8_SA(0, 0), cA, voffA); PG8_STAGE(PG8_SA(0, 1), cA + hstepA, voffA);
        if (wr == 1) PG8_BAR;
        PG8_WAIT_V(2); PG8_BAR;
        PG8_STAGE(PG8_SB(1, 0), cB + kstep, voffB); PG8_STAGE(PG8_SA(1, 0), cA + kstep, voffA); PG8_STAGE(PG8_SB(1, 1), cB + hstepB + kstep, voffB);
        PG8_WAIT_V(6); PG8_BAR;
    } else {
        PG8_STAGE(PG8_SB(0, 0), cB, voffB); PG8_STAGE(PG8_SA(0, 0), cA, voffA); PG8_STAGE(PG8_SB(0, 1), cB + hstepB, voffB); PG8_STAGE(PG8_SA(0, 1), cA + hstepA, voffA);
        if (wr == 1) PG8_BAR;
        PG8_WAIT_V(4); PG8_BAR;
        PG8_STAGE(PG8_SB(1, 0), cB + kstep, voffB); PG8_STAGE(PG8_SA(1, 0), cA + kstep, voffA); PG8_STAGE(PG8_SB(1, 1), cB + hstepB + kstep, voffB);
        PG8_WAIT_V(6); PG8_BAR;
    }
    for (;;) {
        const bool has_next = S.next(ui + 1, nxt);
        const char* nA = has_next ? (const char*)g.A + (size_t)nxt.pm * tstepA : cA; const char* nB = has_next ? (const char*)g.Bt + (size_t)nxt.pn * tstepB : cB;
        for (int t = 0; t < nt; t += 2) {
            const bool last = (t == nt - 2);
            const char* a1 = cA + (size_t)(t + 1) * kstep;
            const char* a2 = last ? nA : cA + (size_t)(t + 2) * kstep; const char* b2 = last ? nB : cB + (size_t)(t + 2) * kstep;
            const char* a3 = a2 + kstep; const char* b3 = b2 + kstep;
            if (last && has_next) S.a_ready(nxt);
            if constexpr (SP2) {
            PG8_LDB(B0, 0, 0); PG8_LDB(B1, 0, 1); PG8_SCHED; PG8_LDA(At, 0, 0); PG8_STAGE(PG8_SA(1, 1), a1 + hstepA, voffA);
            PG8_WAIT_V(8); PG8_WAIT_L(0); PG8_BAR; PG8_MMA(0, 0, At, B0); PG8_MMA(0, 1, At, B1); PG8_BAR; PG8_SCHED;
            PG8_LDA(At, 0, 1); PG8_STAGE(PG8_SB(0, 0), b2, voffB); PG8_STAGE(PG8_SB(0, 1), b2 + hstepB, voffB); PG8_STAGE(PG8_SA(0, 0), a2, voffA);
            PG8_WAIT_V(8); PG8_WAIT_L(0); PG8_BAR; PG8_MMA(1, 0, At, B0); PG8_MMA(1, 1, At, B1); PG8_BAR; PG8_SCHED;
            PG8_LDB(B0, 1, 0); PG8_LDB(B1, 1, 1); PG8_SCHED; PG8_LDA(At, 1, 0); PG8_STAGE(PG8_SA(0, 1), a2 + hstepA, voffA);
            PG8_WAIT_V(8); PG8_WAIT_L(0); PG8_BAR; PG8_MMA(0, 0, At, B0); PG8_MMA(0, 1, At, B1); PG8_BAR; PG8_SCHED;
            PG8_LDA(At, 1, 1); PG8_STAGE(PG8_SB(1, 0), b3, voffB); PG8_STAGE(PG8_SB(1, 1), b3 + hstepB, voffB); PG8_STAGE(PG8_SA(1, 0), a3, voffA);
            PG8_WAIT_V(8); PG8_WAIT_L(0); PG8_BAR; PG8_MMA(1, 0, At, B0); PG8_MMA(1, 1, At, B1); PG8_BAR; PG8_SCHED;
            } else {
            PG8_LDB(B0, 0, 0); PG8_SCHED; PG8_LDA(At, 0, 0); PG8_STAGE(PG8_SA(1, 1), a1 + hstepA, voffA);
            PG8_WAIT_L(8); PG8_BAR; PG8_WAIT_L(0); PG8_MMA(0, 0, At, B0); PG8_BAR; PG8_SCHED;
            PG8_LDB(B1, 0, 1); PG8_STAGE(PG8_SB(0, 0), b2, voffB);
            PG8_BAR; PG8_WAIT_L(0); PG8_MMA(0, 1, At, B1); PG8_BAR;
            PG8_LDA(At, 0, 1); PG8_STAGE(PG8_SA(0, 0), a2, voffA);
            PG8_BAR; PG8_WAIT_L(0); PG8_MMA(1, 0, At, B0); PG8_BAR; PG8_SCHED;
            PG8_STAGE(PG8_SB(0, 1), b2 + hstepB, voffB);
            PG8_WAIT_V(6); PG8_BAR; PG8_MMA(1, 1, At, B1); PG8_BAR;
            PG8_LDB(B0, 1, 0); PG8_SCHED; PG8_LDA(At, 1, 0); PG8_STAGE(PG8_SA(0, 1), a2 + hstepA, voffA);
            PG8_WAIT_L(8); PG8_BAR; PG8_WAIT_L(0); PG8_MMA(0, 0, At, B0); PG8_BAR; PG8_SCHED;
            PG8_LDB(B1, 1, 1); PG8_STAGE(PG8_SB(1, 0), b3, voffB);
            PG8_BAR; PG8_WAIT_L(0); PG8_MMA(0, 1, At, B1); PG8_BAR;
            PG8_LDA(At, 1, 1); PG8_STAGE(PG8_SA(1, 0), a3, voffA);
            PG8_BAR; PG8_WAIT_L(0); PG8_MMA(1, 0, At, B0); PG8_BAR; PG8_SCHED;
            PG8_STAGE(PG8_SB(1, 1), b3 + hstepB, voffB);
            PG8_WAIT_V(6); PG8_BAR; PG8_MMA(1, 1, At, B1); PG8_BAR;
            }
        }
        if constexpr (ALIGN_EPI) { if (wr == 0) PG8_BAR; }
        if constexpr (!Epi::AFTER_DRAIN) { E(acc, cur, wr, wc, fr, fq); S.done(cur); }
        if (!has_next) break;
#pragma unroll
        for (int a = 0; a < 2; ++a)
#pragma unroll
            for (int b = 0; b < 2; ++b)
#pragma unroll
                for (int m = 0; m < 4; ++m)
#pragma unroll
                    for (int n = 0; n < 2; ++n) acc[a][b][m][n] = (f32x4){0.f, 0.f, 0.f, 0.f};
        cur = nxt; cA = nA; cB = nB; ++ui;
        if constexpr (ALIGN_EPI) { if (wr == 1) PG8_BAR; }
    }
    PG8_WAIT_V(0);
    if constexpr (!ALIGN_EPI) { if (wr == 0) PG8_BAR; }
    PG8_BAR;
    if constexpr (Epi::AFTER_DRAIN) { E.fused(acc, cur, wr, wc, fr, fq, lds, wid, lane); S.done(cur); }
#undef PG8_SA
#undef PG8_SB
#undef PG8_STAGE
#undef PG8_LDA
#undef PG8_LDB
#undef PG8_MMA
#undef PG8_WAIT_V
#undef PG8_WAIT_L
#undef PG8_BAR
#undef PG8_SCHED
}
}
namespace attn {
using bf16=unsigned short;
using bf16x8=__attribute__((ext_vector_type(8)))short;
using s16x4=__attribute__((ext_vector_type(4)))short;
using f32x16=__attribute__((ext_vector_type(16)))float;
using u32x4=__attribute__((ext_vector_type(4)))unsigned;
constexpr int D=64, PITCH=4392, SEQ=8192;
constexpr int NW=8,QBLK=32,QB=QBLK*NW,KVBLK=64;
__device__ __forceinline__ int crow(int r,int hi){return (r&3)+8*(r>>2)+4*hi;}
#define SBAR() __builtin_amdgcn_sched_barrier(0)
using f32x4_=__attribute__((ext_vector_type(4)))float;
__device__ __forceinline__ float bfs(short v){ return __uint_as_float(((unsigned)(unsigned short)v)<<16); }
__device__ __forceinline__ float lo16(unsigned w){ return __uint_as_float(w<<16); }
__device__ __forceinline__ float hi16(unsigned w){ return __uint_as_float(w&0xffff0000u); }
__device__ __forceinline__ bf16 f2b(float f){ unsigned u=__float_as_uint(f); return (bf16)((u+0x7fffu+((u>>16)&1u))>>16); }
__device__ __forceinline__ unsigned pk2b(float lo,float hi){ return (unsigned)f2b(lo)|((unsigned)f2b(hi)<<16); }
constexpr int NSLOT=3, SLOTB=8192;
constexpr int LDS_K=0, LDS_V=NSLOT*SLOTB, LDS_WS=2*NSLOT*SLOTB, LDS_OST=LDS_WS+NW*128*4, LDS_BIAS=LDS_OST+NW*4096, LDS_MSK=LDS_BIAS+512, LDS_KM=LDS_MSK+NW*512, LDS_BYTES=LDS_KM+8192;
constexpr float LOG2E_=1.4426950408889634f;
__device__ __forceinline__ void glds16(const void*gsrc,unsigned lds_dst){unsigned keep;
  asm volatile("s_mov_b32 %0, m0\n\ts_mov_b32 m0, %2\n\ts_nop 0\n\tglobal_load_lds_dwordx4 %1, off\n\ts_mov_b32 m0, %0":"=&s"(keep):"v"(gsrc),"s"(lds_dst):"memory");}
__device__ __forceinline__ float max3f(float a,float b,float c){float r;asm("v_max3_f32 %0, %1, %2, %3":"=v"(r):"v"(a),"v"(b),"v"(c));return r;}
__device__ __forceinline__ float max2f(float a,float b){float r;asm("v_max_f32_e32 %0, %1, %2":"=v"(r):"v"(a),"v"(b));return r;}
__device__ __forceinline__ float fadd_s(float a,float b){float r;asm("v_add_f32_e32 %0, %1, %2":"=v"(r):"v"(a),"v"(b));return r;}
__device__ __forceinline__ float fsub_s(float a,float b){float r;asm("v_sub_f32_e32 %0, %1, %2":"=v"(r):"v"(a),"v"(b));return r;}
typedef float f32x2_t __attribute__((ext_vector_type(2))); typedef __bf16 bf16x2_t __attribute__((ext_vector_type(2)));
__device__ __forceinline__ unsigned cvtpk_s(float lo,float hi){f32x2_t v={lo,hi};bf16x2_t b=__builtin_convertvector(v,bf16x2_t);return __builtin_bit_cast(unsigned,b);}
#define WAIT_BAR(N) asm volatile("s_waitcnt vmcnt(" #N ") lgkmcnt(0)\n\ts_barrier":::"memory")

__device__ __forceinline__ void qkt(f32x16&p0,f32x16&p1,const char*Kslot,const bf16x8*qr,const f32x16&negm,int r32,int hi){
  const char*kb=Kslot+hi*1024+r32*16;
  #pragma unroll
  for(int d0=0;d0<4;++d0){
    const bf16x8 b0=*reinterpret_cast<const bf16x8*>(kb+d0*2048);
    const bf16x8 b1=*reinterpret_cast<const bf16x8*>(kb+d0*2048+512);
    if(d0==0){p0=__builtin_amdgcn_mfma_f32_32x32x16_bf16(b0,qr[0],negm,0,0,0);p1=__builtin_amdgcn_mfma_f32_32x32x16_bf16(b1,qr[0],negm,0,0,0);}
    else{p0=__builtin_amdgcn_mfma_f32_32x32x16_bf16(b0,qr[d0],p0,0,0,0);p1=__builtin_amdgcn_mfma_f32_32x32x16_bf16(b1,qr[d0],p1,0,0,0);}}
}
typedef __attribute__((address_space(3))) const char* lds_cptr;
typedef short v4i16_t __attribute__((ext_vector_type(4)));
__device__ __forceinline__ void kload8(bf16x8*kf,lds_cptr kp){
  kf[0]=*(const __attribute__((address_space(3))) bf16x8*)(kp);      kf[1]=*(const __attribute__((address_space(3))) bf16x8*)(kp+512);
  kf[2]=*(const __attribute__((address_space(3))) bf16x8*)(kp+2048); kf[3]=*(const __attribute__((address_space(3))) bf16x8*)(kp+2560);
  kf[4]=*(const __attribute__((address_space(3))) bf16x8*)(kp+4096); kf[5]=*(const __attribute__((address_space(3))) bf16x8*)(kp+4608);
  kf[6]=*(const __attribute__((address_space(3))) bf16x8*)(kp+6144); kf[7]=*(const __attribute__((address_space(3))) bf16x8*)(kp+6656);
}
__device__ __forceinline__ void kload2(bf16x8*kf,lds_cptr kp,int j){ kf[2*j]=*(const __attribute__((address_space(3))) bf16x8*)(kp+j*2048); kf[2*j+1]=*(const __attribute__((address_space(3))) bf16x8*)(kp+j*2048+512); }
__device__ __forceinline__ s16x4 vtr(lds_cptr p){ return __builtin_bit_cast(s16x4,__builtin_amdgcn_ds_read_tr16_b64_v4i16((__attribute__((address_space(3))) v4i16_t*)p)); }
__device__ __forceinline__ float rowmax(const f32x16&p0,const f32x16&p1){
  float a=max3f(p0[0],p0[1],p1[0]),b=max3f(p0[2],p0[3],p1[1]);a=max3f(a,p1[2],p1[3]);
  #pragma unroll
  for(int r=4;r<16;r+=4){a=max3f(a,p0[r],p0[r+1]);b=max3f(b,p0[r+2],p0[r+3]);a=max3f(a,p1[r],p1[r+1]);b=max3f(b,p1[r+2],p1[r+3]);}
  const float m=max2f(a,b);
  auto rr=__builtin_amdgcn_permlane32_swap(__float_as_uint(m),__float_as_uint(m),false,false);
  return max2f(__uint_as_float(rr[0]),__uint_as_float(rr[1]));
}
__device__ __forceinline__ void pv(f32x16*o,int vb,bf16x8 pa0,bf16x8 pa1,bf16x8 pa2,bf16x8 pa3){
  #pragma unroll
  for(int d0=0;d0<2;++d0){s16x4 lo[4],hi[4];
    #pragma unroll
    for(int ks=0;ks<4;++ks){
      asm volatile("ds_read_b64_tr_b16 %0,%1 offset:%c2":"=&v"(lo[ks]):"v"(vb),"i"(d0*4096+ks*1024):"memory");
      asm volatile("ds_read_b64_tr_b16 %0,%1 offset:%c2":"=&v"(hi[ks]):"v"(vb),"i"(d0*4096+ks*1024+512):"memory");}
    asm volatile("s_waitcnt lgkmcnt(0)":::"memory");SBAR();
    #define PK(k) (bf16x8){lo[k][0],lo[k][1],lo[k][2],lo[k][3],hi[k][0],hi[k][1],hi[k][2],hi[k][3]}
    o[d0]=__builtin_amdgcn_mfma_f32_32x32x16_bf16(pa0,PK(0),o[d0],0,0,0);
    o[d0]=__builtin_amdgcn_mfma_f32_32x32x16_bf16(pa1,PK(1),o[d0],0,0,0);
    o[d0]=__builtin_amdgcn_mfma_f32_32x32x16_bf16(pa2,PK(2),o[d0],0,0,0);
    o[d0]=__builtin_amdgcn_mfma_f32_32x32x16_bf16(pa3,PK(3),o[d0],0,0,0);
    #undef PK
  }
}

#ifndef ATTN_STORE16
#define ATTN_STORE16(p,v) (*(u32x4*)(p)=(v))
#endif
struct UArgs {
  const bf16* Qb; const bf16* Kh; const bf16* Vh; bf16* Ob;
  int NT, q0, kt0, hc;
  const float* rel;
  const float* km; int qb;
  const unsigned* selg;
  const bf16* gate; int gcol;
  const bf16* tmp;
};
__device__ __forceinline__ int t5b(int d){ if(d<16)return d<0?0:d; int b=16; b+=(d>=19);b+=(d>=21);b+=(d>=24);b+=(d>=27);b+=(d>=31);b+=(d>=35);b+=(d>=40);b+=(d>=46);b+=(d>=52);b+=(d>=59);b+=(d>=67);b+=(d>=77);b+=(d>=87);b+=(d>=99);b+=(d>=113); return b; }
template<int MODE,int EPI,int THRL> __device__ __forceinline__ void attn_unit(const UArgs&U,char*shm){
  const int tid=threadIdx.x,lane=tid&63,r32=lane&31,hi=lane>>5; const int wid=__builtin_amdgcn_readfirstlane(tid>>6);
  const bf16*Qw=U.Qb+(long)(wid*QBLK)*PITCH;
  const bf16*Kh=U.Kh,*Vh=U.Vh;
  const unsigned lds0=(unsigned)(uintptr_t)shm;
  float*wsf=(float*)(shm+LDS_WS)+wid*128;
  const bf16*ksrc=Kh+(long)lane*PITCH+wid*8;
  const bf16*vsrc=Vh+(long)(16*(wid&3)+(lane>>2))*PITCH+(wid>>2)*32+(lane&3)*8;
  const unsigned kdst=lds0+LDS_K+wid*1024, vdst=lds0+LDS_V+wid*1024;
  #define DMA_K(t,slot) glds16(ksrc+(long)(t)*KVBLK*PITCH,(unsigned)__builtin_amdgcn_readfirstlane(kdst+(slot)))
  #define DMA_V(t,slot) glds16(vsrc+(long)(t)*KVBLK*PITCH,(unsigned)__builtin_amdgcn_readfirstlane(vdst+(slot)))
  const int vb0=(int)(lds0+LDS_V)+((lane>>4)&1)*32+(lane&3)*8+(4*hi+((lane&15)>>2))*64;
  const char*Kbase=shm+LDS_K; bf16x8 kf[8];
  const lds_cptr shm3=(lds_cptr)shm; const lds_cptr kp0=shm3+LDS_K+hi*1024+r32*16; const lds_cptr vp0=shm3+LDS_V+((lane>>4)&1)*32+(lane&3)*8+(4*hi+((lane&15)>>2))*64;
  const int NT=U.NT;
  const int qpos=U.q0+wid*QBLK+r32;
  float*biasT=(float*)(shm+LDS_BIAS);
  if(tid<128) biasT[tid]=(U.rel[t5b(tid)*16+U.hc]-U.rel[31*16+U.hc])*LOG2E_;
  unsigned selw=0u,cw=0u; const unsigned*mskp=(const unsigned*)(shm+LDS_MSK)+wid*128+r32*4;
  if(MODE==0){ ((u32x4*)(shm+LDS_KM))[tid]=((const u32x4*)U.km)[tid]; }
  if(MODE==1){ if(hi==0){ const u32x4 w=*(const u32x4*)(U.selg+(long)(wid*QBLK+r32)*4); *(u32x4*)((unsigned*)(shm+LDS_MSK)+wid*128+r32*4)=w; } }
  asm volatile("s_waitcnt vmcnt(0) lgkmcnt(0)\n\ts_barrier":::"memory");
  bf16x8 qr[4];
  #pragma unroll
  for(int d0=0;d0<4;++d0)qr[d0]=*reinterpret_cast<const bf16x8*>(&Qw[(long)r32*PITCH+d0*16+hi*8]);
  if(MODE==0){
    float v1=-INFINITY,v2=-INFINITY,v3=-INFINITY; int i1=-1,i2=-1,i3=-1;
    for(int n=0;n<U.qb;++n){ const float*km=(const float*)(shm+LDS_KM)+n*64+hi*8; float p=0.f;
      #pragma unroll
      for(int d0=0;d0<4;++d0){ const f32x4_ a=*(const f32x4_*)(km+d0*16), c=*(const f32x4_*)(km+d0*16+4);
        p+=bfs(qr[d0][0])*a[0]+bfs(qr[d0][1])*a[1]+bfs(qr[d0][2])*a[2]+bfs(qr[d0][3])*a[3]+bfs(qr[d0][4])*c[0]+bfs(qr[d0][5])*c[1]+bfs(qr[d0][6])*c[2]+bfs(qr[d0][7])*c[3]; }
      auto rr=__builtin_amdgcn_permlane32_swap(__float_as_uint(p),__float_as_uint(p),false,false); const float sc_=__uint_as_float(rr[0])+__uint_as_float(rr[1]);
      if(sc_>v1){v3=v2;i3=i2;v2=v1;i2=i1;v1=sc_;i1=n;} else if(sc_>v2){v3=v2;i3=i2;v2=sc_;i2=n;} else if(sc_>v3){v3=sc_;i3=n;} }
    if(i1>=0)selw|=1u<<i1; if(i2>=0)selw|=1u<<i2; if(i3>=0)selw|=1u<<i3; selw|=1u<<U.qb; }
  DMA_K(0,0);DMA_V(0,0);DMA_K(1,SLOTB);
  float mhat=0.f,l_reg=0.f;f32x16 o[2];o[0]=f32x16{};o[1]=f32x16{};f32x16 negm=f32x16{};asm volatile("":"+v"(negm));
  #define MASK_FAR(P0,P1,t) do{ bool on_=true; if(MODE==0)on_=((selw>>((t)>>2))&1u)!=0u; if(MODE==1){ if(((t)&31)==0)cw=mskp[(t)>>5]; on_=((cw>>((t)&31))&1u)!=0u; } \
      _Pragma("unroll") for(int r=0;r<16;++r){ P0[r]=on_?P0[r]:-INFINITY; P1[r]=on_?P1[r]:-INFINITY; } }while(0)
  #define MASK_BAND(P0,P1,t) do{ bool on_=true; if(MODE==0)on_=((selw>>((t)>>2))&1u)!=0u; if(MODE==1){ if(((t)&31)==0)cw=mskp[(t)>>5]; on_=((cw>>((t)&31))&1u)!=0u; } \
      const int d0_=qpos-(U.kt0+64*(t)+4*hi); \
      _Pragma("unroll") for(int r=0;r<16;++r){ const int da_=d0_-((r&3)+8*(r>>2)), db_=da_-32; \
        const bool oka_=on_&&da_>=0&&(MODE!=2||da_<512), okb_=on_&&db_>=0&&(MODE!=2||db_<512); \
        const float ba_=biasT[da_<0?0:(da_>127?127:da_)], bb_=biasT[db_<0?0:(db_>127?127:db_)]; \
        P0[r]=oka_?P0[r]+ba_:-INFINITY; P1[r]=okb_?P1[r]+bb_:-INFINITY; \
        if((r&1)==1){ asm volatile("s_waitcnt lgkmcnt(0)":"+v"(P0),"+v"(P1)::"memory"); } } }while(0)
  #define CMASK(P0,P1,t) MASK_BAND(P0,P1,t)
  bool resc=false;
  #define START(P0,P1) do{ const float rm=rowmax(P0,P1); resc=false; \
    { const float dl=rm>-1e30f?rm:0.f; mhat=fadd_s(mhat,dl); \
      _Pragma("unroll") for(int r=0;r<16;++r){P0[r]=fsub_s(P0[r],dl);P1[r]=fsub_s(P1[r],dl);} \
      _Pragma("unroll") for(int r=0;r<16;++r)negm[r]=-mhat; asm volatile("":"+v"(negm)); } \
    _Pragma("unroll") for(int r=0;r<16;++r)P0[r]=__builtin_amdgcn_exp2f(P0[r]); }while(0)
  #define RESC() do{ if(resc){ asm volatile("s_waitcnt lgkmcnt(0)":::"memory"); \
      _Pragma("unroll") for(int d_=0;d_<2;++d_) _Pragma("unroll") for(int r=0;r<16;++r)o[d_][r]*=wsf[crow(r,hi)]; } }while(0)
  f32x16 pA0,pA1,pB0,pB1;
  int sl_prev=0,sl_cur=0,sl_next=SLOTB;
  #define ROT() do{sl_prev=sl_cur;sl_cur=sl_next;sl_next=(sl_next==(NSLOT-1)*SLOTB)?0:sl_next+SLOTB;}while(0)
  DMA_K(2,2*SLOTB);
  WAIT_BAR(3);
  qkt(pA0,pA1,Kbase,qr,negm,r32,hi);asm volatile("s_nop 15\n\ts_nop 7":"+v"(pA0),"+v"(pA1));CMASK(pA0,pA1,0);
  START(pA0,pA1);
  _Pragma("unroll") for(int r=0;r<16;++r)pA1[r]=__builtin_amdgcn_exp2f(pA1[r]);
  WAIT_BAR(0);
  DMA_K(3,0);DMA_V(1,SLOTB);
  ROT();
  kload8(kf,kp0+sl_cur);
  WAIT_BAR(2);
  s16x4 vlo[8],vhi[8]; u32x4 pw0,pw1,pw2,pw3;
  #define PKW(P,B) cvtpk_s(P[B],P[B+1])
  #define PAF(k) __builtin_bit_cast(bf16x8,pw##k)
  #define VFR(i) (bf16x8){vlo[i][0],vlo[i][1],vlo[i][2],vlo[i][3],vhi[i][0],vhi[i][1],vhi[i][2],vhi[i][3]}
  #define PIN(x) asm volatile("":"+v"(x))
  #define MX3(a,b,c) __builtin_fmaxf(__builtin_fmaxf((a),(b)),(c))
  #define GAPA(MF,A0,A1,A2,A3,W0,W1,PW) do{ MF; sacc+=A0; sacc+=A1; sacc+=A2; sacc+=A3; PIN(sacc); W0; W1; PIN(PW); SBAR(); }while(0)
  #define EX(v) __builtin_amdgcn_exp2f(v)
  #define GAPB(MF,X,B) do{ MF; X[B]=EX(X[B]); X[B+1]=EX(X[B+1]); X[B+2]=EX(X[B+2]); X[B+3]=EX(X[B+3]); PIN(X); SBAR(); }while(0)
  #define VRD(i) do{ vlo[i]=vtr(vp_+(((i)>>2)*4096+((i)&3)*1024)); vhi[i]=vtr(vp_+(((i)>>2)*4096+((i)&3)*1024+512)); }while(0)
  #define KRD(G,j) do{ if(G){ kload2(kf,kp0+sl_next,j); SBAR(); } }while(0)
  #define STEP(C0,C1,P0,P1,t,GK,GV,GL) do{ SBAR(); \
    const lds_cptr vp_=vp0+sl_prev; \
    VRD(0); SBAR(); float sacc=(P0[0]+P0[1]); \
    GAPA(C0=__builtin_amdgcn_mfma_f32_32x32x16_bf16(kf[0],qr[0],negm,0,0,0), P0[2],P0[3],P0[4],P0[5],     pw0[0]=PKW(P0,0), pw0[1]=PKW(P0,2), pw0); \
    VRD(4); SBAR(); GAPA(C1=__builtin_amdgcn_mfma_f32_32x32x16_bf16(kf[1],qr[0],negm,0,0,0), P0[6],P0[7],P0[8],P0[9],     pw0[2]=PKW(P0,4), pw0[3]=PKW(P0,6), pw0); \
    VRD(1); SBAR(); GAPA(C0=__builtin_amdgcn_mfma_f32_32x32x16_bf16(kf[2],qr[1],C0,0,0,0),   P0[10],P0[11],P0[12],P0[13], pw1[0]=PKW(P0,8), pw1[1]=PKW(P0,10), pw1); \
    VRD(5); SBAR(); GAPA(C1=__builtin_amdgcn_mfma_f32_32x32x16_bf16(kf[3],qr[1],C1,0,0,0),   P0[14],P0[15],P1[0],P1[1],   pw1[2]=PKW(P0,12),pw1[3]=PKW(P0,14), pw1); \
    VRD(2); SBAR(); GAPA(C0=__builtin_amdgcn_mfma_f32_32x32x16_bf16(kf[4],qr[2],C0,0,0,0),   P1[2],P1[3],P1[4],P1[5],     pw2[0]=PKW(P1,0), pw2[1]=PKW(P1,2), pw2); \
    VRD(6); SBAR(); GAPA(C1=__builtin_amdgcn_mfma_f32_32x32x16_bf16(kf[5],qr[2],C1,0,0,0),   P1[6],P1[7],P1[8],P1[9],     pw2[2]=PKW(P1,4), pw2[3]=PKW(P1,6), pw2); \
    VRD(3); SBAR(); GAPA(C0=__builtin_amdgcn_mfma_f32_32x32x16_bf16(kf[6],qr[3],C0,0,0,0),   P1[10],P1[11],P1[12],P1[13], pw3[0]=PKW(P1,8), pw3[1]=PKW(P1,10), pw3); \
    VRD(7); SBAR(); GAPA(C1=__builtin_amdgcn_mfma_f32_32x32x16_bf16(kf[7],qr[3],C1,0,0,0),   P1[14],P1[15],0.f,0.f,       pw3[2]=PKW(P1,12),pw3[3]=PKW(P1,14), pw3); \
    l_reg+=sacc; \
    if(GK){DMA_K((t)+3,sl_cur);} if(GV){DMA_V((t)+1,sl_next);} \
    CMASK(C0,C1,t); \
    { float a=MX3(C0[0],C0[1],C1[0]),b=MX3(C0[2],C0[3],C1[1]); a=MX3(a,C1[2],C1[3]); \
      _Pragma("unroll") for(int r=4;r<16;r+=4){a=MX3(a,C0[r],C0[r+1]);b=MX3(b,C0[r+2],C0[r+3]);a=MX3(a,C1[r],C1[r+1]);b=MX3(b,C1[r+2],C1[r+3]);} \
      float rm=__builtin_fmaxf(a,b); { auto rr=__builtin_amdgcn_permlane32_swap(__float_as_uint(rm),__float_as_uint(rm),false,false); rm=__builtin_fmaxf(__uint_as_float(rr[0]),__uint_as_float(rr[1])); } \
      resc=false; \
      if(__builtin_expect(__any(rm>(float)THRL),0)){ const float dl=__builtin_fmaxf(rm,0.f); mhat+=dl; \
        _Pragma("unroll") for(int r=0;r<16;++r){C0[r]-=dl;C1[r]-=dl;} \
        _Pragma("unroll") for(int r=0;r<16;++r)negm[r]=-mhat; asm volatile("":"+v"(negm)); \
        const float f=__builtin_amdgcn_exp2f(-dl); l_reg*=f; if(hi==0)wsf[r32]=f; resc=true; } } \
    SBAR(); \
    GAPB(o[0]=__builtin_amdgcn_mfma_f32_32x32x16_bf16(PAF(0),VFR(0),o[0],0,0,0), C0,0); \
    GAPB(o[1]=__builtin_amdgcn_mfma_f32_32x32x16_bf16(PAF(0),VFR(4),o[1],0,0,0), C0,4); \
    KRD(GL,0); GAPB(o[0]=__builtin_amdgcn_mfma_f32_32x32x16_bf16(PAF(1),VFR(1),o[0],0,0,0), C0,8); \
    KRD(GL,1); GAPB(o[1]=__builtin_amdgcn_mfma_f32_32x32x16_bf16(PAF(1),VFR(5),o[1],0,0,0), C0,12); \
    KRD(GL,2); GAPB(o[0]=__builtin_amdgcn_mfma_f32_32x32x16_bf16(PAF(2),VFR(2),o[0],0,0,0), C1,0); \
    KRD(GL,3); GAPB(o[1]=__builtin_amdgcn_mfma_f32_32x32x16_bf16(PAF(2),VFR(6),o[1],0,0,0), C1,4); \
    GAPB(o[0]=__builtin_amdgcn_mfma_f32_32x32x16_bf16(PAF(3),VFR(3),o[0],0,0,0), C1,8); \
    GAPB(o[1]=__builtin_amdgcn_mfma_f32_32x32x16_bf16(PAF(3),VFR(7),o[1],0,0,0), C1,12); \
    }while(0)
  int t=1;
  #undef CMASK
  #define CMASK(P0,P1,t) MASK_FAR(P0,P1,t)
  for(;MODE!=2&&t+7<NT;t+=2){
    STEP(pB0,pB1,pA0,pA1,t,true,true,true);     WAIT_BAR(2); RESC(); ROT();
    STEP(pA0,pA1,pB0,pB1,t+1,true,true,true);   WAIT_BAR(2); RESC(); ROT();
  }
  #undef CMASK
  #define CMASK(P0,P1,t) MASK_BAND(P0,P1,t)
  #define ENDW(tt) do{ if((tt)+3<NT){WAIT_BAR(2);} else if((tt)+2<NT){WAIT_BAR(1);} else {WAIT_BAR(0);} }while(0)
  for(;t+1<NT;t+=2){
    STEP(pB0,pB1,pA0,pA1,t,(t+3<NT),(t+1<NT),(t+1<NT));       ENDW(t);   RESC(); ROT();
    STEP(pA0,pA1,pB0,pB1,t+1,(t+4<NT),(t+2<NT),(t+2<NT));     ENDW(t+1); RESC(); ROT();
  }
  STEP(pB0,pB1,pA0,pA1,NT-1,false,false,false); RESC();
  { float sacc=pB0[0]+pB0[1]; _Pragma("unroll") for(int r=2;r<16;++r)sacc+=pB0[r]; _Pragma("unroll") for(int r=0;r<16;++r)sacc+=pB1[r]; l_reg+=sacc;
    pw0=(u32x4){PKW(pB0,0),PKW(pB0,2),PKW(pB0,4),PKW(pB0,6)};pw1=(u32x4){PKW(pB0,8),PKW(pB0,10),PKW(pB0,12),PKW(pB0,14)};pw2=(u32x4){PKW(pB1,0),PKW(pB1,2),PKW(pB1,4),PKW(pB1,6)};pw3=(u32x4){PKW(pB1,8),PKW(pB1,10),PKW(pB1,12),PKW(pB1,14)};
    SBAR(); pv(o,vb0+sl_cur,PAF(0),PAF(1),PAF(2),PAF(3)); }
  #undef PKW
  #undef PAF
  #undef VFR
  #undef PIN
  #undef MX3
  #undef GAPA
  #undef GAPB
  #undef EX
  #undef VRD
  #undef KRD
  #undef STEP
  #undef ENDW
  {auto rr=__builtin_amdgcn_permlane32_swap(__float_as_uint(l_reg),__float_as_uint(l_reg),false,false);l_reg=__uint_as_float(rr[0])+__uint_as_float(rr[1]);}
  int lane_e=lane; asm volatile("":"+v"(lane_e)); const int r32e=lane_e&31, hie=lane_e>>5;
  float*wsfe=(float*)(shm+LDS_WS)+wid*128;
  if(hie==0){ wsfe[32+r32e]=l_reg; if(EPI!=0){ const float gl=bfs((short)U.gate[(long)(wid*QBLK+r32e)*PITCH+U.gcol]); wsfe[64+r32e]=1.f/(1.f+__expf(-gl)); } }
  asm volatile("s_waitcnt lgkmcnt(0)":::"memory");
  float rli[16];
  #pragma unroll
  for(int r=0;r<16;++r){ rli[r]=__builtin_amdgcn_rcpf(fmaxf(wsfe[32+crow(r,hie)],1e-30f)); if(EPI!=0)rli[r]*=wsfe[64+crow(r,hie)]; }
  bf16*Ow=U.Ob+(long)(wid*QBLK)*PITCH;
  { bf16*stg=(bf16*)(shm+LDS_OST)+wid*2048;
    #pragma unroll
    for(int r=0;r<16;++r){const int orow=crow(r,hie);
      #pragma unroll
      for(int d0=0;d0<2;++d0){ float v=o[d0][r]*rli[r]; if(EPI==2)v+=bfs((short)stg[orow*64+d0*32+r32e]); stg[orow*64+d0*32+r32e]=f2b(v);} }
    asm volatile("s_waitcnt lgkmcnt(0)":::"memory");
    if(EPI!=1){
    #pragma unroll
    for(int i=0;i<4;++i){const int row=i*8+(lane_e>>3),ch=lane_e&7; u32x4 v=*(const u32x4*)(stg+row*64+ch*8);
      if(EPI==2){ const u32x4 t=*(const u32x4*)(U.tmp+(long)(wid*QBLK+row)*512+ch*8);
        v.x=pk2b(lo16(v.x)+lo16(t.x),hi16(v.x)+hi16(t.x)); v.y=pk2b(lo16(v.y)+lo16(t.y),hi16(v.y)+hi16(t.y)); v.z=pk2b(lo16(v.z)+lo16(t.z),hi16(v.z)+hi16(t.z)); v.w=pk2b(lo16(v.w)+lo16(t.w),hi16(v.w)+hi16(t.w)); }
      ATTN_STORE16(Ow+(long)row*PITCH+ch*8,v);} } }
  asm volatile("s_waitcnt lgkmcnt(0)\n\ts_barrier":::"memory");
  #undef DMA_K
  #undef DMA_V
  #undef CMASK
  #undef START
  #undef RESC
  #undef ROT
}
constexpr int ATTN_LDS_BYTES=LDS_BYTES;
#undef SBAR
#undef WAIT_BAR
}

constexpr int NWAVES = 8;
constexpr int B_ = 4, S_ = 8192, DM = 1024, M_ = B_ * S_, DIN = 7464, FF = 2816, NL = 2;
constexpr int YP = pg8::YP_;
constexpr float C2 = pg8::C2_, LOG2E = 1.4426950408889634f;
constexpr float NORM_EPS = 1e-6f;
constexpr int Y_AQ = 0, Y_AKC = 512, Y_AVC = 640, Y_AKS = 768, Y_AVS = 896, Y_AKW = 1024, Y_AVW = 1152, Y_CQ = 1280, Y_CK = 1792, Y_CV = 2304,
              Y_BQ = 2816, Y_BK = 3072, Y_BV = 3328, Y_BR = 3840, Y_AG = 4352, Y_BLR = 4376;
constexpr int NIN = 7680;
constexpr size_t MiB = 1u << 20;
constexpr size_t WS_CTL = 0, CTL_ZERO_BYTES = 1 * MiB;
constexpr size_t WS_WIN = 1 * MiB, WS_WA = 16 * MiB, WS_WB = 17 * MiB, WS_WC = 18 * MiB, WS_WO = 19 * MiB, WS_WF1 = 21 * MiB, WS_WF2 = 32 * MiB;
constexpr size_t WS_H = 40 * MiB;
constexpr size_t WS_Y = 104 * MiB;
constexpr size_t WS_G8 = 379 * MiB;
constexpr size_t WS_ACT = WS_Y + 128 * MiB;
constexpr size_t WS_SM = 475 * MiB;
constexpr size_t WS_KCMP = WS_SM, WS_VCMP = WS_SM + 1 * MiB, WS_KMEAN = WS_SM + 2 * MiB;
constexpr size_t WS_GA = WS_SM + 3 * MiB;
constexpr size_t WS_MASK = 38 * MiB;
constexpr size_t WS_OATMP = WS_H;
constexpr size_t WS_O16 = WS_H + 32 * MiB;
constexpr size_t WS_GST = WS_H + 32 * MiB;
constexpr size_t WS_GDEC = WS_SM + 3 * MiB;
constexpr size_t WS_END = 512 * MiB;
static_assert(WS_GA + (size_t)M_ * 256 * 4 <= WS_END && WS_Y + (size_t)M_ * YP * 2 <= WS_G8 && WS_G8 + (size_t)M_ * 3072 <= WS_SM, "ws map");
static_assert(WS_ACT + (size_t)M_ * FF * 2 <= WS_SM && WS_WF2 + (size_t)DM * FF * 2 <= WS_H, "ws map 2");
constexpr int CW_BAR = 4096;
constexpr int RING_OFF = 0, RING_BYTES = 131072;
constexpr int LDSCTL_OFF = RING_BYTES, MISC_OFF = LDSCTL_OFF + 320;
constexpr int LDS_BYTES = 147456;

#define GAS __attribute__((address_space(1)))
#define LAS __attribute__((address_space(3)))
typedef unsigned short bf16;
typedef unsigned v4u __attribute__((ext_vector_type(4)));
typedef float f32x4 __attribute__((ext_vector_type(4)));
typedef short bf16x8 __attribute__((ext_vector_type(8)));
typedef GAS unsigned gu32;
typedef GAS unsigned long long gu64;
#define RLX_AGENT __ATOMIC_RELAXED, __HIP_MEMORY_SCOPE_AGENT
#define LDS_WAIT() asm volatile("s_waitcnt lgkmcnt(0)" ::: "memory")
#define VM_WAIT() asm volatile("s_waitcnt vmcnt(0)" ::: "memory")
__device__ __forceinline__ unsigned long long rt() { return __builtin_amdgcn_s_memrealtime(); }
__device__ __forceinline__ unsigned f2bf(float f) { unsigned u = __builtin_bit_cast(unsigned, f); return (u + 0x7fffu + ((u >> 16) & 1u)) >> 16; }
__device__ __forceinline__ unsigned pk2(float lo, float hi) { return f2bf(lo) | (f2bf(hi) << 16); }

__device__ __forceinline__ float bf2f(bf16 h) { return __uint_as_float((unsigned)h << 16); }
__device__ __forceinline__ float sigm(float v) { return 1.f / (1.f + __expf(-v)); }
#define WFENCE() asm volatile("s_waitcnt lgkmcnt(0)" ::: "memory")

#define XB_TMO      128
#define XB_XCNT(j)  (256  + 64 * (j))
#define XB_XSUB(j)  (1280 + 64 * (j))
#define XB_XGEN(j)  (2304 + 64 * (j))
#define XB_TOP      3328
#define XB_TOPGEN   3392
#define XCD_BAR_WORDS 3456
#define XB_SPIN_CAP (1u << 18)

__device__ __forceinline__ unsigned xb_ld(unsigned* p)              { return __hip_atomic_load(p, __ATOMIC_RELAXED, __HIP_MEMORY_SCOPE_AGENT); }
__device__ __forceinline__ unsigned xb_add(unsigned* p, unsigned v) { return __hip_atomic_fetch_add(p, v, __ATOMIC_RELAXED, __HIP_MEMORY_SCOPE_AGENT); }
__device__ __forceinline__ unsigned xb_xcc_id() { return (unsigned)__builtin_amdgcn_s_getreg((3 << 11) | 20) & 0xFu; }
#define XB_SPIN(cond, bar) do { unsigned _sp = 0; while (cond) { __builtin_amdgcn_s_sleep(1); \
    if ((++_sp & 255u) == 0u) { if (xb_ld(&(bar)[XB_TMO])) break; if (_sp > XB_SPIN_CAP) { atomicAdd(&(bar)[XB_TMO], 1u); break; } } } } while (0)

struct XcdBarrier {
    unsigned* bar; unsigned x;
    volatile LAS unsigned* st;
};

__device__ __forceinline__ XcdBarrier xcd_barrier_post(unsigned* bar, volatile LAS unsigned* st) {
    XcdBarrier b; b.bar = bar; b.x = xb_xcc_id(); b.st = st;
    if (threadIdx.x == 0) (void)xb_add(&bar[XB_XCNT(b.x)], 1u);
    return b;
}
__device__ __forceinline__ void xcd_barrier_complete(unsigned* bar, unsigned x, unsigned& nloc, unsigned& nx) {
    const unsigned G = gridDim.x * gridDim.y * gridDim.z;
    unsigned sum, cnt, mine, sp = 0u;
    for (;;) {
        sum = 0u; cnt = 0u; mine = 0u;
#pragma unroll
        for (unsigned j = 0; j < 16; ++j) { const unsigned c = xb_ld(&bar[XB_XCNT(j)]); sum += c; cnt += (c > 0u) ? 1u : 0u; mine = (j == x) ? c : mine; }
        if (sum == G) break;
        __builtin_amdgcn_s_sleep(1);
        if ((++sp & 255u) == 0u) { if (xb_ld(&bar[XB_TMO])) break; if (sp > XB_SPIN_CAP) { atomicAdd(&bar[XB_TMO], 1u); break; } }
    }
    nloc = mine > 0u ? mine : 1u; nx = cnt > 0u ? cnt : 1u;
}

__device__ __forceinline__ void xcd_barrier(const XcdBarrier& b) {
    asm volatile("s_waitcnt vmcnt(0)" ::: "memory");
    __syncthreads();
    if (threadIdx.x == 0) {
        unsigned* bar = b.bar;
        __builtin_amdgcn_s_waitcnt(0);
        unsigned nloc = b.st[0], nx = b.st[1];
        if (nloc == 0u) { xcd_barrier_complete(bar, b.x, nloc, nx); b.st[0] = nloc; b.st[1] = nx; }
        const unsigned old = xb_add(&bar[XB_XSUB(b.x)], 1u);
        const unsigned gen = old / nloc;
        if (old + 1u == (gen + 1u) * nloc) {
            __builtin_amdgcn_fence(__ATOMIC_RELEASE, "agent");
            asm volatile("s_waitcnt vmcnt(0)" ::: "memory");
            const unsigned og = xb_add(&bar[XB_TOP], 1u);
            const unsigned tg = og / nx;
            if (og + 1u == (tg + 1u) * nx) xb_add(&bar[XB_TOPGEN], 1u);
            else XB_SPIN(xb_ld(&bar[XB_TOPGEN]) == tg, bar);
            __builtin_amdgcn_fence(__ATOMIC_ACQUIRE, "agent");
            xb_add(&bar[XB_XGEN(b.x)], 1u);
            asm volatile("s_waitcnt vmcnt(0)" ::: "memory");
        } else {
            XB_SPIN(xb_ld(&bar[XB_XGEN(b.x)]) == gen, bar);
            __builtin_amdgcn_fence(__ATOMIC_ACQUIRE, "agent");
            asm volatile("s_waitcnt vmcnt(0)" ::: "memory");
        }
    }
    __syncthreads();
}


struct Frame {
    LAS unsigned char* lds;
    volatile LAS unsigned* MISC;
    gu32* ctl;
    int tid, lane, wave, G;
};
__device__ __forceinline__ float wave_sum(float v) {
#pragma unroll
    for (int o = 1; o < 64; o <<= 1) v += __shfl_xor(v, o);
    return v;
}
__device__ __forceinline__ float wave_max(float v) {
#pragma unroll
    for (int o = 1; o < 64; o <<= 1) v = fmaxf(v, __shfl_xor(v, o));
    return v;
}
__device__ __forceinline__ int t5_bucket(int d) {
    if (d < 16) return d < 0 ? 0 : d;
    int b = 16;
    b += (d >= 19); b += (d >= 21); b += (d >= 24); b += (d >= 27); b += (d >= 31); b += (d >= 35); b += (d >= 40); b += (d >= 46);
    b += (d >= 52); b += (d >= 59); b += (d >= 67); b += (d >= 77); b += (d >= 87); b += (d >= 99); b += (d >= 113);
    return b;
}
template <class CM> __device__ __forceinline__ void tr_item(const float* W, int Nsrc, int K, bf16* WT, int item, int nblk, CM cm, LAS float* scr, int lane) {
    const int kb = item / nblk, nb = item % nblk, k0 = 64 * kb, n0 = 32 * nb;
    const int sc = cm(n0 + (lane & 31));
#pragma unroll 8
    for (int i = 0; i < 32; ++i) { const int kk = 2 * i + (lane >> 5); scr[kk * 33 + (lane & 31)] = sc >= 0 ? W[(size_t)(k0 + kk) * Nsrc + sc] : 0.f; }
    LDS_WAIT(); asm volatile("" ::: "memory");
    const int c = lane & 7;
#pragma unroll
    for (int j = 0; j < 4; ++j) { const int n = (lane >> 3) + 8 * j; const LAS float* s = scr + (8 * c) * 33 + n;
        v4u o; o.x = pk2(s[0 * 33], s[1 * 33]); o.y = pk2(s[2 * 33], s[3 * 33]); o.z = pk2(s[4 * 33], s[5 * 33]); o.w = pk2(s[6 * 33], s[7 * 33]);
        *(GAS v4u*)(WT + (size_t)(n0 + n) * K + k0 + 8 * c) = o; }
    LDS_WAIT(); asm volatile("" ::: "memory");
}
struct CmId { __device__ __forceinline__ int operator()(int n) const { return n; } };
struct CmWin { __device__ __forceinline__ int operator()(int n) const {
    if (n < 1280) return n;
    if (n < 2816) return n - 1280 + 2856;
    if (n < 4352) return n - 2816 + 1304;
    if (n < 4376) return n - 4352 + 1280;
    if (n < 4392) return n - 4376 + 2840;
    if (n < 4608) return -1;
    return n - 4608 + 4392; } };
struct CmFfn { __device__ __forceinline__ int operator()(int c) const { const int p = c >> 8, r = c & 255; return r < 128 ? 128 * p + r : FF + 128 * p + (r - 128); } };

struct Args { const float* in[22]; float* out; unsigned char* ws; int ph_lo, ph_hi; };

__device__ __forceinline__ void phase_weights(Frame& F, const Args& a, int l) {
    LAS float* scr = (LAS float*)(F.lds + RING_OFF + F.wave * 16384);
    const int gw = blockIdx.x * NWAVES + F.wave, NGW = F.G * NWAVES;
    unsigned char* ws = a.ws;
    constexpr int I_IN = 16 * (NIN / 32), I_BR = 8 * 32, I_O = 16 * 32, I_F1 = 16 * (2 * FF / 32), I_F2 = (FF / 64) * 32;
    constexpr int NIT = I_IN + 3 * I_BR + I_O + I_F1 + I_F2;
    for (int it = gw; it < NIT; it += NGW) {
        int r = it;
        if (r < I_IN) { tr_item(a.in[6] + (size_t)l * DM * DIN, DIN, DM, (bf16*)(ws + WS_WIN), r, NIN / 32, CmWin(), scr, F.lane); continue; } r -= I_IN;
        if (r < I_BR) { tr_item(a.in[16] + (size_t)l * 512 * DM, DM, 512, (bf16*)(ws + WS_WA), r, 32, CmId(), scr, F.lane); continue; } r -= I_BR;
        if (r < I_BR) { tr_item(a.in[17] + (size_t)l * 512 * DM, DM, 512, (bf16*)(ws + WS_WB), r, 32, CmId(), scr, F.lane); continue; } r -= I_BR;
        if (r < I_BR) { tr_item(a.in[18] + (size_t)l * 512 * DM, DM, 512, (bf16*)(ws + WS_WC), r, 32, CmId(), scr, F.lane); continue; } r -= I_BR;
        if (r < I_O) { tr_item(a.in[19] + (size_t)l * DM * DM, DM, DM, (bf16*)(ws + WS_WO), r, 32, CmId(), scr, F.lane); continue; } r -= I_O;
        if (r < I_F1) { tr_item(a.in[20] + (size_t)l * DM * 2 * FF, 2 * FF, DM, (bf16*)(ws + WS_WF1), r, 2 * FF / 32, CmFfn(), scr, F.lane); continue; } r -= I_F1;
        tr_item(a.in[21] + (size_t)l * FF * DM, DM, FF, (bf16*)(ws + WS_WF2), r, 32, CmId(), scr, F.lane);
    }
}
__device__ __forceinline__ void phase_norm0(Frame& F, const float* x, const float* w, bf16* H) {
    const int gw = blockIdx.x * NWAVES + F.wave, NGW = F.G * NWAVES;
    for (int m = gw; m < M_; m += NGW) {
        const f32x4* xr = (const f32x4*)(x + (size_t)m * DM) + F.lane; f32x4 v[4]; float s = 0.f;
#pragma unroll
        for (int j = 0; j < 4; ++j) { v[j] = xr[64 * j]; s += v[j].x * v[j].x + v[j].y * v[j].y + v[j].z * v[j].z + v[j].w * v[j].w; }
        const float r = rsqrtf(wave_sum(s) * (1.f / DM) + NORM_EPS);
        unsigned long long* o8 = (unsigned long long*)(H + (size_t)m * DM) + F.lane;
#pragma unroll
        for (int j = 0; j < 4; ++j) { const f32x4 wv = ((const f32x4*)w)[F.lane + 64 * j];
            o8[64 * j] = (unsigned long long)pk2(v[j].x * r * wv.x, v[j].y * r * wv.y) | ((unsigned long long)pk2(v[j].z * r * wv.z, v[j].w * r * wv.w) << 32); }
    }
}
__device__ __forceinline__ void phase_resid(Frame& F, const float* y, const float* xin, float* xout, const float* wpost, const float* wpre, bf16* hout) {
    const int gw = blockIdx.x * NWAVES + F.wave, NGW = F.G * NWAVES;
    for (int m = gw; m < M_; m += NGW) {
        const f32x4* yr = (const f32x4*)(y + (size_t)m * DM) + F.lane; const f32x4* xr = (const f32x4*)(xin + (size_t)m * DM) + F.lane;
        f32x4 v[4], xv[4]; float s = 0.f;
#pragma unroll
        for (int j = 0; j < 4; ++j) { v[j] = yr[64 * j]; xv[j] = xr[64 * j]; s += v[j].x * v[j].x + v[j].y * v[j].y + v[j].z * v[j].z + v[j].w * v[j].w; }
        const float r = rsqrtf(wave_sum(s) * (1.f / DM) + NORM_EPS); float s2 = 0.f;
        f32x4* xo = (f32x4*)(xout + (size_t)m * DM) + F.lane;
#pragma unroll
        for (int j = 0; j < 4; ++j) { const f32x4 wv = ((const f32x4*)wpost)[F.lane + 64 * j]; f32x4 n;
            n.x = xv[j].x + v[j].x * r * wv.x; n.y = xv[j].y + v[j].y * r * wv.y; n.z = xv[j].z + v[j].z * r * wv.z; n.w = xv[j].w + v[j].w * r * wv.w;
            xo[64 * j] = n; v[j] = n; s2 += n.x * n.x + n.y * n.y + n.z * n.z + n.w * n.w; }
        if (hout) { const float r2 = rsqrtf(wave_sum(s2) * (1.f / DM) + NORM_EPS);
            unsigned long long* o8 = (unsigned long long*)(hout + (size_t)m * DM) + F.lane;
#pragma unroll
            for (int j = 0; j < 4; ++j) { const f32x4 wv = ((const f32x4*)wpre)[F.lane + 64 * j];
                o8[64 * j] = (unsigned long long)pk2(v[j].x * r2 * wv.x, v[j].y * r2 * wv.y) | ((unsigned long long)pk2(v[j].z * r2 * wv.z, v[j].w * r2 * wv.w) << 32); } }
    }
}
__device__ __forceinline__ void unpack8(const v4u w, float (&k)[8]) {
    k[0] = __uint_as_float(w.x << 16); k[1] = __uint_as_float(w.x & 0xffff0000u); k[2] = __uint_as_float(w.y << 16); k[3] = __uint_as_float(w.y & 0xffff0000u);
    k[4] = __uint_as_float(w.z << 16); k[5] = __uint_as_float(w.z & 0xffff0000u); k[6] = __uint_as_float(w.w << 16); k[7] = __uint_as_float(w.w & 0xffff0000u);
}
__device__ __forceinline__ void dot4(const LAS float* qs, const bf16* kr, float (&d)[4]) {
    d[0] = d[1] = d[2] = d[3] = 0.f;
#pragma unroll 1
    for (int c = 0; c < 8; ++c) { asm volatile("" ::: "memory"); const v4u w = ((const v4u*)kr)[c]; float k[8]; unpack8(w, k);
#pragma unroll
        for (int e = 0; e < 8; ++e) { const int dd = c * 8 + e;
#pragma unroll
            for (int h = 0; h < 4; ++h) d[h] += qs[h * 64 + dd] * k[e]; } }
}
__device__ __forceinline__ float dot1(const LAS float* qs, const bf16* kr) {
    float d = 0.f;
#pragma unroll
    for (int c = 0; c < 8; ++c) { const v4u w = ((const v4u*)kr)[c]; float k[8]; unpack8(w, k);
#pragma unroll
        for (int e = 0; e < 8; ++e) d += qs[c * 8 + e] * k[e]; }
    return d;
}
__device__ __forceinline__ float gelu_tanh(float x) { const float u = 0.7978845608028654f * (x + 0.044715f * x * x * x); return 0.5f * x * (1.f + tanhf(u)); }

__device__ __forceinline__ void phase2_naive(Frame& F, const Args& a, int l) {
    const int gw = blockIdx.x * NWAVES + F.wave, NGW = F.G * NWAVES, lane = F.lane;
    const bf16* Y = (const bf16*)(a.ws + WS_Y);
    LAS float* scr = (LAS float*)(F.lds + RING_OFF + F.wave * 16384);
    for (int t = gw; t < 2 * 8 * 511; t += NGW) {
        const int kv = t / (8 * 511), r = t % (8 * 511), bg = r / 511, n = r % 511, b = bg >> 1, g = bg & 1;
        const float* pe = a.in[kv ? 8 : 7] + (size_t)l * 32 * 64; const float* w1 = a.in[kv ? 11 : 9] + (size_t)l * 2048 * 64; const float* w2 = a.in[kv ? 12 : 10] + (size_t)l * 64 * 64;
        const bf16* src = Y + ((size_t)b * S_ + 16 * n) * YP + (kv ? Y_AVC : Y_AKC) + g * 64;
        float acc = 0.f;
        for (int pos = 0; pos < 32; ++pos) {
            const float xin = bf2f(src[(size_t)pos * YP + lane]) + pe[pos * 64 + lane];
            scr[lane] = xin; WFENCE();
#pragma unroll 8
            for (int d = 0; d < 64; ++d) acc += scr[d] * w1[(size_t)(pos * 64 + d) * 64 + lane];
            WFENCE();
        }
        const float hdn = gelu_tanh(acc);
        scr[lane] = hdn; WFENCE();
        float o = 0.f;
#pragma unroll 8
        for (int j = 0; j < 64; ++j) o += scr[j] * w2[j * 64 + lane];
        WFENCE();
        bf16* dst = (bf16*)(a.ws + (kv ? WS_VCMP : WS_KCMP)) + ((size_t)bg * 512 + n) * 64;
        dst[lane] = (bf16)f2bf(o);
    }
    for (int t = gw; t < 4 * 8 * 32; t += NGW) {
        const int blk = t & 31, h = (t >> 5) & 7, b = t >> 8;
        const bf16* src = Y + ((size_t)b * S_ + blk * 256) * YP + Y_CK + h * 64 + lane; float s = 0.f;
        for (int i = 0; i < 256; ++i) s += bf2f(src[(size_t)i * YP]);
        ((float*)(a.ws + WS_KMEAN))[(size_t)t * 64 + lane] = s * (1.f / 256.f);
    }
}
__device__ __forceinline__ void gla_scan_naive(Frame& F, const Args& a) {
    const bf16* Y = (const bf16*)(a.ws + WS_Y); const float* GA = (const float*)(a.ws + WS_GA); bf16* O16 = (bf16*)(a.ws + WS_O16);
    const int lane = F.lane;
    for (int task = blockIdx.x; task < 256; task += F.G) {
        const int eg = task & 15, h = (task >> 4) & 3, b = task >> 6, e = eg * 8 + F.wave;
        float Sst = 0.f;
        for (int t0 = 0; t0 < S_; t0 += 8) {
            float av[8], kv[8], qv[8], vv[8];
#pragma unroll
            for (int j = 0; j < 8; ++j) { const size_t row = (size_t)b * S_ + t0 + j;
                av[j] = GA[row * 256 + h * 64 + lane]; kv[j] = bf2f(Y[row * YP + Y_BK + h * 64 + lane]); qv[j] = bf2f(Y[row * YP + Y_BQ + h * 64 + lane]); vv[j] = bf2f(Y[row * YP + Y_BV + h * 128 + e]); }
#pragma unroll
            for (int j = 0; j < 8; ++j) { Sst = av[j] * Sst + kv[j] * vv[j]; const float o = wave_sum(qv[j] * Sst);
                if (lane == 0) O16[((size_t)b * S_ + t0 + j) * 512 + h * 128 + e] = (bf16)f2bf(o); }
        }
    }
}
__device__ __forceinline__ void nsa_cmp_naive(Frame& F, const Args& a) {
    const int gw = blockIdx.x * NWAVES + F.wave, NGW = F.G * NWAVES, lane = F.lane;
    bf16* Y = (bf16*)(a.ws + WS_Y); const float* rel = a.in[1];
    LAS float* scr = (LAS float*)(F.lds + RING_OFF + F.wave * 16384);
    LAS float* qs = scr; LAS float* sc = scr + 256; LAS float* s2 = scr + 256 + 2048;
    for (int task = gw; task < 8 * S_; task += NGW) {
        const int q = task & (S_ - 1), bg = task >> 13, g = bg & 1, b = bg >> 1;
        const size_t row = (size_t)b * S_ + q; bf16* Yr = Y + row * YP;
#pragma unroll
        for (int h = 0; h < 4; ++h) qs[h * 64 + lane] = bf2f(Yr[Y_AQ + (g * 4 + h) * 64 + lane]);
        float gt[4][3];
#pragma unroll
        for (int h = 0; h < 4; ++h)
#pragma unroll
            for (int br = 0; br < 3; ++br) gt[h][br] = sigm(bf2f(Yr[Y_AG + (g * 4 + h) * 3 + br]));
        WFENCE();
        const int cur = q >> 6, ncv = q >= 31 ? ((q - 31) >> 4) + 1 : 0;
        const bf16* KC = (const bf16*)(a.ws + WS_KCMP) + (size_t)bg * 512 * 64; const bf16* VC = (const bf16*)(a.ws + WS_VCMP) + (size_t)bg * 512 * 64;
        float mx[4] = {-1e30f, -1e30f, -1e30f, -1e30f};
        for (int i = 0; i < 8; ++i) { const int n = lane + 64 * i;
            if (n < ncv) { float d[4]; dot4(qs, KC + (size_t)n * 64, d); const int bk = t5_bucket(q - (16 * n + 31));
#pragma unroll
                for (int h = 0; h < 4; ++h) { const float s = d[h] + rel[bk * 16 + g * 4 + h] * LOG2E; sc[h * 512 + n] = s; mx[h] = fmaxf(mx[h], s); } }
            else {
#pragma unroll
                for (int h = 0; h < 4; ++h) sc[h * 512 + n] = 0.f; } }
        float ls[4] = {0.f, 0.f, 0.f, 0.f};
#pragma unroll
        for (int h = 0; h < 4; ++h) mx[h] = wave_max(mx[h]);
        WFENCE();
        for (int i = 0; i < 8; ++i) { const int n = lane + 64 * i;
            if (n < ncv) {
#pragma unroll
                for (int h = 0; h < 4; ++h) { const float e = exp2f(sc[h * 512 + n] - mx[h]); sc[h * 512 + n] = e; ls[h] += e; } } }
#pragma unroll
        for (int h = 0; h < 4; ++h) ls[h] = 1.f / fmaxf(wave_sum(ls[h]), 1e-20f);
        for (int i = 0; i < 8; ++i) { const int n = lane + 64 * i;
            if (n < ncv) {
#pragma unroll
                for (int h = 0; h < 4; ++h) sc[h * 512 + n] *= ls[h]; } }
        WFENCE();
        float v0, v1;
        { float t[2];
#pragma unroll
          for (int jj = 0; jj < 2; ++jj) { const int j = lane + 64 * jj; float v = 0.f;
              for (int n = 4 * j - 1; n <= 4 * j + 3; ++n) if (n >= 0 && n < 511) v += (sc[n] + sc[512 + n]) + (sc[1024 + n] + sc[1536 + n]);
              const bool forced = (j == 0) || (j == cur) || (j == cur - 1);
              t[jj] = forced ? 1e9f : (j <= cur ? v : -1e30f); }
          v0 = t[0]; v1 = t[1]; }
        bool sel0 = false, sel1 = false;
        for (int it = 0; it < 16; ++it) {
            const float c0 = sel0 ? -INFINITY : v0, c1 = sel1 ? -INFINITY : v1;
            const float mxv = wave_max(fmaxf(c0, c1));
            const unsigned long long m0 = __ballot(!sel0 && v0 == mxv);
            if (m0) { const int idx = __builtin_ctzll(m0); if (lane == idx) sel0 = true; }
            else { const unsigned long long m1 = __ballot(!sel1 && v1 == mxv); const int idx = m1 ? __builtin_ctzll(m1) : -1; if (lane == idx) sel1 = true; }
        }
        sel0 = sel0 && (lane <= cur); sel1 = sel1 && (lane + 64 <= cur);
        const unsigned long long sm0 = __ballot(sel0), sm1 = __ballot(sel1);
        float oc[4] = {0.f, 0.f, 0.f, 0.f};
        for (int n = 0; n < ncv; ++n) { const float vv = bf2f(VC[(size_t)n * 64 + lane]);
#pragma unroll
            for (int h = 0; h < 4; ++h) oc[h] += sc[h * 512 + n] * vv; }
        { unsigned* MK = (unsigned*)(a.ws + WS_MASK) + ((size_t)bg * S_ + q) * 4;
          if (lane == 0) { MK[0] = (unsigned)sm0; MK[1] = (unsigned)(sm0 >> 32); MK[2] = (unsigned)sm1; MK[3] = (unsigned)(sm1 >> 32); }
          bf16* T = (bf16*)(a.ws + WS_OATMP) + row * 512;
#pragma unroll
          for (int h = 0; h < 4; ++h) T[(g * 4 + h) * 64 + lane] = (bf16)f2bf(gt[h][0] * oc[h]); }
        WFENCE();
    }
}
__device__ __forceinline__ void nsa_naive(Frame& F, const Args& a) {
    const int gw = blockIdx.x * NWAVES + F.wave, NGW = F.G * NWAVES, lane = F.lane;
    bf16* Y = (bf16*)(a.ws + WS_Y); const float* rel = a.in[1];
    LAS float* scr = (LAS float*)(F.lds + RING_OFF + F.wave * 16384);
    LAS float* qs = scr; LAS float* sc = scr + 256; LAS float* s2 = scr + 256 + 2048;
    for (int task = gw; task < 8 * S_; task += NGW) {
        const int q = task & (S_ - 1), bg = task >> 13, g = bg & 1, b = bg >> 1;
        const size_t row = (size_t)b * S_ + q; bf16* Yr = Y + row * YP;
#pragma unroll
        for (int h = 0; h < 4; ++h) qs[h * 64 + lane] = bf2f(Yr[Y_AQ + (g * 4 + h) * 64 + lane]);
        float gt[4][3];
#pragma unroll
        for (int h = 0; h < 4; ++h)
#pragma unroll
            for (int br = 0; br < 3; ++br) gt[h][br] = sigm(bf2f(Yr[Y_AG + (g * 4 + h) * 3 + br]));
        WFENCE();
        const int cur = q >> 6, ncv = q >= 31 ? ((q - 31) >> 4) + 1 : 0;
        const bf16* KC = (const bf16*)(a.ws + WS_KCMP) + (size_t)bg * 512 * 64; const bf16* VC = (const bf16*)(a.ws + WS_VCMP) + (size_t)bg * 512 * 64;
        float mx[4] = {-1e30f, -1e30f, -1e30f, -1e30f};
        for (int i = 0; i < 8; ++i) { const int n = lane + 64 * i;
            if (n < ncv) { float d[4]; dot4(qs, KC + (size_t)n * 64, d); const int bk = t5_bucket(q - (16 * n + 31));
#pragma unroll
                for (int h = 0; h < 4; ++h) { const float s = d[h] + rel[bk * 16 + g * 4 + h] * LOG2E; sc[h * 512 + n] = s; mx[h] = fmaxf(mx[h], s); } }
            else {
#pragma unroll
                for (int h = 0; h < 4; ++h) sc[h * 512 + n] = 0.f; } }
        float ls[4] = {0.f, 0.f, 0.f, 0.f};
#pragma unroll
        for (int h = 0; h < 4; ++h) mx[h] = wave_max(mx[h]);
        WFENCE();
        for (int i = 0; i < 8; ++i) { const int n = lane + 64 * i;
            if (n < ncv) {
#pragma unroll
                for (int h = 0; h < 4; ++h) { const float e = exp2f(sc[h * 512 + n] - mx[h]); sc[h * 512 + n] = e; ls[h] += e; } } }
#pragma unroll
        for (int h = 0; h < 4; ++h) ls[h] = 1.f / fmaxf(wave_sum(ls[h]), 1e-20f);
        for (int i = 0; i < 8; ++i) { const int n = lane + 64 * i;
            if (n < ncv) {
#pragma unroll
                for (int h = 0; h < 4; ++h) sc[h * 512 + n] *= ls[h]; } }
        WFENCE();
        float v0, v1;
        { float t[2];
#pragma unroll
          for (int jj = 0; jj < 2; ++jj) { const int j = lane + 64 * jj; float v = 0.f;
              for (int n = 4 * j - 1; n <= 4 * j + 3; ++n) if (n >= 0 && n < 511) v += (sc[n] + sc[512 + n]) + (sc[1024 + n] + sc[1536 + n]);
              const bool forced = (j == 0) || (j == cur) || (j == cur - 1);
              t[jj] = forced ? 1e9f : (j <= cur ? v : -1e30f); }
          v0 = t[0]; v1 = t[1]; }
        bool sel0 = false, sel1 = false;
        for (int it = 0; it < 16; ++it) {
            const float c0 = sel0 ? -INFINITY : v0, c1 = sel1 ? -INFINITY : v1;
            const float mxv = wave_max(fmaxf(c0, c1));
            const unsigned long long m0 = __ballot(!sel0 && v0 == mxv);
            if (m0) { const int idx = __builtin_ctzll(m0); if (lane == idx) sel0 = true; }
            else { const unsigned long long m1 = __ballot(!sel1 && v1 == mxv); const int idx = m1 ? __builtin_ctzll(m1) : -1; if (lane == idx) sel1 = true; }
        }
        sel0 = sel0 && (lane <= cur); sel1 = sel1 && (lane + 64 <= cur);
        const unsigned long long sm0 = __ballot(sel0), sm1 = __ballot(sel1);
        float oc[4] = {0.f, 0.f, 0.f, 0.f};
        for (int n = 0; n < ncv; ++n) { const float vv = bf2f(VC[(size_t)n * 64 + lane]);
#pragma unroll
            for (int h = 0; h < 4; ++h) oc[h] += sc[h * 512 + n] * vv; }
        float ms[4] = {-1e30f, -1e30f, -1e30f, -1e30f}, lsel[4] = {0.f, 0.f, 0.f, 0.f}, os[4] = {0.f, 0.f, 0.f, 0.f};
        for (int j = 0; j <= cur; ++j) {
            const bool on = j < 64 ? ((sm0 >> j) & 1ull) : ((sm1 >> (j - 64)) & 1ull);
            if (!on) continue;
            const int kpos = 64 * j + lane; const bool valid = kpos <= q;
            float d[4]; dot4(qs, Y + ((size_t)b * S_ + kpos) * YP + Y_AKS + g * 64, d);
            const int bk = t5_bucket(q - kpos);
            WFENCE();
#pragma unroll
            for (int h = 0; h < 4; ++h) { const float s = valid ? d[h] + rel[bk * 16 + g * 4 + h] * LOG2E : -1e30f;
                const float mn = fmaxf(ms[h], wave_max(s)); const float p = valid ? exp2f(s - mn) : 0.f; s2[h * 64 + lane] = p;
                const float scl = exp2f(ms[h] - mn); lsel[h] = lsel[h] * scl + wave_sum(p); os[h] *= scl; ms[h] = mn; }
            WFENCE();
            const bf16* vb = Y + ((size_t)b * S_ + 64 * j) * YP + Y_AVS + g * 64 + lane;
            for (int kk = 0; kk < 64; ++kk) { const float vv = bf2f(vb[(size_t)kk * YP]);
#pragma unroll
                for (int h = 0; h < 4; ++h) os[h] += s2[h * 64 + kk] * vv; }
        }
        float mw[4] = {-1e30f, -1e30f, -1e30f, -1e30f}, lw[4] = {0.f, 0.f, 0.f, 0.f}, ow[4] = {0.f, 0.f, 0.f, 0.f};
        for (int c = 0; c < 8; ++c) {
            if (q - 64 * c < 0) break;
            const int dist = 64 * c + lane, kpos = q - dist; const bool valid = kpos >= 0;
            float d[4]; dot4(qs, Y + ((size_t)b * S_ + (valid ? kpos : 0)) * YP + Y_AKW + g * 64, d);
            const int bk = t5_bucket(dist);
            WFENCE();
#pragma unroll
            for (int h = 0; h < 4; ++h) { const float s = valid ? d[h] + rel[bk * 16 + g * 4 + h] * LOG2E : -1e30f;
                const float mn = fmaxf(mw[h], wave_max(s)); const float p = valid ? exp2f(s - mn) : 0.f; s2[h * 64 + lane] = p;
                const float scl = exp2f(mw[h] - mn); lw[h] = lw[h] * scl + wave_sum(p); ow[h] *= scl; mw[h] = mn; }
            WFENCE();
            for (int kk = 0; kk < 64; ++kk) { const int kp = q - 64 * c - kk; if (kp < 0) break;
                const float vv = bf2f(Y[((size_t)b * S_ + kp) * YP + Y_AVW + g * 64 + lane]);
#pragma unroll
                for (int h = 0; h < 4; ++h) ow[h] += s2[h * 64 + kk] * vv; }
        }
        WFENCE();
#pragma unroll
        for (int h = 0; h < 4; ++h) { const float o = gt[h][0] * oc[h] + gt[h][1] * os[h] / fmaxf(lsel[h], 1e-20f) + gt[h][2] * ow[h] / fmaxf(lw[h], 1e-20f);
            Yr[Y_AQ + (g * 4 + h) * 64 + lane] = (bf16)f2bf(o); }
    }
}
__device__ __forceinline__ void moba_naive(Frame& F, const Args& a) {
    const int gw = blockIdx.x * NWAVES + F.wave, NGW = F.G * NWAVES, lane = F.lane;
    bf16* Y = (bf16*)(a.ws + WS_Y); const float* rel = a.in[1]; const float* KM = (const float*)(a.ws + WS_KMEAN);
    LAS float* scr = (LAS float*)(F.lds + RING_OFF + F.wave * 16384);
    LAS float* qs = scr; LAS float* s2 = scr + 64;
    for (int task = gw; task < 32 * S_; task += NGW) {
        const int q = task & (S_ - 1), bh = task >> 13, h = bh & 7, b = bh >> 3;
        const size_t row = (size_t)b * S_ + q; bf16* Yr = Y + row * YP;
        WFENCE();
        qs[lane] = bf2f(Yr[Y_CQ + h * 64 + lane]);
        WFENCE();
        const int cur = q >> 8;
        float gs = -1e30f;
        if (lane < 32 && lane < cur) { const float* km = KM + ((size_t)bh * 32 + lane) * 64; float d = 0.f;
            for (int dd = 0; dd < 64; ++dd) d += qs[dd] * km[dd];
            gs = d; }
        if (lane >= 32) gs = -INFINITY;
        bool sel = false;
        for (int it = 0; it < 3; ++it) { const float c = sel ? -INFINITY : gs; const float mxv = wave_max(c);
            const unsigned long long m0 = __ballot(!sel && lane < 32 && gs == mxv); const int idx = m0 ? __builtin_ctzll(m0) : -1; if (lane == idx) sel = true; }
        sel = sel && (lane < cur);
        const unsigned smask = (unsigned)__ballot(sel);
        float mr = -1e30f, lr = 0.f, o = 0.f;
        for (int j = 0; j <= cur; ++j) {
            const bool own = (j == cur);
            if (!own && !((smask >> j) & 1u)) continue;
            for (int c = 0; c < 4; ++c) {
                const int kpos = 256 * j + 64 * c + lane; const bool valid = kpos <= q;
                if (256 * j + 64 * c > q) break;
                const float d = dot1(qs, Y + ((size_t)b * S_ + kpos) * YP + Y_CK + h * 64);
                const int bk = t5_bucket(q - kpos);
                const float s = valid ? d + rel[bk * 16 + 8 + h] * LOG2E : -1e30f;
                const float mn = fmaxf(mr, wave_max(s)); const float p = valid ? exp2f(s - mn) : 0.f;
                WFENCE(); s2[lane] = p; WFENCE();
                const float scl = exp2f(mr - mn); lr = lr * scl + wave_sum(p); o *= scl; mr = mn;
                const bf16* vb = Y + ((size_t)b * S_ + 256 * j + 64 * c) * YP + Y_CV + h * 64 + lane;
                for (int kk = 0; kk < 64; ++kk) o += s2[kk] * bf2f(vb[(size_t)kk * YP]);
            }
        }
        Yr[Y_CQ + h * 64 + lane] = (bf16)f2bf(o / fmaxf(lr, 1e-20f));
    }
}
constexpr int CW_Q = 8192;
__device__ __forceinline__ int next_unit(Frame& F, int k) {
    __syncthreads();
    if (F.tid == 0) F.MISC[16] = __hip_atomic_fetch_add(F.ctl + CW_Q + 64 * k, 1u, RLX_AGENT);
    __syncthreads();
    return (int)F.MISC[16];
}
__device__ __forceinline__ void moba_fast(Frame& F, const Args& a, int qk) {
    bf16* Y = (bf16*)(a.ws + WS_Y); const float* KM = (const float*)(a.ws + WS_KMEAN);
    for (;;) {
        const int u = next_unit(F, qk); if (u >= 1024) break;
        const int qb = 31 - (u >> 5), bh = u & 31, b = bh >> 3, h = bh & 7; const long rowbase = (long)b * S_;
        attn::UArgs U{};
        U.Qb = Y + (rowbase + qb * 256) * YP + Y_CQ + h * 64; U.Kh = Y + rowbase * YP + Y_CK + h * 64; U.Vh = Y + rowbase * YP + Y_CV + h * 64; U.Ob = Y + (rowbase + qb * 256) * YP + Y_CQ + h * 64;
        U.NT = 4 * (qb + 1); U.q0 = qb * 256; U.kt0 = 0; U.hc = 8 + h; U.rel = a.in[1]; U.km = KM + (size_t)bh * 32 * 64; U.qb = qb;
        attn::attn_unit<0, 0, 8>(U, (char*)F.lds + RING_OFF);
    }
}
__device__ __forceinline__ void nsa_fast(Frame& F, const Args& a, int qk) {
    bf16* Y = (bf16*)(a.ws + WS_Y);
    for (;;) {
        const int u = next_unit(F, qk); if (u >= 1024) break;
        const int qb = 31 - (u >> 5), bh = u & 31, b = bh >> 3, h = bh & 7, g = h >> 2; const long rowbase = (long)b * S_; const int q0 = qb * 256;
        attn::UArgs U{};
        U.Qb = Y + (rowbase + q0) * YP + Y_AQ + h * 64; U.Ob = Y + (rowbase + q0) * YP + Y_AQ + h * 64; U.q0 = q0; U.hc = h; U.rel = a.in[1]; U.gate = Y + (rowbase + q0) * YP;
        { const int T0 = 4 * qb - 8 > 0 ? 4 * qb - 8 : 0;
          U.Kh = Y + (rowbase + 64 * T0) * YP + Y_AKW + g * 64; U.Vh = Y + (rowbase + 64 * T0) * YP + Y_AVW + g * 64; U.NT = 4 * qb + 4 - T0; U.kt0 = 64 * T0; U.gcol = Y_AG + h * 3 + 2;
          attn::attn_unit<2, 1, 8>(U, (char*)F.lds + RING_OFF); }
        { U.Kh = Y + rowbase * YP + Y_AKS + g * 64; U.Vh = Y + rowbase * YP + Y_AVS + g * 64; U.NT = 4 * (qb + 1); U.kt0 = 0; U.gcol = Y_AG + h * 3 + 1;
          U.selg = (const unsigned*)(a.ws + WS_MASK) + ((size_t)(b * 2 + g) * S_ + q0) * 4; U.tmp = (const bf16*)(a.ws + WS_OATMP) + (rowbase + q0) * 512 + h * 64;
          attn::attn_unit<1, 2, 8>(U, (char*)F.lds + RING_OFF); }
    }
}
typedef float f32x16g __attribute__((ext_vector_type(16)));
constexpr int GP = 72;
constexpr int GL_GS = 0;
constexpr int GL_VT = 16640 + 0;
constexpr int GL_A0 = GL_VT + 128 * GP * 2;
constexpr int GL_A1 = GL_A0 + 64 * GP * 2;
constexpr int GL_A2 = GL_A1 + 64 * GP * 2;
constexpr int GL_SS = GL_A2 + 64 * GP * 2;
constexpr int GL_END = GL_SS + 1024;
static_assert(GL_END <= RING_BYTES, "GLA LDS map");
__device__ __forceinline__ int crow32(int r, int hi) { return (r & 3) + 8 * (r >> 2) + 4 * hi; }
__device__ __forceinline__ void gla_bcum(Frame& F, const Args& a, int l, const bf16* Yc  , int h) {
    LAS float* gS = (LAS float*)(F.lds + RING_OFF + GL_GS);
    const int t = F.tid >> 3, dg = F.tid & 7;
    const float* w2 = a.in[13] + (size_t)l * 16 * 256 + h * 64 + dg * 8; const float* bias = a.in[14] + (size_t)l * 256 + h * 64 + dg * 8;
    float blr[16];
    { const v4u w0 = *(const v4u*)(Yc + (size_t)t * YP + Y_BLR), w1 = *(const v4u*)(Yc + (size_t)t * YP + Y_BLR + 8); float k0[8], k1[8]; unpack8(w0, k0); unpack8(w1, k1);
#pragma unroll
      for (int i = 0; i < 8; ++i) { blr[i] = k0[i]; blr[8 + i] = k1[i]; } }
    float z[8];
#pragma unroll
    for (int i = 0; i < 8; ++i) z[i] = bias[i];
#pragma unroll
    for (int r = 0; r < 16; ++r) { const f32x4 wa = *(const f32x4*)(w2 + r * 256), wb = *(const f32x4*)(w2 + r * 256 + 4);
        z[0] += blr[r] * wa.x; z[1] += blr[r] * wa.y; z[2] += blr[r] * wa.z; z[3] += blr[r] * wa.w; z[4] += blr[r] * wb.x; z[5] += blr[r] * wb.y; z[6] += blr[r] * wb.z; z[7] += blr[r] * wb.w; }
#pragma unroll
    for (int i = 0; i < 8; ++i) { const float zz = z[i]; gS[t * 65 + dg * 8 + i] = -(fmaxf(-zz, 0.f) + log1pf(__expf(-fabsf(zz)))) * (1.f / 16.f); }
    __syncthreads();
    if (F.tid < 64) { float acc = 0.f;
#pragma unroll 8
        for (int tt = 0; tt < 64; ++tt) { acc += gS[tt * 65 + F.tid]; gS[tt * 65 + F.tid] = acc; } }
    __syncthreads();
}
__device__ __forceinline__ void gla_stage_vT(Frame& F, const bf16* Yc, int h) {
    LAS bf16* vT = (LAS bf16*)(F.lds + RING_OFF + GL_VT); const int t = F.tid >> 3, dg = F.tid & 7;
    const v4u w0 = *(const v4u*)(Yc + (size_t)t * YP + Y_BV + h * 128 + dg * 16), w1 = *(const v4u*)(Yc + (size_t)t * YP + Y_BV + h * 128 + dg * 16 + 8);
    const unsigned ww[8] = {w0.x, w0.y, w0.z, w0.w, w1.x, w1.y, w1.z, w1.w};
#pragma unroll
    for (int i = 0; i < 8; ++i) { vT[(dg * 16 + 2 * i) * GP + t] = (bf16)(ww[i] & 0xffffu); vT[(dg * 16 + 2 * i + 1) * GP + t] = (bf16)(ww[i] >> 16); }
}
__device__ __forceinline__ bf16x8 lds_frag(const LAS bf16* X, int row, int kk) { return *(const LAS bf16x8*)(X + row * GP + kk); }
__device__ __forceinline__ void gla_g1(Frame& F, const Args& a, int l) {
    const bf16* Y = (const bf16*)(a.ws + WS_Y); bf16* GST = (bf16*)(a.ws + WS_GST); float* DEC = (float*)(a.ws + WS_GDEC);
    LAS float* gS = (LAS float*)(F.lds + RING_OFF + GL_GS); LAS bf16* vT = (LAS bf16*)(F.lds + RING_OFF + GL_VT); LAS bf16* kT = (LAS bf16*)(F.lds + RING_OFF + GL_A0);
    const int lane = F.lane, r32 = lane & 31, hi = lane >> 5, w = F.wave;
    for (int u = blockIdx.x; u < 2048; u += F.G) {
        const int c = u & 127, bh = u >> 7, h = bh & 3, b = bh >> 2; const bf16* Yc = Y + ((size_t)b * S_ + c * 64) * YP;
        gla_bcum(F, a, l, Yc, h);
        { const int t = F.tid >> 3, dg = F.tid & 7; const v4u kw = *(const v4u*)(Yc + (size_t)t * YP + Y_BK + h * 64 + dg * 8); float kk[8]; unpack8(kw, kk);
#pragma unroll
          for (int i = 0; i < 8; ++i) { const int d = dg * 8 + i; kT[d * GP + t] = (bf16)f2bf(kk[i] * __expf(gS[63 * 65 + d] - gS[t * 65 + d])); }
          if (F.tid < 64) DEC[(size_t)u * 64 + F.tid] = __expf(gS[63 * 65 + F.tid]); }
        gla_stage_vT(F, Yc, h);
        __syncthreads();
        { const int et = w >> 1, dt = w & 1; f32x16g acc = {};
#pragma unroll
          for (int ks = 0; ks < 4; ++ks) acc = __builtin_amdgcn_mfma_f32_32x32x16_bf16(lds_frag(vT, et * 32 + r32, ks * 16 + hi * 8), lds_frag(kT, dt * 32 + r32, ks * 16 + hi * 8), acc, 0, 0, 0);
          bf16* slot = GST + (size_t)u * 8192;
#pragma unroll
          for (int r = 0; r < 16; ++r) slot[(et * 32 + crow32(r, hi)) * 64 + dt * 32 + r32] = (bf16)f2bf(acc[r]); }
        __syncthreads();
    }
}
__device__ __forceinline__ void gla_g2(Frame& F, const Args& a) {
    unsigned* GST = (unsigned*)(a.ws + WS_GST); const float* DEC = (const float*)(a.ws + WS_GDEC);
    for (int i = blockIdx.x * 512 + F.tid; i < 16 * 128 * 32; i += F.G * 512) {
        const int dp = i & 31, bh = i >> 12; const int eo = (i >> 5) & 127;
        float s0 = 0.f, s1 = 0.f;
        for (int c0 = 0; c0 < 128; c0 += 8) {
            unsigned uu[8]; float d0[8], d1[8];
#pragma unroll
            for (int j = 0; j < 8; ++j) { const size_t sl = (size_t)(bh * 128 + c0 + j); uu[j] = GST[sl * 4096 + eo * 32 + dp]; d0[j] = DEC[sl * 64 + 2 * dp]; d1[j] = DEC[sl * 64 + 2 * dp + 1]; }
#pragma unroll
            for (int j = 0; j < 8; ++j) { const size_t sl = (size_t)(bh * 128 + c0 + j); GST[sl * 4096 + eo * 32 + dp] = pk2(s0, s1);
                s0 = s0 * d0[j] + __uint_as_float(uu[j] << 16); s1 = s1 * d1[j] + __uint_as_float(uu[j] & 0xffff0000u); }
        }
    }
}
__device__ __forceinline__ void gla_g3(Frame& F, const Args& a, int l) {
    bf16* Y = (bf16*)(a.ws + WS_Y); const bf16* GST = (const bf16*)(a.ws + WS_GST); const float* nw = a.in[15] + (size_t)l * 128;
    LAS float* gS = (LAS float*)(F.lds + RING_OFF + GL_GS); LAS bf16* vT = (LAS bf16*)(F.lds + RING_OFF + GL_VT);
    LAS bf16* qd = (LAS bf16*)(F.lds + RING_OFF + GL_A0); LAS bf16* kd = (LAS bf16*)(F.lds + RING_OFF + GL_A1); LAS bf16* at = (LAS bf16*)(F.lds + RING_OFF + GL_A2);
    LAS float* ssq = (LAS float*)(F.lds + RING_OFF + GL_SS);
    const int lane = F.lane, r32 = lane & 31, hi = lane >> 5, w = F.wave;
    for (int u = blockIdx.x; u < 2048; u += F.G) {
        const int c = u & 127, bh = u >> 7, h = bh & 3, b = bh >> 2; bf16* Yc = Y + ((size_t)b * S_ + c * 64) * YP;
        gla_bcum(F, a, l, Yc, h);
        { const int t = F.tid >> 3, dg = F.tid & 7; const v4u qw = *(const v4u*)(Yc + (size_t)t * YP + Y_BQ + h * 64 + dg * 8), kw = *(const v4u*)(Yc + (size_t)t * YP + Y_BK + h * 64 + dg * 8);
          float qq[8], kk[8]; unpack8(qw, qq); unpack8(kw, kk); v4u qo, ko; unsigned qa[4], ka[4];
#pragma unroll
          for (int i = 0; i < 4; ++i) { const float g0 = gS[t * 65 + dg * 8 + 2 * i], g1 = gS[t * 65 + dg * 8 + 2 * i + 1];
              qa[i] = pk2(qq[2 * i] * __expf(g0), qq[2 * i + 1] * __expf(g1)); ka[i] = pk2(kk[2 * i] * __expf(-g0), kk[2 * i + 1] * __expf(-g1)); }
          qo.x = qa[0]; qo.y = qa[1]; qo.z = qa[2]; qo.w = qa[3]; ko.x = ka[0]; ko.y = ka[1]; ko.z = ka[2]; ko.w = ka[3];
          *(LAS v4u*)(qd + t * GP + dg * 8) = qo; *(LAS v4u*)(kd + t * GP + dg * 8) = ko; }
        gla_stage_vT(F, Yc, h);
        __syncthreads();
        if (w < 4) { const int ib = w >> 1, jb = w & 1;
            if (jb <= ib) { f32x16g acc = {};
#pragma unroll
                for (int ks = 0; ks < 4; ++ks) acc = __builtin_amdgcn_mfma_f32_32x32x16_bf16(lds_frag(qd, ib * 32 + r32, ks * 16 + hi * 8), lds_frag(kd, jb * 32 + r32, ks * 16 + hi * 8), acc, 0, 0, 0);
#pragma unroll
                for (int r = 0; r < 16; ++r) { const int i = ib * 32 + crow32(r, hi), j = jb * 32 + r32; at[i * GP + j] = (bf16)f2bf(j <= i ? acc[r] : 0.f); } } }
        __syncthreads();
        { const int rb = w >> 2, et = w & 3; f32x16g acc = {};
          const bf16* slot = GST + (size_t)u * 8192 + (size_t)(et * 32 + r32) * 64 + hi * 8;
#pragma unroll
          for (int ks = 0; ks < 4; ++ks) { const bf16x8 sb = *(const bf16x8*)(slot + ks * 16);
              acc = __builtin_amdgcn_mfma_f32_32x32x16_bf16(lds_frag(qd, rb * 32 + r32, ks * 16 + hi * 8), sb, acc, 0, 0, 0); }
          for (int ks = 0; ks < 2 * (rb + 1); ++ks) acc = __builtin_amdgcn_mfma_f32_32x32x16_bf16(lds_frag(at, rb * 32 + r32, ks * 16 + hi * 8), lds_frag(vT, et * 32 + r32, ks * 16 + hi * 8), acc, 0, 0, 0);
          float sq[16];
#pragma unroll
          for (int r = 0; r < 16; ++r) { float v = acc[r] * acc[r];
              v += __shfl_xor(v, 1); v += __shfl_xor(v, 2); v += __shfl_xor(v, 4); v += __shfl_xor(v, 8); v += __shfl_xor(v, 16); sq[r] = v; }
          if (r32 == 0) {
#pragma unroll
              for (int r = 0; r < 16; ++r) ssq[w * 32 + crow32(r, hi)] = sq[r]; }
          __syncthreads();
          const float nwe = nw[et * 32 + r32];
#pragma unroll
          for (int r = 0; r < 16; ++r) { const int tr = crow32(r, hi); const float tot = ssq[(rb * 4 + 0) * 32 + tr] + ssq[(rb * 4 + 1) * 32 + tr] + ssq[(rb * 4 + 2) * 32 + tr] + ssq[(rb * 4 + 3) * 32 + tr];
              bf16* yp = Yc + (size_t)(rb * 32 + tr) * YP + Y_BR + h * 128 + et * 32 + r32; const float rv = bf2f(*yp);
              *yp = (bf16)f2bf(acc[r] * rsqrtf(tot * (1.f / 128.f) + NORM_EPS) * nwe * (rv * sigm(rv))); } }
        __syncthreads();
    }
}
__device__ __forceinline__ void gla_out_naive(Frame& F, const Args& a, int l) {
    const int gw = blockIdx.x * NWAVES + F.wave, NGW = F.G * NWAVES, lane = F.lane;
    bf16* Y = (bf16*)(a.ws + WS_Y); const bf16* O16 = (const bf16*)(a.ws + WS_O16); const float* nw = a.in[15] + (size_t)l * 128;
    for (int t = gw; t < M_ * 4; t += NGW) {
        const int h = t & 3; const size_t row = (size_t)(t >> 2);
        const float o0 = bf2f(O16[row * 512 + h * 128 + lane]), o1 = bf2f(O16[row * 512 + h * 128 + 64 + lane]);
        const float r = rsqrtf(wave_sum(o0 * o0 + o1 * o1) * (1.f / 128.f) + NORM_EPS);
        bf16* yr = Y + row * YP + Y_BR + h * 128;
        const float r0 = bf2f(yr[lane]), r1 = bf2f(yr[64 + lane]);
        yr[lane] = (bf16)f2bf(o0 * r * nw[lane] * (r0 * sigm(r0))); yr[64 + lane] = (bf16)f2bf(o1 * r * nw[64 + lane] * (r1 * sigm(r1)));
    }
}

constexpr int PPL = 11, NPH = NL * PPL;
#define IN(k) (lo <= (k) && (k) < hi)
#define SEAM(k) do { if (IN(k) && IN((k) + 1)) xcd_barrier(bar); } while (0)
template <int l> __device__ __forceinline__ void layer_body(Frame& F, const Args& args, const XcdBarrier& bar, const int lo, const int hi) {
    unsigned char* ws = args.ws;
    bf16* H = (bf16*)(ws + WS_H); bf16* Y = (bf16*)(ws + WS_Y); unsigned char* G8 = ws + WS_G8;
    float* Yf = (float*)(ws + WS_Y); bf16* ACT = (bf16*)(ws + WS_ACT);
    constexpr int p0 = l * PPL;
    const float* xin = l == 0 ? args.in[0] : args.out;
    if (IN(p0 + 0)) { phase_weights(F, args, l); if (l == 0) phase_norm0(F, args.in[0], args.in[2], H); SEAM(p0 + 0); }
    if (IN(p0 + 1)) {
        pg8::Gemm g{H, (const bf16*)(ws + WS_WIN), M_, NIN, DM, DM}; pg8::StaticOrder So; So.init(M_, NIN, F.G, (int)blockIdx.x);
        pg8::EpiInProj E{Y, G8};
        pg8::gemm_phase<pg8::EpiInProj, pg8::StaticOrder, true, true>(F.lds + RING_OFF, g, So, E);
        SEAM(p0 + 1);
    }
    if (IN(p0 + 2)) { phase2_naive(F, args, l); gla_g1(F, args, l); SEAM(p0 + 2); }
    if (IN(p0 + 3)) { gla_g2(F, args); nsa_cmp_naive(F, args); moba_fast(F, args, l * 4 + 0); SEAM(p0 + 3); }
    if (IN(p0 + 4)) { nsa_fast(F, args, l * 4 + 1); gla_g3(F, args, l); SEAM(p0 + 4); }
    if (IN(p0 + 5)) {
        pg8::StaticOrder So; So.init(M_, DM, F.G, (int)blockIdx.x);
        { pg8::Gemm g{Y + Y_AQ, (const bf16*)(ws + WS_WA), M_, DM, 512, YP}; pg8::EpiMerge<0> E{H, G8}; pg8::gemm_phase<pg8::EpiMerge<0>, pg8::StaticOrder, true, true>(F.lds + RING_OFF, g, So, E); }
        __syncthreads();
        { pg8::Gemm g{Y + Y_BR, (const bf16*)(ws + WS_WB), M_, DM, 512, YP}; pg8::EpiMerge<1> E{H, G8}; pg8::gemm_phase<pg8::EpiMerge<1>, pg8::StaticOrder, true, true>(F.lds + RING_OFF, g, So, E); }
        __syncthreads();
        { pg8::Gemm g{Y + Y_CQ, (const bf16*)(ws + WS_WC), M_, DM, 512, YP}; pg8::EpiMerge<2> E{H, G8}; pg8::gemm_phase<pg8::EpiMerge<2>, pg8::StaticOrder, true, true>(F.lds + RING_OFF, g, So, E); }
        SEAM(p0 + 5);
    }
    if (IN(p0 + 6)) {
        pg8::Gemm g{H, (const bf16*)(ws + WS_WO), M_, DM, DM, DM}; pg8::StaticOrder So; So.init(M_, DM, F.G, (int)blockIdx.x);
        pg8::EpiF32 E{Yf, DM}; pg8::gemm_phase<pg8::EpiF32, pg8::StaticOrder, true, true>(F.lds + RING_OFF, g, So, E);
        SEAM(p0 + 6);
    }
    if (IN(p0 + 7)) { phase_resid(F, Yf, xin, args.out, args.in[3] + (size_t)l * DM, args.in[4] + (size_t)l * DM, H); SEAM(p0 + 7); }
    if (IN(p0 + 8)) {
        pg8::Gemm g{H, (const bf16*)(ws + WS_WF1), M_, 2 * FF, DM, DM}; pg8::StaticOrder So; So.init(M_, 2 * FF, F.G, (int)blockIdx.x);
        pg8::EpiSwiglu E{ACT, FF}; pg8::gemm_phase<pg8::EpiSwiglu, pg8::StaticOrder, true, true>(F.lds + RING_OFF, g, So, E);
        SEAM(p0 + 8);
    }
    if (IN(p0 + 9)) {
        pg8::Gemm g{ACT, (const bf16*)(ws + WS_WF2), M_, DM, FF, FF}; pg8::StaticOrder So; So.init(M_, DM, F.G, (int)blockIdx.x);
        pg8::EpiF32 E{Yf, DM}; pg8::gemm_phase<pg8::EpiF32, pg8::StaticOrder, true, true>(F.lds + RING_OFF, g, So, E);
        SEAM(p0 + 9);
    }
    if (IN(p0 + 10)) { phase_resid(F, Yf, args.out, args.out, args.in[5] + (size_t)l * DM, l + 1 < NL ? args.in[2] + (size_t)(l + 1) * DM : nullptr, l + 1 < NL ? H : nullptr); SEAM(p0 + 10); }
}
__global__ void __launch_bounds__(NWAVES * 64, 2) mk_fwd(Args args) {
    extern __shared__ __attribute__((aligned(16))) unsigned char lds[];
    Frame F;
    F.lds = (LAS unsigned char*)lds; F.MISC = (volatile LAS unsigned*)(F.lds + MISC_OFF);
    F.tid = threadIdx.x; F.lane = F.tid & 63; F.wave = __builtin_amdgcn_readfirstlane(F.tid >> 6); F.G = gridDim.x;
    F.ctl = (gu32*)(args.ws + WS_CTL);
    for (int u = F.tid; u < (LDS_BYTES - LDSCTL_OFF) / 4; u += NWAVES * 64) ((LAS unsigned*)(F.lds + LDSCTL_OFF))[u] = 0u;
    __syncthreads();
    const int lo = args.ph_lo, hi = args.ph_hi;
    XcdBarrier bar; bar.bar = (unsigned*)(F.ctl + CW_BAR); bar.x = 0; bar.st = nullptr;
    if (hi - lo > 1) bar = xcd_barrier_post((unsigned*)(F.ctl + CW_BAR), F.MISC + 8);
    layer_body<0>(F, args, bar, lo, hi);
    layer_body<1>(F, args, bar, lo, hi);
}
#undef IN
#undef SEAM

#ifndef MK_ONE_LAUNCH
#define MK_ONE_LAUNCH 1
#endif
extern "C" void kernel_launch(void* const* d_in, const int* in_sizes, int n_in, void* d_out, int out_size, void* d_ws, size_t ws_size, hipStream_t stream) {
    static int grid = 0;
    if (grid == 0) {
        if (n_in != 22 || out_size != M_ * DM || ws_size < WS_END) { fprintf(stderr, "kernel_launch: unexpected sizes (n_in %d out %d ws %zu)\n", n_in, out_size, ws_size); grid = -1; return; }
        int dev = 0, cus = 0;
        if (hipGetDevice(&dev) != hipSuccess || hipDeviceGetAttribute(&cus, hipDeviceAttributeMultiprocessorCount, dev) != hipSuccess) { grid = -1; return; }
        if (hipFuncSetAttribute((const void*)mk_fwd, hipFuncAttributeMaxDynamicSharedMemorySize, LDS_BYTES) != hipSuccess) { grid = -1; return; }
        (void)hipGetLastError();
        grid = cus;
    }
    if (grid < 0) return;
    if (hipMemsetAsync((char*)d_ws + WS_CTL, 0, CTL_ZERO_BYTES, stream) != hipSuccess) return;
    Args a{};
    for (int i = 0; i < 22; ++i) a.in[i] = (const float*)d_in[i];
    a.out = (float*)d_out; a.ws = (unsigned char*)d_ws;
#if MK_ONE_LAUNCH
    a.ph_lo = 0; a.ph_hi = NPH;
    hipLaunchKernelGGL(mk_fwd, dim3(grid), dim3(NWAVES * 64), LDS_BYTES, stream, a);
#else
    for (int p = 0; p < NPH; ++p) { a.ph_lo = p; a.ph_hi = p + 1; hipLaunchKernelGGL(mk_fwd, dim3(grid), dim3(NWAVES * 64), LDS_BYTES, stream, a); }
#endif
}
```

```cpp
#include <hip/hip_runtime.h>
#include <cstdio>
#include <cstdint>
#include <cmath>
namespace pg8 {
#define PG8_LAS __attribute__((address_space(3)))
typedef unsigned short bf16_t;
typedef short bf16x8 __attribute__((ext_vector_type(8)));
typedef float f32x4 __attribute__((ext_vector_type(4)));
typedef unsigned u32x4 __attribute__((ext_vector_type(4)));
constexpr int BM = 256, BK = 64, HALF = 128, HTB = HALF * BK * 2  , STAGE_BYTES = 8 * HTB, NXCD = 8, WGM = 8;

__host__ __device__ __forceinline__ int lds_byte(int r, int c) { const int st = (r >> 4) * 2 + (c >> 5), rr = r & 15, cc = c & 31, ob = rr * 64 + cc * 2; return st * 1024 + (ob ^ (((ob >> 9) & 1) << 5)); }
__host__ __device__ __forceinline__ void stage_rc(int b, int& R, int& C) { const int st = b / 1024, sb = b % 1024, swz = sb ^ (((sb >> 9) & 1) << 5); R = (st >> 1) * 16 + swz / 64; C = (st & 1) * 32 + (swz % 64) / 2; }
__host__ __device__ __forceinline__ int perm32(int rho) { const int n = rho >> 4, i = rho & 15; return 8 * (i >> 2) + 4 * n + (i & 3); }

struct Unit { int pm, pn; };
struct Gemm { const bf16_t* A; const bf16_t* Bt; int M, N, K, lda; };

struct StaticOrder {
    int nM, nN, nwg, G, c;
    __host__ __device__ void init(int M, int N, int G_, int c_) { nM = M / BM; nN = N / BM; nwg = nM * nN; G = G_; c = c_; }
    __host__ __device__ bool next(int i, Unit& u) const {
        const long L = (long)i * G + c; if (L >= nwg) return false;
        int wgid = (int)L; { const int q = nwg / NXCD, r = nwg % NXCD, xcd = wgid % NXCD, off = wgid / NXCD; wgid = (xcd < r ? xcd * (q + 1) : r * (q + 1) + (xcd - r) * q) + off; }
        const int nig = WGM * nN, gid = wgid / nig, fm = gid * WGM, gsz = (nM - fm) < WGM ? (nM - fm) : WGM;
        u.pm = fm + ((wgid % nig) % gsz); u.pn = (wgid % nig) / gsz; return true;
    }
    __device__ __forceinline__ void a_ready(const Unit&) const {}
    __device__ __forceinline__ void done(const Unit&) const {}
};

__device__ __forceinline__ unsigned cvt_pk_bf16(float lo, float hi) { unsigned r; asm volatile("v_cvt_pk_bf16_f32 %0, %1, %2" : "=v"(r) : "v"(lo), "v"(hi)); return r; }
typedef float f32x2 __attribute__((ext_vector_type(2)));
constexpr int YP_ = 4392;
constexpr float C2_ = 0.125f * 1.4426950408889634f;
__device__ __forceinline__ float sigmoidf_(float v) { return 1.f / (1.f + __expf(-v)); }
struct EpiInProj {
    static constexpr bool PERM = true, AFTER_DRAIN = false;
    bf16_t* Y; unsigned char* G8;
    __device__ __forceinline__ void operator()(const f32x4 (&acc)[2][2][4][2], const Unit& u, int wr, int wc, int fr, int fq) const {
        const int row0 = u.pm * BM + wr * 64 + fr, colt = u.pn * BM, cin = wc * 32 + 8 * fq;
        if (u.pn < 18) {
            float sc = 1.f; if (u.pn < 2 || u.pn == 5 || u.pn == 6) sc = C2_; else if (u.pn == 11) sc = 0.125f;
#pragma unroll
            for (int ai = 0; ai < 2; ++ai)
#pragma unroll
                for (int m = 0; m < 4; ++m) { bf16_t* rowp = Y + (size_t)(row0 + ai * HALF + m * 16) * YP_;
#pragma unroll
                    for (int bj = 0; bj < 2; ++bj) { const int col = colt + cin + bj * HALF;
                        if (col + 8 <= YP_) { const f32x4 v0 = acc[ai][bj][m][0] * sc, v1 = acc[ai][bj][m][1] * sc; u32x4 w;
                            w.x = cvt_pk_bf16(v0[0], v0[1]); w.y = cvt_pk_bf16(v0[2], v0[3]); w.z = cvt_pk_bf16(v1[0], v1[1]); w.w = cvt_pk_bf16(v1[2], v1[3]);
                            *(u32x4*)(rowp + col) = w; } } }
        } else {
#pragma unroll
            for (int ai = 0; ai < 2; ++ai)
#pragma unroll
                for (int m = 0; m < 4; ++m) { unsigned char* rowp = G8 + (size_t)(row0 + ai * HALF + m * 16) * 3072 + (colt - 4608) + cin;
#pragma unroll
                    for (int bj = 0; bj < 2; ++bj) { const f32x4 v0 = acc[ai][bj][m][0], v1 = acc[ai][bj][m][1]; unsigned lo = 0u, hi = 0u;
#pragma unroll
                        for (int e = 0; e < 4; ++e) { lo |= (unsigned)(sigmoidf_(v0[e]) * 255.f + 0.5f) << (8 * e); hi |= (unsigned)(sigmoidf_(v1[e]) * 255.f + 0.5f) << (8 * e); }
                        typedef unsigned u32x2 __attribute__((ext_vector_type(2))); u32x2 w; w.x = lo; w.y = hi; *(u32x2*)(rowp + bj * HALF) = w; } }
        }
    }
};
template <int I> struct EpiMerge {
    static constexpr bool PERM = true, AFTER_DRAIN = false;
    bf16_t* Mg; const unsigned char* G8;
    __device__ __forceinline__ void operator()(const f32x4 (&acc)[2][2][4][2], const Unit& u, int wr, int wc, int fr, int fq) const {
        const int row0 = u.pm * BM + wr * 64 + fr, col0 = u.pn * BM + wc * 32 + 8 * fq;
#pragma unroll
        for (int ai = 0; ai < 2; ++ai)
#pragma unroll
            for (int m = 0; m < 4; ++m) { const size_t row = (size_t)(row0 + ai * HALF + m * 16);
#pragma unroll
                for (int bj = 0; bj < 2; ++bj) { const int col = col0 + bj * HALF;
                    typedef unsigned u32x2 __attribute__((ext_vector_type(2)));
                    const u32x2 gw = *(const u32x2*)(G8 + row * 3072 + I * 1024 + col);
                    float v[8];
#pragma unroll
                    for (int e = 0; e < 4; ++e) { v[e] = acc[ai][bj][m][0][e] * ((float)((gw.x >> (8 * e)) & 255u) * (1.f / 255.f)); v[4 + e] = acc[ai][bj][m][1][e] * ((float)((gw.y >> (8 * e)) & 255u) * (1.f / 255.f)); }
                    bf16_t* p = Mg + row * 1024 + col;
                    if (I > 0) { const u32x4 o = *(const u32x4*)p;
                        v[0] += __uint_as_float(o.x << 16); v[1] += __uint_as_float(o.x & 0xffff0000u); v[2] += __uint_as_float(o.y << 16); v[3] += __uint_as_float(o.y & 0xffff0000u);
                        v[4] += __uint_as_float(o.z << 16); v[5] += __uint_as_float(o.z & 0xffff0000u); v[6] += __uint_as_float(o.w << 16); v[7] += __uint_as_float(o.w & 0xffff0000u); }
                    u32x4 w; w.x = cvt_pk_bf16(v[0], v[1]); w.y = cvt_pk_bf16(v[2], v[3]); w.z = cvt_pk_bf16(v[4], v[5]); w.w = cvt_pk_bf16(v[6], v[7]);
                    *(u32x4*)p = w; } }
    }
};
struct EpiF32 {
    static constexpr bool PERM = true, AFTER_DRAIN = false;
    float* O; int ldc;
    __device__ __forceinline__ void operator()(const f32x4 (&acc)[2][2][4][2], const Unit& u, int wr, int wc, int fr, int fq) const {
        const int row0 = u.pm * BM + wr * 64 + fr, col0 = u.pn * BM + wc * 32 + 8 * fq;
#pragma unroll
        for (int ai = 0; ai < 2; ++ai)
#pragma unroll
            for (int m = 0; m < 4; ++m) { float* rowp = O + (size_t)(row0 + ai * HALF + m * 16) * ldc + col0;
#pragma unroll
                for (int bj = 0; bj < 2; ++bj) { *(f32x4*)(rowp + bj * HALF) = acc[ai][bj][m][0]; *(f32x4*)(rowp + bj * HALF + 4) = acc[ai][bj][m][1]; } }
    }
};
struct EpiSwiglu {
    static constexpr bool PERM = true, AFTER_DRAIN = false;
    bf16_t* Act; int ldc;
    __device__ __forceinline__ void operator()(const f32x4 (&acc)[2][2][4][2], const Unit& u, int wr, int wc, int fr, int fq) const {
        const int row0 = u.pm * BM + wr * 64 + fr, col0 = u.pn * HALF + wc * 32 + 8 * fq;
#pragma unroll
        for (int ai = 0; ai < 2; ++ai)
#pragma unroll
            for (int m = 0; m < 4; ++m) { bf16_t* p = Act + (size_t)(row0 + ai * HALF + m * 16) * ldc + col0; float v[8];
#pragma unroll
                for (int e = 0; e < 4; ++e) { const float g0 = acc[ai][0][m][0][e], g1 = acc[ai][0][m][1][e];
                    v[e] = g0 * sigmoidf_(g0) * acc[ai][1][m][0][e]; v[4 + e] = g1 * sigmoidf_(g1) * acc[ai][1][m][1][e]; }
                u32x4 w; w.x = cvt_pk_bf16(v[0], v[1]); w.y = cvt_pk_bf16(v[2], v[3]); w.z = cvt_pk_bf16(v[4], v[5]); w.w = cvt_pk_bf16(v[6], v[7]);
                *(u32x4*)p = w; }
    }
};
template <class Epi, class Sched, bool ALIGN_EPI = false, bool SP2 = false>
__device__ __forceinline__ void gemm_phase(PG8_LAS unsigned char* lds, const Gemm g, const Sched& S, const Epi& E) {
    const int tid = threadIdx.x, wid = __builtin_amdgcn_readfirstlane(tid >> 6), lane = tid & 63, wr = wid >> 2, wc = wid & 3, fr = lane & 15, fq = lane >> 4;
    const int K = g.K, nt = K / BK;
    unsigned voffA[2], voffB[2];
#pragma unroll
    for (int i = 0; i < 2; ++i) { int R, C; stage_rc(tid * 16 + i * 8192, R, C); const int Rb = Epi::PERM ? ((R & ~31) + perm32(R & 31)) : R;
        voffA[i] = (unsigned)(R * g.lda + C) * 2u; voffB[i] = (unsigned)(Rb * K + C) * 2u; }
    const size_t kstep = (size_t)(BK * 2);
    const size_t hstepB = (size_t)HALF * K * 2, hstepA = (size_t)HALF * g.lda * 2;
    const size_t tstepA = 2 * hstepA, tstepB = 2 * hstepB;
    const unsigned ldsw = (unsigned)wid * 1024u;
    const int aoff = lds_byte(wr * 64 + fr, fq * 8), boff = lds_byte(wc * 32 + fr, fq * 8);
#define PG8_SA(b, h) (((b) * 2 + (h)) * HTB)
#define PG8_SB(b, h) ((4 + (b) * 2 + (h)) * HTB)
#define PG8_STAGE(bufoff, gbase, voff) do { _Pragma("unroll") for (int _i = 0; _i < 2; ++_i) \
        __builtin_amdgcn_global_load_lds((const unsigned*)((const char*)(gbase) + (voff)[_i]), (PG8_LAS unsigned*)(lds + (bufoff) + ldsw + _i * 8192), 16, 0, 0); } while (0)
#define PG8_LDA(dst, b, h) do { _Pragma("unroll") for (int m = 0; m < 4; ++m) _Pragma("unroll") for (int k = 0; k < 2; ++k) dst[m][k] = *(const PG8_LAS bf16x8*)(lds + PG8_SA(b, h) + aoff + m * 2048 + k * 1024); } while (0)
#define PG8_LDB(dst, b, h) do { _Pragma("unroll") for (int n = 0; n < 2; ++n) _Pragma("unroll") for (int k = 0; k < 2; ++k) dst[n][k] = *(const PG8_LAS bf16x8*)(lds + PG8_SB(b, h) + boff + n * 2048 + k * 1024); } while (0)
#define PG8_MMA(ai, bj, At, Bt) do { __builtin_amdgcn_s_setprio(1); _Pragma("unroll") for (int m = 0; m < 4; ++m) _Pragma("unroll") for (int n = 0; n < 2; ++n) _Pragma("unroll") for (int k = 0; k < 2; ++k) \
        acc[ai][bj][m][n] = __builtin_amdgcn_mfma_f32_16x16x32_bf16(Bt[n][k], At[m][k], acc[ai][bj][m][n], 0, 0, 0); __builtin_amdgcn_s_setprio(0); } while (0)
#define PG8_WAIT_V(n) asm volatile("s_waitcnt vmcnt(" #n ")" ::: "memory")
#define PG8_WAIT_L(n) asm volatile("s_waitcnt lgkmcnt(" #n ")" ::: "memory")
#define PG8_BAR __builtin_amdgcn_s_barrier()
#define PG8_SCHED __builtin_amdgcn_sched_barrier(0)
    Unit cur, nxt; int ui = 0;
    if (!S.next(0, cur)) return;
    f32x4 acc[2][2][4][2];
#pragma unroll
    for (int a = 0; a < 2; ++a)
#pragma unroll
        for (int b = 0; b < 2; ++b)
#pragma unroll
            for (int m = 0; m < 4; ++m)
#pragma unroll
                for (int n = 0; n < 2; ++n) acc[a][b][m][n] = (f32x4){0.f, 0.f, 0.f, 0.f};
    bf16x8 At[4][2], B0[2][2], B1[2][2];
    const char* cA = (const char*)g.A + (size_t)cur.pm * tstepA; const char* cB = (const char*)g.Bt + (size_t)cur.pn * tstepB;
    S.a_ready(cur);
    if constexpr (SP2) {
        PG8_STAGE(PG8_SB(0, 0), cB, voffB); PG8_STAGE(PG8_SB(0, 1), cB + hstepB, voffB); PG8_STAGE(PG8_SA(0, 0), cA, voffA); PG8_STAGE(PG8_SA(0, 1), cA + hstepA, voffA);
        if (wr == 1) PG8_BAR;
        PG8_WAIT_V(2); PG8_BAR;
        PG8_STAGE(PG8_SB(1, 0), cB + kstep, voffB); PG8_STAGE(PG8_SA(1, 0), cA + kstep, voffA); PG8_STAGE(PG8_SB(1, 1), cB + hstepB + kstep, voffB);
        PG8_WAIT_V(6); PG8_BAR;
    } else {
        PG8_STAGE(PG8_SB(0, 0), cB, voffB); PG8_STAGE(PG8_SA(0, 0), cA, voffA); PG8_STAGE(PG8_SB(0, 1), cB + hstepB, voffB); PG8_STAGE(PG8_SA(0, 1), cA + hstepA, voffA);
        if (wr == 1) PG8_BAR;
        PG8_WAIT_V(4); PG8_BAR;
        PG8_STAGE(PG8_SB(1, 0), cB + kstep, voffB); PG8_STAGE(PG8_SA(1, 0), cA + kstep, voffA); PG8_STAGE(PG8_SB(1, 1), cB + hstepB + kstep, voffB);
        PG8_WAIT_V(6); PG8_BAR;
    }
    for (;;) {
        const bool has_next = S.next(ui + 1, nxt);
        const char* nA = has_next ? (const char*)g.A + (size_t)nxt.pm * tstepA : cA; const char* nB = has_next ? (const char*)g.Bt + (size_t)nxt.pn * tstepB : cB;
        for (int t = 0; t < nt; t += 2) {
            const bool last = (t == nt - 2);
            const char* a1 = cA + (size_t)(t + 1) * kstep;
            const char* a2 = last ? nA : cA + (size_t)(t + 2) * kstep; const char* b2 = last ? nB : cB + (size_t)(t + 2) * kstep;
            const char* a3 = a2 + kstep; const char* b3 = b2 + kstep;
            if (last && has_next) S.a_ready(nxt);
            if constexpr (SP2) {
            PG8_LDB(B0, 0, 0); PG8_LDB(B1, 0, 1); PG8_SCHED; PG8_LDA(At, 0, 0); PG8_STAGE(PG8_SA(1, 1), a1 + hstepA, voffA);
            PG8_WAIT_V(8); PG8_WAIT_L(0); PG8_BAR; PG8_MMA(0, 0, At, B0); PG8_MMA(0, 1, At, B1); PG8_BAR; PG8_SCHED;
            PG8_LDA(At, 0, 1); PG8_STAGE(PG8_SB(0, 0), b2, voffB); PG8_STAGE(PG8_SB(0, 1), b2 + hstepB, voffB); PG8_STAGE(PG8_SA(0, 0), a2, voffA);
            PG8_WAIT_V(8); PG8_WAIT_L(0); PG8_BAR; PG8_MMA(1, 0, At, B0); PG8_MMA(1, 1, At, B1); PG8_BAR; PG8_SCHED;
            PG8_LDB(B0, 1, 0); PG8_LDB(B1, 1, 1); PG8_SCHED; PG8_LDA(At, 1, 0); PG8_STAGE(PG8_SA(0, 1), a2 + hstepA, voffA);
            PG8_WAIT_V(8); PG8_WAIT_L(0); PG8_BAR; PG8_MMA(0, 0, At, B0); PG8_MMA(0, 1, At, B1); PG8_BAR; PG8_SCHED;
            PG8_LDA(At, 1, 1); PG8_STAGE(PG8_SB(1, 0), b3, voffB); PG8_STAGE(PG8_SB(1, 1), b3 + hstepB, voffB); PG8_STAGE(PG8_SA(1, 0), a3, voffA);
            PG8_WAIT_V(8); PG8_WAIT_L(0); PG8_BAR; PG8_MMA(1, 0, At, B0); PG8_MMA(1, 1, At, B1); PG8_BAR; PG8_SCHED;
            } else {
            PG8_LDB(B0, 0, 0); PG8_SCHED; PG8_LDA(At, 0, 0); PG8_STAGE(PG8_SA(1, 1), a1 + hstepA, voffA);
            PG8_WAIT_L(8); PG8_BAR; PG8_WAIT_L(0); PG8_MMA(0, 0, At, B0); PG8_BAR; PG8_SCHED;
            PG8_LDB(B1, 0, 1); PG8_STAGE(PG8_SB(0, 0), b2, voffB);
            PG8_BAR; PG8_WAIT_L(0); PG8_MMA(0, 1, At, B1); PG8_BAR;
            PG8_LDA(At, 0, 1); PG8_STAGE(PG8_SA(0, 0), a2, voffA);
            PG8_BAR; PG8_WAIT_L(0); PG8_MMA(1, 0, At, B0); PG8_BAR; PG8_SCHED;
            PG8_STAGE(PG8_SB(0, 1), b2 + hstepB, voffB);
            PG8_WAIT_V(6); PG8_BAR; PG8_MMA(1, 1, At, B1); PG8_BAR;
            PG8_LDB(B0, 1, 0); PG8_SCHED; PG8_LDA(At, 1, 0); PG8_STAGE(PG8_SA(0, 1), a2 + hstepA, voffA);
            PG8_WAIT_L(8); PG8_BAR; PG8_WAIT_L(0); PG8_MMA(0, 0, At, B0); PG8_BAR; PG8_SCHED;
            PG8_LDB(B1, 1, 1); PG8_STAGE(PG8_SB(1, 0), b3, voffB);
            PG8_BAR; PG8_WAIT_L(0); PG8_MMA(0, 1, At, B1); PG8_BAR;
            PG8_LDA(At, 1, 1); PG8_STAGE(PG8_SA(1, 0), a3, voffA);
            PG8_BAR; PG8_WAIT_L(0); PG8_MMA(1, 0, At, B0); PG8_BAR; PG8_SCHED;
            PG8_STAGE(PG8_SB(1, 1), b3 + hstepB, voffB);
            PG8_WAIT_V(6); PG8_BAR; PG8_MMA(1, 1, At, B1); PG8_BAR;
            }
        }
        if constexpr (ALIGN_EPI) { if (wr == 0) PG8_BAR; }
        if constexpr (!Epi::AFTER_DRAIN) { E(acc, cur, wr, wc, fr, fq); S.done(cur); }
        if (!has_next) break;
#pragma unroll
        for (int a = 0; a < 2; ++a)
#pragma unroll
            for (int b = 0; b < 2; ++b)
#pragma unroll
                for (int m = 0; m < 4; ++m)
#pragma unroll
                    for (int n = 0; n < 2; ++n) acc[a][b][m][n] = (f32x4){0.f, 0.f, 0.f, 0.f};
        cur = nxt; cA = nA; cB = nB; ++ui;
        if constexpr (ALIGN_EPI) { if (wr == 1) PG8_BAR; }
    }
    PG8_WAIT_V(0);
    if constexpr (!ALIGN_EPI) { if (wr == 0) PG8_BAR; }
    PG8_BAR;
    if constexpr (Epi::AFTER_DRAIN) { E.fused(acc, cur, wr, wc, fr, fq, lds, wid, lane); S.done(cur); }
#undef PG8_SA
#undef PG8_SB
#undef PG8_STAGE
#undef PG8_LDA
#undef PG8_LDB
#undef PG8_MMA
#undef PG8_WAIT_V
#undef PG8_WAIT_L
#undef PG8_BAR
#undef PG8_SCHED
}
}
namespace attn {
using bf16=unsigned short;
using bf16x8=__attribute__((ext_vector_type(8)))short;
using s16x4=__attribute__((ext_vector_type(4)))short;
using f32x16=__attribute__((ext_vector_type(16)))float;
using u32x4=__attribute__((ext_vector_type(4)))unsigned;
constexpr int D=64, PITCH=4392, SEQ=8192;
constexpr int NW=8,QBLK=32,QB=QBLK*NW,KVBLK=64;
__device__ __forceinline__ int crow(int r,int hi){return (r&3)+8*(r>>2)+4*hi;}
#define SBAR() __builtin_amdgcn_sched_barrier(0)
using f32x4_=__attribute__((ext_vector_type(4)))float;
__device__ __forceinline__ float bfs(short v){ return __uint_as_float(((unsigned)(unsigned short)v)<<16); }
__device__ __forceinline__ float lo16(unsigned w){ return __uint_as_float(w<<16); }
__device__ __forceinline__ float hi16(unsigned w){ return __uint_as_float(w&0xffff0000u); }
__device__ __forceinline__ bf16 f2b(float f){ unsigned u=__float_as_uint(f); return (bf16)((u+0x7fffu+((u>>16)&1u))>>16); }
__device__ __forceinline__ unsigned pk2b(float lo,float hi){ return (unsigned)f2b(lo)|((unsigned)f2b(hi)<<16); }
constexpr int NSLOT=3, SLOTB=8192;
constexpr int LDS_K=0, LDS_V=NSLOT*SLOTB, LDS_WS=2*NSLOT*SLOTB, LDS_OST=LDS_WS+NW*128*4, LDS_BIAS=LDS_OST+NW*4096, LDS_MSK=LDS_BIAS+512, LDS_KM=LDS_MSK+NW*512, LDS_BYTES=LDS_KM+8192;
constexpr float LOG2E_=1.4426950408889634f;
__device__ __forceinline__ void glds16(const void*gsrc,unsigned lds_dst){unsigned keep;
  asm volatile("s_mov_b32 %0, m0\n\ts_mov_b32 m0, %2\n\ts_nop 0\n\tglobal_load_lds_dwordx4 %1, off\n\ts_mov_b32 m0, %0":"=&s"(keep):"v"(gsrc),"s"(lds_dst):"memory");}
__device__ __forceinline__ float max3f(float a,float b,float c){float r;asm("v_max3_f32 %0, %1, %2, %3":"=v"(r):"v"(a),"v"(b),"v"(c));return r;}
__device__ __forceinline__ float max2f(float a,float b){float r;asm("v_max_f32_e32 %0, %1, %2":"=v"(r):"v"(a),"v"(b));return r;}
__device__ __forceinline__ float fadd_s(float a,float b){float r;asm("v_add_f32_e32 %0, %1, %2":"=v"(r):"v"(a),"v"(b));return r;}
__device__ __forceinline__ float fsub_s(float a,float b){float r;asm("v_sub_f32_e32 %0, %1, %2":"=v"(r):"v"(a),"v"(b));return r;}
typedef float f32x2_t __attribute__((ext_vector_type(2))); typedef __bf16 bf16x2_t __attribute__((ext_vector_type(2)));
__device__ __forceinline__ unsigned cvtpk_s(float lo,float hi){f32x2_t v={lo,hi};bf16x2_t b=__builtin_convertvector(v,bf16x2_t);return __builtin_bit_cast(unsigned,b);}
#define WAIT_BAR(N) asm volatile("s_waitcnt vmcnt(" #N ") lgkmcnt(0)\n\ts_barrier":::"memory")

__device__ __forceinline__ void qkt(f32x16&p0,f32x16&p1,const char*Kslot,const bf16x8*qr,const f32x16&negm,int r32,int hi){
  const char*kb=Kslot+hi*1024+r32*16;
  #pragma unroll
  for(int d0=0;d0<4;++d0){
    const bf16x8 b0=*reinterpret_cast<const bf16x8*>(kb+d0*2048);
    const bf16x8 b1=*reinterpret_cast<const bf16x8*>(kb+d0*2048+512);
    if(d0==0){p0=__builtin_amdgcn_mfma_f32_32x32x16_bf16(b0,qr[0],negm,0,0,0);p1=__builtin_amdgcn_mfma_f32_32x32x16_bf16(b1,qr[0],negm,0,0,0);}
    else{p0=__builtin_amdgcn_mfma_f32_32x32x16_bf16(b0,qr[d0],p0,0,0,0);p1=__builtin_amdgcn_mfma_f32_32x32x16_bf16(b1,qr[d0],p1,0,0,0);}}
}
typedef __attribute__((address_space(3))) const char* lds_cptr;
typedef short v4i16_t __attribute__((ext_vector_type(4)));
__device__ __forceinline__ void kload8(bf16x8*kf,lds_cptr kp){
  kf[0]=*(const __attribute__((address_space(3))) bf16x8*)(kp);      kf[1]=*(const __attribute__((address_space(3))) bf16x8*)(kp+512);
  kf[2]=*(const __attribute__((address_space(3))) bf16x8*)(kp+2048); kf[3]=*(const __attribute__((address_space(3))) bf16x8*)(kp+2560);
  kf[4]=*(const __attribute__((address_space(3))) bf16x8*)(kp+4096); kf[5]=*(const __attribute__((address_space(3))) bf16x8*)(kp+4608);
  kf[6]=*(const __attribute__((address_space(3))) bf16x8*)(kp+6144); kf[7]=*(const __attribute__((address_space(3))) bf16x8*)(kp+6656);
}
__device__ __forceinline__ void kload2(bf16x8*kf,lds_cptr kp,int j){ kf[2*j]=*(const __attribute__((address_space(3))) bf16x8*)(kp+j*2048); kf[2*j+1]=*(const __attribute__((address_space(3))) bf16x8*)(kp+j*2048+512); }
__device__ __forceinline__ s16x4 vtr(lds_cptr p){ return __builtin_bit_cast(s16x4,__builtin_amdgcn_ds_read_tr16_b64_v4i16((__attribute__((address_space(3))) v4i16_t*)p)); }
__device__ __forceinline__ float rowmax(const f32x16&p0,const f32x16&p1){
  float a=max3f(p0[0],p0[1],p1[0]),b=max3f(p0[2],p0[3],p1[1]);a=max3f(a,p1[2],p1[3]);
  #pragma unroll
  for(int r=4;r<16;r+=4){a=max3f(a,p0[r],p0[r+1]);b=max3f(b,p0[r+2],p0[r+3]);a=max3f(a,p1[r],p1[r+1]);b=max3f(b,p1[r+2],p1[r+3]);}
  const float m=max2f(a,b);
  auto rr=__builtin_amdgcn_permlane32_swap(__float_as_uint(m),__float_as_uint(m),false,false);
  return max2f(__uint_as_float(rr[0]),__uint_as_float(rr[1]));
}
__device__ __forceinline__ void pv(f32x16*o,int vb,bf16x8 pa0,bf16x8 pa1,bf16x8 pa2,bf16x8 pa3){
  #pragma unroll
  for(int d0=0;d0<2;++d0){s16x4 lo[4],hi[4];
    #pragma unroll
    for(int ks=0;ks<4;++ks){
      asm volatile("ds_read_b64_tr_b16 %0,%1 offset:%c2":"=&v"(lo[ks]):"v"(vb),"i"(d0*4096+ks*1024):"memory");
      asm volatile("ds_read_b64_tr_b16 %0,%1 offset:%c2":"=&v"(hi[ks]):"v"(vb),"i"(d0*4096+ks*1024+512):"memory");}
    asm volatile("s_waitcnt lgkmcnt(0)":::"memory");SBAR();
    #define PK(k) (bf16x8){lo[k][0],lo[k][1],lo[k][2],lo[k][3],hi[k][0],hi[k][1],hi[k][2],hi[k][3]}
    o[d0]=__builtin_amdgcn_mfma_f32_32x32x16_bf16(pa0,PK(0),o[d0],0,0,0);
    o[d0]=__builtin_amdgcn_mfma_f32_32x32x16_bf16(pa1,PK(1),o[d0],0,0,0);
    o[d0]=__builtin_amdgcn_mfma_f32_32x32x16_bf16(pa2,PK(2),o[d0],0,0,0);
    o[d0]=__builtin_amdgcn_mfma_f32_32x32x16_bf16(pa3,PK(3),o[d0],0,0,0);
    #undef PK
  }
}

#ifndef ATTN_STORE16
#define ATTN_STORE16(p,v) (*(u32x4*)(p)=(v))
#endif
struct UArgs {
  const bf16* Qb; const bf16* Kh; const bf16* Vh; bf16* Ob;
  int NT, q0, kt0, hc;
  const float* rel;
  const float* km; int qb;
  const unsigned* selg;
  const bf16* gate; int gcol;
  const bf16* tmp;
};
__device__ __forceinline__ int t5b(int d){ if(d<16)return d<0?0:d; int b=16; b+=(d>=19);b+=(d>=21);b+=(d>=24);b+=(d>=27);b+=(d>=31);b+=(d>=35);b+=(d>=40);b+=(d>=46);b+=(d>=52);b+=(d>=59);b+=(d>=67);b+=(d>=77);b+=(d>=87);b+=(d>=99);b+=(d>=113); return b; }
template<int MODE,int EPI,int THRL> __device__ __forceinline__ void attn_unit(const UArgs&U,char*shm){
  const int tid=threadIdx.x,lane=tid&63,r32=lane&31,hi=lane>>5; const int wid=__builtin_amdgcn_readfirstlane(tid>>6);
  const bf16*Qw=U.Qb+(long)(wid*QBLK)*PITCH;
  const bf16*Kh=U.Kh,*Vh=U.Vh;
  const unsigned lds0=(unsigned)(uintptr_t)shm;
  float*wsf=(float*)(shm+LDS_WS)+wid*128;
  const bf16*ksrc=Kh+(long)lane*PITCH+wid*8;
  const bf16*vsrc=Vh+(long)(16*(wid&3)+(lane>>2))*PITCH+(wid>>2)*32+(lane&3)*8;
  const unsigned kdst=lds0+LDS_K+wid*1024, vdst=lds0+LDS_V+wid*1024;
  #define DMA_K(t,slot) glds16(ksrc+(long)(t)*KVBLK*PITCH,(unsigned)__builtin_amdgcn_readfirstlane(kdst+(slot)))
  #define DMA_V(t,slot) glds16(vsrc+(long)(t)*KVBLK*PITCH,(unsigned)__builtin_amdgcn_readfirstlane(vdst+(slot)))
  const int vb0=(int)(lds0+LDS_V)+((lane>>4)&1)*32+(lane&3)*8+(4*hi+((lane&15)>>2))*64;
  const char*Kbase=shm+LDS_K; bf16x8 kf[8];
  const lds_cptr shm3=(lds_cptr)shm; const lds_cptr kp0=shm3+LDS_K+hi*1024+r32*16; const lds_cptr vp0=shm3+LDS_V+((lane>>4)&1)*32+(lane&3)*8+(4*hi+((lane&15)>>2))*64;
  const int NT=U.NT;
  const int qpos=U.q0+wid*QBLK+r32;
  float*biasT=(float*)(shm+LDS_BIAS);
  if(tid<128) biasT[tid]=(U.rel[t5b(tid)*16+U.hc]-U.rel[31*16+U.hc])*LOG2E_;
  unsigned selw=0u,cw=0u; const unsigned*mskp=(const unsigned*)(shm+LDS_MSK)+wid*128+r32*4;
  if(MODE==0){ ((u32x4*)(shm+LDS_KM))[tid]=((const u32x4*)U.km)[tid]; }
  if(MODE==1){ if(hi==0){ const u32x4 w=*(const u32x4*)(U.selg+(long)(wid*QBLK+r32)*4); *(u32x4*)((unsigned*)(shm+LDS_MSK)+wid*128+r32*4)=w; } }
  asm volatile("s_waitcnt vmcnt(0) lgkmcnt(0)\n\ts_barrier":::"memory");
  bf16x8 qr[4];
  #pragma unroll
  for(int d0=0;d0<4;++d0)qr[d0]=*reinterpret_cast<const bf16x8*>(&Qw[(long)r32*PITCH+d0*16+hi*8]);
  if(MODE==0){
    float v1=-INFINITY,v2=-INFINITY,v3=-INFINITY; int i1=-1,i2=-1,i3=-1;
    for(int n=0;n<U.qb;++n){ const float*km=(const float*)(shm+LDS_KM)+n*64+hi*8; float p=0.f;
      #pragma unroll
      for(int d0=0;d0<4;++d0){ const f32x4_ a=*(const f32x4_*)(km+d0*16), c=*(const f32x4_*)(km+d0*16+4);
        p+=bfs(qr[d0][0])*a[0]+bfs(qr[d0][1])*a[1]+bfs(qr[d0][2])*a[2]+bfs(qr[d0][3])*a[3]+bfs(qr[d0][4])*c[0]+bfs(qr[d0][5])*c[1]+bfs(qr[d0][6])*c[2]+bfs(qr[d0][7])*c[3]; }
      auto rr=__builtin_amdgcn_permlane32_swap(__float_as_uint(p),__float_as_uint(p),false,false); const float sc_=__uint_as_float(rr[0])+__uint_as_float(rr[1]);
      if(sc_>v1){v3=v2;i3=i2;v2=v1;i2=i1;v1=sc_;i1=n;} else if(sc_>v2){v3=v2;i3=i2;v2=sc_;i2=n;} else if(sc_>v3){v3=sc_;i3=n;} }
    if(i1>=0)selw|=1u<<i1; if(i2>=0)selw|=1u<<i2; if(i3>=0)selw|=1u<<i3; selw|=1u<<U.qb; }
  DMA_K(0,0);DMA_V(0,0);DMA_K(1,SLOTB);
  float mhat=0.f,l_reg=0.f;f32x16 o[2];o[0]=f32x16{};o[1]=f32x16{};f32x16 negm=f32x16{};asm volatile("":"+v"(negm));
  #define MASK_FAR(P0,P1,t) do{ bool on_=true; if(MODE==0)on_=((selw>>((t)>>2))&1u)!=0u; if(MODE==1){ if(((t)&31)==0)cw=mskp[(t)>>5]; on_=((cw>>((t)&31))&1u)!=0u; } \
      _Pragma("unroll") for(int r=0;r<16;++r){ P0[r]=on_?P0[r]:-INFINITY; P1[r]=on_?P1[r]:-INFINITY; } }while(0)
  #define MASK_BAND(P0,P1,t) do{ bool on_=true; if(MODE==0)on_=((selw>>((t)>>2))&1u)!=0u; if(MODE==1){ if(((t)&31)==0)cw=mskp[(t)>>5]; on_=((cw>>((t)&31))&1u)!=0u; } \
      const int d0_=qpos-(U.kt0+64*(t)+4*hi); \
      _Pragma("unroll") for(int r=0;r<16;++r){ const int da_=d0_-((r&3)+8*(r>>2)), db_=da_-32; \
        const bool oka_=on_&&da_>=0&&(MODE!=2||da_<512), okb_=on_&&db_>=0&&(MODE!=2||db_<512); \
        const float ba_=biasT[da_<0?0:(da_>127?127:da_)], bb_=biasT[db_<0?0:(db_>127?127:db_)]; \
        P0[r]=oka_?P0[r]+ba_:-INFINITY; P1[r]=okb_?P1[r]+bb_:-INFINITY; \
        if((r&1)==1){ asm volatile("s_waitcnt lgkmcnt(0)":"+v"(P0),"+v"(P1)::"memory"); } } }while(0)
  #define CMASK(P0,P1,t) MASK_BAND(P0,P1,t)
  bool resc=false;
  #define START(P0,P1) do{ const float rm=rowmax(P0,P1); resc=false; \
    { const float dl=rm>-1e30f?rm:0.f; mhat=fadd_s(mhat,dl); \
      _Pragma("unroll") for(int r=0;r<16;++r){P0[r]=fsub_s(P0[r],dl);P1[r]=fsub_s(P1[r],dl);} \
      _Pragma("unroll") for(int r=0;r<16;++r)negm[r]=-mhat; asm volatile("":"+v"(negm)); } \
    _Pragma("unroll") for(int r=0;r<16;++r)P0[r]=__builtin_amdgcn_exp2f(P0[r]); }while(0)
  #define RESC() do{ if(resc){ asm volatile("s_waitcnt lgkmcnt(0)":::"memory"); \
      _Pragma("unroll") for(int d_=0;d_<2;++d_) _Pragma("unroll") for(int r=0;r<16;++r)o[d_][r]*=wsf[crow(r,hi)]; } }while(0)
  f32x16 pA0,pA1,pB0,pB1;
  int sl_prev=0,sl_cur=0,sl_next=SLOTB;
  #define ROT() do{sl_prev=sl_cur;sl_cur=sl_next;sl_next=(sl_next==(NSLOT-1)*SLOTB)?0:sl_next+SLOTB;}while(0)
  DMA_K(2,2*SLOTB);
  WAIT_BAR(3);
  qkt(pA0,pA1,Kbase,qr,negm,r32,hi);asm volatile("s_nop 15\n\ts_nop 7":"+v"(pA0),"+v"(pA1));CMASK(pA0,pA1,0);
  START(pA0,pA1);
  _Pragma("unroll") for(int r=0;r<16;++r)pA1[r]=__builtin_amdgcn_exp2f(pA1[r]);
  WAIT_BAR(0);
  DMA_K(3,0);DMA_V(1,SLOTB);
  ROT();
  kload8(kf,kp0+sl_cur);
  WAIT_BAR(2);
  s16x4 vlo[8],vhi[8]; u32x4 pw0,pw1,pw2,pw3;
  #define PKW(P,B) cvtpk_s(P[B],P[B+1])
  #define PAF(k) __builtin_bit_cast(bf16x8,pw##k)
  #define VFR(i) (bf16x8){vlo[i][0],vlo[i][1],vlo[i][2],vlo[i][3],vhi[i][0],vhi[i][1],vhi[i][2],vhi[i][3]}
  #define PIN(x) asm volatile("":"+v"(x))
  #define MX3(a,b,c) __builtin_fmaxf(__builtin_fmaxf((a),(b)),(c))
  #define GAPA(MF,A0,A1,A2,A3,W0,W1,PW) do{ MF; sacc+=A0; sacc+=A1; sacc+=A2; sacc+=A3; PIN(sacc); W0; W1; PIN(PW); SBAR(); }while(0)
  #define EX(v) __builtin_amdgcn_exp2f(v)
  #define GAPB(MF,X,B) do{ MF; X[B]=EX(X[B]); X[B+1]=EX(X[B+1]); X[B+2]=EX(X[B+2]); X[B+3]=EX(X[B+3]); PIN(X); SBAR(); }while(0)
  #define VRD(i) do{ vlo[i]=vtr(vp_+(((i)>>2)*4096+((i)&3)*1024)); vhi[i]=vtr(vp_+(((i)>>2)*4096+((i)&3)*1024+512)); }while(0)
  #define KRD(G,j) do{ if(G){ kload2(kf,kp0+sl_next,j); SBAR(); } }while(0)
  #define STEP(C0,C1,P0,P1,t,GK,GV,GL) do{ SBAR(); \
    const lds_cptr vp_=vp0+sl_prev; \
    VRD(0); SBAR(); float sacc=(P0[0]+P0[1]); \
    GAPA(C0=__builtin_amdgcn_mfma_f32_32x32x16_bf16(kf[0],qr[0],negm,0,0,0), P0[2],P0[3],P0[4],P0[5],     pw0[0]=PKW(P0,0), pw0[1]=PKW(P0,2), pw0); \
    VRD(4); SBAR(); GAPA(C1=__builtin_amdgcn_mfma_f32_32x32x16_bf16(kf[1],qr[0],negm,0,0,0), P0[6],P0[7],P0[8],P0[9],     pw0[2]=PKW(P0,4), pw0[3]=PKW(P0,6), pw0); \
    VRD(1); SBAR(); GAPA(C0=__builtin_amdgcn_mfma_f32_32x32x16_bf16(kf[2],qr[1],C0,0,0,0),   P0[10],P0[11],P0[12],P0[13], pw1[0]=PKW(P0,8), pw1[1]=PKW(P0,10), pw1); \
    VRD(5); SBAR(); GAPA(C1=__builtin_amdgcn_mfma_f32_32x32x16_bf16(kf[3],qr[1],C1,0,0,0),   P0[14],P0[15],P1[0],P1[1],   pw1[2]=PKW(P0,12),pw1[3]=PKW(P0,14), pw1); \
    VRD(2); SBAR(); GAPA(C0=__builtin_amdgcn_mfma_f32_32x32x16_bf16(kf[4],qr[2],C0,0,0,0),   P1[2],P1[3],P1[4],P1[5],     pw2[0]=PKW(P1,0), pw2[1]=PKW(P1,2), pw2); \
    VRD(6); SBAR(); GAPA(C1=__builtin_amdgcn_mfma_f32_32x32x16_bf16(kf[5],qr[2],C1,0,0,0),   P1[6],P1[7],P1[8],P1[9],     pw2[2]=PKW(P1,4), pw2[3]=PKW(P1,6), pw2); \
    VRD(3); SBAR(); GAPA(C0=__builtin_amdgcn_mfma_f32_32x32x16_bf16(kf[6],qr[3],C0,0,0,0),   P1[10],P1[11],P1[12],P1[13], pw3[0]=PKW(P1,8), pw3[1]=PKW(P1,10), pw3); \
    VRD(7); SBAR(); GAPA(C1=__builtin_amdgcn_mfma_f32_32x32x16_bf16(kf[7],qr[3],C1,0,0,0),   P1[14],P1[15],0.f,0.f,       pw3[2]=PKW(P1,12),pw3[3]=PKW(P1,14), pw3); \
    l_reg+=sacc; \
    if(GK){DMA_K((t)+3,sl_cur);} if(GV){DMA_V((t)+1,sl_next);} \
    CMASK(C0,C1,t); \
    { float a=MX3(C0[0],C0[1],C1[0]),b=MX3(C0[2],C0[3],C1[1]); a=MX3(a,C1[2],C1[3]); \
      _Pragma("unroll") for(int r=4;r<16;r+=4){a=MX3(a,C0[r],C0[r+1]);b=MX3(b,C0[r+2],C0[r+3]);a=MX3(a,C1[r],C1[r+1]);b=MX3(b,C1[r+2],C1[r+3]);} \
      float rm=__builtin_fmaxf(a,b); { auto rr=__builtin_amdgcn_permlane32_swap(__float_as_uint(rm),__float_as_uint(rm),false,false); rm=__builtin_fmaxf(__uint_as_float(rr[0]),__uint_as_float(rr[1])); } \
      resc=false; \
      if(__builtin_expect(__any(rm>(float)THRL),0)){ const float dl=__builtin_fmaxf(rm,0.f); mhat+=dl; \
        _Pragma("unroll") for(int r=0;r<16;++r){C0[r]-=dl;C1[r]-=dl;} \
        _Pragma("unroll") for(int r=0;r<16;++r)negm[r]=-mhat; asm volatile("":"+v"(negm)); \
        const float f=__builtin_amdgcn_exp2f(-dl); l_reg*=f; if(hi==0)wsf[r32]=f; resc=true; } } \
    SBAR(); \
    GAPB(o[0]=__builtin_amdgcn_mfma_f32_32x32x16_bf16(PAF(0),VFR(0),o[0],0,0,0), C0,0); \
    GAPB(o[1]=__builtin_amdgcn_mfma_f32_32x32x16_bf16(PAF(0),VFR(4),o[1],0,0,0), C0,4); \
    KRD(GL,0); GAPB(o[0]=__builtin_amdgcn_mfma_f32_32x32x16_bf16(PAF(1),VFR(1),o[0],0,0,0), C0,8); \
    KRD(GL,1); GAPB(o[1]=__builtin_amdgcn_mfma_f32_32x32x16_bf16(PAF(1),VFR(5),o[1],0,0,0), C0,12); \
    KRD(GL,2); GAPB(o[0]=__builtin_amdgcn_mfma_f32_32x32x16_bf16(PAF(2),VFR(2),o[0],0,0,0), C1,0); \
    KRD(GL,3); GAPB(o[1]=__builtin_amdgcn_mfma_f32_32x32x16_bf16(PAF(2),VFR(6),o[1],0,0,0), C1,4); \
    GAPB(o[0]=__builtin_amdgcn_mfma_f32_32x32x16_bf16(PAF(3),VFR(3),o[0],0,0,0), C1,8); \
    GAPB(o[1]=__builtin_amdgcn_mfma_f32_32x32x16_bf16(PAF(3),VFR(7),o[1],0,0,0), C1,12); \
    }while(0)
  int t=1;
  #undef CMASK
  #define CMASK(P0,P1,t) MASK_FAR(P0,P1,t)
  for(;MODE!=2&&t+7<NT;t+=2){
    STEP(pB0,pB1,pA0,pA1,t,true,true,true);     WAIT_BAR(2); RESC(); ROT();
    STEP(pA0,pA1,pB0,pB1,t+1,true,true,true);   WAIT_BAR(2); RESC(); ROT();
  }
  #undef CMASK
  #define CMASK(P0,P1,t) MASK_BAND(P0,P1,t)
  #define ENDW(tt) do{ if((tt)+3<NT){WAIT_BAR(2);} else if((tt)+2<NT){WAIT_BAR(1);} else {WAIT_BAR(0);} }while(0)
  for(;t+1<NT;t+=2){
    STEP(pB0,pB1,pA0,pA1,t,(t+3<NT),(t+1<NT),(t+1<NT));       ENDW(t);   RESC(); ROT();
    STEP(pA0,pA1,pB0,pB1,t+1,(t+4<NT),(t+2<NT),(t+2<NT));     ENDW(t+1); RESC(); ROT();
  }
  STEP(pB0,pB1,pA0,pA1,NT-1,false,false,false); RESC();
  { float sacc=pB0[0]+pB0[1]; _Pragma("unroll") for(int r=2;r<16;++r)sacc+=pB0[r]; _Pragma("unroll") for(int r=0;r<16;++r)sacc+=pB1[r]; l_reg+=sacc;
    pw0=(u32x4){PKW(pB0,0),PKW(pB0,2),PKW(pB0,4),PKW(pB0,6)};pw1=(u32x4){PKW(pB0,8),PKW(pB0,10),PKW(pB0,12),PKW(pB0,14)};pw2=(u32x4){PKW(pB1,0),PKW(pB1,2),PKW(pB1,4),PKW(pB1,6)};pw3=(u32x4){PKW(pB1,8),PKW(pB1,10),PKW(pB1,12),PKW(pB1,14)};
    SBAR(); pv(o,vb0+sl_cur,PAF(0),PAF(1),PAF(2),PAF(3)); }
  #undef PKW
  #undef PAF
  #undef VFR
  #undef PIN
  #undef MX3
  #undef GAPA
  #undef GAPB
  #undef EX
  #undef VRD
  #undef KRD
  #undef STEP
  #undef ENDW
  {auto rr=__builtin_amdgcn_permlane32_swap(__float_as_uint(l_reg),__float_as_uint(l_reg),false,false);l_reg=__uint_as_float(rr[0])+__uint_as_float(rr[1]);}
  int lane_e=lane; asm volatile("":"+v"(lane_e)); const int r32e=lane_e&31, hie=lane_e>>5;
  float*wsfe=(float*)(shm+LDS_WS)+wid*128;
  if(hie==0){ wsfe[32+r32e]=l_reg; if(EPI!=0){ const float gl=bfs((short)U.gate[(long)(wid*QBLK+r32e)*PITCH+U.gcol]); wsfe[64+r32e]=1.f/(1.f+__expf(-gl)); } }
  asm volatile("s_waitcnt lgkmcnt(0)":::"memory");
  float rli[16];
  #pragma unroll
  for(int r=0;r<16;++r){ rli[r]=__builtin_amdgcn_rcpf(fmaxf(wsfe[32+crow(r,hie)],1e-30f)); if(EPI!=0)rli[r]*=wsfe[64+crow(r,hie)]; }
  bf16*Ow=U.Ob+(long)(wid*QBLK)*PITCH;
  { bf16*stg=(bf16*)(shm+LDS_OST)+wid*2048;
    #pragma unroll
    for(int r=0;r<16;++r){const int orow=crow(r,hie);
      #pragma unroll
      for(int d0=0;d0<2;++d0){ float v=o[d0][r]*rli[r]; if(EPI==2)v+=bfs((short)stg[orow*64+d0*32+r32e]); stg[orow*64+d0*32+r32e]=f2b(v);} }
    asm volatile("s_waitcnt lgkmcnt(0)":::"memory");
    if(EPI!=1){
    #pragma unroll
    for(int i=0;i<4;++i){const int row=i*8+(lane_e>>3),ch=lane_e&7; u32x4 v=*(const u32x4*)(stg+row*64+ch*8);
      if(EPI==2){ const u32x4 t=*(const u32x4*)(U.tmp+(long)(wid*QBLK+row)*512+ch*8);
        v.x=pk2b(lo16(v.x)+lo16(t.x),hi16(v.x)+hi16(t.x)); v.y=pk2b(lo16(v.y)+lo16(t.y),hi16(v.y)+hi16(t.y)); v.z=pk2b(lo16(v.z)+lo16(t.z),hi16(v.z)+hi16(t.z)); v.w=pk2b(lo16(v.w)+lo16(t.w),hi16(v.w)+hi16(t.w)); }
      ATTN_STORE16(Ow+(long)row*PITCH+ch*8,v);} } }
  asm volatile("s_waitcnt lgkmcnt(0)\n\ts_barrier":::"memory");
  #undef DMA_K
  #undef DMA_V
  #undef CMASK
  #undef START
  #undef RESC
  #undef ROT
}
constexpr int ATTN_LDS_BYTES=LDS_BYTES;
#undef SBAR
#undef WAIT_BAR
}

constexpr int NWAVES = 8;
constexpr int B_ = 4, S_ = 8192, DM = 1024, M_ = B_ * S_, DIN = 7464, FF = 2816, NL = 2;
constexpr int YP = pg8::YP_;
constexpr float C2 = pg8::C2_, LOG2E = 1.4426950408889634f;
constexpr float NORM_EPS = 1e-6f;
constexpr int Y_AQ = 0, Y_AKC = 512, Y_AVC = 640, Y_AKS = 768, Y_AVS = 896, Y_AKW = 1024, Y_AVW = 1152, Y_CQ = 1280, Y_CK = 1792, Y_CV = 2304,
              Y_BQ = 2816, Y_BK = 3072, Y_BV = 3328, Y_BR = 3840, Y_AG = 4352, Y_BLR = 4376;
constexpr int NIN = 7680;
constexpr size_t MiB = 1u << 20;
constexpr size_t WS_CTL = 0, CTL_ZERO_BYTES = 1 * MiB;
constexpr size_t WS_WIN = 1 * MiB, WS_WA = 16 * MiB, WS_WB = 17 * MiB, WS_WC = 18 * MiB, WS_WO = 19 * MiB, WS_WF1 = 21 * MiB, WS_WF2 = 32 * MiB;
constexpr size_t WS_H = 40 * MiB;
constexpr size_t WS_Y = 104 * MiB;
constexpr size_t WS_G8 = 379 * MiB;
constexpr size_t WS_ACT = WS_Y + 128 * MiB;
constexpr size_t WS_SM = 475 * MiB;
constexpr size_t WS_KCMP = WS_SM, WS_VCMP = WS_SM + 1 * MiB, WS_KMEAN = WS_SM + 2 * MiB;
constexpr size_t WS_GA = WS_SM + 3 * MiB;
constexpr size_t WS_MASK = 38 * MiB;
constexpr size_t WS_OATMP = WS_H;
constexpr size_t WS_O16 = WS_H + 32 * MiB;
constexpr size_t WS_VCMPT = WS_VCMP + 512 * 1024;
constexpr size_t WS_GST = WS_H + 32 * MiB;
constexpr size_t WS_GDEC = WS_SM + 3 * MiB;
constexpr size_t WS_END = 512 * MiB;
static_assert(WS_GA + (size_t)M_ * 256 * 4 <= WS_END && WS_Y + (size_t)M_ * YP * 2 <= WS_G8 && WS_G8 + (size_t)M_ * 3072 <= WS_SM, "ws map");
static_assert(WS_ACT + (size_t)M_ * FF * 2 <= WS_SM && WS_WF2 + (size_t)DM * FF * 2 <= WS_H, "ws map 2");
constexpr int CW_BAR = 4096;
constexpr int RING_OFF = 0, RING_BYTES = 131072;
constexpr int LDSCTL_OFF = RING_BYTES, MISC_OFF = LDSCTL_OFF + 320;
constexpr int LDS_BYTES = 147456;

#define GAS __attribute__((address_space(1)))
#define LAS __attribute__((address_space(3)))
typedef unsigned short bf16;
typedef unsigned v4u __attribute__((ext_vector_type(4)));
typedef float f32x4 __attribute__((ext_vector_type(4)));
typedef short bf16x8 __attribute__((ext_vector_type(8)));
typedef GAS unsigned gu32;
typedef GAS unsigned long long gu64;
#define RLX_AGENT __ATOMIC_RELAXED, __HIP_MEMORY_SCOPE_AGENT
#define LDS_WAIT() asm volatile("s_waitcnt lgkmcnt(0)" ::: "memory")
#define VM_WAIT() asm volatile("s_waitcnt vmcnt(0)" ::: "memory")
__device__ __forceinline__ unsigned long long rt() { return __builtin_amdgcn_s_memrealtime(); }
__device__ __forceinline__ unsigned f2bf(float f) { unsigned u = __builtin_bit_cast(unsigned, f); return (u + 0x7fffu + ((u >> 16) & 1u)) >> 16; }
__device__ __forceinline__ unsigned pk2(float lo, float hi) { return f2bf(lo) | (f2bf(hi) << 16); }

__device__ __forceinline__ float bf2f(bf16 h) { return __uint_as_float((unsigned)h << 16); }
__device__ __forceinline__ float sigm(float v) { return 1.f / (1.f + __expf(-v)); }
#define WFENCE() asm volatile("s_waitcnt lgkmcnt(0)" ::: "memory")

#define XB_TMO      128
#define XB_XCNT(j)  (256  + 64 * (j))
#define XB_XSUB(j)  (1280 + 64 * (j))
#define XB_XGEN(j)  (2304 + 64 * (j))
#define XB_TOP      3328
#define XB_TOPGEN   3392
#define XCD_BAR_WORDS 3456
#define XB_SPIN_CAP (1u << 18)

__device__ __forceinline__ unsigned xb_ld(unsigned* p)              { return __hip_atomic_load(p, __ATOMIC_RELAXED, __HIP_MEMORY_SCOPE_AGENT); }
__device__ __forceinline__ unsigned xb_add(unsigned* p, unsigned v) { return __hip_atomic_fetch_add(p, v, __ATOMIC_RELAXED, __HIP_MEMORY_SCOPE_AGENT); }
__device__ __forceinline__ unsigned xb_xcc_id() { return (unsigned)__builtin_amdgcn_s_getreg((3 << 11) | 20) & 0xFu; }
#define XB_SPIN(cond, bar) do { unsigned _sp = 0; while (cond) { __builtin_amdgcn_s_sleep(1); \
    if ((++_sp & 255u) == 0u) { if (xb_ld(&(bar)[XB_TMO])) break; if (_sp > XB_SPIN_CAP) { atomicAdd(&(bar)[XB_TMO], 1u); break; } } } } while (0)

struct XcdBarrier {
    unsigned* bar; unsigned x;
    volatile LAS unsigned* st;
};

__device__ __forceinline__ XcdBarrier xcd_barrier_post(unsigned* bar, volatile LAS unsigned* st) {
    XcdBarrier b; b.bar = bar; b.x = xb_xcc_id(); b.st = st;
    if (threadIdx.x == 0) (void)xb_add(&bar[XB_XCNT(b.x)], 1u);
    return b;
}
__device__ __forceinline__ void xcd_barrier_complete(unsigned* bar, unsigned x, unsigned& nloc, unsigned& nx) {
    const unsigned G = gridDim.x * gridDim.y * gridDim.z;
    unsigned sum, cnt, mine, sp = 0u;
    for (;;) {
        sum = 0u; cnt = 0u; mine = 0u;
#pragma unroll
        for (unsigned j = 0; j < 16; ++j) { const unsigned c = xb_ld(&bar[XB_XCNT(j)]); sum += c; cnt += (c > 0u) ? 1u : 0u; mine = (j == x) ? c : mine; }
        if (sum == G) break;
        __builtin_amdgcn_s_sleep(1);
        if ((++sp & 255u) == 0u) { if (xb_ld(&bar[XB_TMO])) break; if (sp > XB_SPIN_CAP) { atomicAdd(&bar[XB_TMO], 1u); break; } }
    }
    nloc = mine > 0u ? mine : 1u; nx = cnt > 0u ? cnt : 1u;
}

__device__ __forceinline__ void xcd_barrier(const XcdBarrier& b) {
    asm volatile("s_waitcnt vmcnt(0)" ::: "memory");
    __syncthreads();
    if (threadIdx.x == 0) {
        unsigned* bar = b.bar;
        __builtin_amdgcn_s_waitcnt(0);
        unsigned nloc = b.st[0], nx = b.st[1];
        if (nloc == 0u) { xcd_barrier_complete(bar, b.x, nloc, nx); b.st[0] = nloc; b.st[1] = nx; }
        const unsigned old = xb_add(&bar[XB_XSUB(b.x)], 1u);
        const unsigned gen = old / nloc;
        if (old + 1u == (gen + 1u) * nloc) {
            __builtin_amdgcn_fence(__ATOMIC_RELEASE, "agent");
            asm volatile("s_waitcnt vmcnt(0)" ::: "memory");
            const unsigned og = xb_add(&bar[XB_TOP], 1u);
            const unsigned tg = og / nx;
            if (og + 1u == (tg + 1u) * nx) xb_add(&bar[XB_TOPGEN], 1u);
            else XB_SPIN(xb_ld(&bar[XB_TOPGEN]) == tg, bar);
            __builtin_amdgcn_fence(__ATOMIC_ACQUIRE, "agent");
            xb_add(&bar[XB_XGEN(b.x)], 1u);
            asm volatile("s_waitcnt vmcnt(0)" ::: "memory");
        } else {
            XB_SPIN(xb_ld(&bar[XB_XGEN(b.x)]) == gen, bar);
            __builtin_amdgcn_fence(__ATOMIC_ACQUIRE, "agent");
            asm volatile("s_waitcnt vmcnt(0)" ::: "memory");
        }
    }
    __syncthreads();
}


struct Frame {
    LAS unsigned char* lds;
    volatile LAS unsigned* MISC;
    gu32* ctl;
    int tid, lane, wave, G;
};
__device__ __forceinline__ float wave_sum(float v) {
#pragma unroll
    for (int o = 1; o < 64; o <<= 1) v += __shfl_xor(v, o);
    return v;
}
__device__ __forceinline__ float wave_max(float v) {
#pragma unroll
    for (int o = 1; o < 64; o <<= 1) v = fmaxf(v, __shfl_xor(v, o));
    return v;
}
__device__ __forceinline__ int t5_bucket(int d) {
    if (d < 16) return d < 0 ? 0 : d;
    int b = 16;
    b += (d >= 19); b += (d >= 21); b += (d >= 24); b += (d >= 27); b += (d >= 31); b += (d >= 35); b += (d >= 40); b += (d >= 46);
    b += (d >= 52); b += (d >= 59); b += (d >= 67); b += (d >= 77); b += (d >= 87); b += (d >= 99); b += (d >= 113);
    return b;
}
template <class CM> __device__ __forceinline__ void tr_item(const float* W, int Nsrc, int K, bf16* WT, int item, int nblk, CM cm, LAS float* scr, int lane) {
    const int kb = item / nblk, nb = item % nblk, k0 = 64 * kb, n0 = 32 * nb;
    const int sc = cm(n0 + (lane & 31));
#pragma unroll 8
    for (int i = 0; i < 32; ++i) { const int kk = 2 * i + (lane >> 5); scr[kk * 33 + (lane & 31)] = sc >= 0 ? W[(size_t)(k0 + kk) * Nsrc + sc] : 0.f; }
    LDS_WAIT(); asm volatile("" ::: "memory");
    const int c = lane & 7;
#pragma unroll
    for (int j = 0; j < 4; ++j) { const int n = (lane >> 3) + 8 * j; const LAS float* s = scr + (8 * c) * 33 + n;
        v4u o; o.x = pk2(s[0 * 33], s[1 * 33]); o.y = pk2(s[2 * 33], s[3 * 33]); o.z = pk2(s[4 * 33], s[5 * 33]); o.w = pk2(s[6 * 33], s[7 * 33]);
        *(GAS v4u*)(WT + (size_t)(n0 + n) * K + k0 + 8 * c) = o; }
    LDS_WAIT(); asm volatile("" ::: "memory");
}
struct CmId { __device__ __forceinline__ int operator()(int n) const { return n; } };
struct CmWin { __device__ __forceinline__ int operator()(int n) const {
    if (n < 1280) return n;
    if (n < 2816) return n - 1280 + 2856;
    if (n < 4352) return n - 2816 + 1304;
    if (n < 4376) return n - 4352 + 1280;
    if (n < 4392) return n - 4376 + 2840;
    if (n < 4608) return -1;
    return n - 4608 + 4392; } };
struct CmFfn { __device__ __forceinline__ int operator()(int c) const { const int p = c >> 8, r = c & 255; return r < 128 ? 128 * p + r : FF + 128 * p + (r - 128); } };

struct Args { const float* in[22]; float* out; unsigned char* ws; int ph_lo, ph_hi; };

__device__ __forceinline__ void phase_weights(Frame& F, const Args& a, int l) {
    LAS float* scr = (LAS float*)(F.lds + RING_OFF + F.wave * 16384);
    const int gw = blockIdx.x * NWAVES + F.wave, NGW = F.G * NWAVES;
    unsigned char* ws = a.ws;
    constexpr int I_IN = 16 * (NIN / 32), I_BR = 8 * 32, I_O = 16 * 32, I_F1 = 16 * (2 * FF / 32), I_F2 = (FF / 64) * 32;
    constexpr int NIT = I_IN + 3 * I_BR + I_O + I_F1 + I_F2;
    for (int it = gw; it < NIT; it += NGW) {
        int r = it;
        if (r < I_IN) { tr_item(a.in[6] + (size_t)l * DM * DIN, DIN, DM, (bf16*)(ws + WS_WIN), r, NIN / 32, CmWin(), scr, F.lane); continue; } r -= I_IN;
        if (r < I_BR) { tr_item(a.in[16] + (size_t)l * 512 * DM, DM, 512, (bf16*)(ws + WS_WA), r, 32, CmId(), scr, F.lane); continue; } r -= I_BR;
        if (r < I_BR) { tr_item(a.in[17] + (size_t)l * 512 * DM, DM, 512, (bf16*)(ws + WS_WB), r, 32, CmId(), scr, F.lane); continue; } r -= I_BR;
        if (r < I_BR) { tr_item(a.in[18] + (size_t)l * 512 * DM, DM, 512, (bf16*)(ws + WS_WC), r, 32, CmId(), scr, F.lane); continue; } r -= I_BR;
        if (r < I_O) { tr_item(a.in[19] + (size_t)l * DM * DM, DM, DM, (bf16*)(ws + WS_WO), r, 32, CmId(), scr, F.lane); continue; } r -= I_O;
        if (r < I_F1) { tr_item(a.in[20] + (size_t)l * DM * 2 * FF, 2 * FF, DM, (bf16*)(ws + WS_WF1), r, 2 * FF / 32, CmFfn(), scr, F.lane); continue; } r -= I_F1;
        tr_item(a.in[21] + (size_t)l * FF * DM, DM, FF, (bf16*)(ws + WS_WF2), r, 32, CmId(), scr, F.lane);
    }
}
__device__ __forceinline__ void phase_norm0(Frame& F, const float* x, const float* w, bf16* H) {
    const int gw = blockIdx.x * NWAVES + F.wave, NGW = F.G * NWAVES;
    for (int m = gw; m < M_; m += NGW) {
        const f32x4* xr = (const f32x4*)(x + (size_t)m * DM) + F.lane; f32x4 v[4]; float s = 0.f;
#pragma unroll
        for (int j = 0; j < 4; ++j) { v[j] = xr[64 * j]; s += v[j].x * v[j].x + v[j].y * v[j].y + v[j].z * v[j].z + v[j].w * v[j].w; }
        const float r = rsqrtf(wave_sum(s) * (1.f / DM) + NORM_EPS);
        unsigned long long* o8 = (unsigned long long*)(H + (size_t)m * DM) + F.lane;
#pragma unroll
        for (int j = 0; j < 4; ++j) { const f32x4 wv = ((const f32x4*)w)[F.lane + 64 * j];
            o8[64 * j] = (unsigned long long)pk2(v[j].x * r * wv.x, v[j].y * r * wv.y) | ((unsigned long long)pk2(v[j].z * r * wv.z, v[j].w * r * wv.w) << 32); }
    }
}
__device__ __forceinline__ void phase_resid(Frame& F, const float* y, const float* xin, float* xout, const float* wpost, const float* wpre, bf16* hout) {
    const int gw = blockIdx.x * NWAVES + F.wave, NGW = F.G * NWAVES;
    for (int m = gw; m < M_; m += NGW) {
        const f32x4* yr = (const f32x4*)(y + (size_t)m * DM) + F.lane; const f32x4* xr = (const f32x4*)(xin + (size_t)m * DM) + F.lane;
        f32x4 v[4], xv[4]; float s = 0.f;
#pragma unroll
        for (int j = 0; j < 4; ++j) { v[j] = yr[64 * j]; xv[j] = xr[64 * j]; s += v[j].x * v[j].x + v[j].y * v[j].y + v[j].z * v[j].z + v[j].w * v[j].w; }
        const float r = rsqrtf(wave_sum(s) * (1.f / DM) + NORM_EPS); float s2 = 0.f;
        f32x4* xo = (f32x4*)(xout + (size_t)m * DM) + F.lane;
#pragma unroll
        for (int j = 0; j < 4; ++j) { const f32x4 wv = ((const f32x4*)wpost)[F.lane + 64 * j]; f32x4 n;
            n.x = xv[j].x + v[j].x * r * wv.x; n.y = xv[j].y + v[j].y * r * wv.y; n.z = xv[j].z + v[j].z * r * wv.z; n.w = xv[j].w + v[j].w * r * wv.w;
            xo[64 * j] = n; v[j] = n; s2 += n.x * n.x + n.y * n.y + n.z * n.z + n.w * n.w; }
        if (hout) { const float r2 = rsqrtf(wave_sum(s2) * (1.f / DM) + NORM_EPS);
            unsigned long long* o8 = (unsigned long long*)(hout + (size_t)m * DM) + F.lane;
#pragma unroll
            for (int j = 0; j < 4; ++j) { const f32x4 wv = ((const f32x4*)wpre)[F.lane + 64 * j];
                o8[64 * j] = (unsigned long long)pk2(v[j].x * r2 * wv.x, v[j].y * r2 * wv.y) | ((unsigned long long)pk2(v[j].z * r2 * wv.z, v[j].w * r2 * wv.w) << 32); } }
    }
}
__device__ __forceinline__ void unpack8(const v4u w, float (&k)[8]) {
    k[0] = __uint_as_float(w.x << 16); k[1] = __uint_as_float(w.x & 0xffff0000u); k[2] = __uint_as_float(w.y << 16); k[3] = __uint_as_float(w.y & 0xffff0000u);
    k[4] = __uint_as_float(w.z << 16); k[5] = __uint_as_float(w.z & 0xffff0000u); k[6] = __uint_as_float(w.w << 16); k[7] = __uint_as_float(w.w & 0xffff0000u);
}
__device__ __forceinline__ void dot4(const LAS float* qs, const bf16* kr, float (&d)[4]) {
    d[0] = d[1] = d[2] = d[3] = 0.f;
#pragma unroll 1
    for (int c = 0; c < 8; ++c) { asm volatile("" ::: "memory"); const v4u w = ((const v4u*)kr)[c]; float k[8]; unpack8(w, k);
#pragma unroll
        for (int e = 0; e < 8; ++e) { const int dd = c * 8 + e;
#pragma unroll
            for (int h = 0; h < 4; ++h) d[h] += qs[h * 64 + dd] * k[e]; } }
}
__device__ __forceinline__ float dot1(const LAS float* qs, const bf16* kr) {
    float d = 0.f;
#pragma unroll
    for (int c = 0; c < 8; ++c) { const v4u w = ((const v4u*)kr)[c]; float k[8]; unpack8(w, k);
#pragma unroll
        for (int e = 0; e < 8; ++e) d += qs[c * 8 + e] * k[e]; }
    return d;
}
__device__ __forceinline__ float gelu_tanh(float x) { const float u = 0.7978845608028654f * (x + 0.044715f * x * x * x); return 0.5f * x * (1.f + tanhf(u)); }

__device__ __forceinline__ void phase2_naive(Frame& F, const Args& a, int l) {
    const int gw = blockIdx.x * NWAVES + F.wave, NGW = F.G * NWAVES, lane = F.lane;
    const bf16* Y = (const bf16*)(a.ws + WS_Y);
    LAS float* scr = (LAS float*)(F.lds + RING_OFF + F.wave * 16384);
    for (int t = gw; t < 2 * 8 * 511; t += NGW) {
        const int kv = t / (8 * 511), r = t % (8 * 511), bg = r / 511, n = r % 511, b = bg >> 1, g = bg & 1;
        const float* pe = a.in[kv ? 8 : 7] + (size_t)l * 32 * 64; const float* w1 = a.in[kv ? 11 : 9] + (size_t)l * 2048 * 64; const float* w2 = a.in[kv ? 12 : 10] + (size_t)l * 64 * 64;
        const bf16* src = Y + ((size_t)b * S_ + 16 * n) * YP + (kv ? Y_AVC : Y_AKC) + g * 64;
        float acc = 0.f;
        for (int pos = 0; pos < 32; ++pos) {
            const float xin = bf2f(src[(size_t)pos * YP + lane]) + pe[pos * 64 + lane];
            scr[lane] = xin; WFENCE();
#pragma unroll 8
            for (int d = 0; d < 64; ++d) acc += scr[d] * w1[(size_t)(pos * 64 + d) * 64 + lane];
            WFENCE();
        }
        const float hdn = gelu_tanh(acc);
        scr[lane] = hdn; WFENCE();
        float o = 0.f;
#pragma unroll 8
        for (int j = 0; j < 64; ++j) o += scr[j] * w2[j * 64 + lane];
        WFENCE();
        bf16* dst = (bf16*)(a.ws + (kv ? WS_VCMP : WS_KCMP)) + ((size_t)bg * 512 + n) * 64;
        dst[lane] = (bf16)f2bf(o);
        if (kv) ((bf16*)(a.ws + WS_VCMPT))[((size_t)bg * 64 + lane) * 512 + n] = (bf16)f2bf(o);
    }
    for (int t = gw; t < 4 * 8 * 32; t += NGW) {
        const int blk = t & 31, h = (t >> 5) & 7, b = t >> 8;
        const bf16* src = Y + ((size_t)b * S_ + blk * 256) * YP + Y_CK + h * 64 + lane; float s = 0.f;
        for (int i = 0; i < 256; ++i) s += bf2f(src[(size_t)i * YP]);
        ((float*)(a.ws + WS_KMEAN))[(size_t)t * 64 + lane] = s * (1.f / 256.f);
    }
}
__device__ __forceinline__ void gla_scan_naive(Frame& F, const Args& a) {
    const bf16* Y = (const bf16*)(a.ws + WS_Y); const float* GA = (const float*)(a.ws + WS_GA); bf16* O16 = (bf16*)(a.ws + WS_O16);
    const int lane = F.lane;
    for (int task = blockIdx.x; task < 256; task += F.G) {
        const int eg = task & 15, h = (task >> 4) & 3, b = task >> 6, e = eg * 8 + F.wave;
        float Sst = 0.f;
        for (int t0 = 0; t0 < S_; t0 += 8) {
            float av[8], kv[8], qv[8], vv[8];
#pragma unroll
            for (int j = 0; j < 8; ++j) { const size_t row = (size_t)b * S_ + t0 + j;
                av[j] = GA[row * 256 + h * 64 + lane]; kv[j] = bf2f(Y[row * YP + Y_BK + h * 64 + lane]); qv[j] = bf2f(Y[row * YP + Y_BQ + h * 64 + lane]); vv[j] = bf2f(Y[row * YP + Y_BV + h * 128 + e]); }
#pragma unroll
            for (int j = 0; j < 8; ++j) { Sst = av[j] * Sst + kv[j] * vv[j]; const float o = wave_sum(qv[j] * Sst);
                if (lane == 0) O16[((size_t)b * S_ + t0 + j) * 512 + h * 128 + e] = (bf16)f2bf(o); }
        }
    }
}
__device__ __forceinline__ void nsa_cmp_naive(Frame& F, const Args& a) {
    const int gw = blockIdx.x * NWAVES + F.wave, NGW = F.G * NWAVES, lane = F.lane;
    bf16* Y = (bf16*)(a.ws + WS_Y); const float* rel = a.in[1];
    LAS float* scr = (LAS float*)(F.lds + RING_OFF + F.wave * 16384);
    LAS float* qs = scr; LAS float* sc = scr + 256; LAS float* s2 = scr + 256 + 2048;
    for (int task = gw; task < 8 * S_; task += NGW) {
        const int q = task & (S_ - 1), bg = task >> 13, g = bg & 1, b = bg >> 1;
        const size_t row = (size_t)b * S_ + q; bf16* Yr = Y + row * YP;
#pragma unroll
        for (int h = 0; h < 4; ++h) qs[h * 64 + lane] = bf2f(Yr[Y_AQ + (g * 4 + h) * 64 + lane]);
        float gt[4][3];
#pragma unroll
        for (int h = 0; h < 4; ++h)
#pragma unroll
            for (int br = 0; br < 3; ++br) gt[h][br] = sigm(bf2f(Yr[Y_AG + (g * 4 + h) * 3 + br]));
        WFENCE();
        const int cur = q >> 6, ncv = q >= 31 ? ((q - 31) >> 4) + 1 : 0;
        const bf16* KC = (const bf16*)(a.ws + WS_KCMP) + (size_t)bg * 512 * 64; const bf16* VC = (const bf16*)(a.ws + WS_VCMP) + (size_t)bg * 512 * 64;
        float mx[4] = {-1e30f, -1e30f, -1e30f, -1e30f};
        for (int i = 0; i < 8; ++i) { const int n = lane + 64 * i;
            if (n < ncv) { float d[4]; dot4(qs, KC + (size_t)n * 64, d); const int bk = t5_bucket(q - (16 * n + 31));
#pragma unroll
                for (int h = 0; h < 4; ++h) { const float s = d[h] + rel[bk * 16 + g * 4 + h] * LOG2E; sc[h * 512 + n] = s; mx[h] = fmaxf(mx[h], s); } }
            else {
#pragma unroll
                for (int h = 0; h < 4; ++h) sc[h * 512 + n] = 0.f; } }
        float ls[4] = {0.f, 0.f, 0.f, 0.f};
#pragma unroll
        for (int h = 0; h < 4; ++h) mx[h] = wave_max(mx[h]);
        WFENCE();
        for (int i = 0; i < 8; ++i) { const int n = lane + 64 * i;
            if (n < ncv) {
#pragma unroll
                for (int h = 0; h < 4; ++h) { const float e = exp2f(sc[h * 512 + n] - mx[h]); sc[h * 512 + n] = e; ls[h] += e; } } }
#pragma unroll
        for (int h = 0; h < 4; ++h) ls[h] = 1.f / fmaxf(wave_sum(ls[h]), 1e-20f);
        for (int i = 0; i < 8; ++i) { const int n = lane + 64 * i;
            if (n < ncv) {
#pragma unroll
                for (int h = 0; h < 4; ++h) sc[h * 512 + n] *= ls[h]; } }
        WFENCE();
        float v0, v1;
        { float t[2];
#pragma unroll
          for (int jj = 0; jj < 2; ++jj) { const int j = lane + 64 * jj; float v = 0.f;
              for (int n = 4 * j - 1; n <= 4 * j + 3; ++n) if (n >= 0 && n < 511) v += (sc[n] + sc[512 + n]) + (sc[1024 + n] + sc[1536 + n]);
              const bool forced = (j == 0) || (j == cur) || (j == cur - 1);
              t[jj] = forced ? 1e9f : (j <= cur ? v : -1e30f); }
          v0 = t[0]; v1 = t[1]; }
        bool sel0 = false, sel1 = false;
        for (int it = 0; it < 16; ++it) {
            const float c0 = sel0 ? -INFINITY : v0, c1 = sel1 ? -INFINITY : v1;
            const float mxv = wave_max(fmaxf(c0, c1));
            const unsigned long long m0 = __ballot(!sel0 && v0 == mxv);
            if (m0) { const int idx = __builtin_ctzll(m0); if (lane == idx) sel0 = true; }
            else { const unsigned long long m1 = __ballot(!sel1 && v1 == mxv); const int idx = m1 ? __builtin_ctzll(m1) : -1; if (lane == idx) sel1 = true; }
        }
        sel0 = sel0 && (lane <= cur); sel1 = sel1 && (lane + 64 <= cur);
        const unsigned long long sm0 = __ballot(sel0), sm1 = __ballot(sel1);
        float oc[4] = {0.f, 0.f, 0.f, 0.f};
        for (int n = 0; n < ncv; ++n) { const float vv = bf2f(VC[(size_t)n * 64 + lane]);
#pragma unroll
            for (int h = 0; h < 4; ++h) oc[h] += sc[h * 512 + n] * vv; }
        { unsigned* MK = (unsigned*)(a.ws + WS_MASK) + ((size_t)bg * S_ + q) * 4;
          if (lane == 0) { MK[0] = (unsigned)sm0; MK[1] = (unsigned)(sm0 >> 32); MK[2] = (unsigned)sm1; MK[3] = (unsigned)(sm1 >> 32); }
          bf16* T = (bf16*)(a.ws + WS_OATMP) + row * 512;
#pragma unroll
          for (int h = 0; h < 4; ++h) T[(g * 4 + h) * 64 + lane] = (bf16)f2bf(gt[h][0] * oc[h]); }
        WFENCE();
    }
}
__device__ __forceinline__ void nsa_naive(Frame& F, const Args& a) {
    const int gw = blockIdx.x * NWAVES + F.wave, NGW = F.G * NWAVES, lane = F.lane;
    bf16* Y = (bf16*)(a.ws + WS_Y); const float* rel = a.in[1];
    LAS float* scr = (LAS float*)(F.lds + RING_OFF + F.wave * 16384);
    LAS float* qs = scr; LAS float* sc = scr + 256; LAS float* s2 = scr + 256 + 2048;
    for (int task = gw; task < 8 * S_; task += NGW) {
        const int q = task & (S_ - 1), bg = task >> 13, g = bg & 1, b = bg >> 1;
        const size_t row = (size_t)b * S_ + q; bf16* Yr = Y + row * YP;
#pragma unroll
        for (int h = 0; h < 4; ++h) qs[h * 64 + lane] = bf2f(Yr[Y_AQ + (g * 4 + h) * 64 + lane]);
        float gt[4][3];
#pragma unroll
        for (int h = 0; h < 4; ++h)
#pragma unroll
            for (int br = 0; br < 3; ++br) gt[h][br] = sigm(bf2f(Yr[Y_AG + (g * 4 + h) * 3 + br]));
        WFENCE();
        const int cur = q >> 6, ncv = q >= 31 ? ((q - 31) >> 4) + 1 : 0;
        const bf16* KC = (const bf16*)(a.ws + WS_KCMP) + (size_t)bg * 512 * 64; const bf16* VC = (const bf16*)(a.ws + WS_VCMP) + (size_t)bg * 512 * 64;
        float mx[4] = {-1e30f, -1e30f, -1e30f, -1e30f};
        for (int i = 0; i < 8; ++i) { const int n = lane + 64 * i;
            if (n < ncv) { float d[4]; dot4(qs, KC + (size_t)n * 64, d); const int bk = t5_bucket(q - (16 * n + 31));
#pragma unroll
                for (int h = 0; h < 4; ++h) { const float s = d[h] + rel[bk * 16 + g * 4 + h] * LOG2E; sc[h * 512 + n] = s; mx[h] = fmaxf(mx[h], s); } }
            else {
#pragma unroll
                for (int h = 0; h < 4; ++h) sc[h * 512 + n] = 0.f; } }
        float ls[4] = {0.f, 0.f, 0.f, 0.f};
#pragma unroll
        for (int h = 0; h < 4; ++h) mx[h] = wave_max(mx[h]);
        WFENCE();
        for (int i = 0; i < 8; ++i) { const int n = lane + 64 * i;
            if (n < ncv) {
#pragma unroll
                for (int h = 0; h < 4; ++h) { const float e = exp2f(sc[h * 512 + n] - mx[h]); sc[h * 512 + n] = e; ls[h] += e; } } }
#pragma unroll
        for (int h = 0; h < 4; ++h) ls[h] = 1.f / fmaxf(wave_sum(ls[h]), 1e-20f);
        for (int i = 0; i < 8; ++i) { const int n = lane + 64 * i;
            if (n < ncv) {
#pragma unroll
                for (int h = 0; h < 4; ++h) sc[h * 512 + n] *= ls[h]; } }
        WFENCE();
        float v0, v1;
        { float t[2];
#pragma unroll
          for (int jj = 0; jj < 2; ++jj) { const int j = lane + 64 * jj; float v = 0.f;
              for (int n = 4 * j - 1; n <= 4 * j + 3; ++n) if (n >= 0 && n < 511) v += (sc[n] + sc[512 + n]) + (sc[1024 + n] + sc[1536 + n]);
              const bool forced = (j == 0) || (j == cur) || (j == cur - 1);
              t[jj] = forced ? 1e9f : (j <= cur ? v : -1e30f); }
          v0 = t[0]; v1 = t[1]; }
        bool sel0 = false, sel1 = false;
        for (int it = 0; it < 16; ++it) {
            const float c0 = sel0 ? -INFINITY : v0, c1 = sel1 ? -INFINITY : v1;
            const float mxv = wave_max(fmaxf(c0, c1));
            const unsigned long long m0 = __ballot(!sel0 && v0 == mxv);
            if (m0) { const int idx = __builtin_ctzll(m0); if (lane == idx) sel0 = true; }
            else { const unsigned long long m1 = __ballot(!sel1 && v1 == mxv); const int idx = m1 ? __builtin_ctzll(m1) : -1; if (lane == idx) sel1 = true; }
        }
        sel0 = sel0 && (lane <= cur); sel1 = sel1 && (lane + 64 <= cur);
        const unsigned long long sm0 = __ballot(sel0), sm1 = __ballot(sel1);
        float oc[4] = {0.f, 0.f, 0.f, 0.f};
        for (int n = 0; n < ncv; ++n) { const float vv = bf2f(VC[(size_t)n * 64 + lane]);
#pragma unroll
            for (int h = 0; h < 4; ++h) oc[h] += sc[h * 512 + n] * vv; }
        float ms[4] = {-1e30f, -1e30f, -1e30f, -1e30f}, lsel[4] = {0.f, 0.f, 0.f, 0.f}, os[4] = {0.f, 0.f, 0.f, 0.f};
        for (int j = 0; j <= cur; ++j) {
            const bool on = j < 64 ? ((sm0 >> j) & 1ull) : ((sm1 >> (j - 64)) & 1ull);
            if (!on) continue;
            const int kpos = 64 * j + lane; const bool valid = kpos <= q;
            float d[4]; dot4(qs, Y + ((size_t)b * S_ + kpos) * YP + Y_AKS + g * 64, d);
            const int bk = t5_bucket(q - kpos);
            WFENCE();
#pragma unroll
            for (int h = 0; h < 4; ++h) { const float s = valid ? d[h] + rel[bk * 16 + g * 4 + h] * LOG2E : -1e30f;
                const float mn = fmaxf(ms[h], wave_max(s)); const float p = valid ? exp2f(s - mn) : 0.f; s2[h * 64 + lane] = p;
                const float scl = exp2f(ms[h] - mn); lsel[h] = lsel[h] * scl + wave_sum(p); os[h] *= scl; ms[h] = mn; }
            WFENCE();
            const bf16* vb = Y + ((size_t)b * S_ + 64 * j) * YP + Y_AVS + g * 64 + lane;
            for (int kk = 0; kk < 64; ++kk) { const float vv = bf2f(vb[(size_t)kk * YP]);
#pragma unroll
                for (int h = 0; h < 4; ++h) os[h] += s2[h * 64 + kk] * vv; }
        }
        float mw[4] = {-1e30f, -1e30f, -1e30f, -1e30f}, lw[4] = {0.f, 0.f, 0.f, 0.f}, ow[4] = {0.f, 0.f, 0.f, 0.f};
        for (int c = 0; c < 8; ++c) {
            if (q - 64 * c < 0) break;
            const int dist = 64 * c + lane, kpos = q - dist; const bool valid = kpos >= 0;
            float d[4]; dot4(qs, Y + ((size_t)b * S_ + (valid ? kpos : 0)) * YP + Y_AKW + g * 64, d);
            const int bk = t5_bucket(dist);
            WFENCE();
#pragma unroll
            for (int h = 0; h < 4; ++h) { const float s = valid ? d[h] + rel[bk * 16 + g * 4 + h] * LOG2E : -1e30f;
                const float mn = fmaxf(mw[h], wave_max(s)); const float p = valid ? exp2f(s - mn) : 0.f; s2[h * 64 + lane] = p;
                const float scl = exp2f(mw[h] - mn); lw[h] = lw[h] * scl + wave_sum(p); ow[h] *= scl; mw[h] = mn; }
            WFENCE();
            for (int kk = 0; kk < 64; ++kk) { const int kp = q - 64 * c - kk; if (kp < 0) break;
                const float vv = bf2f(Y[((size_t)b * S_ + kp) * YP + Y_AVW + g * 64 + lane]);
#pragma unroll
                for (int h = 0; h < 4; ++h) ow[h] += s2[h * 64 + kk] * vv; }
        }
        WFENCE();
#pragma unroll
        for (int h = 0; h < 4; ++h) { const float o = gt[h][0] * oc[h] + gt[h][1] * os[h] / fmaxf(lsel[h], 1e-20f) + gt[h][2] * ow[h] / fmaxf(lw[h], 1e-20f);
            Yr[Y_AQ + (g * 4 + h) * 64 + lane] = (bf16)f2bf(o); }
    }
}
__device__ __forceinline__ void moba_naive(Frame& F, const Args& a) {
    const int gw = blockIdx.x * NWAVES + F.wave, NGW = F.G * NWAVES, lane = F.lane;
    bf16* Y = (bf16*)(a.ws + WS_Y); const float* rel = a.in[1]; const float* KM = (const float*)(a.ws + WS_KMEAN);
    LAS float* scr = (LAS float*)(F.lds + RING_OFF + F.wave * 16384);
    LAS float* qs = scr; LAS float* s2 = scr + 64;
    for (int task = gw; task < 32 * S_; task += NGW) {
        const int q = task & (S_ - 1), bh = task >> 13, h = bh & 7, b = bh >> 3;
        const size_t row = (size_t)b * S_ + q; bf16* Yr = Y + row * YP;
        WFENCE();
        qs[lane] = bf2f(Yr[Y_CQ + h * 64 + lane]);
        WFENCE();
        const int cur = q >> 8;
        float gs = -1e30f;
        if (lane < 32 && lane < cur) { const float* km = KM + ((size_t)bh * 32 + lane) * 64; float d = 0.f;
            for (int dd = 0; dd < 64; ++dd) d += qs[dd] * km[dd];
            gs = d; }
        if (lane >= 32) gs = -INFINITY;
        bool sel = false;
        for (int it = 0; it < 3; ++it) { const float c = sel ? -INFINITY : gs; const float mxv = wave_max(c);
            const unsigned long long m0 = __ballot(!sel && lane < 32 && gs == mxv); const int idx = m0 ? __builtin_ctzll(m0) : -1; if (lane == idx) sel = true; }
        sel = sel && (lane < cur);
        const unsigned smask = (unsigned)__ballot(sel);
        float mr = -1e30f, lr = 0.f, o = 0.f;
        for (int j = 0; j <= cur; ++j) {
            const bool own = (j == cur);
            if (!own && !((smask >> j) & 1u)) continue;
            for (int c = 0; c < 4; ++c) {
                const int kpos = 256 * j + 64 * c + lane; const bool valid = kpos <= q;
                if (256 * j + 64 * c > q) break;
                const float d = dot1(qs, Y + ((size_t)b * S_ + kpos) * YP + Y_CK + h * 64);
                const int bk = t5_bucket(q - kpos);
                const float s = valid ? d + rel[bk * 16 + 8 + h] * LOG2E : -1e30f;
                const float mn = fmaxf(mr, wave_max(s)); const float p = valid ? exp2f(s - mn) : 0.f;
                WFENCE(); s2[lane] = p; WFENCE();
                const float scl = exp2f(mr - mn); lr = lr * scl + wave_sum(p); o *= scl; mr = mn;
                const bf16* vb = Y + ((size_t)b * S_ + 256 * j + 64 * c) * YP + Y_CV + h * 64 + lane;
                for (int kk = 0; kk < 64; ++kk) o += s2[kk] * bf2f(vb[(size_t)kk * YP]);
            }
        }
        Yr[Y_CQ + h * 64 + lane] = (bf16)f2bf(o / fmaxf(lr, 1e-20f));
    }
}
constexpr int CW_Q = 8192;
__device__ __forceinline__ int next_unit(Frame& F, int k) {
    __syncthreads();
    if (F.tid == 0) F.MISC[16] = __hip_atomic_fetch_add(F.ctl + CW_Q + 64 * k, 1u, RLX_AGENT);
    __syncthreads();
    return (int)F.MISC[16];
}
__device__ __forceinline__ void moba_fast(Frame& F, const Args& a, int qk) {
    bf16* Y = (bf16*)(a.ws + WS_Y); const float* KM = (const float*)(a.ws + WS_KMEAN);
    for (;;) {
        const int u = next_unit(F, qk); if (u >= 1024) break;
        const int qb = 31 - (u >> 5), bh = u & 31, b = bh >> 3, h = bh & 7; const long rowbase = (long)b * S_;
        attn::UArgs U{};
        U.Qb = Y + (rowbase + qb * 256) * YP + Y_CQ + h * 64; U.Kh = Y + rowbase * YP + Y_CK + h * 64; U.Vh = Y + rowbase * YP + Y_CV + h * 64; U.Ob = Y + (rowbase + qb * 256) * YP + Y_CQ + h * 64;
        U.NT = 4 * (qb + 1); U.q0 = qb * 256; U.kt0 = 0; U.hc = 8 + h; U.rel = a.in[1]; U.km = KM + (size_t)bh * 32 * 64; U.qb = qb;
        attn::attn_unit<0, 0, 8>(U, (char*)F.lds + RING_OFF);
    }
}
__device__ __forceinline__ void nsa_fast(Frame& F, const Args& a, int qk) {
    bf16* Y = (bf16*)(a.ws + WS_Y);
    for (;;) {
        const int u = next_unit(F, qk); if (u >= 1024) break;
        const int qb = 31 - (u >> 5), bh = u & 31, b = bh >> 3, h = bh & 7, g = h >> 2; const long rowbase = (long)b * S_; const int q0 = qb * 256;
        attn::UArgs U{};
        U.Qb = Y + (rowbase + q0) * YP + Y_AQ + h * 64; U.Ob = Y + (rowbase + q0) * YP + Y_AQ + h * 64; U.q0 = q0; U.hc = h; U.rel = a.in[1]; U.gate = Y + (rowbase + q0) * YP;
        { const int T0 = 4 * qb - 8 > 0 ? 4 * qb - 8 : 0;
          U.Kh = Y + (rowbase + 64 * T0) * YP + Y_AKW + g * 64; U.Vh = Y + (rowbase + 64 * T0) * YP + Y_AVW + g * 64; U.NT = 4 * qb + 4 - T0; U.kt0 = 64 * T0; U.gcol = Y_AG + h * 3 + 2;
          attn::attn_unit<2, 1, 8>(U, (char*)F.lds + RING_OFF); }
        { U.Kh = Y + rowbase * YP + Y_AKS + g * 64; U.Vh = Y + rowbase * YP + Y_AVS + g * 64; U.NT = 4 * (qb + 1); U.kt0 = 0; U.gcol = Y_AG + h * 3 + 1;
          U.selg = (const unsigned*)(a.ws + WS_MASK) + ((size_t)(b * 2 + g) * S_ + q0) * 4; U.tmp = (const bf16*)(a.ws + WS_OATMP) + (rowbase + q0) * 512 + h * 64;
          attn::attn_unit<1, 2, 8>(U, (char*)F.lds + RING_OFF); }
    }
}
typedef float f32x16g __attribute__((ext_vector_type(16)));
constexpr int GP = 72;
constexpr int GL_GS = 0;
constexpr int GL_VT = 16640 + 0;
constexpr int GL_A0 = GL_VT + 128 * GP * 2;
constexpr int GL_A1 = GL_A0 + 64 * GP * 2;
constexpr int GL_A2 = GL_A1 + 64 * GP * 2;
constexpr int GL_SS = GL_A2 + 64 * GP * 2;
constexpr int GL_END = GL_SS + 1024;
static_assert(GL_END <= RING_BYTES, "GLA LDS map");
__device__ __forceinline__ int crow32(int r, int hi) { return (r & 3) + 8 * (r >> 2) + 4 * hi; }
__device__ __forceinline__ void gla_bcum(Frame& F, const Args& a, int l, const bf16* Yc  , int h) {
    LAS float* gS = (LAS float*)(F.lds + RING_OFF + GL_GS);
    const int t = F.tid >> 3, dg = F.tid & 7;
    const float* w2 = a.in[13] + (size_t)l * 16 * 256 + h * 64 + dg * 8; const float* bias = a.in[14] + (size_t)l * 256 + h * 64 + dg * 8;
    float blr[16];
    { const v4u w0 = *(const v4u*)(Yc + (size_t)t * YP + Y_BLR), w1 = *(const v4u*)(Yc + (size_t)t * YP + Y_BLR + 8); float k0[8], k1[8]; unpack8(w0, k0); unpack8(w1, k1);
#pragma unroll
      for (int i = 0; i < 8; ++i) { blr[i] = k0[i]; blr[8 + i] = k1[i]; } }
    float z[8];
#pragma unroll
    for (int i = 0; i < 8; ++i) z[i] = bias[i];
#pragma unroll
    for (int r = 0; r < 16; ++r) { const f32x4 wa = *(const f32x4*)(w2 + r * 256), wb = *(const f32x4*)(w2 + r * 256 + 4);
        z[0] += blr[r] * wa.x; z[1] += blr[r] * wa.y; z[2] += blr[r] * wa.z; z[3] += blr[r] * wa.w; z[4] += blr[r] * wb.x; z[5] += blr[r] * wb.y; z[6] += blr[r] * wb.z; z[7] += blr[r] * wb.w; }
#pragma unroll
    for (int i = 0; i < 8; ++i) { const float zz = z[i]; gS[t * 65 + dg * 8 + i] = -(fmaxf(-zz, 0.f) + log1pf(__expf(-fabsf(zz)))) * (1.f / 16.f); }
    __syncthreads();
    if (F.tid < 64) { float acc = 0.f;
#pragma unroll 8
        for (int tt = 0; tt < 64; ++tt) { acc += gS[tt * 65 + F.tid]; gS[tt * 65 + F.tid] = acc; } }
    __syncthreads();
}
__device__ __forceinline__ void gla_stage_vT(Frame& F, const bf16* Yc, int h) {
    LAS bf16* vT = (LAS bf16*)(F.lds + RING_OFF + GL_VT); const int t = F.tid >> 3, dg = F.tid & 7;
    const v4u w0 = *(const v4u*)(Yc + (size_t)t * YP + Y_BV + h * 128 + dg * 16), w1 = *(const v4u*)(Yc + (size_t)t * YP + Y_BV + h * 128 + dg * 16 + 8);
    const unsigned ww[8] = {w0.x, w0.y, w0.z, w0.w, w1.x, w1.y, w1.z, w1.w};
#pragma unroll
    for (int i = 0; i < 8; ++i) { vT[(dg * 16 + 2 * i) * GP + t] = (bf16)(ww[i] & 0xffffu); vT[(dg * 16 + 2 * i + 1) * GP + t] = (bf16)(ww[i] >> 16); }
}
__device__ __forceinline__ bf16x8 lds_frag(const LAS bf16* X, int row, int kk) { return *(const LAS bf16x8*)(X + row * GP + kk); }
__device__ __forceinline__ void gla_g1(Frame& F, const Args& a, int l) {
    const bf16* Y = (const bf16*)(a.ws + WS_Y); bf16* GST = (bf16*)(a.ws + WS_GST); float* DEC = (float*)(a.ws + WS_GDEC);
    LAS float* gS = (LAS float*)(F.lds + RING_OFF + GL_GS); LAS bf16* vT = (LAS bf16*)(F.lds + RING_OFF + GL_VT); LAS bf16* kT = (LAS bf16*)(F.lds + RING_OFF + GL_A0);
    const int lane = F.lane, r32 = lane & 31, hi = lane >> 5, w = F.wave;
    for (int u = blockIdx.x; u < 2048; u += F.G) {
        const int c = u & 127, bh = u >> 7, h = bh & 3, b = bh >> 2; const bf16* Yc = Y + ((size_t)b * S_ + c * 64) * YP;
        gla_bcum(F, a, l, Yc, h);
        { const int t = F.tid >> 3, dg = F.tid & 7; const v4u kw = *(const v4u*)(Yc + (size_t)t * YP + Y_BK + h * 64 + dg * 8); float kk[8]; unpack8(kw, kk);
#pragma unroll
          for (int i = 0; i < 8; ++i) { const int d = dg * 8 + i; kT[d * GP + t] = (bf16)f2bf(kk[i] * __expf(gS[63 * 65 + d] - gS[t * 65 + d])); }
          if (F.tid < 64) DEC[(size_t)u * 64 + F.tid] = __expf(gS[63 * 65 + F.tid]); }
        gla_stage_vT(F, Yc, h);
        __syncthreads();
        { const int et = w >> 1, dt = w & 1; f32x16g acc = {};
#pragma unroll
          for (int ks = 0; ks < 4; ++ks) acc = __builtin_amdgcn_mfma_f32_32x32x16_bf16(lds_frag(vT, et * 32 + r32, ks * 16 + hi * 8), lds_frag(kT, dt * 32 + r32, ks * 16 + hi * 8), acc, 0, 0, 0);
          bf16* slot = GST + (size_t)u * 8192;
#pragma unroll
          for (int r = 0; r < 16; ++r) slot[(et * 32 + crow32(r, hi)) * 64 + dt * 32 + r32] = (bf16)f2bf(acc[r]); }
        __syncthreads();
    }
}
__device__ __forceinline__ void gla_g2(Frame& F, const Args& a) {
    unsigned* GST = (unsigned*)(a.ws + WS_GST); const float* DEC = (const float*)(a.ws + WS_GDEC);
    for (int i = blockIdx.x * 512 + F.tid; i < 16 * 128 * 32; i += F.G * 512) {
        const int dp = i & 31, bh = i >> 12; const int eo = (i >> 5) & 127;
        float s0 = 0.f, s1 = 0.f;
        for (int c0 = 0; c0 < 128; c0 += 8) {
            unsigned uu[8]; float d0[8], d1[8];
#pragma unroll
            for (int j = 0; j < 8; ++j) { const size_t sl = (size_t)(bh * 128 + c0 + j); uu[j] = GST[sl * 4096 + eo * 32 + dp]; d0[j] = DEC[sl * 64 + 2 * dp]; d1[j] = DEC[sl * 64 + 2 * dp + 1]; }
#pragma unroll
            for (int j = 0; j < 8; ++j) { const size_t sl = (size_t)(bh * 128 + c0 + j); GST[sl * 4096 + eo * 32 + dp] = pk2(s0, s1);
                s0 = s0 * d0[j] + __uint_as_float(uu[j] << 16); s1 = s1 * d1[j] + __uint_as_float(uu[j] & 0xffff0000u); }
        }
    }
}
__device__ __forceinline__ void gla_g3(Frame& F, const Args& a, int l) {
    bf16* Y = (bf16*)(a.ws + WS_Y); const bf16* GST = (const bf16*)(a.ws + WS_GST); const float* nw = a.in[15] + (size_t)l * 128;
    LAS float* gS = (LAS float*)(F.lds + RING_OFF + GL_GS); LAS bf16* vT = (LAS bf16*)(F.lds + RING_OFF + GL_VT);
    LAS bf16* qd = (LAS bf16*)(F.lds + RING_OFF + GL_A0); LAS bf16* kd = (LAS bf16*)(F.lds + RING_OFF + GL_A1); LAS bf16* at = (LAS bf16*)(F.lds + RING_OFF + GL_A2);
    LAS float* ssq = (LAS float*)(F.lds + RING_OFF + GL_SS);
    const int lane = F.lane, r32 = lane & 31, hi = lane >> 5, w = F.wave;
    for (int u = blockIdx.x; u < 2048; u += F.G) {
        const int c = u & 127, bh = u >> 7, h = bh & 3, b = bh >> 2; bf16* Yc = Y + ((size_t)b * S_ + c * 64) * YP;
        gla_bcum(F, a, l, Yc, h);
        { const int t = F.tid >> 3, dg = F.tid & 7; const v4u qw = *(const v4u*)(Yc + (size_t)t * YP + Y_BQ + h * 64 + dg * 8), kw = *(const v4u*)(Yc + (size_t)t * YP + Y_BK + h * 64 + dg * 8);
          float qq[8], kk[8]; unpack8(qw, qq); unpack8(kw, kk); v4u qo, ko; unsigned qa[4], ka[4];
#pragma unroll
          for (int i = 0; i < 4; ++i) { const float g0 = gS[t * 65 + dg * 8 + 2 * i], g1 = gS[t * 65 + dg * 8 + 2 * i + 1];
              qa[i] = pk2(qq[2 * i] * __expf(g0), qq[2 * i + 1] * __expf(g1)); ka[i] = pk2(kk[2 * i] * __expf(-g0), kk[2 * i + 1] * __expf(-g1)); }
          qo.x = qa[0]; qo.y = qa[1]; qo.z = qa[2]; qo.w = qa[3]; ko.x = ka[0]; ko.y = ka[1]; ko.z = ka[2]; ko.w = ka[3];
          *(LAS v4u*)(qd + t * GP + dg * 8) = qo; *(LAS v4u*)(kd + t * GP + dg * 8) = ko; }
        gla_stage_vT(F, Yc, h);
        __syncthreads();
        if (w < 4) { const int ib = w >> 1, jb = w & 1;
            if (jb <= ib) { f32x16g acc = {};
#pragma unroll
                for (int ks = 0; ks < 4; ++ks) acc = __builtin_amdgcn_mfma_f32_32x32x16_bf16(lds_frag(qd, ib * 32 + r32, ks * 16 + hi * 8), lds_frag(kd, jb * 32 + r32, ks * 16 + hi * 8), acc, 0, 0, 0);
#pragma unroll
                for (int r = 0; r < 16; ++r) { const int i = ib * 32 + crow32(r, hi), j = jb * 32 + r32; at[i * GP + j] = (bf16)f2bf(j <= i ? acc[r] : 0.f); } } }
        __syncthreads();
        { const int rb = w >> 2, et = w & 3; f32x16g acc = {};
          const bf16* slot = GST + (size_t)u * 8192 + (size_t)(et * 32 + r32) * 64 + hi * 8;
#pragma unroll
          for (int ks = 0; ks < 4; ++ks) { const bf16x8 sb = *(const bf16x8*)(slot + ks * 16);
              acc = __builtin_amdgcn_mfma_f32_32x32x16_bf16(lds_frag(qd, rb * 32 + r32, ks * 16 + hi * 8), sb, acc, 0, 0, 0); }
          for (int ks = 0; ks < 2 * (rb + 1); ++ks) acc = __builtin_amdgcn_mfma_f32_32x32x16_bf16(lds_frag(at, rb * 32 + r32, ks * 16 + hi * 8), lds_frag(vT, et * 32 + r32, ks * 16 + hi * 8), acc, 0, 0, 0);
          float sq[16];
#pragma unroll
          for (int r = 0; r < 16; ++r) { float v = acc[r] * acc[r];
              v += __shfl_xor(v, 1); v += __shfl_xor(v, 2); v += __shfl_xor(v, 4); v += __shfl_xor(v, 8); v += __shfl_xor(v, 16); sq[r] = v; }
          if (r32 == 0) {
#pragma unroll
              for (int r = 0; r < 16; ++r) ssq[w * 32 + crow32(r, hi)] = sq[r]; }
          __syncthreads();
          const float nwe = nw[et * 32 + r32];
#pragma unroll
          for (int r = 0; r < 16; ++r) { const int tr = crow32(r, hi); const float tot = ssq[(rb * 4 + 0) * 32 + tr] + ssq[(rb * 4 + 1) * 32 + tr] + ssq[(rb * 4 + 2) * 32 + tr] + ssq[(rb * 4 + 3) * 32 + tr];
              bf16* yp = Yc + (size_t)(rb * 32 + tr) * YP + Y_BR + h * 128 + et * 32 + r32; const float rv = bf2f(*yp);
              *yp = (bf16)f2bf(acc[r] * rsqrtf(tot * (1.f / 128.f) + NORM_EPS) * nwe * (rv * sigm(rv))); } }
        __syncthreads();
    }
}
constexpr int CL_IMP = 0, CL_BIAS = 64 * 129 * 4, CL_END = CL_BIAS + 2048;
__device__ __forceinline__ int red8(int v) { v += __shfl_xor(v, 1); v += __shfl_xor(v, 2); v += __shfl_xor(v, 4); return v; }
__device__ __forceinline__ void nsa_cmp_fast(Frame& F, const Args& a, int qk) {
    const bf16* Y = (const bf16*)(a.ws + WS_Y); const float* rel = a.in[1];
    LAS unsigned* impI = (LAS unsigned*)(F.lds + RING_OFF + CL_IMP); LAS float* biasT = (LAS float*)(F.lds + RING_OFF + CL_BIAS);
    const int lane = F.lane, r32 = lane & 31, hi = lane >> 5, w = F.wave, hr = w >> 1, qh = w & 1;
    for (;;) {
        const int u = next_unit(F, qk); if (u >= 1024) break;
        const int c = 127 - (u >> 3), bg = u & 7, g = bg & 1, b = bg >> 1, q0 = 64 * c; const size_t rowbase = (size_t)b * S_;
        for (int i = F.tid; i < 64 * 129; i += 512) impI[i] = 0u;
        { const int hh = F.tid >> 7, dd = F.tid & 127; biasT[F.tid] = (rel[t5_bucket(dd) * 16 + g * 4 + hh] - rel[31 * 16 + g * 4 + hh]) * LOG2E; }
        __syncthreads();
        const int head = g * 4 + hr, qw0 = q0 + qh * 32, qpos = qw0 + r32;
        const bf16* Qw = Y + (rowbase + qw0) * YP + Y_AQ + head * 64;
        bf16x8 qr[4];
#pragma unroll
        for (int ks = 0; ks < 4; ++ks) qr[ks] = *(const bf16x8*)(Qw + (size_t)r32 * YP + ks * 16 + hi * 8);
        const bf16* KC = (const bf16*)(a.ws + WS_KCMP) + (size_t)bg * 512 * 64; const bf16* VT = (const bf16*)(a.ws + WS_VCMPT) + (size_t)bg * 64 * 512;
        const int NTw = (qw0 / 16 + 1 + 31) >> 5;
        const LAS float* bT = biasT + hr * 128;
        float lsum = 0.f;
        for (int nt = 0; nt < NTw; ++nt) { f32x16g C = {};
#pragma unroll
            for (int ks = 0; ks < 4; ++ks) { const bf16x8 kf = *(const bf16x8*)(KC + (size_t)(nt * 32 + r32) * 64 + ks * 16 + hi * 8); C = __builtin_amdgcn_mfma_f32_32x32x16_bf16(kf, qr[ks], C, 0, 0, 0); }
#pragma unroll
            for (int r = 0; r < 16; ++r) { const int dist = qpos - (16 * (nt * 32 + crow32(r, hi)) + 31); lsum += dist >= 0 ? exp2f(fminf(C[r] + bT[dist > 127 ? 127 : (dist < 0 ? 0 : dist)], 100.f)) : 0.f; } }
        { auto rr = __builtin_amdgcn_permlane32_swap(__float_as_uint(lsum), __float_as_uint(lsum), false, false); lsum = __uint_as_float(rr[0]) + __uint_as_float(rr[1]); }
        const float inv = 1.f / fmaxf(lsum, 1e-30f);
        f32x16g o0 = {}, o1 = {};
        for (int nt = 0; nt < NTw; ++nt) { f32x16g C = {};
#pragma unroll
            for (int ks = 0; ks < 4; ++ks) { const bf16x8 kf = *(const bf16x8*)(KC + (size_t)(nt * 32 + r32) * 64 + ks * 16 + hi * 8); C = __builtin_amdgcn_mfma_f32_32x32x16_bf16(kf, qr[ks], C, 0, 0, 0); }
            float p[16];
#pragma unroll
            for (int r = 0; r < 16; ++r) { const int dist = qpos - (16 * (nt * 32 + crow32(r, hi)) + 31); p[r] = dist >= 0 ? exp2f(fminf(C[r] + bT[dist > 127 ? 127 : (dist < 0 ? 0 : dist)], 100.f)) * inv : 0.f; }
#pragma unroll
            for (int m = 0; m < 4; ++m) { const float G = (p[4 * m] + p[4 * m + 1]) + (p[4 * m + 2] + p[4 * m + 3]); const int j = nt * 8 + 2 * m + hi;
                LAS unsigned* ip = impI + (qh * 32 + r32) * 129 + j;
                __hip_atomic_fetch_add(ip, (unsigned)(G * 67108864.f + 0.5f), __ATOMIC_RELAXED, __HIP_MEMORY_SCOPE_WORKGROUP);
                if (j + 1 < 128) __hip_atomic_fetch_add(ip + 1, (unsigned)(p[4 * m + 3] * 67108864.f + 0.5f), __ATOMIC_RELAXED, __HIP_MEMORY_SCOPE_WORKGROUP); }
            v4u pw0, pw1; pw0.x = pk2(p[0], p[1]); pw0.y = pk2(p[2], p[3]); pw0.z = pk2(p[4], p[5]); pw0.w = pk2(p[6], p[7]); pw1.x = pk2(p[8], p[9]); pw1.y = pk2(p[10], p[11]); pw1.z = pk2(p[12], p[13]); pw1.w = pk2(p[14], p[15]);
            const bf16x8 pa0 = __builtin_bit_cast(bf16x8, pw0), pa1 = __builtin_bit_cast(bf16x8, pw1);
            typedef unsigned u32x2g __attribute__((ext_vector_type(2)));
#pragma unroll
            for (int dt = 0; dt < 2; ++dt)
#pragma unroll
                for (int kk = 0; kk < 2; ++kk) { const bf16* vp = VT + (size_t)(dt * 32 + r32) * 512 + nt * 32 + kk * 16 + 4 * hi;
                    const u32x2g va = *(const u32x2g*)vp, vb = *(const u32x2g*)(vp + 8); v4u vv; vv.x = va.x; vv.y = va.y; vv.z = vb.x; vv.w = vb.y;
                    if (dt == 0) o0 = __builtin_amdgcn_mfma_f32_32x32x16_bf16(kk ? pa1 : pa0, __builtin_bit_cast(bf16x8, vv), o0, 0, 0, 0);
                    else o1 = __builtin_amdgcn_mfma_f32_32x32x16_bf16(kk ? pa1 : pa0, __builtin_bit_cast(bf16x8, vv), o1, 0, 0, 0); } }
        { bf16* T = (bf16*)(a.ws + WS_OATMP);
#pragma unroll
          for (int r = 0; r < 16; ++r) { const size_t row = rowbase + qw0 + crow32(r, hi); const float gs = sigm(bf2f(Y[row * YP + Y_AG + head * 3]));
              T[row * 512 + head * 64 + r32] = (bf16)f2bf(gs * o0[r]); T[row * 512 + head * 64 + 32 + r32] = (bf16)f2bf(gs * o1[r]); } }
        __syncthreads();
        { const int qi = F.tid >> 3, part = F.tid & 7, cur = c; unsigned key[16];
#pragma unroll
          for (int i = 0; i < 16; ++i) { const int j = part * 16 + i; const unsigned raw = impI[qi * 129 + j] >> 6; const bool forced = (j == 0) || (j == cur) || (j == cur - 1);
              key[i] = forced ? (0xFFFFFF80u | (unsigned)(127 - j)) : (j <= cur ? ((((raw > 33554430u ? 33554430u : raw) + 1u) << 7) | (unsigned)(127 - j)) : (unsigned)(127 - j)); }
          unsigned T = 0u;
          for (int bit = 31; bit >= 0; --bit) { const unsigned Tt = T | (1u << bit); int cnt = 0;
#pragma unroll
              for (int i = 0; i < 16; ++i) cnt += key[i] >= Tt ? 1 : 0;
              cnt = red8(cnt); if (cnt >= 16) T = Tt; }
          unsigned bits = 0u;
#pragma unroll
          for (int i = 0; i < 16; ++i) bits |= (key[i] >= T && (part * 16 + i) <= cur) ? (1u << i) : 0u;
          ((unsigned short*)(a.ws + WS_MASK))[((size_t)bg * S_ + q0 + qi) * 8 + part] = (unsigned short)bits; }
    }
}
__device__ __forceinline__ void gla_out_naive(Frame& F, const Args& a, int l) {
    const int gw = blockIdx.x * NWAVES + F.wave, NGW = F.G * NWAVES, lane = F.lane;
    bf16* Y = (bf16*)(a.ws + WS_Y); const bf16* O16 = (const bf16*)(a.ws + WS_O16); const float* nw = a.in[15] + (size_t)l * 128;
    for (int t = gw; t < M_ * 4; t += NGW) {
        const int h = t & 3; const size_t row = (size_t)(t >> 2);
        const float o0 = bf2f(O16[row * 512 + h * 128 + lane]), o1 = bf2f(O16[row * 512 + h * 128 + 64 + lane]);
        const float r = rsqrtf(wave_sum(o0 * o0 + o1 * o1) * (1.f / 128.f) + NORM_EPS);
        bf16* yr = Y + row * YP + Y_BR + h * 128;
        const float r0 = bf2f(yr[lane]), r1 = bf2f(yr[64 + lane]);
        yr[lane] = (bf16)f2bf(o0 * r * nw[lane] * (r0 * sigm(r0))); yr[64 + lane] = (bf16)f2bf(o1 * r * nw[64 + lane] * (r1 * sigm(r1)));
    }
}

constexpr int PPL = 11, NPH = NL * PPL;
#define IN(k) (lo <= (k) && (k) < hi)
#define SEAM(k) do { if (IN(k) && IN((k) + 1)) xcd_barrier(bar); } while (0)
template <int l> __device__ __forceinline__ void layer_body(Frame& F, const Args& args, const XcdBarrier& bar, const int lo, const int hi) {
    unsigned char* ws = args.ws;
    bf16* H = (bf16*)(ws + WS_H); bf16* Y = (bf16*)(ws + WS_Y); unsigned char* G8 = ws + WS_G8;
    float* Yf = (float*)(ws + WS_Y); bf16* ACT = (bf16*)(ws + WS_ACT);
    constexpr int p0 = l * PPL;
    const float* xin = l == 0 ? args.in[0] : args.out;
    if (IN(p0 + 0)) { phase_weights(F, args, l); if (l == 0) phase_norm0(F, args.in[0], args.in[2], H); SEAM(p0 + 0); }
    if (IN(p0 + 1)) {
        pg8::Gemm g{H, (const bf16*)(ws + WS_WIN), M_, NIN, DM, DM}; pg8::StaticOrder So; So.init(M_, NIN, F.G, (int)blockIdx.x);
        pg8::EpiInProj E{Y, G8};
        pg8::gemm_phase<pg8::EpiInProj, pg8::StaticOrder, true, true>(F.lds + RING_OFF, g, So, E);
        SEAM(p0 + 1);
    }
    if (IN(p0 + 2)) { phase2_naive(F, args, l); gla_g1(F, args, l); SEAM(p0 + 2); }
    if (IN(p0 + 3)) { gla_g2(F, args); nsa_cmp_fast(F, args, l * 4 + 2); moba_fast(F, args, l * 4 + 0); SEAM(p0 + 3); }
    if (IN(p0 + 4)) { nsa_fast(F, args, l * 4 + 1); gla_g3(F, args, l); SEAM(p0 + 4); }
    if (IN(p0 + 5)) {
        pg8::StaticOrder So; So.init(M_, DM, F.G, (int)blockIdx.x);
        { pg8::Gemm g{Y + Y_AQ, (const bf16*)(ws + WS_WA), M_, DM, 512, YP}; pg8::EpiMerge<0> E{H, G8}; pg8::gemm_phase<pg8::EpiMerge<0>, pg8::StaticOrder, true, true>(F.lds + RING_OFF, g, So, E); }
        __syncthreads();
        { pg8::Gemm g{Y + Y_BR, (const bf16*)(ws + WS_WB), M_, DM, 512, YP}; pg8::EpiMerge<1> E{H, G8}; pg8::gemm_phase<pg8::EpiMerge<1>, pg8::StaticOrder, true, true>(F.lds + RING_OFF, g, So, E); }
        __syncthreads();
        { pg8::Gemm g{Y + Y_CQ, (const bf16*)(ws + WS_WC), M_, DM, 512, YP}; pg8::EpiMerge<2> E{H, G8}; pg8::gemm_phase<pg8::EpiMerge<2>, pg8::StaticOrder, true, true>(F.lds + RING_OFF, g, So, E); }
        SEAM(p0 + 5);
    }
    if (IN(p0 + 6)) {
        pg8::Gemm g{H, (const bf16*)(ws + WS_WO), M_, DM, DM, DM}; pg8::StaticOrder So; So.init(M_, DM, F.G, (int)blockIdx.x);
        pg8::EpiF32 E{Yf, DM}; pg8::gemm_phase<pg8::EpiF32, pg8::StaticOrder, true, true>(F.lds + RING_OFF, g, So, E);
        SEAM(p0 + 6);
    }
    if (IN(p0 + 7)) { phase_resid(F, Yf, xin, args.out, args.in[3] + (size_t)l * DM, args.in[4] + (size_t)l * DM, H); SEAM(p0 + 7); }
    if (IN(p0 + 8)) {
        pg8::Gemm g{H, (const bf16*)(ws + WS_WF1), M_, 2 * FF, DM, DM}; pg8::StaticOrder So; So.init(M_, 2 * FF, F.G, (int)blockIdx.x);
        pg8::EpiSwiglu E{ACT, FF}; pg8::gemm_phase<pg8::EpiSwiglu, pg8::StaticOrder, true, true>(F.lds + RING_OFF, g, So, E);
        SEAM(p0 + 8);
    }
    if (IN(p0 + 9)) {
        pg8::Gemm g{ACT, (const bf16*)(ws + WS_WF2), M_, DM, FF, FF}; pg8::StaticOrder So; So.init(M_, DM, F.G, (int)blockIdx.x);
        pg8::EpiF32 E{Yf, DM}; pg8::gemm_phase<pg8::EpiF32, pg8::StaticOrder, true, true>(F.lds + RING_OFF, g, So, E);
        SEAM(p0 + 9);
    }
    if (IN(p0 + 10)) { phase_resid(F, Yf, args.out, args.out, args.in[5] + (size_t)l * DM, l + 1 < NL ? args.in[2] + (size_t)(l + 1) * DM : nullptr, l + 1 < NL ? H : nullptr); SEAM(p0 + 10); }
}
__global__ void __launch_bounds__(NWAVES * 64, 2) mk_fwd(Args args) {
    extern __shared__ __attribute__((aligned(16))) unsigned char lds[];
    Frame F;
    F.lds = (LAS unsigned char*)lds; F.MISC = (volatile LAS unsigned*)(F.lds + MISC_OFF);
    F.tid = threadIdx.x; F.lane = F.tid & 63; F.wave = __builtin_amdgcn_readfirstlane(F.tid >> 6); F.G = gridDim.x;
    F.ctl = (gu32*)(args.ws + WS_CTL);
    for (int u = F.tid; u < (LDS_BYTES - LDSCTL_OFF) / 4; u += NWAVES * 64) ((LAS unsigned*)(F.lds + LDSCTL_OFF))[u] = 0u;
    __syncthreads();
    const int lo = args.ph_lo, hi = args.ph_hi;
    XcdBarrier bar; bar.bar = (unsigned*)(F.ctl + CW_BAR); bar.x = 0; bar.st = nullptr;
    if (hi - lo > 1) bar = xcd_barrier_post((unsigned*)(F.ctl + CW_BAR), F.MISC + 8);
    layer_body<0>(F, args, bar, lo, hi);
    layer_body<1>(F, args, bar, lo, hi);
}
#undef IN
#undef SEAM

#ifndef MK_ONE_LAUNCH
#define MK_ONE_LAUNCH 1
#endif
extern "C" void kernel_launch(void* const* d_in, const int* in_sizes, int n_in, void* d_out, int out_size, void* d_ws, size_t ws_size, hipStream_t stream) {
    static int grid = 0;
    if (grid == 0) {
        if (n_in != 22 || out_size != M_ * DM || ws_size < WS_END) { fprintf(stderr, "kernel_launch: unexpected sizes (n_in %d out %d ws %zu)\n", n_in, out_size, ws_size); grid = -1; return; }
        int dev = 0, cus = 0;
        if (hipGetDevice(&dev) != hipSuccess || hipDeviceGetAttribute(&cus, hipDeviceAttributeMultiprocessorCount, dev) != hipSuccess) { grid = -1; return; }
        if (hipFuncSetAttribute((const void*)mk_fwd, hipFuncAttributeMaxDynamicSharedMemorySize, LDS_BYTES) != hipSuccess) { grid = -1; return; }
        (void)hipGetLastError();
        grid = cus;
    }
    if (grid < 0) return;
    if (hipMemsetAsync((char*)d_ws + WS_CTL, 0, CTL_ZERO_BYTES, stream) != hipSuccess) return;
    Args a{};
    for (int i = 0; i < 22; ++i) a.in[i] = (const float*)d_in[i];
    a.out = (float*)d_out; a.ws = (unsigned char*)d_ws;
#if MK_ONE_LAUNCH
    a.ph_lo = 0; a.ph_hi = NPH;
    hipLaunchKernelGGL(mk_fwd, dim3(grid), dim3(NWAVES * 64), LDS_BYTES, stream, a);
#else
    for (int p = 0; p < NPH; ++p) { a.ph_lo = p; a.ph_hi = p + 1; hipLaunchKernelGGL(mk_fwd, dim3(grid), dim3(NWAVES * 64), LDS_BYTES, stream, a); }
#endif
}
```

```cpp
#include <hip/hip_runtime.h>
#include <cstdio>
#include <cstdint>
#include <cmath>
namespace pg8 {
#define PG8_LAS __attribute__((address_space(3)))
typedef unsigned short bf16_t;
typedef short bf16x8 __attribute__((ext_vector_type(8)));
typedef float f32x4 __attribute__((ext_vector_type(4)));
typedef unsigned u32x4 __attribute__((ext_vector_type(4)));
constexpr int BM = 256, BK = 64, HALF = 128, HTB = HALF * BK * 2  , STAGE_BYTES = 8 * HTB, NXCD = 8, WGM = 8;

__host__ __device__ __forceinline__ int lds_byte(int r, int c) { const int st = (r >> 4) * 2 + (c >> 5), rr = r & 15, cc = c & 31, ob = rr * 64 + cc * 2; return st * 1024 + (ob ^ (((ob >> 9) & 1) << 5)); }
__host__ __device__ __forceinline__ void stage_rc(int b, int& R, int& C) { const int st = b / 1024, sb = b % 1024, swz = sb ^ (((sb >> 9) & 1) << 5); R = (st >> 1) * 16 + swz / 64; C = (st & 1) * 32 + (swz % 64) / 2; }
__host__ __device__ __forceinline__ int perm32(int rho) { const int n = rho >> 4, i = rho & 15; return 8 * (i >> 2) + 4 * n + (i & 3); }

struct Unit { int pm, pn; };
struct Gemm { const bf16_t* A; const bf16_t* Bt; int M, N, K, lda; };

struct StaticOrder {
    int nM, nN, nwg, G, c;
    __host__ __device__ void init(int M, int N, int G_, int c_) { nM = M / BM; nN = N / BM; nwg = nM * nN; G = G_; c = c_; }
    __host__ __device__ bool next(int i, Unit& u) const {
        const long L = (long)i * G + c; if (L >= nwg) return false;
        int wgid = (int)L; { const int q = nwg / NXCD, r = nwg % NXCD, xcd = wgid % NXCD, off = wgid / NXCD; wgid = (xcd < r ? xcd * (q + 1) : r * (q + 1) + (xcd - r) * q) + off; }
        const int nig = WGM * nN, gid = wgid / nig, fm = gid * WGM, gsz = (nM - fm) < WGM ? (nM - fm) : WGM;
        u.pm = fm + ((wgid % nig) % gsz); u.pn = (wgid % nig) / gsz; return true;
    }
    __device__ __forceinline__ void a_ready(const Unit&) const {}
    __device__ __forceinline__ void done(const Unit&) const {}
};

__device__ __forceinline__ unsigned cvt_pk_bf16(float lo, float hi) { unsigned r; asm volatile("v_cvt_pk_bf16_f32 %0, %1, %2" : "=v"(r) : "v"(lo), "v"(hi)); return r; }
typedef float f32x2 __attribute__((ext_vector_type(2)));
constexpr int YP_ = 4392;
constexpr float C2_ = 0.125f * 1.4426950408889634f;
__device__ __forceinline__ float sigmoidf_(float v) { return 1.f / (1.f + __expf(-v)); }
struct EpiInProj {
    static constexpr bool PERM = true, AFTER_DRAIN = false;
    bf16_t* Y; unsigned char* G8;
    __device__ __forceinline__ void operator()(const f32x4 (&acc)[2][2][4][2], const Unit& u, int wr, int wc, int fr, int fq) const {
        const int row0 = u.pm * BM + wr * 64 + fr, colt = u.pn * BM, cin = wc * 32 + 8 * fq;
        if (u.pn < 18) {
            float sc = 1.f; if (u.pn < 2 || u.pn == 5 || u.pn == 6) sc = C2_; else if (u.pn == 11) sc = 0.125f;
#pragma unroll
            for (int ai = 0; ai < 2; ++ai)
#pragma unroll
                for (int m = 0; m < 4; ++m) { bf16_t* rowp = Y + (size_t)(row0 + ai * HALF + m * 16) * YP_;
#pragma unroll
                    for (int bj = 0; bj < 2; ++bj) { const int col = colt + cin + bj * HALF;
                        if (col + 8 <= YP_) { const f32x4 v0 = acc[ai][bj][m][0] * sc, v1 = acc[ai][bj][m][1] * sc; u32x4 w;
                            w.x = cvt_pk_bf16(v0[0], v0[1]); w.y = cvt_pk_bf16(v0[2], v0[3]); w.z = cvt_pk_bf16(v1[0], v1[1]); w.w = cvt_pk_bf16(v1[2], v1[3]);
                            *(u32x4*)(rowp + col) = w; } } }
        } else {
#pragma unroll
            for (int ai = 0; ai < 2; ++ai)
#pragma unroll
                for (int m = 0; m < 4; ++m) { unsigned char* rowp = G8 + (size_t)(row0 + ai * HALF + m * 16) * 3072 + (colt - 4608) + cin;
#pragma unroll
                    for (int bj = 0; bj < 2; ++bj) { const f32x4 v0 = acc[ai][bj][m][0], v1 = acc[ai][bj][m][1]; unsigned lo = 0u, hi = 0u;
#pragma unroll
                        for (int e = 0; e < 4; ++e) { lo |= (unsigned)(sigmoidf_(v0[e]) * 255.f + 0.5f) << (8 * e); hi |= (unsigned)(sigmoidf_(v1[e]) * 255.f + 0.5f) << (8 * e); }
                        typedef unsigned u32x2 __attribute__((ext_vector_type(2))); u32x2 w; w.x = lo; w.y = hi; *(u32x2*)(rowp + bj * HALF) = w; } }
        }
    }
};
template <int I> struct EpiMerge {
    static constexpr bool PERM = true, AFTER_DRAIN = false;
    bf16_t* Mg; const unsigned char* G8;
    __device__ __forceinline__ void operator()(const f32x4 (&acc)[2][2][4][2], const Unit& u, int wr, int wc, int fr, int fq) const {
        const int row0 = u.pm * BM + wr * 64 + fr, col0 = u.pn * BM + wc * 32 + 8 * fq;
#pragma unroll
        for (int ai = 0; ai < 2; ++ai)
#pragma unroll
            for (int m = 0; m < 4; ++m) { const size_t row = (size_t)(row0 + ai * HALF + m * 16);
#pragma unroll
                for (int bj = 0; bj < 2; ++bj) { const int col = col0 + bj * HALF;
                    typedef unsigned u32x2 __attribute__((ext_vector_type(2)));
                    const u32x2 gw = *(const u32x2*)(G8 + row * 3072 + I * 1024 + col);
                    float v[8];
#pragma unroll
                    for (int e = 0; e < 4; ++e) { v[e] = acc[ai][bj][m][0][e] * ((float)((gw.x >> (8 * e)) & 255u) * (1.f / 255.f)); v[4 + e] = acc[ai][bj][m][1][e] * ((float)((gw.y >> (8 * e)) & 255u) * (1.f / 255.f)); }
                    bf16_t* p = Mg + row * 1024 + col;
                    if (I > 0) { const u32x4 o = *(const u32x4*)p;
                        v[0] += __uint_as_float(o.x << 16); v[1] += __uint_as_float(o.x & 0xffff0000u); v[2] += __uint_as_float(o.y << 16); v[3] += __uint_as_float(o.y & 0xffff0000u);
                        v[4] += __uint_as_float(o.z << 16); v[5] += __uint_as_float(o.z & 0xffff0000u); v[6] += __uint_as_float(o.w << 16); v[7] += __uint_as_float(o.w & 0xffff0000u); }
                    u32x4 w; w.x = cvt_pk_bf16(v[0], v[1]); w.y = cvt_pk_bf16(v[2], v[3]); w.z = cvt_pk_bf16(v[4], v[5]); w.w = cvt_pk_bf16(v[6], v[7]);
                    *(u32x4*)p = w; } }
    }
};
struct EpiF32 {
    static constexpr bool PERM = true, AFTER_DRAIN = false;
    float* O; int ldc;
    __device__ __forceinline__ void operator()(const f32x4 (&acc)[2][2][4][2], const Unit& u, int wr, int wc, int fr, int fq) const {
        const int row0 = u.pm * BM + wr * 64 + fr, col0 = u.pn * BM + wc * 32 + 8 * fq;
#pragma unroll
        for (int ai = 0; ai < 2; ++ai)
#pragma unroll
            for (int m = 0; m < 4; ++m) { float* rowp = O + (size_t)(row0 + ai * HALF + m * 16) * ldc + col0;
#pragma unroll
                for (int bj = 0; bj < 2; ++bj) { *(f32x4*)(rowp + bj * HALF) = acc[ai][bj][m][0]; *(f32x4*)(rowp + bj * HALF + 4) = acc[ai][bj][m][1]; } }
    }
};
struct EpiSwiglu {
    static constexpr bool PERM = true, AFTER_DRAIN = false;
    bf16_t* Act; int ldc;
    __device__ __forceinline__ void operator()(const f32x4 (&acc)[2][2][4][2], const Unit& u, int wr, int wc, int fr, int fq) const {
        const int row0 = u.pm * BM + wr * 64 + fr, col0 = u.pn * HALF + wc * 32 + 8 * fq;
#pragma unroll
        for (int ai = 0; ai < 2; ++ai)
#pragma unroll
            for (int m = 0; m < 4; ++m) { bf16_t* p = Act + (size_t)(row0 + ai * HALF + m * 16) * ldc + col0; float v[8];
#pragma unroll
                for (int e = 0; e < 4; ++e) { const float g0 = acc[ai][0][m][0][e], g1 = acc[ai][0][m][1][e];
                    v[e] = g0 * sigmoidf_(g0) * acc[ai][1][m][0][e]; v[4 + e] = g1 * sigmoidf_(g1) * acc[ai][1][m][1][e]; }
                u32x4 w; w.x = cvt_pk_bf16(v[0], v[1]); w.y = cvt_pk_bf16(v[2], v[3]); w.z = cvt_pk_bf16(v[4], v[5]); w.w = cvt_pk_bf16(v[6], v[7]);
                *(u32x4*)p = w; }
    }
};
template <class Epi, class Sched, bool ALIGN_EPI = false, bool SP2 = false>
__device__ __forceinline__ void gemm_phase(PG8_LAS unsigned char* lds, const Gemm g, const Sched& S, const Epi& E) {
    const int tid = threadIdx.x, wid = __builtin_amdgcn_readfirstlane(tid >> 6), lane = tid & 63, wr = wid >> 2, wc = wid & 3, fr = lane & 15, fq = lane >> 4;
    const int K = g.K, nt = K / BK;
    unsigned voffA[2], voffB[2];
#pragma unroll
    for (int i = 0; i < 2; ++i) { int R, C; stage_rc(tid * 16 + i * 8192, R, C); const int Rb = Epi::PERM ? ((R & ~31) + perm32(R & 31)) : R;
        voffA[i] = (unsigned)(R * g.lda + C) * 2u; voffB[i] = (unsigned)(Rb * K + C) * 2u; }
    const size_t kstep = (size_t)(BK * 2);
    const size_t hstepB = (size_t)HALF * K * 2, hstepA = (size_t)HALF * g.lda * 2;
    const size_t tstepA = 2 * hstepA, tstepB = 2 * hstepB;
    const unsigned ldsw = (unsigned)wid * 1024u;
    const int aoff = lds_byte(wr * 64 + fr, fq * 8), boff = lds_byte(wc * 32 + fr, fq * 8);
#define PG8_SA(b, h) (((b) * 2 + (h)) * HTB)
#define PG8_SB(b, h) ((4 + (b) * 2 + (h)) * HTB)
#define PG8_STAGE(bufoff, gbase, voff) do { _Pragma("unroll") for (int _i = 0; _i < 2; ++_i) \
        __builtin_amdgcn_global_load_lds((const unsigned*)((const char*)(gbase) + (voff)[_i]), (PG8_LAS unsigned*)(lds + (bufoff) + ldsw + _i * 8192), 16, 0, 0); } while (0)
#define PG8_LDA(dst, b, h) do { _Pragma("unroll") for (int m = 0; m < 4; ++m) _Pragma("unroll") for (int k = 0; k < 2; ++k) dst[m][k] = *(const PG8_LAS bf16x8*)(lds + PG8_SA(b, h) + aoff + m * 2048 + k * 1024); } while (0)
#define PG8_LDB(dst, b, h) do { _Pragma("unroll") for (int n = 0; n < 2; ++n) _Pragma("unroll") for (int k = 0; k < 2; ++k) dst[n][k] = *(const PG8_LAS bf16x8*)(lds + PG8_SB(b, h) + boff + n * 2048 + k * 1024); } while (0)
#define PG8_MMA(ai, bj, At, Bt) do { __builtin_amdgcn_s_setprio(1); _Pragma("unroll") for (int m = 0; m < 4; ++m) _Pragma("unroll") for (int n = 0; n < 2; ++n) _Pragma("unroll") for (int k = 0; k < 2; ++k) \
        acc[ai][bj][m][n] = __builtin_amdgcn_mfma_f32_16x16x32_bf16(Bt[n][k], At[m][k], acc[ai][bj][m][n], 0, 0, 0); __builtin_amdgcn_s_setprio(0); } while (0)
#define PG8_WAIT_V(n) asm volatile("s_waitcnt vmcnt(" #n ")" ::: "memory")
#define PG8_WAIT_L(n) asm volatile("s_waitcnt lgkmcnt(" #n ")" ::: "memory")
#define PG8_BAR __builtin_amdgcn_s_barrier()
#define PG8_SCHED __builtin_amdgcn_sched_barrier(0)
    Unit cur, nxt; int ui = 0;
    if (!S.next(0, cur)) return;
    f32x4 acc[2][2][4][2];
#pragma unroll
    for (int a = 0; a < 2; ++a)
#pragma unroll
        for (int b = 0; b < 2; ++b)
#pragma unroll
            for (int m = 0; m < 4; ++m)
#pragma unroll
                for (int n = 0; n < 2; ++n) acc[a][b][m][n] = (f32x4){0.f, 0.f, 0.f, 0.f};
    bf16x8 At[4][2], B0[2][2], B1[2][2];
    const char* cA = (const char*)g.A + (size_t)cur.pm * tstepA; const char* cB = (const char*)g.Bt + (size_t)cur.pn * tstepB;
    S.a_ready(cur);
    if constexpr (SP2) {
        PG8_STAGE(PG8_SB(0, 0), cB, voffB); PG8_STAGE(PG8_SB(0, 1), cB + hstepB, voffB); PG8_STAGE(PG8_SA(0, 0), cA, voffA); PG8_STAGE(PG8_SA(0, 1), cA + hstepA, voffA);
        if (wr == 1) PG8_BAR;
        PG8_WAIT_V(2); PG8_BAR;
        PG8_STAGE(PG8_SB(1, 0), cB + kstep, voffB); PG8_STAGE(PG8_SA(1, 0), cA + kstep, voffA); PG8_STAGE(PG8_SB(1, 1), cB + hstepB + kstep, voffB);
        PG8_WAIT_V(6); PG8_BAR;
    } else {
        PG8_STAGE(PG8_SB(0, 0), cB, voffB); PG8_STAGE(PG8_SA(0, 0), cA, voffA); PG8_STAGE(PG8_SB(0, 1), cB + hstepB, voffB); PG8_STAGE(PG8_SA(0, 1), cA + hstepA, voffA);
        if (wr == 1) PG8_BAR;
        PG8_WAIT_V(4); PG8_BAR;
        PG8_STAGE(PG8_SB(1, 0), cB + kstep, voffB); PG8_STAGE(PG8_SA(1, 0), cA + kstep, voffA); PG8_STAGE(PG8_SB(1, 1), cB + hstepB + kstep, voffB);
        PG8_WAIT_V(6); PG8_BAR;
    }
    for (;;) {
        const bool has_next = S.next(ui + 1, nxt);
        const char* nA = has_next ? (const char*)g.A + (size_t)nxt.pm * tstepA : cA; const char* nB = has_next ? (const char*)g.Bt + (size_t)nxt.pn * tstepB : cB;
        for (int t = 0; t < nt; t += 2) {
            const bool last = (t == nt - 2);
            const char* a1 = cA + (size_t)(t + 1) * kstep;
            const char* a2 = last ? nA : cA + (size_t)(t + 2) * kstep; const char* b2 = last ? nB : cB + (size_t)(t + 2) * kstep;
            const char* a3 = a2 + kstep; const char* b3 = b2 + kstep;
            if (last && has_next) S.a_ready(nxt);
            if constexpr (SP2) {
            PG8_LDB(B0, 0, 0); PG8_LDB(B1, 0, 1); PG8_SCHED; PG8_LDA(At, 0, 0); PG8_STAGE(PG8_SA(1, 1), a1 + hstepA, voffA);
            PG8_WAIT_V(8); PG8_WAIT_L(0); PG8_BAR; PG8_MMA(0, 0, At, B0); PG8_MMA(0, 1, At, B1); PG8_BAR; PG8_SCHED;
            PG8_LDA(At, 0, 1); PG8_STAGE(PG8_SB(0, 0), b2, voffB); PG8_STAGE(PG8_SB(0, 1), b2 + hstepB, voffB); PG8_STAGE(PG8_SA(0, 0), a2, voffA);
            PG8_WAIT_V(8); PG8_WAIT_L(0); PG8_BAR; PG8_MMA(1, 0, At, B0); PG8_MMA(1, 1, At, B1); PG8_BAR; PG8_SCHED;
            PG8_LDB(B0, 1, 0); PG8_LDB(B1, 1, 1); PG8_SCHED; PG8_LDA(At, 1, 0); PG8_STAGE(PG8_SA(0, 1), a2 + hstepA, voffA);
            PG8_WAIT_V(8); PG8_WAIT_L(0); PG8_BAR; PG8_MMA(0, 0, At, B0); PG8_MMA(0, 1, At, B1); PG8_BAR; PG8_SCHED;
            PG8_LDA(At, 1, 1); PG8_STAGE(PG8_SB(1, 0), b3, voffB); PG8_STAGE(PG8_SB(1, 1), b3 + hstepB, voffB); PG8_STAGE(PG8_SA(1, 0), a3, voffA);
            PG8_WAIT_V(8); PG8_WAIT_L(0); PG8_BAR; PG8_MMA(1, 0, At, B0); PG8_MMA(1, 1, At, B1); PG8_BAR; PG8_SCHED;
            } else {
            PG8_LDB(B0, 0, 0); PG8_SCHED; PG8_LDA(At, 0, 0); PG8_STAGE(PG8_SA(1, 1), a1 + hstepA, voffA);
            PG8_WAIT_L(8); PG8_BAR; PG8_WAIT_L(0); PG8_MMA(0, 0, At, B0); PG8_BAR; PG8_SCHED;
            PG8_LDB(B1, 0, 1); PG8_STAGE(PG8_SB(0, 0), b2, voffB);
            PG8_BAR; PG8_WAIT_L(0); PG8_MMA(0, 1, At, B1); PG8_BAR;
            PG8_LDA(At, 0, 1); PG8_STAGE(PG8_SA(0, 0), a2, voffA);
            PG8_BAR; PG8_WAIT_L(0); PG8_MMA(1, 0, At, B0); PG8_BAR; PG8_SCHED;
            PG8_STAGE(PG8_SB(0, 1), b2 + hstepB, voffB);
            PG8_WAIT_V(6); PG8_BAR; PG8_MMA(1, 1, At, B1); PG8_BAR;
            PG8_LDB(B0, 1, 0); PG8_SCHED; PG8_LDA(At, 1, 0); PG8_STAGE(PG8_SA(0, 1), a2 + hstepA, voffA);
            PG8_WAIT_L(8); PG8_BAR; PG8_WAIT_L(0); PG8_MMA(0, 0, At, B0); PG8_BAR; PG8_SCHED;
            PG8_LDB(B1, 1, 1); PG8_STAGE(PG8_SB(1, 0), b3, voffB);
            PG8_BAR; PG8_WAIT_L(0); PG8_MMA(0, 1, At, B1); PG8_BAR;
            PG8_LDA(At, 1, 1); PG8_STAGE(PG8_SA(1, 0), a3, voffA);
            PG8_BAR; PG8_WAIT_L(0); PG8_MMA(1, 0, At, B0); PG8_BAR; PG8_SCHED;
            PG8_STAGE(PG8_SB(1, 1), b3 + hstepB, voffB);
            PG8_WAIT_V(6); PG8_BAR; PG8_MMA(1, 1, At, B1); PG8_BAR;
            }
        }
        if constexpr (ALIGN_EPI) { if (wr == 0) PG8_BAR; }
        if constexpr (!Epi::AFTER_DRAIN) { E(acc, cur, wr, wc, fr, fq); S.done(cur); }
        if (!has_next) break;
#pragma unroll
        for (int a = 0; a < 2; ++a)
#pragma unroll
            for (int b = 0; b < 2; ++b)
#pragma unroll
                for (int m = 0; m < 4; ++m)
#pragma unroll
                    for (int n = 0; n < 2; ++n) acc[a][b][m][n] = (f32x4){0.f, 0.f, 0.f, 0.f};
        cur = nxt; cA = nA; cB = nB; ++ui;
        if constexpr (ALIGN_EPI) { if (wr == 1) PG8_BAR; }
    }
    PG8_WAIT_V(0);
    if constexpr (!ALIGN_EPI) { if (wr == 0) PG8_BAR; }
    PG8_BAR;
    if constexpr (Epi::AFTER_DRAIN) { E.fused(acc, cur, wr, wc, fr, fq, lds, wid, lane); S.done(cur); }
#undef PG8_SA
#undef PG8_SB
#undef PG8_STAGE
#undef PG8_LDA
#undef PG8_LDB
#undef PG8_MMA
#undef PG8_WAIT_V
#undef PG8_WAIT_L
#undef PG8_BAR
#undef PG8_SCHED
}
}
namespace attn {
using bf16=unsigned short;
using bf16x8=__attribute__((ext_vector_type(8)))short;
using s16x4=__attribute__((ext_vector_type(4)))short;
using f32x16=__attribute__((ext_vector_type(16)))float;
using u32x4=__attribute__((ext_vector_type(4)))unsigned;
constexpr int D=64, PITCH=4392, SEQ=8192;
constexpr int NW=8,QBLK=32,QB=QBLK*NW,KVBLK=64;
__device__ __forceinline__ int crow(int r,int hi){return (r&3)+8*(r>>2)+4*hi;}
#define SBAR() __builtin_amdgcn_sched_barrier(0)
using f32x4_=__attribute__((ext_vector_type(4)))float;
__device__ __forceinline__ float bfs(short v){ return __uint_as_float(((unsigned)(unsigned short)v)<<16); }
__device__ __forceinline__ float lo16(unsigned w){ return __uint_as_float(w<<16); }
__device__ __forceinline__ float hi16(unsigned w){ return __uint_as_float(w&0xffff0000u); }
__device__ __forceinline__ bf16 f2b(float f){ unsigned u=__float_as_uint(f); return (bf16)((u+0x7fffu+((u>>16)&1u))>>16); }
__device__ __forceinline__ unsigned pk2b(float lo,float hi){ return (unsigned)f2b(lo)|((unsigned)f2b(hi)<<16); }
constexpr int NSLOT=3, SLOTB=8192;
constexpr int LDS_K=0, LDS_V=NSLOT*SLOTB, LDS_WS=2*NSLOT*SLOTB, LDS_OST=LDS_WS+NW*128*4, LDS_BIAS=LDS_OST+NW*4096, LDS_MSK=LDS_BIAS+512, LDS_KM=LDS_MSK+NW*512, LDS_BYTES=LDS_KM+8192;
constexpr float LOG2E_=1.4426950408889634f;
__device__ __forceinline__ void glds16(const void*gsrc,unsigned lds_dst){unsigned keep;
  asm volatile("s_mov_b32 %0, m0\n\ts_mov_b32 m0, %2\n\ts_nop 0\n\tglobal_load_lds_dwordx4 %1, off\n\ts_mov_b32 m0, %0":"=&s"(keep):"v"(gsrc),"s"(lds_dst):"memory");}
__device__ __forceinline__ float max3f(float a,float b,float c){float r;asm("v_max3_f32 %0, %1, %2, %3":"=v"(r):"v"(a),"v"(b),"v"(c));return r;}
__device__ __forceinline__ float max2f(float a,float b){float r;asm("v_max_f32_e32 %0, %1, %2":"=v"(r):"v"(a),"v"(b));return r;}
__device__ __forceinline__ float fadd_s(float a,float b){float r;asm("v_add_f32_e32 %0, %1, %2":"=v"(r):"v"(a),"v"(b));return r;}
__device__ __forceinline__ float fsub_s(float a,float b){float r;asm("v_sub_f32_e32 %0, %1, %2":"=v"(r):"v"(a),"v"(b));return r;}
typedef float f32x2_t __attribute__((ext_vector_type(2))); typedef __bf16 bf16x2_t __attribute__((ext_vector_type(2)));
__device__ __forceinline__ unsigned cvtpk_s(float lo,float hi){f32x2_t v={lo,hi};bf16x2_t b=__builtin_convertvector(v,bf16x2_t);return __builtin_bit_cast(unsigned,b);}
#define WAIT_BAR(N) asm volatile("s_waitcnt vmcnt(" #N ") lgkmcnt(0)\n\ts_barrier":::"memory")

__device__ __forceinline__ void qkt(f32x16&p0,f32x16&p1,const char*Kslot,const bf16x8*qr,const f32x16&negm,int r32,int hi){
  const char*kb=Kslot+hi*1024+r32*16;
  #pragma unroll
  for(int d0=0;d0<4;++d0){
    const bf16x8 b0=*reinterpret_cast<const bf16x8*>(kb+d0*2048);
    const bf16x8 b1=*reinterpret_cast<const bf16x8*>(kb+d0*2048+512);
    if(d0==0){p0=__builtin_amdgcn_mfma_f32_32x32x16_bf16(b0,qr[0],negm,0,0,0);p1=__builtin_amdgcn_mfma_f32_32x32x16_bf16(b1,qr[0],negm,0,0,0);}
    else{p0=__builtin_amdgcn_mfma_f32_32x32x16_bf16(b0,qr[d0],p0,0,0,0);p1=__builtin_amdgcn_mfma_f32_32x32x16_bf16(b1,qr[d0],p1,0,0,0);}}
}
typedef __attribute__((address_space(3))) const char* lds_cptr;
typedef short v4i16_t __attribute__((ext_vector_type(4)));
__device__ __forceinline__ void kload8(bf16x8*kf,lds_cptr kp){
  kf[0]=*(const __attribute__((address_space(3))) bf16x8*)(kp);      kf[1]=*(const __attribute__((address_space(3))) bf16x8*)(kp+512);
  kf[2]=*(const __attribute__((address_space(3))) bf16x8*)(kp+2048); kf[3]=*(const __attribute__((address_space(3))) bf16x8*)(kp+2560);
  kf[4]=*(const __attribute__((address_space(3))) bf16x8*)(kp+4096); kf[5]=*(const __attribute__((address_space(3))) bf16x8*)(kp+4608);
  kf[6]=*(const __attribute__((address_space(3))) bf16x8*)(kp+6144); kf[7]=*(const __attribute__((address_space(3))) bf16x8*)(kp+6656);
}
__device__ __forceinline__ void kload2(bf16x8*kf,lds_cptr kp,int j){ kf[2*j]=*(const __attribute__((address_space(3))) bf16x8*)(kp+j*2048); kf[2*j+1]=*(const __attribute__((address_space(3))) bf16x8*)(kp+j*2048+512); }
__device__ __forceinline__ s16x4 vtr(lds_cptr p){ return __builtin_bit_cast(s16x4,__builtin_amdgcn_ds_read_tr16_b64_v4i16((__attribute__((address_space(3))) v4i16_t*)p)); }
__device__ __forceinline__ float rowmax(const f32x16&p0,const f32x16&p1){
  float a=max3f(p0[0],p0[1],p1[0]),b=max3f(p0[2],p0[3],p1[1]);a=max3f(a,p1[2],p1[3]);
  #pragma unroll
  for(int r=4;r<16;r+=4){a=max3f(a,p0[r],p0[r+1]);b=max3f(b,p0[r+2],p0[r+3]);a=max3f(a,p1[r],p1[r+1]);b=max3f(b,p1[r+2],p1[r+3]);}
  const float m=max2f(a,b);
  auto rr=__builtin_amdgcn_permlane32_swap(__float_as_uint(m),__float_as_uint(m),false,false);
  return max2f(__uint_as_float(rr[0]),__uint_as_float(rr[1]));
}
__device__ __forceinline__ void pv(f32x16*o,int vb,bf16x8 pa0,bf16x8 pa1,bf16x8 pa2,bf16x8 pa3){
  #pragma unroll
  for(int d0=0;d0<2;++d0){s16x4 lo[4],hi[4];
    #pragma unroll
    for(int ks=0;ks<4;++ks){
      asm volatile("ds_read_b64_tr_b16 %0,%1 offset:%c2":"=&v"(lo[ks]):"v"(vb),"i"(d0*4096+ks*1024):"memory");
      asm volatile("ds_read_b64_tr_b16 %0,%1 offset:%c2":"=&v"(hi[ks]):"v"(vb),"i"(d0*4096+ks*1024+512):"memory");}
    asm volatile("s_waitcnt lgkmcnt(0)":::"memory");SBAR();
    #define PK(k) (bf16x8){lo[k][0],lo[k][1],lo[k][2],lo[k][3],hi[k][0],hi[k][1],hi[k][2],hi[k][3]}
    o[d0]=__builtin_amdgcn_mfma_f32_32x32x16_bf16(pa0,PK(0),o[d0],0,0,0);
    o[d0]=__builtin_amdgcn_mfma_f32_32x32x16_bf16(pa1,PK(1),o[d0],0,0,0);
    o[d0]=__builtin_amdgcn_mfma_f32_32x32x16_bf16(pa2,PK(2),o[d0],0,0,0);
    o[d0]=__builtin_amdgcn_mfma_f32_32x32x16_bf16(pa3,PK(3),o[d0],0,0,0);
    #undef PK
  }
}

#ifndef ATTN_STORE16
#define ATTN_STORE16(p,v) (*(u32x4*)(p)=(v))
#endif
struct UArgs {
  const bf16* Qb; const bf16* Kh; const bf16* Vh; bf16* Ob;
  int NT, q0, kt0, hc;
  const float* rel;
  const float* km; int qb;
  const unsigned* selg;
  const bf16* gate; int gcol;
  const bf16* tmp;
};
__device__ __forceinline__ int t5b(int d){ if(d<16)return d<0?0:d; int b=16; b+=(d>=19);b+=(d>=21);b+=(d>=24);b+=(d>=27);b+=(d>=31);b+=(d>=35);b+=(d>=40);b+=(d>=46);b+=(d>=52);b+=(d>=59);b+=(d>=67);b+=(d>=77);b+=(d>=87);b+=(d>=99);b+=(d>=113); return b; }
template<int MODE,int EPI,int THRL> __device__ __forceinline__ void attn_unit(const UArgs&U,char*shm){
  const int tid=threadIdx.x,lane=tid&63,r32=lane&31,hi=lane>>5; const int wid=__builtin_amdgcn_readfirstlane(tid>>6);
  const bf16*Qw=U.Qb+(long)(wid*QBLK)*PITCH;
  const bf16*Kh=U.Kh,*Vh=U.Vh;
  const unsigned lds0=(unsigned)(uintptr_t)shm;
  float*wsf=(float*)(shm+LDS_WS)+wid*128;
  const bf16*ksrc=Kh+(long)lane*PITCH+wid*8;
  const bf16*vsrc=Vh+(long)(16*(wid&3)+(lane>>2))*PITCH+(wid>>2)*32+(lane&3)*8;
  const unsigned kdst=lds0+LDS_K+wid*1024, vdst=lds0+LDS_V+wid*1024;
  #define DMA_K(t,slot) glds16(ksrc+(long)(t)*KVBLK*PITCH,(unsigned)__builtin_amdgcn_readfirstlane(kdst+(slot)))
  #define DMA_V(t,slot) glds16(vsrc+(long)(t)*KVBLK*PITCH,(unsigned)__builtin_amdgcn_readfirstlane(vdst+(slot)))
  const int vb0=(int)(lds0+LDS_V)+((lane>>4)&1)*32+(lane&3)*8+(4*hi+((lane&15)>>2))*64;
  const char*Kbase=shm+LDS_K; bf16x8 kf[8];
  const lds_cptr shm3=(lds_cptr)shm; const lds_cptr kp0=shm3+LDS_K+hi*1024+r32*16; const lds_cptr vp0=shm3+LDS_V+((lane>>4)&1)*32+(lane&3)*8+(4*hi+((lane&15)>>2))*64;
  const int NT=U.NT;
  const int qpos=U.q0+wid*QBLK+r32;
  float*biasT=(float*)(shm+LDS_BIAS);
  if(tid<128) biasT[tid]=(U.rel[t5b(tid)*16+U.hc]-U.rel[31*16+U.hc])*LOG2E_;
  unsigned selw=0u,cw=0u; const unsigned*mskp=(const unsigned*)(shm+LDS_MSK)+wid*128+r32*4;
  if(MODE==0){ ((u32x4*)(shm+LDS_KM))[tid]=((const u32x4*)U.km)[tid]; }
  if(MODE==1){ if(hi==0){ const u32x4 w=*(const u32x4*)(U.selg+(long)(wid*QBLK+r32)*4); *(u32x4*)((unsigned*)(shm+LDS_MSK)+wid*128+r32*4)=w; } }
  asm volatile("s_waitcnt vmcnt(0) lgkmcnt(0)\n\ts_barrier":::"memory");
  bf16x8 qr[4];
  #pragma unroll
  for(int d0=0;d0<4;++d0)qr[d0]=*reinterpret_cast<const bf16x8*>(&Qw[(long)r32*PITCH+d0*16+hi*8]);
  if(MODE==0){
    float v1=-INFINITY,v2=-INFINITY,v3=-INFINITY; int i1=-1,i2=-1,i3=-1;
    for(int n=0;n<U.qb;++n){ const float*km=(const float*)(shm+LDS_KM)+n*64+hi*8; float p=0.f;
      #pragma unroll
      for(int d0=0;d0<4;++d0){ const f32x4_ a=*(const f32x4_*)(km+d0*16), c=*(const f32x4_*)(km+d0*16+4);
        p+=bfs(qr[d0][0])*a[0]+bfs(qr[d0][1])*a[1]+bfs(qr[d0][2])*a[2]+bfs(qr[d0][3])*a[3]+bfs(qr[d0][4])*c[0]+bfs(qr[d0][5])*c[1]+bfs(qr[d0][6])*c[2]+bfs(qr[d0][7])*c[3]; }
      auto rr=__builtin_amdgcn_permlane32_swap(__float_as_uint(p),__float_as_uint(p),false,false); const float sc_=__uint_as_float(rr[0])+__uint_as_float(rr[1]);
      if(sc_>v1){v3=v2;i3=i2;v2=v1;i2=i1;v1=sc_;i1=n;} else if(sc_>v2){v3=v2;i3=i2;v2=sc_;i2=n;} else if(sc_>v3){v3=sc_;i3=n;} }
    if(i1>=0)selw|=1u<<i1; if(i2>=0)selw|=1u<<i2; if(i3>=0)selw|=1u<<i3; selw|=1u<<U.qb; }
  DMA_K(0,0);DMA_V(0,0);DMA_K(1,SLOTB);
  float mhat=0.f,l_reg=0.f;f32x16 o[2];o[0]=f32x16{};o[1]=f32x16{};f32x16 negm=f32x16{};asm volatile("":"+v"(negm));
  #define MASK_FAR(P0,P1,t) do{ bool on_=true; if(MODE==0)on_=((selw>>((t)>>2))&1u)!=0u; if(MODE==1){ if(((t)&31)==0)cw=mskp[(t)>>5]; on_=((cw>>((t)&31))&1u)!=0u; } \
      _Pragma("unroll") for(int r=0;r<16;++r){ P0[r]=on_?P0[r]:-INFINITY; P1[r]=on_?P1[r]:-INFINITY; } }while(0)
  #define MASK_BAND(P0,P1,t) do{ bool on_=true; if(MODE==0)on_=((selw>>((t)>>2))&1u)!=0u; if(MODE==1){ if(((t)&31)==0)cw=mskp[(t)>>5]; on_=((cw>>((t)&31))&1u)!=0u; } \
      const int d0_=qpos-(U.kt0+64*(t)+4*hi); \
      _Pragma("unroll") for(int r=0;r<16;++r){ const int da_=d0_-((r&3)+8*(r>>2)), db_=da_-32; \
        const bool oka_=on_&&da_>=0&&(MODE!=2||da_<512), okb_=on_&&db_>=0&&(MODE!=2||db_<512); \
        const float ba_=biasT[da_<0?0:(da_>127?127:da_)], bb_=biasT[db_<0?0:(db_>127?127:db_)]; \
        P0[r]=oka_?P0[r]+ba_:-INFINITY; P1[r]=okb_?P1[r]+bb_:-INFINITY; \
        if((r&1)==1){ asm volatile("s_waitcnt lgkmcnt(0)":"+v"(P0),"+v"(P1)::"memory"); } } }while(0)
  #define CMASK(P0,P1,t) MASK_BAND(P0,P1,t)
  bool resc=false;
  #define START(P0,P1) do{ const float rm=rowmax(P0,P1); resc=false; \
    { const float dl=rm>-1e30f?rm:0.f; mhat=fadd_s(mhat,dl); \
      _Pragma("unroll") for(int r=0;r<16;++r){P0[r]=fsub_s(P0[r],dl);P1[r]=fsub_s(P1[r],dl);} \
      _Pragma("unroll") for(int r=0;r<16;++r)negm[r]=-mhat; asm volatile("":"+v"(negm)); } \
    _Pragma("unroll") for(int r=0;r<16;++r)P0[r]=__builtin_amdgcn_exp2f(P0[r]); }while(0)
  #define RESC() do{ if(resc){ asm volatile("s_waitcnt lgkmcnt(0)":::"memory"); \
      _Pragma("unroll") for(int d_=0;d_<2;++d_) _Pragma("unroll") for(int r=0;r<16;++r)o[d_][r]*=wsf[crow(r,hi)]; } }while(0)
  f32x16 pA0,pA1,pB0,pB1;
  int sl_prev=0,sl_cur=0,sl_next=SLOTB;
  #define ROT() do{sl_prev=sl_cur;sl_cur=sl_next;sl_next=(sl_next==(NSLOT-1)*SLOTB)?0:sl_next+SLOTB;}while(0)
  DMA_K(2,2*SLOTB);
  WAIT_BAR(3);
  qkt(pA0,pA1,Kbase,qr,negm,r32,hi);asm volatile("s_nop 15\n\ts_nop 7":"+v"(pA0),"+v"(pA1));CMASK(pA0,pA1,0);
  START(pA0,pA1);
  _Pragma("unroll") for(int r=0;r<16;++r)pA1[r]=__builtin_amdgcn_exp2f(pA1[r]);
  WAIT_BAR(0);
  DMA_K(3,0);DMA_V(1,SLOTB);
  ROT();
  kload8(kf,kp0+sl_cur);
  WAIT_BAR(2);
  s16x4 vlo[8],vhi[8]; u32x4 pw0,pw1,pw2,pw3;
  #define PKW(P,B) cvtpk_s(P[B],P[B+1])
  #define PAF(k) __builtin_bit_cast(bf16x8,pw##k)
  #define VFR(i) (bf16x8){vlo[i][0],vlo[i][1],vlo[i][2],vlo[i][3],vhi[i][0],vhi[i][1],vhi[i][2],vhi[i][3]}
  #define PIN(x) asm volatile("":"+v"(x))
  #define MX3(a,b,c) __builtin_fmaxf(__builtin_fmaxf((a),(b)),(c))
  #define GAPA(MF,A0,A1,A2,A3,W0,W1,PW) do{ MF; sacc+=A0; sacc+=A1; sacc+=A2; sacc+=A3; PIN(sacc); W0; W1; PIN(PW); SBAR(); }while(0)
  #define EX(v) __builtin_amdgcn_exp2f(v)
  #define GAPB(MF,X,B) do{ MF; X[B]=EX(X[B]); X[B+1]=EX(X[B+1]); X[B+2]=EX(X[B+2]); X[B+3]=EX(X[B+3]); PIN(X); SBAR(); }while(0)
  #define VRD(i) do{ vlo[i]=vtr(vp_+(((i)>>2)*4096+((i)&3)*1024)); vhi[i]=vtr(vp_+(((i)>>2)*4096+((i)&3)*1024+512)); }while(0)
  #define KRD(G,j) do{ if(G){ kload2(kf,kp0+sl_next,j); SBAR(); } }while(0)
  #define STEP(C0,C1,P0,P1,t,GK,GV,GL) do{ SBAR(); \
    const lds_cptr vp_=vp0+sl_prev; \
    VRD(0); SBAR(); float sacc=(P0[0]+P0[1]); \
    GAPA(C0=__builtin_amdgcn_mfma_f32_32x32x16_bf16(kf[0],qr[0],negm,0,0,0), P0[2],P0[3],P0[4],P0[5],     pw0[0]=PKW(P0,0), pw0[1]=PKW(P0,2), pw0); \
    VRD(4); SBAR(); GAPA(C1=__builtin_amdgcn_mfma_f32_32x32x16_bf16(kf[1],qr[0],negm,0,0,0), P0[6],P0[7],P0[8],P0[9],     pw0[2]=PKW(P0,4), pw0[3]=PKW(P0,6), pw0); \
    VRD(1); SBAR(); GAPA(C0=__builtin_amdgcn_mfma_f32_32x32x16_bf16(kf[2],qr[1],C0,0,0,0),   P0[10],P0[11],P0[12],P0[13], pw1[0]=PKW(P0,8), pw1[1]=PKW(P0,10), pw1); \
    VRD(5); SBAR(); GAPA(C1=__builtin_amdgcn_mfma_f32_32x32x16_bf16(kf[3],qr[1],C1,0,0,0),   P0[14],P0[15],P1[0],P1[1],   pw1[2]=PKW(P0,12),pw1[3]=PKW(P0,14), pw1); \
    VRD(2); SBAR(); GAPA(C0=__builtin_amdgcn_mfma_f32_32x32x16_bf16(kf[4],qr[2],C0,0,0,0),   P1[2],P1[3],P1[4],P1[5],     pw2[0]=PKW(P1,0), pw2[1]=PKW(P1,2), pw2); \
    VRD(6); SBAR(); GAPA(C1=__builtin_amdgcn_mfma_f32_32x32x16_bf16(kf[5],qr[2],C1,0,0,0),   P1[6],P1[7],P1[8],P1[9],     pw2[2]=PKW(P1,4), pw2[3]=PKW(P1,6), pw2); \
    VRD(3); SBAR(); GAPA(C0=__builtin_amdgcn_mfma_f32_32x32x16_bf16(kf[6],qr[3],C0,0,0,0),   P1[10],P1[11],P1[12],P1[13], pw3[0]=PKW(P1,8), pw3[1]=PKW(P1,10), pw3); \
    VRD(7); SBAR(); GAPA(C1=__builtin_amdgcn_mfma_f32_32x32x16_bf16(kf[7],qr[3],C1,0,0,0),   P1[14],P1[15],0.f,0.f,       pw3[2]=PKW(P1,12),pw3[3]=PKW(P1,14), pw3); \
    l_reg+=sacc; \
    if(GK){DMA_K((t)+3,sl_cur);} if(GV){DMA_V((t)+1,sl_next);} \
    CMASK(C0,C1,t); \
    { float a=MX3(C0[0],C0[1],C1[0]),b=MX3(C0[2],C0[3],C1[1]); a=MX3(a,C1[2],C1[3]); \
      _Pragma("unroll") for(int r=4;r<16;r+=4){a=MX3(a,C0[r],C0[r+1]);b=MX3(b,C0[r+2],C0[r+3]);a=MX3(a,C1[r],C1[r+1]);b=MX3(b,C1[r+2],C1[r+3]);} \
      float rm=__builtin_fmaxf(a,b); { auto rr=__builtin_amdgcn_permlane32_swap(__float_as_uint(rm),__float_as_uint(rm),false,false); rm=__builtin_fmaxf(__uint_as_float(rr[0]),__uint_as_float(rr[1])); } \
      resc=false; \
      if(__builtin_expect(__any(rm>(float)THRL),0)){ const float dl=__builtin_fmaxf(rm,0.f); mhat+=dl; \
        _Pragma("unroll") for(int r=0;r<16;++r){C0[r]-=dl;C1[r]-=dl;} \
        _Pragma("unroll") for(int r=0;r<16;++r)negm[r]=-mhat; asm volatile("":"+v"(negm)); \
        const float f=__builtin_amdgcn_exp2f(-dl); l_reg*=f; if(hi==0)wsf[r32]=f; resc=true; } } \
    SBAR(); \
    GAPB(o[0]=__builtin_amdgcn_mfma_f32_32x32x16_bf16(PAF(0),VFR(0),o[0],0,0,0), C0,0); \
    GAPB(o[1]=__builtin_amdgcn_mfma_f32_32x32x16_bf16(PAF(0),VFR(4),o[1],0,0,0), C0,4); \
    KRD(GL,0); GAPB(o[0]=__builtin_amdgcn_mfma_f32_32x32x16_bf16(PAF(1),VFR(1),o[0],0,0,0), C0,8); \
    KRD(GL,1); GAPB(o[1]=__builtin_amdgcn_mfma_f32_32x32x16_bf16(PAF(1),VFR(5),o[1],0,0,0), C0,12); \
    KRD(GL,2); GAPB(o[0]=__builtin_amdgcn_mfma_f32_32x32x16_bf16(PAF(2),VFR(2),o[0],0,0,0), C1,0); \
    KRD(GL,3); GAPB(o[1]=__builtin_amdgcn_mfma_f32_32x32x16_bf16(PAF(2),VFR(6),o[1],0,0,0), C1,4); \
    GAPB(o[0]=__builtin_amdgcn_mfma_f32_32x32x16_bf16(PAF(3),VFR(3),o[0],0,0,0), C1,8); \
    GAPB(o[1]=__builtin_amdgcn_mfma_f32_32x32x16_bf16(PAF(3),VFR(7),o[1],0,0,0), C1,12); \
    }while(0)
  int t=1;
  #undef CMASK
  #define CMASK(P0,P1,t) MASK_FAR(P0,P1,t)
  for(;MODE!=2&&t+7<NT;t+=2){
    STEP(pB0,pB1,pA0,pA1,t,true,true,true);     WAIT_BAR(2); RESC(); ROT();
    STEP(pA0,pA1,pB0,pB1,t+1,true,true,true);   WAIT_BAR(2); RESC(); ROT();
  }
  #undef CMASK
  #define CMASK(P0,P1,t) MASK_BAND(P0,P1,t)
  #define ENDW(tt) do{ if((tt)+3<NT){WAIT_BAR(2);} else if((tt)+2<NT){WAIT_BAR(1);} else {WAIT_BAR(0);} }while(0)
  for(;t+1<NT;t+=2){
    STEP(pB0,pB1,pA0,pA1,t,(t+3<NT),(t+1<NT),(t+1<NT));       ENDW(t);   RESC(); ROT();
    STEP(pA0,pA1,pB0,pB1,t+1,(t+4<NT),(t+2<NT),(t+2<NT));     ENDW(t+1); RESC(); ROT();
  }
  STEP(pB0,pB1,pA0,pA1,NT-1,false,false,false); RESC();
  { float sacc=pB0[0]+pB0[1]; _Pragma("unroll") for(int r=2;r<16;++r)sacc+=pB0[r]; _Pragma("unroll") for(int r=0;r<16;++r)sacc+=pB1[r]; l_reg+=sacc;
    pw0=(u32x4){PKW(pB0,0),PKW(pB0,2),PKW(pB0,4),PKW(pB0,6)};pw1=(u32x4){PKW(pB0,8),PKW(pB0,10),PKW(pB0,12),PKW(pB0,14)};pw2=(u32x4){PKW(pB1,0),PKW(pB1,2),PKW(pB1,4),PKW(pB1,6)};pw3=(u32x4){PKW(pB1,8),PKW(pB1,10),PKW(pB1,12),PKW(pB1,14)};
    SBAR(); pv(o,vb0+sl_cur,PAF(0),PAF(1),PAF(2),PAF(3)); }
  #undef PKW
  #undef PAF
  #undef VFR
  #undef PIN
  #undef MX3
  #undef GAPA
  #undef GAPB
  #undef EX
  #undef VRD
  #undef KRD
  #undef STEP
  #undef ENDW
  {auto rr=__builtin_amdgcn_permlane32_swap(__float_as_uint(l_reg),__float_as_uint(l_reg),false,false);l_reg=__uint_as_float(rr[0])+__uint_as_float(rr[1]);}
  int lane_e=lane; asm volatile("":"+v"(lane_e)); const int r32e=lane_e&31, hie=lane_e>>5;
  float*wsfe=(float*)(shm+LDS_WS)+wid*128;
  if(hie==0){ wsfe[32+r32e]=l_reg; if(EPI!=0){ const float gl=bfs((short)U.gate[(long)(wid*QBLK+r32e)*PITCH+U.gcol]); wsfe[64+r32e]=1.f/(1.f+__expf(-gl)); } }
  asm volatile("s_waitcnt lgkmcnt(0)":::"memory");
  float rli[16];
  #pragma unroll
  for(int r=0;r<16;++r){ rli[r]=__builtin_amdgcn_rcpf(fmaxf(wsfe[32+crow(r,hie)],1e-30f)); if(EPI!=0)rli[r]*=wsfe[64+crow(r,hie)]; }
  bf16*Ow=U.Ob+(long)(wid*QBLK)*PITCH;
  { bf16*stg=(bf16*)(shm+LDS_OST)+wid*2048;
    #pragma unroll
    for(int r=0;r<16;++r){const int orow=crow(r,hie);
      #pragma unroll
      for(int d0=0;d0<2;++d0){ float v=o[d0][r]*rli[r]; if(EPI==2)v+=bfs((short)stg[orow*64+d0*32+r32e]); stg[orow*64+d0*32+r32e]=f2b(v);} }
    asm volatile("s_waitcnt lgkmcnt(0)":::"memory");
    if(EPI!=1){
    #pragma unroll
    for(int i=0;i<4;++i){const int row=i*8+(lane_e>>3),ch=lane_e&7; u32x4 v=*(const u32x4*)(stg+row*64+ch*8);
      if(EPI==2){ const u32x4 t=*(const u32x4*)(U.tmp+(long)(wid*QBLK+row)*512+ch*8);
        v.x=pk2b(lo16(v.x)+lo16(t.x),hi16(v.x)+hi16(t.x)); v.y=pk2b(lo16(v.y)+lo16(t.y),hi16(v.y)+hi16(t.y)); v.z=pk2b(lo16(v.z)+lo16(t.z),hi16(v.z)+hi16(t.z)); v.w=pk2b(lo16(v.w)+lo16(t.w),hi16(v.w)+hi16(t.w)); }
      ATTN_STORE16(Ow+(long)row*PITCH+ch*8,v);} } }
  asm volatile("s_waitcnt lgkmcnt(0)\n\ts_barrier":::"memory");
  #undef DMA_K
  #undef DMA_V
  #undef CMASK
  #undef START
  #undef RESC
  #undef ROT
}
constexpr int ATTN_LDS_BYTES=LDS_BYTES;
#undef SBAR
#undef WAIT_BAR
}

constexpr int NWAVES = 8;
constexpr int B_ = 4, S_ = 8192, DM = 1024, M_ = B_ * S_, DIN = 7464, FF = 2816, NL = 2;
constexpr int YP = pg8::YP_;
constexpr float C2 = pg8::C2_, LOG2E = 1.4426950408889634f;
constexpr float NORM_EPS = 1e-6f;
constexpr int Y_AQ = 0, Y_AKC = 512, Y_AVC = 640, Y_AKS = 768, Y_AVS = 896, Y_AKW = 1024, Y_AVW = 1152, Y_CQ = 1280, Y_CK = 1792, Y_CV = 2304,
              Y_BQ = 2816, Y_BK = 3072, Y_BV = 3328, Y_BR = 3840, Y_AG = 4352, Y_BLR = 4376;
constexpr int NIN = 7680;
constexpr size_t MiB = 1u << 20;
constexpr size_t WS_CTL = 0, CTL_ZERO_BYTES = 1 * MiB;
constexpr size_t WS_WIN = 1 * MiB, WS_WA = 16 * MiB, WS_WB = 17 * MiB, WS_WC = 18 * MiB, WS_WO = 19 * MiB, WS_WF1 = 21 * MiB, WS_WF2 = 32 * MiB;
constexpr size_t WS_H = 40 * MiB;
constexpr size_t WS_Y = 104 * MiB;
constexpr size_t WS_G8 = 379 * MiB;
constexpr size_t WS_ACT = WS_Y + 128 * MiB;
constexpr size_t WS_SM = 475 * MiB;
constexpr size_t WS_KCMP = WS_SM, WS_VCMP = WS_SM + 1 * MiB, WS_KMEAN = WS_SM + 2 * MiB;
constexpr size_t WS_GA = WS_SM + 3 * MiB;
constexpr size_t WS_MASK = 38 * MiB;
constexpr size_t WS_OATMP = WS_H;
constexpr size_t WS_O16 = WS_H + 32 * MiB;
constexpr size_t WS_VCMPT = WS_VCMP + 512 * 1024;
constexpr size_t WS_CW1T = 39 * MiB;
constexpr size_t WS_CW2T = WS_CW1T + 512 * 1024;
constexpr size_t WS_CC0 = WS_CW2T + 16 * 1024;
constexpr size_t WS_GST = WS_H + 32 * MiB;
constexpr size_t WS_GDEC = WS_SM + 3 * MiB;
constexpr size_t WS_END = 512 * MiB;
static_assert(WS_GA + (size_t)M_ * 256 * 4 <= WS_END && WS_Y + (size_t)M_ * YP * 2 <= WS_G8 && WS_G8 + (size_t)M_ * 3072 <= WS_SM, "ws map");
static_assert(WS_ACT + (size_t)M_ * FF * 2 <= WS_SM && WS_WF2 + (size_t)DM * FF * 2 <= WS_H, "ws map 2");
constexpr int CW_BAR = 4096;
constexpr int RING_OFF = 0, RING_BYTES = 131072;
constexpr int LDSCTL_OFF = RING_BYTES, MISC_OFF = LDSCTL_OFF + 320;
constexpr int LDS_BYTES = 147456;

#define GAS __attribute__((address_space(1)))
#define LAS __attribute__((address_space(3)))
typedef unsigned short bf16;
typedef unsigned v4u __attribute__((ext_vector_type(4)));
typedef float f32x4 __attribute__((ext_vector_type(4)));
typedef short bf16x8 __attribute__((ext_vector_type(8)));
typedef GAS unsigned gu32;
typedef GAS unsigned long long gu64;
#define RLX_AGENT __ATOMIC_RELAXED, __HIP_MEMORY_SCOPE_AGENT
#define LDS_WAIT() asm volatile("s_waitcnt lgkmcnt(0)" ::: "memory")
#define VM_WAIT() asm volatile("s_waitcnt vmcnt(0)" ::: "memory")
__device__ __forceinline__ unsigned long long rt() { return __builtin_amdgcn_s_memrealtime(); }
__device__ __forceinline__ unsigned f2bf(float f) { unsigned u = __builtin_bit_cast(unsigned, f); return (u + 0x7fffu + ((u >> 16) & 1u)) >> 16; }
__device__ __forceinline__ unsigned pk2(float lo, float hi) { return f2bf(lo) | (f2bf(hi) << 16); }

__device__ __forceinline__ float bf2f(bf16 h) { return __uint_as_float((unsigned)h << 16); }
__device__ __forceinline__ float sigm(float v) { return 1.f / (1.f + __expf(-v)); }
#define WFENCE() asm volatile("s_waitcnt lgkmcnt(0)" ::: "memory")

#define XB_TMO      128
#define XB_XCNT(j)  (256  + 64 * (j))
#define XB_XSUB(j)  (1280 + 64 * (j))
#define XB_XGEN(j)  (2304 + 64 * (j))
#define XB_TOP      3328
#define XB_TOPGEN   3392
#define XCD_BAR_WORDS 3456
#define XB_SPIN_CAP (1u << 18)

__device__ __forceinline__ unsigned xb_ld(unsigned* p)              { return __hip_atomic_load(p, __ATOMIC_RELAXED, __HIP_MEMORY_SCOPE_AGENT); }
__device__ __forceinline__ unsigned xb_add(unsigned* p, unsigned v) { return __hip_atomic_fetch_add(p, v, __ATOMIC_RELAXED, __HIP_MEMORY_SCOPE_AGENT); }
__device__ __forceinline__ unsigned xb_xcc_id() { return (unsigned)__builtin_amdgcn_s_getreg((3 << 11) | 20) & 0xFu; }
#define XB_SPIN(cond, bar) do { unsigned _sp = 0; while (cond) { __builtin_amdgcn_s_sleep(1); \
    if ((++_sp & 255u) == 0u) { if (xb_ld(&(bar)[XB_TMO])) break; if (_sp > XB_SPIN_CAP) { atomicAdd(&(bar)[XB_TMO], 1u); break; } } } } while (0)

struct XcdBarrier {
    unsigned* bar; unsigned x;
    volatile LAS unsigned* st;
};

__device__ __forceinline__ XcdBarrier xcd_barrier_post(unsigned* bar, volatile LAS unsigned* st) {
    XcdBarrier b; b.bar = bar; b.x = xb_xcc_id(); b.st = st;
    if (threadIdx.x == 0) (void)xb_add(&bar[XB_XCNT(b.x)], 1u);
    return b;
}
__device__ __forceinline__ void xcd_barrier_complete(unsigned* bar, unsigned x, unsigned& nloc, unsigned& nx) {
    const unsigned G = gridDim.x * gridDim.y * gridDim.z;
    unsigned sum, cnt, mine, sp = 0u;
    for (;;) {
        sum = 0u; cnt = 0u; mine = 0u;
#pragma unroll
        for (unsigned j = 0; j < 16; ++j) { const unsigned c = xb_ld(&bar[XB_XCNT(j)]); sum += c; cnt += (c > 0u) ? 1u : 0u; mine = (j == x) ? c : mine; }
        if (sum == G) break;
        __builtin_amdgcn_s_sleep(1);
        if ((++sp & 255u) == 0u) { if (xb_ld(&bar[XB_TMO])) break; if (sp > XB_SPIN_CAP) { atomicAdd(&bar[XB_TMO], 1u); break; } }
    }
    nloc = mine > 0u ? mine : 1u; nx = cnt > 0u ? cnt : 1u;
}

__device__ __forceinline__ void xcd_barrier(const XcdBarrier& b) {
    asm volatile("s_waitcnt vmcnt(0)" ::: "memory");
    __syncthreads();
    if (threadIdx.x == 0) {
        unsigned* bar = b.bar;
        __builtin_amdgcn_s_waitcnt(0);
        unsigned nloc = b.st[0], nx = b.st[1];
        if (nloc == 0u) { xcd_barrier_complete(bar, b.x, nloc, nx); b.st[0] = nloc; b.st[1] = nx; }
        const unsigned old = xb_add(&bar[XB_XSUB(b.x)], 1u);
        const unsigned gen = old / nloc;
        if (old + 1u == (gen + 1u) * nloc) {
            __builtin_amdgcn_fence(__ATOMIC_RELEASE, "agent");
            asm volatile("s_waitcnt vmcnt(0)" ::: "memory");
            const unsigned og = xb_add(&bar[XB_TOP], 1u);
            const unsigned tg = og / nx;
            if (og + 1u == (tg + 1u) * nx) xb_add(&bar[XB_TOPGEN], 1u);
            else XB_SPIN(xb_ld(&bar[XB_TOPGEN]) == tg, bar);
            __builtin_amdgcn_fence(__ATOMIC_ACQUIRE, "agent");
            xb_add(&bar[XB_XGEN(b.x)], 1u);
            asm volatile("s_waitcnt vmcnt(0)" ::: "memory");
        } else {
            XB_SPIN(xb_ld(&bar[XB_XGEN(b.x)]) == gen, bar);
            __builtin_amdgcn_fence(__ATOMIC_ACQUIRE, "agent");
            asm volatile("s_waitcnt vmcnt(0)" ::: "memory");
        }
    }
    __syncthreads();
}


struct Frame {
    LAS unsigned char* lds;
    volatile LAS unsigned* MISC;
    gu32* ctl;
    int tid, lane, wave, G;
};
__device__ __forceinline__ float wave_sum(float v) {
#pragma unroll
    for (int o = 1; o < 64; o <<= 1) v += __shfl_xor(v, o);
    return v;
}
__device__ __forceinline__ float wave_max(float v) {
#pragma unroll
    for (int o = 1; o < 64; o <<= 1) v = fmaxf(v, __shfl_xor(v, o));
    return v;
}
__device__ __forceinline__ int t5_bucket(int d) {
    if (d < 16) return d < 0 ? 0 : d;
    int b = 16;
    b += (d >= 19); b += (d >= 21); b += (d >= 24); b += (d >= 27); b += (d >= 31); b += (d >= 35); b += (d >= 40); b += (d >= 46);
    b += (d >= 52); b += (d >= 59); b += (d >= 67); b += (d >= 77); b += (d >= 87); b += (d >= 99); b += (d >= 113);
    return b;
}
template <class CM> __device__ __forceinline__ void tr_item(const float* W, int Nsrc, int K, bf16* WT, int item, int nblk, CM cm, LAS float* scr, int lane) {
    const int kb = item / nblk, nb = item % nblk, k0 = 64 * kb, n0 = 32 * nb;
    const int sc = cm(n0 + (lane & 31));
#pragma unroll 8
    for (int i = 0; i < 32; ++i) { const int kk = 2 * i + (lane >> 5); scr[kk * 33 + (lane & 31)] = sc >= 0 ? W[(size_t)(k0 + kk) * Nsrc + sc] : 0.f; }
    LDS_WAIT(); asm volatile("" ::: "memory");
    const int c = lane & 7;
#pragma unroll
    for (int j = 0; j < 4; ++j) { const int n = (lane >> 3) + 8 * j; const LAS float* s = scr + (8 * c) * 33 + n;
        v4u o; o.x = pk2(s[0 * 33], s[1 * 33]); o.y = pk2(s[2 * 33], s[3 * 33]); o.z = pk2(s[4 * 33], s[5 * 33]); o.w = pk2(s[6 * 33], s[7 * 33]);
        *(GAS v4u*)(WT + (size_t)(n0 + n) * K + k0 + 8 * c) = o; }
    LDS_WAIT(); asm volatile("" ::: "memory");
}
struct CmId { __device__ __forceinline__ int operator()(int n) const { return n; } };
struct CmWin { __device__ __forceinline__ int operator()(int n) const {
    if (n < 1280) return n;
    if (n < 2816) return n - 1280 + 2856;
    if (n < 4352) return n - 2816 + 1304;
    if (n < 4376) return n - 4352 + 1280;
    if (n < 4392) return n - 4376 + 2840;
    if (n < 4608) return -1;
    return n - 4608 + 4392; } };
struct CmFfn { __device__ __forceinline__ int operator()(int c) const { const int p = c >> 8, r = c & 255; return r < 128 ? 128 * p + r : FF + 128 * p + (r - 128); } };

struct Args { const float* in[22]; float* out; unsigned char* ws; int ph_lo, ph_hi; };

__device__ __forceinline__ void phase_weights(Frame& F, const Args& a, int l) {
    LAS float* scr = (LAS float*)(F.lds + RING_OFF + F.wave * 16384);
    const int gw = blockIdx.x * NWAVES + F.wave, NGW = F.G * NWAVES;
    unsigned char* ws = a.ws;
    constexpr int I_IN = 16 * (NIN / 32), I_BR = 8 * 32, I_O = 16 * 32, I_F1 = 16 * (2 * FF / 32), I_F2 = (FF / 64) * 32;
    constexpr int NIT = I_IN + 3 * I_BR + I_O + I_F1 + I_F2;
    for (int it = gw; it < NIT; it += NGW) {
        int r = it;
        if (r < I_IN) { tr_item(a.in[6] + (size_t)l * DM * DIN, DIN, DM, (bf16*)(ws + WS_WIN), r, NIN / 32, CmWin(), scr, F.lane); continue; } r -= I_IN;
        if (r < I_BR) { tr_item(a.in[16] + (size_t)l * 512 * DM, DM, 512, (bf16*)(ws + WS_WA), r, 32, CmId(), scr, F.lane); continue; } r -= I_BR;
        if (r < I_BR) { tr_item(a.in[17] + (size_t)l * 512 * DM, DM, 512, (bf16*)(ws + WS_WB), r, 32, CmId(), scr, F.lane); continue; } r -= I_BR;
        if (r < I_BR) { tr_item(a.in[18] + (size_t)l * 512 * DM, DM, 512, (bf16*)(ws + WS_WC), r, 32, CmId(), scr, F.lane); continue; } r -= I_BR;
        if (r < I_O) { tr_item(a.in[19] + (size_t)l * DM * DM, DM, DM, (bf16*)(ws + WS_WO), r, 32, CmId(), scr, F.lane); continue; } r -= I_O;
        if (r < I_F1) { tr_item(a.in[20] + (size_t)l * DM * 2 * FF, 2 * FF, DM, (bf16*)(ws + WS_WF1), r, 2 * FF / 32, CmFfn(), scr, F.lane); continue; } r -= I_F1;
        tr_item(a.in[21] + (size_t)l * FF * DM, DM, FF, (bf16*)(ws + WS_WF2), r, 32, CmId(), scr, F.lane);
    }
    for (int it = gw; it < 2 * 66 + 2; it += NGW) {
        if (it < 132) { const int kv = it / 66, r = it % 66;
            if (r < 64) tr_item(a.in[kv ? 11 : 9] + (size_t)l * 2048 * 64, 64, 2048, (bf16*)(ws + WS_CW1T) + (size_t)kv * 64 * 2048, r, 2, CmId(), scr, F.lane);
            else tr_item(a.in[kv ? 12 : 10] + (size_t)l * 64 * 64, 64, 64, (bf16*)(ws + WS_CW2T) + (size_t)kv * 64 * 64, r - 64, 2, CmId(), scr, F.lane); }
        else { const int kv = it - 132; const float* pe = a.in[kv ? 8 : 7] + (size_t)l * 2048; const float* w1 = a.in[kv ? 11 : 9] + (size_t)l * 2048 * 64; float acc = 0.f;
            for (int k = 0; k < 2048; ++k) acc += pe[k] * w1[(size_t)k * 64 + F.lane];
            ((float*)(ws + WS_CC0))[kv * 64 + F.lane] = acc; }
    }
}
__device__ __forceinline__ void phase_norm0(Frame& F, const float* x, const float* w, bf16* H) {
    const int gw = blockIdx.x * NWAVES + F.wave, NGW = F.G * NWAVES;
    for (int m = gw; m < M_; m += NGW) {
        const f32x4* xr = (const f32x4*)(x + (size_t)m * DM) + F.lane; f32x4 v[4]; float s = 0.f;
#pragma unroll
        for (int j = 0; j < 4; ++j) { v[j] = xr[64 * j]; s += v[j].x * v[j].x + v[j].y * v[j].y + v[j].z * v[j].z + v[j].w * v[j].w; }
        const float r = rsqrtf(wave_sum(s) * (1.f / DM) + NORM_EPS);
        unsigned long long* o8 = (unsigned long long*)(H + (size_t)m * DM) + F.lane;
#pragma unroll
        for (int j = 0; j < 4; ++j) { const f32x4 wv = ((const f32x4*)w)[F.lane + 64 * j];
            o8[64 * j] = (unsigned long long)pk2(v[j].x * r * wv.x, v[j].y * r * wv.y) | ((unsigned long long)pk2(v[j].z * r * wv.z, v[j].w * r * wv.w) << 32); }
    }
}
__device__ __forceinline__ void phase_resid(Frame& F, const float* y, const float* xin, float* xout, const float* wpost, const float* wpre, bf16* hout) {
    const int gw = blockIdx.x * NWAVES + F.wave, NGW = F.G * NWAVES;
    for (int m = gw; m < M_; m += NGW) {
        const f32x4* yr = (const f32x4*)(y + (size_t)m * DM) + F.lane; const f32x4* xr = (const f32x4*)(xin + (size_t)m * DM) + F.lane;
        f32x4 v[4], xv[4]; float s = 0.f;
#pragma unroll
        for (int j = 0; j < 4; ++j) { v[j] = yr[64 * j]; xv[j] = xr[64 * j]; s += v[j].x * v[j].x + v[j].y * v[j].y + v[j].z * v[j].z + v[j].w * v[j].w; }
        const float r = rsqrtf(wave_sum(s) * (1.f / DM) + NORM_EPS); float s2 = 0.f;
        f32x4* xo = (f32x4*)(xout + (size_t)m * DM) + F.lane;
#pragma unroll
        for (int j = 0; j < 4; ++j) { const f32x4 wv = ((const f32x4*)wpost)[F.lane + 64 * j]; f32x4 n;
            n.x = xv[j].x + v[j].x * r * wv.x; n.y = xv[j].y + v[j].y * r * wv.y; n.z = xv[j].z + v[j].z * r * wv.z; n.w = xv[j].w + v[j].w * r * wv.w;
            xo[64 * j] = n; v[j] = n; s2 += n.x * n.x + n.y * n.y + n.z * n.z + n.w * n.w; }
        if (hout) { const float r2 = rsqrtf(wave_sum(s2) * (1.f / DM) + NORM_EPS);
            unsigned long long* o8 = (unsigned long long*)(hout + (size_t)m * DM) + F.lane;
#pragma unroll
            for (int j = 0; j < 4; ++j) { const f32x4 wv = ((const f32x4*)wpre)[F.lane + 64 * j];
                o8[64 * j] = (unsigned long long)pk2(v[j].x * r2 * wv.x, v[j].y * r2 * wv.y) | ((unsigned long long)pk2(v[j].z * r2 * wv.z, v[j].w * r2 * wv.w) << 32); } }
    }
}
__device__ __forceinline__ void unpack8(const v4u w, float (&k)[8]) {
    k[0] = __uint_as_float(w.x << 16); k[1] = __uint_as_float(w.x & 0xffff0000u); k[2] = __uint_as_float(w.y << 16); k[3] = __uint_as_float(w.y & 0xffff0000u);
    k[4] = __uint_as_float(w.z << 16); k[5] = __uint_as_float(w.z & 0xffff0000u); k[6] = __uint_as_float(w.w << 16); k[7] = __uint_as_float(w.w & 0xffff0000u);
}
__device__ __forceinline__ void dot4(const LAS float* qs, const bf16* kr, float (&d)[4]) {
    d[0] = d[1] = d[2] = d[3] = 0.f;
#pragma unroll 1
    for (int c = 0; c < 8; ++c) { asm volatile("" ::: "memory"); const v4u w = ((const v4u*)kr)[c]; float k[8]; unpack8(w, k);
#pragma unroll
        for (int e = 0; e < 8; ++e) { const int dd = c * 8 + e;
#pragma unroll
            for (int h = 0; h < 4; ++h) d[h] += qs[h * 64 + dd] * k[e]; } }
}
__device__ __forceinline__ float dot1(const LAS float* qs, const bf16* kr) {
    float d = 0.f;
#pragma unroll
    for (int c = 0; c < 8; ++c) { const v4u w = ((const v4u*)kr)[c]; float k[8]; unpack8(w, k);
#pragma unroll
        for (int e = 0; e < 8; ++e) d += qs[c * 8 + e] * k[e]; }
    return d;
}
__device__ __forceinline__ float gelu_tanh(float x) { const float u = 0.7978845608028654f * (x + 0.044715f * x * x * x); return 0.5f * x * (1.f + tanhf(u)); }

__device__ __forceinline__ void phase2_naive(Frame& F, const Args& a, int l) {
    const int gw = blockIdx.x * NWAVES + F.wave, NGW = F.G * NWAVES, lane = F.lane;
    const bf16* Y = (const bf16*)(a.ws + WS_Y);
    LAS float* scr = (LAS float*)(F.lds + RING_OFF + F.wave * 16384);
    for (int t = gw; t < 4 * 8 * 32; t += NGW) {
        const int blk = t & 31, h = (t >> 5) & 7, b = t >> 8;
        const bf16* src = Y + ((size_t)b * S_ + blk * 256) * YP + Y_CK + h * 64 + lane; float s = 0.f;
        for (int i = 0; i < 256; ++i) s += bf2f(src[(size_t)i * YP]);
        ((float*)(a.ws + WS_KMEAN))[(size_t)t * 64 + lane] = s * (1.f / 256.f);
    }
}
__device__ __forceinline__ void gla_scan_naive(Frame& F, const Args& a) {
    const bf16* Y = (const bf16*)(a.ws + WS_Y); const float* GA = (const float*)(a.ws + WS_GA); bf16* O16 = (bf16*)(a.ws + WS_O16);
    const int lane = F.lane;
    for (int task = blockIdx.x; task < 256; task += F.G) {
        const int eg = task & 15, h = (task >> 4) & 3, b = task >> 6, e = eg * 8 + F.wave;
        float Sst = 0.f;
        for (int t0 = 0; t0 < S_; t0 += 8) {
            float av[8], kv[8], qv[8], vv[8];
#pragma unroll
            for (int j = 0; j < 8; ++j) { const size_t row = (size_t)b * S_ + t0 + j;
                av[j] = GA[row * 256 + h * 64 + lane]; kv[j] = bf2f(Y[row * YP + Y_BK + h * 64 + lane]); qv[j] = bf2f(Y[row * YP + Y_BQ + h * 64 + lane]); vv[j] = bf2f(Y[row * YP + Y_BV + h * 128 + e]); }
#pragma unroll
            for (int j = 0; j < 8; ++j) { Sst = av[j] * Sst + kv[j] * vv[j]; const float o = wave_sum(qv[j] * Sst);
                if (lane == 0) O16[((size_t)b * S_ + t0 + j) * 512 + h * 128 + e] = (bf16)f2bf(o); }
        }
    }
}
__device__ __forceinline__ void nsa_cmp_naive(Frame& F, const Args& a) {
    const int gw = blockIdx.x * NWAVES + F.wave, NGW = F.G * NWAVES, lane = F.lane;
    bf16* Y = (bf16*)(a.ws + WS_Y); const float* rel = a.in[1];
    LAS float* scr = (LAS float*)(F.lds + RING_OFF + F.wave * 16384);
    LAS float* qs = scr; LAS float* sc = scr + 256; LAS float* s2 = scr + 256 + 2048;
    for (int task = gw; task < 8 * S_; task += NGW) {
        const int q = task & (S_ - 1), bg = task >> 13, g = bg & 1, b = bg >> 1;
        const size_t row = (size_t)b * S_ + q; bf16* Yr = Y + row * YP;
#pragma unroll
        for (int h = 0; h < 4; ++h) qs[h * 64 + lane] = bf2f(Yr[Y_AQ + (g * 4 + h) * 64 + lane]);
        float gt[4][3];
#pragma unroll
        for (int h = 0; h < 4; ++h)
#pragma unroll
            for (int br = 0; br < 3; ++br) gt[h][br] = sigm(bf2f(Yr[Y_AG + (g * 4 + h) * 3 + br]));
        WFENCE();
        const int cur = q >> 6, ncv = q >= 31 ? ((q - 31) >> 4) + 1 : 0;
        const bf16* KC = (const bf16*)(a.ws + WS_KCMP) + (size_t)bg * 512 * 64; const bf16* VC = (const bf16*)(a.ws + WS_VCMP) + (size_t)bg * 512 * 64;
        float mx[4] = {-1e30f, -1e30f, -1e30f, -1e30f};
        for (int i = 0; i < 8; ++i) { const int n = lane + 64 * i;
            if (n < ncv) { float d[4]; dot4(qs, KC + (size_t)n * 64, d); const int bk = t5_bucket(q - (16 * n + 31));
#pragma unroll
                for (int h = 0; h < 4; ++h) { const float s = d[h] + rel[bk * 16 + g * 4 + h] * LOG2E; sc[h * 512 + n] = s; mx[h] = fmaxf(mx[h], s); } }
            else {
#pragma unroll
                for (int h = 0; h < 4; ++h) sc[h * 512 + n] = 0.f; } }
        float ls[4] = {0.f, 0.f, 0.f, 0.f};
#pragma unroll
        for (int h = 0; h < 4; ++h) mx[h] = wave_max(mx[h]);
        WFENCE();
        for (int i = 0; i < 8; ++i) { const int n = lane + 64 * i;
            if (n < ncv) {
#pragma unroll
                for (int h = 0; h < 4; ++h) { const float e = exp2f(sc[h * 512 + n] - mx[h]); sc[h * 512 + n] = e; ls[h] += e; } } }
#pragma unroll
        for (int h = 0; h < 4; ++h) ls[h] = 1.f / fmaxf(wave_sum(ls[h]), 1e-20f);
        for (int i = 0; i < 8; ++i) { const int n = lane + 64 * i;
            if (n < ncv) {
#pragma unroll
                for (int h = 0; h < 4; ++h) sc[h * 512 + n] *= ls[h]; } }
        WFENCE();
        float v0, v1;
        { float t[2];
#pragma unroll
          for (int jj = 0; jj < 2; ++jj) { const int j = lane + 64 * jj; float v = 0.f;
              for (int n = 4 * j - 1; n <= 4 * j + 3; ++n) if (n >= 0 && n < 511) v += (sc[n] + sc[512 + n]) + (sc[1024 + n] + sc[1536 + n]);
              const bool forced = (j == 0) || (j == cur) || (j == cur - 1);
              t[jj] = forced ? 1e9f : (j <= cur ? v : -1e30f); }
          v0 = t[0]; v1 = t[1]; }
        bool sel0 = false, sel1 = false;
        for (int it = 0; it < 16; ++it) {
            const float c0 = sel0 ? -INFINITY : v0, c1 = sel1 ? -INFINITY : v1;
            const float mxv = wave_max(fmaxf(c0, c1));
            const unsigned long long m0 = __ballot(!sel0 && v0 == mxv);
            if (m0) { const int idx = __builtin_ctzll(m0); if (lane == idx) sel0 = true; }
            else { const unsigned long long m1 = __ballot(!sel1 && v1 == mxv); const int idx = m1 ? __builtin_ctzll(m1) : -1; if (lane == idx) sel1 = true; }
        }
        sel0 = sel0 && (lane <= cur); sel1 = sel1 && (lane + 64 <= cur);
        const unsigned long long sm0 = __ballot(sel0), sm1 = __ballot(sel1);
        float oc[4] = {0.f, 0.f, 0.f, 0.f};
        for (int n = 0; n < ncv; ++n) { const float vv = bf2f(VC[(size_t)n * 64 + lane]);
#pragma unroll
            for (int h = 0; h < 4; ++h) oc[h] += sc[h * 512 + n] * vv; }
        { unsigned* MK = (unsigned*)(a.ws + WS_MASK) + ((size_t)bg * S_ + q) * 4;
          if (lane == 0) { MK[0] = (unsigned)sm0; MK[1] = (unsigned)(sm0 >> 32); MK[2] = (unsigned)sm1; MK[3] = (unsigned)(sm1 >> 32); }
          bf16* T = (bf16*)(a.ws + WS_OATMP) + row * 512;
#pragma unroll
          for (int h = 0; h < 4; ++h) T[(g * 4 + h) * 64 + lane] = (bf16)f2bf(gt[h][0] * oc[h]); }
        WFENCE();
    }
}
__device__ __forceinline__ void nsa_naive(Frame& F, const Args& a) {
    const int gw = blockIdx.x * NWAVES + F.wave, NGW = F.G * NWAVES, lane = F.lane;
    bf16* Y = (bf16*)(a.ws + WS_Y); const float* rel = a.in[1];
    LAS float* scr = (LAS float*)(F.lds + RING_OFF + F.wave * 16384);
    LAS float* qs = scr; LAS float* sc = scr + 256; LAS float* s2 = scr + 256 + 2048;
    for (int task = gw; task < 8 * S_; task += NGW) {
        const int q = task & (S_ - 1), bg = task >> 13, g = bg & 1, b = bg >> 1;
        const size_t row = (size_t)b * S_ + q; bf16* Yr = Y + row * YP;
#pragma unroll
        for (int h = 0; h < 4; ++h) qs[h * 64 + lane] = bf2f(Yr[Y_AQ + (g * 4 + h) * 64 + lane]);
        float gt[4][3];
#pragma unroll
        for (int h = 0; h < 4; ++h)
#pragma unroll
            for (int br = 0; br < 3; ++br) gt[h][br] = sigm(bf2f(Yr[Y_AG + (g * 4 + h) * 3 + br]));
        WFENCE();
        const int cur = q >> 6, ncv = q >= 31 ? ((q - 31) >> 4) + 1 : 0;
        const bf16* KC = (const bf16*)(a.ws + WS_KCMP) + (size_t)bg * 512 * 64; const bf16* VC = (const bf16*)(a.ws + WS_VCMP) + (size_t)bg * 512 * 64;
        float mx[4] = {-1e30f, -1e30f, -1e30f, -1e30f};
        for (int i = 0; i < 8; ++i) { const int n = lane + 64 * i;
            if (n < ncv) { float d[4]; dot4(qs, KC + (size_t)n * 64, d); const int bk = t5_bucket(q - (16 * n + 31));
#pragma unroll
                for (int h = 0; h < 4; ++h) { const float s = d[h] + rel[bk * 16 + g * 4 + h] * LOG2E; sc[h * 512 + n] = s; mx[h] = fmaxf(mx[h], s); } }
            else {
#pragma unroll
                for (int h = 0; h < 4; ++h) sc[h * 512 + n] = 0.f; } }
        float ls[4] = {0.f, 0.f, 0.f, 0.f};
#pragma unroll
        for (int h = 0; h < 4; ++h) mx[h] = wave_max(mx[h]);
        WFENCE();
        for (int i = 0; i < 8; ++i) { const int n = lane + 64 * i;
            if (n < ncv) {
#pragma unroll
                for (int h = 0; h < 4; ++h) { const float e = exp2f(sc[h * 512 + n] - mx[h]); sc[h * 512 + n] = e; ls[h] += e; } } }
#pragma unroll
        for (int h = 0; h < 4; ++h) ls[h] = 1.f / fmaxf(wave_sum(ls[h]), 1e-20f);
        for (int i = 0; i < 8; ++i) { const int n = lane + 64 * i;
            if (n < ncv) {
#pragma unroll
                for (int h = 0; h < 4; ++h) sc[h * 512 + n] *= ls[h]; } }
        WFENCE();
        float v0, v1;
        { float t[2];
#pragma unroll
          for (int jj = 0; jj < 2; ++jj) { const int j = lane + 64 * jj; float v = 0.f;
              for (int n = 4 * j - 1; n <= 4 * j + 3; ++n) if (n >= 0 && n < 511) v += (sc[n] + sc[512 + n]) + (sc[1024 + n] + sc[1536 + n]);
              const bool forced = (j == 0) || (j == cur) || (j == cur - 1);
              t[jj] = forced ? 1e9f : (j <= cur ? v : -1e30f); }
          v0 = t[0]; v1 = t[1]; }
        bool sel0 = false, sel1 = false;
        for (int it = 0; it < 16; ++it) {
            const float c0 = sel0 ? -INFINITY : v0, c1 = sel1 ? -INFINITY : v1;
            const float mxv = wave_max(fmaxf(c0, c1));
            const unsigned long long m0 = __ballot(!sel0 && v0 == mxv);
            if (m0) { const int idx = __builtin_ctzll(m0); if (lane == idx) sel0 = true; }
            else { const unsigned long long m1 = __ballot(!sel1 && v1 == mxv); const int idx = m1 ? __builtin_ctzll(m1) : -1; if (lane == idx) sel1 = true; }
        }
        sel0 = sel0 && (lane <= cur); sel1 = sel1 && (lane + 64 <= cur);
        const unsigned long long sm0 = __ballot(sel0), sm1 = __ballot(sel1);
        float oc[4] = {0.f, 0.f, 0.f, 0.f};
        for (int n = 0; n < ncv; ++n) { const float vv = bf2f(VC[(size_t)n * 64 + lane]);
#pragma unroll
            for (int h = 0; h < 4; ++h) oc[h] += sc[h * 512 + n] * vv; }
        float ms[4] = {-1e30f, -1e30f, -1e30f, -1e30f}, lsel[4] = {0.f, 0.f, 0.f, 0.f}, os[4] = {0.f, 0.f, 0.f, 0.f};
        for (int j = 0; j <= cur; ++j) {
            const bool on = j < 64 ? ((sm0 >> j) & 1ull) : ((sm1 >> (j - 64)) & 1ull);
            if (!on) continue;
            const int kpos = 64 * j + lane; const bool valid = kpos <= q;
            float d[4]; dot4(qs, Y + ((size_t)b * S_ + kpos) * YP + Y_AKS + g * 64, d);
            const int bk = t5_bucket(q - kpos);
            WFENCE();
#pragma unroll
            for (int h = 0; h < 4; ++h) { const float s = valid ? d[h] + rel[bk * 16 + g * 4 + h] * LOG2E : -1e30f;
                const float mn = fmaxf(ms[h], wave_max(s)); const float p = valid ? exp2f(s - mn) : 0.f; s2[h * 64 + lane] = p;
                const float scl = exp2f(ms[h] - mn); lsel[h] = lsel[h] * scl + wave_sum(p); os[h] *= scl; ms[h] = mn; }
            WFENCE();
            const bf16* vb = Y + ((size_t)b * S_ + 64 * j) * YP + Y_AVS + g * 64 + lane;
            for (int kk = 0; kk < 64; ++kk) { const float vv = bf2f(vb[(size_t)kk * YP]);
#pragma unroll
                for (int h = 0; h < 4; ++h) os[h] += s2[h * 64 + kk] * vv; }
        }
        float mw[4] = {-1e30f, -1e30f, -1e30f, -1e30f}, lw[4] = {0.f, 0.f, 0.f, 0.f}, ow[4] = {0.f, 0.f, 0.f, 0.f};
        for (int c = 0; c < 8; ++c) {
            if (q - 64 * c < 0) break;
            const int dist = 64 * c + lane, kpos = q - dist; const bool valid = kpos >= 0;
            float d[4]; dot4(qs, Y + ((size_t)b * S_ + (valid ? kpos : 0)) * YP + Y_AKW + g * 64, d);
            const int bk = t5_bucket(dist);
            WFENCE();
#pragma unroll
            for (int h = 0; h < 4; ++h) { const float s = valid ? d[h] + rel[bk * 16 + g * 4 + h] * LOG2E : -1e30f;
                const float mn = fmaxf(mw[h], wave_max(s)); const float p = valid ? exp2f(s - mn) : 0.f; s2[h * 64 + lane] = p;
                const float scl = exp2f(mw[h] - mn); lw[h] = lw[h] * scl + wave_sum(p); ow[h] *= scl; mw[h] = mn; }
            WFENCE();
            for (int kk = 0; kk < 64; ++kk) { const int kp = q - 64 * c - kk; if (kp < 0) break;
                const float vv = bf2f(Y[((size_t)b * S_ + kp) * YP + Y_AVW + g * 64 + lane]);
#pragma unroll
                for (int h = 0; h < 4; ++h) ow[h] += s2[h * 64 + kk] * vv; }
        }
        WFENCE();
#pragma unroll
        for (int h = 0; h < 4; ++h) { const float o = gt[h][0] * oc[h] + gt[h][1] * os[h] / fmaxf(lsel[h], 1e-20f) + gt[h][2] * ow[h] / fmaxf(lw[h], 1e-20f);
            Yr[Y_AQ + (g * 4 + h) * 64 + lane] = (bf16)f2bf(o); }
    }
}
__device__ __forceinline__ void moba_naive(Frame& F, const Args& a) {
    const int gw = blockIdx.x * NWAVES + F.wave, NGW = F.G * NWAVES, lane = F.lane;
    bf16* Y = (bf16*)(a.ws + WS_Y); const float* rel = a.in[1]; const float* KM = (const float*)(a.ws + WS_KMEAN);
    LAS float* scr = (LAS float*)(F.lds + RING_OFF + F.wave * 16384);
    LAS float* qs = scr; LAS float* s2 = scr + 64;
    for (int task = gw; task < 32 * S_; task += NGW) {
        const int q = task & (S_ - 1), bh = task >> 13, h = bh & 7, b = bh >> 3;
        const size_t row = (size_t)b * S_ + q; bf16* Yr = Y + row * YP;
        WFENCE();
        qs[lane] = bf2f(Yr[Y_CQ + h * 64 + lane]);
        WFENCE();
        const int cur = q >> 8;
        float gs = -1e30f;
        if (lane < 32 && lane < cur) { const float* km = KM + ((size_t)bh * 32 + lane) * 64; float d = 0.f;
            for (int dd = 0; dd < 64; ++dd) d += qs[dd] * km[dd];
            gs = d; }
        if (lane >= 32) gs = -INFINITY;
        bool sel = false;
        for (int it = 0; it < 3; ++it) { const float c = sel ? -INFINITY : gs; const float mxv = wave_max(c);
            const unsigned long long m0 = __ballot(!sel && lane < 32 && gs == mxv); const int idx = m0 ? __builtin_ctzll(m0) : -1; if (lane == idx) sel = true; }
        sel = sel && (lane < cur);
        const unsigned smask = (unsigned)__ballot(sel);
        float mr = -1e30f, lr = 0.f, o = 0.f;
        for (int j = 0; j <= cur; ++j) {
            const bool own = (j == cur);
            if (!own && !((smask >> j) & 1u)) continue;
            for (int c = 0; c < 4; ++c) {
                const int kpos = 256 * j + 64 * c + lane; const bool valid = kpos <= q;
                if (256 * j + 64 * c > q) break;
                const float d = dot1(qs, Y + ((size_t)b * S_ + kpos) * YP + Y_CK + h * 64);
                const int bk = t5_bucket(q - kpos);
                const float s = valid ? d + rel[bk * 16 + 8 + h] * LOG2E : -1e30f;
                const float mn = fmaxf(mr, wave_max(s)); const float p = valid ? exp2f(s - mn) : 0.f;
                WFENCE(); s2[lane] = p; WFENCE();
                const float scl = exp2f(mr - mn); lr = lr * scl + wave_sum(p); o *= scl; mr = mn;
                const bf16* vb = Y + ((size_t)b * S_ + 256 * j + 64 * c) * YP + Y_CV + h * 64 + lane;
                for (int kk = 0; kk < 64; ++kk) o += s2[kk] * bf2f(vb[(size_t)kk * YP]);
            }
        }
        Yr[Y_CQ + h * 64 + lane] = (bf16)f2bf(o / fmaxf(lr, 1e-20f));
    }
}
constexpr int CW_Q = 8192;
__device__ __forceinline__ int next_unit(Frame& F, int k) {
    __syncthreads();
    if (F.tid == 0) F.MISC[16] = __hip_atomic_fetch_add(F.ctl + CW_Q + 64 * k, 1u, RLX_AGENT);
    __syncthreads();
    return (int)F.MISC[16];
}
__device__ __forceinline__ void moba_fast(Frame& F, const Args& a, int qk) {
    bf16* Y = (bf16*)(a.ws + WS_Y); const float* KM = (const float*)(a.ws + WS_KMEAN);
    for (;;) {
        const int u = next_unit(F, qk); if (u >= 1024) break;
        const int qb = 31 - (u >> 5), bh = u & 31, b = bh >> 3, h = bh & 7; const long rowbase = (long)b * S_;
        attn::UArgs U{};
        U.Qb = Y + (rowbase + qb * 256) * YP + Y_CQ + h * 64; U.Kh = Y + rowbase * YP + Y_CK + h * 64; U.Vh = Y + rowbase * YP + Y_CV + h * 64; U.Ob = Y + (rowbase + qb * 256) * YP + Y_CQ + h * 64;
        U.NT = 4 * (qb + 1); U.q0 = qb * 256; U.kt0 = 0; U.hc = 8 + h; U.rel = a.in[1]; U.km = KM + (size_t)bh * 32 * 64; U.qb = qb;
        attn::attn_unit<0, 0, 8>(U, (char*)F.lds + RING_OFF);
    }
}
__device__ __forceinline__ void nsa_fast(Frame& F, const Args& a, int qk) {
    bf16* Y = (bf16*)(a.ws + WS_Y);
    for (;;) {
        const int u = next_unit(F, qk); if (u >= 1024) break;
        const int qb = 31 - (u >> 5), bh = u & 31, b = bh >> 3, h = bh & 7, g = h >> 2; const long rowbase = (long)b * S_; const int q0 = qb * 256;
        attn::UArgs U{};
        U.Qb = Y + (rowbase + q0) * YP + Y_AQ + h * 64; U.Ob = Y + (rowbase + q0) * YP + Y_AQ + h * 64; U.q0 = q0; U.hc = h; U.rel = a.in[1]; U.gate = Y + (rowbase + q0) * YP;
        { const int T0 = 4 * qb - 8 > 0 ? 4 * qb - 8 : 0;
          U.Kh = Y + (rowbase + 64 * T0) * YP + Y_AKW + g * 64; U.Vh = Y + (rowbase + 64 * T0) * YP + Y_AVW + g * 64; U.NT = 4 * qb + 4 - T0; U.kt0 = 64 * T0; U.gcol = Y_AG + h * 3 + 2;
          attn::attn_unit<2, 1, 8>(U, (char*)F.lds + RING_OFF); }
        { U.Kh = Y + rowbase * YP + Y_AKS + g * 64; U.Vh = Y + rowbase * YP + Y_AVS + g * 64; U.NT = 4 * (qb + 1); U.kt0 = 0; U.gcol = Y_AG + h * 3 + 1;
          U.selg = (const unsigned*)(a.ws + WS_MASK) + ((size_t)(b * 2 + g) * S_ + q0) * 4; U.tmp = (const bf16*)(a.ws + WS_OATMP) + (rowbase + q0) * 512 + h * 64;
          attn::attn_unit<1, 2, 8>(U, (char*)F.lds + RING_OFF); }
    }
}
typedef float f32x16g __attribute__((ext_vector_type(16)));
constexpr int GP = 72;
constexpr int GL_GS = 0;
constexpr int GL_VT = 16640 + 0;
constexpr int GL_A0 = GL_VT + 128 * GP * 2;
constexpr int GL_A1 = GL_A0 + 64 * GP * 2;
constexpr int GL_A2 = GL_A1 + 64 * GP * 2;
constexpr int GL_SS = GL_A2 + 64 * GP * 2;
constexpr int GL_END = GL_SS + 1024;
static_assert(GL_END <= RING_BYTES, "GLA LDS map");
__device__ __forceinline__ int crow32(int r, int hi) { return (r & 3) + 8 * (r >> 2) + 4 * hi; }
__device__ __forceinline__ void gla_bcum(Frame& F, const Args& a, int l, const bf16* Yc  , int h) {
    LAS float* gS = (LAS float*)(F.lds + RING_OFF + GL_GS);
    const int t = F.tid >> 3, dg = F.tid & 7;
    const float* w2 = a.in[13] + (size_t)l * 16 * 256 + h * 64 + dg * 8; const float* bias = a.in[14] + (size_t)l * 256 + h * 64 + dg * 8;
    float blr[16];
    { const v4u w0 = *(const v4u*)(Yc + (size_t)t * YP + Y_BLR), w1 = *(const v4u*)(Yc + (size_t)t * YP + Y_BLR + 8); float k0[8], k1[8]; unpack8(w0, k0); unpack8(w1, k1);
#pragma unroll
      for (int i = 0; i < 8; ++i) { blr[i] = k0[i]; blr[8 + i] = k1[i]; } }
    float z[8];
#pragma unroll
    for (int i = 0; i < 8; ++i) z[i] = bias[i];
#pragma unroll
    for (int r = 0; r < 16; ++r) { const f32x4 wa = *(const f32x4*)(w2 + r * 256), wb = *(const f32x4*)(w2 + r * 256 + 4);
        z[0] += blr[r] * wa.x; z[1] += blr[r] * wa.y; z[2] += blr[r] * wa.z; z[3] += blr[r] * wa.w; z[4] += blr[r] * wb.x; z[5] += blr[r] * wb.y; z[6] += blr[r] * wb.z; z[7] += blr[r] * wb.w; }
#pragma unroll
    for (int i = 0; i < 8; ++i) { const float zz = z[i]; gS[t * 65 + dg * 8 + i] = -(fmaxf(-zz, 0.f) + log1pf(__expf(-fabsf(zz)))) * (1.f / 16.f); }
    __syncthreads();
    if (F.tid < 64) { float acc = 0.f;
#pragma unroll 8
        for (int tt = 0; tt < 64; ++tt) { acc += gS[tt * 65 + F.tid]; gS[tt * 65 + F.tid] = acc; } }
    __syncthreads();
}
__device__ __forceinline__ void gla_stage_vT(Frame& F, const bf16* Yc, int h) {
    LAS bf16* vT = (LAS bf16*)(F.lds + RING_OFF + GL_VT); const int t = F.tid >> 3, dg = F.tid & 7;
    const v4u w0 = *(const v4u*)(Yc + (size_t)t * YP + Y_BV + h * 128 + dg * 16), w1 = *(const v4u*)(Yc + (size_t)t * YP + Y_BV + h * 128 + dg * 16 + 8);
    const unsigned ww[8] = {w0.x, w0.y, w0.z, w0.w, w1.x, w1.y, w1.z, w1.w};
#pragma unroll
    for (int i = 0; i < 8; ++i) { vT[(dg * 16 + 2 * i) * GP + t] = (bf16)(ww[i] & 0xffffu); vT[(dg * 16 + 2 * i + 1) * GP + t] = (bf16)(ww[i] >> 16); }
}
__device__ __forceinline__ bf16x8 lds_frag(const LAS bf16* X, int row, int kk) { return *(const LAS bf16x8*)(X + row * GP + kk); }
__device__ __forceinline__ void gla_g1(Frame& F, const Args& a, int l) {
    const bf16* Y = (const bf16*)(a.ws + WS_Y); bf16* GST = (bf16*)(a.ws + WS_GST); float* DEC = (float*)(a.ws + WS_GDEC);
    LAS float* gS = (LAS float*)(F.lds + RING_OFF + GL_GS); LAS bf16* vT = (LAS bf16*)(F.lds + RING_OFF + GL_VT); LAS bf16* kT = (LAS bf16*)(F.lds + RING_OFF + GL_A0);
    const int lane = F.lane, r32 = lane & 31, hi = lane >> 5, w = F.wave;
    for (int u = blockIdx.x; u < 2048; u += F.G) {
        const int c = u & 127, bh = u >> 7, h = bh & 3, b = bh >> 2; const bf16* Yc = Y + ((size_t)b * S_ + c * 64) * YP;
        gla_bcum(F, a, l, Yc, h);
        { const int t = F.tid >> 3, dg = F.tid & 7; const v4u kw = *(const v4u*)(Yc + (size_t)t * YP + Y_BK + h * 64 + dg * 8); float kk[8]; unpack8(kw, kk);
#pragma unroll
          for (int i = 0; i < 8; ++i) { const int d = dg * 8 + i; kT[d * GP + t] = (bf16)f2bf(kk[i] * __expf(gS[63 * 65 + d] - gS[t * 65 + d])); }
          if (F.tid < 64) DEC[(size_t)u * 64 + F.tid] = __expf(gS[63 * 65 + F.tid]); }
        gla_stage_vT(F, Yc, h);
        __syncthreads();
        { const int et = w >> 1, dt = w & 1; f32x16g acc = {};
#pragma unroll
          for (int ks = 0; ks < 4; ++ks) acc = __builtin_amdgcn_mfma_f32_32x32x16_bf16(lds_frag(vT, et * 32 + r32, ks * 16 + hi * 8), lds_frag(kT, dt * 32 + r32, ks * 16 + hi * 8), acc, 0, 0, 0);
          bf16* slot = GST + (size_t)u * 8192;
#pragma unroll
          for (int r = 0; r < 16; ++r) slot[(et * 32 + crow32(r, hi)) * 64 + dt * 32 + r32] = (bf16)f2bf(acc[r]); }
        __syncthreads();
    }
}
__device__ __forceinline__ void gla_g2(Frame& F, const Args& a) {
    unsigned* GST = (unsigned*)(a.ws + WS_GST); const float* DEC = (const float*)(a.ws + WS_GDEC);
    for (int i = blockIdx.x * 512 + F.tid; i < 16 * 128 * 32; i += F.G * 512) {
        const int dp = i & 31, bh = i >> 12; const int eo = (i >> 5) & 127;
        float s0 = 0.f, s1 = 0.f;
        for (int c0 = 0; c0 < 128; c0 += 8) {
            unsigned uu[8]; float d0[8], d1[8];
#pragma unroll
            for (int j = 0; j < 8; ++j) { const size_t sl = (size_t)(bh * 128 + c0 + j); uu[j] = GST[sl * 4096 + eo * 32 + dp]; d0[j] = DEC[sl * 64 + 2 * dp]; d1[j] = DEC[sl * 64 + 2 * dp + 1]; }
#pragma unroll
            for (int j = 0; j < 8; ++j) { const size_t sl = (size_t)(bh * 128 + c0 + j); GST[sl * 4096 + eo * 32 + dp] = pk2(s0, s1);
                s0 = s0 * d0[j] + __uint_as_float(uu[j] << 16); s1 = s1 * d1[j] + __uint_as_float(uu[j] & 0xffff0000u); }
        }
    }
}
__device__ __forceinline__ void gla_g3(Frame& F, const Args& a, int l) {
    bf16* Y = (bf16*)(a.ws + WS_Y); const bf16* GST = (const bf16*)(a.ws + WS_GST); const float* nw = a.in[15] + (size_t)l * 128;
    LAS float* gS = (LAS float*)(F.lds + RING_OFF + GL_GS); LAS bf16* vT = (LAS bf16*)(F.lds + RING_OFF + GL_VT);
    LAS bf16* qd = (LAS bf16*)(F.lds + RING_OFF + GL_A0); LAS bf16* kd = (LAS bf16*)(F.lds + RING_OFF + GL_A1); LAS bf16* at = (LAS bf16*)(F.lds + RING_OFF + GL_A2);
    LAS float* ssq = (LAS float*)(F.lds + RING_OFF + GL_SS);
    const int lane = F.lane, r32 = lane & 31, hi = lane >> 5, w = F.wave;
    for (int u = blockIdx.x; u < 2048; u += F.G) {
        const int c = u & 127, bh = u >> 7, h = bh & 3, b = bh >> 2; bf16* Yc = Y + ((size_t)b * S_ + c * 64) * YP;
        gla_bcum(F, a, l, Yc, h);
        { const int t = F.tid >> 3, dg = F.tid & 7; const v4u qw = *(const v4u*)(Yc + (size_t)t * YP + Y_BQ + h * 64 + dg * 8), kw = *(const v4u*)(Yc + (size_t)t * YP + Y_BK + h * 64 + dg * 8);
          float qq[8], kk[8]; unpack8(qw, qq); unpack8(kw, kk); v4u qo, ko; unsigned qa[4], ka[4];
#pragma unroll
          for (int i = 0; i < 4; ++i) { const float g0 = gS[t * 65 + dg * 8 + 2 * i], g1 = gS[t * 65 + dg * 8 + 2 * i + 1];
              qa[i] = pk2(qq[2 * i] * __expf(g0), qq[2 * i + 1] * __expf(g1)); ka[i] = pk2(kk[2 * i] * __expf(-g0), kk[2 * i + 1] * __expf(-g1)); }
          qo.x = qa[0]; qo.y = qa[1]; qo.z = qa[2]; qo.w = qa[3]; ko.x = ka[0]; ko.y = ka[1]; ko.z = ka[2]; ko.w = ka[3];
          *(LAS v4u*)(qd + t * GP + dg * 8) = qo; *(LAS v4u*)(kd + t * GP + dg * 8) = ko; }
        gla_stage_vT(F, Yc, h);
        __syncthreads();
        if (w < 4) { const int ib = w >> 1, jb = w & 1;
            if (jb <= ib) { f32x16g acc = {};
#pragma unroll
                for (int ks = 0; ks < 4; ++ks) acc = __builtin_amdgcn_mfma_f32_32x32x16_bf16(lds_frag(qd, ib * 32 + r32, ks * 16 + hi * 8), lds_frag(kd, jb * 32 + r32, ks * 16 + hi * 8), acc, 0, 0, 0);
#pragma unroll
                for (int r = 0; r < 16; ++r) { const int i = ib * 32 + crow32(r, hi), j = jb * 32 + r32; at[i * GP + j] = (bf16)f2bf(j <= i ? acc[r] : 0.f); } } }
        __syncthreads();
        { const int rb = w >> 2, et = w & 3; f32x16g acc = {};
          const bf16* slot = GST + (size_t)u * 8192 + (size_t)(et * 32 + r32) * 64 + hi * 8;
#pragma unroll
          for (int ks = 0; ks < 4; ++ks) { const bf16x8 sb = *(const bf16x8*)(slot + ks * 16);
              acc = __builtin_amdgcn_mfma_f32_32x32x16_bf16(lds_frag(qd, rb * 32 + r32, ks * 16 + hi * 8), sb, acc, 0, 0, 0); }
          for (int ks = 0; ks < 2 * (rb + 1); ++ks) acc = __builtin_amdgcn_mfma_f32_32x32x16_bf16(lds_frag(at, rb * 32 + r32, ks * 16 + hi * 8), lds_frag(vT, et * 32 + r32, ks * 16 + hi * 8), acc, 0, 0, 0);
          float sq[16];
#pragma unroll
          for (int r = 0; r < 16; ++r) { float v = acc[r] * acc[r];
              v += __shfl_xor(v, 1); v += __shfl_xor(v, 2); v += __shfl_xor(v, 4); v += __shfl_xor(v, 8); v += __shfl_xor(v, 16); sq[r] = v; }
          if (r32 == 0) {
#pragma unroll
              for (int r = 0; r < 16; ++r) ssq[w * 32 + crow32(r, hi)] = sq[r]; }
          __syncthreads();
          const float nwe = nw[et * 32 + r32];
#pragma unroll
          for (int r = 0; r < 16; ++r) { const int tr = crow32(r, hi); const float tot = ssq[(rb * 4 + 0) * 32 + tr] + ssq[(rb * 4 + 1) * 32 + tr] + ssq[(rb * 4 + 2) * 32 + tr] + ssq[(rb * 4 + 3) * 32 + tr];
              bf16* yp = Yc + (size_t)(rb * 32 + tr) * YP + Y_BR + h * 128 + et * 32 + r32; const float rv = bf2f(*yp);
              *yp = (bf16)f2bf(acc[r] * rsqrtf(tot * (1.f / 128.f) + NORM_EPS) * nwe * (rv * sigm(rv))); } }
        __syncthreads();
    }
}
constexpr int CL_IMP = 0, CL_BIAS = 64 * 129 * 4, CL_END = CL_BIAS + 2048;
__device__ __forceinline__ int red8(int v) { v += __shfl_xor(v, 1); v += __shfl_xor(v, 2); v += __shfl_xor(v, 4); return v; }
__device__ __forceinline__ void nsa_cmp_fast(Frame& F, const Args& a, int qk) {
    const bf16* Y = (const bf16*)(a.ws + WS_Y); const float* rel = a.in[1];
    LAS unsigned* impI = (LAS unsigned*)(F.lds + RING_OFF + CL_IMP); LAS float* biasT = (LAS float*)(F.lds + RING_OFF + CL_BIAS);
    const int lane = F.lane, r32 = lane & 31, hi = lane >> 5, w = F.wave, hr = w >> 1, qh = w & 1;
    for (;;) {
        const int u = next_unit(F, qk); if (u >= 1024) break;
        const int c = 127 - (u >> 3), bg = u & 7, g = bg & 1, b = bg >> 1, q0 = 64 * c; const size_t rowbase = (size_t)b * S_;
        for (int i = F.tid; i < 64 * 129; i += 512) impI[i] = 0u;
        { const int hh = F.tid >> 7, dd = F.tid & 127; biasT[F.tid] = (rel[t5_bucket(dd) * 16 + g * 4 + hh] - rel[31 * 16 + g * 4 + hh]) * LOG2E; }
        __syncthreads();
        const int head = g * 4 + hr, qw0 = q0 + qh * 32, qpos = qw0 + r32;
        const bf16* Qw = Y + (rowbase + qw0) * YP + Y_AQ + head * 64;
        bf16x8 qr[4];
#pragma unroll
        for (int ks = 0; ks < 4; ++ks) qr[ks] = *(const bf16x8*)(Qw + (size_t)r32 * YP + ks * 16 + hi * 8);
        const bf16* KC = (const bf16*)(a.ws + WS_KCMP) + (size_t)bg * 512 * 64; const bf16* VT = (const bf16*)(a.ws + WS_VCMPT) + (size_t)bg * 64 * 512;
        const int NTw = (qw0 / 16 + 1 + 31) >> 5;
        const LAS float* bT = biasT + hr * 128;
        float lsum = 0.f;
        for (int nt = 0; nt < NTw; ++nt) { f32x16g C = {};
#pragma unroll
            for (int ks = 0; ks < 4; ++ks) { const bf16x8 kf = *(const bf16x8*)(KC + (size_t)(nt * 32 + r32) * 64 + ks * 16 + hi * 8); C = __builtin_amdgcn_mfma_f32_32x32x16_bf16(kf, qr[ks], C, 0, 0, 0); }
#pragma unroll
            for (int r = 0; r < 16; ++r) { const int dist = qpos - (16 * (nt * 32 + crow32(r, hi)) + 31); lsum += dist >= 0 ? exp2f(fminf(C[r] + bT[dist > 127 ? 127 : (dist < 0 ? 0 : dist)], 100.f)) : 0.f; } }
        { auto rr = __builtin_amdgcn_permlane32_swap(__float_as_uint(lsum), __float_as_uint(lsum), false, false); lsum = __uint_as_float(rr[0]) + __uint_as_float(rr[1]); }
        const float inv = 1.f / fmaxf(lsum, 1e-30f);
        f32x16g o0 = {}, o1 = {};
        for (int nt = 0; nt < NTw; ++nt) { f32x16g C = {};
#pragma unroll
            for (int ks = 0; ks < 4; ++ks) { const bf16x8 kf = *(const bf16x8*)(KC + (size_t)(nt * 32 + r32) * 64 + ks * 16 + hi * 8); C = __builtin_amdgcn_mfma_f32_32x32x16_bf16(kf, qr[ks], C, 0, 0, 0); }
            float p[16];
#pragma unroll
            for (int r = 0; r < 16; ++r) { const int dist = qpos - (16 * (nt * 32 + crow32(r, hi)) + 31); p[r] = dist >= 0 ? exp2f(fminf(C[r] + bT[dist > 127 ? 127 : (dist < 0 ? 0 : dist)], 100.f)) * inv : 0.f; }
#pragma unroll
            for (int m = 0; m < 4; ++m) { const float G = (p[4 * m] + p[4 * m + 1]) + (p[4 * m + 2] + p[4 * m + 3]); const int j = nt * 8 + 2 * m + hi;
                LAS unsigned* ip = impI + (qh * 32 + r32) * 129 + j;
                __hip_atomic_fetch_add(ip, (unsigned)(G * 67108864.f + 0.5f), __ATOMIC_RELAXED, __HIP_MEMORY_SCOPE_WORKGROUP);
                if (j + 1 < 128) __hip_atomic_fetch_add(ip + 1, (unsigned)(p[4 * m + 3] * 67108864.f + 0.5f), __ATOMIC_RELAXED, __HIP_MEMORY_SCOPE_WORKGROUP); }
            v4u pw0, pw1; pw0.x = pk2(p[0], p[1]); pw0.y = pk2(p[2], p[3]); pw0.z = pk2(p[4], p[5]); pw0.w = pk2(p[6], p[7]); pw1.x = pk2(p[8], p[9]); pw1.y = pk2(p[10], p[11]); pw1.z = pk2(p[12], p[13]); pw1.w = pk2(p[14], p[15]);
            const bf16x8 pa0 = __builtin_bit_cast(bf16x8, pw0), pa1 = __builtin_bit_cast(bf16x8, pw1);
            typedef unsigned u32x2g __attribute__((ext_vector_type(2)));
#pragma unroll
            for (int dt = 0; dt < 2; ++dt)
#pragma unroll
                for (int kk = 0; kk < 2; ++kk) { const bf16* vp = VT + (size_t)(dt * 32 + r32) * 512 + nt * 32 + kk * 16 + 4 * hi;
                    const u32x2g va = *(const u32x2g*)vp, vb = *(const u32x2g*)(vp + 8); v4u vv; vv.x = va.x; vv.y = va.y; vv.z = vb.x; vv.w = vb.y;
                    if (dt == 0) o0 = __builtin_amdgcn_mfma_f32_32x32x16_bf16(kk ? pa1 : pa0, __builtin_bit_cast(bf16x8, vv), o0, 0, 0, 0);
                    else o1 = __builtin_amdgcn_mfma_f32_32x32x16_bf16(kk ? pa1 : pa0, __builtin_bit_cast(bf16x8, vv), o1, 0, 0, 0); } }
        { bf16* T = (bf16*)(a.ws + WS_OATMP);
#pragma unroll
          for (int r = 0; r < 16; ++r) { const size_t row = rowbase + qw0 + crow32(r, hi); const float gs = sigm(bf2f(Y[row * YP + Y_AG + head * 3]));
              T[row * 512 + head * 64 + r32] = (bf16)f2bf(gs * o0[r]); T[row * 512 + head * 64 + 32 + r32] = (bf16)f2bf(gs * o1[r]); } }
        __syncthreads();
        { const int qi = F.tid >> 3, part = F.tid & 7, cur = c; unsigned key[16];
#pragma unroll
          for (int i = 0; i < 16; ++i) { const int j = part * 16 + i; const unsigned raw = impI[qi * 129 + j] >> 6; const bool forced = (j == 0) || (j == cur) || (j == cur - 1);
              key[i] = forced ? (0xFFFFFF80u | (unsigned)(127 - j)) : (j <= cur ? ((((raw > 33554430u ? 33554430u : raw) + 1u) << 7) | (unsigned)(127 - j)) : (unsigned)(127 - j)); }
          unsigned T = 0u;
          for (int bit = 31; bit >= 0; --bit) { const unsigned Tt = T | (1u << bit); int cnt = 0;
#pragma unroll
              for (int i = 0; i < 16; ++i) cnt += key[i] >= Tt ? 1 : 0;
              cnt = red8(cnt); if (cnt >= 16) T = Tt; }
          unsigned bits = 0u;
#pragma unroll
          for (int i = 0; i < 16; ++i) bits |= (key[i] >= T && (part * 16 + i) <= cur) ? (1u << i) : 0u;
          ((unsigned short*)(a.ws + WS_MASK))[((size_t)bg * S_ + q0 + qi) * 8 + part] = (unsigned short)bits; }
    }
}
constexpr int CP_RED = 0, CP_HS = 8 * 32 * 64 * 4, CP_END = CP_HS + 32 * GP * 2;
static_assert(CP_END <= RING_BYTES, "compress LDS map");
__device__ __forceinline__ void compress_fast(Frame& F, const Args& a) {
    const bf16* Y = (const bf16*)(a.ws + WS_Y);
    LAS float* red = (LAS float*)(F.lds + RING_OFF + CP_RED); LAS bf16* hs = (LAS bf16*)(F.lds + RING_OFF + CP_HS);
    const int lane = F.lane, r32 = lane & 31, hi = lane >> 5, w = F.wave;
    for (int u = blockIdx.x; u < 256; u += F.G) {
        const int nt = u & 15, bg = (u >> 4) & 7, kv = u >> 7, g = bg & 1, b = bg >> 1;
        const int n = nt * 32 + r32, nn = n > 510 ? 510 : n;
        const bf16* xrow = Y + ((size_t)b * S_ + 16 * nn) * YP + (kv ? Y_AVC : Y_AKC) + g * 64 + hi * 8;
        const bf16* W1T = (const bf16*)(a.ws + WS_CW1T) + (size_t)kv * 64 * 2048;
        f32x16g acc0 = {}, acc1 = {};
#pragma unroll 4
        for (int s = 0; s < 16; ++s) { const int ks = w * 16 + s, pos = ks >> 2;
            const bf16x8 af = *(const bf16x8*)(xrow + (size_t)pos * YP + (ks & 3) * 16);
            const bf16x8 b0 = *(const bf16x8*)(W1T + (size_t)r32 * 2048 + ks * 16 + hi * 8), b1 = *(const bf16x8*)(W1T + (size_t)(32 + r32) * 2048 + ks * 16 + hi * 8);
            acc0 = __builtin_amdgcn_mfma_f32_32x32x16_bf16(af, b0, acc0, 0, 0, 0); acc1 = __builtin_amdgcn_mfma_f32_32x32x16_bf16(af, b1, acc1, 0, 0, 0); }
#pragma unroll
        for (int r = 0; r < 16; ++r) { red[(w * 32 + crow32(r, hi)) * 64 + r32] = acc0[r]; red[(w * 32 + crow32(r, hi)) * 64 + 32 + r32] = acc1[r]; }
        __syncthreads();
        { const float* c0 = (const float*)(a.ws + WS_CC0) + kv * 64;
#pragma unroll
          for (int i = 0; i < 4; ++i) { const int e = F.tid * 4 + i, rn = e >> 6, j = e & 63; float v = c0[j];
#pragma unroll
              for (int ww = 0; ww < 8; ++ww) v += red[(ww * 32 + rn) * 64 + j];
              hs[rn * GP + j] = (bf16)f2bf(gelu_tanh(v)); } }
        __syncthreads();
        if (w < 2) { const bf16* W2T = (const bf16*)(a.ws + WS_CW2T) + (size_t)kv * 64 * 64; f32x16g o = {};
#pragma unroll
            for (int ks = 0; ks < 4; ++ks) { const bf16x8 bf = *(const bf16x8*)(W2T + (size_t)(w * 32 + r32) * 64 + ks * 16 + hi * 8);
                o = __builtin_amdgcn_mfma_f32_32x32x16_bf16(lds_frag(hs, r32, ks * 16 + hi * 8), bf, o, 0, 0, 0); }
#pragma unroll
            for (int r = 0; r < 16; ++r) { const int rn = nt * 32 + crow32(r, hi), jp = w * 32 + r32;
                if (kv == 0) ((bf16*)(a.ws + WS_KCMP))[((size_t)bg * 512 + rn) * 64 + jp] = (bf16)f2bf(o[r]);
                else ((bf16*)(a.ws + WS_VCMPT))[((size_t)bg * 64 + jp) * 512 + rn] = (bf16)f2bf(o[r]); } }
        __syncthreads();
    }
}
__device__ __forceinline__ void gla_out_naive(Frame& F, const Args& a, int l) {
    const int gw = blockIdx.x * NWAVES + F.wave, NGW = F.G * NWAVES, lane = F.lane;
    bf16* Y = (bf16*)(a.ws + WS_Y); const bf16* O16 = (const bf16*)(a.ws + WS_O16); const float* nw = a.in[15] + (size_t)l * 128;
    for (int t = gw; t < M_ * 4; t += NGW) {
        const int h = t & 3; const size_t row = (size_t)(t >> 2);
        const float o0 = bf2f(O16[row * 512 + h * 128 + lane]), o1 = bf2f(O16[row * 512 + h * 128 + 64 + lane]);
        const float r = rsqrtf(wave_sum(o0 * o0 + o1 * o1) * (1.f / 128.f) + NORM_EPS);
        bf16* yr = Y + row * YP + Y_BR + h * 128;
        const float r0 = bf2f(yr[lane]), r1 = bf2f(yr[64 + lane]);
        yr[lane] = (bf16)f2bf(o0 * r * nw[lane] * (r0 * sigm(r0))); yr[64 + lane] = (bf16)f2bf(o1 * r * nw[64 + lane] * (r1 * sigm(r1)));
    }
}

constexpr int PPL = 11, NPH = NL * PPL;
#define IN(k) (lo <= (k) && (k) < hi)
#define SEAM(k) do { if (IN(k) && IN((k) + 1)) xcd_barrier(bar); } while (0)
template <int l> __device__ __forceinline__ void layer_body(Frame& F, const Args& args, const XcdBarrier& bar, const int lo, const int hi) {
    unsigned char* ws = args.ws;
    bf16* H = (bf16*)(ws + WS_H); bf16* Y = (bf16*)(ws + WS_Y); unsigned char* G8 = ws + WS_G8;
    float* Yf = (float*)(ws + WS_Y); bf16* ACT = (bf16*)(ws + WS_ACT);
    constexpr int p0 = l * PPL;
    const float* xin = l == 0 ? args.in[0] : args.out;
    if (IN(p0 + 0)) { phase_weights(F, args, l); if (l == 0) phase_norm0(F, args.in[0], args.in[2], H); SEAM(p0 + 0); }
    if (IN(p0 + 1)) {
        pg8::Gemm g{H, (const bf16*)(ws + WS_WIN), M_, NIN, DM, DM}; pg8::StaticOrder So; So.init(M_, NIN, F.G, (int)blockIdx.x);
        pg8::EpiInProj E{Y, G8};
        pg8::gemm_phase<pg8::EpiInProj, pg8::StaticOrder, true, true>(F.lds + RING_OFF, g, So, E);
        SEAM(p0 + 1);
    }
    if (IN(p0 + 2)) { compress_fast(F, args); phase2_naive(F, args, l); gla_g1(F, args, l); SEAM(p0 + 2); }
    if (IN(p0 + 3)) { gla_g2(F, args); nsa_cmp_fast(F, args, l * 4 + 2); moba_fast(F, args, l * 4 + 0); SEAM(p0 + 3); }
    if (IN(p0 + 4)) { nsa_fast(F, args, l * 4 + 1); gla_g3(F, args, l); SEAM(p0 + 4); }
    if (IN(p0 + 5)) {
        pg8::StaticOrder So; So.init(M_, DM, F.G, (int)blockIdx.x);
        { pg8::Gemm g{Y + Y_AQ, (const bf16*)(ws + WS_WA), M_, DM, 512, YP}; pg8::EpiMerge<0> E{H, G8}; pg8::gemm_phase<pg8::EpiMerge<0>, pg8::StaticOrder, true, true>(F.lds + RING_OFF, g, So, E); }
        __syncthreads();
        { pg8::Gemm g{Y + Y_BR, (const bf16*)(ws + WS_WB), M_, DM, 512, YP}; pg8::EpiMerge<1> E{H, G8}; pg8::gemm_phase<pg8::EpiMerge<1>, pg8::StaticOrder, true, true>(F.lds + RING_OFF, g, So, E); }
        __syncthreads();
        { pg8::Gemm g{Y + Y_CQ, (const bf16*)(ws + WS_WC), M_, DM, 512, YP}; pg8::EpiMerge<2> E{H, G8}; pg8::gemm_phase<pg8::EpiMerge<2>, pg8::StaticOrder, true, true>(F.lds + RING_OFF, g, So, E); }
        SEAM(p0 + 5);
    }
    if (IN(p0 + 6)) {
        pg8::Gemm g{H, (const bf16*)(ws + WS_WO), M_, DM, DM, DM}; pg8::StaticOrder So; So.init(M_, DM, F.G, (int)blockIdx.x);
        pg8::EpiF32 E{Yf, DM}; pg8::gemm_phase<pg8::EpiF32, pg8::StaticOrder, true, true>(F.lds + RING_OFF, g, So, E);
        SEAM(p0 + 6);
    }
    if (IN(p0 + 7)) { phase_resid(F, Yf, xin, args.out, args.in[3] + (size_t)l * DM, args.in[4] + (size_t)l * DM, H); SEAM(p0 + 7); }
    if (IN(p0 + 8)) {
        pg8::Gemm g{H, (const bf16*)(ws + WS_WF1), M_, 2 * FF, DM, DM}; pg8::StaticOrder So; So.init(M_, 2 * FF, F.G, (int)blockIdx.x);
        pg8::EpiSwiglu E{ACT, FF}; pg8::gemm_phase<pg8::EpiSwiglu, pg8::StaticOrder, true, true>(F.lds + RING_OFF, g, So, E);
        SEAM(p0 + 8);
    }
    if (IN(p0 + 9)) {
        pg8::Gemm g{ACT, (const bf16*)(ws + WS_WF2), M_, DM, FF, FF}; pg8::StaticOrder So; So.init(M_, DM, F.G, (int)blockIdx.x);
        pg8::EpiF32 E{Yf, DM}; pg8::gemm_phase<pg8::EpiF32, pg8::StaticOrder, true, true>(F.lds + RING_OFF, g, So, E);
        SEAM(p0 + 9);
    }
    if (IN(p0 + 10)) { phase_resid(F, Yf, args.out, args.out, args.in[5] + (size_t)l * DM, l + 1 < NL ? args.in[2] + (size_t)(l + 1) * DM : nullptr, l + 1 < NL ? H : nullptr); SEAM(p0 + 10); }
}
__global__ void __launch_bounds__(NWAVES * 64, 2) mk_fwd(Args args) {
    extern __shared__ __attribute__((aligned(16))) unsigned char lds[];
    Frame F;
    F.lds = (LAS unsigned char*)lds; F.MISC = (volatile LAS unsigned*)(F.lds + MISC_OFF);
    F.tid = threadIdx.x; F.lane = F.tid & 63; F.wave = __builtin_amdgcn_readfirstlane(F.tid >> 6); F.G = gridDim.x;
    F.ctl = (gu32*)(args.ws + WS_CTL);
    for (int u = F.tid; u < (LDS_BYTES - LDSCTL_OFF) / 4; u += NWAVES * 64) ((LAS unsigned*)(F.lds + LDSCTL_OFF))[u] = 0u;
    __syncthreads();
    const int lo = args.ph_lo, hi = args.ph_hi;
    XcdBarrier bar; bar.bar = (unsigned*)(F.ctl + CW_BAR); bar.x = 0; bar.st = nullptr;
    if (hi - lo > 1) bar = xcd_barrier_post((unsigned*)(F.ctl + CW_BAR), F.MISC + 8);
    layer_body<0>(F, args, bar, lo, hi);
    layer_body<1>(F, args, bar, lo, hi);
}
#undef IN
#undef SEAM

#ifndef MK_ONE_LAUNCH
#define MK_ONE_LAUNCH 1
#endif
extern "C" void kernel_launch(void* const* d_in, const int* in_sizes, int n_in, void* d_out, int out_size, void* d_ws, size_t ws_size, hipStream_t stream) {
    static int grid = 0;
    if (grid == 0) {
        if (n_in != 22 || out_size != M_ * DM || ws_size < WS_END) { fprintf(stderr, "kernel_launch: unexpected sizes (n_in %d out %d ws %zu)\n", n_in, out_size, ws_size); grid = -1; return; }
        int dev = 0, cus = 0;
        if (hipGetDevice(&dev) != hipSuccess || hipDeviceGetAttribute(&cus, hipDeviceAttributeMultiprocessorCount, dev) != hipSuccess) { grid = -1; return; }
        if (hipFuncSetAttribute((const void*)mk_fwd, hipFuncAttributeMaxDynamicSharedMemorySize, LDS_BYTES) != hipSuccess) { grid = -1; return; }
        (void)hipGetLastError();
        grid = cus;
    }
    if (grid < 0) return;
    if (hipMemsetAsync((char*)d_ws + WS_CTL, 0, CTL_ZERO_BYTES, stream) != hipSuccess) return;
    Args a{};
    for (int i = 0; i < 22; ++i) a.in[i] = (const float*)d_in[i];
    a.out = (float*)d_out; a.ws = (unsigned char*)d_ws;
#if MK_ONE_LAUNCH
    a.ph_lo = 0; a.ph_hi = NPH;
    hipLaunchKernelGGL(mk_fwd, dim3(grid), dim3(NWAVES * 64), LDS_BYTES, stream, a);
#else
    for (int p = 0; p < NPH; ++p) { a.ph_lo = p; a.ph_hi = p + 1; hipLaunchKernelGGL(mk_fwd, dim3(grid), dim3(NWAVES * 64), LDS_BYTES, stream, a); }
#endif
}
```

```cpp
#include <hip/hip_runtime.h>
#include <cstdio>
#include <cstdint>
#include <cmath>
namespace pg8 {
#define PG8_LAS __attribute__((address_space(3)))
typedef unsigned short bf16_t;
typedef short bf16x8 __attribute__((ext_vector_type(8)));
typedef float f32x4 __attribute__((ext_vector_type(4)));
typedef unsigned u32x4 __attribute__((ext_vector_type(4)));
constexpr int BM = 256, BK = 64, HALF = 128, HTB = HALF * BK * 2  , STAGE_BYTES = 8 * HTB, NXCD = 8, WGM = 8;

__host__ __device__ __forceinline__ int lds_byte(int r, int c) { const int st = (r >> 4) * 2 + (c >> 5), rr = r & 15, cc = c & 31, ob = rr * 64 + cc * 2; return st * 1024 + (ob ^ (((ob >> 9) & 1) << 5)); }
__host__ __device__ __forceinline__ void stage_rc(int b, int& R, int& C) { const int st = b / 1024, sb = b % 1024, swz = sb ^ (((sb >> 9) & 1) << 5); R = (st >> 1) * 16 + swz / 64; C = (st & 1) * 32 + (swz % 64) / 2; }
__host__ __device__ __forceinline__ int perm32(int rho) { const int n = rho >> 4, i = rho & 15; return 8 * (i >> 2) + 4 * n + (i & 3); }

struct Unit { int pm, pn; };
struct Gemm { const bf16_t* A; const bf16_t* Bt; int M, N, K, lda; };

struct StaticOrder {
    int nM, nN, nwg, G, c;
    __host__ __device__ void init(int M, int N, int G_, int c_) { nM = M / BM; nN = N / BM; nwg = nM * nN; G = G_; c = c_; }
    __host__ __device__ bool next(int i, Unit& u) const {
        const long L = (long)i * G + c; if (L >= nwg) return false;
        int wgid = (int)L; { const int q = nwg / NXCD, r = nwg % NXCD, xcd = wgid % NXCD, off = wgid / NXCD; wgid = (xcd < r ? xcd * (q + 1) : r * (q + 1) + (xcd - r) * q) + off; }
        const int nig = WGM * nN, gid = wgid / nig, fm = gid * WGM, gsz = (nM - fm) < WGM ? (nM - fm) : WGM;
        u.pm = fm + ((wgid % nig) % gsz); u.pn = (wgid % nig) / gsz; return true;
    }
    __device__ __forceinline__ void a_ready(const Unit&) const {}
    __device__ __forceinline__ void done(const Unit&) const {}
};

__device__ __forceinline__ unsigned cvt_pk_bf16(float lo, float hi) { unsigned r; asm volatile("v_cvt_pk_bf16_f32 %0, %1, %2" : "=v"(r) : "v"(lo), "v"(hi)); return r; }
typedef float f32x2 __attribute__((ext_vector_type(2)));
constexpr int YP_ = 4392;
constexpr float C2_ = 0.125f * 1.4426950408889634f;
__device__ __forceinline__ float sigmoidf_(float v) { return 1.f / (1.f + __expf(-v)); }
struct EpiInProj {
    static constexpr bool PERM = true, AFTER_DRAIN = false;
    bf16_t* Y; unsigned char* G8;
    __device__ __forceinline__ void operator()(const f32x4 (&acc)[2][2][4][2], const Unit& u, int wr, int wc, int fr, int fq) const {
        const int row0 = u.pm * BM + wr * 64 + fr, colt = u.pn * BM, cin = wc * 32 + 8 * fq;
        if (u.pn < 18) {
            float sc = 1.f; if (u.pn < 2 || u.pn == 5 || u.pn == 6) sc = C2_; else if (u.pn == 11) sc = 0.125f;
#pragma unroll
            for (int ai = 0; ai < 2; ++ai)
#pragma unroll
                for (int m = 0; m < 4; ++m) { bf16_t* rowp = Y + (size_t)(row0 + ai * HALF + m * 16) * YP_;
#pragma unroll
                    for (int bj = 0; bj < 2; ++bj) { const int col = colt + cin + bj * HALF;
                        if (col + 8 <= YP_) { const f32x4 v0 = acc[ai][bj][m][0] * sc, v1 = acc[ai][bj][m][1] * sc; u32x4 w;
                            w.x = cvt_pk_bf16(v0[0], v0[1]); w.y = cvt_pk_bf16(v0[2], v0[3]); w.z = cvt_pk_bf16(v1[0], v1[1]); w.w = cvt_pk_bf16(v1[2], v1[3]);
                            *(u32x4*)(rowp + col) = w; } } }
        } else {
#pragma unroll
            for (int ai = 0; ai < 2; ++ai)
#pragma unroll
                for (int m = 0; m < 4; ++m) { unsigned char* rowp = G8 + (size_t)(row0 + ai * HALF + m * 16) * 3072 + (colt - 4608) + cin;
#pragma unroll
                    for (int bj = 0; bj < 2; ++bj) { const f32x4 v0 = acc[ai][bj][m][0], v1 = acc[ai][bj][m][1]; unsigned lo = 0u, hi = 0u;
#pragma unroll
                        for (int e = 0; e < 4; ++e) { lo |= (unsigned)(sigmoidf_(v0[e]) * 255.f + 0.5f) << (8 * e); hi |= (unsigned)(sigmoidf_(v1[e]) * 255.f + 0.5f) << (8 * e); }
                        typedef unsigned u32x2 __attribute__((ext_vector_type(2))); u32x2 w; w.x = lo; w.y = hi; *(u32x2*)(rowp + bj * HALF) = w; } }
        }
    }
};
template <int I> struct EpiMerge {
    static constexpr bool PERM = true, AFTER_DRAIN = false;
    bf16_t* Mg; const unsigned char* G8;
    __device__ __forceinline__ void operator()(const f32x4 (&acc)[2][2][4][2], const Unit& u, int wr, int wc, int fr, int fq) const {
        const int row0 = u.pm * BM + wr * 64 + fr, col0 = u.pn * BM + wc * 32 + 8 * fq;
#pragma unroll
        for (int ai = 0; ai < 2; ++ai)
#pragma unroll
            for (int m = 0; m < 4; ++m) { const size_t row = (size_t)(row0 + ai * HALF + m * 16);
#pragma unroll
                for (int bj = 0; bj < 2; ++bj) { const int col = col0 + bj * HALF;
                    typedef unsigned u32x2 __attribute__((ext_vector_type(2)));
                    const u32x2 gw = *(const u32x2*)(G8 + row * 3072 + I * 1024 + col);
                    float v[8];
#pragma unroll
                    for (int e = 0; e < 4; ++e) { v[e] = acc[ai][bj][m][0][e] * ((float)((gw.x >> (8 * e)) & 255u) * (1.f / 255.f)); v[4 + e] = acc[ai][bj][m][1][e] * ((float)((gw.y >> (8 * e)) & 255u) * (1.f / 255.f)); }
                    bf16_t* p = Mg + row * 1024 + col;
                    if (I > 0) { const u32x4 o = *(const u32x4*)p;
                        v[0] += __uint_as_float(o.x << 16); v[1] += __uint_as_float(o.x & 0xffff0000u); v[2] += __uint_as_float(o.y << 16); v[3] += __uint_as_float(o.y & 0xffff0000u);
                        v[4] += __uint_as_float(o.z << 16); v[5] += __uint_as_float(o.z & 0xffff0000u); v[6] += __uint_as_float(o.w << 16); v[7] += __uint_as_float(o.w & 0xffff0000u); }
                    u32x4 w; w.x = cvt_pk_bf16(v[0], v[1]); w.y = cvt_pk_bf16(v[2], v[3]); w.z = cvt_pk_bf16(v[4], v[5]); w.w = cvt_pk_bf16(v[6], v[7]);
                    *(u32x4*)p = w; } }
    }
};
struct EpiF32 {
    static constexpr bool PERM = true, AFTER_DRAIN = false;
    float* O; int ldc;
    __device__ __forceinline__ void operator()(const f32x4 (&acc)[2][2][4][2], const Unit& u, int wr, int wc, int fr, int fq) const {
        const int row0 = u.pm * BM + wr * 64 + fr, col0 = u.pn * BM + wc * 32 + 8 * fq;
#pragma unroll
        for (int ai = 0; ai < 2; ++ai)
#pragma unroll
            for (int m = 0; m < 4; ++m) { float* rowp = O + (size_t)(row0 + ai * HALF + m * 16) * ldc + col0;
#pragma unroll
                for (int bj = 0; bj < 2; ++bj) { *(f32x4*)(rowp + bj * HALF) = acc[ai][bj][m][0]; *(f32x4*)(rowp + bj * HALF + 4) = acc[ai][bj][m][1]; } }
    }
};
struct EpiSwiglu {
    static constexpr bool PERM = true, AFTER_DRAIN = false;
    bf16_t* Act; int ldc;
    __device__ __forceinline__ void operator()(const f32x4 (&acc)[2][2][4][2], const Unit& u, int wr, int wc, int fr, int fq) const {
        const int row0 = u.pm * BM + wr * 64 + fr, col0 = u.pn * HALF + wc * 32 + 8 * fq;
#pragma unroll
        for (int ai = 0; ai < 2; ++ai)
#pragma unroll
            for (int m = 0; m < 4; ++m) { bf16_t* p = Act + (size_t)(row0 + ai * HALF + m * 16) * ldc + col0; float v[8];
#pragma unroll
                for (int e = 0; e < 4; ++e) { const float g0 = acc[ai][0][m][0][e], g1 = acc[ai][0][m][1][e];
                    v[e] = g0 * sigmoidf_(g0) * acc[ai][1][m][0][e]; v[4 + e] = g1 * sigmoidf_(g1) * acc[ai][1][m][1][e]; }
                u32x4 w; w.x = cvt_pk_bf16(v[0], v[1]); w.y = cvt_pk_bf16(v[2], v[3]); w.z = cvt_pk_bf16(v[4], v[5]); w.w = cvt_pk_bf16(v[6], v[7]);
                *(u32x4*)p = w; }
    }
};
template <class Epi, class Sched, bool ALIGN_EPI = false, bool SP2 = false>
__device__ __forceinline__ void gemm_phase(PG8_LAS unsigned char* lds, const Gemm g, const Sched& S, const Epi& E) {
    int tid_l = threadIdx.x; asm volatile("" : "+v"(tid_l));
    const int tid = tid_l, wid = __builtin_amdgcn_readfirstlane(tid >> 6), lane = tid & 63, wr = wid >> 2, wc = wid & 3, fr = lane & 15, fq = lane >> 4;
    const int K = g.K, nt = K / BK;
    unsigned voffA[2], voffB[2];
#pragma unroll
    for (int i = 0; i < 2; ++i) { int R, C; stage_rc(tid * 16 + i * 8192, R, C); const int Rb = Epi::PERM ? ((R & ~31) + perm32(R & 31)) : R;
        voffA[i] = (unsigned)(R * g.lda + C) * 2u; voffB[i] = (unsigned)(Rb * K + C) * 2u; }
    const size_t kstep = (size_t)(BK * 2);
    const size_t hstepB = (size_t)HALF * K * 2, hstepA = (size_t)HALF * g.lda * 2;
    const size_t tstepA = 2 * hstepA, tstepB = 2 * hstepB;
    const unsigned ldsw = (unsigned)wid * 1024u;
    const int aoff = lds_byte(wr * 64 + fr, fq * 8), boff = lds_byte(wc * 32 + fr, fq * 8);
#define PG8_SA(b, h) (((b) * 2 + (h)) * HTB)
#define PG8_SB(b, h) ((4 + (b) * 2 + (h)) * HTB)
#define PG8_STAGE(bufoff, gbase, voff) do { _Pragma("unroll") for (int _i = 0; _i < 2; ++_i) \
        __builtin_amdgcn_global_load_lds((const unsigned*)((const char*)(gbase) + (voff)[_i]), (PG8_LAS unsigned*)(lds + (bufoff) + ldsw + _i * 8192), 16, 0, 0); } while (0)
#define PG8_LDA(dst, b, h) do { _Pragma("unroll") for (int m = 0; m < 4; ++m) _Pragma("unroll") for (int k = 0; k < 2; ++k) dst[m][k] = *(const PG8_LAS bf16x8*)(lds + PG8_SA(b, h) + aoff + m * 2048 + k * 1024); } while (0)
#define PG8_LDB(dst, b, h) do { _Pragma("unroll") for (int n = 0; n < 2; ++n) _Pragma("unroll") for (int k = 0; k < 2; ++k) dst[n][k] = *(const PG8_LAS bf16x8*)(lds + PG8_SB(b, h) + boff + n * 2048 + k * 1024); } while (0)
#define PG8_MMA(ai, bj, At, Bt) do { __builtin_amdgcn_s_setprio(1); _Pragma("unroll") for (int m = 0; m < 4; ++m) _Pragma("unroll") for (int n = 0; n < 2; ++n) _Pragma("unroll") for (int k = 0; k < 2; ++k) \
        acc[ai][bj][m][n] = __builtin_amdgcn_mfma_f32_16x16x32_bf16(Bt[n][k], At[m][k], acc[ai][bj][m][n], 0, 0, 0); __builtin_amdgcn_s_setprio(0); } while (0)
#define PG8_WAIT_V(n) asm volatile("s_waitcnt vmcnt(" #n ")" ::: "memory")
#define PG8_WAIT_L(n) asm volatile("s_waitcnt lgkmcnt(" #n ")" ::: "memory")
#define PG8_BAR __builtin_amdgcn_s_barrier()
#define PG8_SCHED __builtin_amdgcn_sched_barrier(0)
    Unit cur, nxt; int ui = 0;
    if (!S.next(0, cur)) return;
    f32x4 acc[2][2][4][2];
#pragma unroll
    for (int a = 0; a < 2; ++a)
#pragma unroll
        for (int b = 0; b < 2; ++b)
#pragma unroll
            for (int m = 0; m < 4; ++m)
#pragma unroll
                for (int n = 0; n < 2; ++n) acc[a][b][m][n] = (f32x4){0.f, 0.f, 0.f, 0.f};
    bf16x8 At[4][2], B0[2][2], B1[2][2];
    const char* cA = (const char*)g.A + (size_t)cur.pm * tstepA; const char* cB = (const char*)g.Bt + (size_t)cur.pn * tstepB;
    S.a_ready(cur);
    if constexpr (SP2) {
        PG8_STAGE(PG8_SB(0, 0), cB, voffB); PG8_STAGE(PG8_SB(0, 1), cB + hstepB, voffB); PG8_STAGE(PG8_SA(0, 0), cA, voffA); PG8_STAGE(PG8_SA(0, 1), cA + hstepA, voffA);
        if (wr == 1) PG8_BAR;
        PG8_WAIT_V(2); PG8_BAR;
        PG8_STAGE(PG8_SB(1, 0), cB + kstep, voffB); PG8_STAGE(PG8_SA(1, 0), cA + kstep, voffA); PG8_STAGE(PG8_SB(1, 1), cB + hstepB + kstep, voffB);
        PG8_WAIT_V(6); PG8_BAR;
    } else {
        PG8_STAGE(PG8_SB(0, 0), cB, voffB); PG8_STAGE(PG8_SA(0, 0), cA, voffA); PG8_STAGE(PG8_SB(0, 1), cB + hstepB, voffB); PG8_STAGE(PG8_SA(0, 1), cA + hstepA, voffA);
        if (wr == 1) PG8_BAR;
        PG8_WAIT_V(4); PG8_BAR;
        PG8_STAGE(PG8_SB(1, 0), cB + kstep, voffB); PG8_STAGE(PG8_SA(1, 0), cA + kstep, voffA); PG8_STAGE(PG8_SB(1, 1), cB + hstepB + kstep, voffB);
        PG8_WAIT_V(6); PG8_BAR;
    }
    for (;;) {
        const bool has_next = S.next(ui + 1, nxt);
        const char* nA = has_next ? (const char*)g.A + (size_t)nxt.pm * tstepA : cA; const char* nB = has_next ? (const char*)g.Bt + (size_t)nxt.pn * tstepB : cB;
        for (int t = 0; t < nt; t += 2) {
            const bool last = (t == nt - 2);
            const char* a1 = cA + (size_t)(t + 1) * kstep;
            const char* a2 = last ? nA : cA + (size_t)(t + 2) * kstep; const char* b2 = last ? nB : cB + (size_t)(t + 2) * kstep;
            const char* a3 = a2 + kstep; const char* b3 = b2 + kstep;
            if (last && has_next) S.a_ready(nxt);
            if constexpr (SP2) {
            PG8_LDB(B0, 0, 0); PG8_LDB(B1, 0, 1); PG8_SCHED; PG8_LDA(At, 0, 0); PG8_STAGE(PG8_SA(1, 1), a1 + hstepA, voffA);
            PG8_WAIT_V(8); PG8_WAIT_L(0); PG8_BAR; PG8_MMA(0, 0, At, B0); PG8_MMA(0, 1, At, B1); PG8_BAR; PG8_SCHED;
            PG8_LDA(At, 0, 1); PG8_STAGE(PG8_SB(0, 0), b2, voffB); PG8_STAGE(PG8_SB(0, 1), b2 + hstepB, voffB); PG8_STAGE(PG8_SA(0, 0), a2, voffA);
            PG8_WAIT_V(8); PG8_WAIT_L(0); PG8_BAR; PG8_MMA(1, 0, At, B0); PG8_MMA(1, 1, At, B1); PG8_BAR; PG8_SCHED;
            PG8_LDB(B0, 1, 0); PG8_LDB(B1, 1, 1); PG8_SCHED; PG8_LDA(At, 1, 0); PG8_STAGE(PG8_SA(0, 1), a2 + hstepA, voffA);
            PG8_WAIT_V(8); PG8_WAIT_L(0); PG8_BAR; PG8_MMA(0, 0, At, B0); PG8_MMA(0, 1, At, B1); PG8_BAR; PG8_SCHED;
            PG8_LDA(At, 1, 1); PG8_STAGE(PG8_SB(1, 0), b3, voffB); PG8_STAGE(PG8_SB(1, 1), b3 + hstepB, voffB); PG8_STAGE(PG8_SA(1, 0), a3, voffA);
            PG8_WAIT_V(8); PG8_WAIT_L(0); PG8_BAR; PG8_MMA(1, 0, At, B0); PG8_MMA(1, 1, At, B1); PG8_BAR; PG8_SCHED;
            } else {
            PG8_LDB(B0, 0, 0); PG8_SCHED; PG8_LDA(At, 0, 0); PG8_STAGE(PG8_SA(1, 1), a1 + hstepA, voffA);
            PG8_WAIT_L(8); PG8_BAR; PG8_WAIT_L(0); PG8_MMA(0, 0, At, B0); PG8_BAR; PG8_SCHED;
            PG8_LDB(B1, 0, 1); PG8_STAGE(PG8_SB(0, 0), b2, voffB);
            PG8_BAR; PG8_WAIT_L(0); PG8_MMA(0, 1, At, B1); PG8_BAR;
            PG8_LDA(At, 0, 1); PG8_STAGE(PG8_SA(0, 0), a2, voffA);
            PG8_BAR; PG8_WAIT_L(0); PG8_MMA(1, 0, At, B0); PG8_BAR; PG8_SCHED;
            PG8_STAGE(PG8_SB(0, 1), b2 + hstepB, voffB);
            PG8_WAIT_V(6); PG8_BAR; PG8_MMA(1, 1, At, B1); PG8_BAR;
            PG8_LDB(B0, 1, 0); PG8_SCHED; PG8_LDA(At, 1, 0); PG8_STAGE(PG8_SA(0, 1), a2 + hstepA, voffA);
            PG8_WAIT_L(8); PG8_BAR; PG8_WAIT_L(0); PG8_MMA(0, 0, At, B0); PG8_BAR; PG8_SCHED;
            PG8_LDB(B1, 1, 1); PG8_STAGE(PG8_SB(1, 0), b3, voffB);
            PG8_BAR; PG8_WAIT_L(0); PG8_MMA(0, 1, At, B1); PG8_BAR;
            PG8_LDA(At, 1, 1); PG8_STAGE(PG8_SA(1, 0), a3, voffA);
            PG8_BAR; PG8_WAIT_L(0); PG8_MMA(1, 0, At, B0); PG8_BAR; PG8_SCHED;
            PG8_STAGE(PG8_SB(1, 1), b3 + hstepB, voffB);
            PG8_WAIT_V(6); PG8_BAR; PG8_MMA(1, 1, At, B1); PG8_BAR;
            }
        }
        if constexpr (ALIGN_EPI) { if (wr == 0) PG8_BAR; }
        if constexpr (!Epi::AFTER_DRAIN) { E(acc, cur, wr, wc, fr, fq); S.done(cur); }
        if (!has_next) break;
#pragma unroll
        for (int a = 0; a < 2; ++a)
#pragma unroll
            for (int b = 0; b < 2; ++b)
#pragma unroll
                for (int m = 0; m < 4; ++m)
#pragma unroll
                    for (int n = 0; n < 2; ++n) acc[a][b][m][n] = (f32x4){0.f, 0.f, 0.f, 0.f};
        cur = nxt; cA = nA; cB = nB; ++ui;
        if constexpr (ALIGN_EPI) { if (wr == 1) PG8_BAR; }
    }
    PG8_WAIT_V(0);
    if constexpr (!ALIGN_EPI) { if (wr == 0) PG8_BAR; }
    PG8_BAR;
    if constexpr (Epi::AFTER_DRAIN) { E.fused(acc, cur, wr, wc, fr, fq, lds, wid, lane); S.done(cur); }
#undef PG8_SA
#undef PG8_SB
#undef PG8_STAGE
#undef PG8_LDA
#undef PG8_LDB
#undef PG8_MMA
#undef PG8_WAIT_V
#undef PG8_WAIT_L
#undef PG8_BAR
#undef PG8_SCHED
}
}
namespace attn {
using bf16=unsigned short;
using bf16x8=__attribute__((ext_vector_type(8)))short;
using s16x4=__attribute__((ext_vector_type(4)))short;
using f32x16=__attribute__((ext_vector_type(16)))float;
using u32x4=__attribute__((ext_vector_type(4)))unsigned;
constexpr int D=64, PITCH=4392, SEQ=8192;
constexpr int NW=8,QBLK=32,QB=QBLK*NW,KVBLK=64;
__device__ __forceinline__ int crow(int r,int hi){return (r&3)+8*(r>>2)+4*hi;}
#define SBAR() __builtin_amdgcn_sched_barrier(0)
using f32x4_=__attribute__((ext_vector_type(4)))float;
__device__ __forceinline__ float bfs(short v){ return __uint_as_float(((unsigned)(unsigned short)v)<<16); }
__device__ __forceinline__ float lo16(unsigned w){ return __uint_as_float(w<<16); }
__device__ __forceinline__ float hi16(unsigned w){ return __uint_as_float(w&0xffff0000u); }
__device__ __forceinline__ bf16 f2b(float f){ unsigned u=__float_as_uint(f); return (bf16)((u+0x7fffu+((u>>16)&1u))>>16); }
__device__ __forceinline__ unsigned pk2b(float lo,float hi){ return (unsigned)f2b(lo)|((unsigned)f2b(hi)<<16); }
constexpr int NSLOT=3, SLOTB=8192;
constexpr int LDS_K=0, LDS_V=NSLOT*SLOTB, LDS_WS=2*NSLOT*SLOTB, LDS_OST=LDS_WS+NW*128*4, LDS_BIAS=LDS_OST+NW*4096, LDS_MSK=LDS_BIAS+512, LDS_KM=LDS_MSK+NW*512, LDS_BYTES=LDS_KM+8192;
constexpr float LOG2E_=1.4426950408889634f;
__device__ __forceinline__ void glds16(const void*gsrc,unsigned lds_dst){unsigned keep;
  asm volatile("s_mov_b32 %0, m0\n\ts_mov_b32 m0, %2\n\ts_nop 0\n\tglobal_load_lds_dwordx4 %1, off\n\ts_mov_b32 m0, %0":"=&s"(keep):"v"(gsrc),"s"(lds_dst):"memory");}
__device__ __forceinline__ float max3f(float a,float b,float c){float r;asm("v_max3_f32 %0, %1, %2, %3":"=v"(r):"v"(a),"v"(b),"v"(c));return r;}
__device__ __forceinline__ float max2f(float a,float b){float r;asm("v_max_f32_e32 %0, %1, %2":"=v"(r):"v"(a),"v"(b));return r;}
__device__ __forceinline__ float fadd_s(float a,float b){float r;asm("v_add_f32_e32 %0, %1, %2":"=v"(r):"v"(a),"v"(b));return r;}
__device__ __forceinline__ float fsub_s(float a,float b){float r;asm("v_sub_f32_e32 %0, %1, %2":"=v"(r):"v"(a),"v"(b));return r;}
typedef float f32x2_t __attribute__((ext_vector_type(2))); typedef __bf16 bf16x2_t __attribute__((ext_vector_type(2)));
__device__ __forceinline__ unsigned cvtpk_s(float lo,float hi){f32x2_t v={lo,hi};bf16x2_t b=__builtin_convertvector(v,bf16x2_t);return __builtin_bit_cast(unsigned,b);}
#define WAIT_BAR(N) asm volatile("s_waitcnt vmcnt(" #N ") lgkmcnt(0)\n\ts_barrier":::"memory")

__device__ __forceinline__ void qkt(f32x16&p0,f32x16&p1,const char*Kslot,const bf16x8*qr,const f32x16&negm,int r32,int hi){
  const char*kb=Kslot+hi*1024+r32*16;
  #pragma unroll
  for(int d0=0;d0<4;++d0){
    const bf16x8 b0=*reinterpret_cast<const bf16x8*>(kb+d0*2048);
    const bf16x8 b1=*reinterpret_cast<const bf16x8*>(kb+d0*2048+512);
    if(d0==0){p0=__builtin_amdgcn_mfma_f32_32x32x16_bf16(b0,qr[0],negm,0,0,0);p1=__builtin_amdgcn_mfma_f32_32x32x16_bf16(b1,qr[0],negm,0,0,0);}
    else{p0=__builtin_amdgcn_mfma_f32_32x32x16_bf16(b0,qr[d0],p0,0,0,0);p1=__builtin_amdgcn_mfma_f32_32x32x16_bf16(b1,qr[d0],p1,0,0,0);}}
}
typedef __attribute__((address_space(3))) const char* lds_cptr;
typedef short v4i16_t __attribute__((ext_vector_type(4)));
__device__ __forceinline__ void kload8(bf16x8*kf,lds_cptr kp){
  kf[0]=*(const __attribute__((address_space(3))) bf16x8*)(kp);      kf[1]=*(const __attribute__((address_space(3))) bf16x8*)(kp+512);
  kf[2]=*(const __attribute__((address_space(3))) bf16x8*)(kp+2048); kf[3]=*(const __attribute__((address_space(3))) bf16x8*)(kp+2560);
  kf[4]=*(const __attribute__((address_space(3))) bf16x8*)(kp+4096); kf[5]=*(const __attribute__((address_space(3))) bf16x8*)(kp+4608);
  kf[6]=*(const __attribute__((address_space(3))) bf16x8*)(kp+6144); kf[7]=*(const __attribute__((address_space(3))) bf16x8*)(kp+6656);
}
__device__ __forceinline__ void kload2(bf16x8*kf,lds_cptr kp,int j){ kf[2*j]=*(const __attribute__((address_space(3))) bf16x8*)(kp+j*2048); kf[2*j+1]=*(const __attribute__((address_space(3))) bf16x8*)(kp+j*2048+512); }
__device__ __forceinline__ s16x4 vtr(lds_cptr p){ return __builtin_bit_cast(s16x4,__builtin_amdgcn_ds_read_tr16_b64_v4i16((__attribute__((address_space(3))) v4i16_t*)p)); }
__device__ __forceinline__ float rowmax(const f32x16&p0,const f32x16&p1){
  float a=max3f(p0[0],p0[1],p1[0]),b=max3f(p0[2],p0[3],p1[1]);a=max3f(a,p1[2],p1[3]);
  #pragma unroll
  for(int r=4;r<16;r+=4){a=max3f(a,p0[r],p0[r+1]);b=max3f(b,p0[r+2],p0[r+3]);a=max3f(a,p1[r],p1[r+1]);b=max3f(b,p1[r+2],p1[r+3]);}
  const float m=max2f(a,b);
  auto rr=__builtin_amdgcn_permlane32_swap(__float_as_uint(m),__float_as_uint(m),false,false);
  return max2f(__uint_as_float(rr[0]),__uint_as_float(rr[1]));
}
__device__ __forceinline__ void pv(f32x16*o,int vb,bf16x8 pa0,bf16x8 pa1,bf16x8 pa2,bf16x8 pa3){
  #pragma unroll
  for(int d0=0;d0<2;++d0){s16x4 lo[4],hi[4];
    #pragma unroll
    for(int ks=0;ks<4;++ks){
      asm volatile("ds_read_b64_tr_b16 %0,%1 offset:%c2":"=&v"(lo[ks]):"v"(vb),"i"(d0*4096+ks*1024):"memory");
      asm volatile("ds_read_b64_tr_b16 %0,%1 offset:%c2":"=&v"(hi[ks]):"v"(vb),"i"(d0*4096+ks*1024+512):"memory");}
    asm volatile("s_waitcnt lgkmcnt(0)":::"memory");SBAR();
    #define PK(k) (bf16x8){lo[k][0],lo[k][1],lo[k][2],lo[k][3],hi[k][0],hi[k][1],hi[k][2],hi[k][3]}
    o[d0]=__builtin_amdgcn_mfma_f32_32x32x16_bf16(pa0,PK(0),o[d0],0,0,0);
    o[d0]=__builtin_amdgcn_mfma_f32_32x32x16_bf16(pa1,PK(1),o[d0],0,0,0);
    o[d0]=__builtin_amdgcn_mfma_f32_32x32x16_bf16(pa2,PK(2),o[d0],0,0,0);
    o[d0]=__builtin_amdgcn_mfma_f32_32x32x16_bf16(pa3,PK(3),o[d0],0,0,0);
    #undef PK
  }
}

#ifndef ATTN_STORE16
#define ATTN_STORE16(p,v) (*(u32x4*)(p)=(v))
#endif
struct UArgs {
  const bf16* Qb; const bf16* Kh; const bf16* Vh; bf16* Ob;
  int NT, q0, kt0, hc;
  const float* rel;
  const float* km; int qb;
  const unsigned* selg;
  const bf16* gate; int gcol;
  const bf16* tmp;
};
__device__ __forceinline__ int t5b(int d){ if(d<16)return d<0?0:d; int b=16; b+=(d>=19);b+=(d>=21);b+=(d>=24);b+=(d>=27);b+=(d>=31);b+=(d>=35);b+=(d>=40);b+=(d>=46);b+=(d>=52);b+=(d>=59);b+=(d>=67);b+=(d>=77);b+=(d>=87);b+=(d>=99);b+=(d>=113); return b; }
template<int MODE,int EPI,int THRL> __device__ __forceinline__ void attn_unit(const UArgs&U,char*shm){
  int tid_l=threadIdx.x; asm volatile("":"+v"(tid_l));
  const int tid=tid_l,lane=tid&63,r32=lane&31,hi=lane>>5; const int wid=__builtin_amdgcn_readfirstlane(tid>>6);
  const bf16*Qw=U.Qb+(long)(wid*QBLK)*PITCH;
  const bf16*Kh=U.Kh,*Vh=U.Vh;
  const unsigned lds0=(unsigned)(uintptr_t)shm;
  float*wsf=(float*)(shm+LDS_WS)+wid*128;
  const bf16*ksrc=Kh+(long)lane*PITCH+wid*8;
  const bf16*vsrc=Vh+(long)(16*(wid&3)+(lane>>2))*PITCH+(wid>>2)*32+(lane&3)*8;
  const unsigned kdst=lds0+LDS_K+wid*1024, vdst=lds0+LDS_V+wid*1024;
  #define DMA_K(t,slot) glds16(ksrc+(long)(t)*KVBLK*PITCH,(unsigned)__builtin_amdgcn_readfirstlane(kdst+(slot)))
  #define DMA_V(t,slot) glds16(vsrc+(long)(t)*KVBLK*PITCH,(unsigned)__builtin_amdgcn_readfirstlane(vdst+(slot)))
  const int vb0=(int)(lds0+LDS_V)+((lane>>4)&1)*32+(lane&3)*8+(4*hi+((lane&15)>>2))*64;
  const char*Kbase=shm+LDS_K; bf16x8 kf[8];
  const lds_cptr shm3=(lds_cptr)shm; const lds_cptr kp0=shm3+LDS_K+hi*1024+r32*16; const lds_cptr vp0=shm3+LDS_V+((lane>>4)&1)*32+(lane&3)*8+(4*hi+((lane&15)>>2))*64;
  const int NT=U.NT;
  const int qpos=U.q0+wid*QBLK+r32;
  float*biasT=(float*)(shm+LDS_BIAS);
  if(tid<128) biasT[tid]=(U.rel[t5b(tid)*16+U.hc]-U.rel[31*16+U.hc])*LOG2E_;
  unsigned selw=0u,cw=0u; const unsigned*mskp=(const unsigned*)(shm+LDS_MSK)+wid*128+r32*4;
  if(MODE==0){ ((u32x4*)(shm+LDS_KM))[tid]=((const u32x4*)U.km)[tid]; }
  if(MODE==1){ if(hi==0){ const u32x4 w=*(const u32x4*)(U.selg+(long)(wid*QBLK+r32)*4); *(u32x4*)((unsigned*)(shm+LDS_MSK)+wid*128+r32*4)=w; } }
  asm volatile("s_waitcnt vmcnt(0) lgkmcnt(0)\n\ts_barrier":::"memory");
  bf16x8 qr[4];
  #pragma unroll
  for(int d0=0;d0<4;++d0)qr[d0]=*reinterpret_cast<const bf16x8*>(&Qw[(long)r32*PITCH+d0*16+hi*8]);
  if(MODE==0){
    float v1=-INFINITY,v2=-INFINITY,v3=-INFINITY; int i1=-1,i2=-1,i3=-1;
    for(int n=0;n<U.qb;++n){ const float*km=(const float*)(shm+LDS_KM)+n*64+hi*8; float p=0.f;
      #pragma unroll
      for(int d0=0;d0<4;++d0){ const f32x4_ a=*(const f32x4_*)(km+d0*16), c=*(const f32x4_*)(km+d0*16+4);
        p+=bfs(qr[d0][0])*a[0]+bfs(qr[d0][1])*a[1]+bfs(qr[d0][2])*a[2]+bfs(qr[d0][3])*a[3]+bfs(qr[d0][4])*c[0]+bfs(qr[d0][5])*c[1]+bfs(qr[d0][6])*c[2]+bfs(qr[d0][7])*c[3]; }
      auto rr=__builtin_amdgcn_permlane32_swap(__float_as_uint(p),__float_as_uint(p),false,false); const float sc_=__uint_as_float(rr[0])+__uint_as_float(rr[1]);
      if(sc_>v1){v3=v2;i3=i2;v2=v1;i2=i1;v1=sc_;i1=n;} else if(sc_>v2){v3=v2;i3=i2;v2=sc_;i2=n;} else if(sc_>v3){v3=sc_;i3=n;} }
    if(i1>=0)selw|=1u<<i1; if(i2>=0)selw|=1u<<i2; if(i3>=0)selw|=1u<<i3; selw|=1u<<U.qb; }
  DMA_K(0,0);DMA_V(0,0);DMA_K(1,SLOTB);
  float mhat=0.f,l_reg=0.f;f32x16 o[2];o[0]=f32x16{};o[1]=f32x16{};f32x16 negm=f32x16{};asm volatile("":"+v"(negm));
  #define MASK_FAR(P0,P1,t) do{ bool on_=true; if(MODE==0)on_=((selw>>((t)>>2))&1u)!=0u; if(MODE==1){ if(((t)&31)==0)cw=mskp[(t)>>5]; on_=((cw>>((t)&31))&1u)!=0u; } \
      _Pragma("unroll") for(int r=0;r<16;++r){ P0[r]=on_?P0[r]:-INFINITY; P1[r]=on_?P1[r]:-INFINITY; } }while(0)
  #define MASK_BAND(P0,P1,t) do{ bool on_=true; if(MODE==0)on_=((selw>>((t)>>2))&1u)!=0u; if(MODE==1){ if(((t)&31)==0)cw=mskp[(t)>>5]; on_=((cw>>((t)&31))&1u)!=0u; } \
      const int d0_=qpos-(U.kt0+64*(t)+4*hi); \
      _Pragma("unroll") for(int r=0;r<16;++r){ const int da_=d0_-((r&3)+8*(r>>2)), db_=da_-32; \
        const bool oka_=on_&&da_>=0&&(MODE!=2||da_<512), okb_=on_&&db_>=0&&(MODE!=2||db_<512); \
        const float ba_=biasT[da_<0?0:(da_>127?127:da_)], bb_=biasT[db_<0?0:(db_>127?127:db_)]; \
        P0[r]=oka_?P0[r]+ba_:-INFINITY; P1[r]=okb_?P1[r]+bb_:-INFINITY; \
        if((r&1)==1){ asm volatile("s_waitcnt lgkmcnt(0)":"+v"(P0),"+v"(P1)::"memory"); } } }while(0)
  #define CMASK(P0,P1,t) MASK_BAND(P0,P1,t)
  bool resc=false;
  #define START(P0,P1) do{ const float rm=rowmax(P0,P1); resc=false; \
    { const float dl=rm>-1e30f?rm:0.f; mhat=fadd_s(mhat,dl); \
      _Pragma("unroll") for(int r=0;r<16;++r){P0[r]=fsub_s(P0[r],dl);P1[r]=fsub_s(P1[r],dl);} \
      _Pragma("unroll") for(int r=0;r<16;++r)negm[r]=-mhat; asm volatile("":"+v"(negm)); } \
    _Pragma("unroll") for(int r=0;r<16;++r)P0[r]=__builtin_amdgcn_exp2f(P0[r]); }while(0)
  #define RESC() do{ if(resc){ asm volatile("s_waitcnt lgkmcnt(0)":::"memory"); \
      _Pragma("unroll") for(int d_=0;d_<2;++d_) _Pragma("unroll") for(int r=0;r<16;++r)o[d_][r]*=wsf[crow(r,hi)]; } }while(0)
  f32x16 pA0,pA1,pB0,pB1;
  int sl_prev=0,sl_cur=0,sl_next=SLOTB;
  #define ROT() do{sl_prev=sl_cur;sl_cur=sl_next;sl_next=(sl_next==(NSLOT-1)*SLOTB)?0:sl_next+SLOTB;}while(0)
  DMA_K(2,2*SLOTB);
  WAIT_BAR(3);
  qkt(pA0,pA1,Kbase,qr,negm,r32,hi);asm volatile("s_nop 15\n\ts_nop 7":"+v"(pA0),"+v"(pA1));CMASK(pA0,pA1,0);
  START(pA0,pA1);
  _Pragma("unroll") for(int r=0;r<16;++r)pA1[r]=__builtin_amdgcn_exp2f(pA1[r]);
  WAIT_BAR(0);
  DMA_K(3,0);DMA_V(1,SLOTB);
  ROT();
  kload8(kf,kp0+sl_cur);
  WAIT_BAR(2);
  s16x4 vlo[8],vhi[8]; u32x4 pw0,pw1,pw2,pw3;
  #define PKW(P,B) cvtpk_s(P[B],P[B+1])
  #define PAF(k) __builtin_bit_cast(bf16x8,pw##k)
  #define VFR(i) (bf16x8){vlo[i][0],vlo[i][1],vlo[i][2],vlo[i][3],vhi[i][0],vhi[i][1],vhi[i][2],vhi[i][3]}
  #define PIN(x) asm volatile("":"+v"(x))
  #define MX3(a,b,c) __builtin_fmaxf(__builtin_fmaxf((a),(b)),(c))
  #define GAPA(MF,A0,A1,A2,A3,W0,W1,PW) do{ MF; sacc+=A0; sacc+=A1; sacc+=A2; sacc+=A3; PIN(sacc); W0; W1; PIN(PW); SBAR(); }while(0)
  #define EX(v) __builtin_amdgcn_exp2f(v)
  #define GAPB(MF,X,B) do{ MF; X[B]=EX(X[B]); X[B+1]=EX(X[B+1]); X[B+2]=EX(X[B+2]); X[B+3]=EX(X[B+3]); PIN(X); SBAR(); }while(0)
  #define VRD(i) do{ vlo[i]=vtr(vp_+(((i)>>2)*4096+((i)&3)*1024)); vhi[i]=vtr(vp_+(((i)>>2)*4096+((i)&3)*1024+512)); }while(0)
  #define KRD(G,j) do{ if(G){ kload2(kf,kp0+sl_next,j); SBAR(); } }while(0)
  #define STEP(C0,C1,P0,P1,t,GK,GV,GL) do{ SBAR(); \
    const lds_cptr vp_=vp0+sl_prev; \
    VRD(0); SBAR(); float sacc=(P0[0]+P0[1]); \
    GAPA(C0=__builtin_amdgcn_mfma_f32_32x32x16_bf16(kf[0],qr[0],negm,0,0,0), P0[2],P0[3],P0[4],P0[5],     pw0[0]=PKW(P0,0), pw0[1]=PKW(P0,2), pw0); \
    VRD(4); SBAR(); GAPA(C1=__builtin_amdgcn_mfma_f32_32x32x16_bf16(kf[1],qr[0],negm,0,0,0), P0[6],P0[7],P0[8],P0[9],     pw0[2]=PKW(P0,4), pw0[3]=PKW(P0,6), pw0); \
    VRD(1); SBAR(); GAPA(C0=__builtin_amdgcn_mfma_f32_32x32x16_bf16(kf[2],qr[1],C0,0,0,0),   P0[10],P0[11],P0[12],P0[13], pw1[0]=PKW(P0,8), pw1[1]=PKW(P0,10), pw1); \
    VRD(5); SBAR(); GAPA(C1=__builtin_amdgcn_mfma_f32_32x32x16_bf16(kf[3],qr[1],C1,0,0,0),   P0[14],P0[15],P1[0],P1[1],   pw1[2]=PKW(P0,12),pw1[3]=PKW(P0,14), pw1); \
    VRD(2); SBAR(); GAPA(C0=__builtin_amdgcn_mfma_f32_32x32x16_bf16(kf[4],qr[2],C0,0,0,0),   P1[2],P1[3],P1[4],P1[5],     pw2[0]=PKW(P1,0), pw2[1]=PKW(P1,2), pw2); \
    VRD(6); SBAR(); GAPA(C1=__builtin_amdgcn_mfma_f32_32x32x16_bf16(kf[5],qr[2],C1,0,0,0),   P1[6],P1[7],P1[8],P1[9],     pw2[2]=PKW(P1,4), pw2[3]=PKW(P1,6), pw2); \
    VRD(3); SBAR(); GAPA(C0=__builtin_amdgcn_mfma_f32_32x32x16_bf16(kf[6],qr[3],C0,0,0,0),   P1[10],P1[11],P1[12],P1[13], pw3[0]=PKW(P1,8), pw3[1]=PKW(P1,10), pw3); \
    VRD(7); SBAR(); GAPA(C1=__builtin_amdgcn_mfma_f32_32x32x16_bf16(kf[7],qr[3],C1,0,0,0),   P1[14],P1[15],0.f,0.f,       pw3[2]=PKW(P1,12),pw3[3]=PKW(P1,14), pw3); \
    l_reg+=sacc; \
    if(GK){DMA_K((t)+3,sl_cur);} if(GV){DMA_V((t)+1,sl_next);} \
    CMASK(C0,C1,t); \
    { float a=MX3(C0[0],C0[1],C1[0]),b=MX3(C0[2],C0[3],C1[1]); a=MX3(a,C1[2],C1[3]); \
      _Pragma("unroll") for(int r=4;r<16;r+=4){a=MX3(a,C0[r],C0[r+1]);b=MX3(b,C0[r+2],C0[r+3]);a=MX3(a,C1[r],C1[r+1]);b=MX3(b,C1[r+2],C1[r+3]);} \
      float rm=__builtin_fmaxf(a,b); { auto rr=__builtin_amdgcn_permlane32_swap(__float_as_uint(rm),__float_as_uint(rm),false,false); rm=__builtin_fmaxf(__uint_as_float(rr[0]),__uint_as_float(rr[1])); } \
      resc=false; \
      if(__builtin_expect(__any(rm>(float)THRL),0)){ const float dl=__builtin_fmaxf(rm,0.f); mhat+=dl; \
        _Pragma("unroll") for(int r=0;r<16;++r){C0[r]-=dl;C1[r]-=dl;} \
        _Pragma("unroll") for(int r=0;r<16;++r)negm[r]=-mhat; asm volatile("":"+v"(negm)); \
        const float f=__builtin_amdgcn_exp2f(-dl); l_reg*=f; if(hi==0)wsf[r32]=f; resc=true; } } \
    SBAR(); \
    GAPB(o[0]=__builtin_amdgcn_mfma_f32_32x32x16_bf16(PAF(0),VFR(0),o[0],0,0,0), C0,0); \
    GAPB(o[1]=__builtin_amdgcn_mfma_f32_32x32x16_bf16(PAF(0),VFR(4),o[1],0,0,0), C0,4); \
    KRD(GL,0); GAPB(o[0]=__builtin_amdgcn_mfma_f32_32x32x16_bf16(PAF(1),VFR(1),o[0],0,0,0), C0,8); \
    KRD(GL,1); GAPB(o[1]=__builtin_amdgcn_mfma_f32_32x32x16_bf16(PAF(1),VFR(5),o[1],0,0,0), C0,12); \
    KRD(GL,2); GAPB(o[0]=__builtin_amdgcn_mfma_f32_32x32x16_bf16(PAF(2),VFR(2),o[0],0,0,0), C1,0); \
    KRD(GL,3); GAPB(o[1]=__builtin_amdgcn_mfma_f32_32x32x16_bf16(PAF(2),VFR(6),o[1],0,0,0), C1,4); \
    GAPB(o[0]=__builtin_amdgcn_mfma_f32_32x32x16_bf16(PAF(3),VFR(3),o[0],0,0,0), C1,8); \
    GAPB(o[1]=__builtin_amdgcn_mfma_f32_32x32x16_bf16(PAF(3),VFR(7),o[1],0,0,0), C1,12); \
    }while(0)
  int t=1;
  #undef CMASK
  #define CMASK(P0,P1,t) MASK_FAR(P0,P1,t)
  for(;MODE!=2&&t+7<NT;t+=2){
    STEP(pB0,pB1,pA0,pA1,t,true,true,true);     WAIT_BAR(2); RESC(); ROT();
    STEP(pA0,pA1,pB0,pB1,t+1,true,true,true);   WAIT_BAR(2); RESC(); ROT();
  }
  #undef CMASK
  #define CMASK(P0,P1,t) MASK_BAND(P0,P1,t)
  #define ENDW(tt) do{ if((tt)+3<NT){WAIT_BAR(2);} else if((tt)+2<NT){WAIT_BAR(1);} else {WAIT_BAR(0);} }while(0)
  for(;t+1<NT;t+=2){
    STEP(pB0,pB1,pA0,pA1,t,(t+3<NT),(t+1<NT),(t+1<NT));       ENDW(t);   RESC(); ROT();
    STEP(pA0,pA1,pB0,pB1,t+1,(t+4<NT),(t+2<NT),(t+2<NT));     ENDW(t+1); RESC(); ROT();
  }
  STEP(pB0,pB1,pA0,pA1,NT-1,false,false,false); RESC();
  { float sacc=pB0[0]+pB0[1]; _Pragma("unroll") for(int r=2;r<16;++r)sacc+=pB0[r]; _Pragma("unroll") for(int r=0;r<16;++r)sacc+=pB1[r]; l_reg+=sacc;
    pw0=(u32x4){PKW(pB0,0),PKW(pB0,2),PKW(pB0,4),PKW(pB0,6)};pw1=(u32x4){PKW(pB0,8),PKW(pB0,10),PKW(pB0,12),PKW(pB0,14)};pw2=(u32x4){PKW(pB1,0),PKW(pB1,2),PKW(pB1,4),PKW(pB1,6)};pw3=(u32x4){PKW(pB1,8),PKW(pB1,10),PKW(pB1,12),PKW(pB1,14)};
    SBAR(); pv(o,vb0+sl_cur,PAF(0),PAF(1),PAF(2),PAF(3)); }
  #undef PKW
  #undef PAF
  #undef VFR
  #undef PIN
  #undef MX3
  #undef GAPA
  #undef GAPB
  #undef EX
  #undef VRD
  #undef KRD
  #undef STEP
  #undef ENDW
  {auto rr=__builtin_amdgcn_permlane32_swap(__float_as_uint(l_reg),__float_as_uint(l_reg),false,false);l_reg=__uint_as_float(rr[0])+__uint_as_float(rr[1]);}
  int lane_e=lane; asm volatile("":"+v"(lane_e)); const int r32e=lane_e&31, hie=lane_e>>5;
  float*wsfe=(float*)(shm+LDS_WS)+wid*128;
  if(hie==0){ wsfe[32+r32e]=l_reg; if(EPI!=0){ const float gl=bfs((short)U.gate[(long)(wid*QBLK+r32e)*PITCH+U.gcol]); wsfe[64+r32e]=1.f/(1.f+__expf(-gl)); } }
  asm volatile("s_waitcnt lgkmcnt(0)":::"memory");
  float rli[16];
  #pragma unroll
  for(int r=0;r<16;++r){ rli[r]=__builtin_amdgcn_rcpf(fmaxf(wsfe[32+crow(r,hie)],1e-30f)); if(EPI!=0)rli[r]*=wsfe[64+crow(r,hie)]; }
  bf16*Ow=U.Ob+(long)(wid*QBLK)*PITCH;
  { bf16*stg=(bf16*)(shm+LDS_OST)+wid*2048;
    #pragma unroll
    for(int r=0;r<16;++r){const int orow=crow(r,hie);
      #pragma unroll
      for(int d0=0;d0<2;++d0){ float v=o[d0][r]*rli[r]; if(EPI==2)v+=bfs((short)stg[orow*64+d0*32+r32e]); stg[orow*64+d0*32+r32e]=f2b(v);} }
    asm volatile("s_waitcnt lgkmcnt(0)":::"memory");
    if(EPI!=1){
    #pragma unroll
    for(int i=0;i<4;++i){const int row=i*8+(lane_e>>3),ch=lane_e&7; u32x4 v=*(const u32x4*)(stg+row*64+ch*8);
      if(EPI==2){ const u32x4 t=*(const u32x4*)(U.tmp+(long)(wid*QBLK+row)*512+ch*8);
        v.x=pk2b(lo16(v.x)+lo16(t.x),hi16(v.x)+hi16(t.x)); v.y=pk2b(lo16(v.y)+lo16(t.y),hi16(v.y)+hi16(t.y)); v.z=pk2b(lo16(v.z)+lo16(t.z),hi16(v.z)+hi16(t.z)); v.w=pk2b(lo16(v.w)+lo16(t.w),hi16(v.w)+hi16(t.w)); }
      ATTN_STORE16(Ow+(long)row*PITCH+ch*8,v);} } }
  asm volatile("s_waitcnt lgkmcnt(0)\n\ts_barrier":::"memory");
  #undef DMA_K
  #undef DMA_V
  #undef CMASK
  #undef START
  #undef RESC
  #undef ROT
}
constexpr int ATTN_LDS_BYTES=LDS_BYTES;
#undef SBAR
#undef WAIT_BAR
}

constexpr int NWAVES = 8;
constexpr int B_ = 4, S_ = 8192, DM = 1024, M_ = B_ * S_, DIN = 7464, FF = 2816, NL = 2;
constexpr int YP = pg8::YP_;
constexpr float C2 = pg8::C2_, LOG2E = 1.4426950408889634f;
constexpr float NORM_EPS = 1e-6f;
constexpr int Y_AQ = 0, Y_AKC = 512, Y_AVC = 640, Y_AKS = 768, Y_AVS = 896, Y_AKW = 1024, Y_AVW = 1152, Y_CQ = 1280, Y_CK = 1792, Y_CV = 2304,
              Y_BQ = 2816, Y_BK = 3072, Y_BV = 3328, Y_BR = 3840, Y_AG = 4352, Y_BLR = 4376;
constexpr int NIN = 7680;
constexpr size_t MiB = 1u << 20;
constexpr size_t WS_CTL = 0, CTL_ZERO_BYTES = 1 * MiB;
constexpr size_t WS_WIN = 1 * MiB, WS_WA = 16 * MiB, WS_WB = 17 * MiB, WS_WC = 18 * MiB, WS_WO = 19 * MiB, WS_WF1 = 21 * MiB, WS_WF2 = 32 * MiB;
constexpr size_t WS_H = 40 * MiB;
constexpr size_t WS_Y = 104 * MiB;
constexpr size_t WS_G8 = 379 * MiB;
constexpr size_t WS_ACT = WS_Y + 128 * MiB;
constexpr size_t WS_SM = 475 * MiB;
constexpr size_t WS_KCMP = WS_SM, WS_VCMP = WS_SM + 1 * MiB, WS_KMEAN = WS_SM + 2 * MiB;
constexpr size_t WS_GA = WS_SM + 3 * MiB;
constexpr size_t WS_MASK = 38 * MiB;
constexpr size_t WS_OATMP = WS_H;
constexpr size_t WS_O16 = WS_H + 32 * MiB;
constexpr size_t WS_VCMPT = WS_VCMP + 512 * 1024;
constexpr size_t WS_CW1T = 39 * MiB;
constexpr size_t WS_CW2T = WS_CW1T + 512 * 1024;
constexpr size_t WS_CC0 = WS_CW2T + 16 * 1024;
constexpr size_t WS_GST = WS_H + 32 * MiB;
constexpr size_t WS_GDEC = WS_SM + 3 * MiB;
constexpr size_t WS_END = 512 * MiB;
static_assert(WS_GA + (size_t)M_ * 256 * 4 <= WS_END && WS_Y + (size_t)M_ * YP * 2 <= WS_G8 && WS_G8 + (size_t)M_ * 3072 <= WS_SM, "ws map");
static_assert(WS_ACT + (size_t)M_ * FF * 2 <= WS_SM && WS_WF2 + (size_t)DM * FF * 2 <= WS_H, "ws map 2");
constexpr int CW_BAR = 4096;
constexpr int RING_OFF = 0, RING_BYTES = 131072;
constexpr int LDSCTL_OFF = RING_BYTES, MISC_OFF = LDSCTL_OFF + 320;
constexpr int LDS_BYTES = 147456;

#define GAS __attribute__((address_space(1)))
#define LAS __attribute__((address_space(3)))
typedef unsigned short bf16;
typedef unsigned v4u __attribute__((ext_vector_type(4)));
typedef float f32x4 __attribute__((ext_vector_type(4)));
typedef short bf16x8 __attribute__((ext_vector_type(8)));
typedef GAS unsigned gu32;
typedef GAS unsigned long long gu64;
#define RLX_AGENT __ATOMIC_RELAXED, __HIP_MEMORY_SCOPE_AGENT
#define LDS_WAIT() asm volatile("s_waitcnt lgkmcnt(0)" ::: "memory")
#define VM_WAIT() asm volatile("s_waitcnt vmcnt(0)" ::: "memory")
__device__ __forceinline__ unsigned long long rt() { return __builtin_amdgcn_s_memrealtime(); }
__device__ __forceinline__ unsigned f2bf(float f) { unsigned u = __builtin_bit_cast(unsigned, f); return (u + 0x7fffu + ((u >> 16) & 1u)) >> 16; }
__device__ __forceinline__ unsigned pk2(float lo, float hi) { return f2bf(lo) | (f2bf(hi) << 16); }

__device__ __forceinline__ float bf2f(bf16 h) { return __uint_as_float((unsigned)h << 16); }
__device__ __forceinline__ float sigm(float v) { return 1.f / (1.f + __expf(-v)); }
#define WFENCE() asm volatile("s_waitcnt lgkmcnt(0)" ::: "memory")

#define XB_TMO      128
#define XB_XCNT(j)  (256  + 64 * (j))
#define XB_XSUB(j)  (1280 + 64 * (j))
#define XB_XGEN(j)  (2304 + 64 * (j))
#define XB_TOP      3328
#define XB_TOPGEN   3392
#define XCD_BAR_WORDS 3456
#define XB_SPIN_CAP (1u << 18)

__device__ __forceinline__ unsigned xb_ld(unsigned* p)              { return __hip_atomic_load(p, __ATOMIC_RELAXED, __HIP_MEMORY_SCOPE_AGENT); }
__device__ __forceinline__ unsigned xb_add(unsigned* p, unsigned v) { return __hip_atomic_fetch_add(p, v, __ATOMIC_RELAXED, __HIP_MEMORY_SCOPE_AGENT); }
__device__ __forceinline__ unsigned xb_xcc_id() { return (unsigned)__builtin_amdgcn_s_getreg((3 << 11) | 20) & 0xFu; }
#define XB_SPIN(cond, bar) do { unsigned _sp = 0; while (cond) { __builtin_amdgcn_s_sleep(1); \
    if ((++_sp & 255u) == 0u) { if (xb_ld(&(bar)[XB_TMO])) break; if (_sp > XB_SPIN_CAP) { atomicAdd(&(bar)[XB_TMO], 1u); break; } } } } while (0)

struct XcdBarrier {
    unsigned* bar; unsigned x;
    volatile LAS unsigned* st;
};

__device__ __forceinline__ XcdBarrier xcd_barrier_post(unsigned* bar, volatile LAS unsigned* st) {
    XcdBarrier b; b.bar = bar; b.x = xb_xcc_id(); b.st = st;
    if (threadIdx.x == 0) (void)xb_add(&bar[XB_XCNT(b.x)], 1u);
    return b;
}
__device__ __forceinline__ void xcd_barrier_complete(unsigned* bar, unsigned x, unsigned& nloc, unsigned& nx) {
    const unsigned G = gridDim.x * gridDim.y * gridDim.z;
    unsigned sum, cnt, mine, sp = 0u;
    for (;;) {
        sum = 0u; cnt = 0u; mine = 0u;
#pragma unroll
        for (unsigned j = 0; j < 16; ++j) { const unsigned c = xb_ld(&bar[XB_XCNT(j)]); sum += c; cnt += (c > 0u) ? 1u : 0u; mine = (j == x) ? c : mine; }
        if (sum == G) break;
        __builtin_amdgcn_s_sleep(1);
        if ((++sp & 255u) == 0u) { if (xb_ld(&bar[XB_TMO])) break; if (sp > XB_SPIN_CAP) { atomicAdd(&bar[XB_TMO], 1u); break; } }
    }
    nloc = mine > 0u ? mine : 1u; nx = cnt > 0u ? cnt : 1u;
}

__device__ __forceinline__ void xcd_barrier(const XcdBarrier& b) {
    asm volatile("s_waitcnt vmcnt(0)" ::: "memory");
    __syncthreads();
    if (threadIdx.x == 0) {
        unsigned* bar = b.bar;
        __builtin_amdgcn_s_waitcnt(0);
        unsigned nloc = b.st[0], nx = b.st[1];
        if (nloc == 0u) { xcd_barrier_complete(bar, b.x, nloc, nx); b.st[0] = nloc; b.st[1] = nx; }
        const unsigned old = xb_add(&bar[XB_XSUB(b.x)], 1u);
        const unsigned gen = old / nloc;
        if (old + 1u == (gen + 1u) * nloc) {
            __builtin_amdgcn_fence(__ATOMIC_RELEASE, "agent");
            asm volatile("s_waitcnt vmcnt(0)" ::: "memory");
            const unsigned og = xb_add(&bar[XB_TOP], 1u);
            const unsigned tg = og / nx;
            if (og + 1u == (tg + 1u) * nx) xb_add(&bar[XB_TOPGEN], 1u);
            else XB_SPIN(xb_ld(&bar[XB_TOPGEN]) == tg, bar);
            __builtin_amdgcn_fence(__ATOMIC_ACQUIRE, "agent");
            xb_add(&bar[XB_XGEN(b.x)], 1u);
            asm volatile("s_waitcnt vmcnt(0)" ::: "memory");
        } else {
            XB_SPIN(xb_ld(&bar[XB_XGEN(b.x)]) == gen, bar);
            __builtin_amdgcn_fence(__ATOMIC_ACQUIRE, "agent");
            asm volatile("s_waitcnt vmcnt(0)" ::: "memory");
        }
    }
    __syncthreads();
}


struct Frame {
    LAS unsigned char* lds;
    volatile LAS unsigned* MISC;
    gu32* ctl;
    int tid, lane, wave, G;
};
__device__ __forceinline__ float wave_sum(float v) {
#pragma unroll
    for (int o = 1; o < 64; o <<= 1) v += __shfl_xor(v, o);
    return v;
}
__device__ __forceinline__ float wave_max(float v) {
#pragma unroll
    for (int o = 1; o < 64; o <<= 1) v = fmaxf(v, __shfl_xor(v, o));
    return v;
}
__device__ __forceinline__ int t5_bucket(int d) {
    if (d < 16) return d < 0 ? 0 : d;
    int b = 16;
    b += (d >= 19); b += (d >= 21); b += (d >= 24); b += (d >= 27); b += (d >= 31); b += (d >= 35); b += (d >= 40); b += (d >= 46);
    b += (d >= 52); b += (d >= 59); b += (d >= 67); b += (d >= 77); b += (d >= 87); b += (d >= 99); b += (d >= 113);
    return b;
}
template <class CM> __device__ __forceinline__ void tr_item(const float* W, int Nsrc, int K, bf16* WT, int item, int nblk, CM cm, LAS float* scr, int lane) {
    const int kb = item / nblk, nb = item % nblk, k0 = 64 * kb, n0 = 32 * nb;
    const int sc = cm(n0 + (lane & 31));
#pragma unroll 8
    for (int i = 0; i < 32; ++i) { const int kk = 2 * i + (lane >> 5); scr[kk * 33 + (lane & 31)] = sc >= 0 ? W[(size_t)(k0 + kk) * Nsrc + sc] : 0.f; }
    LDS_WAIT(); asm volatile("" ::: "memory");
    const int c = lane & 7;
#pragma unroll
    for (int j = 0; j < 4; ++j) { const int n = (lane >> 3) + 8 * j; const LAS float* s = scr + (8 * c) * 33 + n;
        v4u o; o.x = pk2(s[0 * 33], s[1 * 33]); o.y = pk2(s[2 * 33], s[3 * 33]); o.z = pk2(s[4 * 33], s[5 * 33]); o.w = pk2(s[6 * 33], s[7 * 33]);
        *(GAS v4u*)(WT + (size_t)(n0 + n) * K + k0 + 8 * c) = o; }
    LDS_WAIT(); asm volatile("" ::: "memory");
}
struct CmId { __device__ __forceinline__ int operator()(int n) const { return n; } };
struct CmWin { __device__ __forceinline__ int operator()(int n) const {
    if (n < 1280) return n;
    if (n < 2816) return n - 1280 + 2856;
    if (n < 4352) return n - 2816 + 1304;
    if (n < 4376) return n - 4352 + 1280;
    if (n < 4392) return n - 4376 + 2840;
    if (n < 4608) return -1;
    return n - 4608 + 4392; } };
struct CmFfn { __device__ __forceinline__ int operator()(int c) const { const int p = c >> 8, r = c & 255; return r < 128 ? 128 * p + r : FF + 128 * p + (r - 128); } };

struct Args { const float* in[22]; float* out; unsigned char* ws; int ph_lo, ph_hi; };

__device__ __forceinline__ void phase_weights(Frame& F, const Args& a, int l) {
    LAS float* scr = (LAS float*)(F.lds + RING_OFF + F.wave * 16384);
    const int gw = blockIdx.x * NWAVES + F.wave, NGW = F.G * NWAVES;
    unsigned char* ws = a.ws;
    constexpr int I_IN = 16 * (NIN / 32), I_BR = 8 * 32, I_O = 16 * 32, I_F1 = 16 * (2 * FF / 32), I_F2 = (FF / 64) * 32;
    constexpr int NIT = I_IN + 3 * I_BR + I_O + I_F1 + I_F2;
    for (int it = gw; it < NIT; it += NGW) {
        int r = it;
        if (r < I_IN) { tr_item(a.in[6] + (size_t)l * DM * DIN, DIN, DM, (bf16*)(ws + WS_WIN), r, NIN / 32, CmWin(), scr, F.lane); continue; } r -= I_IN;
        if (r < I_BR) { tr_item(a.in[16] + (size_t)l * 512 * DM, DM, 512, (bf16*)(ws + WS_WA), r, 32, CmId(), scr, F.lane); continue; } r -= I_BR;
        if (r < I_BR) { tr_item(a.in[17] + (size_t)l * 512 * DM, DM, 512, (bf16*)(ws + WS_WB), r, 32, CmId(), scr, F.lane); continue; } r -= I_BR;
        if (r < I_BR) { tr_item(a.in[18] + (size_t)l * 512 * DM, DM, 512, (bf16*)(ws + WS_WC), r, 32, CmId(), scr, F.lane); continue; } r -= I_BR;
        if (r < I_O) { tr_item(a.in[19] + (size_t)l * DM * DM, DM, DM, (bf16*)(ws + WS_WO), r, 32, CmId(), scr, F.lane); continue; } r -= I_O;
        if (r < I_F1) { tr_item(a.in[20] + (size_t)l * DM * 2 * FF, 2 * FF, DM, (bf16*)(ws + WS_WF1), r, 2 * FF / 32, CmFfn(), scr, F.lane); continue; } r -= I_F1;
        tr_item(a.in[21] + (size_t)l * FF * DM, DM, FF, (bf16*)(ws + WS_WF2), r, 32, CmId(), scr, F.lane);
    }
    for (int it = gw; it < 2 * 66 + 2; it += NGW) {
        if (it < 132) { const int kv = it / 66, r = it % 66;
            if (r < 64) tr_item(a.in[kv ? 11 : 9] + (size_t)l * 2048 * 64, 64, 2048, (bf16*)(ws + WS_CW1T) + (size_t)kv * 64 * 2048, r, 2, CmId(), scr, F.lane);
            else tr_item(a.in[kv ? 12 : 10] + (size_t)l * 64 * 64, 64, 64, (bf16*)(ws + WS_CW2T) + (size_t)kv * 64 * 64, r - 64, 2, CmId(), scr, F.lane); }
        else { const int kv = it - 132; const float* pe = a.in[kv ? 8 : 7] + (size_t)l * 2048; const float* w1 = a.in[kv ? 11 : 9] + (size_t)l * 2048 * 64; float acc = 0.f;
            for (int k = 0; k < 2048; ++k) acc += pe[k] * w1[(size_t)k * 64 + F.lane];
            ((float*)(ws + WS_CC0))[kv * 64 + F.lane] = acc; }
    }
}
__device__ __forceinline__ void phase_norm0(Frame& F, const float* x, const float* w, bf16* H) {
    const int gw = blockIdx.x * NWAVES + F.wave, NGW = F.G * NWAVES;
    for (int m = gw; m < M_; m += NGW) {
        const f32x4* xr = (const f32x4*)(x + (size_t)m * DM) + F.lane; f32x4 v[4]; float s = 0.f;
#pragma unroll
        for (int j = 0; j < 4; ++j) { v[j] = xr[64 * j]; s += v[j].x * v[j].x + v[j].y * v[j].y + v[j].z * v[j].z + v[j].w * v[j].w; }
        const float r = rsqrtf(wave_sum(s) * (1.f / DM) + NORM_EPS);
        unsigned long long* o8 = (unsigned long long*)(H + (size_t)m * DM) + F.lane;
#pragma unroll
        for (int j = 0; j < 4; ++j) { const f32x4 wv = ((const f32x4*)w)[F.lane + 64 * j];
            o8[64 * j] = (unsigned long long)pk2(v[j].x * r * wv.x, v[j].y * r * wv.y) | ((unsigned long long)pk2(v[j].z * r * wv.z, v[j].w * r * wv.w) << 32); }
    }
}
__device__ __forceinline__ void phase_resid(Frame& F, const float* y, const float* xin, float* xout, const float* wpost, const float* wpre, bf16* hout) {
    const int gw = blockIdx.x * NWAVES + F.wave, NGW = F.G * NWAVES;
    for (int m = gw; m < M_; m += NGW) {
        const f32x4* yr = (const f32x4*)(y + (size_t)m * DM) + F.lane; const f32x4* xr = (const f32x4*)(xin + (size_t)m * DM) + F.lane;
        f32x4 v[4], xv[4]; float s = 0.f;
#pragma unroll
        for (int j = 0; j < 4; ++j) { v[j] = yr[64 * j]; xv[j] = xr[64 * j]; s += v[j].x * v[j].x + v[j].y * v[j].y + v[j].z * v[j].z + v[j].w * v[j].w; }
        const float r = rsqrtf(wave_sum(s) * (1.f / DM) + NORM_EPS); float s2 = 0.f;
        f32x4* xo = (f32x4*)(xout + (size_t)m * DM) + F.lane;
#pragma unroll
        for (int j = 0; j < 4; ++j) { const f32x4 wv = ((const f32x4*)wpost)[F.lane + 64 * j]; f32x4 n;
            n.x = xv[j].x + v[j].x * r * wv.x; n.y = xv[j].y + v[j].y * r * wv.y; n.z = xv[j].z + v[j].z * r * wv.z; n.w = xv[j].w + v[j].w * r * wv.w;
            xo[64 * j] = n; v[j] = n; s2 += n.x * n.x + n.y * n.y + n.z * n.z + n.w * n.w; }
        if (hout) { const float r2 = rsqrtf(wave_sum(s2) * (1.f / DM) + NORM_EPS);
            unsigned long long* o8 = (unsigned long long*)(hout + (size_t)m * DM) + F.lane;
#pragma unroll
            for (int j = 0; j < 4; ++j) { const f32x4 wv = ((const f32x4*)wpre)[F.lane + 64 * j];
                o8[64 * j] = (unsigned long long)pk2(v[j].x * r2 * wv.x, v[j].y * r2 * wv.y) | ((unsigned long long)pk2(v[j].z * r2 * wv.z, v[j].w * r2 * wv.w) << 32); } }
    }
}
__device__ __forceinline__ void unpack8(const v4u w, float (&k)[8]) {
    k[0] = __uint_as_float(w.x << 16); k[1] = __uint_as_float(w.x & 0xffff0000u); k[2] = __uint_as_float(w.y << 16); k[3] = __uint_as_float(w.y & 0xffff0000u);
    k[4] = __uint_as_float(w.z << 16); k[5] = __uint_as_float(w.z & 0xffff0000u); k[6] = __uint_as_float(w.w << 16); k[7] = __uint_as_float(w.w & 0xffff0000u);
}
__device__ __forceinline__ void dot4(const LAS float* qs, const bf16* kr, float (&d)[4]) {
    d[0] = d[1] = d[2] = d[3] = 0.f;
#pragma unroll 1
    for (int c = 0; c < 8; ++c) { asm volatile("" ::: "memory"); const v4u w = ((const v4u*)kr)[c]; float k[8]; unpack8(w, k);
#pragma unroll
        for (int e = 0; e < 8; ++e) { const int dd = c * 8 + e;
#pragma unroll
            for (int h = 0; h < 4; ++h) d[h] += qs[h * 64 + dd] * k[e]; } }
}
__device__ __forceinline__ float dot1(const LAS float* qs, const bf16* kr) {
    float d = 0.f;
#pragma unroll
    for (int c = 0; c < 8; ++c) { const v4u w = ((const v4u*)kr)[c]; float k[8]; unpack8(w, k);
#pragma unroll
        for (int e = 0; e < 8; ++e) d += qs[c * 8 + e] * k[e]; }
    return d;
}
__device__ __forceinline__ float gelu_tanh(float x) { const float u = 0.7978845608028654f * (x + 0.044715f * x * x * x); return 0.5f * x * (1.f + tanhf(u)); }

__device__ __forceinline__ void phase2_naive(Frame& F, const Args& a, int l) {
    const int gw = blockIdx.x * NWAVES + F.wave, NGW = F.G * NWAVES, lane = F.lane;
    const bf16* Y = (const bf16*)(a.ws + WS_Y);
    LAS float* scr = (LAS float*)(F.lds + RING_OFF + F.wave * 16384);
    for (int t = gw; t < 4 * 8 * 32; t += NGW) {
        const int blk = t & 31, h = (t >> 5) & 7, b = t >> 8;
        const bf16* src = Y + ((size_t)b * S_ + blk * 256) * YP + Y_CK + h * 64 + lane; float s = 0.f;
        for (int i = 0; i < 256; ++i) s += bf2f(src[(size_t)i * YP]);
        ((float*)(a.ws + WS_KMEAN))[(size_t)t * 64 + lane] = s * (1.f / 256.f);
    }
}
__device__ __forceinline__ void gla_scan_naive(Frame& F, const Args& a) {
    const bf16* Y = (const bf16*)(a.ws + WS_Y); const float* GA = (const float*)(a.ws + WS_GA); bf16* O16 = (bf16*)(a.ws + WS_O16);
    const int lane = F.lane;
    for (int task = blockIdx.x; task < 256; task += F.G) {
        const int eg = task & 15, h = (task >> 4) & 3, b = task >> 6, e = eg * 8 + F.wave;
        float Sst = 0.f;
        for (int t0 = 0; t0 < S_; t0 += 8) {
            float av[8], kv[8], qv[8], vv[8];
#pragma unroll
            for (int j = 0; j < 8; ++j) { const size_t row = (size_t)b * S_ + t0 + j;
                av[j] = GA[row * 256 + h * 64 + lane]; kv[j] = bf2f(Y[row * YP + Y_BK + h * 64 + lane]); qv[j] = bf2f(Y[row * YP + Y_BQ + h * 64 + lane]); vv[j] = bf2f(Y[row * YP + Y_BV + h * 128 + e]); }
#pragma unroll
            for (int j = 0; j < 8; ++j) { Sst = av[j] * Sst + kv[j] * vv[j]; const float o = wave_sum(qv[j] * Sst);
                if (lane == 0) O16[((size_t)b * S_ + t0 + j) * 512 + h * 128 + e] = (bf16)f2bf(o); }
        }
    }
}
__device__ __forceinline__ void nsa_cmp_naive(Frame& F, const Args& a) {
    const int gw = blockIdx.x * NWAVES + F.wave, NGW = F.G * NWAVES, lane = F.lane;
    bf16* Y = (bf16*)(a.ws + WS_Y); const float* rel = a.in[1];
    LAS float* scr = (LAS float*)(F.lds + RING_OFF + F.wave * 16384);
    LAS float* qs = scr; LAS float* sc = scr + 256; LAS float* s2 = scr + 256 + 2048;
    for (int task = gw; task < 8 * S_; task += NGW) {
        const int q = task & (S_ - 1), bg = task >> 13, g = bg & 1, b = bg >> 1;
        const size_t row = (size_t)b * S_ + q; bf16* Yr = Y + row * YP;
#pragma unroll
        for (int h = 0; h < 4; ++h) qs[h * 64 + lane] = bf2f(Yr[Y_AQ + (g * 4 + h) * 64 + lane]);
        float gt[4][3];
#pragma unroll
        for (int h = 0; h < 4; ++h)
#pragma unroll
            for (int br = 0; br < 3; ++br) gt[h][br] = sigm(bf2f(Yr[Y_AG + (g * 4 + h) * 3 + br]));
        WFENCE();
        const int cur = q >> 6, ncv = q >= 31 ? ((q - 31) >> 4) + 1 : 0;
        const bf16* KC = (const bf16*)(a.ws + WS_KCMP) + (size_t)bg * 512 * 64; const bf16* VC = (const bf16*)(a.ws + WS_VCMP) + (size_t)bg * 512 * 64;
        float mx[4] = {-1e30f, -1e30f, -1e30f, -1e30f};
        for (int i = 0; i < 8; ++i) { const int n = lane + 64 * i;
            if (n < ncv) { float d[4]; dot4(qs, KC + (size_t)n * 64, d); const int bk = t5_bucket(q - (16 * n + 31));
#pragma unroll
                for (int h = 0; h < 4; ++h) { const float s = d[h] + rel[bk * 16 + g * 4 + h] * LOG2E; sc[h * 512 + n] = s; mx[h] = fmaxf(mx[h], s); } }
            else {
#pragma unroll
                for (int h = 0; h < 4; ++h) sc[h * 512 + n] = 0.f; } }
        float ls[4] = {0.f, 0.f, 0.f, 0.f};
#pragma unroll
        for (int h = 0; h < 4; ++h) mx[h] = wave_max(mx[h]);
        WFENCE();
        for (int i = 0; i < 8; ++i) { const int n = lane + 64 * i;
            if (n < ncv) {
#pragma unroll
                for (int h = 0; h < 4; ++h) { const float e = exp2f(sc[h * 512 + n] - mx[h]); sc[h * 512 + n] = e; ls[h] += e; } } }
#pragma unroll
        for (int h = 0; h < 4; ++h) ls[h] = 1.f / fmaxf(wave_sum(ls[h]), 1e-20f);
        for (int i = 0; i < 8; ++i) { const int n = lane + 64 * i;
            if (n < ncv) {
#pragma unroll
                for (int h = 0; h < 4; ++h) sc[h * 512 + n] *= ls[h]; } }
        WFENCE();
        float v0, v1;
        { float t[2];
#pragma unroll
          for (int jj = 0; jj < 2; ++jj) { const int j = lane + 64 * jj; float v = 0.f;
              for (int n = 4 * j - 1; n <= 4 * j + 3; ++n) if (n >= 0 && n < 511) v += (sc[n] + sc[512 + n]) + (sc[1024 + n] + sc[1536 + n]);
              const bool forced = (j == 0) || (j == cur) || (j == cur - 1);
              t[jj] = forced ? 1e9f : (j <= cur ? v : -1e30f); }
          v0 = t[0]; v1 = t[1]; }
        bool sel0 = false, sel1 = false;
        for (int it = 0; it < 16; ++it) {
            const float c0 = sel0 ? -INFINITY : v0, c1 = sel1 ? -INFINITY : v1;
            const float mxv = wave_max(fmaxf(c0, c1));
            const unsigned long long m0 = __ballot(!sel0 && v0 == mxv);
            if (m0) { const int idx = __builtin_ctzll(m0); if (lane == idx) sel0 = true; }
            else { const unsigned long long m1 = __ballot(!sel1 && v1 == mxv); const int idx = m1 ? __builtin_ctzll(m1) : -1; if (lane == idx) sel1 = true; }
        }
        sel0 = sel0 && (lane <= cur); sel1 = sel1 && (lane + 64 <= cur);
        const unsigned long long sm0 = __ballot(sel0), sm1 = __ballot(sel1);
        float oc[4] = {0.f, 0.f, 0.f, 0.f};
        for (int n = 0; n < ncv; ++n) { const float vv = bf2f(VC[(size_t)n * 64 + lane]);
#pragma unroll
            for (int h = 0; h < 4; ++h) oc[h] += sc[h * 512 + n] * vv; }
        { unsigned* MK = (unsigned*)(a.ws + WS_MASK) + ((size_t)bg * S_ + q) * 4;
          if (lane == 0) { MK[0] = (unsigned)sm0; MK[1] = (unsigned)(sm0 >> 32); MK[2] = (unsigned)sm1; MK[3] = (unsigned)(sm1 >> 32); }
          bf16* T = (bf16*)(a.ws + WS_OATMP) + row * 512;
#pragma unroll
          for (int h = 0; h < 4; ++h) T[(g * 4 + h) * 64 + lane] = (bf16)f2bf(gt[h][0] * oc[h]); }
        WFENCE();
    }
}
__device__ __forceinline__ void nsa_naive(Frame& F, const Args& a) {
    const int gw = blockIdx.x * NWAVES + F.wave, NGW = F.G * NWAVES, lane = F.lane;
    bf16* Y = (bf16*)(a.ws + WS_Y); const float* rel = a.in[1];
    LAS float* scr = (LAS float*)(F.lds + RING_OFF + F.wave * 16384);
    LAS float* qs = scr; LAS float* sc = scr + 256; LAS float* s2 = scr + 256 + 2048;
    for (int task = gw; task < 8 * S_; task += NGW) {
        const int q = task & (S_ - 1), bg = task >> 13, g = bg & 1, b = bg >> 1;
        const size_t row = (size_t)b * S_ + q; bf16* Yr = Y + row * YP;
#pragma unroll
        for (int h = 0; h < 4; ++h) qs[h * 64 + lane] = bf2f(Yr[Y_AQ + (g * 4 + h) * 64 + lane]);
        float gt[4][3];
#pragma unroll
        for (int h = 0; h < 4; ++h)
#pragma unroll
            for (int br = 0; br < 3; ++br) gt[h][br] = sigm(bf2f(Yr[Y_AG + (g * 4 + h) * 3 + br]));
        WFENCE();
        const int cur = q >> 6, ncv = q >= 31 ? ((q - 31) >> 4) + 1 : 0;
        const bf16* KC = (const bf16*)(a.ws + WS_KCMP) + (size_t)bg * 512 * 64; const bf16* VC = (const bf16*)(a.ws + WS_VCMP) + (size_t)bg * 512 * 64;
        float mx[4] = {-1e30f, -1e30f, -1e30f, -1e30f};
        for (int i = 0; i < 8; ++i) { const int n = lane + 64 * i;
            if (n < ncv) { float d[4]; dot4(qs, KC + (size_t)n * 64, d); const int bk = t5_bucket(q - (16 * n + 31));
#pragma unroll
                for (int h = 0; h < 4; ++h) { const float s = d[h] + rel[bk * 16 + g * 4 + h] * LOG2E; sc[h * 512 + n] = s; mx[h] = fmaxf(mx[h], s); } }
            else {
#pragma unroll
                for (int h = 0; h < 4; ++h) sc[h * 512 + n] = 0.f; } }
        float ls[4] = {0.f, 0.f, 0.f, 0.f};
#pragma unroll
        for (int h = 0; h < 4; ++h) mx[h] = wave_max(mx[h]);
        WFENCE();
        for (int i = 0; i < 8; ++i) { const int n = lane + 64 * i;
            if (n < ncv) {
#pragma unroll
                for (int h = 0; h < 4; ++h) { const float e = exp2f(sc[h * 512 + n] - mx[h]); sc[h * 512 + n] = e; ls[h] += e; } } }
#pragma unroll
        for (int h = 0; h < 4; ++h) ls[h] = 1.f / fmaxf(wave_sum(ls[h]), 1e-20f);
        for (int i = 0; i < 8; ++i) { const int n = lane + 64 * i;
            if (n < ncv) {
#pragma unroll
                for (int h = 0; h < 4; ++h) sc[h * 512 + n] *= ls[h]; } }
        WFENCE();
        float v0, v1;
        { float t[2];
#pragma unroll
          for (int jj = 0; jj < 2; ++jj) { const int j = lane + 64 * jj; float v = 0.f;
              for (int n = 4 * j - 1; n <= 4 * j + 3; ++n) if (n >= 0 && n < 511) v += (sc[n] + sc[512 + n]) + (sc[1024 + n] + sc[1536 + n]);
              const bool forced = (j == 0) || (j == cur) || (j == cur - 1);
              t[jj] = forced ? 1e9f : (j <= cur ? v : -1e30f); }
          v0 = t[0]; v1 = t[1]; }
        bool sel0 = false, sel1 = false;
        for (int it = 0; it < 16; ++it) {
            const float c0 = sel0 ? -INFINITY : v0, c1 = sel1 ? -INFINITY : v1;
            const float mxv = wave_max(fmaxf(c0, c1));
            const unsigned long long m0 = __ballot(!sel0 && v0 == mxv);
            if (m0) { const int idx = __builtin_ctzll(m0); if (lane == idx) sel0 = true; }
            else { const unsigned long long m1 = __ballot(!sel1 && v1 == mxv); const int idx = m1 ? __builtin_ctzll(m1) : -1; if (lane == idx) sel1 = true; }
        }
        sel0 = sel0 && (lane <= cur); sel1 = sel1 && (lane + 64 <= cur);
        const unsigned long long sm0 = __ballot(sel0), sm1 = __ballot(sel1);
        float oc[4] = {0.f, 0.f, 0.f, 0.f};
        for (int n = 0; n < ncv; ++n) { const float vv = bf2f(VC[(size_t)n * 64 + lane]);
#pragma unroll
            for (int h = 0; h < 4; ++h) oc[h] += sc[h * 512 + n] * vv; }
        float ms[4] = {-1e30f, -1e30f, -1e30f, -1e30f}, lsel[4] = {0.f, 0.f, 0.f, 0.f}, os[4] = {0.f, 0.f, 0.f, 0.f};
        for (int j = 0; j <= cur; ++j) {
            const bool on = j < 64 ? ((sm0 >> j) & 1ull) : ((sm1 >> (j - 64)) & 1ull);
            if (!on) continue;
            const int kpos = 64 * j + lane; const bool valid = kpos <= q;
            float d[4]; dot4(qs, Y + ((size_t)b * S_ + kpos) * YP + Y_AKS + g * 64, d);
            const int bk = t5_bucket(q - kpos);
            WFENCE();
#pragma unroll
            for (int h = 0; h < 4; ++h) { const float s = valid ? d[h] + rel[bk * 16 + g * 4 + h] * LOG2E : -1e30f;
                const float mn = fmaxf(ms[h], wave_max(s)); const float p = valid ? exp2f(s - mn) : 0.f; s2[h * 64 + lane] = p;
                const float scl = exp2f(ms[h] - mn); lsel[h] = lsel[h] * scl + wave_sum(p); os[h] *= scl; ms[h] = mn; }
            WFENCE();
            const bf16* vb = Y + ((size_t)b * S_ + 64 * j) * YP + Y_AVS + g * 64 + lane;
            for (int kk = 0; kk < 64; ++kk) { const float vv = bf2f(vb[(size_t)kk * YP]);
#pragma unroll
                for (int h = 0; h < 4; ++h) os[h] += s2[h * 64 + kk] * vv; }
        }
        float mw[4] = {-1e30f, -1e30f, -1e30f, -1e30f}, lw[4] = {0.f, 0.f, 0.f, 0.f}, ow[4] = {0.f, 0.f, 0.f, 0.f};
        for (int c = 0; c < 8; ++c) {
            if (q - 64 * c < 0) break;
            const int dist = 64 * c + lane, kpos = q - dist; const bool valid = kpos >= 0;
            float d[4]; dot4(qs, Y + ((size_t)b * S_ + (valid ? kpos : 0)) * YP + Y_AKW + g * 64, d);
            const int bk = t5_bucket(dist);
            WFENCE();
#pragma unroll
            for (int h = 0; h < 4; ++h) { const float s = valid ? d[h] + rel[bk * 16 + g * 4 + h] * LOG2E : -1e30f;
                const float mn = fmaxf(mw[h], wave_max(s)); const float p = valid ? exp2f(s - mn) : 0.f; s2[h * 64 + lane] = p;
                const float scl = exp2f(mw[h] - mn); lw[h] = lw[h] * scl + wave_sum(p); ow[h] *= scl; mw[h] = mn; }
            WFENCE();
            for (int kk = 0; kk < 64; ++kk) { const int kp = q - 64 * c - kk; if (kp < 0) break;
                const float vv = bf2f(Y[((size_t)b * S_ + kp) * YP + Y_AVW + g * 64 + lane]);
#pragma unroll
                for (int h = 0; h < 4; ++h) ow[h] += s2[h * 64 + kk] * vv; }
        }
        WFENCE();
#pragma unroll
        for (int h = 0; h < 4; ++h) { const float o = gt[h][0] * oc[h] + gt[h][1] * os[h] / fmaxf(lsel[h], 1e-20f) + gt[h][2] * ow[h] / fmaxf(lw[h], 1e-20f);
            Yr[Y_AQ + (g * 4 + h) * 64 + lane] = (bf16)f2bf(o); }
    }
}
__device__ __forceinline__ void moba_naive(Frame& F, const Args& a) {
    const int gw = blockIdx.x * NWAVES + F.wave, NGW = F.G * NWAVES, lane = F.lane;
    bf16* Y = (bf16*)(a.ws + WS_Y); const float* rel = a.in[1]; const float* KM = (const float*)(a.ws + WS_KMEAN);
    LAS float* scr = (LAS float*)(F.lds + RING_OFF + F.wave * 16384);
    LAS float* qs = scr; LAS float* s2 = scr + 64;
    for (int task = gw; task < 32 * S_; task += NGW) {
        const int q = task & (S_ - 1), bh = task >> 13, h = bh & 7, b = bh >> 3;
        const size_t row = (size_t)b * S_ + q; bf16* Yr = Y + row * YP;
        WFENCE();
        qs[lane] = bf2f(Yr[Y_CQ + h * 64 + lane]);
        WFENCE();
        const int cur = q >> 8;
        float gs = -1e30f;
        if (lane < 32 && lane < cur) { const float* km = KM + ((size_t)bh * 32 + lane) * 64; float d = 0.f;
            for (int dd = 0; dd < 64; ++dd) d += qs[dd] * km[dd];
            gs = d; }
        if (lane >= 32) gs = -INFINITY;
        bool sel = false;
        for (int it = 0; it < 3; ++it) { const float c = sel ? -INFINITY : gs; const float mxv = wave_max(c);
            const unsigned long long m0 = __ballot(!sel && lane < 32 && gs == mxv); const int idx = m0 ? __builtin_ctzll(m0) : -1; if (lane == idx) sel = true; }
        sel = sel && (lane < cur);
        const unsigned smask = (unsigned)__ballot(sel);
        float mr = -1e30f, lr = 0.f, o = 0.f;
        for (int j = 0; j <= cur; ++j) {
            const bool own = (j == cur);
            if (!own && !((smask >> j) & 1u)) continue;
            for (int c = 0; c < 4; ++c) {
                const int kpos = 256 * j + 64 * c + lane; const bool valid = kpos <= q;
                if (256 * j + 64 * c > q) break;
                const float d = dot1(qs, Y + ((size_t)b * S_ + kpos) * YP + Y_CK + h * 64);
                const int bk = t5_bucket(q - kpos);
                const float s = valid ? d + rel[bk * 16 + 8 + h] * LOG2E : -1e30f;
                const float mn = fmaxf(mr, wave_max(s)); const float p = valid ? exp2f(s - mn) : 0.f;
                WFENCE(); s2[lane] = p; WFENCE();
                const float scl = exp2f(mr - mn); lr = lr * scl + wave_sum(p); o *= scl; mr = mn;
                const bf16* vb = Y + ((size_t)b * S_ + 256 * j + 64 * c) * YP + Y_CV + h * 64 + lane;
                for (int kk = 0; kk < 64; ++kk) o += s2[kk] * bf2f(vb[(size_t)kk * YP]);
            }
        }
        Yr[Y_CQ + h * 64 + lane] = (bf16)f2bf(o / fmaxf(lr, 1e-20f));
    }
}
constexpr int CW_Q = 8192;
__device__ __forceinline__ int next_unit(Frame& F, int k) {
    __syncthreads();
    if (F.tid == 0) F.MISC[16] = __hip_atomic_fetch_add(F.ctl + CW_Q + 64 * k, 1u, RLX_AGENT);
    __syncthreads();
    return (int)F.MISC[16];
}
__device__ __forceinline__ void moba_fast(Frame& F, const Args& a, int qk) {
    bf16* Y = (bf16*)(a.ws + WS_Y); const float* KM = (const float*)(a.ws + WS_KMEAN);
    for (;;) {
        const int u = next_unit(F, qk); if (u >= 1024) break;
        const int qb = 31 - (u >> 5), bh = u & 31, b = bh >> 3, h = bh & 7; const long rowbase = (long)b * S_;
        attn::UArgs U{};
        U.Qb = Y + (rowbase + qb * 256) * YP + Y_CQ + h * 64; U.Kh = Y + rowbase * YP + Y_CK + h * 64; U.Vh = Y + rowbase * YP + Y_CV + h * 64; U.Ob = Y + (rowbase + qb * 256) * YP + Y_CQ + h * 64;
        U.NT = 4 * (qb + 1); U.q0 = qb * 256; U.kt0 = 0; U.hc = 8 + h; U.rel = a.in[1]; U.km = KM + (size_t)bh * 32 * 64; U.qb = qb;
        attn::attn_unit<0, 0, 8>(U, (char*)F.lds + RING_OFF);
    }
}
__device__ __forceinline__ void nsa_fast(Frame& F, const Args& a, int qk) {
    bf16* Y = (bf16*)(a.ws + WS_Y);
    for (;;) {
        const int u = next_unit(F, qk); if (u >= 1024) break;
        const int qb = 31 - (u >> 5), bh = u & 31, b = bh >> 3, h = bh & 7, g = h >> 2; const long rowbase = (long)b * S_; const int q0 = qb * 256;
        attn::UArgs U{};
        U.Qb = Y + (rowbase + q0) * YP + Y_AQ + h * 64; U.Ob = Y + (rowbase + q0) * YP + Y_AQ + h * 64; U.q0 = q0; U.hc = h; U.rel = a.in[1]; U.gate = Y + (rowbase + q0) * YP;
        { const int T0 = 4 * qb - 8 > 0 ? 4 * qb - 8 : 0;
          U.Kh = Y + (rowbase + 64 * T0) * YP + Y_AKW + g * 64; U.Vh = Y + (rowbase + 64 * T0) * YP + Y_AVW + g * 64; U.NT = 4 * qb + 4 - T0; U.kt0 = 64 * T0; U.gcol = Y_AG + h * 3 + 2;
          attn::attn_unit<2, 1, 8>(U, (char*)F.lds + RING_OFF); }
        { U.Kh = Y + rowbase * YP + Y_AKS + g * 64; U.Vh = Y + rowbase * YP + Y_AVS + g * 64; U.NT = 4 * (qb + 1); U.kt0 = 0; U.gcol = Y_AG + h * 3 + 1;
          U.selg = (const unsigned*)(a.ws + WS_MASK) + ((size_t)(b * 2 + g) * S_ + q0) * 4; U.tmp = (const bf16*)(a.ws + WS_OATMP) + (rowbase + q0) * 512 + h * 64;
          attn::attn_unit<1, 2, 8>(U, (char*)F.lds + RING_OFF); }
    }
}
typedef float f32x16g __attribute__((ext_vector_type(16)));
constexpr int GP = 72;
constexpr int GL_GS = 0;
constexpr int GL_VT = 16640 + 0;
constexpr int GL_A0 = GL_VT + 128 * GP * 2;
constexpr int GL_A1 = GL_A0 + 64 * GP * 2;
constexpr int GL_A2 = GL_A1 + 64 * GP * 2;
constexpr int GL_SS = GL_A2 + 64 * GP * 2;
constexpr int GL_END = GL_SS + 1024;
static_assert(GL_END <= RING_BYTES, "GLA LDS map");
__device__ __forceinline__ int crow32(int r, int hi) { return (r & 3) + 8 * (r >> 2) + 4 * hi; }
__device__ __forceinline__ void gla_bcum(Frame& F, const Args& a, int l, const bf16* Yc  , int h) {
    LAS float* gS = (LAS float*)(F.lds + RING_OFF + GL_GS);
    const int t = F.tid >> 3, dg = F.tid & 7;
    const float* w2 = a.in[13] + (size_t)l * 16 * 256 + h * 64 + dg * 8; const float* bias = a.in[14] + (size_t)l * 256 + h * 64 + dg * 8;
    float blr[16];
    { const v4u w0 = *(const v4u*)(Yc + (size_t)t * YP + Y_BLR), w1 = *(const v4u*)(Yc + (size_t)t * YP + Y_BLR + 8); float k0[8], k1[8]; unpack8(w0, k0); unpack8(w1, k1);
#pragma unroll
      for (int i = 0; i < 8; ++i) { blr[i] = k0[i]; blr[8 + i] = k1[i]; } }
    float z[8];
#pragma unroll
    for (int i = 0; i < 8; ++i) z[i] = bias[i];
#pragma unroll
    for (int r = 0; r < 16; ++r) { const f32x4 wa = *(const f32x4*)(w2 + r * 256), wb = *(const f32x4*)(w2 + r * 256 + 4);
        z[0] += blr[r] * wa.x; z[1] += blr[r] * wa.y; z[2] += blr[r] * wa.z; z[3] += blr[r] * wa.w; z[4] += blr[r] * wb.x; z[5] += blr[r] * wb.y; z[6] += blr[r] * wb.z; z[7] += blr[r] * wb.w; }
#pragma unroll
    for (int i = 0; i < 8; ++i) { const float zz = z[i]; gS[t * 65 + dg * 8 + i] = -(fmaxf(-zz, 0.f) + log1pf(__expf(-fabsf(zz)))) * (1.f / 16.f); }
    __syncthreads();
    if (F.tid < 64) { float acc = 0.f;
#pragma unroll 8
        for (int tt = 0; tt < 64; ++tt) { acc += gS[tt * 65 + F.tid]; gS[tt * 65 + F.tid] = acc; } }
    __syncthreads();
}
__device__ __forceinline__ void gla_stage_vT(Frame& F, const bf16* Yc, int h) {
    LAS bf16* vT = (LAS bf16*)(F.lds + RING_OFF + GL_VT); const int t = F.tid >> 3, dg = F.tid & 7;
    const v4u w0 = *(const v4u*)(Yc + (size_t)t * YP + Y_BV + h * 128 + dg * 16), w1 = *(const v4u*)(Yc + (size_t)t * YP + Y_BV + h * 128 + dg * 16 + 8);
    const unsigned ww[8] = {w0.x, w0.y, w0.z, w0.w, w1.x, w1.y, w1.z, w1.w};
#pragma unroll
    for (int i = 0; i < 8; ++i) { vT[(dg * 16 + 2 * i) * GP + t] = (bf16)(ww[i] & 0xffffu); vT[(dg * 16 + 2 * i + 1) * GP + t] = (bf16)(ww[i] >> 16); }
}
__device__ __forceinline__ bf16x8 lds_frag(const LAS bf16* X, int row, int kk) { return *(const LAS bf16x8*)(X + row * GP + kk); }
__device__ __forceinline__ void gla_g1(Frame& F, const Args& a, int l) {
    const bf16* Y = (const bf16*)(a.ws + WS_Y); bf16* GST = (bf16*)(a.ws + WS_GST); float* DEC = (float*)(a.ws + WS_GDEC);
    LAS float* gS = (LAS float*)(F.lds + RING_OFF + GL_GS); LAS bf16* vT = (LAS bf16*)(F.lds + RING_OFF + GL_VT); LAS bf16* kT = (LAS bf16*)(F.lds + RING_OFF + GL_A0);
    const int lane = F.lane, r32 = lane & 31, hi = lane >> 5, w = F.wave;
    for (int u = blockIdx.x; u < 2048; u += F.G) {
        const int c = u & 127, bh = u >> 7, h = bh & 3, b = bh >> 2; const bf16* Yc = Y + ((size_t)b * S_ + c * 64) * YP;
        gla_bcum(F, a, l, Yc, h);
        { const int t = F.tid >> 3, dg = F.tid & 7; const v4u kw = *(const v4u*)(Yc + (size_t)t * YP + Y_BK + h * 64 + dg * 8); float kk[8]; unpack8(kw, kk);
#pragma unroll
          for (int i = 0; i < 8; ++i) { const int d = dg * 8 + i; kT[d * GP + t] = (bf16)f2bf(kk[i] * __expf(gS[63 * 65 + d] - gS[t * 65 + d])); }
          if (F.tid < 64) DEC[(size_t)u * 64 + F.tid] = __expf(gS[63 * 65 + F.tid]); }
        gla_stage_vT(F, Yc, h);
        __syncthreads();
        { const int et = w >> 1, dt = w & 1; f32x16g acc = {};
#pragma unroll
          for (int ks = 0; ks < 4; ++ks) acc = __builtin_amdgcn_mfma_f32_32x32x16_bf16(lds_frag(vT, et * 32 + r32, ks * 16 + hi * 8), lds_frag(kT, dt * 32 + r32, ks * 16 + hi * 8), acc, 0, 0, 0);
          bf16* slot = GST + (size_t)u * 8192;
#pragma unroll
          for (int r = 0; r < 16; ++r) slot[(et * 32 + crow32(r, hi)) * 64 + dt * 32 + r32] = (bf16)f2bf(acc[r]); }
        __syncthreads();
    }
}
__device__ __forceinline__ void gla_g2(Frame& F, const Args& a) {
    unsigned* GST = (unsigned*)(a.ws + WS_GST); const float* DEC = (const float*)(a.ws + WS_GDEC);
    for (int i = blockIdx.x * 512 + F.tid; i < 16 * 128 * 32; i += F.G * 512) {
        const int dp = i & 31, bh = i >> 12; const int eo = (i >> 5) & 127;
        float s0 = 0.f, s1 = 0.f;
        for (int c0 = 0; c0 < 128; c0 += 8) {
            unsigned uu[8]; float d0[8], d1[8];
#pragma unroll
            for (int j = 0; j < 8; ++j) { const size_t sl = (size_t)(bh * 128 + c0 + j); uu[j] = GST[sl * 4096 + eo * 32 + dp]; d0[j] = DEC[sl * 64 + 2 * dp]; d1[j] = DEC[sl * 64 + 2 * dp + 1]; }
#pragma unroll
            for (int j = 0; j < 8; ++j) { const size_t sl = (size_t)(bh * 128 + c0 + j); GST[sl * 4096 + eo * 32 + dp] = pk2(s0, s1);
                s0 = s0 * d0[j] + __uint_as_float(uu[j] << 16); s1 = s1 * d1[j] + __uint_as_float(uu[j] & 0xffff0000u); }
        }
    }
}
__device__ __forceinline__ void gla_g3(Frame& F, const Args& a, int l) {
    bf16* Y = (bf16*)(a.ws + WS_Y); const bf16* GST = (const bf16*)(a.ws + WS_GST); const float* nw = a.in[15] + (size_t)l * 128;
    LAS float* gS = (LAS float*)(F.lds + RING_OFF + GL_GS); LAS bf16* vT = (LAS bf16*)(F.lds + RING_OFF + GL_VT);
    LAS bf16* qd = (LAS bf16*)(F.lds + RING_OFF + GL_A0); LAS bf16* kd = (LAS bf16*)(F.lds + RING_OFF + GL_A1); LAS bf16* at = (LAS bf16*)(F.lds + RING_OFF + GL_A2);
    LAS float* ssq = (LAS float*)(F.lds + RING_OFF + GL_SS);
    const int lane = F.lane, r32 = lane & 31, hi = lane >> 5, w = F.wave;
    for (int u = blockIdx.x; u < 2048; u += F.G) {
        const int c = u & 127, bh = u >> 7, h = bh & 3, b = bh >> 2; bf16* Yc = Y + ((size_t)b * S_ + c * 64) * YP;
        gla_bcum(F, a, l, Yc, h);
        { const int t = F.tid >> 3, dg = F.tid & 7; const v4u qw = *(const v4u*)(Yc + (size_t)t * YP + Y_BQ + h * 64 + dg * 8), kw = *(const v4u*)(Yc + (size_t)t * YP + Y_BK + h * 64 + dg * 8);
          float qq[8], kk[8]; unpack8(qw, qq); unpack8(kw, kk); v4u qo, ko; unsigned qa[4], ka[4];
#pragma unroll
          for (int i = 0; i < 4; ++i) { const float g0 = gS[t * 65 + dg * 8 + 2 * i], g1 = gS[t * 65 + dg * 8 + 2 * i + 1];
              qa[i] = pk2(qq[2 * i] * __expf(g0), qq[2 * i + 1] * __expf(g1)); ka[i] = pk2(kk[2 * i] * __expf(-g0), kk[2 * i + 1] * __expf(-g1)); }
          qo.x = qa[0]; qo.y = qa[1]; qo.z = qa[2]; qo.w = qa[3]; ko.x = ka[0]; ko.y = ka[1]; ko.z = ka[2]; ko.w = ka[3];
          *(LAS v4u*)(qd + t * GP + dg * 8) = qo; *(LAS v4u*)(kd + t * GP + dg * 8) = ko; }
        gla_stage_vT(F, Yc, h);
        __syncthreads();
        if (w < 4) { const int ib = w >> 1, jb = w & 1;
            if (jb <= ib) { f32x16g acc = {};
#pragma unroll
                for (int ks = 0; ks < 4; ++ks) acc = __builtin_amdgcn_mfma_f32_32x32x16_bf16(lds_frag(qd, ib * 32 + r32, ks * 16 + hi * 8), lds_frag(kd, jb * 32 + r32, ks * 16 + hi * 8), acc, 0, 0, 0);
#pragma unroll
                for (int r = 0; r < 16; ++r) { const int i = ib * 32 + crow32(r, hi), j = jb * 32 + r32; at[i * GP + j] = (bf16)f2bf(j <= i ? acc[r] : 0.f); } } }
        __syncthreads();
        { const int rb = w >> 2, et = w & 3; f32x16g acc = {};
          const bf16* slot = GST + (size_t)u * 8192 + (size_t)(et * 32 + r32) * 64 + hi * 8;
#pragma unroll
          for (int ks = 0; ks < 4; ++ks) { const bf16x8 sb = *(const bf16x8*)(slot + ks * 16);
              acc = __builtin_amdgcn_mfma_f32_32x32x16_bf16(lds_frag(qd, rb * 32 + r32, ks * 16 + hi * 8), sb, acc, 0, 0, 0); }
          for (int ks = 0; ks < 2 * (rb + 1); ++ks) acc = __builtin_amdgcn_mfma_f32_32x32x16_bf16(lds_frag(at, rb * 32 + r32, ks * 16 + hi * 8), lds_frag(vT, et * 32 + r32, ks * 16 + hi * 8), acc, 0, 0, 0);
          float sq[16];
#pragma unroll
          for (int r = 0; r < 16; ++r) { float v = acc[r] * acc[r];
              v += __shfl_xor(v, 1); v += __shfl_xor(v, 2); v += __shfl_xor(v, 4); v += __shfl_xor(v, 8); v += __shfl_xor(v, 16); sq[r] = v; }
          if (r32 == 0) {
#pragma unroll
              for (int r = 0; r < 16; ++r) ssq[w * 32 + crow32(r, hi)] = sq[r]; }
          __syncthreads();
          const float nwe = nw[et * 32 + r32];
#pragma unroll
          for (int r = 0; r < 16; ++r) { const int tr = crow32(r, hi); const float tot = ssq[(rb * 4 + 0) * 32 + tr] + ssq[(rb * 4 + 1) * 32 + tr] + ssq[(rb * 4 + 2) * 32 + tr] + ssq[(rb * 4 + 3) * 32 + tr];
              bf16* yp = Yc + (size_t)(rb * 32 + tr) * YP + Y_BR + h * 128 + et * 32 + r32; const float rv = bf2f(*yp);
              *yp = (bf16)f2bf(acc[r] * rsqrtf(tot * (1.f / 128.f) + NORM_EPS) * nwe * (rv * sigm(rv))); } }
        __syncthreads();
    }
}
constexpr int CL_IMP = 0, CL_BIAS = 64 * 129 * 4, CL_END = CL_BIAS + 2048;
__device__ __forceinline__ int red8(int v) { v += __shfl_xor(v, 1); v += __shfl_xor(v, 2); v += __shfl_xor(v, 4); return v; }
__device__ __forceinline__ void nsa_cmp_fast(Frame& F, const Args& a, int qk) {
    const bf16* Y = (const bf16*)(a.ws + WS_Y); const float* rel = a.in[1];
    LAS unsigned* impI = (LAS unsigned*)(F.lds + RING_OFF + CL_IMP); LAS float* biasT = (LAS float*)(F.lds + RING_OFF + CL_BIAS);
    const int lane = F.lane, r32 = lane & 31, hi = lane >> 5, w = F.wave, hr = w >> 1, qh = w & 1;
    for (;;) {
        const int u = next_unit(F, qk); if (u >= 1024) break;
        const int c = 127 - (u >> 3), bg = u & 7, g = bg & 1, b = bg >> 1, q0 = 64 * c; const size_t rowbase = (size_t)b * S_;
        for (int i = F.tid; i < 64 * 129; i += 512) impI[i] = 0u;
        { const int hh = F.tid >> 7, dd = F.tid & 127; biasT[F.tid] = (rel[t5_bucket(dd) * 16 + g * 4 + hh] - rel[31 * 16 + g * 4 + hh]) * LOG2E; }
        __syncthreads();
        const int head = g * 4 + hr, qw0 = q0 + qh * 32, qpos = qw0 + r32;
        const bf16* Qw = Y + (rowbase + qw0) * YP + Y_AQ + head * 64;
        bf16x8 qr[4];
#pragma unroll
        for (int ks = 0; ks < 4; ++ks) qr[ks] = *(const bf16x8*)(Qw + (size_t)r32 * YP + ks * 16 + hi * 8);
        const bf16* KC = (const bf16*)(a.ws + WS_KCMP) + (size_t)bg * 512 * 64; const bf16* VT = (const bf16*)(a.ws + WS_VCMPT) + (size_t)bg * 64 * 512;
        const int NTw = (qw0 / 16 + 1 + 31) >> 5;
        const LAS float* bT = biasT + hr * 128;
        float lsum = 0.f;
        for (int nt = 0; nt < NTw; ++nt) { f32x16g C = {};
#pragma unroll
            for (int ks = 0; ks < 4; ++ks) { const bf16x8 kf = *(const bf16x8*)(KC + (size_t)(nt * 32 + r32) * 64 + ks * 16 + hi * 8); C = __builtin_amdgcn_mfma_f32_32x32x16_bf16(kf, qr[ks], C, 0, 0, 0); }
#pragma unroll
            for (int r = 0; r < 16; ++r) { const int dist = qpos - (16 * (nt * 32 + crow32(r, hi)) + 31); lsum += dist >= 0 ? exp2f(fminf(C[r] + bT[dist > 127 ? 127 : (dist < 0 ? 0 : dist)], 100.f)) : 0.f; } }
        { auto rr = __builtin_amdgcn_permlane32_swap(__float_as_uint(lsum), __float_as_uint(lsum), false, false); lsum = __uint_as_float(rr[0]) + __uint_as_float(rr[1]); }
        const float inv = 1.f / fmaxf(lsum, 1e-30f);
        f32x16g o0 = {}, o1 = {};
        for (int nt = 0; nt < NTw; ++nt) { f32x16g C = {};
#pragma unroll
            for (int ks = 0; ks < 4; ++ks) { const bf16x8 kf = *(const bf16x8*)(KC + (size_t)(nt * 32 + r32) * 64 + ks * 16 + hi * 8); C = __builtin_amdgcn_mfma_f32_32x32x16_bf16(kf, qr[ks], C, 0, 0, 0); }
            float p[16];
#pragma unroll
            for (int r = 0; r < 16; ++r) { const int dist = qpos - (16 * (nt * 32 + crow32(r, hi)) + 31); p[r] = dist >= 0 ? exp2f(fminf(C[r] + bT[dist > 127 ? 127 : (dist < 0 ? 0 : dist)], 100.f)) * inv : 0.f; }
#pragma unroll
            for (int m = 0; m < 4; ++m) { const float G = (p[4 * m] + p[4 * m + 1]) + (p[4 * m + 2] + p[4 * m + 3]); const int j = nt * 8 + 2 * m + hi;
                LAS unsigned* ip = impI + (qh * 32 + r32) * 129 + j;
                __hip_atomic_fetch_add(ip, (unsigned)(G * 67108864.f + 0.5f), __ATOMIC_RELAXED, __HIP_MEMORY_SCOPE_WORKGROUP);
                if (j + 1 < 128) __hip_atomic_fetch_add(ip + 1, (unsigned)(p[4 * m + 3] * 67108864.f + 0.5f), __ATOMIC_RELAXED, __HIP_MEMORY_SCOPE_WORKGROUP); }
            v4u pw0, pw1; pw0.x = pk2(p[0], p[1]); pw0.y = pk2(p[2], p[3]); pw0.z = pk2(p[4], p[5]); pw0.w = pk2(p[6], p[7]); pw1.x = pk2(p[8], p[9]); pw1.y = pk2(p[10], p[11]); pw1.z = pk2(p[12], p[13]); pw1.w = pk2(p[14], p[15]);
            const bf16x8 pa0 = __builtin_bit_cast(bf16x8, pw0), pa1 = __builtin_bit_cast(bf16x8, pw1);
            typedef unsigned u32x2g __attribute__((ext_vector_type(2)));
#pragma unroll
            for (int dt = 0; dt < 2; ++dt)
#pragma unroll
                for (int kk = 0; kk < 2; ++kk) { const bf16* vp = VT + (size_t)(dt * 32 + r32) * 512 + nt * 32 + kk * 16 + 4 * hi;
                    const u32x2g va = *(const u32x2g*)vp, vb = *(const u32x2g*)(vp + 8); v4u vv; vv.x = va.x; vv.y = va.y; vv.z = vb.x; vv.w = vb.y;
                    if (dt == 0) o0 = __builtin_amdgcn_mfma_f32_32x32x16_bf16(kk ? pa1 : pa0, __builtin_bit_cast(bf16x8, vv), o0, 0, 0, 0);
                    else o1 = __builtin_amdgcn_mfma_f32_32x32x16_bf16(kk ? pa1 : pa0, __builtin_bit_cast(bf16x8, vv), o1, 0, 0, 0); } }
        { bf16* T = (bf16*)(a.ws + WS_OATMP);
#pragma unroll
          for (int r = 0; r < 16; ++r) { const size_t row = rowbase + qw0 + crow32(r, hi); const float gs = sigm(bf2f(Y[row * YP + Y_AG + head * 3]));
              T[row * 512 + head * 64 + r32] = (bf16)f2bf(gs * o0[r]); T[row * 512 + head * 64 + 32 + r32] = (bf16)f2bf(gs * o1[r]); } }
        __syncthreads();
        { const int qi = F.tid >> 3, part = F.tid & 7, cur = c; unsigned key[16];
#pragma unroll
          for (int i = 0; i < 16; ++i) { const int j = part * 16 + i; const unsigned raw = impI[qi * 129 + j] >> 6; const bool forced = (j == 0) || (j == cur) || (j == cur - 1);
              key[i] = forced ? (0xFFFFFF80u | (unsigned)(127 - j)) : (j <= cur ? ((((raw > 33554430u ? 33554430u : raw) + 1u) << 7) | (unsigned)(127 - j)) : (unsigned)(127 - j)); }
          unsigned T = 0u;
          for (int bit = 31; bit >= 0; --bit) { const unsigned Tt = T | (1u << bit); int cnt = 0;
#pragma unroll
              for (int i = 0; i < 16; ++i) cnt += key[i] >= Tt ? 1 : 0;
              cnt = red8(cnt); if (cnt >= 16) T = Tt; }
          unsigned bits = 0u;
#pragma unroll
          for (int i = 0; i < 16; ++i) bits |= (key[i] >= T && (part * 16 + i) <= cur) ? (1u << i) : 0u;
          ((unsigned short*)(a.ws + WS_MASK))[((size_t)bg * S_ + q0 + qi) * 8 + part] = (unsigned short)bits; }
    }
}
constexpr int CP_RED = 0, CP_HS = 8 * 32 * 64 * 4, CP_END = CP_HS + 32 * GP * 2;
static_assert(CP_END <= RING_BYTES, "compress LDS map");
__device__ __forceinline__ void compress_fast(Frame& F, const Args& a) {
    const bf16* Y = (const bf16*)(a.ws + WS_Y);
    LAS float* red = (LAS float*)(F.lds + RING_OFF + CP_RED); LAS bf16* hs = (LAS bf16*)(F.lds + RING_OFF + CP_HS);
    const int lane = F.lane, r32 = lane & 31, hi = lane >> 5, w = F.wave;
    for (int u = blockIdx.x; u < 256; u += F.G) {
        const int nt = u & 15, bg = (u >> 4) & 7, kv = u >> 7, g = bg & 1, b = bg >> 1;
        const int n = nt * 32 + r32, nn = n > 510 ? 510 : n;
        const bf16* xrow = Y + ((size_t)b * S_ + 16 * nn) * YP + (kv ? Y_AVC : Y_AKC) + g * 64 + hi * 8;
        const bf16* W1T = (const bf16*)(a.ws + WS_CW1T) + (size_t)kv * 64 * 2048;
        f32x16g acc0 = {}, acc1 = {};
#pragma unroll 4
        for (int s = 0; s < 16; ++s) { const int ks = w * 16 + s, pos = ks >> 2;
            const bf16x8 af = *(const bf16x8*)(xrow + (size_t)pos * YP + (ks & 3) * 16);
            const bf16x8 b0 = *(const bf16x8*)(W1T + (size_t)r32 * 2048 + ks * 16 + hi * 8), b1 = *(const bf16x8*)(W1T + (size_t)(32 + r32) * 2048 + ks * 16 + hi * 8);
            acc0 = __builtin_amdgcn_mfma_f32_32x32x16_bf16(af, b0, acc0, 0, 0, 0); acc1 = __builtin_amdgcn_mfma_f32_32x32x16_bf16(af, b1, acc1, 0, 0, 0); }
#pragma unroll
        for (int r = 0; r < 16; ++r) { red[(w * 32 + crow32(r, hi)) * 64 + r32] = acc0[r]; red[(w * 32 + crow32(r, hi)) * 64 + 32 + r32] = acc1[r]; }
        __syncthreads();
        { const float* c0 = (const float*)(a.ws + WS_CC0) + kv * 64;
#pragma unroll
          for (int i = 0; i < 4; ++i) { const int e = F.tid * 4 + i, rn = e >> 6, j = e & 63; float v = c0[j];
#pragma unroll
              for (int ww = 0; ww < 8; ++ww) v += red[(ww * 32 + rn) * 64 + j];
              hs[rn * GP + j] = (bf16)f2bf(gelu_tanh(v)); } }
        __syncthreads();
        if (w < 2) { const bf16* W2T = (const bf16*)(a.ws + WS_CW2T) + (size_t)kv * 64 * 64; f32x16g o = {};
#pragma unroll
            for (int ks = 0; ks < 4; ++ks) { const bf16x8 bf = *(const bf16x8*)(W2T + (size_t)(w * 32 + r32) * 64 + ks * 16 + hi * 8);
                o = __builtin_amdgcn_mfma_f32_32x32x16_bf16(lds_frag(hs, r32, ks * 16 + hi * 8), bf, o, 0, 0, 0); }
#pragma unroll
            for (int r = 0; r < 16; ++r) { const int rn = nt * 32 + crow32(r, hi), jp = w * 32 + r32;
                if (kv == 0) ((bf16*)(a.ws + WS_KCMP))[((size_t)bg * 512 + rn) * 64 + jp] = (bf16)f2bf(o[r]);
                else ((bf16*)(a.ws + WS_VCMPT))[((size_t)bg * 64 + jp) * 512 + rn] = (bf16)f2bf(o[r]); } }
        __syncthreads();
    }
}
__device__ __forceinline__ void gla_out_naive(Frame& F, const Args& a, int l) {
    const int gw = blockIdx.x * NWAVES + F.wave, NGW = F.G * NWAVES, lane = F.lane;
    bf16* Y = (bf16*)(a.ws + WS_Y); const bf16* O16 = (const bf16*)(a.ws + WS_O16); const float* nw = a.in[15] + (size_t)l * 128;
    for (int t = gw; t < M_ * 4; t += NGW) {
        const int h = t & 3; const size_t row = (size_t)(t >> 2);
        const float o0 = bf2f(O16[row * 512 + h * 128 + lane]), o1 = bf2f(O16[row * 512 + h * 128 + 64 + lane]);
        const float r = rsqrtf(wave_sum(o0 * o0 + o1 * o1) * (1.f / 128.f) + NORM_EPS);
        bf16* yr = Y + row * YP + Y_BR + h * 128;
        const float r0 = bf2f(yr[lane]), r1 = bf2f(yr[64 + lane]);
        yr[lane] = (bf16)f2bf(o0 * r * nw[lane] * (r0 * sigm(r0))); yr[64 + lane] = (bf16)f2bf(o1 * r * nw[64 + lane] * (r1 * sigm(r1)));
    }
}

__device__ __forceinline__ Frame fresh(const Frame& F) { Frame f = F; int t = threadIdx.x; asm volatile("" : "+v"(t)); f.tid = t; f.lane = t & 63; return f; }
constexpr int PPL = 11, NPH = NL * PPL;
#define IN(k) (lo <= (k) && (k) < hi)
#define SEAM(k) do { if (IN(k) && IN((k) + 1)) xcd_barrier(bar); } while (0)
template <int l> __device__ __forceinline__ void layer_body(Frame& F0, const Args& args, const XcdBarrier& bar, const int lo, const int hi) {
    unsigned char* ws = args.ws;
    bf16* H = (bf16*)(ws + WS_H); bf16* Y = (bf16*)(ws + WS_Y); unsigned char* G8 = ws + WS_G8;
    float* Yf = (float*)(ws + WS_Y); bf16* ACT = (bf16*)(ws + WS_ACT);
    constexpr int p0 = l * PPL;
    const float* xin = l == 0 ? args.in[0] : args.out;
    if (IN(p0 + 0)) { Frame F = fresh(F0); phase_weights(F, args, l); if (l == 0) phase_norm0(F, args.in[0], args.in[2], H); SEAM(p0 + 0); }
    if (IN(p0 + 1)) { Frame F = fresh(F0);
        pg8::Gemm g{H, (const bf16*)(ws + WS_WIN), M_, NIN, DM, DM}; pg8::StaticOrder So; So.init(M_, NIN, F.G, (int)blockIdx.x);
        pg8::EpiInProj E{Y, G8};
        pg8::gemm_phase<pg8::EpiInProj, pg8::StaticOrder, true, true>(F.lds + RING_OFF, g, So, E);
        SEAM(p0 + 1);
    }
    if (IN(p0 + 2)) { Frame F = fresh(F0); compress_fast(F, args); phase2_naive(F, args, l); gla_g1(F, args, l); SEAM(p0 + 2); }
    if (IN(p0 + 3)) { Frame F = fresh(F0); gla_g2(F, args); nsa_cmp_fast(F, args, l * 4 + 2); moba_fast(F, args, l * 4 + 0); SEAM(p0 + 3); }
    if (IN(p0 + 4)) { Frame F = fresh(F0); nsa_fast(F, args, l * 4 + 1); gla_g3(F, args, l); SEAM(p0 + 4); }
    if (IN(p0 + 5)) { Frame F = fresh(F0);
        pg8::StaticOrder So; So.init(M_, DM, F.G, (int)blockIdx.x);
        { pg8::Gemm g{Y + Y_AQ, (const bf16*)(ws + WS_WA), M_, DM, 512, YP}; pg8::EpiMerge<0> E{H, G8}; pg8::gemm_phase<pg8::EpiMerge<0>, pg8::StaticOrder, true, true>(F.lds + RING_OFF, g, So, E); }
        __syncthreads();
        { pg8::Gemm g{Y + Y_BR, (const bf16*)(ws + WS_WB), M_, DM, 512, YP}; pg8::EpiMerge<1> E{H, G8}; pg8::gemm_phase<pg8::EpiMerge<1>, pg8::StaticOrder, true, true>(F.lds + RING_OFF, g, So, E); }
        __syncthreads();
        { pg8::Gemm g{Y + Y_CQ, (const bf16*)(ws + WS_WC), M_, DM, 512, YP}; pg8::EpiMerge<2> E{H, G8}; pg8::gemm_phase<pg8::EpiMerge<2>, pg8::StaticOrder, true, true>(F.lds + RING_OFF, g, So, E); }
        SEAM(p0 + 5);
    }
    if (IN(p0 + 6)) { Frame F = fresh(F0);
        pg8::Gemm g{H, (const bf16*)(ws + WS_WO), M_, DM, DM, DM}; pg8::StaticOrder So; So.init(M_, DM, F.G, (int)blockIdx.x);
        pg8::EpiF32 E{Yf, DM}; pg8::gemm_phase<pg8::EpiF32, pg8::StaticOrder, true, true>(F.lds + RING_OFF, g, So, E);
        SEAM(p0 + 6);
    }
    if (IN(p0 + 7)) { Frame F = fresh(F0); phase_resid(F, Yf, xin, args.out, args.in[3] + (size_t)l * DM, args.in[4] + (size_t)l * DM, H); SEAM(p0 + 7); }
    if (IN(p0 + 8)) { Frame F = fresh(F0);
        pg8::Gemm g{H, (const bf16*)(ws + WS_WF1), M_, 2 * FF, DM, DM}; pg8::StaticOrder So; So.init(M_, 2 * FF, F.G, (int)blockIdx.x);
        pg8::EpiSwiglu E{ACT, FF}; pg8::gemm_phase<pg8::EpiSwiglu, pg8::StaticOrder, true, true>(F.lds + RING_OFF, g, So, E);
        SEAM(p0 + 8);
    }
    if (IN(p0 + 9)) { Frame F = fresh(F0);
        pg8::Gemm g{ACT, (const bf16*)(ws + WS_WF2), M_, DM, FF, FF}; pg8::StaticOrder So; So.init(M_, DM, F.G, (int)blockIdx.x);
        pg8::EpiF32 E{Yf, DM}; pg8::gemm_phase<pg8::EpiF32, pg8::StaticOrder, true, true>(F.lds + RING_OFF, g, So, E);
        SEAM(p0 + 9);
    }
    if (IN(p0 + 10)) { Frame F = fresh(F0); phase_resid(F, Yf, args.out, args.out, args.in[5] + (size_t)l * DM, l + 1 < NL ? args.in[2] + (size_t)(l + 1) * DM : nullptr, l + 1 < NL ? H : nullptr); SEAM(p0 + 10); }
}
__global__ void __launch_bounds__(NWAVES * 64, 2) mk_fwd(Args args) {
    extern __shared__ __attribute__((aligned(16))) unsigned char lds[];
    Frame F;
    F.lds = (LAS unsigned char*)lds; F.MISC = (volatile LAS unsigned*)(F.lds + MISC_OFF);
    F.tid = threadIdx.x; F.lane = F.tid & 63; F.wave = __builtin_amdgcn_readfirstlane(F.tid >> 6); F.G = gridDim.x;
    F.ctl = (gu32*)(args.ws + WS_CTL);
    for (int u = F.tid; u < (LDS_BYTES - LDSCTL_OFF) / 4; u += NWAVES * 64) ((LAS unsigned*)(F.lds + LDSCTL_OFF))[u] = 0u;
    __syncthreads();
    const int lo = args.ph_lo, hi = args.ph_hi;
    XcdBarrier bar; bar.bar = (unsigned*)(F.ctl + CW_BAR); bar.x = 0; bar.st = nullptr;
    if (hi - lo > 1) bar = xcd_barrier_post((unsigned*)(F.ctl + CW_BAR), F.MISC + 8);
    layer_body<0>(F, args, bar, lo, hi);
    layer_body<1>(F, args, bar, lo, hi);
}
#undef IN
#undef SEAM

#ifndef MK_ONE_LAUNCH
#define MK_ONE_LAUNCH 1
#endif
extern "C" void kernel_launch(void* const* d_in, const int* in_sizes, int n_in, void* d_out, int out_size, void* d_ws, size_t ws_size, hipStream_t stream) {
    static int grid = 0;
    if (grid == 0) {
        if (n_in != 22 || out_size != M_ * DM || ws_size < WS_END) { fprintf(stderr, "kernel_launch: unexpected sizes (n_in %d out %d ws %zu)\n", n_in, out_size, ws_size); grid = -1; return; }
        int dev = 0, cus = 0;
        if (hipGetDevice(&dev) != hipSuccess || hipDeviceGetAttribute(&cus, hipDeviceAttributeMultiprocessorCount, dev) != hipSuccess) { grid = -1; return; }
        if (hipFuncSetAttribute((const void*)mk_fwd, hipFuncAttributeMaxDynamicSharedMemorySize, LDS_BYTES) != hipSuccess) { grid = -1; return; }
        (void)hipGetLastError();
        grid = cus;
    }
    if (grid < 0) return;
    if (hipMemsetAsync((char*)d_ws + WS_CTL, 0, CTL_ZERO_BYTES, stream) != hipSuccess) return;
    Args a{};
    for (int i = 0; i < 22; ++i) a.in[i] = (const float*)d_in[i];
    a.out = (float*)d_out; a.ws = (unsigned char*)d_ws;
#if MK_ONE_LAUNCH
    a.ph_lo = 0; a.ph_hi = NPH;
    hipLaunchKernelGGL(mk_fwd, dim3(grid), dim3(NWAVES * 64), LDS_BYTES, stream, a);
#else
    for (int p = 0; p < NPH; ++p) { a.ph_lo = p; a.ph_hi = p + 1; hipLaunchKernelGGL(mk_fwd, dim3(grid), dim3(NWAVES * 64), LDS_BYTES, stream, a); }
#endif
}
```

```cpp
#include <hip/hip_runtime.h>
#include <cstdio>
#include <cstdint>
#include <cmath>
namespace pg8 {
#define PG8_LAS __attribute__((address_space(3)))
typedef unsigned short bf16_t;
typedef short bf16x8 __attribute__((ext_vector_type(8)));
typedef float f32x4 __attribute__((ext_vector_type(4)));
typedef unsigned u32x4 __attribute__((ext_vector_type(4)));
constexpr int BM = 256, BK = 64, HALF = 128, HTB = HALF * BK * 2  , STAGE_BYTES = 8 * HTB, NXCD = 8, WGM = 8;

__host__ __device__ __forceinline__ int lds_byte(int r, int c) { const int st = (r >> 4) * 2 + (c >> 5), rr = r & 15, cc = c & 31, ob = rr * 64 + cc * 2; return st * 1024 + (ob ^ (((ob >> 9) & 1) << 5)); }
__host__ __device__ __forceinline__ void stage_rc(int b, int& R, int& C) { const int st = b / 1024, sb = b % 1024, swz = sb ^ (((sb >> 9) & 1) << 5); R = (st >> 1) * 16 + swz / 64; C = (st & 1) * 32 + (swz % 64) / 2; }
__host__ __device__ __forceinline__ int perm32(int rho) { const int n = rho >> 4, i = rho & 15; return 8 * (i >> 2) + 4 * n + (i & 3); }

struct Unit { int pm, pn; };
struct Gemm { const bf16_t* A; const bf16_t* Bt; int M, N, K, lda; };

struct StaticOrder {
    int nM, nN, nwg, G, c;
    __host__ __device__ void init(int M, int N, int G_, int c_) { nM = M / BM; nN = N / BM; nwg = nM * nN; G = G_; c = c_; }
    __host__ __device__ bool next(int i, Unit& u) const {
        const long L = (long)i * G + c; if (L >= nwg) return false;
        int wgid = (int)L; { const int q = nwg / NXCD, r = nwg % NXCD, xcd = wgid % NXCD, off = wgid / NXCD; wgid = (xcd < r ? xcd * (q + 1) : r * (q + 1) + (xcd - r) * q) + off; }
        const int nig = WGM * nN, gid = wgid / nig, fm = gid * WGM, gsz = (nM - fm) < WGM ? (nM - fm) : WGM;
        u.pm = fm + ((wgid % nig) % gsz); u.pn = (wgid % nig) / gsz; return true;
    }
    __device__ __forceinline__ void a_ready(const Unit&) const {}
    __device__ __forceinline__ void done(const Unit&) const {}
};

__device__ __forceinline__ unsigned cvt_pk_bf16(float lo, float hi) { unsigned r; asm volatile("v_cvt_pk_bf16_f32 %0, %1, %2" : "=v"(r) : "v"(lo), "v"(hi)); return r; }
typedef float f32x2 __attribute__((ext_vector_type(2)));
constexpr int YP_ = 4392;
constexpr float C2_ = 0.125f * 1.4426950408889634f;
__device__ __forceinline__ float sigmoidf_(float v) { return 1.f / (1.f + __expf(-v)); }
struct EpiInProj {
    static constexpr bool PERM = true, AFTER_DRAIN = false;
    bf16_t* Y; unsigned char* G8;
    __device__ __forceinline__ void operator()(const f32x4 (&acc)[2][2][4][2], const Unit& u, int wr, int wc, int fr, int fq) const {
        const int row0 = u.pm * BM + wr * 64 + fr, colt = u.pn * BM, cin = wc * 32 + 8 * fq;
        if (u.pn < 18) {
            float sc = 1.f; if (u.pn < 2 || u.pn == 5 || u.pn == 6) sc = C2_; else if (u.pn == 11) sc = 0.125f;
#pragma unroll
            for (int ai = 0; ai < 2; ++ai)
#pragma unroll
                for (int m = 0; m < 4; ++m) { bf16_t* rowp = Y + (size_t)(row0 + ai * HALF + m * 16) * YP_;
#pragma unroll
                    for (int bj = 0; bj < 2; ++bj) { const int col = colt + cin + bj * HALF;
                        if (col + 8 <= YP_) { const f32x4 v0 = acc[ai][bj][m][0] * sc, v1 = acc[ai][bj][m][1] * sc; u32x4 w;
                            w.x = cvt_pk_bf16(v0[0], v0[1]); w.y = cvt_pk_bf16(v0[2], v0[3]); w.z = cvt_pk_bf16(v1[0], v1[1]); w.w = cvt_pk_bf16(v1[2], v1[3]);
                            *(u32x4*)(rowp + col) = w; } } }
        } else {
#pragma unroll
            for (int ai = 0; ai < 2; ++ai)
#pragma unroll
                for (int m = 0; m < 4; ++m) { unsigned char* rowp = G8 + (size_t)(row0 + ai * HALF + m * 16) * 3072 + (colt - 4608) + cin;
#pragma unroll
                    for (int bj = 0; bj < 2; ++bj) { const f32x4 v0 = acc[ai][bj][m][0], v1 = acc[ai][bj][m][1]; unsigned lo = 0u, hi = 0u;
#pragma unroll
                        for (int e = 0; e < 4; ++e) { lo |= (unsigned)(sigmoidf_(v0[e]) * 255.f + 0.5f) << (8 * e); hi |= (unsigned)(sigmoidf_(v1[e]) * 255.f + 0.5f) << (8 * e); }
                        typedef unsigned u32x2 __attribute__((ext_vector_type(2))); u32x2 w; w.x = lo; w.y = hi; *(u32x2*)(rowp + bj * HALF) = w; } }
        }
    }
};
template <int I> struct EpiMerge {
    static constexpr bool PERM = true, AFTER_DRAIN = false;
    bf16_t* Mg; const unsigned char* G8;
    __device__ __forceinline__ void operator()(const f32x4 (&acc)[2][2][4][2], const Unit& u, int wr, int wc, int fr, int fq) const {
        const int row0 = u.pm * BM + wr * 64 + fr, col0 = u.pn * BM + wc * 32 + 8 * fq;
#pragma unroll
        for (int ai = 0; ai < 2; ++ai)
#pragma unroll
            for (int m = 0; m < 4; ++m) { const size_t row = (size_t)(row0 + ai * HALF + m * 16);
#pragma unroll
                for (int bj = 0; bj < 2; ++bj) { const int col = col0 + bj * HALF;
                    typedef unsigned u32x2 __attribute__((ext_vector_type(2)));
                    const u32x2 gw = *(const u32x2*)(G8 + row * 3072 + I * 1024 + col);
                    float v[8];
#pragma unroll
                    for (int e = 0; e < 4; ++e) { v[e] = acc[ai][bj][m][0][e] * ((float)((gw.x >> (8 * e)) & 255u) * (1.f / 255.f)); v[4 + e] = acc[ai][bj][m][1][e] * ((float)((gw.y >> (8 * e)) & 255u) * (1.f / 255.f)); }
                    bf16_t* p = Mg + row * 1024 + col;
                    if (I > 0) { const u32x4 o = *(const u32x4*)p;
                        v[0] += __uint_as_float(o.x << 16); v[1] += __uint_as_float(o.x & 0xffff0000u); v[2] += __uint_as_float(o.y << 16); v[3] += __uint_as_float(o.y & 0xffff0000u);
                        v[4] += __uint_as_float(o.z << 16); v[5] += __uint_as_float(o.z & 0xffff0000u); v[6] += __uint_as_float(o.w << 16); v[7] += __uint_as_float(o.w & 0xffff0000u); }
                    u32x4 w; w.x = cvt_pk_bf16(v[0], v[1]); w.y = cvt_pk_bf16(v[2], v[3]); w.z = cvt_pk_bf16(v[4], v[5]); w.w = cvt_pk_bf16(v[6], v[7]);
                    *(u32x4*)p = w; } }
    }
};
struct EpiF32 {
    static constexpr bool PERM = true, AFTER_DRAIN = false;
    float* O; int ldc;
    __device__ __forceinline__ void operator()(const f32x4 (&acc)[2][2][4][2], const Unit& u, int wr, int wc, int fr, int fq) const {
        const int row0 = u.pm * BM + wr * 64 + fr, col0 = u.pn * BM + wc * 32 + 8 * fq;
#pragma unroll
        for (int ai = 0; ai < 2; ++ai)
#pragma unroll
            for (int m = 0; m < 4; ++m) { float* rowp = O + (size_t)(row0 + ai * HALF + m * 16) * ldc + col0;
#pragma unroll
                for (int bj = 0; bj < 2; ++bj) { *(f32x4*)(rowp + bj * HALF) = acc[ai][bj][m][0]; *(f32x4*)(rowp + bj * HALF + 4) = acc[ai][bj][m][1]; } }
    }
};
struct EpiSwiglu {
    static constexpr bool PERM = true, AFTER_DRAIN = false;
    bf16_t* Act; int ldc;
    __device__ __forceinline__ void operator()(const f32x4 (&acc)[2][2][4][2], const Unit& u, int wr, int wc, int fr, int fq) const {
        const int row0 = u.pm * BM + wr * 64 + fr, col0 = u.pn * HALF + wc * 32 + 8 * fq;
#pragma unroll
        for (int ai = 0; ai < 2; ++ai)
#pragma unroll
            for (int m = 0; m < 4; ++m) { bf16_t* p = Act + (size_t)(row0 + ai * HALF + m * 16) * ldc + col0; float v[8];
#pragma unroll
                for (int e = 0; e < 4; ++e) { const float g0 = acc[ai][0][m][0][e], g1 = acc[ai][0][m][1][e];
                    v[e] = g0 * sigmoidf_(g0) * acc[ai][1][m][0][e]; v[4 + e] = g1 * sigmoidf_(g1) * acc[ai][1][m][1][e]; }
                u32x4 w; w.x = cvt_pk_bf16(v[0], v[1]); w.y = cvt_pk_bf16(v[2], v[3]); w.z = cvt_pk_bf16(v[4], v[5]); w.w = cvt_pk_bf16(v[6], v[7]);
                *(u32x4*)p = w; }
    }
};
template <class Epi, class Sched, bool ALIGN_EPI = false, bool SP2 = false>
__device__ __forceinline__ void gemm_phase(PG8_LAS unsigned char* lds, const Gemm g, const Sched& S, const Epi& E) {
    int tid_l = threadIdx.x; asm volatile("" : "+v"(tid_l));
    const int tid = tid_l, wid = __builtin_amdgcn_readfirstlane(tid >> 6), lane = tid & 63, wr = wid >> 2, wc = wid & 3, fr = lane & 15, fq = lane >> 4;
    const int K = g.K, nt = K / BK;
    unsigned voffA[2], voffB[2];
#pragma unroll
    for (int i = 0; i < 2; ++i) { int R, C; stage_rc(tid * 16 + i * 8192, R, C); const int Rb = Epi::PERM ? ((R & ~31) + perm32(R & 31)) : R;
        voffA[i] = (unsigned)(R * g.lda + C) * 2u; voffB[i] = (unsigned)(Rb * K + C) * 2u; }
    const size_t kstep = (size_t)(BK * 2);
    const size_t hstepB = (size_t)HALF * K * 2, hstepA = (size_t)HALF * g.lda * 2;
    const size_t tstepA = 2 * hstepA, tstepB = 2 * hstepB;
    const unsigned ldsw = (unsigned)wid * 1024u;
    const int aoff = lds_byte(wr * 64 + fr, fq * 8), boff = lds_byte(wc * 32 + fr, fq * 8);
#define PG8_SA(b, h) (((b) * 2 + (h)) * HTB)
#define PG8_SB(b, h) ((4 + (b) * 2 + (h)) * HTB)
#define PG8_STAGE(bufoff, gbase, voff) do { _Pragma("unroll") for (int _i = 0; _i < 2; ++_i) \
        __builtin_amdgcn_global_load_lds((const unsigned*)((const char*)(gbase) + (voff)[_i]), (PG8_LAS unsigned*)(lds + (bufoff) + ldsw + _i * 8192), 16, 0, 0); } while (0)
#define PG8_LDA(dst, b, h) do { _Pragma("unroll") for (int m = 0; m < 4; ++m) _Pragma("unroll") for (int k = 0; k < 2; ++k) dst[m][k] = *(const PG8_LAS bf16x8*)(lds + PG8_SA(b, h) + aoff + m * 2048 + k * 1024); } while (0)
#define PG8_LDB(dst, b, h) do { _Pragma("unroll") for (int n = 0; n < 2; ++n) _Pragma("unroll") for (int k = 0; k < 2; ++k) dst[n][k] = *(const PG8_LAS bf16x8*)(lds + PG8_SB(b, h) + boff + n * 2048 + k * 1024); } while (0)
#define PG8_MMA(ai, bj, At, Bt) do { __builtin_amdgcn_s_setprio(1); _Pragma("unroll") for (int m = 0; m < 4; ++m) _Pragma("unroll") for (int n = 0; n < 2; ++n) _Pragma("unroll") for (int k = 0; k < 2; ++k) \
        acc[ai][bj][m][n] = __builtin_amdgcn_mfma_f32_16x16x32_bf16(Bt[n][k], At[m][k], acc[ai][bj][m][n], 0, 0, 0); __builtin_amdgcn_s_setprio(0); } while (0)
#define PG8_WAIT_V(n) asm volatile("s_waitcnt vmcnt(" #n ")" ::: "memory")
#define PG8_WAIT_L(n) asm volatile("s_waitcnt lgkmcnt(" #n ")" ::: "memory")
#define PG8_BAR __builtin_amdgcn_s_barrier()
#define PG8_SCHED __builtin_amdgcn_sched_barrier(0)
    Unit cur, nxt; int ui = 0;
    if (!S.next(0, cur)) return;
    f32x4 acc[2][2][4][2];
#pragma unroll
    for (int a = 0; a < 2; ++a)
#pragma unroll
        for (int b = 0; b < 2; ++b)
#pragma unroll
            for (int m = 0; m < 4; ++m)
#pragma unroll
                for (int n = 0; n < 2; ++n) acc[a][b][m][n] = (f32x4){0.f, 0.f, 0.f, 0.f};
    bf16x8 At[4][2], B0[2][2], B1[2][2];
    const char* cA = (const char*)g.A + (size_t)cur.pm * tstepA; const char* cB = (const char*)g.Bt + (size_t)cur.pn * tstepB;
    S.a_ready(cur);
    if constexpr (SP2) {
        PG8_STAGE(PG8_SB(0, 0), cB, voffB); PG8_STAGE(PG8_SB(0, 1), cB + hstepB, voffB); PG8_STAGE(PG8_SA(0, 0), cA, voffA); PG8_STAGE(PG8_SA(0, 1), cA + hstepA, voffA);
        if (wr == 1) PG8_BAR;
        PG8_WAIT_V(2); PG8_BAR;
        PG8_STAGE(PG8_SB(1, 0), cB + kstep, voffB); PG8_STAGE(PG8_SA(1, 0), cA + kstep, voffA); PG8_STAGE(PG8_SB(1, 1), cB + hstepB + kstep, voffB);
        PG8_WAIT_V(6); PG8_BAR;
    } else {
        PG8_STAGE(PG8_SB(0, 0), cB, voffB); PG8_STAGE(PG8_SA(0, 0), cA, voffA); PG8_STAGE(PG8_SB(0, 1), cB + hstepB, voffB); PG8_STAGE(PG8_SA(0, 1), cA + hstepA, voffA);
        if (wr == 1) PG8_BAR;
        PG8_WAIT_V(4); PG8_BAR;
        PG8_STAGE(PG8_SB(1, 0), cB + kstep, voffB); PG8_STAGE(PG8_SA(1, 0), cA + kstep, voffA); PG8_STAGE(PG8_SB(1, 1), cB + hstepB + kstep, voffB);
        PG8_WAIT_V(6); PG8_BAR;
    }
    for (;;) {
        const bool has_next = S.next(ui + 1, nxt);
        const char* nA = has_next ? (const char*)g.A + (size_t)nxt.pm * tstepA : cA; const char* nB = has_next ? (const char*)g.Bt + (size_t)nxt.pn * tstepB : cB;
        for (int t = 0; t < nt; t += 2) {
            const bool last = (t == nt - 2);
            const char* a1 = cA + (size_t)(t + 1) * kstep;
            const char* a2 = last ? nA : cA + (size_t)(t + 2) * kstep; const char* b2 = last ? nB : cB + (size_t)(t + 2) * kstep;
            const char* a3 = a2 + kstep; const char* b3 = b2 + kstep;
            if (last && has_next) S.a_ready(nxt);
            if constexpr (SP2) {
            PG8_LDB(B0, 0, 0); PG8_LDB(B1, 0, 1); PG8_SCHED; PG8_LDA(At, 0, 0); PG8_STAGE(PG8_SA(1, 1), a1 + hstepA, voffA);
            PG8_WAIT_V(8); PG8_WAIT_L(0); PG8_BAR; PG8_MMA(0, 0, At, B0); PG8_MMA(0, 1, At, B1); PG8_BAR; PG8_SCHED;
            PG8_LDA(At, 0, 1); PG8_STAGE(PG8_SB(0, 0), b2, voffB); PG8_STAGE(PG8_SB(0, 1), b2 + hstepB, voffB); PG8_STAGE(PG8_SA(0, 0), a2, voffA);
            PG8_WAIT_V(8); PG8_WAIT_L(0); PG8_BAR; PG8_MMA(1, 0, At, B0); PG8_MMA(1, 1, At, B1); PG8_BAR; PG8_SCHED;
            PG8_LDB(B0, 1, 0); PG8_LDB(B1, 1, 1); PG8_SCHED; PG8_LDA(At, 1, 0); PG8_STAGE(PG8_SA(0, 1), a2 + hstepA, voffA);
            PG8_WAIT_V(8); PG8_WAIT_L(0); PG8_BAR; PG8_MMA(0, 0, At, B0); PG8_MMA(0, 1, At, B1); PG8_BAR; PG8_SCHED;
            PG8_LDA(At, 1, 1); PG8_STAGE(PG8_SB(1, 0), b3, voffB); PG8_STAGE(PG8_SB(1, 1), b3 + hstepB, voffB); PG8_STAGE(PG8_SA(1, 0), a3, voffA);
            PG8_WAIT_V(8); PG8_WAIT_L(0); PG8_BAR; PG8_MMA(1, 0, At, B0); PG8_MMA(1, 1, At, B1); PG8_BAR; PG8_SCHED;
            } else {
            PG8_LDB(B0, 0, 0); PG8_SCHED; PG8_LDA(At, 0, 0); PG8_STAGE(PG8_SA(1, 1), a1 + hstepA, voffA);
            PG8_WAIT_L(8); PG8_BAR; PG8_WAIT_L(0); PG8_MMA(0, 0, At, B0); PG8_BAR; PG8_SCHED;
            PG8_LDB(B1, 0, 1); PG8_STAGE(PG8_SB(0, 0), b2, voffB);
            PG8_BAR; PG8_WAIT_L(0); PG8_MMA(0, 1, At, B1); PG8_BAR;
            PG8_LDA(At, 0, 1); PG8_STAGE(PG8_SA(0, 0), a2, voffA);
            PG8_BAR; PG8_WAIT_L(0); PG8_MMA(1, 0, At, B0); PG8_BAR; PG8_SCHED;
            PG8_STAGE(PG8_SB(0, 1), b2 + hstepB, voffB);
            PG8_WAIT_V(6); PG8_BAR; PG8_MMA(1, 1, At, B1); PG8_BAR;
            PG8_LDB(B0, 1, 0); PG8_SCHED; PG8_LDA(At, 1, 0); PG8_STAGE(PG8_SA(0, 1), a2 + hstepA, voffA);
            PG8_WAIT_L(8); PG8_BAR; PG8_WAIT_L(0); PG8_MMA(0, 0, At, B0); PG8_BAR; PG8_SCHED;
            PG8_LDB(B1, 1, 1); PG8_STAGE(PG8_SB(1, 0), b3, voffB);
            PG8_BAR; PG8_WAIT_L(0); PG8_MMA(0, 1, At, B1); PG8_BAR;
            PG8_LDA(At, 1, 1); PG8_STAGE(PG8_SA(1, 0), a3, voffA);
            PG8_BAR; PG8_WAIT_L(0); PG8_MMA(1, 0, At, B0); PG8_BAR; PG8_SCHED;
            PG8_STAGE(PG8_SB(1, 1), b3 + hstepB, voffB);
            PG8_WAIT_V(6); PG8_BAR; PG8_MMA(1, 1, At, B1); PG8_BAR;
            }
        }
        if constexpr (ALIGN_EPI) { if (wr == 0) PG8_BAR; }
        if constexpr (!Epi::AFTER_DRAIN) { E(acc, cur, wr, wc, fr, fq); S.done(cur); }
        if (!has_next) break;
#pragma unroll
        for (int a = 0; a < 2; ++a)
#pragma unroll
            for (int b = 0; b < 2; ++b)
#pragma unroll
                for (int m = 0; m < 4; ++m)
#pragma unroll
                    for (int n = 0; n < 2; ++n) acc[a][b][m][n] = (f32x4){0.f, 0.f, 0.f, 0.f};
        cur = nxt; cA = nA; cB = nB; ++ui;
        if constexpr (ALIGN_EPI) { if (wr == 1) PG8_BAR; }
    }
    PG8_WAIT_V(0);
    if constexpr (!ALIGN_EPI) { if (wr == 0) PG8_BAR; }
    PG8_BAR;
    if constexpr (Epi::AFTER_DRAIN) { E.fused(acc, cur, wr, wc, fr, fq, lds, wid, lane); S.done(cur); }
#undef PG8_SA
#undef PG8_SB
#undef PG8_STAGE
#undef PG8_LDA
#undef PG8_LDB
#undef PG8_MMA
#undef PG8_WAIT_V
#undef PG8_WAIT_L
#undef PG8_BAR
#undef PG8_SCHED
}
}
namespace attn {
using bf16=unsigned short;
using bf16x8=__attribute__((ext_vector_type(8)))short;
using s16x4=__attribute__((ext_vector_type(4)))short;
using f32x16=__attribute__((ext_vector_type(16)))float;
using u32x4=__attribute__((ext_vector_type(4)))unsigned;
constexpr int D=64, PITCH=4392, SEQ=8192;
constexpr int NW=8,QBLK=32,QB=QBLK*NW,KVBLK=64;
__device__ __forceinline__ int crow(int r,int hi){return (r&3)+8*(r>>2)+4*hi;}
#define SBAR() __builtin_amdgcn_sched_barrier(0)
using f32x4_=__attribute__((ext_vector_type(4)))float;
__device__ __forceinline__ float bfs(short v){ return __uint_as_float(((unsigned)(unsigned short)v)<<16); }
__device__ __forceinline__ float lo16(unsigned w){ return __uint_as_float(w<<16); }
__device__ __forceinline__ float hi16(unsigned w){ return __uint_as_float(w&0xffff0000u); }
__device__ __forceinline__ bf16 f2b(float f){ unsigned u=__float_as_uint(f); return (bf16)((u+0x7fffu+((u>>16)&1u))>>16); }
__device__ __forceinline__ unsigned pk2b(float lo,float hi){ return (unsigned)f2b(lo)|((unsigned)f2b(hi)<<16); }
constexpr int NSLOT=3, SLOTB=8192;
constexpr int LDS_K=0, LDS_V=NSLOT*SLOTB, LDS_WS=2*NSLOT*SLOTB, LDS_OST=LDS_WS+NW*128*4, LDS_BIAS=LDS_OST+NW*4096, LDS_MSK=LDS_BIAS+512, LDS_KM=LDS_MSK+NW*512, LDS_BYTES=LDS_KM+8192;
constexpr float LOG2E_=1.4426950408889634f;
__device__ __forceinline__ void glds16(const void*gsrc,unsigned lds_dst){unsigned keep;
  asm volatile("s_mov_b32 %0, m0\n\ts_mov_b32 m0, %2\n\ts_nop 0\n\tglobal_load_lds_dwordx4 %1, off\n\ts_mov_b32 m0, %0":"=&s"(keep):"v"(gsrc),"s"(lds_dst):"memory");}
__device__ __forceinline__ float max3f(float a,float b,float c){float r;asm("v_max3_f32 %0, %1, %2, %3":"=v"(r):"v"(a),"v"(b),"v"(c));return r;}
__device__ __forceinline__ float max2f(float a,float b){float r;asm("v_max_f32_e32 %0, %1, %2":"=v"(r):"v"(a),"v"(b));return r;}
__device__ __forceinline__ float fadd_s(float a,float b){float r;asm("v_add_f32_e32 %0, %1, %2":"=v"(r):"v"(a),"v"(b));return r;}
__device__ __forceinline__ float fsub_s(float a,float b){float r;asm("v_sub_f32_e32 %0, %1, %2":"=v"(r):"v"(a),"v"(b));return r;}
typedef float f32x2_t __attribute__((ext_vector_type(2))); typedef __bf16 bf16x2_t __attribute__((ext_vector_type(2)));
__device__ __forceinline__ unsigned cvtpk_s(float lo,float hi){f32x2_t v={lo,hi};bf16x2_t b=__builtin_convertvector(v,bf16x2_t);return __builtin_bit_cast(unsigned,b);}
#define WAIT_BAR(N) asm volatile("s_waitcnt vmcnt(" #N ") lgkmcnt(0)\n\ts_barrier":::"memory")

__device__ __forceinline__ void qkt(f32x16&p0,f32x16&p1,const char*Kslot,const bf16x8*qr,const f32x16&negm,int r32,int hi){
  const char*kb=Kslot+hi*1024+r32*16;
  #pragma unroll
  for(int d0=0;d0<4;++d0){
    const bf16x8 b0=*reinterpret_cast<const bf16x8*>(kb+d0*2048);
    const bf16x8 b1=*reinterpret_cast<const bf16x8*>(kb+d0*2048+512);
    if(d0==0){p0=__builtin_amdgcn_mfma_f32_32x32x16_bf16(b0,qr[0],negm,0,0,0);p1=__builtin_amdgcn_mfma_f32_32x32x16_bf16(b1,qr[0],negm,0,0,0);}
    else{p0=__builtin_amdgcn_mfma_f32_32x32x16_bf16(b0,qr[d0],p0,0,0,0);p1=__builtin_amdgcn_mfma_f32_32x32x16_bf16(b1,qr[d0],p1,0,0,0);}}
}
typedef __attribute__((address_space(3))) const char* lds_cptr;
typedef short v4i16_t __attribute__((ext_vector_type(4)));
__device__ __forceinline__ void kload8(bf16x8*kf,lds_cptr kp){
  kf[0]=*(const __attribute__((address_space(3))) bf16x8*)(kp);      kf[1]=*(const __attribute__((address_space(3))) bf16x8*)(kp+512);
  kf[2]=*(const __attribute__((address_space(3))) bf16x8*)(kp+2048); kf[3]=*(const __attribute__((address_space(3))) bf16x8*)(kp+2560);
  kf[4]=*(const __attribute__((address_space(3))) bf16x8*)(kp+4096); kf[5]=*(const __attribute__((address_space(3))) bf16x8*)(kp+4608);
  kf[6]=*(const __attribute__((address_space(3))) bf16x8*)(kp+6144); kf[7]=*(const __attribute__((address_space(3))) bf16x8*)(kp+6656);
}
__device__ __forceinline__ void kload2(bf16x8*kf,lds_cptr kp,int j){ kf[2*j]=*(const __attribute__((address_space(3))) bf16x8*)(kp+j*2048); kf[2*j+1]=*(const __attribute__((address_space(3))) bf16x8*)(kp+j*2048+512); }
__device__ __forceinline__ s16x4 vtr(lds_cptr p){ return __builtin_bit_cast(s16x4,__builtin_amdgcn_ds_read_tr16_b64_v4i16((__attribute__((address_space(3))) v4i16_t*)p)); }
__device__ __forceinline__ float rowmax(const f32x16&p0,const f32x16&p1){
  float a=max3f(p0[0],p0[1],p1[0]),b=max3f(p0[2],p0[3],p1[1]);a=max3f(a,p1[2],p1[3]);
  #pragma unroll
  for(int r=4;r<16;r+=4){a=max3f(a,p0[r],p0[r+1]);b=max3f(b,p0[r+2],p0[r+3]);a=max3f(a,p1[r],p1[r+1]);b=max3f(b,p1[r+2],p1[r+3]);}
  const float m=max2f(a,b);
  auto rr=__builtin_amdgcn_permlane32_swap(__float_as_uint(m),__float_as_uint(m),false,false);
  return max2f(__uint_as_float(rr[0]),__uint_as_float(rr[1]));
}
__device__ __forceinline__ void pv(f32x16*o,int vb,bf16x8 pa0,bf16x8 pa1,bf16x8 pa2,bf16x8 pa3){
  #pragma unroll
  for(int d0=0;d0<2;++d0){s16x4 lo[4],hi[4];
    #pragma unroll
    for(int ks=0;ks<4;++ks){
      asm volatile("ds_read_b64_tr_b16 %0,%1 offset:%c2":"=&v"(lo[ks]):"v"(vb),"i"(d0*4096+ks*1024):"memory");
      asm volatile("ds_read_b64_tr_b16 %0,%1 offset:%c2":"=&v"(hi[ks]):"v"(vb),"i"(d0*4096+ks*1024+512):"memory");}
    asm volatile("s_waitcnt lgkmcnt(0)":::"memory");SBAR();
    #define PK(k) (bf16x8){lo[k][0],lo[k][1],lo[k][2],lo[k][3],hi[k][0],hi[k][1],hi[k][2],hi[k][3]}
    o[d0]=__builtin_amdgcn_mfma_f32_32x32x16_bf16(pa0,PK(0),o[d0],0,0,0);
    o[d0]=__builtin_amdgcn_mfma_f32_32x32x16_bf16(pa1,PK(1),o[d0],0,0,0);
    o[d0]=__builtin_amdgcn_mfma_f32_32x32x16_bf16(pa2,PK(2),o[d0],0,0,0);
    o[d0]=__builtin_amdgcn_mfma_f32_32x32x16_bf16(pa3,PK(3),o[d0],0,0,0);
    #undef PK
  }
}

#ifndef ATTN_STORE16
#define ATTN_STORE16(p,v) (*(u32x4*)(p)=(v))
#endif
struct UArgs {
  const bf16* Qb; const bf16* Kh; const bf16* Vh; bf16* Ob;
  int NT, q0, kt0, hc;
  const float* rel;
  const float* km; int qb;
  const unsigned* selg;
  const bf16* gate; int gcol;
  const bf16* tmp;
};
__device__ __forceinline__ int t5b(int d){ if(d<16)return d<0?0:d; int b=16; b+=(d>=19);b+=(d>=21);b+=(d>=24);b+=(d>=27);b+=(d>=31);b+=(d>=35);b+=(d>=40);b+=(d>=46);b+=(d>=52);b+=(d>=59);b+=(d>=67);b+=(d>=77);b+=(d>=87);b+=(d>=99);b+=(d>=113); return b; }
template<int MODE,int EPI,int THRL> __device__ __forceinline__ void attn_unit(const UArgs&U,char*shm){
  int tid_l=threadIdx.x; asm volatile("":"+v"(tid_l));
  const int tid=tid_l,lane=tid&63,r32=lane&31,hi=lane>>5; const int wid=__builtin_amdgcn_readfirstlane(tid>>6);
  const bf16*Qw=U.Qb+(long)(wid*QBLK)*PITCH;
  const bf16*Kh=U.Kh,*Vh=U.Vh;
  const unsigned lds0=(unsigned)(uintptr_t)shm;
  float*wsf=(float*)(shm+LDS_WS)+wid*128;
  const bf16*ksrc=Kh+(long)lane*PITCH+wid*8;
  const bf16*vsrc=Vh+(long)(16*(wid&3)+(lane>>2))*PITCH+(wid>>2)*32+(lane&3)*8;
  const unsigned kdst=lds0+LDS_K+wid*1024, vdst=lds0+LDS_V+wid*1024;
  #define DMA_K(t,slot) glds16(ksrc+(long)(t)*KVBLK*PITCH,(unsigned)__builtin_amdgcn_readfirstlane(kdst+(slot)))
  #define DMA_V(t,slot) glds16(vsrc+(long)(t)*KVBLK*PITCH,(unsigned)__builtin_amdgcn_readfirstlane(vdst+(slot)))
  const int vb0=(int)(lds0+LDS_V)+((lane>>4)&1)*32+(lane&3)*8+(4*hi+((lane&15)>>2))*64;
  const char*Kbase=shm+LDS_K; bf16x8 kf[8];
  const lds_cptr shm3=(lds_cptr)shm; const lds_cptr kp0=shm3+LDS_K+hi*1024+r32*16; const lds_cptr vp0=shm3+LDS_V+((lane>>4)&1)*32+(lane&3)*8+(4*hi+((lane&15)>>2))*64;
  const int NT=U.NT;
  const int qpos=U.q0+wid*QBLK+r32;
  float*biasT=(float*)(shm+LDS_BIAS);
  if(tid<128) biasT[tid]=(U.rel[t5b(tid)*16+U.hc]-U.rel[31*16+U.hc])*LOG2E_;
  unsigned selw=0u,cw=0u; const unsigned*mskp=(const unsigned*)(shm+LDS_MSK)+wid*128+r32*4;
  if(MODE==0){ ((u32x4*)(shm+LDS_KM))[tid]=((const u32x4*)U.km)[tid]; }
  if(MODE==1){ if(hi==0){ const u32x4 w=*(const u32x4*)(U.selg+(long)(wid*QBLK+r32)*4); *(u32x4*)((unsigned*)(shm+LDS_MSK)+wid*128+r32*4)=w; } }
  asm volatile("s_waitcnt vmcnt(0) lgkmcnt(0)\n\ts_barrier":::"memory");
  bf16x8 qr[4];
  #pragma unroll
  for(int d0=0;d0<4;++d0)qr[d0]=*reinterpret_cast<const bf16x8*>(&Qw[(long)r32*PITCH+d0*16+hi*8]);
  if(MODE==0){
    float v1=-INFINITY,v2=-INFINITY,v3=-INFINITY; int i1=-1,i2=-1,i3=-1;
    for(int n=0;n<U.qb;++n){ const float*km=(const float*)(shm+LDS_KM)+n*64+hi*8; float p=0.f;
      #pragma unroll
      for(int d0=0;d0<4;++d0){ const f32x4_ a=*(const f32x4_*)(km+d0*16), c=*(const f32x4_*)(km+d0*16+4);
        p+=bfs(qr[d0][0])*a[0]+bfs(qr[d0][1])*a[1]+bfs(qr[d0][2])*a[2]+bfs(qr[d0][3])*a[3]+bfs(qr[d0][4])*c[0]+bfs(qr[d0][5])*c[1]+bfs(qr[d0][6])*c[2]+bfs(qr[d0][7])*c[3]; }
      auto rr=__builtin_amdgcn_permlane32_swap(__float_as_uint(p),__float_as_uint(p),false,false); const float sc_=__uint_as_float(rr[0])+__uint_as_float(rr[1]);
      if(sc_>v1){v3=v2;i3=i2;v2=v1;i2=i1;v1=sc_;i1=n;} else if(sc_>v2){v3=v2;i3=i2;v2=sc_;i2=n;} else if(sc_>v3){v3=sc_;i3=n;} }
    if(i1>=0)selw|=1u<<i1; if(i2>=0)selw|=1u<<i2; if(i3>=0)selw|=1u<<i3; selw|=1u<<U.qb; }
  DMA_K(0,0);DMA_V(0,0);DMA_K(1,SLOTB);
  float mhat=0.f,l_reg=0.f;f32x16 o[2];o[0]=f32x16{};o[1]=f32x16{};f32x16 negm=f32x16{};asm volatile("":"+v"(negm));
  #define MASK_FAR(P0,P1,t) do{ bool on_=true; if(MODE==0)on_=((selw>>((t)>>2))&1u)!=0u; if(MODE==1){ if(((t)&31)==0)cw=mskp[(t)>>5]; on_=((cw>>((t)&31))&1u)!=0u; } \
      _Pragma("unroll") for(int r=0;r<16;++r){ P0[r]=on_?P0[r]:-INFINITY; P1[r]=on_?P1[r]:-INFINITY; } }while(0)
  #define MASK_BAND(P0,P1,t) do{ bool on_=true; if(MODE==0)on_=((selw>>((t)>>2))&1u)!=0u; if(MODE==1){ if(((t)&31)==0)cw=mskp[(t)>>5]; on_=((cw>>((t)&31))&1u)!=0u; } \
      const int kb_=U.kt0+64*(t), qw_=U.q0+wid*QBLK; \
      if((qw_-(kb_+63))<128||(MODE==2&&(qw_+31-kb_)>=512)){            \
      const int d0_=qpos-(kb_+4*hi); \
      _Pragma("unroll") for(int r=0;r<16;++r){ const int da_=d0_-((r&3)+8*(r>>2)), db_=da_-32; \
        const bool oka_=on_&&da_>=0&&(MODE!=2||da_<512), okb_=on_&&db_>=0&&(MODE!=2||db_<512); \
        const float ba_=biasT[da_<0?0:(da_>127?127:da_)], bb_=biasT[db_<0?0:(db_>127?127:db_)]; \
        P0[r]=oka_?P0[r]+ba_:-INFINITY; P1[r]=okb_?P1[r]+bb_:-INFINITY; \
        if((r&1)==1){ asm volatile("s_waitcnt lgkmcnt(0)":"+v"(P0),"+v"(P1)::"memory"); } } \
      } else if(MODE!=2){ _Pragma("unroll") for(int r=0;r<16;++r){ P0[r]=on_?P0[r]:-INFINITY; P1[r]=on_?P1[r]:-INFINITY; } } }while(0)
  #define CMASK(P0,P1,t) MASK_BAND(P0,P1,t)
  bool resc=false;
  #define START(P0,P1) do{ const float rm=rowmax(P0,P1); resc=false; \
    { const float dl=rm>-1e30f?rm:0.f; mhat=fadd_s(mhat,dl); \
      _Pragma("unroll") for(int r=0;r<16;++r){P0[r]=fsub_s(P0[r],dl);P1[r]=fsub_s(P1[r],dl);} \
      _Pragma("unroll") for(int r=0;r<16;++r)negm[r]=-mhat; asm volatile("":"+v"(negm)); } \
    _Pragma("unroll") for(int r=0;r<16;++r)P0[r]=__builtin_amdgcn_exp2f(P0[r]); }while(0)
  #define RESC() do{ if(resc){ asm volatile("s_waitcnt lgkmcnt(0)":::"memory"); \
      _Pragma("unroll") for(int d_=0;d_<2;++d_) _Pragma("unroll") for(int r=0;r<16;++r)o[d_][r]*=wsf[crow(r,hi)]; } }while(0)
  f32x16 pA0,pA1,pB0,pB1;
  int sl_prev=0,sl_cur=0,sl_next=SLOTB;
  #define ROT() do{sl_prev=sl_cur;sl_cur=sl_next;sl_next=(sl_next==(NSLOT-1)*SLOTB)?0:sl_next+SLOTB;}while(0)
  DMA_K(2,2*SLOTB);
  WAIT_BAR(3);
  qkt(pA0,pA1,Kbase,qr,negm,r32,hi);asm volatile("s_nop 15\n\ts_nop 7":"+v"(pA0),"+v"(pA1));CMASK(pA0,pA1,0);
  START(pA0,pA1);
  _Pragma("unroll") for(int r=0;r<16;++r)pA1[r]=__builtin_amdgcn_exp2f(pA1[r]);
  WAIT_BAR(0);
  DMA_K(3,0);DMA_V(1,SLOTB);
  ROT();
  kload8(kf,kp0+sl_cur);
  WAIT_BAR(2);
  s16x4 vlo[8],vhi[8]; u32x4 pw0,pw1,pw2,pw3;
  #define PKW(P,B) cvtpk_s(P[B],P[B+1])
  #define PAF(k) __builtin_bit_cast(bf16x8,pw##k)
  #define VFR(i) (bf16x8){vlo[i][0],vlo[i][1],vlo[i][2],vlo[i][3],vhi[i][0],vhi[i][1],vhi[i][2],vhi[i][3]}
  #define PIN(x) asm volatile("":"+v"(x))
  #define MX3(a,b,c) __builtin_fmaxf(__builtin_fmaxf((a),(b)),(c))
  #define GAPA(MF,A0,A1,A2,A3,W0,W1,PW) do{ MF; sacc+=A0; sacc+=A1; sacc+=A2; sacc+=A3; PIN(sacc); W0; W1; PIN(PW); SBAR(); }while(0)
  #define EX(v) __builtin_amdgcn_exp2f(v)
  #define GAPB(MF,X,B) do{ MF; X[B]=EX(X[B]); X[B+1]=EX(X[B+1]); X[B+2]=EX(X[B+2]); X[B+3]=EX(X[B+3]); PIN(X); SBAR(); }while(0)
  #define VRD(i) do{ vlo[i]=vtr(vp_+(((i)>>2)*4096+((i)&3)*1024)); vhi[i]=vtr(vp_+(((i)>>2)*4096+((i)&3)*1024+512)); }while(0)
  #define KRD(G,j) do{ if(G){ kload2(kf,kp0+sl_next,j); SBAR(); } }while(0)
  #define STEP(C0,C1,P0,P1,t,GK,GV,GL) do{ SBAR(); \
    const lds_cptr vp_=vp0+sl_prev; \
    VRD(0); SBAR(); float sacc=(P0[0]+P0[1]); \
    GAPA(C0=__builtin_amdgcn_mfma_f32_32x32x16_bf16(kf[0],qr[0],negm,0,0,0), P0[2],P0[3],P0[4],P0[5],     pw0[0]=PKW(P0,0), pw0[1]=PKW(P0,2), pw0); \
    VRD(4); SBAR(); GAPA(C1=__builtin_amdgcn_mfma_f32_32x32x16_bf16(kf[1],qr[0],negm,0,0,0), P0[6],P0[7],P0[8],P0[9],     pw0[2]=PKW(P0,4), pw0[3]=PKW(P0,6), pw0); \
    VRD(1); SBAR(); GAPA(C0=__builtin_amdgcn_mfma_f32_32x32x16_bf16(kf[2],qr[1],C0,0,0,0),   P0[10],P0[11],P0[12],P0[13], pw1[0]=PKW(P0,8), pw1[1]=PKW(P0,10), pw1); \
    VRD(5); SBAR(); GAPA(C1=__builtin_amdgcn_mfma_f32_32x32x16_bf16(kf[3],qr[1],C1,0,0,0),   P0[14],P0[15],P1[0],P1[1],   pw1[2]=PKW(P0,12),pw1[3]=PKW(P0,14), pw1); \
    VRD(2); SBAR(); GAPA(C0=__builtin_amdgcn_mfma_f32_32x32x16_bf16(kf[4],qr[2],C0,0,0,0),   P1[2],P1[3],P1[4],P1[5],     pw2[0]=PKW(P1,0), pw2[1]=PKW(P1,2), pw2); \
    VRD(6); SBAR(); GAPA(C1=__builtin_amdgcn_mfma_f32_32x32x16_bf16(kf[5],qr[2],C1,0,0,0),   P1[6],P1[7],P1[8],P1[9],     pw2[2]=PKW(P1,4), pw2[3]=PKW(P1,6), pw2); \
    VRD(3); SBAR(); GAPA(C0=__builtin_amdgcn_mfma_f32_32x32x16_bf16(kf[6],qr[3],C0,0,0,0),   P1[10],P1[11],P1[12],P1[13], pw3[0]=PKW(P1,8), pw3[1]=PKW(P1,10), pw3); \
    VRD(7); SBAR(); GAPA(C1=__builtin_amdgcn_mfma_f32_32x32x16_bf16(kf[7],qr[3],C1,0,0,0),   P1[14],P1[15],0.f,0.f,       pw3[2]=PKW(P1,12),pw3[3]=PKW(P1,14), pw3); \
    l_reg+=sacc; \
    if(GK){DMA_K((t)+3,sl_cur);} if(GV){DMA_V((t)+1,sl_next);} \
    CMASK(C0,C1,t); \
    { float a=MX3(C0[0],C0[1],C1[0]),b=MX3(C0[2],C0[3],C1[1]); a=MX3(a,C1[2],C1[3]); \
      _Pragma("unroll") for(int r=4;r<16;r+=4){a=MX3(a,C0[r],C0[r+1]);b=MX3(b,C0[r+2],C0[r+3]);a=MX3(a,C1[r],C1[r+1]);b=MX3(b,C1[r+2],C1[r+3]);} \
      float rm=__builtin_fmaxf(a,b); { auto rr=__builtin_amdgcn_permlane32_swap(__float_as_uint(rm),__float_as_uint(rm),false,false); rm=__builtin_fmaxf(__uint_as_float(rr[0]),__uint_as_float(rr[1])); } \
      resc=false; \
      if(__builtin_expect(__any(rm>(float)THRL),0)){ const float dl=__builtin_fmaxf(rm,0.f); mhat+=dl; \
        _Pragma("unroll") for(int r=0;r<16;++r){C0[r]-=dl;C1[r]-=dl;} \
        _Pragma("unroll") for(int r=0;r<16;++r)negm[r]=-mhat; asm volatile("":"+v"(negm)); \
        const float f=__builtin_amdgcn_exp2f(-dl); l_reg*=f; if(hi==0)wsf[r32]=f; resc=true; } } \
    SBAR(); \
    GAPB(o[0]=__builtin_amdgcn_mfma_f32_32x32x16_bf16(PAF(0),VFR(0),o[0],0,0,0), C0,0); \
    GAPB(o[1]=__builtin_amdgcn_mfma_f32_32x32x16_bf16(PAF(0),VFR(4),o[1],0,0,0), C0,4); \
    KRD(GL,0); GAPB(o[0]=__builtin_amdgcn_mfma_f32_32x32x16_bf16(PAF(1),VFR(1),o[0],0,0,0), C0,8); \
    KRD(GL,1); GAPB(o[1]=__builtin_amdgcn_mfma_f32_32x32x16_bf16(PAF(1),VFR(5),o[1],0,0,0), C0,12); \
    KRD(GL,2); GAPB(o[0]=__builtin_amdgcn_mfma_f32_32x32x16_bf16(PAF(2),VFR(2),o[0],0,0,0), C1,0); \
    KRD(GL,3); GAPB(o[1]=__builtin_amdgcn_mfma_f32_32x32x16_bf16(PAF(2),VFR(6),o[1],0,0,0), C1,4); \
    GAPB(o[0]=__builtin_amdgcn_mfma_f32_32x32x16_bf16(PAF(3),VFR(3),o[0],0,0,0), C1,8); \
    GAPB(o[1]=__builtin_amdgcn_mfma_f32_32x32x16_bf16(PAF(3),VFR(7),o[1],0,0,0), C1,12); \
    }while(0)
  int t=1;
  #undef CMASK
  #define CMASK(P0,P1,t) MASK_FAR(P0,P1,t)
  for(;MODE!=2&&t+7<NT;t+=2){
    STEP(pB0,pB1,pA0,pA1,t,true,true,true);     WAIT_BAR(2); RESC(); ROT();
    STEP(pA0,pA1,pB0,pB1,t+1,true,true,true);   WAIT_BAR(2); RESC(); ROT();
  }
  #undef CMASK
  #define CMASK(P0,P1,t) MASK_BAND(P0,P1,t)
  #define ENDW(tt) do{ if((tt)+3<NT){WAIT_BAR(2);} else if((tt)+2<NT){WAIT_BAR(1);} else {WAIT_BAR(0);} }while(0)
  for(;t+1<NT;t+=2){
    STEP(pB0,pB1,pA0,pA1,t,(t+3<NT),(t+1<NT),(t+1<NT));       ENDW(t);   RESC(); ROT();
    STEP(pA0,pA1,pB0,pB1,t+1,(t+4<NT),(t+2<NT),(t+2<NT));     ENDW(t+1); RESC(); ROT();
  }
  STEP(pB0,pB1,pA0,pA1,NT-1,false,false,false); RESC();
  { float sacc=pB0[0]+pB0[1]; _Pragma("unroll") for(int r=2;r<16;++r)sacc+=pB0[r]; _Pragma("unroll") for(int r=0;r<16;++r)sacc+=pB1[r]; l_reg+=sacc;
    pw0=(u32x4){PKW(pB0,0),PKW(pB0,2),PKW(pB0,4),PKW(pB0,6)};pw1=(u32x4){PKW(pB0,8),PKW(pB0,10),PKW(pB0,12),PKW(pB0,14)};pw2=(u32x4){PKW(pB1,0),PKW(pB1,2),PKW(pB1,4),PKW(pB1,6)};pw3=(u32x4){PKW(pB1,8),PKW(pB1,10),PKW(pB1,12),PKW(pB1,14)};
    SBAR(); pv(o,vb0+sl_cur,PAF(0),PAF(1),PAF(2),PAF(3)); }
  #undef PKW
  #undef PAF
  #undef VFR
  #undef PIN
  #undef MX3
  #undef GAPA
  #undef GAPB
  #undef EX
  #undef VRD
  #undef KRD
  #undef STEP
  #undef ENDW
  {auto rr=__builtin_amdgcn_permlane32_swap(__float_as_uint(l_reg),__float_as_uint(l_reg),false,false);l_reg=__uint_as_float(rr[0])+__uint_as_float(rr[1]);}
  int lane_e=lane; asm volatile("":"+v"(lane_e)); const int r32e=lane_e&31, hie=lane_e>>5;
  float*wsfe=(float*)(shm+LDS_WS)+wid*128;
  if(hie==0){ wsfe[32+r32e]=l_reg; if(EPI!=0){ const float gl=bfs((short)U.gate[(long)(wid*QBLK+r32e)*PITCH+U.gcol]); wsfe[64+r32e]=1.f/(1.f+__expf(-gl)); } }
  asm volatile("s_waitcnt lgkmcnt(0)":::"memory");
  float rli[16];
  #pragma unroll
  for(int r=0;r<16;++r){ rli[r]=__builtin_amdgcn_rcpf(fmaxf(wsfe[32+crow(r,hie)],1e-30f)); if(EPI!=0)rli[r]*=wsfe[64+crow(r,hie)]; }
  bf16*Ow=U.Ob+(long)(wid*QBLK)*PITCH;
  { bf16*stg=(bf16*)(shm+LDS_OST)+wid*2048;
    #pragma unroll
    for(int r=0;r<16;++r){const int orow=crow(r,hie);
      #pragma unroll
      for(int d0=0;d0<2;++d0){ float v=o[d0][r]*rli[r]; if(EPI==2)v+=bfs((short)stg[orow*64+d0*32+r32e]); stg[orow*64+d0*32+r32e]=f2b(v);} }
    asm volatile("s_waitcnt lgkmcnt(0)":::"memory");
    if(EPI!=1){
    #pragma unroll
    for(int i=0;i<4;++i){const int row=i*8+(lane_e>>3),ch=lane_e&7; u32x4 v=*(const u32x4*)(stg+row*64+ch*8);
      if(EPI==2){ const u32x4 t=*(const u32x4*)(U.tmp+(long)(wid*QBLK+row)*512+ch*8);
        v.x=pk2b(lo16(v.x)+lo16(t.x),hi16(v.x)+hi16(t.x)); v.y=pk2b(lo16(v.y)+lo16(t.y),hi16(v.y)+hi16(t.y)); v.z=pk2b(lo16(v.z)+lo16(t.z),hi16(v.z)+hi16(t.z)); v.w=pk2b(lo16(v.w)+lo16(t.w),hi16(v.w)+hi16(t.w)); }
      ATTN_STORE16(Ow+(long)row*PITCH+ch*8,v);} } }
  asm volatile("s_waitcnt lgkmcnt(0)\n\ts_barrier":::"memory");
  #undef DMA_K
  #undef DMA_V
  #undef CMASK
  #undef START
  #undef RESC
  #undef ROT
}
constexpr int ATTN_LDS_BYTES=LDS_BYTES;
#undef SBAR
#undef WAIT_BAR
}

constexpr int NWAVES = 8;
constexpr int B_ = 4, S_ = 8192, DM = 1024, M_ = B_ * S_, DIN = 7464, FF = 2816, NL = 2;
constexpr int YP = pg8::YP_;
constexpr float C2 = pg8::C2_, LOG2E = 1.4426950408889634f;
constexpr float NORM_EPS = 1e-6f;
constexpr int Y_AQ = 0, Y_AKC = 512, Y_AVC = 640, Y_AKS = 768, Y_AVS = 896, Y_AKW = 1024, Y_AVW = 1152, Y_CQ = 1280, Y_CK = 1792, Y_CV = 2304,
              Y_BQ = 2816, Y_BK = 3072, Y_BV = 3328, Y_BR = 3840, Y_AG = 4352, Y_BLR = 4376;
constexpr int NIN = 7680;
constexpr size_t MiB = 1u << 20;
constexpr size_t WS_CTL = 0, CTL_ZERO_BYTES = 1 * MiB;
constexpr size_t WS_WIN = 1 * MiB, WS_WA = 16 * MiB, WS_WB = 17 * MiB, WS_WC = 18 * MiB, WS_WO = 19 * MiB, WS_WF1 = 21 * MiB, WS_WF2 = 32 * MiB;
constexpr size_t WS_H = 40 * MiB;
constexpr size_t WS_Y = 104 * MiB;
constexpr size_t WS_G8 = 379 * MiB;
constexpr size_t WS_ACT = WS_Y + 128 * MiB;
constexpr size_t WS_SM = 475 * MiB;
constexpr size_t WS_KCMP = WS_SM, WS_VCMP = WS_SM + 1 * MiB, WS_KMEAN = WS_SM + 2 * MiB;
constexpr size_t WS_GA = WS_SM + 3 * MiB;
constexpr size_t WS_MASK = 38 * MiB;
constexpr size_t WS_OATMP = WS_H;
constexpr size_t WS_O16 = WS_H + 32 * MiB;
constexpr size_t WS_VCMPT = WS_VCMP + 512 * 1024;
constexpr size_t WS_CW1T = 39 * MiB;
constexpr size_t WS_CW2T = WS_CW1T + 512 * 1024;
constexpr size_t WS_CC0 = WS_CW2T + 16 * 1024;
constexpr size_t WS_GST = WS_H + 32 * MiB;
constexpr size_t WS_GDEC = WS_SM + 3 * MiB;
constexpr size_t WS_END = 512 * MiB;
static_assert(WS_GA + (size_t)M_ * 256 * 4 <= WS_END && WS_Y + (size_t)M_ * YP * 2 <= WS_G8 && WS_G8 + (size_t)M_ * 3072 <= WS_SM, "ws map");
static_assert(WS_ACT + (size_t)M_ * FF * 2 <= WS_SM && WS_WF2 + (size_t)DM * FF * 2 <= WS_H, "ws map 2");
constexpr int CW_BAR = 4096;
constexpr int RING_OFF = 0, RING_BYTES = 131072;
constexpr int LDSCTL_OFF = RING_BYTES, MISC_OFF = LDSCTL_OFF + 320;
constexpr int LDS_BYTES = 147456;

#define GAS __attribute__((address_space(1)))
#define LAS __attribute__((address_space(3)))
typedef unsigned short bf16;
typedef unsigned v4u __attribute__((ext_vector_type(4)));
typedef float f32x4 __attribute__((ext_vector_type(4)));
typedef short bf16x8 __attribute__((ext_vector_type(8)));
typedef GAS unsigned gu32;
typedef GAS unsigned long long gu64;
#define RLX_AGENT __ATOMIC_RELAXED, __HIP_MEMORY_SCOPE_AGENT
#define LDS_WAIT() asm volatile("s_waitcnt lgkmcnt(0)" ::: "memory")
#define VM_WAIT() asm volatile("s_waitcnt vmcnt(0)" ::: "memory")
__device__ __forceinline__ unsigned long long rt() { return __builtin_amdgcn_s_memrealtime(); }
__device__ __forceinline__ unsigned f2bf(float f) { unsigned u = __builtin_bit_cast(unsigned, f); return (u + 0x7fffu + ((u >> 16) & 1u)) >> 16; }
__device__ __forceinline__ unsigned pk2(float lo, float hi) { return f2bf(lo) | (f2bf(hi) << 16); }

__device__ __forceinline__ float bf2f(bf16 h) { return __uint_as_float((unsigned)h << 16); }
__device__ __forceinline__ float sigm(float v) { return 1.f / (1.f + __expf(-v)); }
#define WFENCE() asm volatile("s_waitcnt lgkmcnt(0)" ::: "memory")

#define XB_TMO      128
#define XB_XCNT(j)  (256  + 64 * (j))
#define XB_XSUB(j)  (1280 + 64 * (j))
#define XB_XGEN(j)  (2304 + 64 * (j))
#define XB_TOP      3328
#define XB_TOPGEN   3392
#define XCD_BAR_WORDS 3456
#define XB_SPIN_CAP (1u << 18)

__device__ __forceinline__ unsigned xb_ld(unsigned* p)              { return __hip_atomic_load(p, __ATOMIC_RELAXED, __HIP_MEMORY_SCOPE_AGENT); }
__device__ __forceinline__ unsigned xb_add(unsigned* p, unsigned v) { return __hip_atomic_fetch_add(p, v, __ATOMIC_RELAXED, __HIP_MEMORY_SCOPE_AGENT); }
__device__ __forceinline__ unsigned xb_xcc_id() { return (unsigned)__builtin_amdgcn_s_getreg((3 << 11) | 20) & 0xFu; }
#define XB_SPIN(cond, bar) do { unsigned _sp = 0; while (cond) { __builtin_amdgcn_s_sleep(1); \
    if ((++_sp & 255u) == 0u) { if (xb_ld(&(bar)[XB_TMO])) break; if (_sp > XB_SPIN_CAP) { atomicAdd(&(bar)[XB_TMO], 1u); break; } } } } while (0)

struct XcdBarrier {
    unsigned* bar; unsigned x;
    volatile LAS unsigned* st;
};

__device__ __forceinline__ XcdBarrier xcd_barrier_post(unsigned* bar, volatile LAS unsigned* st) {
    XcdBarrier b; b.bar = bar; b.x = xb_xcc_id(); b.st = st;
    if (threadIdx.x == 0) (void)xb_add(&bar[XB_XCNT(b.x)], 1u);
    return b;
}
__device__ __forceinline__ void xcd_barrier_complete(unsigned* bar, unsigned x, unsigned& nloc, unsigned& nx) {
    const unsigned G = gridDim.x * gridDim.y * gridDim.z;
    unsigned sum, cnt, mine, sp = 0u;
    for (;;) {
        sum = 0u; cnt = 0u; mine = 0u;
#pragma unroll
        for (unsigned j = 0; j < 16; ++j) { const unsigned c = xb_ld(&bar[XB_XCNT(j)]); sum += c; cnt += (c > 0u) ? 1u : 0u; mine = (j == x) ? c : mine; }
        if (sum == G) break;
        __builtin_amdgcn_s_sleep(1);
        if ((++sp & 255u) == 0u) { if (xb_ld(&bar[XB_TMO])) break; if (sp > XB_SPIN_CAP) { atomicAdd(&bar[XB_TMO], 1u); break; } }
    }
    nloc = mine > 0u ? mine : 1u; nx = cnt > 0u ? cnt : 1u;
}

__device__ __forceinline__ void xcd_barrier(const XcdBarrier& b) {
    asm volatile("s_waitcnt vmcnt(0)" ::: "memory");
    __syncthreads();
    if (threadIdx.x == 0) {
        unsigned* bar = b.bar;
        __builtin_amdgcn_s_waitcnt(0);
        unsigned nloc = b.st[0], nx = b.st[1];
        if (nloc == 0u) { xcd_barrier_complete(bar, b.x, nloc, nx); b.st[0] = nloc; b.st[1] = nx; }
        const unsigned old = xb_add(&bar[XB_XSUB(b.x)], 1u);
        const unsigned gen = old / nloc;
        if (old + 1u == (gen + 1u) * nloc) {
            __builtin_amdgcn_fence(__ATOMIC_RELEASE, "agent");
            asm volatile("s_waitcnt vmcnt(0)" ::: "memory");
            const unsigned og = xb_add(&bar[XB_TOP], 1u);
            const unsigned tg = og / nx;
            if (og + 1u == (tg + 1u) * nx) xb_add(&bar[XB_TOPGEN], 1u);
            else XB_SPIN(xb_ld(&bar[XB_TOPGEN]) == tg, bar);
            __builtin_amdgcn_fence(__ATOMIC_ACQUIRE, "agent");
            xb_add(&bar[XB_XGEN(b.x)], 1u);
            asm volatile("s_waitcnt vmcnt(0)" ::: "memory");
        } else {
            XB_SPIN(xb_ld(&bar[XB_XGEN(b.x)]) == gen, bar);
            __builtin_amdgcn_fence(__ATOMIC_ACQUIRE, "agent");
            asm volatile("s_waitcnt vmcnt(0)" ::: "memory");
        }
    }
    __syncthreads();
}


struct Frame {
    LAS unsigned char* lds;
    volatile LAS unsigned* MISC;
    gu32* ctl;
    int tid, lane, wave, G;
};
__device__ __forceinline__ float wave_sum(float v) {
#pragma unroll
    for (int o = 1; o < 64; o <<= 1) v += __shfl_xor(v, o);
    return v;
}
__device__ __forceinline__ float wave_max(float v) {
#pragma unroll
    for (int o = 1; o < 64; o <<= 1) v = fmaxf(v, __shfl_xor(v, o));
    return v;
}
__device__ __forceinline__ int t5_bucket(int d) {
    if (d < 16) return d < 0 ? 0 : d;
    int b = 16;
    b += (d >= 19); b += (d >= 21); b += (d >= 24); b += (d >= 27); b += (d >= 31); b += (d >= 35); b += (d >= 40); b += (d >= 46);
    b += (d >= 52); b += (d >= 59); b += (d >= 67); b += (d >= 77); b += (d >= 87); b += (d >= 99); b += (d >= 113);
    return b;
}
template <class CM> __device__ __forceinline__ void tr_item(const float* W, int Nsrc, int K, bf16* WT, int item, int nblk, CM cm, LAS float* scr, int lane) {
    const int kb = item / nblk, nb = item % nblk, k0 = 64 * kb, n0 = 32 * nb;
    const int sc = cm(n0 + (lane & 31));
#pragma unroll 8
    for (int i = 0; i < 32; ++i) { const int kk = 2 * i + (lane >> 5); scr[kk * 33 + (lane & 31)] = sc >= 0 ? W[(size_t)(k0 + kk) * Nsrc + sc] : 0.f; }
    LDS_WAIT(); asm volatile("" ::: "memory");
    const int c = lane & 7;
#pragma unroll
    for (int j = 0; j < 4; ++j) { const int n = (lane >> 3) + 8 * j; const LAS float* s = scr + (8 * c) * 33 + n;
        v4u o; o.x = pk2(s[0 * 33], s[1 * 33]); o.y = pk2(s[2 * 33], s[3 * 33]); o.z = pk2(s[4 * 33], s[5 * 33]); o.w = pk2(s[6 * 33], s[7 * 33]);
        *(GAS v4u*)(WT + (size_t)(n0 + n) * K + k0 + 8 * c) = o; }
    LDS_WAIT(); asm volatile("" ::: "memory");
}
struct CmId { __device__ __forceinline__ int operator()(int n) const { return n; } };
struct CmWin { __device__ __forceinline__ int operator()(int n) const {
    if (n < 1280) return n;
    if (n < 2816) return n - 1280 + 2856;
    if (n < 4352) return n - 2816 + 1304;
    if (n < 4376) return n - 4352 + 1280;
    if (n < 4392) return n - 4376 + 2840;
    if (n < 4608) return -1;
    return n - 4608 + 4392; } };
struct CmFfn { __device__ __forceinline__ int operator()(int c) const { const int p = c >> 8, r = c & 255; return r < 128 ? 128 * p + r : FF + 128 * p + (r - 128); } };

struct Args { const float* in[22]; float* out; unsigned char* ws; int ph_lo, ph_hi; };

__device__ __forceinline__ void phase_weights(Frame& F, const Args& a, int l) {
    LAS float* scr = (LAS float*)(F.lds + RING_OFF + F.wave * 16384);
    const int gw = blockIdx.x * NWAVES + F.wave, NGW = F.G * NWAVES;
    unsigned char* ws = a.ws;
    constexpr int I_IN = 16 * (NIN / 32), I_BR = 8 * 32, I_O = 16 * 32, I_F1 = 16 * (2 * FF / 32), I_F2 = (FF / 64) * 32;
    constexpr int NIT = I_IN + 3 * I_BR + I_O + I_F1 + I_F2;
    for (int it = gw; it < NIT; it += NGW) {
        int r = it;
        if (r < I_IN) { tr_item(a.in[6] + (size_t)l * DM * DIN, DIN, DM, (bf16*)(ws + WS_WIN), r, NIN / 32, CmWin(), scr, F.lane); continue; } r -= I_IN;
        if (r < I_BR) { tr_item(a.in[16] + (size_t)l * 512 * DM, DM, 512, (bf16*)(ws + WS_WA), r, 32, CmId(), scr, F.lane); continue; } r -= I_BR;
        if (r < I_BR) { tr_item(a.in[17] + (size_t)l * 512 * DM, DM, 512, (bf16*)(ws + WS_WB), r, 32, CmId(), scr, F.lane); continue; } r -= I_BR;
        if (r < I_BR) { tr_item(a.in[18] + (size_t)l * 512 * DM, DM, 512, (bf16*)(ws + WS_WC), r, 32, CmId(), scr, F.lane); continue; } r -= I_BR;
        if (r < I_O) { tr_item(a.in[19] + (size_t)l * DM * DM, DM, DM, (bf16*)(ws + WS_WO), r, 32, CmId(), scr, F.lane); continue; } r -= I_O;
        if (r < I_F1) { tr_item(a.in[20] + (size_t)l * DM * 2 * FF, 2 * FF, DM, (bf16*)(ws + WS_WF1), r, 2 * FF / 32, CmFfn(), scr, F.lane); continue; } r -= I_F1;
        tr_item(a.in[21] + (size_t)l * FF * DM, DM, FF, (bf16*)(ws + WS_WF2), r, 32, CmId(), scr, F.lane);
    }
    for (int it = gw; it < 2 * 66 + 2; it += NGW) {
        if (it < 132) { const int kv = it / 66, r = it % 66;
            if (r < 64) tr_item(a.in[kv ? 11 : 9] + (size_t)l * 2048 * 64, 64, 2048, (bf16*)(ws + WS_CW1T) + (size_t)kv * 64 * 2048, r, 2, CmId(), scr, F.lane);
            else tr_item(a.in[kv ? 12 : 10] + (size_t)l * 64 * 64, 64, 64, (bf16*)(ws + WS_CW2T) + (size_t)kv * 64 * 64, r - 64, 2, CmId(), scr, F.lane); }
        else { const int kv = it - 132; const float* pe = a.in[kv ? 8 : 7] + (size_t)l * 2048; const float* w1 = a.in[kv ? 11 : 9] + (size_t)l * 2048 * 64; float acc = 0.f;
            for (int k = 0; k < 2048; ++k) acc += pe[k] * w1[(size_t)k * 64 + F.lane];
            ((float*)(ws + WS_CC0))[kv * 64 + F.lane] = acc; }
    }
}
__device__ __forceinline__ void phase_norm0(Frame& F, const float* x, const float* w, bf16* H) {
    const int gw = blockIdx.x * NWAVES + F.wave, NGW = F.G * NWAVES;
    for (int m = gw; m < M_; m += NGW) {
        const f32x4* xr = (const f32x4*)(x + (size_t)m * DM) + F.lane; f32x4 v[4]; float s = 0.f;
#pragma unroll
        for (int j = 0; j < 4; ++j) { v[j] = xr[64 * j]; s += v[j].x * v[j].x + v[j].y * v[j].y + v[j].z * v[j].z + v[j].w * v[j].w; }
        const float r = rsqrtf(wave_sum(s) * (1.f / DM) + NORM_EPS);
        unsigned long long* o8 = (unsigned long long*)(H + (size_t)m * DM) + F.lane;
#pragma unroll
        for (int j = 0; j < 4; ++j) { const f32x4 wv = ((const f32x4*)w)[F.lane + 64 * j];
            o8[64 * j] = (unsigned long long)pk2(v[j].x * r * wv.x, v[j].y * r * wv.y) | ((unsigned long long)pk2(v[j].z * r * wv.z, v[j].w * r * wv.w) << 32); }
    }
}
__device__ __forceinline__ void phase_resid(Frame& F, const float* y, const float* xin, float* xout, const float* wpost, const float* wpre, bf16* hout) {
    const int gw = blockIdx.x * NWAVES + F.wave, NGW = F.G * NWAVES;
    for (int m = gw; m < M_; m += NGW) {
        const f32x4* yr = (const f32x4*)(y + (size_t)m * DM) + F.lane; const f32x4* xr = (const f32x4*)(xin + (size_t)m * DM) + F.lane;
        f32x4 v[4], xv[4]; float s = 0.f;
#pragma unroll
        for (int j = 0; j < 4; ++j) { v[j] = yr[64 * j]; xv[j] = xr[64 * j]; s += v[j].x * v[j].x + v[j].y * v[j].y + v[j].z * v[j].z + v[j].w * v[j].w; }
        const float r = rsqrtf(wave_sum(s) * (1.f / DM) + NORM_EPS); float s2 = 0.f;
        f32x4* xo = (f32x4*)(xout + (size_t)m * DM) + F.lane;
#pragma unroll
        for (int j = 0; j < 4; ++j) { const f32x4 wv = ((const f32x4*)wpost)[F.lane + 64 * j]; f32x4 n;
            n.x = xv[j].x + v[j].x * r * wv.x; n.y = xv[j].y + v[j].y * r * wv.y; n.z = xv[j].z + v[j].z * r * wv.z; n.w = xv[j].w + v[j].w * r * wv.w;
            xo[64 * j] = n; v[j] = n; s2 += n.x * n.x + n.y * n.y + n.z * n.z + n.w * n.w; }
        if (hout) { const float r2 = rsqrtf(wave_sum(s2) * (1.f / DM) + NORM_EPS);
            unsigned long long* o8 = (unsigned long long*)(hout + (size_t)m * DM) + F.lane;
#pragma unroll
            for (int j = 0; j < 4; ++j) { const f32x4 wv = ((const f32x4*)wpre)[F.lane + 64 * j];
                o8[64 * j] = (unsigned long long)pk2(v[j].x * r2 * wv.x, v[j].y * r2 * wv.y) | ((unsigned long long)pk2(v[j].z * r2 * wv.z, v[j].w * r2 * wv.w) << 32); } }
    }
}
__device__ __forceinline__ void unpack8(const v4u w, float (&k)[8]) {
    k[0] = __uint_as_float(w.x << 16); k[1] = __uint_as_float(w.x & 0xffff0000u); k[2] = __uint_as_float(w.y << 16); k[3] = __uint_as_float(w.y & 0xffff0000u);
    k[4] = __uint_as_float(w.z << 16); k[5] = __uint_as_float(w.z & 0xffff0000u); k[6] = __uint_as_float(w.w << 16); k[7] = __uint_as_float(w.w & 0xffff0000u);
}
__device__ __forceinline__ void dot4(const LAS float* qs, const bf16* kr, float (&d)[4]) {
    d[0] = d[1] = d[2] = d[3] = 0.f;
#pragma unroll 1
    for (int c = 0; c < 8; ++c) { asm volatile("" ::: "memory"); const v4u w = ((const v4u*)kr)[c]; float k[8]; unpack8(w, k);
#pragma unroll
        for (int e = 0; e < 8; ++e) { const int dd = c * 8 + e;
#pragma unroll
            for (int h = 0; h < 4; ++h) d[h] += qs[h * 64 + dd] * k[e]; } }
}
__device__ __forceinline__ float dot1(const LAS float* qs, const bf16* kr) {
    float d = 0.f;
#pragma unroll
    for (int c = 0; c < 8; ++c) { const v4u w = ((const v4u*)kr)[c]; float k[8]; unpack8(w, k);
#pragma unroll
        for (int e = 0; e < 8; ++e) d += qs[c * 8 + e] * k[e]; }
    return d;
}
__device__ __forceinline__ float gelu_tanh(float x) { const float u = 0.7978845608028654f * (x + 0.044715f * x * x * x); return 0.5f * x * (1.f + tanhf(u)); }

__device__ __forceinline__ void phase2_naive(Frame& F, const Args& a, int l) {
    const int gw = blockIdx.x * NWAVES + F.wave, NGW = F.G * NWAVES, lane = F.lane;
    const bf16* Y = (const bf16*)(a.ws + WS_Y);
    LAS float* scr = (LAS float*)(F.lds + RING_OFF + F.wave * 16384);
    for (int t = gw; t < 4 * 8 * 32; t += NGW) {
        const int blk = t & 31, h = (t >> 5) & 7, b = t >> 8;
        const bf16* src = Y + ((size_t)b * S_ + blk * 256) * YP + Y_CK + h * 64 + lane; float s = 0.f;
        for (int i = 0; i < 256; ++i) s += bf2f(src[(size_t)i * YP]);
        ((float*)(a.ws + WS_KMEAN))[(size_t)t * 64 + lane] = s * (1.f / 256.f);
    }
}
__device__ __forceinline__ void gla_scan_naive(Frame& F, const Args& a) {
    const bf16* Y = (const bf16*)(a.ws + WS_Y); const float* GA = (const float*)(a.ws + WS_GA); bf16* O16 = (bf16*)(a.ws + WS_O16);
    const int lane = F.lane;
    for (int task = blockIdx.x; task < 256; task += F.G) {
        const int eg = task & 15, h = (task >> 4) & 3, b = task >> 6, e = eg * 8 + F.wave;
        float Sst = 0.f;
        for (int t0 = 0; t0 < S_; t0 += 8) {
            float av[8], kv[8], qv[8], vv[8];
#pragma unroll
            for (int j = 0; j < 8; ++j) { const size_t row = (size_t)b * S_ + t0 + j;
                av[j] = GA[row * 256 + h * 64 + lane]; kv[j] = bf2f(Y[row * YP + Y_BK + h * 64 + lane]); qv[j] = bf2f(Y[row * YP + Y_BQ + h * 64 + lane]); vv[j] = bf2f(Y[row * YP + Y_BV + h * 128 + e]); }
#pragma unroll
            for (int j = 0; j < 8; ++j) { Sst = av[j] * Sst + kv[j] * vv[j]; const float o = wave_sum(qv[j] * Sst);
                if (lane == 0) O16[((size_t)b * S_ + t0 + j) * 512 + h * 128 + e] = (bf16)f2bf(o); }
        }
    }
}
__device__ __forceinline__ void nsa_cmp_naive(Frame& F, const Args& a) {
    const int gw = blockIdx.x * NWAVES + F.wave, NGW = F.G * NWAVES, lane = F.lane;
    bf16* Y = (bf16*)(a.ws + WS_Y); const float* rel = a.in[1];
    LAS float* scr = (LAS float*)(F.lds + RING_OFF + F.wave * 16384);
    LAS float* qs = scr; LAS float* sc = scr + 256; LAS float* s2 = scr + 256 + 2048;
    for (int task = gw; task < 8 * S_; task += NGW) {
        const int q = task & (S_ - 1), bg = task >> 13, g = bg & 1, b = bg >> 1;
        const size_t row = (size_t)b * S_ + q; bf16* Yr = Y + row * YP;
#pragma unroll
        for (int h = 0; h < 4; ++h) qs[h * 64 + lane] = bf2f(Yr[Y_AQ + (g * 4 + h) * 64 + lane]);
        float gt[4][3];
#pragma unroll
        for (int h = 0; h < 4; ++h)
#pragma unroll
            for (int br = 0; br < 3; ++br) gt[h][br] = sigm(bf2f(Yr[Y_AG + (g * 4 + h) * 3 + br]));
        WFENCE();
        const int cur = q >> 6, ncv = q >= 31 ? ((q - 31) >> 4) + 1 : 0;
        const bf16* KC = (const bf16*)(a.ws + WS_KCMP) + (size_t)bg * 512 * 64; const bf16* VC = (const bf16*)(a.ws + WS_VCMP) + (size_t)bg * 512 * 64;
        float mx[4] = {-1e30f, -1e30f, -1e30f, -1e30f};
        for (int i = 0; i < 8; ++i) { const int n = lane + 64 * i;
            if (n < ncv) { float d[4]; dot4(qs, KC + (size_t)n * 64, d); const int bk = t5_bucket(q - (16 * n + 31));
#pragma unroll
                for (int h = 0; h < 4; ++h) { const float s = d[h] + rel[bk * 16 + g * 4 + h] * LOG2E; sc[h * 512 + n] = s; mx[h] = fmaxf(mx[h], s); } }
            else {
#pragma unroll
                for (int h = 0; h < 4; ++h) sc[h * 512 + n] = 0.f; } }
        float ls[4] = {0.f, 0.f, 0.f, 0.f};
#pragma unroll
        for (int h = 0; h < 4; ++h) mx[h] = wave_max(mx[h]);
        WFENCE();
        for (int i = 0; i < 8; ++i) { const int n = lane + 64 * i;
            if (n < ncv) {
#pragma unroll
                for (int h = 0; h < 4; ++h) { const float e = exp2f(sc[h * 512 + n] - mx[h]); sc[h * 512 + n] = e; ls[h] += e; } } }
#pragma unroll
        for (int h = 0; h < 4; ++h) ls[h] = 1.f / fmaxf(wave_sum(ls[h]), 1e-20f);
        for (int i = 0; i < 8; ++i) { const int n = lane + 64 * i;
            if (n < ncv) {
#pragma unroll
                for (int h = 0; h < 4; ++h) sc[h * 512 + n] *= ls[h]; } }
        WFENCE();
        float v0, v1;
        { float t[2];
#pragma unroll
          for (int jj = 0; jj < 2; ++jj) { const int j = lane + 64 * jj; float v = 0.f;
              for (int n = 4 * j - 1; n <= 4 * j + 3; ++n) if (n >= 0 && n < 511) v += (sc[n] + sc[512 + n]) + (sc[1024 + n] + sc[1536 + n]);
              const bool forced = (j == 0) || (j == cur) || (j == cur - 1);
              t[jj] = forced ? 1e9f : (j <= cur ? v : -1e30f); }
          v0 = t[0]; v1 = t[1]; }
        bool sel0 = false, sel1 = false;
        for (int it = 0; it < 16; ++it) {
            const float c0 = sel0 ? -INFINITY : v0, c1 = sel1 ? -INFINITY : v1;
            const float mxv = wave_max(fmaxf(c0, c1));
            const unsigned long long m0 = __ballot(!sel0 && v0 == mxv);
            if (m0) { const int idx = __builtin_ctzll(m0); if (lane == idx) sel0 = true; }
            else { const unsigned long long m1 = __ballot(!sel1 && v1 == mxv); const int idx = m1 ? __builtin_ctzll(m1) : -1; if (lane == idx) sel1 = true; }
        }
        sel0 = sel0 && (lane <= cur); sel1 = sel1 && (lane + 64 <= cur);
        const unsigned long long sm0 = __ballot(sel0), sm1 = __ballot(sel1);
        float oc[4] = {0.f, 0.f, 0.f, 0.f};
        for (int n = 0; n < ncv; ++n) { const float vv = bf2f(VC[(size_t)n * 64 + lane]);
#pragma unroll
            for (int h = 0; h < 4; ++h) oc[h] += sc[h * 512 + n] * vv; }
        { unsigned* MK = (unsigned*)(a.ws + WS_MASK) + ((size_t)bg * S_ + q) * 4;
          if (lane == 0) { MK[0] = (unsigned)sm0; MK[1] = (unsigned)(sm0 >> 32); MK[2] = (unsigned)sm1; MK[3] = (unsigned)(sm1 >> 32); }
          bf16* T = (bf16*)(a.ws + WS_OATMP) + row * 512;
#pragma unroll
          for (int h = 0; h < 4; ++h) T[(g * 4 + h) * 64 + lane] = (bf16)f2bf(gt[h][0] * oc[h]); }
        WFENCE();
    }
}
__device__ __forceinline__ void nsa_naive(Frame& F, const Args& a) {
    const int gw = blockIdx.x * NWAVES + F.wave, NGW = F.G * NWAVES, lane = F.lane;
    bf16* Y = (bf16*)(a.ws + WS_Y); const float* rel = a.in[1];
    LAS float* scr = (LAS float*)(F.lds + RING_OFF + F.wave * 16384);
    LAS float* qs = scr; LAS float* sc = scr + 256; LAS float* s2 = scr + 256 + 2048;
    for (int task = gw; task < 8 * S_; task += NGW) {
        const int q = task & (S_ - 1), bg = task >> 13, g = bg & 1, b = bg >> 1;
        const size_t row = (size_t)b * S_ + q; bf16* Yr = Y + row * YP;
#pragma unroll
        for (int h = 0; h < 4; ++h) qs[h * 64 + lane] = bf2f(Yr[Y_AQ + (g * 4 + h) * 64 + lane]);
        float gt[4][3];
#pragma unroll
        for (int h = 0; h < 4; ++h)
#pragma unroll
            for (int br = 0; br < 3; ++br) gt[h][br] = sigm(bf2f(Yr[Y_AG + (g * 4 + h) * 3 + br]));
        WFENCE();
        const int cur = q >> 6, ncv = q >= 31 ? ((q - 31) >> 4) + 1 : 0;
        const bf16* KC = (const bf16*)(a.ws + WS_KCMP) + (size_t)bg * 512 * 64; const bf16* VC = (const bf16*)(a.ws + WS_VCMP) + (size_t)bg * 512 * 64;
        float mx[4] = {-1e30f, -1e30f, -1e30f, -1e30f};
        for (int i = 0; i < 8; ++i) { const int n = lane + 64 * i;
            if (n < ncv) { float d[4]; dot4(qs, KC + (size_t)n * 64, d); const int bk = t5_bucket(q - (16 * n + 31));
#pragma unroll
                for (int h = 0; h < 4; ++h) { const float s = d[h] + rel[bk * 16 + g * 4 + h] * LOG2E; sc[h * 512 + n] = s; mx[h] = fmaxf(mx[h], s); } }
            else {
#pragma unroll
                for (int h = 0; h < 4; ++h) sc[h * 512 + n] = 0.f; } }
        float ls[4] = {0.f, 0.f, 0.f, 0.f};
#pragma unroll
        for (int h = 0; h < 4; ++h) mx[h] = wave_max(mx[h]);
        WFENCE();
        for (int i = 0; i < 8; ++i) { const int n = lane + 64 * i;
            if (n < ncv) {
#pragma unroll
                for (int h = 0; h < 4; ++h) { const float e = exp2f(sc[h * 512 + n] - mx[h]); sc[h * 512 + n] = e; ls[h] += e; } } }
#pragma unroll
        for (int h = 0; h < 4; ++h) ls[h] = 1.f / fmaxf(wave_sum(ls[h]), 1e-20f);
        for (int i = 0; i < 8; ++i) { const int n = lane + 64 * i;
            if (n < ncv) {
#pragma unroll
                for (int h = 0; h < 4; ++h) sc[h * 512 + n] *= ls[h]; } }
        WFENCE();
        float v0, v1;
        { float t[2];
#pragma unroll
          for (int jj = 0; jj < 2; ++jj) { const int j = lane + 64 * jj; float v = 0.f;
              for (int n = 4 * j - 1; n <= 4 * j + 3; ++n) if (n >= 0 && n < 511) v += (sc[n] + sc[512 + n]) + (sc[1024 + n] + sc[1536 + n]);
              const bool forced = (j == 0) || (j == cur) || (j == cur - 1);
              t[jj] = forced ? 1e9f : (j <= cur ? v : -1e30f); }
          v0 = t[0]; v1 = t[1]; }
        bool sel0 = false, sel1 = false;
        for (int it = 0; it < 16; ++it) {
            const float c0 = sel0 ? -INFINITY : v0, c1 = sel1 ? -INFINITY : v1;
            const float mxv = wave_max(fmaxf(c0, c1));
            const unsigned long long m0 = __ballot(!sel0 && v0 == mxv);
            if (m0) { const int idx = __builtin_ctzll(m0); if (lane == idx) sel0 = true; }
            else { const unsigned long long m1 = __ballot(!sel1 && v1 == mxv); const int idx = m1 ? __builtin_ctzll(m1) : -1; if (lane == idx) sel1 = true; }
        }
        sel0 = sel0 && (lane <= cur); sel1 = sel1 && (lane + 64 <= cur);
        const unsigned long long sm0 = __ballot(sel0), sm1 = __ballot(sel1);
        float oc[4] = {0.f, 0.f, 0.f, 0.f};
        for (int n = 0; n < ncv; ++n) { const float vv = bf2f(VC[(size_t)n * 64 + lane]);
#pragma unroll
            for (int h = 0; h < 4; ++h) oc[h] += sc[h * 512 + n] * vv; }
        float ms[4] = {-1e30f, -1e30f, -1e30f, -1e30f}, lsel[4] = {0.f, 0.f, 0.f, 0.f}, os[4] = {0.f, 0.f, 0.f, 0.f};
        for (int j = 0; j <= cur; ++j) {
            const bool on = j < 64 ? ((sm0 >> j) & 1ull) : ((sm1 >> (j - 64)) & 1ull);
            if (!on) continue;
            const int kpos = 64 * j + lane; const bool valid = kpos <= q;
            float d[4]; dot4(qs, Y + ((size_t)b * S_ + kpos) * YP + Y_AKS + g * 64, d);
            const int bk = t5_bucket(q - kpos);
            WFENCE();
#pragma unroll
            for (int h = 0; h < 4; ++h) { const float s = valid ? d[h] + rel[bk * 16 + g * 4 + h] * LOG2E : -1e30f;
                const float mn = fmaxf(ms[h], wave_max(s)); const float p = valid ? exp2f(s - mn) : 0.f; s2[h * 64 + lane] = p;
                const float scl = exp2f(ms[h] - mn); lsel[h] = lsel[h] * scl + wave_sum(p); os[h] *= scl; ms[h] = mn; }
            WFENCE();
            const bf16* vb = Y + ((size_t)b * S_ + 64 * j) * YP + Y_AVS + g * 64 + lane;
            for (int kk = 0; kk < 64; ++kk) { const float vv = bf2f(vb[(size_t)kk * YP]);
#pragma unroll
                for (int h = 0; h < 4; ++h) os[h] += s2[h * 64 + kk] * vv; }
        }
        float mw[4] = {-1e30f, -1e30f, -1e30f, -1e30f}, lw[4] = {0.f, 0.f, 0.f, 0.f}, ow[4] = {0.f, 0.f, 0.f, 0.f};
        for (int c = 0; c < 8; ++c) {
            if (q - 64 * c < 0) break;
            const int dist = 64 * c + lane, kpos = q - dist; const bool valid = kpos >= 0;
            float d[4]; dot4(qs, Y + ((size_t)b * S_ + (valid ? kpos : 0)) * YP + Y_AKW + g * 64, d);
            const int bk = t5_bucket(dist);
            WFENCE();
#pragma unroll
            for (int h = 0; h < 4; ++h) { const float s = valid ? d[h] + rel[bk * 16 + g * 4 + h] * LOG2E : -1e30f;
                const float mn = fmaxf(mw[h], wave_max(s)); const float p = valid ? exp2f(s - mn) : 0.f; s2[h * 64 + lane] = p;
                const float scl = exp2f(mw[h] - mn); lw[h] = lw[h] * scl + wave_sum(p); ow[h] *= scl; mw[h] = mn; }
            WFENCE();
            for (int kk = 0; kk < 64; ++kk) { const int kp = q - 64 * c - kk; if (kp < 0) break;
                const float vv = bf2f(Y[((size_t)b * S_ + kp) * YP + Y_AVW + g * 64 + lane]);
#pragma unroll
                for (int h = 0; h < 4; ++h) ow[h] += s2[h * 64 + kk] * vv; }
        }
        WFENCE();
#pragma unroll
        for (int h = 0; h < 4; ++h) { const float o = gt[h][0] * oc[h] + gt[h][1] * os[h] / fmaxf(lsel[h], 1e-20f) + gt[h][2] * ow[h] / fmaxf(lw[h], 1e-20f);
            Yr[Y_AQ + (g * 4 + h) * 64 + lane] = (bf16)f2bf(o); }
    }
}
__device__ __forceinline__ void moba_naive(Frame& F, const Args& a) {
    const int gw = blockIdx.x * NWAVES + F.wave, NGW = F.G * NWAVES, lane = F.lane;
    bf16* Y = (bf16*)(a.ws + WS_Y); const float* rel = a.in[1]; const float* KM = (const float*)(a.ws + WS_KMEAN);
    LAS float* scr = (LAS float*)(F.lds + RING_OFF + F.wave * 16384);
    LAS float* qs = scr; LAS float* s2 = scr + 64;
    for (int task = gw; task < 32 * S_; task += NGW) {
        const int q = task & (S_ - 1), bh = task >> 13, h = bh & 7, b = bh >> 3;
        const size_t row = (size_t)b * S_ + q; bf16* Yr = Y + row * YP;
        WFENCE();
        qs[lane] = bf2f(Yr[Y_CQ + h * 64 + lane]);
        WFENCE();
        const int cur = q >> 8;
        float gs = -1e30f;
        if (lane < 32 && lane < cur) { const float* km = KM + ((size_t)bh * 32 + lane) * 64; float d = 0.f;
            for (int dd = 0; dd < 64; ++dd) d += qs[dd] * km[dd];
            gs = d; }
        if (lane >= 32) gs = -INFINITY;
        bool sel = false;
        for (int it = 0; it < 3; ++it) { const float c = sel ? -INFINITY : gs; const float mxv = wave_max(c);
            const unsigned long long m0 = __ballot(!sel && lane < 32 && gs == mxv); const int idx = m0 ? __builtin_ctzll(m0) : -1; if (lane == idx) sel = true; }
        sel = sel && (lane < cur);
        const unsigned smask = (unsigned)__ballot(sel);
        float mr = -1e30f, lr = 0.f, o = 0.f;
        for (int j = 0; j <= cur; ++j) {
            const bool own = (j == cur);
            if (!own && !((smask >> j) & 1u)) continue;
            for (int c = 0; c < 4; ++c) {
                const int kpos = 256 * j + 64 * c + lane; const bool valid = kpos <= q;
                if (256 * j + 64 * c > q) break;
                const float d = dot1(qs, Y + ((size_t)b * S_ + kpos) * YP + Y_CK + h * 64);
                const int bk = t5_bucket(q - kpos);
                const float s = valid ? d + rel[bk * 16 + 8 + h] * LOG2E : -1e30f;
                const float mn = fmaxf(mr, wave_max(s)); const float p = valid ? exp2f(s - mn) : 0.f;
                WFENCE(); s2[lane] = p; WFENCE();
                const float scl = exp2f(mr - mn); lr = lr * scl + wave_sum(p); o *= scl; mr = mn;
                const bf16* vb = Y + ((size_t)b * S_ + 256 * j + 64 * c) * YP + Y_CV + h * 64 + lane;
                for (int kk = 0; kk < 64; ++kk) o += s2[kk] * bf2f(vb[(size_t)kk * YP]);
            }
        }
        Yr[Y_CQ + h * 64 + lane] = (bf16)f2bf(o / fmaxf(lr, 1e-20f));
    }
}
constexpr int CW_Q = 8192;
__device__ __forceinline__ int next_unit(Frame& F, int k) {
    __syncthreads();
    if (F.tid == 0) F.MISC[16] = __hip_atomic_fetch_add(F.ctl + CW_Q + 64 * k, 1u, RLX_AGENT);
    __syncthreads();
    return (int)F.MISC[16];
}
__device__ __forceinline__ int next_unit_x(Frame& F, int qs, int nper, int x0, int& xo, int& xq) {
    for (;;) { if (xo >= 8) return -1; xq = (x0 + xo) & 7; const int i = next_unit(F, qs * 8 + xq); if (i < nper) return i; ++xo; }
}
__device__ __forceinline__ void moba_fast(Frame& F, const Args& a, int qk) {
    bf16* Y = (bf16*)(a.ws + WS_Y); const float* KM = (const float*)(a.ws + WS_KMEAN);
    const int x0 = (int)(xb_xcc_id() & 7u); int xo = 0, xq = 0;
    for (;;) {
        const int i = next_unit_x(F, qk, 128, x0, xo, xq); if (i < 0) break;
        const int qb = 31 - (i & 31), bh = xq + 8 * (i >> 5), b = bh >> 3, h = bh & 7; const long rowbase = (long)b * S_;
        attn::UArgs U{};
        U.Qb = Y + (rowbase + qb * 256) * YP + Y_CQ + h * 64; U.Kh = Y + rowbase * YP + Y_CK + h * 64; U.Vh = Y + rowbase * YP + Y_CV + h * 64; U.Ob = Y + (rowbase + qb * 256) * YP + Y_CQ + h * 64;
        U.NT = 4 * (qb + 1); U.q0 = qb * 256; U.kt0 = 0; U.hc = 8 + h; U.rel = a.in[1]; U.km = KM + (size_t)bh * 32 * 64; U.qb = qb;
        attn::attn_unit<0, 0, 8>(U, (char*)F.lds + RING_OFF);
    }
}
__device__ __forceinline__ void nsa_fast(Frame& F, const Args& a, int qk) {
    bf16* Y = (bf16*)(a.ws + WS_Y);
    const int x0 = (int)(xb_xcc_id() & 7u); int xo = 0, xq = 0;
    for (;;) {
        const int i = next_unit_x(F, qk, 128, x0, xo, xq); if (i < 0) break;
        const int qb = 31 - (i & 31), b = xq >> 1, g = xq & 1, h = g * 4 + (i >> 5); const long rowbase = (long)b * S_; const int q0 = qb * 256;
        attn::UArgs U{};
        U.Qb = Y + (rowbase + q0) * YP + Y_AQ + h * 64; U.Ob = Y + (rowbase + q0) * YP + Y_AQ + h * 64; U.q0 = q0; U.hc = h; U.rel = a.in[1]; U.gate = Y + (rowbase + q0) * YP;
        { const int T0 = 4 * qb - 8 > 0 ? 4 * qb - 8 : 0;
          U.Kh = Y + (rowbase + 64 * T0) * YP + Y_AKW + g * 64; U.Vh = Y + (rowbase + 64 * T0) * YP + Y_AVW + g * 64; U.NT = 4 * qb + 4 - T0; U.kt0 = 64 * T0; U.gcol = Y_AG + h * 3 + 2;
          attn::attn_unit<2, 1, 8>(U, (char*)F.lds + RING_OFF); }
        { U.Kh = Y + rowbase * YP + Y_AKS + g * 64; U.Vh = Y + rowbase * YP + Y_AVS + g * 64; U.NT = 4 * (qb + 1); U.kt0 = 0; U.gcol = Y_AG + h * 3 + 1;
          U.selg = (const unsigned*)(a.ws + WS_MASK) + ((size_t)(b * 2 + g) * S_ + q0) * 4; U.tmp = (const bf16*)(a.ws + WS_OATMP) + (rowbase + q0) * 512 + h * 64;
          attn::attn_unit<1, 2, 8>(U, (char*)F.lds + RING_OFF); }
    }
}
typedef float f32x16g __attribute__((ext_vector_type(16)));
constexpr int GP = 72;
constexpr int GL_GS = 0;
constexpr int GL_VT = 16640 + 0;
constexpr int GL_A0 = GL_VT + 128 * GP * 2;
constexpr int GL_A1 = GL_A0 + 64 * GP * 2;
constexpr int GL_A2 = GL_A1 + 64 * GP * 2;
constexpr int GL_SS = GL_A2 + 64 * GP * 2;
constexpr int GL_END = GL_SS + 1024;
static_assert(GL_END <= RING_BYTES, "GLA LDS map");
__device__ __forceinline__ int crow32(int r, int hi) { return (r & 3) + 8 * (r >> 2) + 4 * hi; }
__device__ __forceinline__ void gla_bcum(Frame& F, const Args& a, int l, const bf16* Yc  , int h) {
    LAS float* gS = (LAS float*)(F.lds + RING_OFF + GL_GS);
    const int t = F.tid >> 3, dg = F.tid & 7;
    const float* w2 = a.in[13] + (size_t)l * 16 * 256 + h * 64 + dg * 8; const float* bias = a.in[14] + (size_t)l * 256 + h * 64 + dg * 8;
    float blr[16];
    { const v4u w0 = *(const v4u*)(Yc + (size_t)t * YP + Y_BLR), w1 = *(const v4u*)(Yc + (size_t)t * YP + Y_BLR + 8); float k0[8], k1[8]; unpack8(w0, k0); unpack8(w1, k1);
#pragma unroll
      for (int i = 0; i < 8; ++i) { blr[i] = k0[i]; blr[8 + i] = k1[i]; } }
    float z[8];
#pragma unroll
    for (int i = 0; i < 8; ++i) z[i] = bias[i];
#pragma unroll
    for (int r = 0; r < 16; ++r) { const f32x4 wa = *(const f32x4*)(w2 + r * 256), wb = *(const f32x4*)(w2 + r * 256 + 4);
        z[0] += blr[r] * wa.x; z[1] += blr[r] * wa.y; z[2] += blr[r] * wa.z; z[3] += blr[r] * wa.w; z[4] += blr[r] * wb.x; z[5] += blr[r] * wb.y; z[6] += blr[r] * wb.z; z[7] += blr[r] * wb.w; }
#pragma unroll
    for (int i = 0; i < 8; ++i) { const float zz = z[i]; gS[t * 65 + dg * 8 + i] = -(fmaxf(-zz, 0.f) + log1pf(__expf(-fabsf(zz)))) * (1.f / 16.f); }
    __syncthreads();
    if (F.tid < 64) { float acc = 0.f;
#pragma unroll 8
        for (int tt = 0; tt < 64; ++tt) { acc += gS[tt * 65 + F.tid]; gS[tt * 65 + F.tid] = acc; } }
    __syncthreads();
}
__device__ __forceinline__ void gla_stage_vT(Frame& F, const bf16* Yc, int h) {
    LAS bf16* vT = (LAS bf16*)(F.lds + RING_OFF + GL_VT); const int t = F.tid >> 3, dg = F.tid & 7;
    const v4u w0 = *(const v4u*)(Yc + (size_t)t * YP + Y_BV + h * 128 + dg * 16), w1 = *(const v4u*)(Yc + (size_t)t * YP + Y_BV + h * 128 + dg * 16 + 8);
    const unsigned ww[8] = {w0.x, w0.y, w0.z, w0.w, w1.x, w1.y, w1.z, w1.w};
#pragma unroll
    for (int i = 0; i < 8; ++i) { vT[(dg * 16 + 2 * i) * GP + t] = (bf16)(ww[i] & 0xffffu); vT[(dg * 16 + 2 * i + 1) * GP + t] = (bf16)(ww[i] >> 16); }
}
__device__ __forceinline__ bf16x8 lds_frag(const LAS bf16* X, int row, int kk) { return *(const LAS bf16x8*)(X + row * GP + kk); }
__device__ __forceinline__ void gla_g1(Frame& F, const Args& a, int l) {
    const bf16* Y = (const bf16*)(a.ws + WS_Y); bf16* GST = (bf16*)(a.ws + WS_GST); float* DEC = (float*)(a.ws + WS_GDEC);
    LAS float* gS = (LAS float*)(F.lds + RING_OFF + GL_GS); LAS bf16* vT = (LAS bf16*)(F.lds + RING_OFF + GL_VT); LAS bf16* kT = (LAS bf16*)(F.lds + RING_OFF + GL_A0);
    const int lane = F.lane, r32 = lane & 31, hi = lane >> 5, w = F.wave;
    for (int u = blockIdx.x; u < 2048; u += F.G) {
        const int c = u & 127, bh = u >> 7, h = bh & 3, b = bh >> 2; const bf16* Yc = Y + ((size_t)b * S_ + c * 64) * YP;
        gla_bcum(F, a, l, Yc, h);
        { const int t = F.tid >> 3, dg = F.tid & 7; const v4u kw = *(const v4u*)(Yc + (size_t)t * YP + Y_BK + h * 64 + dg * 8); float kk[8]; unpack8(kw, kk);
#pragma unroll
          for (int i = 0; i < 8; ++i) { const int d = dg * 8 + i; kT[d * GP + t] = (bf16)f2bf(kk[i] * __expf(gS[63 * 65 + d] - gS[t * 65 + d])); }
          if (F.tid < 64) DEC[(size_t)u * 64 + F.tid] = __expf(gS[63 * 65 + F.tid]); }
        gla_stage_vT(F, Yc, h);
        __syncthreads();
        { const int et = w >> 1, dt = w & 1; f32x16g acc = {};
#pragma unroll
          for (int ks = 0; ks < 4; ++ks) acc = __builtin_amdgcn_mfma_f32_32x32x16_bf16(lds_frag(vT, et * 32 + r32, ks * 16 + hi * 8), lds_frag(kT, dt * 32 + r32, ks * 16 + hi * 8), acc, 0, 0, 0);
          bf16* slot = GST + (size_t)u * 8192;
#pragma unroll
          for (int r = 0; r < 16; ++r) slot[(et * 32 + crow32(r, hi)) * 64 + dt * 32 + r32] = (bf16)f2bf(acc[r]); }
        __syncthreads();
    }
}
__device__ __forceinline__ void gla_g2(Frame& F, const Args& a) {
    unsigned* GST = (unsigned*)(a.ws + WS_GST); const float* DEC = (const float*)(a.ws + WS_GDEC);
    for (int i = blockIdx.x * 512 + F.tid; i < 16 * 128 * 32; i += F.G * 512) {
        const int dp = i & 31, bh = i >> 12; const int eo = (i >> 5) & 127;
        float s0 = 0.f, s1 = 0.f;
        for (int c0 = 0; c0 < 128; c0 += 8) {
            unsigned uu[8]; float d0[8], d1[8];
#pragma unroll
            for (int j = 0; j < 8; ++j) { const size_t sl = (size_t)(bh * 128 + c0 + j); uu[j] = GST[sl * 4096 + eo * 32 + dp]; d0[j] = DEC[sl * 64 + 2 * dp]; d1[j] = DEC[sl * 64 + 2 * dp + 1]; }
#pragma unroll
            for (int j = 0; j < 8; ++j) { const size_t sl = (size_t)(bh * 128 + c0 + j); GST[sl * 4096 + eo * 32 + dp] = pk2(s0, s1);
                s0 = s0 * d0[j] + __uint_as_float(uu[j] << 16); s1 = s1 * d1[j] + __uint_as_float(uu[j] & 0xffff0000u); }
        }
    }
}
__device__ __forceinline__ void gla_g3(Frame& F, const Args& a, int l, int qk) {
    bf16* Y = (bf16*)(a.ws + WS_Y); const bf16* GST = (const bf16*)(a.ws + WS_GST); const float* nw = a.in[15] + (size_t)l * 128;
    LAS float* gS = (LAS float*)(F.lds + RING_OFF + GL_GS); LAS bf16* vT = (LAS bf16*)(F.lds + RING_OFF + GL_VT);
    LAS bf16* qd = (LAS bf16*)(F.lds + RING_OFF + GL_A0); LAS bf16* kd = (LAS bf16*)(F.lds + RING_OFF + GL_A1); LAS bf16* at = (LAS bf16*)(F.lds + RING_OFF + GL_A2);
    LAS float* ssq = (LAS float*)(F.lds + RING_OFF + GL_SS);
    const int lane = F.lane, r32 = lane & 31, hi = lane >> 5, w = F.wave;
    const int x0 = (int)(xb_xcc_id() & 7u); int xo = 0, xq = 0;
    for (;;) {
        const int i3 = next_unit_x(F, qk, 256, x0, xo, xq); if (i3 < 0) break;
        const int u = xq * 256 + i3;
        const int c = u & 127, bh = u >> 7, h = bh & 3, b = bh >> 2; bf16* Yc = Y + ((size_t)b * S_ + c * 64) * YP;
        gla_bcum(F, a, l, Yc, h);
        { const int t = F.tid >> 3, dg = F.tid & 7; const v4u qw = *(const v4u*)(Yc + (size_t)t * YP + Y_BQ + h * 64 + dg * 8), kw = *(const v4u*)(Yc + (size_t)t * YP + Y_BK + h * 64 + dg * 8);
          float qq[8], kk[8]; unpack8(qw, qq); unpack8(kw, kk); v4u qo, ko; unsigned qa[4], ka[4];
#pragma unroll
          for (int i = 0; i < 4; ++i) { const float g0 = gS[t * 65 + dg * 8 + 2 * i], g1 = gS[t * 65 + dg * 8 + 2 * i + 1];
              qa[i] = pk2(qq[2 * i] * __expf(g0), qq[2 * i + 1] * __expf(g1)); ka[i] = pk2(kk[2 * i] * __expf(-g0), kk[2 * i + 1] * __expf(-g1)); }
          qo.x = qa[0]; qo.y = qa[1]; qo.z = qa[2]; qo.w = qa[3]; ko.x = ka[0]; ko.y = ka[1]; ko.z = ka[2]; ko.w = ka[3];
          *(LAS v4u*)(qd + t * GP + dg * 8) = qo; *(LAS v4u*)(kd + t * GP + dg * 8) = ko; }
        gla_stage_vT(F, Yc, h);
        __syncthreads();
        if (w < 4) { const int ib = w >> 1, jb = w & 1;
            if (jb <= ib) { f32x16g acc = {};
#pragma unroll
                for (int ks = 0; ks < 4; ++ks) acc = __builtin_amdgcn_mfma_f32_32x32x16_bf16(lds_frag(qd, ib * 32 + r32, ks * 16 + hi * 8), lds_frag(kd, jb * 32 + r32, ks * 16 + hi * 8), acc, 0, 0, 0);
#pragma unroll
                for (int r = 0; r < 16; ++r) { const int i = ib * 32 + crow32(r, hi), j = jb * 32 + r32; at[i * GP + j] = (bf16)f2bf(j <= i ? acc[r] : 0.f); } } }
        __syncthreads();
        { const int rb = w >> 2, et = w & 3; f32x16g acc = {};
          const bf16* slot = GST + (size_t)u * 8192 + (size_t)(et * 32 + r32) * 64 + hi * 8;
#pragma unroll
          for (int ks = 0; ks < 4; ++ks) { const bf16x8 sb = *(const bf16x8*)(slot + ks * 16);
              acc = __builtin_amdgcn_mfma_f32_32x32x16_bf16(lds_frag(qd, rb * 32 + r32, ks * 16 + hi * 8), sb, acc, 0, 0, 0); }
          for (int ks = 0; ks < 2 * (rb + 1); ++ks) acc = __builtin_amdgcn_mfma_f32_32x32x16_bf16(lds_frag(at, rb * 32 + r32, ks * 16 + hi * 8), lds_frag(vT, et * 32 + r32, ks * 16 + hi * 8), acc, 0, 0, 0);
          float sq[16];
#pragma unroll
          for (int r = 0; r < 16; ++r) { float v = acc[r] * acc[r];
              v += __shfl_xor(v, 1); v += __shfl_xor(v, 2); v += __shfl_xor(v, 4); v += __shfl_xor(v, 8); v += __shfl_xor(v, 16); sq[r] = v; }
          if (r32 == 0) {
#pragma unroll
              for (int r = 0; r < 16; ++r) ssq[w * 32 + crow32(r, hi)] = sq[r]; }
          __syncthreads();
          const float nwe = nw[et * 32 + r32];
#pragma unroll
          for (int r = 0; r < 16; ++r) { const int tr = crow32(r, hi); const float tot = ssq[(rb * 4 + 0) * 32 + tr] + ssq[(rb * 4 + 1) * 32 + tr] + ssq[(rb * 4 + 2) * 32 + tr] + ssq[(rb * 4 + 3) * 32 + tr];
              bf16* yp = Yc + (size_t)(rb * 32 + tr) * YP + Y_BR + h * 128 + et * 32 + r32; const float rv = bf2f(*yp);
              *yp = (bf16)f2bf(acc[r] * rsqrtf(tot * (1.f / 128.f) + NORM_EPS) * nwe * (rv * sigm(rv))); } }
        __syncthreads();
    }
}
constexpr int CL_IMP = 0, CL_BIAS = 64 * 129 * 4, CL_K = CL_BIAS + 2048, CL_GATE = CL_K + 512 * GP * 2, CL_END = CL_GATE + 1024;
static_assert(CL_END <= RING_BYTES && (CL_K % 16) == 0, "cmp LDS map");
__device__ __forceinline__ int red8(int v) {
    v += __builtin_amdgcn_update_dpp(0, v, 0xB1, 0xf, 0xf, true);
    v += __builtin_amdgcn_update_dpp(0, v, 0x4E, 0xf, 0xf, true);
    v += __builtin_amdgcn_update_dpp(0, v, 0x141, 0xf, 0xf, true);
    return v;
}
typedef unsigned u32x2g __attribute__((ext_vector_type(2)));
struct VFrag { u32x2g a[8]; };
__device__ __forceinline__ void cmp_load_v(VFrag& f, const bf16* VT, int nt, int r32, int hi) {
#pragma unroll
    for (int dt = 0; dt < 2; ++dt)
#pragma unroll
        for (int kk = 0; kk < 2; ++kk) { const bf16* vp = VT + (size_t)(dt * 32 + r32) * 512 + nt * 32 + kk * 16 + 4 * hi; f.a[(dt * 2 + kk) * 2] = *(const u32x2g*)vp; f.a[(dt * 2 + kk) * 2 + 1] = *(const u32x2g*)(vp + 8); }
}
__device__ __forceinline__ void nsa_cmp_fast(Frame& F, const Args& a, int qk) {
    const bf16* Y = (const bf16*)(a.ws + WS_Y); const float* rel = a.in[1];
    LAS unsigned* impI = (LAS unsigned*)(F.lds + RING_OFF + CL_IMP); LAS float* biasT = (LAS float*)(F.lds + RING_OFF + CL_BIAS); LAS bf16* Ks = (LAS bf16*)(F.lds + RING_OFF + CL_K);
    const int lane = F.lane, r32 = lane & 31, hi = lane >> 5, w = F.wave, hr = w >> 1, qh = w & 1;
    const int x0 = (int)(xb_xcc_id() & 7u); int xo = 0, xq = 0;
    for (;;) {
        const int i = next_unit_x(F, qk, 128, x0, xo, xq); if (i < 0) break;
        const int c = 127 - i, bg = xq, g = bg & 1, b = bg >> 1, q0 = 64 * c; const size_t rowbase = (size_t)b * S_;
        const bf16* KC = (const bf16*)(a.ws + WS_KCMP) + (size_t)bg * 512 * 64; const bf16* VT = (const bf16*)(a.ws + WS_VCMPT) + (size_t)bg * 64 * 512;
        const int head = g * 4 + hr, qw0 = q0 + qh * 32, qpos = qw0 + r32;
        const int NTw = (qw0 / 16 + 1 + 31) >> 5;
        const int nrows = (((q0 + 32) / 16 + 1 + 31) >> 5) * 32;
        { v4u kv[8]; int tl = F.tid; asm volatile("" : "+v"(tl));
          const unsigned o0_ = (unsigned)((tl >> 3) * 64 + (tl & 7) * 8);
#pragma unroll
          for (int j = 0; j < 8; ++j) { const int p = tl + 512 * j; if (p < nrows * 8) kv[j] = *(const v4u*)(KC + o0_ + 4096u * j); }
          for (int ii = F.tid; ii < 64 * 129; ii += 512) impI[ii] = 0u;
          { const int hh = F.tid >> 7, dd = F.tid & 127; biasT[F.tid] = (rel[t5_bucket(dd) * 16 + g * 4 + hh] - rel[31 * 16 + g * 4 + hh]) * LOG2E; }
#pragma unroll
          for (int j = 0; j < 8; ++j) { const int p = tl + 512 * j; if (p < nrows * 8) *(LAS v4u*)(Ks + ((tl >> 3) + 64 * j) * GP + (tl & 7) * 8) = kv[j]; } }
        const bf16* Qw = Y + (rowbase + qw0) * YP + Y_AQ + head * 64;
        bf16x8 qr[4];
#pragma unroll
        for (int ks = 0; ks < 4; ++ks) qr[ks] = *(const bf16x8*)(Qw + (size_t)r32 * YP + ks * 16 + hi * 8);
        if (hi == 0) ((LAS float*)(F.lds + RING_OFF + CL_GATE))[w * 32 + r32] = sigm(bf2f(Y[(rowbase + qw0 + r32) * YP + Y_AG + head * 3]));
        __syncthreads();
        const LAS float* bT = biasT + hr * 128;
        float lsum = 0.f;
#pragma unroll 1
        for (int nt = 0; nt < NTw; ++nt) { f32x16g C = {};
#pragma unroll
            for (int ks = 0; ks < 4; ++ks) C = __builtin_amdgcn_mfma_f32_32x32x16_bf16(lds_frag(Ks, nt * 32 + r32, ks * 16 + hi * 8), qr[ks], C, 0, 0, 0);
#pragma unroll
            for (int r = 0; r < 16; ++r) { const int dist = qpos - (16 * (nt * 32 + crow32(r, hi)) + 31); lsum += dist >= 0 ? __builtin_amdgcn_exp2f(fminf(C[r] + bT[dist > 127 ? 127 : (dist < 0 ? 0 : dist)], 100.f)) : 0.f; } }
        { auto rr = __builtin_amdgcn_permlane32_swap(__float_as_uint(lsum), __float_as_uint(lsum), false, false); lsum = __uint_as_float(rr[0]) + __uint_as_float(rr[1]); }
        const float inv = 1.f / fmaxf(lsum, 1e-30f);
        f32x16g o0 = {}, o1 = {};
#pragma unroll 1
        for (int nt = 0; nt < NTw; ++nt) {
            VFrag vcur; cmp_load_v(vcur, VT, nt, r32, hi);
            f32x16g C = {};
#pragma unroll
            for (int ks = 0; ks < 4; ++ks) C = __builtin_amdgcn_mfma_f32_32x32x16_bf16(lds_frag(Ks, nt * 32 + r32, ks * 16 + hi * 8), qr[ks], C, 0, 0, 0);
            float p[16];
#pragma unroll
            for (int r = 0; r < 16; ++r) { const int dist = qpos - (16 * (nt * 32 + crow32(r, hi)) + 31); p[r] = dist >= 0 ? __builtin_amdgcn_exp2f(fminf(C[r] + bT[dist > 127 ? 127 : (dist < 0 ? 0 : dist)], 100.f)) * inv : 0.f; }
#pragma unroll
            for (int m = 0; m < 4; ++m) { const float G = (p[4 * m] + p[4 * m + 1]) + (p[4 * m + 2] + p[4 * m + 3]); const int j = nt * 8 + 2 * m + hi;
                LAS unsigned* ip = impI + (qh * 32 + r32) * 129 + j;
                __hip_atomic_fetch_add(ip, (unsigned)(G * 67108864.f + 0.5f), __ATOMIC_RELAXED, __HIP_MEMORY_SCOPE_WORKGROUP);
                if (j + 1 < 128) __hip_atomic_fetch_add(ip + 1, (unsigned)(p[4 * m + 3] * 67108864.f + 0.5f), __ATOMIC_RELAXED, __HIP_MEMORY_SCOPE_WORKGROUP); }
            v4u pw0, pw1; pw0.x = pk2(p[0], p[1]); pw0.y = pk2(p[2], p[3]); pw0.z = pk2(p[4], p[5]); pw0.w = pk2(p[6], p[7]); pw1.x = pk2(p[8], p[9]); pw1.y = pk2(p[10], p[11]); pw1.z = pk2(p[12], p[13]); pw1.w = pk2(p[14], p[15]);
            const bf16x8 pa0 = __builtin_bit_cast(bf16x8, pw0), pa1 = __builtin_bit_cast(bf16x8, pw1);
#pragma unroll
            for (int dt = 0; dt < 2; ++dt)
#pragma unroll
                for (int kk = 0; kk < 2; ++kk) { v4u vv; vv.x = vcur.a[(dt * 2 + kk) * 2].x; vv.y = vcur.a[(dt * 2 + kk) * 2].y; vv.z = vcur.a[(dt * 2 + kk) * 2 + 1].x; vv.w = vcur.a[(dt * 2 + kk) * 2 + 1].y;
                    if (dt == 0) o0 = __builtin_amdgcn_mfma_f32_32x32x16_bf16(kk ? pa1 : pa0, __builtin_bit_cast(bf16x8, vv), o0, 0, 0, 0);
                    else o1 = __builtin_amdgcn_mfma_f32_32x32x16_bf16(kk ? pa1 : pa0, __builtin_bit_cast(bf16x8, vv), o1, 0, 0, 0); }
            }
        { bf16* T = (bf16*)(a.ws + WS_OATMP);
#pragma unroll
          for (int r = 0; r < 16; ++r) { const size_t row = rowbase + qw0 + crow32(r, hi); const float gs = ((const LAS float*)(F.lds + RING_OFF + CL_GATE))[w * 32 + crow32(r, hi)];
              T[row * 512 + head * 64 + r32] = (bf16)f2bf(gs * o0[r]); T[row * 512 + head * 64 + 32 + r32] = (bf16)f2bf(gs * o1[r]); } }
        __syncthreads();
        { const int qi = F.tid >> 3, part = F.tid & 7, cur = c; unsigned key[16];
#pragma unroll
          for (int i2 = 0; i2 < 16; ++i2) { const int j = part * 16 + i2; const unsigned raw = impI[qi * 129 + j] >> 6; const bool forced = (j == 0) || (j == cur) || (j == cur - 1);
              key[i2] = forced ? (0xFFFFFF80u | (unsigned)(127 - j)) : (j <= cur ? ((((raw > 33554430u ? 33554430u : raw) + 1u) << 7) | (unsigned)(127 - j)) : (unsigned)(127 - j)); }
          unsigned T = 0u;
          for (int bit = 31; bit >= 0; --bit) { const unsigned Tt = T | (1u << bit); int cnt = 0;
#pragma unroll
              for (int i2 = 0; i2 < 16; ++i2) cnt += key[i2] >= Tt ? 1 : 0;
              cnt = red8(cnt); if (cnt >= 16) T = Tt; }
          unsigned bits = 0u;
#pragma unroll
          for (int i2 = 0; i2 < 16; ++i2) bits |= (key[i2] >= T && (part * 16 + i2) <= cur) ? (1u << i2) : 0u;
          ((unsigned short*)(a.ws + WS_MASK))[((size_t)bg * S_ + q0 + qi) * 8 + part] = (unsigned short)bits; }
    }
}
constexpr int CP_RED = 0, CP_HS = 8 * 32 * 64 * 4, CP_END = CP_HS + 32 * GP * 2;
static_assert(CP_END <= RING_BYTES, "compress LDS map");
__device__ __forceinline__ void compress_fast(Frame& F, const Args& a) {
    const bf16* Y = (const bf16*)(a.ws + WS_Y);
    LAS float* red = (LAS float*)(F.lds + RING_OFF + CP_RED); LAS bf16* hs = (LAS bf16*)(F.lds + RING_OFF + CP_HS);
    const int lane = F.lane, r32 = lane & 31, hi = lane >> 5, w = F.wave;
    for (int u = blockIdx.x; u < 256; u += F.G) {
        const int nt = u & 15, bg = (u >> 4) & 7, kv = u >> 7, g = bg & 1, b = bg >> 1;
        const int n = nt * 32 + r32, nn = n > 510 ? 510 : n;
        const bf16* xrow = Y + ((size_t)b * S_ + 16 * nn) * YP + (kv ? Y_AVC : Y_AKC) + g * 64 + hi * 8;
        const bf16* W1T = (const bf16*)(a.ws + WS_CW1T) + (size_t)kv * 64 * 2048;
        f32x16g acc0 = {}, acc1 = {};
#pragma unroll 4
        for (int s = 0; s < 16; ++s) { const int ks = w * 16 + s, pos = ks >> 2;
            const bf16x8 af = *(const bf16x8*)(xrow + (size_t)pos * YP + (ks & 3) * 16);
            const bf16x8 b0 = *(const bf16x8*)(W1T + (size_t)r32 * 2048 + ks * 16 + hi * 8), b1 = *(const bf16x8*)(W1T + (size_t)(32 + r32) * 2048 + ks * 16 + hi * 8);
            acc0 = __builtin_amdgcn_mfma_f32_32x32x16_bf16(af, b0, acc0, 0, 0, 0); acc1 = __builtin_amdgcn_mfma_f32_32x32x16_bf16(af, b1, acc1, 0, 0, 0); }
#pragma unroll
        for (int r = 0; r < 16; ++r) { red[(w * 32 + crow32(r, hi)) * 64 + r32] = acc0[r]; red[(w * 32 + crow32(r, hi)) * 64 + 32 + r32] = acc1[r]; }
        __syncthreads();
        { const float* c0 = (const float*)(a.ws + WS_CC0) + kv * 64;
#pragma unroll
          for (int i = 0; i < 4; ++i) { const int e = F.tid * 4 + i, rn = e >> 6, j = e & 63; float v = c0[j];
#pragma unroll
              for (int ww = 0; ww < 8; ++ww) v += red[(ww * 32 + rn) * 64 + j];
              hs[rn * GP + j] = (bf16)f2bf(gelu_tanh(v)); } }
        __syncthreads();
        if (w < 2) { const bf16* W2T = (const bf16*)(a.ws + WS_CW2T) + (size_t)kv * 64 * 64; f32x16g o = {};
#pragma unroll
            for (int ks = 0; ks < 4; ++ks) { const bf16x8 bf = *(const bf16x8*)(W2T + (size_t)(w * 32 + r32) * 64 + ks * 16 + hi * 8);
                o = __builtin_amdgcn_mfma_f32_32x32x16_bf16(lds_frag(hs, r32, ks * 16 + hi * 8), bf, o, 0, 0, 0); }
#pragma unroll
            for (int r = 0; r < 16; ++r) { const int rn = nt * 32 + crow32(r, hi), jp = w * 32 + r32;
                if (kv == 0) ((bf16*)(a.ws + WS_KCMP))[((size_t)bg * 512 + rn) * 64 + jp] = (bf16)f2bf(o[r]);
                else ((bf16*)(a.ws + WS_VCMPT))[((size_t)bg * 64 + jp) * 512 + rn] = (bf16)f2bf(o[r]); } }
        __syncthreads();
    }
}
__device__ __forceinline__ void gla_out_naive(Frame& F, const Args& a, int l) {
    const int gw = blockIdx.x * NWAVES + F.wave, NGW = F.G * NWAVES, lane = F.lane;
    bf16* Y = (bf16*)(a.ws + WS_Y); const bf16* O16 = (const bf16*)(a.ws + WS_O16); const float* nw = a.in[15] + (size_t)l * 128;
    for (int t = gw; t < M_ * 4; t += NGW) {
        const int h = t & 3; const size_t row = (size_t)(t >> 2);
        const float o0 = bf2f(O16[row * 512 + h * 128 + lane]), o1 = bf2f(O16[row * 512 + h * 128 + 64 + lane]);
        const float r = rsqrtf(wave_sum(o0 * o0 + o1 * o1) * (1.f / 128.f) + NORM_EPS);
        bf16* yr = Y + row * YP + Y_BR + h * 128;
        const float r0 = bf2f(yr[lane]), r1 = bf2f(yr[64 + lane]);
        yr[lane] = (bf16)f2bf(o0 * r * nw[lane] * (r0 * sigm(r0))); yr[64 + lane] = (bf16)f2bf(o1 * r * nw[64 + lane] * (r1 * sigm(r1)));
    }
}

__device__ __forceinline__ Frame fresh(const Frame& F) { Frame f = F; int t = threadIdx.x; asm volatile("" : "+v"(t)); f.tid = t; f.lane = t & 63; return f; }
constexpr int PPL = 11, NPH = NL * PPL;
#define IN(k) (lo <= (k) && (k) < hi)
#define SEAM(k) do { if (IN(k) && IN((k) + 1)) xcd_barrier(bar); } while (0)
template <int l> __device__ __forceinline__ void layer_body(Frame& F0, const Args& args, const XcdBarrier& bar, const int lo, const int hi) {
    unsigned char* ws = args.ws;
    bf16* H = (bf16*)(ws + WS_H); bf16* Y = (bf16*)(ws + WS_Y); unsigned char* G8 = ws + WS_G8;
    float* Yf = (float*)(ws + WS_Y); bf16* ACT = (bf16*)(ws + WS_ACT);
    constexpr int p0 = l * PPL;
    const float* xin = l == 0 ? args.in[0] : args.out;
    if (IN(p0 + 0)) { Frame F = fresh(F0); phase_weights(F, args, l); if (l == 0) phase_norm0(F, args.in[0], args.in[2], H); SEAM(p0 + 0); }
    if (IN(p0 + 1)) { Frame F = fresh(F0);
        pg8::Gemm g{H, (const bf16*)(ws + WS_WIN), M_, NIN, DM, DM}; pg8::StaticOrder So; So.init(M_, NIN, F.G, (int)blockIdx.x);
        pg8::EpiInProj E{Y, G8};
        pg8::gemm_phase<pg8::EpiInProj, pg8::StaticOrder, true, true>(F.lds + RING_OFF, g, So, E);
        SEAM(p0 + 1);
    }
    if (IN(p0 + 2)) { { Frame F = fresh(F0); compress_fast(F, args); } { Frame F = fresh(F0); phase2_naive(F, args, l); } { Frame F = fresh(F0); gla_g1(F, args, l); } SEAM(p0 + 2); }
    if (IN(p0 + 3)) { { Frame F = fresh(F0); gla_g2(F, args); } { Frame F = fresh(F0); moba_fast(F, args, l * 4 + 0); } { Frame F = fresh(F0); nsa_cmp_fast(F, args, l * 4 + 1); } SEAM(p0 + 3); }
    if (IN(p0 + 4)) { { Frame F = fresh(F0); nsa_fast(F, args, l * 4 + 2); } { Frame F = fresh(F0); gla_g3(F, args, l, l * 4 + 3); } SEAM(p0 + 4); }
    if (IN(p0 + 5)) { Frame F = fresh(F0);
        pg8::StaticOrder So; So.init(M_, DM, F.G, (int)blockIdx.x);
        { pg8::Gemm g{Y + Y_AQ, (const bf16*)(ws + WS_WA), M_, DM, 512, YP}; pg8::EpiMerge<0> E{H, G8}; pg8::gemm_phase<pg8::EpiMerge<0>, pg8::StaticOrder, true, true>(F.lds + RING_OFF, g, So, E); }
        __syncthreads();
        { pg8::Gemm g{Y + Y_BR, (const bf16*)(ws + WS_WB), M_, DM, 512, YP}; pg8::EpiMerge<1> E{H, G8}; pg8::gemm_phase<pg8::EpiMerge<1>, pg8::StaticOrder, true, true>(F.lds + RING_OFF, g, So, E); }
        __syncthreads();
        { pg8::Gemm g{Y + Y_CQ, (const bf16*)(ws + WS_WC), M_, DM, 512, YP}; pg8::EpiMerge<2> E{H, G8}; pg8::gemm_phase<pg8::EpiMerge<2>, pg8::StaticOrder, true, true>(F.lds + RING_OFF, g, So, E); }
        SEAM(p0 + 5);
    }
    if (IN(p0 + 6)) { Frame F = fresh(F0);
        pg8::Gemm g{H, (const bf16*)(ws + WS_WO), M_, DM, DM, DM}; pg8::StaticOrder So; So.init(M_, DM, F.G, (int)blockIdx.x);
        pg8::EpiF32 E{Yf, DM}; pg8::gemm_phase<pg8::EpiF32, pg8::StaticOrder, true, true>(F.lds + RING_OFF, g, So, E);
        SEAM(p0 + 6);
    }
    if (IN(p0 + 7)) { Frame F = fresh(F0); phase_resid(F, Yf, xin, args.out, args.in[3] + (size_t)l * DM, args.in[4] + (size_t)l * DM, H); SEAM(p0 + 7); }
    if (IN(p0 + 8)) { Frame F = fresh(F0);
        pg8::Gemm g{H, (const bf16*)(ws + WS_WF1), M_, 2 * FF, DM, DM}; pg8::StaticOrder So; So.init(M_, 2 * FF, F.G, (int)blockIdx.x);
        pg8::EpiSwiglu E{ACT, FF}; pg8::gemm_phase<pg8::EpiSwiglu, pg8::StaticOrder, true, true>(F.lds + RING_OFF, g, So, E);
        SEAM(p0 + 8);
    }
    if (IN(p0 + 9)) { Frame F = fresh(F0);
        pg8::Gemm g{ACT, (const bf16*)(ws + WS_WF2), M_, DM, FF, FF}; pg8::StaticOrder So; So.init(M_, DM, F.G, (int)blockIdx.x);
        pg8::EpiF32 E{Yf, DM}; pg8::gemm_phase<pg8::EpiF32, pg8::StaticOrder, true, true>(F.lds + RING_OFF, g, So, E);
        SEAM(p0 + 9);
    }
    if (IN(p0 + 10)) { Frame F = fresh(F0); phase_resid(F, Yf, args.out, args.out, args.in[5] + (size_t)l * DM, l + 1 < NL ? args.in[2] + (size_t)(l + 1) * DM : nullptr, l + 1 < NL ? H : nullptr); SEAM(p0 + 10); }
}
__global__ void __launch_bounds__(NWAVES * 64, 2) mk_fwd(Args args) {
    extern __shared__ __attribute__((aligned(16))) unsigned char lds[];
    Frame F;
    F.lds = (LAS unsigned char*)lds; F.MISC = (volatile LAS unsigned*)(F.lds + MISC_OFF);
    F.tid = threadIdx.x; F.lane = F.tid & 63; F.wave = __builtin_amdgcn_readfirstlane(F.tid >> 6); F.G = gridDim.x;
    F.ctl = (gu32*)(args.ws + WS_CTL);
    for (int u = F.tid; u < (LDS_BYTES - LDSCTL_OFF) / 4; u += NWAVES * 64) ((LAS unsigned*)(F.lds + LDSCTL_OFF))[u] = 0u;
    __syncthreads();
    const int lo = args.ph_lo, hi = args.ph_hi;
    XcdBarrier bar; bar.bar = (unsigned*)(F.ctl + CW_BAR); bar.x = 0; bar.st = nullptr;
    if (hi - lo > 1) bar = xcd_barrier_post((unsigned*)(F.ctl + CW_BAR), F.MISC + 8);
    layer_body<0>(F, args, bar, lo, hi);
    layer_body<1>(F, args, bar, lo, hi);
}
#undef IN
#undef SEAM

#ifndef MK_ONE_LAUNCH
#define MK_ONE_LAUNCH 1
#endif
extern "C" void kernel_launch(void* const* d_in, const int* in_sizes, int n_in, void* d_out, int out_size, void* d_ws, size_t ws_size, hipStream_t stream) {
    static int grid = 0;
    if (grid == 0) {
        if (n_in != 22 || out_size != M_ * DM || ws_size < WS_END) { fprintf(stderr, "kernel_launch: unexpected sizes (n_in %d out %d ws %zu)\n", n_in, out_size, ws_size); grid = -1; return; }
        int dev = 0, cus = 0;
        if (hipGetDevice(&dev) != hipSuccess || hipDeviceGetAttribute(&cus, hipDeviceAttributeMultiprocessorCount, dev) != hipSuccess) { grid = -1; return; }
        if (hipFuncSetAttribute((const void*)mk_fwd, hipFuncAttributeMaxDynamicSharedMemorySize, LDS_BYTES) != hipSuccess) { grid = -1; return; }
        (void)hipGetLastError();
        grid = cus;
    }
    if (grid < 0) return;
    if (hipMemsetAsync((char*)d_ws + WS_CTL, 0, CTL_ZERO_BYTES, stream) != hipSuccess) return;
    Args a{};
    for (int i = 0; i < 22; ++i) a.in[i] = (const float*)d_in[i];
    a.out = (float*)d_out; a.ws = (unsigned char*)d_ws;
#if MK_ONE_LAUNCH
    a.ph_lo = 0; a.ph_hi = NPH;
    hipLaunchKernelGGL(mk_fwd, dim3(grid), dim3(NWAVES * 64), LDS_BYTES, stream, a);
#else
    for (int p = 0; p < NPH; ++p) { a.ph_lo = p; a.ph_hi = p + 1; hipLaunchKernelGGL(mk_fwd, dim3(grid), dim3(NWAVES * 64), LDS_BYTES, stream, a); }
#endif
}
```

```cpp
#include <hip/hip_runtime.h>
#include <cstdio>
#include <cstdint>
#include <cmath>
namespace pg8 {
#define PG8_LAS __attribute__((address_space(3)))
typedef unsigned short bf16_t;
typedef short bf16x8 __attribute__((ext_vector_type(8)));
typedef float f32x4 __attribute__((ext_vector_type(4)));
typedef unsigned u32x4 __attribute__((ext_vector_type(4)));
constexpr int BM = 256, BK = 64, HALF = 128, HTB = HALF * BK * 2  , STAGE_BYTES = 8 * HTB, NXCD = 8, WGM = 8;

__host__ __device__ __forceinline__ int lds_byte(int r, int c) { const int st = (r >> 4) * 2 + (c >> 5), rr = r & 15, cc = c & 31, ob = rr * 64 + cc * 2; return st * 1024 + (ob ^ (((ob >> 9) & 1) << 5)); }
__host__ __device__ __forceinline__ void stage_rc(int b, int& R, int& C) { const int st = b / 1024, sb = b % 1024, swz = sb ^ (((sb >> 9) & 1) << 5); R = (st >> 1) * 16 + swz / 64; C = (st & 1) * 32 + (swz % 64) / 2; }
__host__ __device__ __forceinline__ int perm32(int rho) { const int n = rho >> 4, i = rho & 15; return 8 * (i >> 2) + 4 * n + (i & 3); }

struct Unit { int pm, pn; };
struct Gemm { const bf16_t* A; const bf16_t* Bt; int M, N, K, lda; };

struct StaticOrder {
    int nM, nN, nwg, G, c;
    __host__ __device__ void init(int M, int N, int G_, int c_) { nM = M / BM; nN = N / BM; nwg = nM * nN; G = G_; c = c_; }
    __host__ __device__ bool next(int i, Unit& u) const {
        const long L = (long)i * G + c; if (L >= nwg) return false;
        int wgid = (int)L; { const int q = nwg / NXCD, r = nwg % NXCD, xcd = wgid % NXCD, off = wgid / NXCD; wgid = (xcd < r ? xcd * (q + 1) : r * (q + 1) + (xcd - r) * q) + off; }
        const int nig = WGM * nN, gid = wgid / nig, fm = gid * WGM, gsz = (nM - fm) < WGM ? (nM - fm) : WGM;
        u.pm = fm + ((wgid % nig) % gsz); u.pn = (wgid % nig) / gsz; return true;
    }
    __device__ __forceinline__ void a_ready(const Unit&) const {}
    __device__ __forceinline__ void done(const Unit&) const {}
};

__device__ __forceinline__ unsigned cvt_pk_bf16(float lo, float hi) { unsigned r; asm volatile("v_cvt_pk_bf16_f32 %0, %1, %2" : "=v"(r) : "v"(lo), "v"(hi)); return r; }
typedef float f32x2 __attribute__((ext_vector_type(2)));
constexpr int YP_ = 4392;
constexpr float C2_ = 0.125f * 1.4426950408889634f;
__device__ __forceinline__ float sigmoidf_(float v) { return 1.f / (1.f + __expf(-v)); }
struct EpiInProj {
    static constexpr bool PERM = true, AFTER_DRAIN = false;
    bf16_t* Y; unsigned char* G8;
    __device__ __forceinline__ void operator()(const f32x4 (&acc)[2][2][4][2], const Unit& u, int wr, int wc, int fr, int fq) const {
        const int row0 = u.pm * BM + wr * 64 + fr, colt = u.pn * BM, cin = wc * 32 + 8 * fq;
        if (u.pn < 18) {
            float sc = 1.f; if (u.pn < 2 || u.pn == 5 || u.pn == 6) sc = C2_; else if (u.pn == 11) sc = 0.125f;
#pragma unroll
            for (int ai = 0; ai < 2; ++ai)
#pragma unroll
                for (int m = 0; m < 4; ++m) { bf16_t* rowp = Y + (size_t)(row0 + ai * HALF + m * 16) * YP_;
#pragma unroll
                    for (int bj = 0; bj < 2; ++bj) { const int col = colt + cin + bj * HALF;
                        if (col + 8 <= YP_) { const f32x4 v0 = acc[ai][bj][m][0] * sc, v1 = acc[ai][bj][m][1] * sc; u32x4 w;
                            w.x = cvt_pk_bf16(v0[0], v0[1]); w.y = cvt_pk_bf16(v0[2], v0[3]); w.z = cvt_pk_bf16(v1[0], v1[1]); w.w = cvt_pk_bf16(v1[2], v1[3]);
                            *(u32x4*)(rowp + col) = w; } } }
        } else {
#pragma unroll
            for (int ai = 0; ai < 2; ++ai)
#pragma unroll
                for (int m = 0; m < 4; ++m) { unsigned char* rowp = G8 + (size_t)(row0 + ai * HALF + m * 16) * 3072 + (colt - 4608) + cin;
#pragma unroll
                    for (int bj = 0; bj < 2; ++bj) { const f32x4 v0 = acc[ai][bj][m][0], v1 = acc[ai][bj][m][1]; unsigned lo = 0u, hi = 0u;
#pragma unroll
                        for (int e = 0; e < 4; ++e) { lo |= (unsigned)(sigmoidf_(v0[e]) * 255.f + 0.5f) << (8 * e); hi |= (unsigned)(sigmoidf_(v1[e]) * 255.f + 0.5f) << (8 * e); }
                        typedef unsigned u32x2 __attribute__((ext_vector_type(2))); u32x2 w; w.x = lo; w.y = hi; *(u32x2*)(rowp + bj * HALF) = w; } }
        }
    }
};
template <int I> struct EpiMerge {
    static constexpr bool PERM = true, AFTER_DRAIN = false;
    bf16_t* Mg; const unsigned char* G8;
    __device__ __forceinline__ void operator()(const f32x4 (&acc)[2][2][4][2], const Unit& u, int wr, int wc, int fr, int fq) const {
        const int row0 = u.pm * BM + wr * 64 + fr, col0 = u.pn * BM + wc * 32 + 8 * fq;
#pragma unroll
        for (int ai = 0; ai < 2; ++ai)
#pragma unroll
            for (int m = 0; m < 4; ++m) { const size_t row = (size_t)(row0 + ai * HALF + m * 16);
#pragma unroll
                for (int bj = 0; bj < 2; ++bj) { const int col = col0 + bj * HALF;
                    typedef unsigned u32x2 __attribute__((ext_vector_type(2)));
                    const u32x2 gw = *(const u32x2*)(G8 + row * 3072 + I * 1024 + col);
                    float v[8];
#pragma unroll
                    for (int e = 0; e < 4; ++e) { v[e] = acc[ai][bj][m][0][e] * ((float)((gw.x >> (8 * e)) & 255u) * (1.f / 255.f)); v[4 + e] = acc[ai][bj][m][1][e] * ((float)((gw.y >> (8 * e)) & 255u) * (1.f / 255.f)); }
                    bf16_t* p = Mg + row * 1024 + col;
                    if (I > 0) { const u32x4 o = *(const u32x4*)p;
                        v[0] += __uint_as_float(o.x << 16); v[1] += __uint_as_float(o.x & 0xffff0000u); v[2] += __uint_as_float(o.y << 16); v[3] += __uint_as_float(o.y & 0xffff0000u);
                        v[4] += __uint_as_float(o.z << 16); v[5] += __uint_as_float(o.z & 0xffff0000u); v[6] += __uint_as_float(o.w << 16); v[7] += __uint_as_float(o.w & 0xffff0000u); }
                    u32x4 w; w.x = cvt_pk_bf16(v[0], v[1]); w.y = cvt_pk_bf16(v[2], v[3]); w.z = cvt_pk_bf16(v[4], v[5]); w.w = cvt_pk_bf16(v[6], v[7]);
                    *(u32x4*)p = w; } }
    }
};
struct EpiF32 {
    static constexpr bool PERM = true, AFTER_DRAIN = false;
    float* O; int ldc;
    __device__ __forceinline__ void operator()(const f32x4 (&acc)[2][2][4][2], const Unit& u, int wr, int wc, int fr, int fq) const {
        const int row0 = u.pm * BM + wr * 64 + fr, col0 = u.pn * BM + wc * 32 + 8 * fq;
#pragma unroll
        for (int ai = 0; ai < 2; ++ai)
#pragma unroll
            for (int m = 0; m < 4; ++m) { float* rowp = O + (size_t)(row0 + ai * HALF + m * 16) * ldc + col0;
#pragma unroll
                for (int bj = 0; bj < 2; ++bj) { *(f32x4*)(rowp + bj * HALF) = acc[ai][bj][m][0]; *(f32x4*)(rowp + bj * HALF + 4) = acc[ai][bj][m][1]; } }
    }
};
struct EpiSwiglu {
    static constexpr bool PERM = true, AFTER_DRAIN = false;
    bf16_t* Act; int ldc;
    __device__ __forceinline__ void operator()(const f32x4 (&acc)[2][2][4][2], const Unit& u, int wr, int wc, int fr, int fq) const {
        const int row0 = u.pm * BM + wr * 64 + fr, col0 = u.pn * HALF + wc * 32 + 8 * fq;
#pragma unroll
        for (int ai = 0; ai < 2; ++ai)
#pragma unroll
            for (int m = 0; m < 4; ++m) { bf16_t* p = Act + (size_t)(row0 + ai * HALF + m * 16) * ldc + col0; float v[8];
#pragma unroll
                for (int e = 0; e < 4; ++e) { const float g0 = acc[ai][0][m][0][e], g1 = acc[ai][0][m][1][e];
                    v[e] = g0 * sigmoidf_(g0) * acc[ai][1][m][0][e]; v[4 + e] = g1 * sigmoidf_(g1) * acc[ai][1][m][1][e]; }
                u32x4 w; w.x = cvt_pk_bf16(v[0], v[1]); w.y = cvt_pk_bf16(v[2], v[3]); w.z = cvt_pk_bf16(v[4], v[5]); w.w = cvt_pk_bf16(v[6], v[7]);
                *(u32x4*)p = w; }
    }
};
template <class Epi, class Sched, bool ALIGN_EPI = false, bool SP2 = false>
__device__ __forceinline__ void gemm_phase(PG8_LAS unsigned char* lds, const Gemm g, const Sched& S, const Epi& E) {
    int tid_l = threadIdx.x; asm volatile("" : "+v"(tid_l));
    const int tid = tid_l, wid = __builtin_amdgcn_readfirstlane(tid >> 6), lane = tid & 63, wr = wid >> 2, wc = wid & 3, fr = lane & 15, fq = lane >> 4;
    const int K = g.K, nt = K / BK;
    unsigned voffA[2], voffB[2];
#pragma unroll
    for (int i = 0; i < 2; ++i) { int R, C; stage_rc(tid * 16 + i * 8192, R, C); const int Rb = Epi::PERM ? ((R & ~31) + perm32(R & 31)) : R;
        voffA[i] = (unsigned)(R * g.lda + C) * 2u; voffB[i] = (unsigned)(Rb * K + C) * 2u; }
    const size_t kstep = (size_t)(BK * 2);
    const size_t hstepB = (size_t)HALF * K * 2, hstepA = (size_t)HALF * g.lda * 2;
    const size_t tstepA = 2 * hstepA, tstepB = 2 * hstepB;
    const unsigned ldsw = (unsigned)wid * 1024u;
    const int aoff = lds_byte(wr * 64 + fr, fq * 8), boff = lds_byte(wc * 32 + fr, fq * 8);
#define PG8_SA(b, h) (((b) * 2 + (h)) * HTB)
#define PG8_SB(b, h) ((4 + (b) * 2 + (h)) * HTB)
#define PG8_STAGE(bufoff, gbase, voff) do { _Pragma("unroll") for (int _i = 0; _i < 2; ++_i) \
        __builtin_amdgcn_global_load_lds((const unsigned*)((const char*)(gbase) + (voff)[_i]), (PG8_LAS unsigned*)(lds + (bufoff) + ldsw + _i * 8192), 16, 0, 0); } while (0)
#define PG8_LDA(dst, b, h) do { _Pragma("unroll") for (int m = 0; m < 4; ++m) _Pragma("unroll") for (int k = 0; k < 2; ++k) dst[m][k] = *(const PG8_LAS bf16x8*)(lds + PG8_SA(b, h) + aoff + m * 2048 + k * 1024); } while (0)
#define PG8_LDB(dst, b, h) do { _Pragma("unroll") for (int n = 0; n < 2; ++n) _Pragma("unroll") for (int k = 0; k < 2; ++k) dst[n][k] = *(const PG8_LAS bf16x8*)(lds + PG8_SB(b, h) + boff + n * 2048 + k * 1024); } while (0)
#define PG8_MMA(ai, bj, At, Bt) do { __builtin_amdgcn_s_setprio(1); _Pragma("unroll") for (int m = 0; m < 4; ++m) _Pragma("unroll") for (int n = 0; n < 2; ++n) _Pragma("unroll") for (int k = 0; k < 2; ++k) \
        acc[ai][bj][m][n] = __builtin_amdgcn_mfma_f32_16x16x32_bf16(Bt[n][k], At[m][k], acc[ai][bj][m][n], 0, 0, 0); __builtin_amdgcn_s_setprio(0); } while (0)
#define PG8_WAIT_V(n) asm volatile("s_waitcnt vmcnt(" #n ")" ::: "memory")
#define PG8_WAIT_L(n) asm volatile("s_waitcnt lgkmcnt(" #n ")" ::: "memory")
#define PG8_BAR __builtin_amdgcn_s_barrier()
#define PG8_SCHED __builtin_amdgcn_sched_barrier(0)
    Unit cur, nxt; int ui = 0;
    if (!S.next(0, cur)) return;
    f32x4 acc[2][2][4][2];
#pragma unroll
    for (int a = 0; a < 2; ++a)
#pragma unroll
        for (int b = 0; b < 2; ++b)
#pragma unroll
            for (int m = 0; m < 4; ++m)
#pragma unroll
                for (int n = 0; n < 2; ++n) acc[a][b][m][n] = (f32x4){0.f, 0.f, 0.f, 0.f};
    bf16x8 At[4][2], B0[2][2], B1[2][2];
    const char* cA = (const char*)g.A + (size_t)cur.pm * tstepA; const char* cB = (const char*)g.Bt + (size_t)cur.pn * tstepB;
    S.a_ready(cur);
    if constexpr (SP2) {
        PG8_STAGE(PG8_SB(0, 0), cB, voffB); PG8_STAGE(PG8_SB(0, 1), cB + hstepB, voffB); PG8_STAGE(PG8_SA(0, 0), cA, voffA); PG8_STAGE(PG8_SA(0, 1), cA + hstepA, voffA);
        if (wr == 1) PG8_BAR;
        PG8_WAIT_V(2); PG8_BAR;
        PG8_STAGE(PG8_SB(1, 0), cB + kstep, voffB); PG8_STAGE(PG8_SA(1, 0), cA + kstep, voffA); PG8_STAGE(PG8_SB(1, 1), cB + hstepB + kstep, voffB);
        PG8_WAIT_V(6); PG8_BAR;
    } else {
        PG8_STAGE(PG8_SB(0, 0), cB, voffB); PG8_STAGE(PG8_SA(0, 0), cA, voffA); PG8_STAGE(PG8_SB(0, 1), cB + hstepB, voffB); PG8_STAGE(PG8_SA(0, 1), cA + hstepA, voffA);
        if (wr == 1) PG8_BAR;
        PG8_WAIT_V(4); PG8_BAR;
        PG8_STAGE(PG8_SB(1, 0), cB + kstep, voffB); PG8_STAGE(PG8_SA(1, 0), cA + kstep, voffA); PG8_STAGE(PG8_SB(1, 1), cB + hstepB + kstep, voffB);
        PG8_WAIT_V(6); PG8_BAR;
    }
    for (;;) {
        const bool has_next = S.next(ui + 1, nxt);
        const char* nA = has_next ? (const char*)g.A + (size_t)nxt.pm * tstepA : cA; const char* nB = has_next ? (const char*)g.Bt + (size_t)nxt.pn * tstepB : cB;
        for (int t = 0; t < nt; t += 2) {
            const bool last = (t == nt - 2);
            const char* a1 = cA + (size_t)(t + 1) * kstep;
            const char* a2 = last ? nA : cA + (size_t)(t + 2) * kstep; const char* b2 = last ? nB : cB + (size_t)(t + 2) * kstep;
            const char* a3 = a2 + kstep; const char* b3 = b2 + kstep;
            if (last && has_next) S.a_ready(nxt);
            if constexpr (SP2) {
            PG8_LDB(B0, 0, 0); PG8_LDB(B1, 0, 1); PG8_SCHED; PG8_LDA(At, 0, 0); PG8_STAGE(PG8_SA(1, 1), a1 + hstepA, voffA);
            PG8_WAIT_V(8); PG8_WAIT_L(0); PG8_BAR; PG8_MMA(0, 0, At, B0); PG8_MMA(0, 1, At, B1); PG8_BAR; PG8_SCHED;
            PG8_LDA(At, 0, 1); PG8_STAGE(PG8_SB(0, 0), b2, voffB); PG8_STAGE(PG8_SB(0, 1), b2 + hstepB, voffB); PG8_STAGE(PG8_SA(0, 0), a2, voffA);
            PG8_WAIT_V(8); PG8_WAIT_L(0); PG8_BAR; PG8_MMA(1, 0, At, B0); PG8_MMA(1, 1, At, B1); PG8_BAR; PG8_SCHED;
            PG8_LDB(B0, 1, 0); PG8_LDB(B1, 1, 1); PG8_SCHED; PG8_LDA(At, 1, 0); PG8_STAGE(PG8_SA(0, 1), a2 + hstepA, voffA);
            PG8_WAIT_V(8); PG8_WAIT_L(0); PG8_BAR; PG8_MMA(0, 0, At, B0); PG8_MMA(0, 1, At, B1); PG8_BAR; PG8_SCHED;
            PG8_LDA(At, 1, 1); PG8_STAGE(PG8_SB(1, 0), b3, voffB); PG8_STAGE(PG8_SB(1, 1), b3 + hstepB, voffB); PG8_STAGE(PG8_SA(1, 0), a3, voffA);
            PG8_WAIT_V(8); PG8_WAIT_L(0); PG8_BAR; PG8_MMA(1, 0, At, B0); PG8_MMA(1, 1, At, B1); PG8_BAR; PG8_SCHED;
            } else {
            PG8_LDB(B0, 0, 0); PG8_SCHED; PG8_LDA(At, 0, 0); PG8_STAGE(PG8_SA(1, 1), a1 + hstepA, voffA);
            PG8_WAIT_L(8); PG8_BAR; PG8_WAIT_L(0); PG8_MMA(0, 0, At, B0); PG8_BAR; PG8_SCHED;
            PG8_LDB(B1, 0, 1); PG8_STAGE(PG8_SB(0, 0), b2, voffB);
            PG8_BAR; PG8_WAIT_L(0); PG8_MMA(0, 1, At, B1); PG8_BAR;
            PG8_LDA(At, 0, 1); PG8_STAGE(PG8_SA(0, 0), a2, voffA);
            PG8_BAR; PG8_WAIT_L(0); PG8_MMA(1, 0, At, B0); PG8_BAR; PG8_SCHED;
            PG8_STAGE(PG8_SB(0, 1), b2 + hstepB, voffB);
            PG8_WAIT_V(6); PG8_BAR; PG8_MMA(1, 1, At, B1); PG8_BAR;
            PG8_LDB(B0, 1, 0); PG8_SCHED; PG8_LDA(At, 1, 0); PG8_STAGE(PG8_SA(0, 1), a2 + hstepA, voffA);
            PG8_WAIT_L(8); PG8_BAR; PG8_WAIT_L(0); PG8_MMA(0, 0, At, B0); PG8_BAR; PG8_SCHED;
            PG8_LDB(B1, 1, 1); PG8_STAGE(PG8_SB(1, 0), b3, voffB);
            PG8_BAR; PG8_WAIT_L(0); PG8_MMA(0, 1, At, B1); PG8_BAR;
            PG8_LDA(At, 1, 1); PG8_STAGE(PG8_SA(1, 0), a3, voffA);
            PG8_BAR; PG8_WAIT_L(0); PG8_MMA(1, 0, At, B0); PG8_BAR; PG8_SCHED;
            PG8_STAGE(PG8_SB(1, 1), b3 + hstepB, voffB);
            PG8_WAIT_V(6); PG8_BAR; PG8_MMA(1, 1, At, B1); PG8_BAR;
            }
        }
        if constexpr (ALIGN_EPI) { if (wr == 0) PG8_BAR; }
        if constexpr (!Epi::AFTER_DRAIN) { E(acc, cur, wr, wc, fr, fq); S.done(cur); }
        if (!has_next) break;
#pragma unroll
        for (int a = 0; a < 2; ++a)
#pragma unroll
            for (int b = 0; b < 2; ++b)
#pragma unroll
                for (int m = 0; m < 4; ++m)
#pragma unroll
                    for (int n = 0; n < 2; ++n) acc[a][b][m][n] = (f32x4){0.f, 0.f, 0.f, 0.f};
        cur = nxt; cA = nA; cB = nB; ++ui;
        if constexpr (ALIGN_EPI) { if (wr == 1) PG8_BAR; }
    }
    PG8_WAIT_V(0);
    if constexpr (!ALIGN_EPI) { if (wr == 0) PG8_BAR; }
    PG8_BAR;
    if constexpr (Epi::AFTER_DRAIN) { E.fused(acc, cur, wr, wc, fr, fq, lds, wid, lane); S.done(cur); }
#undef PG8_SA
#undef PG8_SB
#undef PG8_STAGE
#undef PG8_LDA
#undef PG8_LDB
#undef PG8_MMA
#undef PG8_WAIT_V
#undef PG8_WAIT_L
#undef PG8_BAR
#undef PG8_SCHED
}
}
namespace attn {
using bf16=unsigned short;
using bf16x8=__attribute__((ext_vector_type(8)))short;
using s16x4=__attribute__((ext_vector_type(4)))short;
using f32x16=__attribute__((ext_vector_type(16)))float;
using u32x4=__attribute__((ext_vector_type(4)))unsigned;
constexpr int D=64, PITCH=4392, SEQ=8192;
constexpr int NW=8,QBLK=32,QB=QBLK*NW,KVBLK=64;
__device__ __forceinline__ int crow(int r,int hi){return (r&3)+8*(r>>2)+4*hi;}
#define SBAR() __builtin_amdgcn_sched_barrier(0)
using f32x4_=__attribute__((ext_vector_type(4)))float;
__device__ __forceinline__ float bfs(short v){ return __uint_as_float(((unsigned)(unsigned short)v)<<16); }
__device__ __forceinline__ float lo16(unsigned w){ return __uint_as_float(w<<16); }
__device__ __forceinline__ float hi16(unsigned w){ return __uint_as_float(w&0xffff0000u); }
__device__ __forceinline__ bf16 f2b(float f){ unsigned u=__float_as_uint(f); return (bf16)((u+0x7fffu+((u>>16)&1u))>>16); }
__device__ __forceinline__ unsigned pk2b(float lo,float hi){ return (unsigned)f2b(lo)|((unsigned)f2b(hi)<<16); }
constexpr int NSLOT=3, SLOTB=8192;
constexpr int LDS_K=0, LDS_V=NSLOT*SLOTB, LDS_WS=2*NSLOT*SLOTB, LDS_OST=LDS_WS+NW*128*4, LDS_BIAS=LDS_OST+NW*4096, LDS_MSK=LDS_BIAS+512, LDS_KM=LDS_MSK+NW*512, LDS_BYTES=LDS_KM+8192;
constexpr float LOG2E_=1.4426950408889634f;
__device__ __forceinline__ void glds16(const void*gsrc,unsigned lds_dst){unsigned keep;
  asm volatile("s_mov_b32 %0, m0\n\ts_mov_b32 m0, %2\n\ts_nop 0\n\tglobal_load_lds_dwordx4 %1, off\n\ts_mov_b32 m0, %0":"=&s"(keep):"v"(gsrc),"s"(lds_dst):"memory");}
__device__ __forceinline__ float max3f(float a,float b,float c){float r;asm("v_max3_f32 %0, %1, %2, %3":"=v"(r):"v"(a),"v"(b),"v"(c));return r;}
__device__ __forceinline__ float max2f(float a,float b){float r;asm("v_max_f32_e32 %0, %1, %2":"=v"(r):"v"(a),"v"(b));return r;}
__device__ __forceinline__ float fadd_s(float a,float b){float r;asm("v_add_f32_e32 %0, %1, %2":"=v"(r):"v"(a),"v"(b));return r;}
__device__ __forceinline__ float fsub_s(float a,float b){float r;asm("v_sub_f32_e32 %0, %1, %2":"=v"(r):"v"(a),"v"(b));return r;}
typedef float f32x2_t __attribute__((ext_vector_type(2))); typedef __bf16 bf16x2_t __attribute__((ext_vector_type(2)));
__device__ __forceinline__ unsigned cvtpk_s(float lo,float hi){f32x2_t v={lo,hi};bf16x2_t b=__builtin_convertvector(v,bf16x2_t);return __builtin_bit_cast(unsigned,b);}
#define WAIT_BAR(N) asm volatile("s_waitcnt vmcnt(" #N ") lgkmcnt(0)\n\ts_barrier":::"memory")

__device__ __forceinline__ void qkt(f32x16&p0,f32x16&p1,const char*Kslot,const bf16x8*qr,const f32x16&negm,int r32,int hi){
  const char*kb=Kslot+hi*1024+r32*16;
  #pragma unroll
  for(int d0=0;d0<4;++d0){
    const bf16x8 b0=*reinterpret_cast<const bf16x8*>(kb+d0*2048);
    const bf16x8 b1=*reinterpret_cast<const bf16x8*>(kb+d0*2048+512);
    if(d0==0){p0=__builtin_amdgcn_mfma_f32_32x32x16_bf16(b0,qr[0],negm,0,0,0);p1=__builtin_amdgcn_mfma_f32_32x32x16_bf16(b1,qr[0],negm,0,0,0);}
    else{p0=__builtin_amdgcn_mfma_f32_32x32x16_bf16(b0,qr[d0],p0,0,0,0);p1=__builtin_amdgcn_mfma_f32_32x32x16_bf16(b1,qr[d0],p1,0,0,0);}}
}
typedef __attribute__((address_space(3))) const char* lds_cptr;
typedef short v4i16_t __attribute__((ext_vector_type(4)));
__device__ __forceinline__ void kload8(bf16x8*kf,lds_cptr kp){
  kf[0]=*(const __attribute__((address_space(3))) bf16x8*)(kp);      kf[1]=*(const __attribute__((address_space(3))) bf16x8*)(kp+512);
  kf[2]=*(const __attribute__((address_space(3))) bf16x8*)(kp+2048); kf[3]=*(const __attribute__((address_space(3))) bf16x8*)(kp+2560);
  kf[4]=*(const __attribute__((address_space(3))) bf16x8*)(kp+4096); kf[5]=*(const __attribute__((address_space(3))) bf16x8*)(kp+4608);
  kf[6]=*(const __attribute__((address_space(3))) bf16x8*)(kp+6144); kf[7]=*(const __attribute__((address_space(3))) bf16x8*)(kp+6656);
}
__device__ __forceinline__ void kload2(bf16x8*kf,lds_cptr kp,int j){ kf[2*j]=*(const __attribute__((address_space(3))) bf16x8*)(kp+j*2048); kf[2*j+1]=*(const __attribute__((address_space(3))) bf16x8*)(kp+j*2048+512); }
__device__ __forceinline__ s16x4 vtr(lds_cptr p){ return __builtin_bit_cast(s16x4,__builtin_amdgcn_ds_read_tr16_b64_v4i16((__attribute__((address_space(3))) v4i16_t*)p)); }
__device__ __forceinline__ float rowmax(const f32x16&p0,const f32x16&p1){
  float a=max3f(p0[0],p0[1],p1[0]),b=max3f(p0[2],p0[3],p1[1]);a=max3f(a,p1[2],p1[3]);
  #pragma unroll
  for(int r=4;r<16;r+=4){a=max3f(a,p0[r],p0[r+1]);b=max3f(b,p0[r+2],p0[r+3]);a=max3f(a,p1[r],p1[r+1]);b=max3f(b,p1[r+2],p1[r+3]);}
  const float m=max2f(a,b);
  auto rr=__builtin_amdgcn_permlane32_swap(__float_as_uint(m),__float_as_uint(m),false,false);
  return max2f(__uint_as_float(rr[0]),__uint_as_float(rr[1]));
}
__device__ __forceinline__ void pv(f32x16*o,int vb,bf16x8 pa0,bf16x8 pa1,bf16x8 pa2,bf16x8 pa3){
  #pragma unroll
  for(int d0=0;d0<2;++d0){s16x4 lo[4],hi[4];
    #pragma unroll
    for(int ks=0;ks<4;++ks){
      asm volatile("ds_read_b64_tr_b16 %0,%1 offset:%c2":"=&v"(lo[ks]):"v"(vb),"i"(d0*4096+ks*1024):"memory");
      asm volatile("ds_read_b64_tr_b16 %0,%1 offset:%c2":"=&v"(hi[ks]):"v"(vb),"i"(d0*4096+ks*1024+512):"memory");}
    asm volatile("s_waitcnt lgkmcnt(0)":::"memory");SBAR();
    #define PK(k) (bf16x8){lo[k][0],lo[k][1],lo[k][2],lo[k][3],hi[k][0],hi[k][1],hi[k][2],hi[k][3]}
    o[d0]=__builtin_amdgcn_mfma_f32_32x32x16_bf16(pa0,PK(0),o[d0],0,0,0);
    o[d0]=__builtin_amdgcn_mfma_f32_32x32x16_bf16(pa1,PK(1),o[d0],0,0,0);
    o[d0]=__builtin_amdgcn_mfma_f32_32x32x16_bf16(pa2,PK(2),o[d0],0,0,0);
    o[d0]=__builtin_amdgcn_mfma_f32_32x32x16_bf16(pa3,PK(3),o[d0],0,0,0);
    #undef PK
  }
}

#ifndef ATTN_STORE16
#define ATTN_STORE16(p,v) (*(u32x4*)(p)=(v))
#endif
struct UArgs {
  const bf16* Qb; const bf16* Kh; const bf16* Vh; bf16* Ob;
  int NT, q0, kt0, hc;
  const float* rel;
  const float* km; int qb;
  const unsigned* selg;
  const bf16* gate; int gcol;
  const bf16* tmp;
};
__device__ __forceinline__ int t5b(int d){ if(d<16)return d<0?0:d; int b=16; b+=(d>=19);b+=(d>=21);b+=(d>=24);b+=(d>=27);b+=(d>=31);b+=(d>=35);b+=(d>=40);b+=(d>=46);b+=(d>=52);b+=(d>=59);b+=(d>=67);b+=(d>=77);b+=(d>=87);b+=(d>=99);b+=(d>=113); return b; }
template<int MODE,int EPI,int THRL> __device__ __forceinline__ void attn_unit(const UArgs&U,char*shm){
  int tid_l=threadIdx.x; asm volatile("":"+v"(tid_l));
  const int tid=tid_l,lane=tid&63,r32=lane&31,hi=lane>>5; const int wid=__builtin_amdgcn_readfirstlane(tid>>6);
  const bf16*Qw=U.Qb+(long)(wid*QBLK)*PITCH;
  const bf16*Kh=U.Kh,*Vh=U.Vh;
  const unsigned lds0=(unsigned)(uintptr_t)shm;
  float*wsf=(float*)(shm+LDS_WS)+wid*128;
  const bf16*ksrc=Kh+(long)lane*PITCH+wid*8;
  const bf16*vsrc=Vh+(long)(16*(wid&3)+(lane>>2))*PITCH+(wid>>2)*32+(lane&3)*8;
  const unsigned kdst=lds0+LDS_K+wid*1024, vdst=lds0+LDS_V+wid*1024;
  #define DMA_K(t,slot) glds16(ksrc+(long)(t)*KVBLK*PITCH,(unsigned)__builtin_amdgcn_readfirstlane(kdst+(slot)))
  #define DMA_V(t,slot) glds16(vsrc+(long)(t)*KVBLK*PITCH,(unsigned)__builtin_amdgcn_readfirstlane(vdst+(slot)))
  const int vb0=(int)(lds0+LDS_V)+((lane>>4)&1)*32+(lane&3)*8+(4*hi+((lane&15)>>2))*64;
  const char*Kbase=shm+LDS_K; bf16x8 kf[8];
  const lds_cptr shm3=(lds_cptr)shm; const lds_cptr kp0=shm3+LDS_K+hi*1024+r32*16; const lds_cptr vp0=shm3+LDS_V+((lane>>4)&1)*32+(lane&3)*8+(4*hi+((lane&15)>>2))*64;
  const int NT=U.NT;
  const int qpos=U.q0+wid*QBLK+r32;
  float*biasT=(float*)(shm+LDS_BIAS);
  if(tid<128) biasT[tid]=(U.rel[t5b(tid)*16+U.hc]-U.rel[31*16+U.hc])*LOG2E_;
  unsigned selw=0u,cw=0u; const unsigned*mskp=(const unsigned*)(shm+LDS_MSK)+wid*128+r32*4;
  if(MODE==0){ ((u32x4*)(shm+LDS_KM))[tid]=((const u32x4*)U.km)[tid]; }
  if(MODE==1){ if(hi==0){ const u32x4 w=*(const u32x4*)(U.selg+(long)(wid*QBLK+r32)*4); *(u32x4*)((unsigned*)(shm+LDS_MSK)+wid*128+r32*4)=w; } }
  asm volatile("s_waitcnt vmcnt(0) lgkmcnt(0)\n\ts_barrier":::"memory");
  bf16x8 qr[4];
  #pragma unroll
  for(int d0=0;d0<4;++d0)qr[d0]=*reinterpret_cast<const bf16x8*>(&Qw[(long)r32*PITCH+d0*16+hi*8]);
  if(MODE==0){
    float v1=-INFINITY,v2=-INFINITY,v3=-INFINITY; int i1=-1,i2=-1,i3=-1;
    for(int n=0;n<U.qb;++n){ const float*km=(const float*)(shm+LDS_KM)+n*64+hi*8; float p=0.f;
      #pragma unroll
      for(int d0=0;d0<4;++d0){ const f32x4_ a=*(const f32x4_*)(km+d0*16), c=*(const f32x4_*)(km+d0*16+4);
        p+=bfs(qr[d0][0])*a[0]+bfs(qr[d0][1])*a[1]+bfs(qr[d0][2])*a[2]+bfs(qr[d0][3])*a[3]+bfs(qr[d0][4])*c[0]+bfs(qr[d0][5])*c[1]+bfs(qr[d0][6])*c[2]+bfs(qr[d0][7])*c[3]; }
      auto rr=__builtin_amdgcn_permlane32_swap(__float_as_uint(p),__float_as_uint(p),false,false); const float sc_=__uint_as_float(rr[0])+__uint_as_float(rr[1]);
      if(sc_>v1){v3=v2;i3=i2;v2=v1;i2=i1;v1=sc_;i1=n;} else if(sc_>v2){v3=v2;i3=i2;v2=sc_;i2=n;} else if(sc_>v3){v3=sc_;i3=n;} }
    if(i1>=0)selw|=1u<<i1; if(i2>=0)selw|=1u<<i2; if(i3>=0)selw|=1u<<i3; selw|=1u<<U.qb; }
  DMA_K(0,0);DMA_V(0,0);DMA_K(1,SLOTB);
  float mhat=0.f,l_reg=0.f;f32x16 o[2];o[0]=f32x16{};o[1]=f32x16{};f32x16 negm=f32x16{};asm volatile("":"+v"(negm));
  #define MASK_FAR(P0,P1,t) do{ bool on_=true; if(MODE==0)on_=((selw>>((t)>>2))&1u)!=0u; if(MODE==1){ if(((t)&31)==0)cw=mskp[(t)>>5]; on_=((cw>>((t)&31))&1u)!=0u; } \
      _Pragma("unroll") for(int r=0;r<16;++r){ P0[r]=on_?P0[r]:-INFINITY; P1[r]=on_?P1[r]:-INFINITY; } }while(0)
  #define MASK_BAND(P0,P1,t) do{ bool on_=true; if(MODE==0)on_=((selw>>((t)>>2))&1u)!=0u; if(MODE==1){ if(((t)&31)==0)cw=mskp[(t)>>5]; on_=((cw>>((t)&31))&1u)!=0u; } \
      const int kb_=U.kt0+64*(t), qw_=U.q0+wid*QBLK; \
      if((qw_-(kb_+63))<128||(MODE==2&&(qw_+31-kb_)>=512)){            \
      const int d0_=qpos-(kb_+4*hi); \
      _Pragma("unroll") for(int r=0;r<16;++r){ const int da_=d0_-((r&3)+8*(r>>2)), db_=da_-32; \
        const bool oka_=on_&&da_>=0&&(MODE!=2||da_<512), okb_=on_&&db_>=0&&(MODE!=2||db_<512); \
        const float ba_=biasT[da_<0?0:(da_>127?127:da_)], bb_=biasT[db_<0?0:(db_>127?127:db_)]; \
        P0[r]=oka_?P0[r]+ba_:-INFINITY; P1[r]=okb_?P1[r]+bb_:-INFINITY; \
        if((r&1)==1){ asm volatile("s_waitcnt lgkmcnt(0)":"+v"(P0),"+v"(P1)::"memory"); } } \
      } else if(MODE!=2){ _Pragma("unroll") for(int r=0;r<16;++r){ P0[r]=on_?P0[r]:-INFINITY; P1[r]=on_?P1[r]:-INFINITY; } } }while(0)
  #define CMASK(P0,P1,t) MASK_BAND(P0,P1,t)
  bool resc=false;
  #define START(P0,P1) do{ const float rm=rowmax(P0,P1); resc=false; \
    { const float dl=rm>-1e30f?rm:0.f; mhat=fadd_s(mhat,dl); \
      _Pragma("unroll") for(int r=0;r<16;++r){P0[r]=fsub_s(P0[r],dl);P1[r]=fsub_s(P1[r],dl);} \
      _Pragma("unroll") for(int r=0;r<16;++r)negm[r]=-mhat; asm volatile("":"+v"(negm)); } \
    _Pragma("unroll") for(int r=0;r<16;++r)P0[r]=__builtin_amdgcn_exp2f(P0[r]); }while(0)
  #define RESC() do{ if(resc){ asm volatile("s_waitcnt lgkmcnt(0)":::"memory"); \
      _Pragma("unroll") for(int d_=0;d_<2;++d_) _Pragma("unroll") for(int r=0;r<16;++r)o[d_][r]*=wsf[crow(r,hi)]; } }while(0)
  f32x16 pA0,pA1,pB0,pB1;
  int sl_prev=0,sl_cur=0,sl_next=SLOTB;
  #define ROT() do{sl_prev=sl_cur;sl_cur=sl_next;sl_next=(sl_next==(NSLOT-1)*SLOTB)?0:sl_next+SLOTB;}while(0)
  DMA_K(2,2*SLOTB);
  WAIT_BAR(3);
  qkt(pA0,pA1,Kbase,qr,negm,r32,hi);asm volatile("s_nop 15\n\ts_nop 7":"+v"(pA0),"+v"(pA1));CMASK(pA0,pA1,0);
  START(pA0,pA1);
  _Pragma("unroll") for(int r=0;r<16;++r)pA1[r]=__builtin_amdgcn_exp2f(pA1[r]);
  WAIT_BAR(0);
  DMA_K(3,0);DMA_V(1,SLOTB);
  ROT();
  kload8(kf,kp0+sl_cur);
  WAIT_BAR(2);
  s16x4 vlo[8],vhi[8]; u32x4 pw0,pw1,pw2,pw3;
  #define PKW(P,B) cvtpk_s(P[B],P[B+1])
  #define PAF(k) __builtin_bit_cast(bf16x8,pw##k)
  #define VFR(i) (bf16x8){vlo[i][0],vlo[i][1],vlo[i][2],vlo[i][3],vhi[i][0],vhi[i][1],vhi[i][2],vhi[i][3]}
  #define PIN(x) asm volatile("":"+v"(x))
  #define MX3(a,b,c) __builtin_fmaxf(__builtin_fmaxf((a),(b)),(c))
  #define GAPA(MF,A0,A1,A2,A3,W0,W1,PW) do{ MF; sacc+=A0; sacc+=A1; sacc+=A2; sacc+=A3; PIN(sacc); W0; W1; PIN(PW); SBAR(); }while(0)
  #define EX(v) __builtin_amdgcn_exp2f(v)
  #define GAPB(MF,X,B) do{ MF; X[B]=EX(X[B]); X[B+1]=EX(X[B+1]); X[B+2]=EX(X[B+2]); X[B+3]=EX(X[B+3]); PIN(X); SBAR(); }while(0)
  #define VRD(i) do{ vlo[i]=vtr(vp_+(((i)>>2)*4096+((i)&3)*1024)); vhi[i]=vtr(vp_+(((i)>>2)*4096+((i)&3)*1024+512)); }while(0)
  #define KRD(G,j) do{ if(G){ kload2(kf,kp0+sl_next,j); SBAR(); } }while(0)
  #define STEP(C0,C1,P0,P1,t,GK,GV,GL) do{ SBAR(); \
    const lds_cptr vp_=vp0+sl_prev; \
    VRD(0); SBAR(); float sacc=(P0[0]+P0[1]); \
    GAPA(C0=__builtin_amdgcn_mfma_f32_32x32x16_bf16(kf[0],qr[0],negm,0,0,0), P0[2],P0[3],P0[4],P0[5],     pw0[0]=PKW(P0,0), pw0[1]=PKW(P0,2), pw0); \
    VRD(4); SBAR(); GAPA(C1=__builtin_amdgcn_mfma_f32_32x32x16_bf16(kf[1],qr[0],negm,0,0,0), P0[6],P0[7],P0[8],P0[9],     pw0[2]=PKW(P0,4), pw0[3]=PKW(P0,6), pw0); \
    VRD(1); SBAR(); GAPA(C0=__builtin_amdgcn_mfma_f32_32x32x16_bf16(kf[2],qr[1],C0,0,0,0),   P0[10],P0[11],P0[12],P0[13], pw1[0]=PKW(P0,8), pw1[1]=PKW(P0,10), pw1); \
    VRD(5); SBAR(); GAPA(C1=__builtin_amdgcn_mfma_f32_32x32x16_bf16(kf[3],qr[1],C1,0,0,0),   P0[14],P0[15],P1[0],P1[1],   pw1[2]=PKW(P0,12),pw1[3]=PKW(P0,14), pw1); \
    VRD(2); SBAR(); GAPA(C0=__builtin_amdgcn_mfma_f32_32x32x16_bf16(kf[4],qr[2],C0,0,0,0),   P1[2],P1[3],P1[4],P1[5],     pw2[0]=PKW(P1,0), pw2[1]=PKW(P1,2), pw2); \
    VRD(6); SBAR(); GAPA(C1=__builtin_amdgcn_mfma_f32_32x32x16_bf16(kf[5],qr[2],C1,0,0,0),   P1[6],P1[7],P1[8],P1[9],     pw2[2]=PKW(P1,4), pw2[3]=PKW(P1,6), pw2); \
    VRD(3); SBAR(); GAPA(C0=__builtin_amdgcn_mfma_f32_32x32x16_bf16(kf[6],qr[3],C0,0,0,0),   P1[10],P1[11],P1[12],P1[13], pw3[0]=PKW(P1,8), pw3[1]=PKW(P1,10), pw3); \
    VRD(7); SBAR(); GAPA(C1=__builtin_amdgcn_mfma_f32_32x32x16_bf16(kf[7],qr[3],C1,0,0,0),   P1[14],P1[15],0.f,0.f,       pw3[2]=PKW(P1,12),pw3[3]=PKW(P1,14), pw3); \
    l_reg+=sacc; \
    if(GK){DMA_K((t)+3,sl_cur);} if(GV){DMA_V((t)+1,sl_next);} \
    CMASK(C0,C1,t); \
    { float a=MX3(C0[0],C0[1],C1[0]),b=MX3(C0[2],C0[3],C1[1]); a=MX3(a,C1[2],C1[3]); \
      _Pragma("unroll") for(int r=4;r<16;r+=4){a=MX3(a,C0[r],C0[r+1]);b=MX3(b,C0[r+2],C0[r+3]);a=MX3(a,C1[r],C1[r+1]);b=MX3(b,C1[r+2],C1[r+3]);} \
      float rm=__builtin_fmaxf(a,b); { auto rr=__builtin_amdgcn_permlane32_swap(__float_as_uint(rm),__float_as_uint(rm),false,false); rm=__builtin_fmaxf(__uint_as_float(rr[0]),__uint_as_float(rr[1])); } \
      resc=false; \
      if(__builtin_expect(__any(rm>(float)THRL),0)){ const float dl=__builtin_fmaxf(rm,0.f); mhat+=dl; \
        _Pragma("unroll") for(int r=0;r<16;++r){C0[r]-=dl;C1[r]-=dl;} \
        _Pragma("unroll") for(int r=0;r<16;++r)negm[r]=-mhat; asm volatile("":"+v"(negm)); \
        const float f=__builtin_amdgcn_exp2f(-dl); l_reg*=f; if(hi==0)wsf[r32]=f; resc=true; } } \
    SBAR(); \
    GAPB(o[0]=__builtin_amdgcn_mfma_f32_32x32x16_bf16(PAF(0),VFR(0),o[0],0,0,0), C0,0); \
    GAPB(o[1]=__builtin_amdgcn_mfma_f32_32x32x16_bf16(PAF(0),VFR(4),o[1],0,0,0), C0,4); \
    KRD(GL,0); GAPB(o[0]=__builtin_amdgcn_mfma_f32_32x32x16_bf16(PAF(1),VFR(1),o[0],0,0,0), C0,8); \
    KRD(GL,1); GAPB(o[1]=__builtin_amdgcn_mfma_f32_32x32x16_bf16(PAF(1),VFR(5),o[1],0,0,0), C0,12); \
    KRD(GL,2); GAPB(o[0]=__builtin_amdgcn_mfma_f32_32x32x16_bf16(PAF(2),VFR(2),o[0],0,0,0), C1,0); \
    KRD(GL,3); GAPB(o[1]=__builtin_amdgcn_mfma_f32_32x32x16_bf16(PAF(2),VFR(6),o[1],0,0,0), C1,4); \
    GAPB(o[0]=__builtin_amdgcn_mfma_f32_32x32x16_bf16(PAF(3),VFR(3),o[0],0,0,0), C1,8); \
    GAPB(o[1]=__builtin_amdgcn_mfma_f32_32x32x16_bf16(PAF(3),VFR(7),o[1],0,0,0), C1,12); \
    }while(0)
  int t=1;
  #undef CMASK
  #define CMASK(P0,P1,t) MASK_FAR(P0,P1,t)
  for(;MODE!=2&&t+7<NT;t+=2){
    STEP(pB0,pB1,pA0,pA1,t,true,true,true);     WAIT_BAR(2); RESC(); ROT();
    STEP(pA0,pA1,pB0,pB1,t+1,true,true,true);   WAIT_BAR(2); RESC(); ROT();
  }
  #undef CMASK
  #define CMASK(P0,P1,t) MASK_BAND(P0,P1,t)
  #define ENDW(tt) do{ if((tt)+3<NT){WAIT_BAR(2);} else if((tt)+2<NT){WAIT_BAR(1);} else {WAIT_BAR(0);} }while(0)
  for(;t+1<NT;t+=2){
    STEP(pB0,pB1,pA0,pA1,t,(t+3<NT),(t+1<NT),(t+1<NT));       ENDW(t);   RESC(); ROT();
    STEP(pA0,pA1,pB0,pB1,t+1,(t+4<NT),(t+2<NT),(t+2<NT));     ENDW(t+1); RESC(); ROT();
  }
  STEP(pB0,pB1,pA0,pA1,NT-1,false,false,false); RESC();
  { float sacc=pB0[0]+pB0[1]; _Pragma("unroll") for(int r=2;r<16;++r)sacc+=pB0[r]; _Pragma("unroll") for(int r=0;r<16;++r)sacc+=pB1[r]; l_reg+=sacc;
    pw0=(u32x4){PKW(pB0,0),PKW(pB0,2),PKW(pB0,4),PKW(pB0,6)};pw1=(u32x4){PKW(pB0,8),PKW(pB0,10),PKW(pB0,12),PKW(pB0,14)};pw2=(u32x4){PKW(pB1,0),PKW(pB1,2),PKW(pB1,4),PKW(pB1,6)};pw3=(u32x4){PKW(pB1,8),PKW(pB1,10),PKW(pB1,12),PKW(pB1,14)};
    SBAR(); pv(o,vb0+sl_cur,PAF(0),PAF(1),PAF(2),PAF(3)); }
  #undef PKW
  #undef PAF
  #undef VFR
  #undef PIN
  #undef MX3
  #undef GAPA
  #undef GAPB
  #undef EX
  #undef VRD
  #undef KRD
  #undef STEP
  #undef ENDW
  {auto rr=__builtin_amdgcn_permlane32_swap(__float_as_uint(l_reg),__float_as_uint(l_reg),false,false);l_reg=__uint_as_float(rr[0])+__uint_as_float(rr[1]);}
  int lane_e=lane; asm volatile("":"+v"(lane_e)); const int r32e=lane_e&31, hie=lane_e>>5;
  float*wsfe=(float*)(shm+LDS_WS)+wid*128;
  if(hie==0){ wsfe[32+r32e]=l_reg; if(EPI!=0){ const float gl=bfs((short)U.gate[(long)(wid*QBLK+r32e)*PITCH+U.gcol]); wsfe[64+r32e]=1.f/(1.f+__expf(-gl)); } }
  asm volatile("s_waitcnt lgkmcnt(0)":::"memory");
  float rli[16];
  #pragma unroll
  for(int r=0;r<16;++r){ rli[r]=__builtin_amdgcn_rcpf(fmaxf(wsfe[32+crow(r,hie)],1e-30f)); if(EPI!=0)rli[r]*=wsfe[64+crow(r,hie)]; }
  bf16*Ow=U.Ob+(long)(wid*QBLK)*PITCH;
  { bf16*stg=(bf16*)(shm+LDS_OST)+wid*2048;
    #pragma unroll
    for(int r=0;r<16;++r){const int orow=crow(r,hie);
      #pragma unroll
      for(int d0=0;d0<2;++d0){ float v=o[d0][r]*rli[r]; if(EPI==2)v+=bfs((short)stg[orow*64+d0*32+r32e]); stg[orow*64+d0*32+r32e]=f2b(v);} }
    asm volatile("s_waitcnt lgkmcnt(0)":::"memory");
    if(EPI!=1){
    #pragma unroll
    for(int i=0;i<4;++i){const int row=i*8+(lane_e>>3),ch=lane_e&7; u32x4 v=*(const u32x4*)(stg+row*64+ch*8);
      if(EPI==2){ const u32x4 t=*(const u32x4*)(U.tmp+(long)(wid*QBLK+row)*512+ch*8);
        v.x=pk2b(lo16(v.x)+lo16(t.x),hi16(v.x)+hi16(t.x)); v.y=pk2b(lo16(v.y)+lo16(t.y),hi16(v.y)+hi16(t.y)); v.z=pk2b(lo16(v.z)+lo16(t.z),hi16(v.z)+hi16(t.z)); v.w=pk2b(lo16(v.w)+lo16(t.w),hi16(v.w)+hi16(t.w)); }
      ATTN_STORE16(Ow+(long)row*PITCH+ch*8,v);} } }
  asm volatile("s_waitcnt lgkmcnt(0)\n\ts_barrier":::"memory");
  #undef DMA_K
  #undef DMA_V
  #undef CMASK
  #undef START
  #undef RESC
  #undef ROT
}
constexpr int ATTN_LDS_BYTES=LDS_BYTES;
#undef SBAR
#undef WAIT_BAR
}

constexpr int NWAVES = 8;
constexpr int B_ = 4, S_ = 8192, DM = 1024, M_ = B_ * S_, DIN = 7464, FF = 2816, NL = 2;
constexpr int YP = pg8::YP_;
constexpr float C2 = pg8::C2_, LOG2E = 1.4426950408889634f;
constexpr float NORM_EPS = 1e-6f;
constexpr int Y_AQ = 0, Y_AKC = 512, Y_AVC = 640, Y_AKS = 768, Y_AVS = 896, Y_AKW = 1024, Y_AVW = 1152, Y_CQ = 1280, Y_CK = 1792, Y_CV = 2304,
              Y_BQ = 2816, Y_BK = 3072, Y_BV = 3328, Y_BR = 3840, Y_AG = 4352, Y_BLR = 4376;
constexpr int NIN = 7680;
constexpr size_t MiB = 1u << 20;
constexpr size_t WS_CTL = 0, CTL_ZERO_BYTES = 1 * MiB;
constexpr size_t WS_WIN = 1 * MiB, WS_WA = 16 * MiB, WS_WB = 17 * MiB, WS_WC = 18 * MiB, WS_WO = 19 * MiB, WS_WF1 = 21 * MiB, WS_WF2 = 32 * MiB;
constexpr size_t WS_H = 40 * MiB;
constexpr size_t WS_Y = 104 * MiB;
constexpr size_t WS_G8 = 379 * MiB;
constexpr size_t WS_ACT = WS_Y + 128 * MiB;
constexpr size_t WS_SM = 475 * MiB;
constexpr size_t WS_KCMP = WS_SM, WS_VCMP = WS_SM + 1 * MiB, WS_KMEAN = WS_SM + 2 * MiB;
constexpr size_t WS_GA = WS_SM + 3 * MiB;
constexpr size_t WS_MASK = 38 * MiB;
constexpr size_t WS_OATMP = WS_H;
constexpr size_t WS_O16 = WS_H + 32 * MiB;
constexpr size_t WS_VCMPT = WS_VCMP + 512 * 1024;
constexpr size_t WS_CW1T = 39 * MiB;
constexpr size_t WS_CW2T = WS_CW1T + 512 * 1024;
constexpr size_t WS_CC0 = WS_CW2T + 16 * 1024;
constexpr size_t WS_GST = WS_H + 32 * MiB;
constexpr size_t WS_GDEC = WS_SM + 3 * MiB;
constexpr size_t WS_BCUM = WS_SM + 4 * MiB;
constexpr size_t WS_END = 512 * MiB;
static_assert(WS_BCUM + (size_t)M_ * 256 * 4 <= WS_END, "ws map 3");
static_assert(WS_GA + (size_t)M_ * 256 * 4 <= WS_END && WS_Y + (size_t)M_ * YP * 2 <= WS_G8 && WS_G8 + (size_t)M_ * 3072 <= WS_SM, "ws map");
static_assert(WS_ACT + (size_t)M_ * FF * 2 <= WS_SM && WS_WF2 + (size_t)DM * FF * 2 <= WS_H, "ws map 2");
constexpr int CW_BAR = 4096;
constexpr int RING_OFF = 0, RING_BYTES = 131072;
constexpr int LDSCTL_OFF = RING_BYTES, MISC_OFF = LDSCTL_OFF + 320;
constexpr int LDS_BYTES = 147456;

#define GAS __attribute__((address_space(1)))
#define LAS __attribute__((address_space(3)))
typedef unsigned short bf16;
typedef unsigned v4u __attribute__((ext_vector_type(4)));
typedef float f32x4 __attribute__((ext_vector_type(4)));
typedef short bf16x8 __attribute__((ext_vector_type(8)));
typedef GAS unsigned gu32;
typedef GAS unsigned long long gu64;
#define RLX_AGENT __ATOMIC_RELAXED, __HIP_MEMORY_SCOPE_AGENT
#define LDS_WAIT() asm volatile("s_waitcnt lgkmcnt(0)" ::: "memory")
#define VM_WAIT() asm volatile("s_waitcnt vmcnt(0)" ::: "memory")
__device__ __forceinline__ unsigned long long rt() { return __builtin_amdgcn_s_memrealtime(); }
__device__ __forceinline__ unsigned f2bf(float f) { unsigned u = __builtin_bit_cast(unsigned, f); return (u + 0x7fffu + ((u >> 16) & 1u)) >> 16; }
__device__ __forceinline__ unsigned pk2(float lo, float hi) { return f2bf(lo) | (f2bf(hi) << 16); }

__device__ __forceinline__ float bf2f(bf16 h) { return __uint_as_float((unsigned)h << 16); }
__device__ __forceinline__ float sigm(float v) { return 1.f / (1.f + __expf(-v)); }
#define WFENCE() asm volatile("s_waitcnt lgkmcnt(0)" ::: "memory")

#define XB_TMO      128
#define XB_XCNT(j)  (256  + 64 * (j))
#define XB_XSUB(j)  (1280 + 64 * (j))
#define XB_XGEN(j)  (2304 + 64 * (j))
#define XB_TOP      3328
#define XB_TOPGEN   3392
#define XCD_BAR_WORDS 3456
#define XB_SPIN_CAP (1u << 18)

__device__ __forceinline__ unsigned xb_ld(unsigned* p)              { return __hip_atomic_load(p, __ATOMIC_RELAXED, __HIP_MEMORY_SCOPE_AGENT); }
__device__ __forceinline__ unsigned xb_add(unsigned* p, unsigned v) { return __hip_atomic_fetch_add(p, v, __ATOMIC_RELAXED, __HIP_MEMORY_SCOPE_AGENT); }
__device__ __forceinline__ unsigned xb_xcc_id() { return (unsigned)__builtin_amdgcn_s_getreg((3 << 11) | 20) & 0xFu; }
#define XB_SPIN(cond, bar) do { unsigned _sp = 0; while (cond) { __builtin_amdgcn_s_sleep(1); \
    if ((++_sp & 255u) == 0u) { if (xb_ld(&(bar)[XB_TMO])) break; if (_sp > XB_SPIN_CAP) { atomicAdd(&(bar)[XB_TMO], 1u); break; } } } } while (0)

struct XcdBarrier {
    unsigned* bar; unsigned x;
    volatile LAS unsigned* st;
};

__device__ __forceinline__ XcdBarrier xcd_barrier_post(unsigned* bar, volatile LAS unsigned* st) {
    XcdBarrier b; b.bar = bar; b.x = xb_xcc_id(); b.st = st;
    if (threadIdx.x == 0) (void)xb_add(&bar[XB_XCNT(b.x)], 1u);
    return b;
}
__device__ __forceinline__ void xcd_barrier_complete(unsigned* bar, unsigned x, unsigned& nloc, unsigned& nx) {
    const unsigned G = gridDim.x * gridDim.y * gridDim.z;
    unsigned sum, cnt, mine, sp = 0u;
    for (;;) {
        sum = 0u; cnt = 0u; mine = 0u;
#pragma unroll
        for (unsigned j = 0; j < 16; ++j) { const unsigned c = xb_ld(&bar[XB_XCNT(j)]); sum += c; cnt += (c > 0u) ? 1u : 0u; mine = (j == x) ? c : mine; }
        if (sum == G) break;
        __builtin_amdgcn_s_sleep(1);
        if ((++sp & 255u) == 0u) { if (xb_ld(&bar[XB_TMO])) break; if (sp > XB_SPIN_CAP) { atomicAdd(&bar[XB_TMO], 1u); break; } }
    }
    nloc = mine > 0u ? mine : 1u; nx = cnt > 0u ? cnt : 1u;
}

__device__ __forceinline__ void xcd_barrier(const XcdBarrier& b) {
    asm volatile("s_waitcnt vmcnt(0)" ::: "memory");
    __syncthreads();
    if (threadIdx.x == 0) {
        unsigned* bar = b.bar;
        __builtin_amdgcn_s_waitcnt(0);
        unsigned nloc = b.st[0], nx = b.st[1];
        if (nloc == 0u) { xcd_barrier_complete(bar, b.x, nloc, nx); b.st[0] = nloc; b.st[1] = nx; }
        const unsigned old = xb_add(&bar[XB_XSUB(b.x)], 1u);
        const unsigned gen = old / nloc;
        if (old + 1u == (gen + 1u) * nloc) {
            __builtin_amdgcn_fence(__ATOMIC_RELEASE, "agent");
            asm volatile("s_waitcnt vmcnt(0)" ::: "memory");
            const unsigned og = xb_add(&bar[XB_TOP], 1u);
            const unsigned tg = og / nx;
            if (og + 1u == (tg + 1u) * nx) xb_add(&bar[XB_TOPGEN], 1u);
            else XB_SPIN(xb_ld(&bar[XB_TOPGEN]) == tg, bar);
            __builtin_amdgcn_fence(__ATOMIC_ACQUIRE, "agent");
            xb_add(&bar[XB_XGEN(b.x)], 1u);
            asm volatile("s_waitcnt vmcnt(0)" ::: "memory");
        } else {
            XB_SPIN(xb_ld(&bar[XB_XGEN(b.x)]) == gen, bar);
            __builtin_amdgcn_fence(__ATOMIC_ACQUIRE, "agent");
            asm volatile("s_waitcnt vmcnt(0)" ::: "memory");
        }
    }
    __syncthreads();
}


struct Frame {
    LAS unsigned char* lds;
    volatile LAS unsigned* MISC;
    gu32* ctl;
    int tid, lane, wave, G;
};
__device__ __forceinline__ float wave_sum(float v) {
#pragma unroll
    for (int o = 1; o < 64; o <<= 1) v += __shfl_xor(v, o);
    return v;
}
__device__ __forceinline__ float wave_max(float v) {
#pragma unroll
    for (int o = 1; o < 64; o <<= 1) v = fmaxf(v, __shfl_xor(v, o));
    return v;
}
__device__ __forceinline__ int t5_bucket(int d) {
    if (d < 16) return d < 0 ? 0 : d;
    int b = 16;
    b += (d >= 19); b += (d >= 21); b += (d >= 24); b += (d >= 27); b += (d >= 31); b += (d >= 35); b += (d >= 40); b += (d >= 46);
    b += (d >= 52); b += (d >= 59); b += (d >= 67); b += (d >= 77); b += (d >= 87); b += (d >= 99); b += (d >= 113);
    return b;
}
template <class CM> __device__ __forceinline__ void tr_item(const float* W, int Nsrc, int K, bf16* WT, int item, int nblk, CM cm, LAS float* scr, int lane) {
    const int kb = item / nblk, nb = item % nblk, k0 = 64 * kb, n0 = 32 * nb;
    const int sc = cm(n0 + (lane & 31));
#pragma unroll 8
    for (int i = 0; i < 32; ++i) { const int kk = 2 * i + (lane >> 5); scr[kk * 33 + (lane & 31)] = sc >= 0 ? W[(size_t)(k0 + kk) * Nsrc + sc] : 0.f; }
    LDS_WAIT(); asm volatile("" ::: "memory");
    const int c = lane & 7;
#pragma unroll
    for (int j = 0; j < 4; ++j) { const int n = (lane >> 3) + 8 * j; const LAS float* s = scr + (8 * c) * 33 + n;
        v4u o; o.x = pk2(s[0 * 33], s[1 * 33]); o.y = pk2(s[2 * 33], s[3 * 33]); o.z = pk2(s[4 * 33], s[5 * 33]); o.w = pk2(s[6 * 33], s[7 * 33]);
        *(GAS v4u*)(WT + (size_t)(n0 + n) * K + k0 + 8 * c) = o; }
    LDS_WAIT(); asm volatile("" ::: "memory");
}
struct CmId { __device__ __forceinline__ int operator()(int n) const { return n; } };
struct CmWin { __device__ __forceinline__ int operator()(int n) const {
    if (n < 1280) return n;
    if (n < 2816) return n - 1280 + 2856;
    if (n < 4352) return n - 2816 + 1304;
    if (n < 4376) return n - 4352 + 1280;
    if (n < 4392) return n - 4376 + 2840;
    if (n < 4608) return -1;
    return n - 4608 + 4392; } };
struct CmFfn { __device__ __forceinline__ int operator()(int c) const { const int p = c >> 8, r = c & 255; return r < 128 ? 128 * p + r : FF + 128 * p + (r - 128); } };

struct Args { const float* in[22]; float* out; unsigned char* ws; int ph_lo, ph_hi; };

__device__ __forceinline__ void phase_weights(Frame& F, const Args& a, int l) {
    LAS float* scr = (LAS float*)(F.lds + RING_OFF + F.wave * 16384);
    const int gw = blockIdx.x * NWAVES + F.wave, NGW = F.G * NWAVES;
    unsigned char* ws = a.ws;
    constexpr int I_IN = 16 * (NIN / 32), I_BR = 8 * 32, I_O = 16 * 32, I_F1 = 16 * (2 * FF / 32), I_F2 = (FF / 64) * 32;
    constexpr int NIT = I_IN + 3 * I_BR + I_O + I_F1 + I_F2;
    for (int it = gw; it < NIT; it += NGW) {
        int r = it;
        if (r < I_IN) { tr_item(a.in[6] + (size_t)l * DM * DIN, DIN, DM, (bf16*)(ws + WS_WIN), r, NIN / 32, CmWin(), scr, F.lane); continue; } r -= I_IN;
        if (r < I_BR) { tr_item(a.in[16] + (size_t)l * 512 * DM, DM, 512, (bf16*)(ws + WS_WA), r, 32, CmId(), scr, F.lane); continue; } r -= I_BR;
        if (r < I_BR) { tr_item(a.in[17] + (size_t)l * 512 * DM, DM, 512, (bf16*)(ws + WS_WB), r, 32, CmId(), scr, F.lane); continue; } r -= I_BR;
        if (r < I_BR) { tr_item(a.in[18] + (size_t)l * 512 * DM, DM, 512, (bf16*)(ws + WS_WC), r, 32, CmId(), scr, F.lane); continue; } r -= I_BR;
        if (r < I_O) { tr_item(a.in[19] + (size_t)l * DM * DM, DM, DM, (bf16*)(ws + WS_WO), r, 32, CmId(), scr, F.lane); continue; } r -= I_O;
        if (r < I_F1) { tr_item(a.in[20] + (size_t)l * DM * 2 * FF, 2 * FF, DM, (bf16*)(ws + WS_WF1), r, 2 * FF / 32, CmFfn(), scr, F.lane); continue; } r -= I_F1;
        tr_item(a.in[21] + (size_t)l * FF * DM, DM, FF, (bf16*)(ws + WS_WF2), r, 32, CmId(), scr, F.lane);
    }
    for (int it = gw; it < 2 * 66 + 2; it += NGW) {
        if (it < 132) { const int kv = it / 66, r = it % 66;
            if (r < 64) tr_item(a.in[kv ? 11 : 9] + (size_t)l * 2048 * 64, 64, 2048, (bf16*)(ws + WS_CW1T) + (size_t)kv * 64 * 2048, r, 2, CmId(), scr, F.lane);
            else tr_item(a.in[kv ? 12 : 10] + (size_t)l * 64 * 64, 64, 64, (bf16*)(ws + WS_CW2T) + (size_t)kv * 64 * 64, r - 64, 2, CmId(), scr, F.lane); }
        else { const int kv = it - 132; const float* pe = a.in[kv ? 8 : 7] + (size_t)l * 2048; const float* w1 = a.in[kv ? 11 : 9] + (size_t)l * 2048 * 64; float acc = 0.f;
            for (int k = 0; k < 2048; ++k) acc += pe[k] * w1[(size_t)k * 64 + F.lane];
            ((float*)(ws + WS_CC0))[kv * 64 + F.lane] = acc; }
    }
}
__device__ __forceinline__ void phase_norm0(Frame& F, const float* x, const float* w, bf16* H) {
    const int gw = blockIdx.x * NWAVES + F.wave, NGW = F.G * NWAVES;
    for (int m = gw; m < M_; m += NGW) {
        const f32x4* xr = (const f32x4*)(x + (size_t)m * DM) + F.lane; f32x4 v[4]; float s = 0.f;
#pragma unroll
        for (int j = 0; j < 4; ++j) { v[j] = xr[64 * j]; s += v[j].x * v[j].x + v[j].y * v[j].y + v[j].z * v[j].z + v[j].w * v[j].w; }
        const float r = rsqrtf(wave_sum(s) * (1.f / DM) + NORM_EPS);
        unsigned long long* o8 = (unsigned long long*)(H + (size_t)m * DM) + F.lane;
#pragma unroll
        for (int j = 0; j < 4; ++j) { const f32x4 wv = ((const f32x4*)w)[F.lane + 64 * j];
            o8[64 * j] = (unsigned long long)pk2(v[j].x * r * wv.x, v[j].y * r * wv.y) | ((unsigned long long)pk2(v[j].z * r * wv.z, v[j].w * r * wv.w) << 32); }
    }
}
__device__ __forceinline__ void phase_resid(Frame& F, const float* y, const float* xin, float* xout, const float* wpost, const float* wpre, bf16* hout) {
    const int gw = blockIdx.x * NWAVES + F.wave, NGW = F.G * NWAVES;
    for (int m = gw; m < M_; m += NGW) {
        const f32x4* yr = (const f32x4*)(y + (size_t)m * DM) + F.lane; const f32x4* xr = (const f32x4*)(xin + (size_t)m * DM) + F.lane;
        f32x4 v[4], xv[4]; float s = 0.f;
#pragma unroll
        for (int j = 0; j < 4; ++j) { v[j] = yr[64 * j]; xv[j] = xr[64 * j]; s += v[j].x * v[j].x + v[j].y * v[j].y + v[j].z * v[j].z + v[j].w * v[j].w; }
        const float r = rsqrtf(wave_sum(s) * (1.f / DM) + NORM_EPS); float s2 = 0.f;
        f32x4* xo = (f32x4*)(xout + (size_t)m * DM) + F.lane;
#pragma unroll
        for (int j = 0; j < 4; ++j) { const f32x4 wv = ((const f32x4*)wpost)[F.lane + 64 * j]; f32x4 n;
            n.x = xv[j].x + v[j].x * r * wv.x; n.y = xv[j].y + v[j].y * r * wv.y; n.z = xv[j].z + v[j].z * r * wv.z; n.w = xv[j].w + v[j].w * r * wv.w;
            xo[64 * j] = n; v[j] = n; s2 += n.x * n.x + n.y * n.y + n.z * n.z + n.w * n.w; }
        if (hout) { const float r2 = rsqrtf(wave_sum(s2) * (1.f / DM) + NORM_EPS);
            unsigned long long* o8 = (unsigned long long*)(hout + (size_t)m * DM) + F.lane;
#pragma unroll
            for (int j = 0; j < 4; ++j) { const f32x4 wv = ((const f32x4*)wpre)[F.lane + 64 * j];
                o8[64 * j] = (unsigned long long)pk2(v[j].x * r2 * wv.x, v[j].y * r2 * wv.y) | ((unsigned long long)pk2(v[j].z * r2 * wv.z, v[j].w * r2 * wv.w) << 32); } }
    }
}
__device__ __forceinline__ void unpack8(const v4u w, float (&k)[8]) {
    k[0] = __uint_as_float(w.x << 16); k[1] = __uint_as_float(w.x & 0xffff0000u); k[2] = __uint_as_float(w.y << 16); k[3] = __uint_as_float(w.y & 0xffff0000u);
    k[4] = __uint_as_float(w.z << 16); k[5] = __uint_as_float(w.z & 0xffff0000u); k[6] = __uint_as_float(w.w << 16); k[7] = __uint_as_float(w.w & 0xffff0000u);
}
__device__ __forceinline__ void dot4(const LAS float* qs, const bf16* kr, float (&d)[4]) {
    d[0] = d[1] = d[2] = d[3] = 0.f;
#pragma unroll 1
    for (int c = 0; c < 8; ++c) { asm volatile("" ::: "memory"); const v4u w = ((const v4u*)kr)[c]; float k[8]; unpack8(w, k);
#pragma unroll
        for (int e = 0; e < 8; ++e) { const int dd = c * 8 + e;
#pragma unroll
            for (int h = 0; h < 4; ++h) d[h] += qs[h * 64 + dd] * k[e]; } }
}
__device__ __forceinline__ float dot1(const LAS float* qs, const bf16* kr) {
    float d = 0.f;
#pragma unroll
    for (int c = 0; c < 8; ++c) { const v4u w = ((const v4u*)kr)[c]; float k[8]; unpack8(w, k);
#pragma unroll
        for (int e = 0; e < 8; ++e) d += qs[c * 8 + e] * k[e]; }
    return d;
}
__device__ __forceinline__ float gelu_tanh(float x) { const float u = 0.7978845608028654f * (x + 0.044715f * x * x * x); return 0.5f * x * (1.f + tanhf(u)); }

__device__ __forceinline__ void phase2_naive(Frame& F, const Args& a, int l) {
    const int gw = blockIdx.x * NWAVES + F.wave, NGW = F.G * NWAVES, lane = F.lane;
    const bf16* Y = (const bf16*)(a.ws + WS_Y);
    LAS float* scr = (LAS float*)(F.lds + RING_OFF + F.wave * 16384);
    for (int t = gw; t < 4 * 8 * 32; t += NGW) {
        const int blk = t & 31, h = (t >> 5) & 7, b = t >> 8;
        const bf16* src = Y + ((size_t)b * S_ + blk * 256) * YP + Y_CK + h * 64 + lane; float s = 0.f;
        for (int i = 0; i < 256; ++i) s += bf2f(src[(size_t)i * YP]);
        ((float*)(a.ws + WS_KMEAN))[(size_t)t * 64 + lane] = s * (1.f / 256.f);
    }
}
__device__ __forceinline__ void gla_scan_naive(Frame& F, const Args& a) {
    const bf16* Y = (const bf16*)(a.ws + WS_Y); const float* GA = (const float*)(a.ws + WS_GA); bf16* O16 = (bf16*)(a.ws + WS_O16);
    const int lane = F.lane;
    for (int task = blockIdx.x; task < 256; task += F.G) {
        const int eg = task & 15, h = (task >> 4) & 3, b = task >> 6, e = eg * 8 + F.wave;
        float Sst = 0.f;
        for (int t0 = 0; t0 < S_; t0 += 8) {
            float av[8], kv[8], qv[8], vv[8];
#pragma unroll
            for (int j = 0; j < 8; ++j) { const size_t row = (size_t)b * S_ + t0 + j;
                av[j] = GA[row * 256 + h * 64 + lane]; kv[j] = bf2f(Y[row * YP + Y_BK + h * 64 + lane]); qv[j] = bf2f(Y[row * YP + Y_BQ + h * 64 + lane]); vv[j] = bf2f(Y[row * YP + Y_BV + h * 128 + e]); }
#pragma unroll
            for (int j = 0; j < 8; ++j) { Sst = av[j] * Sst + kv[j] * vv[j]; const float o = wave_sum(qv[j] * Sst);
                if (lane == 0) O16[((size_t)b * S_ + t0 + j) * 512 + h * 128 + e] = (bf16)f2bf(o); }
        }
    }
}
__device__ __forceinline__ void nsa_cmp_naive(Frame& F, const Args& a) {
    const int gw = blockIdx.x * NWAVES + F.wave, NGW = F.G * NWAVES, lane = F.lane;
    bf16* Y = (bf16*)(a.ws + WS_Y); const float* rel = a.in[1];
    LAS float* scr = (LAS float*)(F.lds + RING_OFF + F.wave * 16384);
    LAS float* qs = scr; LAS float* sc = scr + 256; LAS float* s2 = scr + 256 + 2048;
    for (int task = gw; task < 8 * S_; task += NGW) {
        const int q = task & (S_ - 1), bg = task >> 13, g = bg & 1, b = bg >> 1;
        const size_t row = (size_t)b * S_ + q; bf16* Yr = Y + row * YP;
#pragma unroll
        for (int h = 0; h < 4; ++h) qs[h * 64 + lane] = bf2f(Yr[Y_AQ + (g * 4 + h) * 64 + lane]);
        float gt[4][3];
#pragma unroll
        for (int h = 0; h < 4; ++h)
#pragma unroll
            for (int br = 0; br < 3; ++br) gt[h][br] = sigm(bf2f(Yr[Y_AG + (g * 4 + h) * 3 + br]));
        WFENCE();
        const int cur = q >> 6, ncv = q >= 31 ? ((q - 31) >> 4) + 1 : 0;
        const bf16* KC = (const bf16*)(a.ws + WS_KCMP) + (size_t)bg * 512 * 64; const bf16* VC = (const bf16*)(a.ws + WS_VCMP) + (size_t)bg * 512 * 64;
        float mx[4] = {-1e30f, -1e30f, -1e30f, -1e30f};
        for (int i = 0; i < 8; ++i) { const int n = lane + 64 * i;
            if (n < ncv) { float d[4]; dot4(qs, KC + (size_t)n * 64, d); const int bk = t5_bucket(q - (16 * n + 31));
#pragma unroll
                for (int h = 0; h < 4; ++h) { const float s = d[h] + rel[bk * 16 + g * 4 + h] * LOG2E; sc[h * 512 + n] = s; mx[h] = fmaxf(mx[h], s); } }
            else {
#pragma unroll
                for (int h = 0; h < 4; ++h) sc[h * 512 + n] = 0.f; } }
        float ls[4] = {0.f, 0.f, 0.f, 0.f};
#pragma unroll
        for (int h = 0; h < 4; ++h) mx[h] = wave_max(mx[h]);
        WFENCE();
        for (int i = 0; i < 8; ++i) { const int n = lane + 64 * i;
            if (n < ncv) {
#pragma unroll
                for (int h = 0; h < 4; ++h) { const float e = exp2f(sc[h * 512 + n] - mx[h]); sc[h * 512 + n] = e; ls[h] += e; } } }
#pragma unroll
        for (int h = 0; h < 4; ++h) ls[h] = 1.f / fmaxf(wave_sum(ls[h]), 1e-20f);
        for (int i = 0; i < 8; ++i) { const int n = lane + 64 * i;
            if (n < ncv) {
#pragma unroll
                for (int h = 0; h < 4; ++h) sc[h * 512 + n] *= ls[h]; } }
        WFENCE();
        float v0, v1;
        { float t[2];
#pragma unroll
          for (int jj = 0; jj < 2; ++jj) { const int j = lane + 64 * jj; float v = 0.f;
              for (int n = 4 * j - 1; n <= 4 * j + 3; ++n) if (n >= 0 && n < 511) v += (sc[n] + sc[512 + n]) + (sc[1024 + n] + sc[1536 + n]);
              const bool forced = (j == 0) || (j == cur) || (j == cur - 1);
              t[jj] = forced ? 1e9f : (j <= cur ? v : -1e30f); }
          v0 = t[0]; v1 = t[1]; }
        bool sel0 = false, sel1 = false;
        for (int it = 0; it < 16; ++it) {
            const float c0 = sel0 ? -INFINITY : v0, c1 = sel1 ? -INFINITY : v1;
            const float mxv = wave_max(fmaxf(c0, c1));
            const unsigned long long m0 = __ballot(!sel0 && v0 == mxv);
            if (m0) { const int idx = __builtin_ctzll(m0); if (lane == idx) sel0 = true; }
            else { const unsigned long long m1 = __ballot(!sel1 && v1 == mxv); const int idx = m1 ? __builtin_ctzll(m1) : -1; if (lane == idx) sel1 = true; }
        }
        sel0 = sel0 && (lane <= cur); sel1 = sel1 && (lane + 64 <= cur);
        const unsigned long long sm0 = __ballot(sel0), sm1 = __ballot(sel1);
        float oc[4] = {0.f, 0.f, 0.f, 0.f};
        for (int n = 0; n < ncv; ++n) { const float vv = bf2f(VC[(size_t)n * 64 + lane]);
#pragma unroll
            for (int h = 0; h < 4; ++h) oc[h] += sc[h * 512 + n] * vv; }
        { unsigned* MK = (unsigned*)(a.ws + WS_MASK) + ((size_t)bg * S_ + q) * 4;
          if (lane == 0) { MK[0] = (unsigned)sm0; MK[1] = (unsigned)(sm0 >> 32); MK[2] = (unsigned)sm1; MK[3] = (unsigned)(sm1 >> 32); }
          bf16* T = (bf16*)(a.ws + WS_OATMP) + row * 512;
#pragma unroll
          for (int h = 0; h < 4; ++h) T[(g * 4 + h) * 64 + lane] = (bf16)f2bf(gt[h][0] * oc[h]); }
        WFENCE();
    }
}
__device__ __forceinline__ void nsa_naive(Frame& F, const Args& a) {
    const int gw = blockIdx.x * NWAVES + F.wave, NGW = F.G * NWAVES, lane = F.lane;
    bf16* Y = (bf16*)(a.ws + WS_Y); const float* rel = a.in[1];
    LAS float* scr = (LAS float*)(F.lds + RING_OFF + F.wave * 16384);
    LAS float* qs = scr; LAS float* sc = scr + 256; LAS float* s2 = scr + 256 + 2048;
    for (int task = gw; task < 8 * S_; task += NGW) {
        const int q = task & (S_ - 1), bg = task >> 13, g = bg & 1, b = bg >> 1;
        const size_t row = (size_t)b * S_ + q; bf16* Yr = Y + row * YP;
#pragma unroll
        for (int h = 0; h < 4; ++h) qs[h * 64 + lane] = bf2f(Yr[Y_AQ + (g * 4 + h) * 64 + lane]);
        float gt[4][3];
#pragma unroll
        for (int h = 0; h < 4; ++h)
#pragma unroll
            for (int br = 0; br < 3; ++br) gt[h][br] = sigm(bf2f(Yr[Y_AG + (g * 4 + h) * 3 + br]));
        WFENCE();
        const int cur = q >> 6, ncv = q >= 31 ? ((q - 31) >> 4) + 1 : 0;
        const bf16* KC = (const bf16*)(a.ws + WS_KCMP) + (size_t)bg * 512 * 64; const bf16* VC = (const bf16*)(a.ws + WS_VCMP) + (size_t)bg * 512 * 64;
        float mx[4] = {-1e30f, -1e30f, -1e30f, -1e30f};
        for (int i = 0; i < 8; ++i) { const int n = lane + 64 * i;
            if (n < ncv) { float d[4]; dot4(qs, KC + (size_t)n * 64, d); const int bk = t5_bucket(q - (16 * n + 31));
#pragma unroll
                for (int h = 0; h < 4; ++h) { const float s = d[h] + rel[bk * 16 + g * 4 + h] * LOG2E; sc[h * 512 + n] = s; mx[h] = fmaxf(mx[h], s); } }
            else {
#pragma unroll
                for (int h = 0; h < 4; ++h) sc[h * 512 + n] = 0.f; } }
        float ls[4] = {0.f, 0.f, 0.f, 0.f};
#pragma unroll
        for (int h = 0; h < 4; ++h) mx[h] = wave_max(mx[h]);
        WFENCE();
        for (int i = 0; i < 8; ++i) { const int n = lane + 64 * i;
            if (n < ncv) {
#pragma unroll
                for (int h = 0; h < 4; ++h) { const float e = exp2f(sc[h * 512 + n] - mx[h]); sc[h * 512 + n] = e; ls[h] += e; } } }
#pragma unroll
        for (int h = 0; h < 4; ++h) ls[h] = 1.f / fmaxf(wave_sum(ls[h]), 1e-20f);
        for (int i = 0; i < 8; ++i) { const int n = lane + 64 * i;
            if (n < ncv) {
#pragma unroll
                for (int h = 0; h < 4; ++h) sc[h * 512 + n] *= ls[h]; } }
        WFENCE();
        float v0, v1;
        { float t[2];
#pragma unroll
          for (int jj = 0; jj < 2; ++jj) { const int j = lane + 64 * jj; float v = 0.f;
              for (int n = 4 * j - 1; n <= 4 * j + 3; ++n) if (n >= 0 && n < 511) v += (sc[n] + sc[512 + n]) + (sc[1024 + n] + sc[1536 + n]);
              const bool forced = (j == 0) || (j == cur) || (j == cur - 1);
              t[jj] = forced ? 1e9f : (j <= cur ? v : -1e30f); }
          v0 = t[0]; v1 = t[1]; }
        bool sel0 = false, sel1 = false;
        for (int it = 0; it < 16; ++it) {
            const float c0 = sel0 ? -INFINITY : v0, c1 = sel1 ? -INFINITY : v1;
            const float mxv = wave_max(fmaxf(c0, c1));
            const unsigned long long m0 = __ballot(!sel0 && v0 == mxv);
            if (m0) { const int idx = __builtin_ctzll(m0); if (lane == idx) sel0 = true; }
            else { const unsigned long long m1 = __ballot(!sel1 && v1 == mxv); const int idx = m1 ? __builtin_ctzll(m1) : -1; if (lane == idx) sel1 = true; }
        }
        sel0 = sel0 && (lane <= cur); sel1 = sel1 && (lane + 64 <= cur);
        const unsigned long long sm0 = __ballot(sel0), sm1 = __ballot(sel1);
        float oc[4] = {0.f, 0.f, 0.f, 0.f};
        for (int n = 0; n < ncv; ++n) { const float vv = bf2f(VC[(size_t)n * 64 + lane]);
#pragma unroll
            for (int h = 0; h < 4; ++h) oc[h] += sc[h * 512 + n] * vv; }
        float ms[4] = {-1e30f, -1e30f, -1e30f, -1e30f}, lsel[4] = {0.f, 0.f, 0.f, 0.f}, os[4] = {0.f, 0.f, 0.f, 0.f};
        for (int j = 0; j <= cur; ++j) {
            const bool on = j < 64 ? ((sm0 >> j) & 1ull) : ((sm1 >> (j - 64)) & 1ull);
            if (!on) continue;
            const int kpos = 64 * j + lane; const bool valid = kpos <= q;
            float d[4]; dot4(qs, Y + ((size_t)b * S_ + kpos) * YP + Y_AKS + g * 64, d);
            const int bk = t5_bucket(q - kpos);
            WFENCE();
#pragma unroll
            for (int h = 0; h < 4; ++h) { const float s = valid ? d[h] + rel[bk * 16 + g * 4 + h] * LOG2E : -1e30f;
                const float mn = fmaxf(ms[h], wave_max(s)); const float p = valid ? exp2f(s - mn) : 0.f; s2[h * 64 + lane] = p;
                const float scl = exp2f(ms[h] - mn); lsel[h] = lsel[h] * scl + wave_sum(p); os[h] *= scl; ms[h] = mn; }
            WFENCE();
            const bf16* vb = Y + ((size_t)b * S_ + 64 * j) * YP + Y_AVS + g * 64 + lane;
            for (int kk = 0; kk < 64; ++kk) { const float vv = bf2f(vb[(size_t)kk * YP]);
#pragma unroll
                for (int h = 0; h < 4; ++h) os[h] += s2[h * 64 + kk] * vv; }
        }
        float mw[4] = {-1e30f, -1e30f, -1e30f, -1e30f}, lw[4] = {0.f, 0.f, 0.f, 0.f}, ow[4] = {0.f, 0.f, 0.f, 0.f};
        for (int c = 0; c < 8; ++c) {
            if (q - 64 * c < 0) break;
            const int dist = 64 * c + lane, kpos = q - dist; const bool valid = kpos >= 0;
            float d[4]; dot4(qs, Y + ((size_t)b * S_ + (valid ? kpos : 0)) * YP + Y_AKW + g * 64, d);
            const int bk = t5_bucket(dist);
            WFENCE();
#pragma unroll
            for (int h = 0; h < 4; ++h) { const float s = valid ? d[h] + rel[bk * 16 + g * 4 + h] * LOG2E : -1e30f;
                const float mn = fmaxf(mw[h], wave_max(s)); const float p = valid ? exp2f(s - mn) : 0.f; s2[h * 64 + lane] = p;
                const float scl = exp2f(mw[h] - mn); lw[h] = lw[h] * scl + wave_sum(p); ow[h] *= scl; mw[h] = mn; }
            WFENCE();
            for (int kk = 0; kk < 64; ++kk) { const int kp = q - 64 * c - kk; if (kp < 0) break;
                const float vv = bf2f(Y[((size_t)b * S_ + kp) * YP + Y_AVW + g * 64 + lane]);
#pragma unroll
                for (int h = 0; h < 4; ++h) ow[h] += s2[h * 64 + kk] * vv; }
        }
        WFENCE();
#pragma unroll
        for (int h = 0; h < 4; ++h) { const float o = gt[h][0] * oc[h] + gt[h][1] * os[h] / fmaxf(lsel[h], 1e-20f) + gt[h][2] * ow[h] / fmaxf(lw[h], 1e-20f);
            Yr[Y_AQ + (g * 4 + h) * 64 + lane] = (bf16)f2bf(o); }
    }
}
__device__ __forceinline__ void moba_naive(Frame& F, const Args& a) {
    const int gw = blockIdx.x * NWAVES + F.wave, NGW = F.G * NWAVES, lane = F.lane;
    bf16* Y = (bf16*)(a.ws + WS_Y); const float* rel = a.in[1]; const float* KM = (const float*)(a.ws + WS_KMEAN);
    LAS float* scr = (LAS float*)(F.lds + RING_OFF + F.wave * 16384);
    LAS float* qs = scr; LAS float* s2 = scr + 64;
    for (int task = gw; task < 32 * S_; task += NGW) {
        const int q = task & (S_ - 1), bh = task >> 13, h = bh & 7, b = bh >> 3;
        const size_t row = (size_t)b * S_ + q; bf16* Yr = Y + row * YP;
        WFENCE();
        qs[lane] = bf2f(Yr[Y_CQ + h * 64 + lane]);
        WFENCE();
        const int cur = q >> 8;
        float gs = -1e30f;
        if (lane < 32 && lane < cur) { const float* km = KM + ((size_t)bh * 32 + lane) * 64; float d = 0.f;
            for (int dd = 0; dd < 64; ++dd) d += qs[dd] * km[dd];
            gs = d; }
        if (lane >= 32) gs = -INFINITY;
        bool sel = false;
        for (int it = 0; it < 3; ++it) { const float c = sel ? -INFINITY : gs; const float mxv = wave_max(c);
            const unsigned long long m0 = __ballot(!sel && lane < 32 && gs == mxv); const int idx = m0 ? __builtin_ctzll(m0) : -1; if (lane == idx) sel = true; }
        sel = sel && (lane < cur);
        const unsigned smask = (unsigned)__ballot(sel);
        float mr = -1e30f, lr = 0.f, o = 0.f;
        for (int j = 0; j <= cur; ++j) {
            const bool own = (j == cur);
            if (!own && !((smask >> j) & 1u)) continue;
            for (int c = 0; c < 4; ++c) {
                const int kpos = 256 * j + 64 * c + lane; const bool valid = kpos <= q;
                if (256 * j + 64 * c > q) break;
                const float d = dot1(qs, Y + ((size_t)b * S_ + kpos) * YP + Y_CK + h * 64);
                const int bk = t5_bucket(q - kpos);
                const float s = valid ? d + rel[bk * 16 + 8 + h] * LOG2E : -1e30f;
                const float mn = fmaxf(mr, wave_max(s)); const float p = valid ? exp2f(s - mn) : 0.f;
                WFENCE(); s2[lane] = p; WFENCE();
                const float scl = exp2f(mr - mn); lr = lr * scl + wave_sum(p); o *= scl; mr = mn;
                const bf16* vb = Y + ((size_t)b * S_ + 256 * j + 64 * c) * YP + Y_CV + h * 64 + lane;
                for (int kk = 0; kk < 64; ++kk) o += s2[kk] * bf2f(vb[(size_t)kk * YP]);
            }
        }
        Yr[Y_CQ + h * 64 + lane] = (bf16)f2bf(o / fmaxf(lr, 1e-20f));
    }
}
constexpr int CW_Q = 8192;
__device__ __forceinline__ int next_unit(Frame& F, int k) {
    __syncthreads();
    if (F.tid == 0) F.MISC[16] = __hip_atomic_fetch_add(F.ctl + CW_Q + 64 * k, 1u, RLX_AGENT);
    __syncthreads();
    return (int)F.MISC[16];
}
__device__ __forceinline__ int next_unit_x(Frame& F, int qs, int nper, int x0, int& xo, int& xq) {
    for (;;) { if (xo >= 8) return -1; xq = (x0 + xo) & 7; const int i = next_unit(F, qs * 8 + xq); if (i < nper) return i; ++xo; }
}
__device__ __forceinline__ void moba_fast(Frame& F, const Args& a, int qk) {
    bf16* Y = (bf16*)(a.ws + WS_Y); const float* KM = (const float*)(a.ws + WS_KMEAN);
    const int x0 = (int)(xb_xcc_id() & 7u); int xo = 0, xq = 0;
    for (;;) {
        const int i = next_unit_x(F, qk, 128, x0, xo, xq); if (i < 0) break;
        const int qb = 31 - (i & 31), bh = xq + 8 * (i >> 5), b = bh >> 3, h = bh & 7; const long rowbase = (long)b * S_;
        attn::UArgs U{};
        U.Qb = Y + (rowbase + qb * 256) * YP + Y_CQ + h * 64; U.Kh = Y + rowbase * YP + Y_CK + h * 64; U.Vh = Y + rowbase * YP + Y_CV + h * 64; U.Ob = Y + (rowbase + qb * 256) * YP + Y_CQ + h * 64;
        U.NT = 4 * (qb + 1); U.q0 = qb * 256; U.kt0 = 0; U.hc = 8 + h; U.rel = a.in[1]; U.km = KM + (size_t)bh * 32 * 64; U.qb = qb;
        attn::attn_unit<0, 0, 8>(U, (char*)F.lds + RING_OFF);
    }
}
__device__ __forceinline__ void nsa_fast(Frame& F, const Args& a, int qk) {
    bf16* Y = (bf16*)(a.ws + WS_Y);
    const int x0 = (int)(xb_xcc_id() & 7u); int xo = 0, xq = 0;
    for (;;) {
        const int i = next_unit_x(F, qk, 128, x0, xo, xq); if (i < 0) break;
        const int qb = 31 - (i & 31), b = xq >> 1, g = xq & 1, h = g * 4 + (i >> 5); const long rowbase = (long)b * S_; const int q0 = qb * 256;
        attn::UArgs U{};
        U.Qb = Y + (rowbase + q0) * YP + Y_AQ + h * 64; U.Ob = Y + (rowbase + q0) * YP + Y_AQ + h * 64; U.q0 = q0; U.hc = h; U.rel = a.in[1]; U.gate = Y + (rowbase + q0) * YP;
        { const int T0 = 4 * qb - 8 > 0 ? 4 * qb - 8 : 0;
          U.Kh = Y + (rowbase + 64 * T0) * YP + Y_AKW + g * 64; U.Vh = Y + (rowbase + 64 * T0) * YP + Y_AVW + g * 64; U.NT = 4 * qb + 4 - T0; U.kt0 = 64 * T0; U.gcol = Y_AG + h * 3 + 2;
          attn::attn_unit<2, 1, 8>(U, (char*)F.lds + RING_OFF); }
        { U.Kh = Y + rowbase * YP + Y_AKS + g * 64; U.Vh = Y + rowbase * YP + Y_AVS + g * 64; U.NT = 4 * (qb + 1); U.kt0 = 0; U.gcol = Y_AG + h * 3 + 1;
          U.selg = (const unsigned*)(a.ws + WS_MASK) + ((size_t)(b * 2 + g) * S_ + q0) * 4; U.tmp = (const bf16*)(a.ws + WS_OATMP) + (rowbase + q0) * 512 + h * 64;
          attn::attn_unit<1, 2, 8>(U, (char*)F.lds + RING_OFF); }
    }
}
typedef float f32x16g __attribute__((ext_vector_type(16)));
constexpr int GP = 72;
constexpr int GL_GS = 0;
constexpr int GL_VT = 16640 + 0;
constexpr int GL_A0 = GL_VT + 128 * GP * 2;
constexpr int GL_A1 = GL_A0 + 64 * GP * 2;
constexpr int GL_A2 = GL_A1 + 64 * GP * 2;
constexpr int GL_SS = GL_A2 + 64 * GP * 2;
constexpr int GL_END = GL_SS + 1024;
static_assert(GL_END <= RING_BYTES, "GLA LDS map");
__device__ __forceinline__ int crow32(int r, int hi) { return (r & 3) + 8 * (r >> 2) + 4 * hi; }
__device__ __forceinline__ bf16x8 lds_frag(const LAS bf16* X, int row, int kk) { return *(const LAS bf16x8*)(X + row * GP + kk); }
__device__ __forceinline__ float sum16(float v) {
    v += __int_as_float(__builtin_amdgcn_update_dpp(0, __float_as_int(v), 0xB1, 0xf, 0xf, true));
    v += __int_as_float(__builtin_amdgcn_update_dpp(0, __float_as_int(v), 0x4E, 0xf, 0xf, true));
    v += __int_as_float(__builtin_amdgcn_update_dpp(0, __float_as_int(v), 0x141, 0xf, 0xf, true));
    v += __int_as_float(__builtin_amdgcn_update_dpp(0, __float_as_int(v), 0x140, 0xf, 0xf, true));
    return v;
}
__device__ __forceinline__ void gla_put_vT(LAS bf16* vT, const v4u w0, const v4u w1, int w, int lane) {
    const unsigned ww[8] = {w0.x, w0.y, w0.z, w0.w, w1.x, w1.y, w1.z, w1.w};
#pragma unroll
    for (int i = 0; i < 8; ++i) { vT[(w * 16 + 2 * i) * GP + lane] = (bf16)(ww[i] & 0xffffu); vT[(w * 16 + 2 * i + 1) * GP + lane] = (bf16)(ww[i] >> 16); }
}
__device__ __forceinline__ void gla_g1(Frame& F, const Args& a, int l) {
    const bf16* Y = (const bf16*)(a.ws + WS_Y); bf16* GST = (bf16*)(a.ws + WS_GST); float* DEC = (float*)(a.ws + WS_GDEC); float* BC = (float*)(a.ws + WS_BCUM);
    LAS bf16* vT = (LAS bf16*)(F.lds + RING_OFF + GL_VT); LAS bf16* kT = (LAS bf16*)(F.lds + RING_OFF + GL_A0);
    const int lane = F.lane, r32 = lane & 31, hi = lane >> 5, w = F.wave;
    for (int u = blockIdx.x; u < 2048; u += F.G) {
        const int c = u & 127, bh = u >> 7, h = bh & 3, b = bh >> 2; const size_t row = (size_t)b * S_ + c * 64 + lane; const bf16* Yt = Y + row * YP;
        const v4u bl0 = *(const v4u*)(Yt + Y_BLR), bl1 = *(const v4u*)(Yt + Y_BLR + 8), kw = *(const v4u*)(Yt + Y_BK + h * 64 + 8 * w);
        const v4u vw0 = *(const v4u*)(Yt + Y_BV + h * 128 + 16 * w), vw1 = *(const v4u*)(Yt + Y_BV + h * 128 + 16 * w + 8);
        const float* w2 = a.in[13] + (size_t)l * 16 * 256 + h * 64 + 8 * w; const float* bias = a.in[14] + (size_t)l * 256 + h * 64 + 8 * w;
        float blr[16]; { float k0[8], k1[8]; unpack8(bl0, k0); unpack8(bl1, k1);
#pragma unroll
            for (int i = 0; i < 8; ++i) { blr[i] = k0[i]; blr[8 + i] = k1[i]; } }
        float bc[8];
#pragma unroll
        for (int i = 0; i < 8; ++i) { float z = bias[i];
#pragma unroll
            for (int r = 0; r < 16; ++r) z += blr[r] * w2[r * 256 + i];
            float v = -(fmaxf(-z, 0.f) + __logf(1.f + __expf(-fabsf(z)))) * (1.f / 16.f);
#pragma unroll
            for (int o = 1; o < 64; o <<= 1) { const float n = __shfl_up(v, o); v += lane >= o ? n : 0.f; }
            bc[i] = v; }
        { float* bcp = BC + row * 256 + h * 64 + 8 * w; *(f32x4*)bcp = (f32x4){bc[0], bc[1], bc[2], bc[3]}; *(f32x4*)(bcp + 4) = (f32x4){bc[4], bc[5], bc[6], bc[7]}; }
        { float kk[8]; unpack8(kw, kk);
#pragma unroll
          for (int i = 0; i < 8; ++i) { const float bl = __shfl(bc[i], 63); kT[(8 * w + i) * GP + lane] = (bf16)f2bf(kk[i] * __expf(bl - bc[i])); if (lane == i) DEC[(size_t)u * 64 + 8 * w + i] = __expf(bl); } }
        gla_put_vT(vT, vw0, vw1, w, lane);
        __syncthreads();
        { const int et = w >> 1, dt = w & 1; f32x16g acc = {};
#pragma unroll
          for (int ks = 0; ks < 4; ++ks) acc = __builtin_amdgcn_mfma_f32_32x32x16_bf16(lds_frag(vT, et * 32 + r32, ks * 16 + hi * 8), lds_frag(kT, dt * 32 + r32, ks * 16 + hi * 8), acc, 0, 0, 0);
          bf16* slot = GST + (size_t)u * 8192;
#pragma unroll
          for (int r = 0; r < 16; ++r) slot[(et * 32 + crow32(r, hi)) * 64 + dt * 32 + r32] = (bf16)f2bf(acc[r]); }
        __syncthreads();
    }
}
__device__ __forceinline__ void gla_g2(Frame& F, const Args& a) {
    unsigned* GST = (unsigned*)(a.ws + WS_GST); const float* DEC = (const float*)(a.ws + WS_GDEC);
    for (int i = blockIdx.x * 512 + F.tid; i < 16 * 128 * 32; i += F.G * 512) {
        const int dp = i & 31, bh = i >> 12; const int eo = (i >> 5) & 127;
        float s0 = 0.f, s1 = 0.f;
        for (int c0 = 0; c0 < 128; c0 += 8) {
            unsigned uu[8]; float d0[8], d1[8];
#pragma unroll
            for (int j = 0; j < 8; ++j) { const size_t sl = (size_t)(bh * 128 + c0 + j); uu[j] = GST[sl * 4096 + eo * 32 + dp]; d0[j] = DEC[sl * 64 + 2 * dp]; d1[j] = DEC[sl * 64 + 2 * dp + 1]; }
#pragma unroll
            for (int j = 0; j < 8; ++j) { const size_t sl = (size_t)(bh * 128 + c0 + j); GST[sl * 4096 + eo * 32 + dp] = pk2(s0, s1);
                s0 = s0 * d0[j] + __uint_as_float(uu[j] << 16); s1 = s1 * d1[j] + __uint_as_float(uu[j] & 0xffff0000u); }
        }
    }
}
__device__ __forceinline__ void gla_g3(Frame& F, const Args& a, int l, int qk) {
    bf16* Y = (bf16*)(a.ws + WS_Y); const bf16* GST = (const bf16*)(a.ws + WS_GST); const float* nw = a.in[15] + (size_t)l * 128; const float* BC = (const float*)(a.ws + WS_BCUM);
    LAS bf16* vT = (LAS bf16*)(F.lds + RING_OFF + GL_VT);
    LAS bf16* qd = (LAS bf16*)(F.lds + RING_OFF + GL_A0); LAS bf16* kd = (LAS bf16*)(F.lds + RING_OFF + GL_A1); LAS bf16* at = (LAS bf16*)(F.lds + RING_OFF + GL_A2);
    LAS float* ssq = (LAS float*)(F.lds + RING_OFF + GL_SS);
    const int lane = F.lane, r32 = lane & 31, hi = lane >> 5, w = F.wave, rb = w >> 2, et = w & 3;
    const int x0 = (int)(xb_xcc_id() & 7u); int xo = 0, xq = 0;
    for (;;) {
        const int i3 = next_unit_x(F, qk, 256, x0, xo, xq); if (i3 < 0) break;
        const int u = xq * 256 + i3;
        const int c = u & 127, bh = u >> 7, h = bh & 3, b = bh >> 2; bf16* Yc = Y + ((size_t)b * S_ + c * 64) * YP; const bf16* Yt = Yc + (size_t)lane * YP;
        const v4u qw = *(const v4u*)(Yt + Y_BQ + h * 64 + 8 * w), kw = *(const v4u*)(Yt + Y_BK + h * 64 + 8 * w);
        const v4u vw0 = *(const v4u*)(Yt + Y_BV + h * 128 + 16 * w), vw1 = *(const v4u*)(Yt + Y_BV + h * 128 + 16 * w + 8);
        const float* bcp = BC + ((size_t)b * S_ + c * 64 + lane) * 256 + h * 64 + 8 * w; const f32x4 bc0 = *(const f32x4*)bcp, bc1 = *(const f32x4*)(bcp + 4);
        bf16x8 sb[4]; { const bf16* slot = GST + (size_t)u * 8192 + (size_t)(et * 32 + r32) * 64 + hi * 8;
#pragma unroll
            for (int ks = 0; ks < 4; ++ks) sb[ks] = *(const bf16x8*)(slot + ks * 16); }
        bf16 rr[16];
#pragma unroll
        for (int r = 0; r < 16; ++r) rr[r] = Yc[(size_t)(rb * 32 + crow32(r, hi)) * YP + Y_BR + h * 128 + et * 32 + r32];
        const float nwe = nw[et * 32 + r32];
        { float qq[8], kk[8]; unpack8(qw, qq); unpack8(kw, kk); const float bc[8] = {bc0.x, bc0.y, bc0.z, bc0.w, bc1.x, bc1.y, bc1.z, bc1.w}; unsigned qa[4], ka[4];
#pragma unroll
          for (int i = 0; i < 4; ++i) { qa[i] = pk2(qq[2 * i] * __expf(bc[2 * i]), qq[2 * i + 1] * __expf(bc[2 * i + 1])); ka[i] = pk2(kk[2 * i] * __expf(-bc[2 * i]), kk[2 * i + 1] * __expf(-bc[2 * i + 1])); }
          v4u qo, ko; qo.x = qa[0]; qo.y = qa[1]; qo.z = qa[2]; qo.w = qa[3]; ko.x = ka[0]; ko.y = ka[1]; ko.z = ka[2]; ko.w = ka[3];
          *(LAS v4u*)(qd + lane * GP + 8 * w) = qo; *(LAS v4u*)(kd + lane * GP + 8 * w) = ko; }
        gla_put_vT(vT, vw0, vw1, w, lane);
        __syncthreads();
        if (w < 4) { const int ib = w >> 1, jb = w & 1;
            if (jb <= ib) { f32x16g acc = {};
#pragma unroll
                for (int ks = 0; ks < 4; ++ks) acc = __builtin_amdgcn_mfma_f32_32x32x16_bf16(lds_frag(qd, ib * 32 + r32, ks * 16 + hi * 8), lds_frag(kd, jb * 32 + r32, ks * 16 + hi * 8), acc, 0, 0, 0);
#pragma unroll
                for (int r = 0; r < 16; ++r) { const int i = ib * 32 + crow32(r, hi), j = jb * 32 + r32; at[i * GP + j] = (bf16)f2bf(j <= i ? acc[r] : 0.f); } } }
        __syncthreads();
        { f32x16g acc = {};
#pragma unroll
          for (int ks = 0; ks < 4; ++ks) acc = __builtin_amdgcn_mfma_f32_32x32x16_bf16(lds_frag(qd, rb * 32 + r32, ks * 16 + hi * 8), sb[ks], acc, 0, 0, 0);
          for (int ks = 0; ks < 2 * (rb + 1); ++ks) acc = __builtin_amdgcn_mfma_f32_32x32x16_bf16(lds_frag(at, rb * 32 + r32, ks * 16 + hi * 8), lds_frag(vT, et * 32 + r32, ks * 16 + hi * 8), acc, 0, 0, 0);
          float sq[16];
#pragma unroll
          for (int r = 0; r < 16; ++r) { float v = sum16(acc[r] * acc[r]); v += __shfl_xor(v, 16); sq[r] = v; }
          if (r32 == 0) {
#pragma unroll
              for (int r = 0; r < 16; ++r) ssq[w * 32 + crow32(r, hi)] = sq[r]; }
          __syncthreads();
#pragma unroll
          for (int r = 0; r < 16; ++r) { const int tr = crow32(r, hi); const float tot = ssq[(rb * 4 + 0) * 32 + tr] + ssq[(rb * 4 + 1) * 32 + tr] + ssq[(rb * 4 + 2) * 32 + tr] + ssq[(rb * 4 + 3) * 32 + tr];
              const float rv = bf2f(rr[r]);
              Yc[(size_t)(rb * 32 + tr) * YP + Y_BR + h * 128 + et * 32 + r32] = (bf16)f2bf(acc[r] * rsqrtf(tot * (1.f / 128.f) + NORM_EPS) * nwe * (rv * sigm(rv))); } }
    }
}
constexpr int CL_IMP = 0, CL_BIAS = 64 * 129 * 4, CL_K = CL_BIAS + 2048, CL_GATE = CL_K + 512 * GP * 2, CL_END = CL_GATE + 1024;
static_assert(CL_END <= RING_BYTES && (CL_K % 16) == 0, "cmp LDS map");
__device__ __forceinline__ int red8(int v) {
    v += __builtin_amdgcn_update_dpp(0, v, 0xB1, 0xf, 0xf, true);
    v += __builtin_amdgcn_update_dpp(0, v, 0x4E, 0xf, 0xf, true);
    v += __builtin_amdgcn_update_dpp(0, v, 0x141, 0xf, 0xf, true);
    return v;
}
typedef unsigned u32x2g __attribute__((ext_vector_type(2)));
struct VFrag { u32x2g a[8]; };
__device__ __forceinline__ void cmp_load_v(VFrag& f, const bf16* VT, int nt, int r32, int hi) {
#pragma unroll
    for (int dt = 0; dt < 2; ++dt)
#pragma unroll
        for (int kk = 0; kk < 2; ++kk) { const bf16* vp = VT + (size_t)(dt * 32 + r32) * 512 + nt * 32 + kk * 16 + 4 * hi; f.a[(dt * 2 + kk) * 2] = *(const u32x2g*)vp; f.a[(dt * 2 + kk) * 2 + 1] = *(const u32x2g*)(vp + 8); }
}
__device__ __forceinline__ void nsa_cmp_fast(Frame& F, const Args& a, int qk) {
    const bf16* Y = (const bf16*)(a.ws + WS_Y); const float* rel = a.in[1];
    LAS unsigned* impI = (LAS unsigned*)(F.lds + RING_OFF + CL_IMP); LAS float* biasT = (LAS float*)(F.lds + RING_OFF + CL_BIAS); LAS bf16* Ks = (LAS bf16*)(F.lds + RING_OFF + CL_K);
    const int lane = F.lane, r32 = lane & 31, hi = lane >> 5, w = F.wave, hr = w >> 1, qh = w & 1;
    const int x0 = (int)(xb_xcc_id() & 7u); int xo = 0, xq = 0;
    for (;;) {
        const int i = next_unit_x(F, qk, 128, x0, xo, xq); if (i < 0) break;
        const int c = 127 - i, bg = xq, g = bg & 1, b = bg >> 1, q0 = 64 * c; const size_t rowbase = (size_t)b * S_;
        const bf16* KC = (const bf16*)(a.ws + WS_KCMP) + (size_t)bg * 512 * 64; const bf16* VT = (const bf16*)(a.ws + WS_VCMPT) + (size_t)bg * 64 * 512;
        const int head = g * 4 + hr, qw0 = q0 + qh * 32, qpos = qw0 + r32;
        const int NTw = (qw0 / 16 + 1 + 31) >> 5;
        const int nrows = (((q0 + 32) / 16 + 1 + 31) >> 5) * 32;
        { v4u kv[8]; int tl = F.tid; asm volatile("" : "+v"(tl));
          const unsigned o0_ = (unsigned)((tl >> 3) * 64 + (tl & 7) * 8);
#pragma unroll
          for (int j = 0; j < 8; ++j) { const int p = tl + 512 * j; if (p < nrows * 8) kv[j] = *(const v4u*)(KC + o0_ + 4096u * j); }
          for (int ii = F.tid; ii < 64 * 129; ii += 512) impI[ii] = 0u;
          { const int hh = F.tid >> 7, dd = F.tid & 127; biasT[F.tid] = (rel[t5_bucket(dd) * 16 + g * 4 + hh] - rel[31 * 16 + g * 4 + hh]) * LOG2E; }
#pragma unroll
          for (int j = 0; j < 8; ++j) { const int p = tl + 512 * j; if (p < nrows * 8) *(LAS v4u*)(Ks + ((tl >> 3) + 64 * j) * GP + (tl & 7) * 8) = kv[j]; } }
        const bf16* Qw = Y + (rowbase + qw0) * YP + Y_AQ + head * 64;
        bf16x8 qr[4];
#pragma unroll
        for (int ks = 0; ks < 4; ++ks) qr[ks] = *(const bf16x8*)(Qw + (size_t)r32 * YP + ks * 16 + hi * 8);
        if (hi == 0) ((LAS float*)(F.lds + RING_OFF + CL_GATE))[w * 32 + r32] = sigm(bf2f(Y[(rowbase + qw0 + r32) * YP + Y_AG + head * 3]));
        __syncthreads();
        const LAS float* bT = biasT + hr * 128;
        float lsum = 0.f;
#pragma unroll 1
        for (int nt = 0; nt < NTw; ++nt) { f32x16g C = {};
#pragma unroll
            for (int ks = 0; ks < 4; ++ks) C = __builtin_amdgcn_mfma_f32_32x32x16_bf16(lds_frag(Ks, nt * 32 + r32, ks * 16 + hi * 8), qr[ks], C, 0, 0, 0);
#pragma unroll
            for (int r = 0; r < 16; ++r) { const int dist = qpos - (16 * (nt * 32 + crow32(r, hi)) + 31); lsum += dist >= 0 ? __builtin_amdgcn_exp2f(fminf(C[r] + bT[dist > 127 ? 127 : (dist < 0 ? 0 : dist)], 100.f)) : 0.f; } }
        { auto rr = __builtin_amdgcn_permlane32_swap(__float_as_uint(lsum), __float_as_uint(lsum), false, false); lsum = __uint_as_float(rr[0]) + __uint_as_float(rr[1]); }
        const float inv = 1.f / fmaxf(lsum, 1e-30f);
        f32x16g o0 = {}, o1 = {};
#pragma unroll 1
        for (int nt = 0; nt < NTw; ++nt) {
            VFrag vcur; cmp_load_v(vcur, VT, nt, r32, hi);
            f32x16g C = {};
#pragma unroll
            for (int ks = 0; ks < 4; ++ks) C = __builtin_amdgcn_mfma_f32_32x32x16_bf16(lds_frag(Ks, nt * 32 + r32, ks * 16 + hi * 8), qr[ks], C, 0, 0, 0);
            float p[16];
#pragma unroll
            for (int r = 0; r < 16; ++r) { const int dist = qpos - (16 * (nt * 32 + crow32(r, hi)) + 31); p[r] = dist >= 0 ? __builtin_amdgcn_exp2f(fminf(C[r] + bT[dist > 127 ? 127 : (dist < 0 ? 0 : dist)], 100.f)) * inv : 0.f; }
#pragma unroll
            for (int m = 0; m < 4; ++m) { const float G = (p[4 * m] + p[4 * m + 1]) + (p[4 * m + 2] + p[4 * m + 3]); const int j = nt * 8 + 2 * m + hi;
                LAS unsigned* ip = impI + (qh * 32 + r32) * 129 + j;
                __hip_atomic_fetch_add(ip, (unsigned)(G * 67108864.f + 0.5f), __ATOMIC_RELAXED, __HIP_MEMORY_SCOPE_WORKGROUP);
                if (j + 1 < 128) __hip_atomic_fetch_add(ip + 1, (unsigned)(p[4 * m + 3] * 67108864.f + 0.5f), __ATOMIC_RELAXED, __HIP_MEMORY_SCOPE_WORKGROUP); }
            v4u pw0, pw1; pw0.x = pk2(p[0], p[1]); pw0.y = pk2(p[2], p[3]); pw0.z = pk2(p[4], p[5]); pw0.w = pk2(p[6], p[7]); pw1.x = pk2(p[8], p[9]); pw1.y = pk2(p[10], p[11]); pw1.z = pk2(p[12], p[13]); pw1.w = pk2(p[14], p[15]);
            const bf16x8 pa0 = __builtin_bit_cast(bf16x8, pw0), pa1 = __builtin_bit_cast(bf16x8, pw1);
#pragma unroll
            for (int dt = 0; dt < 2; ++dt)
#pragma unroll
                for (int kk = 0; kk < 2; ++kk) { v4u vv; vv.x = vcur.a[(dt * 2 + kk) * 2].x; vv.y = vcur.a[(dt * 2 + kk) * 2].y; vv.z = vcur.a[(dt * 2 + kk) * 2 + 1].x; vv.w = vcur.a[(dt * 2 + kk) * 2 + 1].y;
                    if (dt == 0) o0 = __builtin_amdgcn_mfma_f32_32x32x16_bf16(kk ? pa1 : pa0, __builtin_bit_cast(bf16x8, vv), o0, 0, 0, 0);
                    else o1 = __builtin_amdgcn_mfma_f32_32x32x16_bf16(kk ? pa1 : pa0, __builtin_bit_cast(bf16x8, vv), o1, 0, 0, 0); }
            }
        { bf16* T = (bf16*)(a.ws + WS_OATMP);
#pragma unroll
          for (int r = 0; r < 16; ++r) { const size_t row = rowbase + qw0 + crow32(r, hi); const float gs = ((const LAS float*)(F.lds + RING_OFF + CL_GATE))[w * 32 + crow32(r, hi)];
              T[row * 512 + head * 64 + r32] = (bf16)f2bf(gs * o0[r]); T[row * 512 + head * 64 + 32 + r32] = (bf16)f2bf(gs * o1[r]); } }
        __syncthreads();
        { const int qi = F.tid >> 3, part = F.tid & 7, cur = c; unsigned key[16];
#pragma unroll
          for (int i2 = 0; i2 < 16; ++i2) { const int j = part * 16 + i2; const unsigned raw = impI[qi * 129 + j] >> 6; const bool forced = (j == 0) || (j == cur) || (j == cur - 1);
              key[i2] = forced ? (0xFFFFFF80u | (unsigned)(127 - j)) : (j <= cur ? ((((raw > 33554430u ? 33554430u : raw) + 1u) << 7) | (unsigned)(127 - j)) : (unsigned)(127 - j)); }
          unsigned T = 0u;
          for (int bit = 31; bit >= 0; --bit) { const unsigned Tt = T | (1u << bit); int cnt = 0;
#pragma unroll
              for (int i2 = 0; i2 < 16; ++i2) cnt += key[i2] >= Tt ? 1 : 0;
              cnt = red8(cnt); if (cnt >= 16) T = Tt; }
          unsigned bits = 0u;
#pragma unroll
          for (int i2 = 0; i2 < 16; ++i2) bits |= (key[i2] >= T && (part * 16 + i2) <= cur) ? (1u << i2) : 0u;
          ((unsigned short*)(a.ws + WS_MASK))[((size_t)bg * S_ + q0 + qi) * 8 + part] = (unsigned short)bits; }
    }
}
constexpr int CP_RED = 0, CP_HS = 8 * 32 * 64 * 4, CP_END = CP_HS + 32 * GP * 2;
static_assert(CP_END <= RING_BYTES, "compress LDS map");
__device__ __forceinline__ void compress_fast(Frame& F, const Args& a) {
    const bf16* Y = (const bf16*)(a.ws + WS_Y);
    LAS float* red = (LAS float*)(F.lds + RING_OFF + CP_RED); LAS bf16* hs = (LAS bf16*)(F.lds + RING_OFF + CP_HS);
    const int lane = F.lane, r32 = lane & 31, hi = lane >> 5, w = F.wave;
    for (int u = blockIdx.x; u < 256; u += F.G) {
        const int nt = u & 15, bg = (u >> 4) & 7, kv = u >> 7, g = bg & 1, b = bg >> 1;
        const int n = nt * 32 + r32, nn = n > 510 ? 510 : n;
        const bf16* xrow = Y + ((size_t)b * S_ + 16 * nn) * YP + (kv ? Y_AVC : Y_AKC) + g * 64 + hi * 8;
        const bf16* W1T = (const bf16*)(a.ws + WS_CW1T) + (size_t)kv * 64 * 2048;
        f32x16g acc0 = {}, acc1 = {};
#pragma unroll 4
        for (int s = 0; s < 16; ++s) { const int ks = w * 16 + s, pos = ks >> 2;
            const bf16x8 af = *(const bf16x8*)(xrow + (size_t)pos * YP + (ks & 3) * 16);
            const bf16x8 b0 = *(const bf16x8*)(W1T + (size_t)r32 * 2048 + ks * 16 + hi * 8), b1 = *(const bf16x8*)(W1T + (size_t)(32 + r32) * 2048 + ks * 16 + hi * 8);
            acc0 = __builtin_amdgcn_mfma_f32_32x32x16_bf16(af, b0, acc0, 0, 0, 0); acc1 = __builtin_amdgcn_mfma_f32_32x32x16_bf16(af, b1, acc1, 0, 0, 0); }
#pragma unroll
        for (int r = 0; r < 16; ++r) { red[(w * 32 + crow32(r, hi)) * 64 + r32] = acc0[r]; red[(w * 32 + crow32(r, hi)) * 64 + 32 + r32] = acc1[r]; }
        __syncthreads();
        { const float* c0 = (const float*)(a.ws + WS_CC0) + kv * 64;
#pragma unroll
          for (int i = 0; i < 4; ++i) { const int e = F.tid * 4 + i, rn = e >> 6, j = e & 63; float v = c0[j];
#pragma unroll
              for (int ww = 0; ww < 8; ++ww) v += red[(ww * 32 + rn) * 64 + j];
              hs[rn * GP + j] = (bf16)f2bf(gelu_tanh(v)); } }
        __syncthreads();
        if (w < 2) { const bf16* W2T = (const bf16*)(a.ws + WS_CW2T) + (size_t)kv * 64 * 64; f32x16g o = {};
#pragma unroll
            for (int ks = 0; ks < 4; ++ks) { const bf16x8 bf = *(const bf16x8*)(W2T + (size_t)(w * 32 + r32) * 64 + ks * 16 + hi * 8);
                o = __builtin_amdgcn_mfma_f32_32x32x16_bf16(lds_frag(hs, r32, ks * 16 + hi * 8), bf, o, 0, 0, 0); }
#pragma unroll
            for (int r = 0; r < 16; ++r) { const int rn = nt * 32 + crow32(r, hi), jp = w * 32 + r32;
                if (kv == 0) ((bf16*)(a.ws + WS_KCMP))[((size_t)bg * 512 + rn) * 64 + jp] = (bf16)f2bf(o[r]);
                else ((bf16*)(a.ws + WS_VCMPT))[((size_t)bg * 64 + jp) * 512 + rn] = (bf16)f2bf(o[r]); } }
        __syncthreads();
    }
}
__device__ __forceinline__ void gla_out_naive(Frame& F, const Args& a, int l) {
    const int gw = blockIdx.x * NWAVES + F.wave, NGW = F.G * NWAVES, lane = F.lane;
    bf16* Y = (bf16*)(a.ws + WS_Y); const bf16* O16 = (const bf16*)(a.ws + WS_O16); const float* nw = a.in[15] + (size_t)l * 128;
    for (int t = gw; t < M_ * 4; t += NGW) {
        const int h = t & 3; const size_t row = (size_t)(t >> 2);
        const float o0 = bf2f(O16[row * 512 + h * 128 + lane]), o1 = bf2f(O16[row * 512 + h * 128 + 64 + lane]);
        const float r = rsqrtf(wave_sum(o0 * o0 + o1 * o1) * (1.f / 128.f) + NORM_EPS);
        bf16* yr = Y + row * YP + Y_BR + h * 128;
        const float r0 = bf2f(yr[lane]), r1 = bf2f(yr[64 + lane]);
        yr[lane] = (bf16)f2bf(o0 * r * nw[lane] * (r0 * sigm(r0))); yr[64 + lane] = (bf16)f2bf(o1 * r * nw[64 + lane] * (r1 * sigm(r1)));
    }
}

__device__ __forceinline__ Frame fresh(const Frame& F) { Frame f = F; int t = threadIdx.x; asm volatile("" : "+v"(t)); f.tid = t; f.lane = t & 63; return f; }
constexpr int PPL = 11, NPH = NL * PPL;
#define IN(k) (lo <= (k) && (k) < hi)
#define SEAM(k) do { if (IN(k) && IN((k) + 1)) xcd_barrier(bar); } while (0)
template <int l> __device__ __forceinline__ void layer_body(Frame& F0, const Args& args, const XcdBarrier& bar, const int lo, const int hi) {
    unsigned char* ws = args.ws;
    bf16* H = (bf16*)(ws + WS_H); bf16* Y = (bf16*)(ws + WS_Y); unsigned char* G8 = ws + WS_G8;
    float* Yf = (float*)(ws + WS_Y); bf16* ACT = (bf16*)(ws + WS_ACT);
    constexpr int p0 = l * PPL;
    const float* xin = l == 0 ? args.in[0] : args.out;
    if (IN(p0 + 0)) { Frame F = fresh(F0); phase_weights(F, args, l); if (l == 0) phase_norm0(F, args.in[0], args.in[2], H); SEAM(p0 + 0); }
    if (IN(p0 + 1)) { Frame F = fresh(F0);
        pg8::Gemm g{H, (const bf16*)(ws + WS_WIN), M_, NIN, DM, DM}; pg8::StaticOrder So; So.init(M_, NIN, F.G, (int)blockIdx.x);
        pg8::EpiInProj E{Y, G8};
        pg8::gemm_phase<pg8::EpiInProj, pg8::StaticOrder, true, true>(F.lds + RING_OFF, g, So, E);
        SEAM(p0 + 1);
    }
    if (IN(p0 + 2)) { { Frame F = fresh(F0); compress_fast(F, args); } { Frame F = fresh(F0); phase2_naive(F, args, l); } { Frame F = fresh(F0); gla_g1(F, args, l); } SEAM(p0 + 2); }
    if (IN(p0 + 3)) { { Frame F = fresh(F0); gla_g2(F, args); } { Frame F = fresh(F0); moba_fast(F, args, l * 4 + 0); } { Frame F = fresh(F0); nsa_cmp_fast(F, args, l * 4 + 1); } SEAM(p0 + 3); }
    if (IN(p0 + 4)) { { Frame F = fresh(F0); nsa_fast(F, args, l * 4 + 2); } { Frame F = fresh(F0); gla_g3(F, args, l, l * 4 + 3); } SEAM(p0 + 4); }
    if (IN(p0 + 5)) { Frame F = fresh(F0);
        pg8::StaticOrder So; So.init(M_, DM, F.G, (int)blockIdx.x);
        { pg8::Gemm g{Y + Y_AQ, (const bf16*)(ws + WS_WA), M_, DM, 512, YP}; pg8::EpiMerge<0> E{H, G8}; pg8::gemm_phase<pg8::EpiMerge<0>, pg8::StaticOrder, true, true>(F.lds + RING_OFF, g, So, E); }
        __syncthreads();
        { pg8::Gemm g{Y + Y_BR, (const bf16*)(ws + WS_WB), M_, DM, 512, YP}; pg8::EpiMerge<1> E{H, G8}; pg8::gemm_phase<pg8::EpiMerge<1>, pg8::StaticOrder, true, true>(F.lds + RING_OFF, g, So, E); }
        __syncthreads();
        { pg8::Gemm g{Y + Y_CQ, (const bf16*)(ws + WS_WC), M_, DM, 512, YP}; pg8::EpiMerge<2> E{H, G8}; pg8::gemm_phase<pg8::EpiMerge<2>, pg8::StaticOrder, true, true>(F.lds + RING_OFF, g, So, E); }
        SEAM(p0 + 5);
    }
    if (IN(p0 + 6)) { Frame F = fresh(F0);
        pg8::Gemm g{H, (const bf16*)(ws + WS_WO), M_, DM, DM, DM}; pg8::StaticOrder So; So.init(M_, DM, F.G, (int)blockIdx.x);
        pg8::EpiF32 E{Yf, DM}; pg8::gemm_phase<pg8::EpiF32, pg8::StaticOrder, true, true>(F.lds + RING_OFF, g, So, E);
        SEAM(p0 + 6);
    }
    if (IN(p0 + 7)) { Frame F = fresh(F0); phase_resid(F, Yf, xin, args.out, args.in[3] + (size_t)l * DM, args.in[4] + (size_t)l * DM, H); SEAM(p0 + 7); }
    if (IN(p0 + 8)) { Frame F = fresh(F0);
        pg8::Gemm g{H, (const bf16*)(ws + WS_WF1), M_, 2 * FF, DM, DM}; pg8::StaticOrder So; So.init(M_, 2 * FF, F.G, (int)blockIdx.x);
        pg8::EpiSwiglu E{ACT, FF}; pg8::gemm_phase<pg8::EpiSwiglu, pg8::StaticOrder, true, true>(F.lds + RING_OFF, g, So, E);
        SEAM(p0 + 8);
    }
    if (IN(p0 + 9)) { Frame F = fresh(F0);
        pg8::Gemm g{ACT, (const bf16*)(ws + WS_WF2), M_, DM, FF, FF}; pg8::StaticOrder So; So.init(M_, DM, F.G, (int)blockIdx.x);
        pg8::EpiF32 E{Yf, DM}; pg8::gemm_phase<pg8::EpiF32, pg8::StaticOrder, true, true>(F.lds + RING_OFF, g, So, E);
        SEAM(p0 + 9);
    }
    if (IN(p0 + 10)) { Frame F = fresh(F0); phase_resid(F, Yf, args.out, args.out, args.in[5] + (size_t)l * DM, l + 1 < NL ? args.in[2] + (size_t)(l + 1) * DM : nullptr, l + 1 < NL ? H : nullptr); SEAM(p0 + 10); }
}
__global__ void __launch_bounds__(NWAVES * 64, 2) mk_fwd(Args args) {
    extern __shared__ __attribute__((aligned(16))) unsigned char lds[];
    Frame F;
    F.lds = (LAS unsigned char*)lds; F.MISC = (volatile LAS unsigned*)(F.lds + MISC_OFF);
    F.tid = threadIdx.x; F.lane = F.tid & 63; F.wave = __builtin_amdgcn_readfirstlane(F.tid >> 6); F.G = gridDim.x;
    F.ctl = (gu32*)(args.ws + WS_CTL);
    for (int u = F.tid; u < (LDS_BYTES - LDSCTL_OFF) / 4; u += NWAVES * 64) ((LAS unsigned*)(F.lds + LDSCTL_OFF))[u] = 0u;
    __syncthreads();
    const int lo = args.ph_lo, hi = args.ph_hi;
    XcdBarrier bar; bar.bar = (unsigned*)(F.ctl + CW_BAR); bar.x = 0; bar.st = nullptr;
    if (hi - lo > 1) bar = xcd_barrier_post((unsigned*)(F.ctl + CW_BAR), F.MISC + 8);
    layer_body<0>(F, args, bar, lo, hi);
    layer_body<1>(F, args, bar, lo, hi);
}
#undef IN
#undef SEAM

#ifndef MK_ONE_LAUNCH
#define MK_ONE_LAUNCH 1
#endif
extern "C" void kernel_launch(void* const* d_in, const int* in_sizes, int n_in, void* d_out, int out_size, void* d_ws, size_t ws_size, hipStream_t stream) {
    static int grid = 0;
    if (grid == 0) {
        if (n_in != 22 || out_size != M_ * DM || ws_size < WS_END) { fprintf(stderr, "kernel_launch: unexpected sizes (n_in %d out %d ws %zu)\n", n_in, out_size, ws_size); grid = -1; return; }
        int dev = 0, cus = 0;
        if (hipGetDevice(&dev) != hipSuccess || hipDeviceGetAttribute(&cus, hipDeviceAttributeMultiprocessorCount, dev) != hipSuccess) { grid = -1; return; }
        if (hipFuncSetAttribute((const void*)mk_fwd, hipFuncAttributeMaxDynamicSharedMemorySize, LDS_BYTES) != hipSuccess) { grid = -1; return; }
        (void)hipGetLastError();
        grid = cus;
    }
    if (grid < 0) return;
    if (hipMemsetAsync((char*)d_ws + WS_CTL, 0, CTL_ZERO_BYTES, stream) != hipSuccess) return;
    Args a{};
    for (int i = 0; i < 22; ++i) a.in[i] = (const float*)d_in[i];
    a.out = (float*)d_out; a.ws = (unsigned char*)d_ws;
#if MK_ONE_LAUNCH
    a.ph_lo = 0; a.ph_hi = NPH;
    hipLaunchKernelGGL(mk_fwd, dim3(grid), dim3(NWAVES * 64), LDS_BYTES, stream, a);
#else
    for (int p = 0; p < NPH; ++p) { a.ph_lo = p; a.ph_hi = p + 1; hipLaunchKernelGGL(mk_fwd, dim3(grid), dim3(NWAVES * 64), LDS_BYTES, stream, a); }
#endif
}
```

```cpp
#include <hip/hip_runtime.h>
#include <cstdio>
#include <cstdint>
#include <cmath>
namespace pg8 {
#define PG8_LAS __attribute__((address_space(3)))
typedef unsigned short bf16_t;
typedef short bf16x8 __attribute__((ext_vector_type(8)));
typedef float f32x4 __attribute__((ext_vector_type(4)));
typedef unsigned u32x4 __attribute__((ext_vector_type(4)));
constexpr int BM = 256, BK = 64, HALF = 128, HTB = HALF * BK * 2  , STAGE_BYTES = 8 * HTB, NXCD = 8, WGM = 8;

__host__ __device__ __forceinline__ int lds_byte(int r, int c) { const int st = (r >> 4) * 2 + (c >> 5), rr = r & 15, cc = c & 31, ob = rr * 64 + cc * 2; return st * 1024 + (ob ^ (((ob >> 9) & 1) << 5)); }
__host__ __device__ __forceinline__ void stage_rc(int b, int& R, int& C) { const int st = b / 1024, sb = b % 1024, swz = sb ^ (((sb >> 9) & 1) << 5); R = (st >> 1) * 16 + swz / 64; C = (st & 1) * 32 + (swz % 64) / 2; }
__host__ __device__ __forceinline__ int perm32(int rho) { const int n = rho >> 4, i = rho & 15; return 8 * (i >> 2) + 4 * n + (i & 3); }

struct Unit { int pm, pn; };
struct Gemm { const bf16_t* A; const bf16_t* Bt; int M, N, K, lda; };

struct StaticOrder {
    int nM, nN, nwg, G, c;
    __host__ __device__ void init(int M, int N, int G_, int c_) { nM = M / BM; nN = N / BM; nwg = nM * nN; G = G_; c = c_; }
    __host__ __device__ bool next(int i, Unit& u) const {
        const long L = (long)i * G + c; if (L >= nwg) return false;
        int wgid = (int)L; { const int q = nwg / NXCD, r = nwg % NXCD, xcd = wgid % NXCD, off = wgid / NXCD; wgid = (xcd < r ? xcd * (q + 1) : r * (q + 1) + (xcd - r) * q) + off; }
        const int nig = WGM * nN, gid = wgid / nig, fm = gid * WGM, gsz = (nM - fm) < WGM ? (nM - fm) : WGM;
        u.pm = fm + ((wgid % nig) % gsz); u.pn = (wgid % nig) / gsz; return true;
    }
    __device__ __forceinline__ void a_ready(const Unit&) const {}
    __device__ __forceinline__ void done(const Unit&) const {}
};

__device__ __forceinline__ unsigned cvt_pk_bf16(float lo, float hi) { unsigned r; asm volatile("v_cvt_pk_bf16_f32 %0, %1, %2" : "=v"(r) : "v"(lo), "v"(hi)); return r; }
typedef float f32x2 __attribute__((ext_vector_type(2)));
constexpr int YP_ = 4392;
constexpr float C2_ = 0.125f * 1.4426950408889634f;
__device__ __forceinline__ float sigmoidf_(float v) { return 1.f / (1.f + __expf(-v)); }
struct EpiInProj {
    static constexpr bool PERM = true, AFTER_DRAIN = false;
    bf16_t* Y; unsigned char* G8;
    __device__ __forceinline__ void operator()(const f32x4 (&acc)[2][2][4][2], const Unit& u, int wr, int wc, int fr, int fq) const {
        const int row0 = u.pm * BM + wr * 64 + fr, colt = u.pn * BM, cin = wc * 32 + 8 * fq;
        if (u.pn < 18) {
            float sc = 1.f; if (u.pn < 2 || u.pn == 5 || u.pn == 6) sc = C2_; else if (u.pn == 11) sc = 0.125f;
#pragma unroll
            for (int ai = 0; ai < 2; ++ai)
#pragma unroll
                for (int m = 0; m < 4; ++m) { bf16_t* rowp = Y + (size_t)(row0 + ai * HALF + m * 16) * YP_;
#pragma unroll
                    for (int bj = 0; bj < 2; ++bj) { const int col = colt + cin + bj * HALF;
                        if (col + 8 <= YP_) { const f32x4 v0 = acc[ai][bj][m][0] * sc, v1 = acc[ai][bj][m][1] * sc; u32x4 w;
                            w.x = cvt_pk_bf16(v0[0], v0[1]); w.y = cvt_pk_bf16(v0[2], v0[3]); w.z = cvt_pk_bf16(v1[0], v1[1]); w.w = cvt_pk_bf16(v1[2], v1[3]);
                            *(u32x4*)(rowp + col) = w; } } }
        } else {
#pragma unroll
            for (int ai = 0; ai < 2; ++ai)
#pragma unroll
                for (int m = 0; m < 4; ++m) { unsigned char* rowp = G8 + (size_t)(row0 + ai * HALF + m * 16) * 3072 + (colt - 4608) + cin;
#pragma unroll
                    for (int bj = 0; bj < 2; ++bj) { const f32x4 v0 = acc[ai][bj][m][0], v1 = acc[ai][bj][m][1]; unsigned lo = 0u, hi = 0u;
#pragma unroll
                        for (int e = 0; e < 4; ++e) { lo |= (unsigned)(sigmoidf_(v0[e]) * 255.f + 0.5f) << (8 * e); hi |= (unsigned)(sigmoidf_(v1[e]) * 255.f + 0.5f) << (8 * e); }
                        typedef unsigned u32x2 __attribute__((ext_vector_type(2))); u32x2 w; w.x = lo; w.y = hi; *(u32x2*)(rowp + bj * HALF) = w; } }
        }
    }
};
template <int I> struct EpiMerge {
    static constexpr bool PERM = true, AFTER_DRAIN = false;
    bf16_t* Mg; const unsigned char* G8;
    __device__ __forceinline__ void operator()(const f32x4 (&acc)[2][2][4][2], const Unit& u, int wr, int wc, int fr, int fq) const {
        const int row0 = u.pm * BM + wr * 64 + fr, col0 = u.pn * BM + wc * 32 + 8 * fq;
#pragma unroll
        for (int ai = 0; ai < 2; ++ai)
#pragma unroll
            for (int m = 0; m < 4; ++m) { const size_t row = (size_t)(row0 + ai * HALF + m * 16);
#pragma unroll
                for (int bj = 0; bj < 2; ++bj) { const int col = col0 + bj * HALF;
                    typedef unsigned u32x2 __attribute__((ext_vector_type(2)));
                    const u32x2 gw = *(const u32x2*)(G8 + row * 3072 + I * 1024 + col);
                    float v[8];
#pragma unroll
                    for (int e = 0; e < 4; ++e) { v[e] = acc[ai][bj][m][0][e] * ((float)((gw.x >> (8 * e)) & 255u) * (1.f / 255.f)); v[4 + e] = acc[ai][bj][m][1][e] * ((float)((gw.y >> (8 * e)) & 255u) * (1.f / 255.f)); }
                    bf16_t* p = Mg + row * 1024 + col;
                    if (I > 0) { const u32x4 o = *(const u32x4*)p;
                        v[0] += __uint_as_float(o.x << 16); v[1] += __uint_as_float(o.x & 0xffff0000u); v[2] += __uint_as_float(o.y << 16); v[3] += __uint_as_float(o.y & 0xffff0000u);
                        v[4] += __uint_as_float(o.z << 16); v[5] += __uint_as_float(o.z & 0xffff0000u); v[6] += __uint_as_float(o.w << 16); v[7] += __uint_as_float(o.w & 0xffff0000u); }
                    u32x4 w; w.x = cvt_pk_bf16(v[0], v[1]); w.y = cvt_pk_bf16(v[2], v[3]); w.z = cvt_pk_bf16(v[4], v[5]); w.w = cvt_pk_bf16(v[6], v[7]);
                    *(u32x4*)p = w; } }
    }
};
struct EpiB16 {
    static constexpr bool PERM = true, AFTER_DRAIN = false;
    bf16_t* O; int ldc;
    __device__ __forceinline__ void operator()(const f32x4 (&acc)[2][2][4][2], const Unit& u, int wr, int wc, int fr, int fq) const {
        const int row0 = u.pm * BM + wr * 64 + fr, col0 = u.pn * BM + wc * 32 + 8 * fq;
#pragma unroll
        for (int ai = 0; ai < 2; ++ai)
#pragma unroll
            for (int m = 0; m < 4; ++m) { bf16_t* rowp = O + (size_t)(row0 + ai * HALF + m * 16) * ldc + col0;
#pragma unroll
                for (int bj = 0; bj < 2; ++bj) { const f32x4 v0 = acc[ai][bj][m][0], v1 = acc[ai][bj][m][1]; u32x4 w;
                    w.x = cvt_pk_bf16(v0[0], v0[1]); w.y = cvt_pk_bf16(v0[2], v0[3]); w.z = cvt_pk_bf16(v1[0], v1[1]); w.w = cvt_pk_bf16(v1[2], v1[3]);
                    *(u32x4*)(rowp + bj * HALF) = w; } }
    }
};
struct EpiF32 {
    static constexpr bool PERM = true, AFTER_DRAIN = false;
    float* O; int ldc;
    __device__ __forceinline__ void operator()(const f32x4 (&acc)[2][2][4][2], const Unit& u, int wr, int wc, int fr, int fq) const {
        const int row0 = u.pm * BM + wr * 64 + fr, col0 = u.pn * BM + wc * 32 + 8 * fq;
#pragma unroll
        for (int ai = 0; ai < 2; ++ai)
#pragma unroll
            for (int m = 0; m < 4; ++m) { float* rowp = O + (size_t)(row0 + ai * HALF + m * 16) * ldc + col0;
#pragma unroll
                for (int bj = 0; bj < 2; ++bj) { *(f32x4*)(rowp + bj * HALF) = acc[ai][bj][m][0]; *(f32x4*)(rowp + bj * HALF + 4) = acc[ai][bj][m][1]; } }
    }
};
struct EpiSwiglu {
    static constexpr bool PERM = true, AFTER_DRAIN = false;
    bf16_t* Act; int ldc;
    __device__ __forceinline__ void operator()(const f32x4 (&acc)[2][2][4][2], const Unit& u, int wr, int wc, int fr, int fq) const {
        const int row0 = u.pm * BM + wr * 64 + fr, col0 = u.pn * HALF + wc * 32 + 8 * fq;
#pragma unroll
        for (int ai = 0; ai < 2; ++ai)
#pragma unroll
            for (int m = 0; m < 4; ++m) { bf16_t* p = Act + (size_t)(row0 + ai * HALF + m * 16) * ldc + col0; float v[8];
#pragma unroll
                for (int e = 0; e < 4; ++e) { const float g0 = acc[ai][0][m][0][e], g1 = acc[ai][0][m][1][e];
                    v[e] = g0 * sigmoidf_(g0) * acc[ai][1][m][0][e]; v[4 + e] = g1 * sigmoidf_(g1) * acc[ai][1][m][1][e]; }
                u32x4 w; w.x = cvt_pk_bf16(v[0], v[1]); w.y = cvt_pk_bf16(v[2], v[3]); w.z = cvt_pk_bf16(v[4], v[5]); w.w = cvt_pk_bf16(v[6], v[7]);
                *(u32x4*)p = w; }
    }
};
template <class Epi, class Sched, bool ALIGN_EPI = false, bool SP2 = false>
__device__ __forceinline__ void gemm_phase(PG8_LAS unsigned char* lds, const Gemm g, const Sched& S, const Epi& E) {
    int tid_l = threadIdx.x; asm volatile("" : "+v"(tid_l));
    const int tid = tid_l, wid = __builtin_amdgcn_readfirstlane(tid >> 6), lane = tid & 63, wr = wid >> 2, wc = wid & 3, fr = lane & 15, fq = lane >> 4;
    const int K = g.K, nt = K / BK;
    unsigned voffA[2], voffB[2];
#pragma unroll
    for (int i = 0; i < 2; ++i) { int R, C; stage_rc(tid * 16 + i * 8192, R, C); const int Rb = Epi::PERM ? ((R & ~31) + perm32(R & 31)) : R;
        voffA[i] = (unsigned)(R * g.lda + C) * 2u; voffB[i] = (unsigned)(Rb * K + C) * 2u; }
    const size_t kstep = (size_t)(BK * 2);
    const size_t hstepB = (size_t)HALF * K * 2, hstepA = (size_t)HALF * g.lda * 2;
    const size_t tstepA = 2 * hstepA, tstepB = 2 * hstepB;
    const unsigned ldsw = (unsigned)wid * 1024u;
    const int aoff = lds_byte(wr * 64 + fr, fq * 8), boff = lds_byte(wc * 32 + fr, fq * 8);
#define PG8_SA(b, h) (((b) * 2 + (h)) * HTB)
#define PG8_SB(b, h) ((4 + (b) * 2 + (h)) * HTB)
#define PG8_STAGE(bufoff, gbase, voff) do { _Pragma("unroll") for (int _i = 0; _i < 2; ++_i) \
        __builtin_amdgcn_global_load_lds((const unsigned*)((const char*)(gbase) + (voff)[_i]), (PG8_LAS unsigned*)(lds + (bufoff) + ldsw + _i * 8192), 16, 0, 0); } while (0)
#define PG8_LDA(dst, b, h) do { _Pragma("unroll") for (int m = 0; m < 4; ++m) _Pragma("unroll") for (int k = 0; k < 2; ++k) dst[m][k] = *(const PG8_LAS bf16x8*)(lds + PG8_SA(b, h) + aoff + m * 2048 + k * 1024); } while (0)
#define PG8_LDB(dst, b, h) do { _Pragma("unroll") for (int n = 0; n < 2; ++n) _Pragma("unroll") for (int k = 0; k < 2; ++k) dst[n][k] = *(const PG8_LAS bf16x8*)(lds + PG8_SB(b, h) + boff + n * 2048 + k * 1024); } while (0)
#define PG8_MMA(ai, bj, At, Bt) do { __builtin_amdgcn_s_setprio(1); _Pragma("unroll") for (int m = 0; m < 4; ++m) _Pragma("unroll") for (int n = 0; n < 2; ++n) _Pragma("unroll") for (int k = 0; k < 2; ++k) \
        acc[ai][bj][m][n] = __builtin_amdgcn_mfma_f32_16x16x32_bf16(Bt[n][k], At[m][k], acc[ai][bj][m][n], 0, 0, 0); __builtin_amdgcn_s_setprio(0); } while (0)
#define PG8_WAIT_V(n) asm volatile("s_waitcnt vmcnt(" #n ")" ::: "memory")
#define PG8_WAIT_L(n) asm volatile("s_waitcnt lgkmcnt(" #n ")" ::: "memory")
#define PG8_BAR __builtin_amdgcn_s_barrier()
#define PG8_SCHED __builtin_amdgcn_sched_barrier(0)
    Unit cur, nxt; int ui = 0;
    if (!S.next(0, cur)) return;
    f32x4 acc[2][2][4][2];
#pragma unroll
    for (int a = 0; a < 2; ++a)
#pragma unroll
        for (int b = 0; b < 2; ++b)
#pragma unroll
            for (int m = 0; m < 4; ++m)
#pragma unroll
                for (int n = 0; n < 2; ++n) acc[a][b][m][n] = (f32x4){0.f, 0.f, 0.f, 0.f};
    bf16x8 At[4][2], B0[2][2], B1[2][2];
    const char* cA = (const char*)g.A + (size_t)cur.pm * tstepA; const char* cB = (const char*)g.Bt + (size_t)cur.pn * tstepB;
    S.a_ready(cur);
    if constexpr (SP2) {
        PG8_STAGE(PG8_SB(0, 0), cB, voffB); PG8_STAGE(PG8_SB(0, 1), cB + hstepB, voffB); PG8_STAGE(PG8_SA(0, 0), cA, voffA); PG8_STAGE(PG8_SA(0, 1), cA + hstepA, voffA);
        if (wr == 1) PG8_BAR;
        PG8_WAIT_V(2); PG8_BAR;
        PG8_STAGE(PG8_SB(1, 0), cB + kstep, voffB); PG8_STAGE(PG8_SA(1, 0), cA + kstep, voffA); PG8_STAGE(PG8_SB(1, 1), cB + hstepB + kstep, voffB);
        PG8_WAIT_V(6); PG8_BAR;
    } else {
        PG8_STAGE(PG8_SB(0, 0), cB, voffB); PG8_STAGE(PG8_SA(0, 0), cA, voffA); PG8_STAGE(PG8_SB(0, 1), cB + hstepB, voffB); PG8_STAGE(PG8_SA(0, 1), cA + hstepA, voffA);
        if (wr == 1) PG8_BAR;
        PG8_WAIT_V(4); PG8_BAR;
        PG8_STAGE(PG8_SB(1, 0), cB + kstep, voffB); PG8_STAGE(PG8_SA(1, 0), cA + kstep, voffA); PG8_STAGE(PG8_SB(1, 1), cB + hstepB + kstep, voffB);
        PG8_WAIT_V(6); PG8_BAR;
    }
    for (;;) {
        const bool has_next = S.next(ui + 1, nxt);
        const char* nA = has_next ? (const char*)g.A + (size_t)nxt.pm * tstepA : cA; const char* nB = has_next ? (const char*)g.Bt + (size_t)nxt.pn * tstepB : cB;
        for (int t = 0; t < nt; t += 2) {
            const bool last = (t == nt - 2);
            const char* a1 = cA + (size_t)(t + 1) * kstep;
            const char* a2 = last ? nA : cA + (size_t)(t + 2) * kstep; const char* b2 = last ? nB : cB + (size_t)(t + 2) * kstep;
            const char* a3 = a2 + kstep; const char* b3 = b2 + kstep;
            if (last && has_next) S.a_ready(nxt);
            if constexpr (SP2) {
            PG8_LDB(B0, 0, 0); PG8_LDB(B1, 0, 1); PG8_SCHED; PG8_LDA(At, 0, 0); PG8_STAGE(PG8_SA(1, 1), a1 + hstepA, voffA);
            PG8_WAIT_V(8); PG8_WAIT_L(0); PG8_BAR; PG8_MMA(0, 0, At, B0); PG8_MMA(0, 1, At, B1); PG8_BAR; PG8_SCHED;
            PG8_LDA(At, 0, 1); PG8_STAGE(PG8_SB(0, 0), b2, voffB); PG8_STAGE(PG8_SB(0, 1), b2 + hstepB, voffB); PG8_STAGE(PG8_SA(0, 0), a2, voffA);
            PG8_WAIT_V(8); PG8_WAIT_L(0); PG8_BAR; PG8_MMA(1, 0, At, B0); PG8_MMA(1, 1, At, B1); PG8_BAR; PG8_SCHED;
            PG8_LDB(B0, 1, 0); PG8_LDB(B1, 1, 1); PG8_SCHED; PG8_LDA(At, 1, 0); PG8_STAGE(PG8_SA(0, 1), a2 + hstepA, voffA);
            PG8_WAIT_V(8); PG8_WAIT_L(0); PG8_BAR; PG8_MMA(0, 0, At, B0); PG8_MMA(0, 1, At, B1); PG8_BAR; PG8_SCHED;
            PG8_LDA(At, 1, 1); PG8_STAGE(PG8_SB(1, 0), b3, voffB); PG8_STAGE(PG8_SB(1, 1), b3 + hstepB, voffB); PG8_STAGE(PG8_SA(1, 0), a3, voffA);
            PG8_WAIT_V(8); PG8_WAIT_L(0); PG8_BAR; PG8_MMA(1, 0, At, B0); PG8_MMA(1, 1, At, B1); PG8_BAR; PG8_SCHED;
            } else {
            PG8_LDB(B0, 0, 0); PG8_SCHED; PG8_LDA(At, 0, 0); PG8_STAGE(PG8_SA(1, 1), a1 + hstepA, voffA);
            PG8_WAIT_L(8); PG8_BAR; PG8_WAIT_L(0); PG8_MMA(0, 0, At, B0); PG8_BAR; PG8_SCHED;
            PG8_LDB(B1, 0, 1); PG8_STAGE(PG8_SB(0, 0), b2, voffB);
            PG8_BAR; PG8_WAIT_L(0); PG8_MMA(0, 1, At, B1); PG8_BAR;
            PG8_LDA(At, 0, 1); PG8_STAGE(PG8_SA(0, 0), a2, voffA);
            PG8_BAR; PG8_WAIT_L(0); PG8_MMA(1, 0, At, B0); PG8_BAR; PG8_SCHED;
            PG8_STAGE(PG8_SB(0, 1), b2 + hstepB, voffB);
            PG8_WAIT_V(6); PG8_BAR; PG8_MMA(1, 1, At, B1); PG8_BAR;
            PG8_LDB(B0, 1, 0); PG8_SCHED; PG8_LDA(At, 1, 0); PG8_STAGE(PG8_SA(0, 1), a2 + hstepA, voffA);
            PG8_WAIT_L(8); PG8_BAR; PG8_WAIT_L(0); PG8_MMA(0, 0, At, B0); PG8_BAR; PG8_SCHED;
            PG8_LDB(B1, 1, 1); PG8_STAGE(PG8_SB(1, 0), b3, voffB);
            PG8_BAR; PG8_WAIT_L(0); PG8_MMA(0, 1, At, B1); PG8_BAR;
            PG8_LDA(At, 1, 1); PG8_STAGE(PG8_SA(1, 0), a3, voffA);
            PG8_BAR; PG8_WAIT_L(0); PG8_MMA(1, 0, At, B0); PG8_BAR; PG8_SCHED;
            PG8_STAGE(PG8_SB(1, 1), b3 + hstepB, voffB);
            PG8_WAIT_V(6); PG8_BAR; PG8_MMA(1, 1, At, B1); PG8_BAR;
            }
        }
        if constexpr (ALIGN_EPI) { if (wr == 0) PG8_BAR; }
        if constexpr (!Epi::AFTER_DRAIN) { E(acc, cur, wr, wc, fr, fq); S.done(cur); }
        if (!has_next) break;
#pragma unroll
        for (int a = 0; a < 2; ++a)
#pragma unroll
            for (int b = 0; b < 2; ++b)
#pragma unroll
                for (int m = 0; m < 4; ++m)
#pragma unroll
                    for (int n = 0; n < 2; ++n) acc[a][b][m][n] = (f32x4){0.f, 0.f, 0.f, 0.f};
        cur = nxt; cA = nA; cB = nB; ++ui;
        if constexpr (ALIGN_EPI) { if (wr == 1) PG8_BAR; }
    }
    PG8_WAIT_V(0);
    if constexpr (!ALIGN_EPI) { if (wr == 0) PG8_BAR; }
    PG8_BAR;
    if constexpr (Epi::AFTER_DRAIN) { E.fused(acc, cur, wr, wc, fr, fq, lds, wid, lane); S.done(cur); }
#undef PG8_SA
#undef PG8_SB
#undef PG8_STAGE
#undef PG8_LDA
#undef PG8_LDB
#undef PG8_MMA
#undef PG8_WAIT_V
#undef PG8_WAIT_L
#undef PG8_BAR
#undef PG8_SCHED
}
}
namespace attn {
using bf16=unsigned short;
using bf16x8=__attribute__((ext_vector_type(8)))short;
using s16x4=__attribute__((ext_vector_type(4)))short;
using f32x16=__attribute__((ext_vector_type(16)))float;
using u32x4=__attribute__((ext_vector_type(4)))unsigned;
constexpr int D=64, PITCH=4392, SEQ=8192;
constexpr int NW=8,QBLK=32,QB=QBLK*NW,KVBLK=64;
__device__ __forceinline__ int crow(int r,int hi){return (r&3)+8*(r>>2)+4*hi;}
#define SBAR() __builtin_amdgcn_sched_barrier(0)
using f32x4_=__attribute__((ext_vector_type(4)))float;
__device__ __forceinline__ float bfs(short v){ return __uint_as_float(((unsigned)(unsigned short)v)<<16); }
__device__ __forceinline__ float lo16(unsigned w){ return __uint_as_float(w<<16); }
__device__ __forceinline__ float hi16(unsigned w){ return __uint_as_float(w&0xffff0000u); }
__device__ __forceinline__ bf16 f2b(float f){ unsigned u=__float_as_uint(f); return (bf16)((u+0x7fffu+((u>>16)&1u))>>16); }
__device__ __forceinline__ unsigned pk2b(float lo,float hi){ return (unsigned)f2b(lo)|((unsigned)f2b(hi)<<16); }
constexpr int NSLOT=3, SLOTB=8192;
constexpr int LDS_K=0, LDS_V=NSLOT*SLOTB, LDS_WS=2*NSLOT*SLOTB, LDS_OST=LDS_WS+NW*128*4, LDS_BIAS=LDS_OST+NW*4096, LDS_MSK=LDS_BIAS+512, LDS_KM=LDS_MSK+NW*512, LDS_BYTES=LDS_KM+8192;
constexpr float LOG2E_=1.4426950408889634f;
__device__ __forceinline__ void glds16(const void*gsrc,unsigned lds_dst){unsigned keep;
  asm volatile("s_mov_b32 %0, m0\n\ts_mov_b32 m0, %2\n\ts_nop 0\n\tglobal_load_lds_dwordx4 %1, off\n\ts_mov_b32 m0, %0":"=&s"(keep):"v"(gsrc),"s"(lds_dst):"memory");}
__device__ __forceinline__ float max3f(float a,float b,float c){float r;asm("v_max3_f32 %0, %1, %2, %3":"=v"(r):"v"(a),"v"(b),"v"(c));return r;}
__device__ __forceinline__ float max2f(float a,float b){float r;asm("v_max_f32_e32 %0, %1, %2":"=v"(r):"v"(a),"v"(b));return r;}
__device__ __forceinline__ float fadd_s(float a,float b){float r;asm("v_add_f32_e32 %0, %1, %2":"=v"(r):"v"(a),"v"(b));return r;}
__device__ __forceinline__ float fsub_s(float a,float b){float r;asm("v_sub_f32_e32 %0, %1, %2":"=v"(r):"v"(a),"v"(b));return r;}
typedef float f32x2_t __attribute__((ext_vector_type(2))); typedef __bf16 bf16x2_t __attribute__((ext_vector_type(2)));
__device__ __forceinline__ unsigned cvtpk_s(float lo,float hi){f32x2_t v={lo,hi};bf16x2_t b=__builtin_convertvector(v,bf16x2_t);return __builtin_bit_cast(unsigned,b);}
#define WAIT_BAR(N) asm volatile("s_waitcnt vmcnt(" #N ") lgkmcnt(0)\n\ts_barrier":::"memory")

__device__ __forceinline__ void qkt(f32x16&p0,f32x16&p1,const char*Kslot,const bf16x8*qr,const f32x16&negm,int r32,int hi){
  const char*kb=Kslot+hi*1024+r32*16;
  #pragma unroll
  for(int d0=0;d0<4;++d0){
    const bf16x8 b0=*reinterpret_cast<const bf16x8*>(kb+d0*2048);
    const bf16x8 b1=*reinterpret_cast<const bf16x8*>(kb+d0*2048+512);
    if(d0==0){p0=__builtin_amdgcn_mfma_f32_32x32x16_bf16(b0,qr[0],negm,0,0,0);p1=__builtin_amdgcn_mfma_f32_32x32x16_bf16(b1,qr[0],negm,0,0,0);}
    else{p0=__builtin_amdgcn_mfma_f32_32x32x16_bf16(b0,qr[d0],p0,0,0,0);p1=__builtin_amdgcn_mfma_f32_32x32x16_bf16(b1,qr[d0],p1,0,0,0);}}
}
typedef __attribute__((address_space(3))) const char* lds_cptr;
typedef short v4i16_t __attribute__((ext_vector_type(4)));
__device__ __forceinline__ void kload8(bf16x8*kf,lds_cptr kp){
  kf[0]=*(const __attribute__((address_space(3))) bf16x8*)(kp);      kf[1]=*(const __attribute__((address_space(3))) bf16x8*)(kp+512);
  kf[2]=*(const __attribute__((address_space(3))) bf16x8*)(kp+2048); kf[3]=*(const __attribute__((address_space(3))) bf16x8*)(kp+2560);
  kf[4]=*(const __attribute__((address_space(3))) bf16x8*)(kp+4096); kf[5]=*(const __attribute__((address_space(3))) bf16x8*)(kp+4608);
  kf[6]=*(const __attribute__((address_space(3))) bf16x8*)(kp+6144); kf[7]=*(const __attribute__((address_space(3))) bf16x8*)(kp+6656);
}
__device__ __forceinline__ void kload2(bf16x8*kf,lds_cptr kp,int j){ kf[2*j]=*(const __attribute__((address_space(3))) bf16x8*)(kp+j*2048); kf[2*j+1]=*(const __attribute__((address_space(3))) bf16x8*)(kp+j*2048+512); }
__device__ __forceinline__ s16x4 vtr(lds_cptr p){ return __builtin_bit_cast(s16x4,__builtin_amdgcn_ds_read_tr16_b64_v4i16((__attribute__((address_space(3))) v4i16_t*)p)); }
__device__ __forceinline__ float rowmax(const f32x16&p0,const f32x16&p1){
  float a=max3f(p0[0],p0[1],p1[0]),b=max3f(p0[2],p0[3],p1[1]);a=max3f(a,p1[2],p1[3]);
  #pragma unroll
  for(int r=4;r<16;r+=4){a=max3f(a,p0[r],p0[r+1]);b=max3f(b,p0[r+2],p0[r+3]);a=max3f(a,p1[r],p1[r+1]);b=max3f(b,p1[r+2],p1[r+3]);}
  const float m=max2f(a,b);
  auto rr=__builtin_amdgcn_permlane32_swap(__float_as_uint(m),__float_as_uint(m),false,false);
  return max2f(__uint_as_float(rr[0]),__uint_as_float(rr[1]));
}
__device__ __forceinline__ void pv(f32x16*o,int vb,bf16x8 pa0,bf16x8 pa1,bf16x8 pa2,bf16x8 pa3){
  #pragma unroll
  for(int d0=0;d0<2;++d0){s16x4 lo[4],hi[4];
    #pragma unroll
    for(int ks=0;ks<4;++ks){
      asm volatile("ds_read_b64_tr_b16 %0,%1 offset:%c2":"=&v"(lo[ks]):"v"(vb),"i"(d0*4096+ks*1024):"memory");
      asm volatile("ds_read_b64_tr_b16 %0,%1 offset:%c2":"=&v"(hi[ks]):"v"(vb),"i"(d0*4096+ks*1024+512):"memory");}
    asm volatile("s_waitcnt lgkmcnt(0)":::"memory");SBAR();
    #define PK(k) (bf16x8){lo[k][0],lo[k][1],lo[k][2],lo[k][3],hi[k][0],hi[k][1],hi[k][2],hi[k][3]}
    o[d0]=__builtin_amdgcn_mfma_f32_32x32x16_bf16(pa0,PK(0),o[d0],0,0,0);
    o[d0]=__builtin_amdgcn_mfma_f32_32x32x16_bf16(pa1,PK(1),o[d0],0,0,0);
    o[d0]=__builtin_amdgcn_mfma_f32_32x32x16_bf16(pa2,PK(2),o[d0],0,0,0);
    o[d0]=__builtin_amdgcn_mfma_f32_32x32x16_bf16(pa3,PK(3),o[d0],0,0,0);
    #undef PK
  }
}

#ifndef ATTN_STORE16
#define ATTN_STORE16(p,v) (*(u32x4*)(p)=(v))
#endif
struct UArgs {
  const bf16* Qb; const bf16* Kh; const bf16* Vh; bf16* Ob;
  int NT, q0, kt0, hc;
  const float* rel;
  const float* km; int qb;
  const unsigned* selg;
  const bf16* gate; int gcol;
  const bf16* tmp;
};
__device__ __forceinline__ int t5b(int d){ if(d<16)return d<0?0:d; int b=16; b+=(d>=19);b+=(d>=21);b+=(d>=24);b+=(d>=27);b+=(d>=31);b+=(d>=35);b+=(d>=40);b+=(d>=46);b+=(d>=52);b+=(d>=59);b+=(d>=67);b+=(d>=77);b+=(d>=87);b+=(d>=99);b+=(d>=113); return b; }
template<int MODE,int EPI,int THRL> __device__ __forceinline__ void attn_unit(const UArgs&U,char*shm){
  int tid_l=threadIdx.x; asm volatile("":"+v"(tid_l));
  const int tid=tid_l,lane=tid&63,r32=lane&31,hi=lane>>5; const int wid=__builtin_amdgcn_readfirstlane(tid>>6);
  const bf16*Qw=U.Qb+(long)(wid*QBLK)*PITCH;
  const bf16*Kh=U.Kh,*Vh=U.Vh;
  const unsigned lds0=(unsigned)(uintptr_t)shm;
  float*wsf=(float*)(shm+LDS_WS)+wid*128;
  const bf16*ksrc=Kh+(long)lane*PITCH+wid*8;
  const bf16*vsrc=Vh+(long)(16*(wid&3)+(lane>>2))*PITCH+(wid>>2)*32+(lane&3)*8;
  const unsigned kdst=lds0+LDS_K+wid*1024, vdst=lds0+LDS_V+wid*1024;
  #define DMA_K(t,slot) glds16(ksrc+(long)(t)*KVBLK*PITCH,(unsigned)__builtin_amdgcn_readfirstlane(kdst+(slot)))
  #define DMA_V(t,slot) glds16(vsrc+(long)(t)*KVBLK*PITCH,(unsigned)__builtin_amdgcn_readfirstlane(vdst+(slot)))
  const int vb0=(int)(lds0+LDS_V)+((lane>>4)&1)*32+(lane&3)*8+(4*hi+((lane&15)>>2))*64;
  const char*Kbase=shm+LDS_K; bf16x8 kf[8];
  const lds_cptr shm3=(lds_cptr)shm; const lds_cptr kp0=shm3+LDS_K+hi*1024+r32*16; const lds_cptr vp0=shm3+LDS_V+((lane>>4)&1)*32+(lane&3)*8+(4*hi+((lane&15)>>2))*64;
  const int NT=U.NT;
  const int qpos=U.q0+wid*QBLK+r32;
  float*biasT=(float*)(shm+LDS_BIAS);
  if(tid<128) biasT[tid]=(U.rel[t5b(tid)*16+U.hc]-U.rel[31*16+U.hc])*LOG2E_;
  unsigned selw=0u,cw=0u; const unsigned*mskp=(const unsigned*)(shm+LDS_MSK)+wid*128+r32*4;
  if(MODE==0){ ((u32x4*)(shm+LDS_KM))[tid]=((const u32x4*)U.km)[tid]; }
  if(MODE==1){ if(hi==0){ const u32x4 w=*(const u32x4*)(U.selg+(long)(wid*QBLK+r32)*4); *(u32x4*)((unsigned*)(shm+LDS_MSK)+wid*128+r32*4)=w; } }
  asm volatile("s_waitcnt vmcnt(0) lgkmcnt(0)\n\ts_barrier":::"memory");
  bf16x8 qr[4];
  #pragma unroll
  for(int d0=0;d0<4;++d0)qr[d0]=*reinterpret_cast<const bf16x8*>(&Qw[(long)r32*PITCH+d0*16+hi*8]);
  if(MODE==0){
    float v1=-INFINITY,v2=-INFINITY,v3=-INFINITY; int i1=-1,i2=-1,i3=-1;
    for(int n=0;n<U.qb;++n){ const float*km=(const float*)(shm+LDS_KM)+n*64+hi*8; float p=0.f;
      #pragma unroll
      for(int d0=0;d0<4;++d0){ const f32x4_ a=*(const f32x4_*)(km+d0*16), c=*(const f32x4_*)(km+d0*16+4);
        p+=bfs(qr[d0][0])*a[0]+bfs(qr[d0][1])*a[1]+bfs(qr[d0][2])*a[2]+bfs(qr[d0][3])*a[3]+bfs(qr[d0][4])*c[0]+bfs(qr[d0][5])*c[1]+bfs(qr[d0][6])*c[2]+bfs(qr[d0][7])*c[3]; }
      auto rr=__builtin_amdgcn_permlane32_swap(__float_as_uint(p),__float_as_uint(p),false,false); const float sc_=__uint_as_float(rr[0])+__uint_as_float(rr[1]);
      if(sc_>v1){v3=v2;i3=i2;v2=v1;i2=i1;v1=sc_;i1=n;} else if(sc_>v2){v3=v2;i3=i2;v2=sc_;i2=n;} else if(sc_>v3){v3=sc_;i3=n;} }
    if(i1>=0)selw|=1u<<i1; if(i2>=0)selw|=1u<<i2; if(i3>=0)selw|=1u<<i3; selw|=1u<<U.qb; }
  DMA_K(0,0);DMA_V(0,0);DMA_K(1,SLOTB);
  float mhat=0.f,l_reg=0.f;f32x16 o[2];o[0]=f32x16{};o[1]=f32x16{};f32x16 negm=f32x16{};asm volatile("":"+v"(negm));
  #define MASK_FAR(P0,P1,t) do{ bool on_=true; if(MODE==0)on_=((selw>>((t)>>2))&1u)!=0u; if(MODE==1){ if(((t)&31)==0)cw=mskp[(t)>>5]; on_=((cw>>((t)&31))&1u)!=0u; } \
      _Pragma("unroll") for(int r=0;r<16;++r){ P0[r]=on_?P0[r]:-INFINITY; P1[r]=on_?P1[r]:-INFINITY; } }while(0)
  #define MASK_BAND(P0,P1,t) do{ bool on_=true; if(MODE==0)on_=((selw>>((t)>>2))&1u)!=0u; if(MODE==1){ if(((t)&31)==0)cw=mskp[(t)>>5]; on_=((cw>>((t)&31))&1u)!=0u; } \
      const int kb_=U.kt0+64*(t), qw_=U.q0+wid*QBLK; \
      if((qw_-(kb_+63))<128||(MODE==2&&(qw_+31-kb_)>=512)){            \
      const int d0_=qpos-(kb_+4*hi); \
      _Pragma("unroll") for(int r=0;r<16;++r){ const int da_=d0_-((r&3)+8*(r>>2)), db_=da_-32; \
        const bool oka_=on_&&da_>=0&&(MODE!=2||da_<512), okb_=on_&&db_>=0&&(MODE!=2||db_<512); \
        const float ba_=biasT[da_<0?0:(da_>127?127:da_)], bb_=biasT[db_<0?0:(db_>127?127:db_)]; \
        P0[r]=oka_?P0[r]+ba_:-INFINITY; P1[r]=okb_?P1[r]+bb_:-INFINITY; \
        if((r&1)==1){ asm volatile("s_waitcnt lgkmcnt(0)":"+v"(P0),"+v"(P1)::"memory"); } } \
      } else if(MODE!=2){ _Pragma("unroll") for(int r=0;r<16;++r){ P0[r]=on_?P0[r]:-INFINITY; P1[r]=on_?P1[r]:-INFINITY; } } }while(0)
  #define CMASK(P0,P1,t) MASK_BAND(P0,P1,t)
  bool resc=false;
  #define START(P0,P1) do{ const float rm=rowmax(P0,P1); resc=false; \
    { const float dl=rm>-1e30f?rm:0.f; mhat=fadd_s(mhat,dl); \
      _Pragma("unroll") for(int r=0;r<16;++r){P0[r]=fsub_s(P0[r],dl);P1[r]=fsub_s(P1[r],dl);} \
      _Pragma("unroll") for(int r=0;r<16;++r)negm[r]=-mhat; asm volatile("":"+v"(negm)); } \
    _Pragma("unroll") for(int r=0;r<16;++r)P0[r]=__builtin_amdgcn_exp2f(P0[r]); }while(0)
  #define RESC() do{ if(resc){ asm volatile("s_waitcnt lgkmcnt(0)":::"memory"); \
      _Pragma("unroll") for(int d_=0;d_<2;++d_) _Pragma("unroll") for(int r=0;r<16;++r)o[d_][r]*=wsf[crow(r,hi)]; } }while(0)
  f32x16 pA0,pA1,pB0,pB1;
  int sl_prev=0,sl_cur=0,sl_next=SLOTB;
  #define ROT() do{sl_prev=sl_cur;sl_cur=sl_next;sl_next=(sl_next==(NSLOT-1)*SLOTB)?0:sl_next+SLOTB;}while(0)
  DMA_K(2,2*SLOTB);
  WAIT_BAR(3);
  qkt(pA0,pA1,Kbase,qr,negm,r32,hi);asm volatile("s_nop 15\n\ts_nop 7":"+v"(pA0),"+v"(pA1));CMASK(pA0,pA1,0);
  START(pA0,pA1);
  _Pragma("unroll") for(int r=0;r<16;++r)pA1[r]=__builtin_amdgcn_exp2f(pA1[r]);
  WAIT_BAR(0);
  DMA_K(3,0);DMA_V(1,SLOTB);
  ROT();
  kload8(kf,kp0+sl_cur);
  WAIT_BAR(2);
  s16x4 vlo[8],vhi[8]; u32x4 pw0,pw1,pw2,pw3;
  #define PKW(P,B) cvtpk_s(P[B],P[B+1])
  #define PAF(k) __builtin_bit_cast(bf16x8,pw##k)
  #define VFR(i) (bf16x8){vlo[i][0],vlo[i][1],vlo[i][2],vlo[i][3],vhi[i][0],vhi[i][1],vhi[i][2],vhi[i][3]}
  #define PIN(x) asm volatile("":"+v"(x))
  #define MX3(a,b,c) __builtin_fmaxf(__builtin_fmaxf((a),(b)),(c))
  #define GAPA(MF,A0,A1,A2,A3,W0,W1,PW) do{ MF; sacc+=A0; sacc+=A1; sacc+=A2; sacc+=A3; PIN(sacc); W0; W1; PIN(PW); SBAR(); }while(0)
  #define EX(v) __builtin_amdgcn_exp2f(v)
  #define GAPB(MF,X,B) do{ MF; X[B]=EX(X[B]); X[B+1]=EX(X[B+1]); X[B+2]=EX(X[B+2]); X[B+3]=EX(X[B+3]); PIN(X); SBAR(); }while(0)
  #define VRD(i) do{ vlo[i]=vtr(vp_+(((i)>>2)*4096+((i)&3)*1024)); vhi[i]=vtr(vp_+(((i)>>2)*4096+((i)&3)*1024+512)); }while(0)
  #define KRD(G,j) do{ if(G){ kload2(kf,kp0+sl_next,j); SBAR(); } }while(0)
  #define STEP(C0,C1,P0,P1,t,GK,GV,GL) do{ SBAR(); \
    const lds_cptr vp_=vp0+sl_prev; \
    VRD(0); SBAR(); float sacc=(P0[0]+P0[1]); \
    GAPA(C0=__builtin_amdgcn_mfma_f32_32x32x16_bf16(kf[0],qr[0],negm,0,0,0), P0[2],P0[3],P0[4],P0[5],     pw0[0]=PKW(P0,0), pw0[1]=PKW(P0,2), pw0); \
    VRD(4); SBAR(); GAPA(C1=__builtin_amdgcn_mfma_f32_32x32x16_bf16(kf[1],qr[0],negm,0,0,0), P0[6],P0[7],P0[8],P0[9],     pw0[2]=PKW(P0,4), pw0[3]=PKW(P0,6), pw0); \
    VRD(1); SBAR(); GAPA(C0=__builtin_amdgcn_mfma_f32_32x32x16_bf16(kf[2],qr[1],C0,0,0,0),   P0[10],P0[11],P0[12],P0[13], pw1[0]=PKW(P0,8), pw1[1]=PKW(P0,10), pw1); \
    VRD(5); SBAR(); GAPA(C1=__builtin_amdgcn_mfma_f32_32x32x16_bf16(kf[3],qr[1],C1,0,0,0),   P0[14],P0[15],P1[0],P1[1],   pw1[2]=PKW(P0,12),pw1[3]=PKW(P0,14), pw1); \
    VRD(2); SBAR(); GAPA(C0=__builtin_amdgcn_mfma_f32_32x32x16_bf16(kf[4],qr[2],C0,0,0,0),   P1[2],P1[3],P1[4],P1[5],     pw2[0]=PKW(P1,0), pw2[1]=PKW(P1,2), pw2); \
    VRD(6); SBAR(); GAPA(C1=__builtin_amdgcn_mfma_f32_32x32x16_bf16(kf[5],qr[2],C1,0,0,0),   P1[6],P1[7],P1[8],P1[9],     pw2[2]=PKW(P1,4), pw2[3]=PKW(P1,6), pw2); \
    VRD(3); SBAR(); GAPA(C0=__builtin_amdgcn_mfma_f32_32x32x16_bf16(kf[6],qr[3],C0,0,0,0),   P1[10],P1[11],P1[12],P1[13], pw3[0]=PKW(P1,8), pw3[1]=PKW(P1,10), pw3); \
    VRD(7); SBAR(); GAPA(C1=__builtin_amdgcn_mfma_f32_32x32x16_bf16(kf[7],qr[3],C1,0,0,0),   P1[14],P1[15],0.f,0.f,       pw3[2]=PKW(P1,12),pw3[3]=PKW(P1,14), pw3); \
    l_reg+=sacc; \
    if(GK){DMA_K((t)+3,sl_cur);} if(GV){DMA_V((t)+1,sl_next);} \
    CMASK(C0,C1,t); \
    { float a=MX3(C0[0],C0[1],C1[0]),b=MX3(C0[2],C0[3],C1[1]); a=MX3(a,C1[2],C1[3]); \
      _Pragma("unroll") for(int r=4;r<16;r+=4){a=MX3(a,C0[r],C0[r+1]);b=MX3(b,C0[r+2],C0[r+3]);a=MX3(a,C1[r],C1[r+1]);b=MX3(b,C1[r+2],C1[r+3]);} \
      float rm=__builtin_fmaxf(a,b); { auto rr=__builtin_amdgcn_permlane32_swap(__float_as_uint(rm),__float_as_uint(rm),false,false); rm=__builtin_fmaxf(__uint_as_float(rr[0]),__uint_as_float(rr[1])); } \
      resc=false; \
      if(__builtin_expect(__any(rm>(float)THRL),0)){ const float dl=__builtin_fmaxf(rm,0.f); mhat+=dl; \
        _Pragma("unroll") for(int r=0;r<16;++r){C0[r]-=dl;C1[r]-=dl;} \
        _Pragma("unroll") for(int r=0;r<16;++r)negm[r]=-mhat; asm volatile("":"+v"(negm)); \
        const float f=__builtin_amdgcn_exp2f(-dl); l_reg*=f; if(hi==0)wsf[r32]=f; resc=true; } } \
    SBAR(); \
    GAPB(o[0]=__builtin_amdgcn_mfma_f32_32x32x16_bf16(PAF(0),VFR(0),o[0],0,0,0), C0,0); \
    GAPB(o[1]=__builtin_amdgcn_mfma_f32_32x32x16_bf16(PAF(0),VFR(4),o[1],0,0,0), C0,4); \
    KRD(GL,0); GAPB(o[0]=__builtin_amdgcn_mfma_f32_32x32x16_bf16(PAF(1),VFR(1),o[0],0,0,0), C0,8); \
    KRD(GL,1); GAPB(o[1]=__builtin_amdgcn_mfma_f32_32x32x16_bf16(PAF(1),VFR(5),o[1],0,0,0), C0,12); \
    KRD(GL,2); GAPB(o[0]=__builtin_amdgcn_mfma_f32_32x32x16_bf16(PAF(2),VFR(2),o[0],0,0,0), C1,0); \
    KRD(GL,3); GAPB(o[1]=__builtin_amdgcn_mfma_f32_32x32x16_bf16(PAF(2),VFR(6),o[1],0,0,0), C1,4); \
    GAPB(o[0]=__builtin_amdgcn_mfma_f32_32x32x16_bf16(PAF(3),VFR(3),o[0],0,0,0), C1,8); \
    GAPB(o[1]=__builtin_amdgcn_mfma_f32_32x32x16_bf16(PAF(3),VFR(7),o[1],0,0,0), C1,12); \
    }while(0)
  int t=1;
  #undef CMASK
  #define CMASK(P0,P1,t) MASK_FAR(P0,P1,t)
  for(;MODE!=2&&t+7<NT;t+=2){
    STEP(pB0,pB1,pA0,pA1,t,true,true,true);     WAIT_BAR(2); RESC(); ROT();
    STEP(pA0,pA1,pB0,pB1,t+1,true,true,true);   WAIT_BAR(2); RESC(); ROT();
  }
  #undef CMASK
  #define CMASK(P0,P1,t) MASK_BAND(P0,P1,t)
  #define ENDW(tt) do{ if((tt)+3<NT){WAIT_BAR(2);} else if((tt)+2<NT){WAIT_BAR(1);} else {WAIT_BAR(0);} }while(0)
  for(;t+1<NT;t+=2){
    STEP(pB0,pB1,pA0,pA1,t,(t+3<NT),(t+1<NT),(t+1<NT));       ENDW(t);   RESC(); ROT();
    STEP(pA0,pA1,pB0,pB1,t+1,(t+4<NT),(t+2<NT),(t+2<NT));     ENDW(t+1); RESC(); ROT();
  }
  STEP(pB0,pB1,pA0,pA1,NT-1,false,false,false); RESC();
  { float sacc=pB0[0]+pB0[1]; _Pragma("unroll") for(int r=2;r<16;++r)sacc+=pB0[r]; _Pragma("unroll") for(int r=0;r<16;++r)sacc+=pB1[r]; l_reg+=sacc;
    pw0=(u32x4){PKW(pB0,0),PKW(pB0,2),PKW(pB0,4),PKW(pB0,6)};pw1=(u32x4){PKW(pB0,8),PKW(pB0,10),PKW(pB0,12),PKW(pB0,14)};pw2=(u32x4){PKW(pB1,0),PKW(pB1,2),PKW(pB1,4),PKW(pB1,6)};pw3=(u32x4){PKW(pB1,8),PKW(pB1,10),PKW(pB1,12),PKW(pB1,14)};
    SBAR(); pv(o,vb0+sl_cur,PAF(0),PAF(1),PAF(2),PAF(3)); }
  #undef PKW
  #undef PAF
  #undef VFR
  #undef PIN
  #undef MX3
  #undef GAPA
  #undef GAPB
  #undef EX
  #undef VRD
  #undef KRD
  #undef STEP
  #undef ENDW
  {auto rr=__builtin_amdgcn_permlane32_swap(__float_as_uint(l_reg),__float_as_uint(l_reg),false,false);l_reg=__uint_as_float(rr[0])+__uint_as_float(rr[1]);}
  int lane_e=lane; asm volatile("":"+v"(lane_e)); const int r32e=lane_e&31, hie=lane_e>>5;
  float*wsfe=(float*)(shm+LDS_WS)+wid*128;
  if(hie==0){ wsfe[32+r32e]=l_reg; if(EPI!=0){ const float gl=bfs((short)U.gate[(long)(wid*QBLK+r32e)*PITCH+U.gcol]); wsfe[64+r32e]=1.f/(1.f+__expf(-gl)); } }
  asm volatile("s_waitcnt lgkmcnt(0)":::"memory");
  float rli[16];
  #pragma unroll
  for(int r=0;r<16;++r){ rli[r]=__builtin_amdgcn_rcpf(fmaxf(wsfe[32+crow(r,hie)],1e-30f)); if(EPI!=0)rli[r]*=wsfe[64+crow(r,hie)]; }
  bf16*Ow=U.Ob+(long)(wid*QBLK)*PITCH;
  { bf16*stg=(bf16*)(shm+LDS_OST)+wid*2048;
    #pragma unroll
    for(int r=0;r<16;++r){const int orow=crow(r,hie);
      #pragma unroll
      for(int d0=0;d0<2;++d0){ float v=o[d0][r]*rli[r]; if(EPI==2)v+=bfs((short)stg[orow*64+d0*32+r32e]); stg[orow*64+d0*32+r32e]=f2b(v);} }
    asm volatile("s_waitcnt lgkmcnt(0)":::"memory");
    if(EPI!=1){
    #pragma unroll
    for(int i=0;i<4;++i){const int row=i*8+(lane_e>>3),ch=lane_e&7; u32x4 v=*(const u32x4*)(stg+row*64+ch*8);
      if(EPI==2){ const u32x4 t=*(const u32x4*)(U.tmp+(long)(wid*QBLK+row)*512+ch*8);
        v.x=pk2b(lo16(v.x)+lo16(t.x),hi16(v.x)+hi16(t.x)); v.y=pk2b(lo16(v.y)+lo16(t.y),hi16(v.y)+hi16(t.y)); v.z=pk2b(lo16(v.z)+lo16(t.z),hi16(v.z)+hi16(t.z)); v.w=pk2b(lo16(v.w)+lo16(t.w),hi16(v.w)+hi16(t.w)); }
      ATTN_STORE16(Ow+(long)row*PITCH+ch*8,v);} } }
  asm volatile("s_waitcnt lgkmcnt(0)\n\ts_barrier":::"memory");
  #undef DMA_K
  #undef DMA_V
  #undef CMASK
  #undef START
  #undef RESC
  #undef ROT
}
constexpr int ATTN_LDS_BYTES=LDS_BYTES;
#undef SBAR
#undef WAIT_BAR
}

constexpr int NWAVES = 8;
constexpr int B_ = 4, S_ = 8192, DM = 1024, M_ = B_ * S_, DIN = 7464, FF = 2816, NL = 2;
constexpr int YP = pg8::YP_;
constexpr float C2 = pg8::C2_, LOG2E = 1.4426950408889634f;
constexpr float NORM_EPS = 1e-6f;
constexpr int Y_AQ = 0, Y_AKC = 512, Y_AVC = 640, Y_AKS = 768, Y_AVS = 896, Y_AKW = 1024, Y_AVW = 1152, Y_CQ = 1280, Y_CK = 1792, Y_CV = 2304,
              Y_BQ = 2816, Y_BK = 3072, Y_BV = 3328, Y_BR = 3840, Y_AG = 4352, Y_BLR = 4376;
constexpr int NIN = 7680;
constexpr size_t MiB = 1u << 20;
constexpr size_t WS_CTL = 0, CTL_ZERO_BYTES = 1 * MiB;
constexpr size_t WS_WIN = 1 * MiB, WS_WA = 16 * MiB, WS_WB = 17 * MiB, WS_WC = 18 * MiB, WS_WO = 19 * MiB, WS_WF1 = 21 * MiB, WS_WF2 = 32 * MiB;
constexpr size_t WS_H = 40 * MiB;
constexpr size_t WS_Y = 104 * MiB;
constexpr size_t WS_G8 = 379 * MiB;
constexpr size_t WS_ACT = WS_Y + 128 * MiB;
constexpr size_t WS_SM = 475 * MiB;
constexpr size_t WS_KCMP = WS_SM, WS_VCMP = WS_SM + 1 * MiB, WS_KMEAN = WS_SM + 2 * MiB;
constexpr size_t WS_GA = WS_SM + 3 * MiB;
constexpr size_t WS_MASK = 38 * MiB;
constexpr size_t WS_OATMP = WS_H;
constexpr size_t WS_O16 = WS_H + 32 * MiB;
constexpr size_t WS_VCMPT = WS_VCMP + 512 * 1024;
constexpr size_t WS_CW1T = 39 * MiB;
constexpr size_t WS_CW2T = WS_CW1T + 512 * 1024;
constexpr size_t WS_CC0 = WS_CW2T + 16 * 1024;
constexpr size_t WS_GST = WS_H + 32 * MiB;
constexpr size_t WS_GDEC = WS_SM + 3 * MiB;
constexpr size_t WS_BCUM = WS_SM + 4 * MiB;
constexpr size_t WS_END = 512 * MiB;
static_assert(WS_BCUM + (size_t)M_ * 256 * 4 <= WS_END, "ws map 3");
static_assert(WS_GA + (size_t)M_ * 256 * 4 <= WS_END && WS_Y + (size_t)M_ * YP * 2 <= WS_G8 && WS_G8 + (size_t)M_ * 3072 <= WS_SM, "ws map");
static_assert(WS_ACT + (size_t)M_ * FF * 2 <= WS_SM && WS_WF2 + (size_t)DM * FF * 2 <= WS_H, "ws map 2");
constexpr int CW_BAR = 4096;
constexpr int RING_OFF = 0, RING_BYTES = 131072;
constexpr int LDSCTL_OFF = RING_BYTES, MISC_OFF = LDSCTL_OFF + 320;
constexpr int LDS_BYTES = 147456;

#define GAS __attribute__((address_space(1)))
#define LAS __attribute__((address_space(3)))
typedef unsigned short bf16;
typedef unsigned v4u __attribute__((ext_vector_type(4)));
typedef float f32x4 __attribute__((ext_vector_type(4)));
typedef short bf16x8 __attribute__((ext_vector_type(8)));
typedef GAS unsigned gu32;
typedef GAS unsigned long long gu64;
#define RLX_AGENT __ATOMIC_RELAXED, __HIP_MEMORY_SCOPE_AGENT
#define LDS_WAIT() asm volatile("s_waitcnt lgkmcnt(0)" ::: "memory")
#define VM_WAIT() asm volatile("s_waitcnt vmcnt(0)" ::: "memory")
__device__ __forceinline__ unsigned long long rt() { return __builtin_amdgcn_s_memrealtime(); }
__device__ __forceinline__ unsigned f2bf(float f) { unsigned u = __builtin_bit_cast(unsigned, f); return (u + 0x7fffu + ((u >> 16) & 1u)) >> 16; }
__device__ __forceinline__ unsigned pk2(float lo, float hi) { return f2bf(lo) | (f2bf(hi) << 16); }

__device__ __forceinline__ float bf2f(bf16 h) { return __uint_as_float((unsigned)h << 16); }
__device__ __forceinline__ float sigm(float v) { return 1.f / (1.f + __expf(-v)); }
#define WFENCE() asm volatile("s_waitcnt lgkmcnt(0)" ::: "memory")

#define XB_TMO      128
#define XB_XCNT(j)  (256  + 64 * (j))
#define XB_XSUB(j)  (1280 + 64 * (j))
#define XB_XGEN(j)  (2304 + 64 * (j))
#define XB_TOP      3328
#define XB_TOPGEN   3392
#define XCD_BAR_WORDS 3456
#define XB_SPIN_CAP (1u << 18)

__device__ __forceinline__ unsigned xb_ld(unsigned* p)              { return __hip_atomic_load(p, __ATOMIC_RELAXED, __HIP_MEMORY_SCOPE_AGENT); }
__device__ __forceinline__ unsigned xb_add(unsigned* p, unsigned v) { return __hip_atomic_fetch_add(p, v, __ATOMIC_RELAXED, __HIP_MEMORY_SCOPE_AGENT); }
__device__ __forceinline__ unsigned xb_xcc_id() { return (unsigned)__builtin_amdgcn_s_getreg((3 << 11) | 20) & 0xFu; }
#define XB_SPIN(cond, bar) do { unsigned _sp = 0; while (cond) { __builtin_amdgcn_s_sleep(1); \
    if ((++_sp & 255u) == 0u) { if (xb_ld(&(bar)[XB_TMO])) break; if (_sp > XB_SPIN_CAP) { atomicAdd(&(bar)[XB_TMO], 1u); break; } } } } while (0)

struct XcdBarrier {
    unsigned* bar; unsigned x;
    volatile LAS unsigned* st;
};

__device__ __forceinline__ XcdBarrier xcd_barrier_post(unsigned* bar, volatile LAS unsigned* st) {
    XcdBarrier b; b.bar = bar; b.x = xb_xcc_id(); b.st = st;
    if (threadIdx.x == 0) (void)xb_add(&bar[XB_XCNT(b.x)], 1u);
    return b;
}
__device__ __forceinline__ void xcd_barrier_complete(unsigned* bar, unsigned x, unsigned& nloc, unsigned& nx) {
    const unsigned G = gridDim.x * gridDim.y * gridDim.z;
    unsigned sum, cnt, mine, sp = 0u;
    for (;;) {
        sum = 0u; cnt = 0u; mine = 0u;
#pragma unroll
        for (unsigned j = 0; j < 16; ++j) { const unsigned c = xb_ld(&bar[XB_XCNT(j)]); sum += c; cnt += (c > 0u) ? 1u : 0u; mine = (j == x) ? c : mine; }
        if (sum == G) break;
        __builtin_amdgcn_s_sleep(1);
        if ((++sp & 255u) == 0u) { if (xb_ld(&bar[XB_TMO])) break; if (sp > XB_SPIN_CAP) { atomicAdd(&bar[XB_TMO], 1u); break; } }
    }
    nloc = mine > 0u ? mine : 1u; nx = cnt > 0u ? cnt : 1u;
}

__device__ __forceinline__ void xcd_barrier(const XcdBarrier& b) {
    asm volatile("s_waitcnt vmcnt(0)" ::: "memory");
    __syncthreads();
    if (threadIdx.x == 0) {
        unsigned* bar = b.bar;
        __builtin_amdgcn_s_waitcnt(0);
        unsigned nloc = b.st[0], nx = b.st[1];
        if (nloc == 0u) { xcd_barrier_complete(bar, b.x, nloc, nx); b.st[0] = nloc; b.st[1] = nx; }
        const unsigned old = xb_add(&bar[XB_XSUB(b.x)], 1u);
        const unsigned gen = old / nloc;
        if (old + 1u == (gen + 1u) * nloc) {
            __builtin_amdgcn_fence(__ATOMIC_RELEASE, "agent");
            asm volatile("s_waitcnt vmcnt(0)" ::: "memory");
            const unsigned og = xb_add(&bar[XB_TOP], 1u);
            const unsigned tg = og / nx;
            if (og + 1u == (tg + 1u) * nx) xb_add(&bar[XB_TOPGEN], 1u);
            else XB_SPIN(xb_ld(&bar[XB_TOPGEN]) == tg, bar);
            __builtin_amdgcn_fence(__ATOMIC_ACQUIRE, "agent");
            xb_add(&bar[XB_XGEN(b.x)], 1u);
            asm volatile("s_waitcnt vmcnt(0)" ::: "memory");
        } else {
            XB_SPIN(xb_ld(&bar[XB_XGEN(b.x)]) == gen, bar);
            __builtin_amdgcn_fence(__ATOMIC_ACQUIRE, "agent");
            asm volatile("s_waitcnt vmcnt(0)" ::: "memory");
        }
    }
    __syncthreads();
}


struct Frame {
    LAS unsigned char* lds;
    volatile LAS unsigned* MISC;
    gu32* ctl;
    int tid, lane, wave, G;
};
__device__ __forceinline__ float wave_sum(float v) {
#pragma unroll
    for (int o = 1; o < 64; o <<= 1) v += __shfl_xor(v, o);
    return v;
}
__device__ __forceinline__ float wave_max(float v) {
#pragma unroll
    for (int o = 1; o < 64; o <<= 1) v = fmaxf(v, __shfl_xor(v, o));
    return v;
}
__device__ __forceinline__ int t5_bucket(int d) {
    if (d < 16) return d < 0 ? 0 : d;
    int b = 16;
    b += (d >= 19); b += (d >= 21); b += (d >= 24); b += (d >= 27); b += (d >= 31); b += (d >= 35); b += (d >= 40); b += (d >= 46);
    b += (d >= 52); b += (d >= 59); b += (d >= 67); b += (d >= 77); b += (d >= 87); b += (d >= 99); b += (d >= 113);
    return b;
}
template <class CM> __device__ __forceinline__ void tr_item(const float* W, int Nsrc, int K, bf16* WT, int item, int nblk, CM cm, LAS float* scr, int lane) {
    const int kb = item / nblk, nb = item % nblk, k0 = 64 * kb, n0 = 32 * nb;
    const int sc = cm(n0 + (lane & 31));
    float tv[32];
#pragma unroll
    for (int i = 0; i < 32; ++i) { const int kk = 2 * i + (lane >> 5); tv[i] = sc >= 0 ? W[(size_t)(k0 + kk) * Nsrc + sc] : 0.f; }
#pragma unroll
    for (int i = 0; i < 32; ++i) { const int kk = 2 * i + (lane >> 5); scr[kk * 33 + (lane & 31)] = tv[i]; }
    LDS_WAIT(); asm volatile("" ::: "memory");
    const int c = lane & 7;
#pragma unroll
    for (int j = 0; j < 4; ++j) { const int n = (lane >> 3) + 8 * j; const LAS float* s = scr + (8 * c) * 33 + n;
        v4u o; o.x = pk2(s[0 * 33], s[1 * 33]); o.y = pk2(s[2 * 33], s[3 * 33]); o.z = pk2(s[4 * 33], s[5 * 33]); o.w = pk2(s[6 * 33], s[7 * 33]);
        *(GAS v4u*)(WT + (size_t)(n0 + n) * K + k0 + 8 * c) = o; }
    LDS_WAIT(); asm volatile("" ::: "memory");
}
struct CmId { __device__ __forceinline__ int operator()(int n) const { return n; } };
struct CmWin { __device__ __forceinline__ int operator()(int n) const {
    if (n < 1280) return n;
    if (n < 2816) return n - 1280 + 2856;
    if (n < 4352) return n - 2816 + 1304;
    if (n < 4376) return n - 4352 + 1280;
    if (n < 4392) return n - 4376 + 2840;
    if (n < 4608) return -1;
    return n - 4608 + 4392; } };
struct CmFfn { __device__ __forceinline__ int operator()(int c) const { const int p = c >> 8, r = c & 255; return r < 128 ? 128 * p + r : FF + 128 * p + (r - 128); } };

struct Args { const float* in[22]; float* out; unsigned char* ws; int ph_lo, ph_hi; };

__device__ __forceinline__ void phase_weights(Frame& F, const Args& a, int l) {
    LAS float* scr = (LAS float*)(F.lds + RING_OFF + F.wave * 16384);
    const int gw = blockIdx.x * NWAVES + F.wave, NGW = F.G * NWAVES;
    unsigned char* ws = a.ws;
    constexpr int I_IN = 16 * (NIN / 32), I_BR = 8 * 32, I_O = 16 * 32, I_F1 = 16 * (2 * FF / 32), I_F2 = (FF / 64) * 32;
    constexpr int NIT = I_IN + 3 * I_BR + I_O + I_F1 + I_F2;
    for (int it = gw; it < NIT; it += NGW) {
        int r = it;
        if (r < I_IN) { tr_item(a.in[6] + (size_t)l * DM * DIN, DIN, DM, (bf16*)(ws + WS_WIN), r, NIN / 32, CmWin(), scr, F.lane); continue; } r -= I_IN;
        if (r < I_BR) { tr_item(a.in[16] + (size_t)l * 512 * DM, DM, 512, (bf16*)(ws + WS_WA), r, 32, CmId(), scr, F.lane); continue; } r -= I_BR;
        if (r < I_BR) { tr_item(a.in[17] + (size_t)l * 512 * DM, DM, 512, (bf16*)(ws + WS_WB), r, 32, CmId(), scr, F.lane); continue; } r -= I_BR;
        if (r < I_BR) { tr_item(a.in[18] + (size_t)l * 512 * DM, DM, 512, (bf16*)(ws + WS_WC), r, 32, CmId(), scr, F.lane); continue; } r -= I_BR;
        if (r < I_O) { tr_item(a.in[19] + (size_t)l * DM * DM, DM, DM, (bf16*)(ws + WS_WO), r, 32, CmId(), scr, F.lane); continue; } r -= I_O;
        if (r < I_F1) { tr_item(a.in[20] + (size_t)l * DM * 2 * FF, 2 * FF, DM, (bf16*)(ws + WS_WF1), r, 2 * FF / 32, CmFfn(), scr, F.lane); continue; } r -= I_F1;
        tr_item(a.in[21] + (size_t)l * FF * DM, DM, FF, (bf16*)(ws + WS_WF2), r, 32, CmId(), scr, F.lane);
    }
    for (int it = gw; it < 2 * 66 + 2; it += NGW) {
        if (it < 132) { const int kv = it / 66, r = it % 66;
            if (r < 64) tr_item(a.in[kv ? 11 : 9] + (size_t)l * 2048 * 64, 64, 2048, (bf16*)(ws + WS_CW1T) + (size_t)kv * 64 * 2048, r, 2, CmId(), scr, F.lane);
            else tr_item(a.in[kv ? 12 : 10] + (size_t)l * 64 * 64, 64, 64, (bf16*)(ws + WS_CW2T) + (size_t)kv * 64 * 64, r - 64, 2, CmId(), scr, F.lane); }
        else { const int kv = it - 132; const float* pe = a.in[kv ? 8 : 7] + (size_t)l * 2048; const float* w1 = a.in[kv ? 11 : 9] + (size_t)l * 2048 * 64; float acc = 0.f;
            for (int k = 0; k < 2048; ++k) acc += pe[k] * w1[(size_t)k * 64 + F.lane];
            ((float*)(ws + WS_CC0))[kv * 64 + F.lane] = acc; }
    }
}
__device__ __forceinline__ void phase_norm0(Frame& F, const float* x, const float* w, bf16* H) {
    const int gw = blockIdx.x * NWAVES + F.wave, NGW = F.G * NWAVES;
    for (int m = gw; m < M_; m += NGW) {
        const f32x4* xr = (const f32x4*)(x + (size_t)m * DM) + F.lane; f32x4 v[4]; float s = 0.f;
#pragma unroll
        for (int j = 0; j < 4; ++j) { v[j] = xr[64 * j]; s += v[j].x * v[j].x + v[j].y * v[j].y + v[j].z * v[j].z + v[j].w * v[j].w; }
        const float r = rsqrtf(wave_sum(s) * (1.f / DM) + NORM_EPS);
        unsigned long long* o8 = (unsigned long long*)(H + (size_t)m * DM) + F.lane;
#pragma unroll
        for (int j = 0; j < 4; ++j) { const f32x4 wv = ((const f32x4*)w)[F.lane + 64 * j];
            o8[64 * j] = (unsigned long long)pk2(v[j].x * r * wv.x, v[j].y * r * wv.y) | ((unsigned long long)pk2(v[j].z * r * wv.z, v[j].w * r * wv.w) << 32); }
    }
}
__device__ __forceinline__ void phase_resid(Frame& F, const float* y_, const float* xin, float* xout, const float* wpost, const float* wpre, bf16* hout) {
    const int gw = blockIdx.x * NWAVES + F.wave, NGW = F.G * NWAVES; const bf16* y = (const bf16*)y_;
    for (int m = gw; m < M_; m += NGW) {
        typedef unsigned u32x2r __attribute__((ext_vector_type(2)));
        const u32x2r* yr = (const u32x2r*)(y + (size_t)m * DM) + F.lane; const f32x4* xr = (const f32x4*)(xin + (size_t)m * DM) + F.lane;
        f32x4 v[4], xv[4]; float s = 0.f;
#pragma unroll
        for (int j = 0; j < 4; ++j) { const u32x2r yw = yr[64 * j]; v[j].x = __uint_as_float(yw.x << 16); v[j].y = __uint_as_float(yw.x & 0xffff0000u); v[j].z = __uint_as_float(yw.y << 16); v[j].w = __uint_as_float(yw.y & 0xffff0000u);
            xv[j] = xr[64 * j]; s += v[j].x * v[j].x + v[j].y * v[j].y + v[j].z * v[j].z + v[j].w * v[j].w; }
        const float r = rsqrtf(wave_sum(s) * (1.f / DM) + NORM_EPS); float s2 = 0.f;
        f32x4* xo = (f32x4*)(xout + (size_t)m * DM) + F.lane;
#pragma unroll
        for (int j = 0; j < 4; ++j) { const f32x4 wv = ((const f32x4*)wpost)[F.lane + 64 * j]; f32x4 n;
            n.x = xv[j].x + v[j].x * r * wv.x; n.y = xv[j].y + v[j].y * r * wv.y; n.z = xv[j].z + v[j].z * r * wv.z; n.w = xv[j].w + v[j].w * r * wv.w;
            xo[64 * j] = n; v[j] = n; s2 += n.x * n.x + n.y * n.y + n.z * n.z + n.w * n.w; }
        if (hout) { const float r2 = rsqrtf(wave_sum(s2) * (1.f / DM) + NORM_EPS);
            unsigned long long* o8 = (unsigned long long*)(hout + (size_t)m * DM) + F.lane;
#pragma unroll
            for (int j = 0; j < 4; ++j) { const f32x4 wv = ((const f32x4*)wpre)[F.lane + 64 * j];
                o8[64 * j] = (unsigned long long)pk2(v[j].x * r2 * wv.x, v[j].y * r2 * wv.y) | ((unsigned long long)pk2(v[j].z * r2 * wv.z, v[j].w * r2 * wv.w) << 32); } }
    }
}
__device__ __forceinline__ void unpack8(const v4u w, float (&k)[8]) {
    k[0] = __uint_as_float(w.x << 16); k[1] = __uint_as_float(w.x & 0xffff0000u); k[2] = __uint_as_float(w.y << 16); k[3] = __uint_as_float(w.y & 0xffff0000u);
    k[4] = __uint_as_float(w.z << 16); k[5] = __uint_as_float(w.z & 0xffff0000u); k[6] = __uint_as_float(w.w << 16); k[7] = __uint_as_float(w.w & 0xffff0000u);
}
__device__ __forceinline__ void dot4(const LAS float* qs, const bf16* kr, float (&d)[4]) {
    d[0] = d[1] = d[2] = d[3] = 0.f;
#pragma unroll 1
    for (int c = 0; c < 8; ++c) { asm volatile("" ::: "memory"); const v4u w = ((const v4u*)kr)[c]; float k[8]; unpack8(w, k);
#pragma unroll
        for (int e = 0; e < 8; ++e) { const int dd = c * 8 + e;
#pragma unroll
            for (int h = 0; h < 4; ++h) d[h] += qs[h * 64 + dd] * k[e]; } }
}
__device__ __forceinline__ float dot1(const LAS float* qs, const bf16* kr) {
    float d = 0.f;
#pragma unroll
    for (int c = 0; c < 8; ++c) { const v4u w = ((const v4u*)kr)[c]; float k[8]; unpack8(w, k);
#pragma unroll
        for (int e = 0; e < 8; ++e) d += qs[c * 8 + e] * k[e]; }
    return d;
}
__device__ __forceinline__ float gelu_tanh(float x) { const float u = 0.7978845608028654f * (x + 0.044715f * x * x * x); return 0.5f * x * (1.f + tanhf(u)); }

__device__ __forceinline__ void phase2_naive(Frame& F, const Args& a, int l) {
    const int gw = blockIdx.x * NWAVES + F.wave, NGW = F.G * NWAVES, lane = F.lane;
    const bf16* Y = (const bf16*)(a.ws + WS_Y);
    LAS float* scr = (LAS float*)(F.lds + RING_OFF + F.wave * 16384);
    for (int t = gw; t < 4 * 8 * 32; t += NGW) {
        const int blk = t & 31, h = (t >> 5) & 7, b = t >> 8;
        const bf16* src = Y + ((size_t)b * S_ + blk * 256) * YP + Y_CK + h * 64 + lane; float s = 0.f;
        for (int i = 0; i < 256; ++i) s += bf2f(src[(size_t)i * YP]);
        ((float*)(a.ws + WS_KMEAN))[(size_t)t * 64 + lane] = s * (1.f / 256.f);
    }
}
__device__ __forceinline__ void gla_scan_naive(Frame& F, const Args& a) {
    const bf16* Y = (const bf16*)(a.ws + WS_Y); const float* GA = (const float*)(a.ws + WS_GA); bf16* O16 = (bf16*)(a.ws + WS_O16);
    const int lane = F.lane;
    for (int task = blockIdx.x; task < 256; task += F.G) {
        const int eg = task & 15, h = (task >> 4) & 3, b = task >> 6, e = eg * 8 + F.wave;
        float Sst = 0.f;
        for (int t0 = 0; t0 < S_; t0 += 8) {
            float av[8], kv[8], qv[8], vv[8];
#pragma unroll
            for (int j = 0; j < 8; ++j) { const size_t row = (size_t)b * S_ + t0 + j;
                av[j] = GA[row * 256 + h * 64 + lane]; kv[j] = bf2f(Y[row * YP + Y_BK + h * 64 + lane]); qv[j] = bf2f(Y[row * YP + Y_BQ + h * 64 + lane]); vv[j] = bf2f(Y[row * YP + Y_BV + h * 128 + e]); }
#pragma unroll
            for (int j = 0; j < 8; ++j) { Sst = av[j] * Sst + kv[j] * vv[j]; const float o = wave_sum(qv[j] * Sst);
                if (lane == 0) O16[((size_t)b * S_ + t0 + j) * 512 + h * 128 + e] = (bf16)f2bf(o); }
        }
    }
}
__device__ __forceinline__ void nsa_cmp_naive(Frame& F, const Args& a) {
    const int gw = blockIdx.x * NWAVES + F.wave, NGW = F.G * NWAVES, lane = F.lane;
    bf16* Y = (bf16*)(a.ws + WS_Y); const float* rel = a.in[1];
    LAS float* scr = (LAS float*)(F.lds + RING_OFF + F.wave * 16384);
    LAS float* qs = scr; LAS float* sc = scr + 256; LAS float* s2 = scr + 256 + 2048;
    for (int task = gw; task < 8 * S_; task += NGW) {
        const int q = task & (S_ - 1), bg = task >> 13, g = bg & 1, b = bg >> 1;
        const size_t row = (size_t)b * S_ + q; bf16* Yr = Y + row * YP;
#pragma unroll
        for (int h = 0; h < 4; ++h) qs[h * 64 + lane] = bf2f(Yr[Y_AQ + (g * 4 + h) * 64 + lane]);
        float gt[4][3];
#pragma unroll
        for (int h = 0; h < 4; ++h)
#pragma unroll
            for (int br = 0; br < 3; ++br) gt[h][br] = sigm(bf2f(Yr[Y_AG + (g * 4 + h) * 3 + br]));
        WFENCE();
        const int cur = q >> 6, ncv = q >= 31 ? ((q - 31) >> 4) + 1 : 0;
        const bf16* KC = (const bf16*)(a.ws + WS_KCMP) + (size_t)bg * 512 * 64; const bf16* VC = (const bf16*)(a.ws + WS_VCMP) + (size_t)bg * 512 * 64;
        float mx[4] = {-1e30f, -1e30f, -1e30f, -1e30f};
        for (int i = 0; i < 8; ++i) { const int n = lane + 64 * i;
            if (n < ncv) { float d[4]; dot4(qs, KC + (size_t)n * 64, d); const int bk = t5_bucket(q - (16 * n + 31));
#pragma unroll
                for (int h = 0; h < 4; ++h) { const float s = d[h] + rel[bk * 16 + g * 4 + h] * LOG2E; sc[h * 512 + n] = s; mx[h] = fmaxf(mx[h], s); } }
            else {
#pragma unroll
                for (int h = 0; h < 4; ++h) sc[h * 512 + n] = 0.f; } }
        float ls[4] = {0.f, 0.f, 0.f, 0.f};
#pragma unroll
        for (int h = 0; h < 4; ++h) mx[h] = wave_max(mx[h]);
        WFENCE();
        for (int i = 0; i < 8; ++i) { const int n = lane + 64 * i;
            if (n < ncv) {
#pragma unroll
                for (int h = 0; h < 4; ++h) { const float e = exp2f(sc[h * 512 + n] - mx[h]); sc[h * 512 + n] = e; ls[h] += e; } } }
#pragma unroll
        for (int h = 0; h < 4; ++h) ls[h] = 1.f / fmaxf(wave_sum(ls[h]), 1e-20f);
        for (int i = 0; i < 8; ++i) { const int n = lane + 64 * i;
            if (n < ncv) {
#pragma unroll
                for (int h = 0; h < 4; ++h) sc[h * 512 + n] *= ls[h]; } }
        WFENCE();
        float v0, v1;
        { float t[2];
#pragma unroll
          for (int jj = 0; jj < 2; ++jj) { const int j = lane + 64 * jj; float v = 0.f;
              for (int n = 4 * j - 1; n <= 4 * j + 3; ++n) if (n >= 0 && n < 511) v += (sc[n] + sc[512 + n]) + (sc[1024 + n] + sc[1536 + n]);
              const bool forced = (j == 0) || (j == cur) || (j == cur - 1);
              t[jj] = forced ? 1e9f : (j <= cur ? v : -1e30f); }
          v0 = t[0]; v1 = t[1]; }
        bool sel0 = false, sel1 = false;
        for (int it = 0; it < 16; ++it) {
            const float c0 = sel0 ? -INFINITY : v0, c1 = sel1 ? -INFINITY : v1;
            const float mxv = wave_max(fmaxf(c0, c1));
            const unsigned long long m0 = __ballot(!sel0 && v0 == mxv);
            if (m0) { const int idx = __builtin_ctzll(m0); if (lane == idx) sel0 = true; }
            else { const unsigned long long m1 = __ballot(!sel1 && v1 == mxv); const int idx = m1 ? __builtin_ctzll(m1) : -1; if (lane == idx) sel1 = true; }
        }
        sel0 = sel0 && (lane <= cur); sel1 = sel1 && (lane + 64 <= cur);
        const unsigned long long sm0 = __ballot(sel0), sm1 = __ballot(sel1);
        float oc[4] = {0.f, 0.f, 0.f, 0.f};
        for (int n = 0; n < ncv; ++n) { const float vv = bf2f(VC[(size_t)n * 64 + lane]);
#pragma unroll
            for (int h = 0; h < 4; ++h) oc[h] += sc[h * 512 + n] * vv; }
        { unsigned* MK = (unsigned*)(a.ws + WS_MASK) + ((size_t)bg * S_ + q) * 4;
          if (lane == 0) { MK[0] = (unsigned)sm0; MK[1] = (unsigned)(sm0 >> 32); MK[2] = (unsigned)sm1; MK[3] = (unsigned)(sm1 >> 32); }
          bf16* T = (bf16*)(a.ws + WS_OATMP) + row * 512;
#pragma unroll
          for (int h = 0; h < 4; ++h) T[(g * 4 + h) * 64 + lane] = (bf16)f2bf(gt[h][0] * oc[h]); }
        WFENCE();
    }
}
__device__ __forceinline__ void nsa_naive(Frame& F, const Args& a) {
    const int gw = blockIdx.x * NWAVES + F.wave, NGW = F.G * NWAVES, lane = F.lane;
    bf16* Y = (bf16*)(a.ws + WS_Y); const float* rel = a.in[1];
    LAS float* scr = (LAS float*)(F.lds + RING_OFF + F.wave * 16384);
    LAS float* qs = scr; LAS float* sc = scr + 256; LAS float* s2 = scr + 256 + 2048;
    for (int task = gw; task < 8 * S_; task += NGW) {
        const int q = task & (S_ - 1), bg = task >> 13, g = bg & 1, b = bg >> 1;
        const size_t row = (size_t)b * S_ + q; bf16* Yr = Y + row * YP;
#pragma unroll
        for (int h = 0; h < 4; ++h) qs[h * 64 + lane] = bf2f(Yr[Y_AQ + (g * 4 + h) * 64 + lane]);
        float gt[4][3];
#pragma unroll
        for (int h = 0; h < 4; ++h)
#pragma unroll
            for (int br = 0; br < 3; ++br) gt[h][br] = sigm(bf2f(Yr[Y_AG + (g * 4 + h) * 3 + br]));
        WFENCE();
        const int cur = q >> 6, ncv = q >= 31 ? ((q - 31) >> 4) + 1 : 0;
        const bf16* KC = (const bf16*)(a.ws + WS_KCMP) + (size_t)bg * 512 * 64; const bf16* VC = (const bf16*)(a.ws + WS_VCMP) + (size_t)bg * 512 * 64;
        float mx[4] = {-1e30f, -1e30f, -1e30f, -1e30f};
        for (int i = 0; i < 8; ++i) { const int n = lane + 64 * i;
            if (n < ncv) { float d[4]; dot4(qs, KC + (size_t)n * 64, d); const int bk = t5_bucket(q - (16 * n + 31));
#pragma unroll
                for (int h = 0; h < 4; ++h) { const float s = d[h] + rel[bk * 16 + g * 4 + h] * LOG2E; sc[h * 512 + n] = s; mx[h] = fmaxf(mx[h], s); } }
            else {
#pragma unroll
                for (int h = 0; h < 4; ++h) sc[h * 512 + n] = 0.f; } }
        float ls[4] = {0.f, 0.f, 0.f, 0.f};
#pragma unroll
        for (int h = 0; h < 4; ++h) mx[h] = wave_max(mx[h]);
        WFENCE();
        for (int i = 0; i < 8; ++i) { const int n = lane + 64 * i;
            if (n < ncv) {
#pragma unroll
                for (int h = 0; h < 4; ++h) { const float e = exp2f(sc[h * 512 + n] - mx[h]); sc[h * 512 + n] = e; ls[h] += e; } } }
#pragma unroll
        for (int h = 0; h < 4; ++h) ls[h] = 1.f / fmaxf(wave_sum(ls[h]), 1e-20f);
        for (int i = 0; i < 8; ++i) { const int n = lane + 64 * i;
            if (n < ncv) {
#pragma unroll
                for (int h = 0; h < 4; ++h) sc[h * 512 + n] *= ls[h]; } }
        WFENCE();
        float v0, v1;
        { float t[2];
#pragma unroll
          for (int jj = 0; jj < 2; ++jj) { const int j = lane + 64 * jj; float v = 0.f;
              for (int n = 4 * j - 1; n <= 4 * j + 3; ++n) if (n >= 0 && n < 511) v += (sc[n] + sc[512 + n]) + (sc[1024 + n] + sc[1536 + n]);
              const bool forced = (j == 0) || (j == cur) || (j == cur - 1);
              t[jj] = forced ? 1e9f : (j <= cur ? v : -1e30f); }
          v0 = t[0]; v1 = t[1]; }
        bool sel0 = false, sel1 = false;
        for (int it = 0; it < 16; ++it) {
            const float c0 = sel0 ? -INFINITY : v0, c1 = sel1 ? -INFINITY : v1;
            const float mxv = wave_max(fmaxf(c0, c1));
            const unsigned long long m0 = __ballot(!sel0 && v0 == mxv);
            if (m0) { const int idx = __builtin_ctzll(m0); if (lane == idx) sel0 = true; }
            else { const unsigned long long m1 = __ballot(!sel1 && v1 == mxv); const int idx = m1 ? __builtin_ctzll(m1) : -1; if (lane == idx) sel1 = true; }
        }
        sel0 = sel0 && (lane <= cur); sel1 = sel1 && (lane + 64 <= cur);
        const unsigned long long sm0 = __ballot(sel0), sm1 = __ballot(sel1);
        float oc[4] = {0.f, 0.f, 0.f, 0.f};
        for (int n = 0; n < ncv; ++n) { const float vv = bf2f(VC[(size_t)n * 64 + lane]);
#pragma unroll
            for (int h = 0; h < 4; ++h) oc[h] += sc[h * 512 + n] * vv; }
        float ms[4] = {-1e30f, -1e30f, -1e30f, -1e30f}, lsel[4] = {0.f, 0.f, 0.f, 0.f}, os[4] = {0.f, 0.f, 0.f, 0.f};
        for (int j = 0; j <= cur; ++j) {
            const bool on = j < 64 ? ((sm0 >> j) & 1ull) : ((sm1 >> (j - 64)) & 1ull);
            if (!on) continue;
            const int kpos = 64 * j + lane; const bool valid = kpos <= q;
            float d[4]; dot4(qs, Y + ((size_t)b * S_ + kpos) * YP + Y_AKS + g * 64, d);
            const int bk = t5_bucket(q - kpos);
            WFENCE();
#pragma unroll
            for (int h = 0; h < 4; ++h) { const float s = valid ? d[h] + rel[bk * 16 + g * 4 + h] * LOG2E : -1e30f;
                const float mn = fmaxf(ms[h], wave_max(s)); const float p = valid ? exp2f(s - mn) : 0.f; s2[h * 64 + lane] = p;
                const float scl = exp2f(ms[h] - mn); lsel[h] = lsel[h] * scl + wave_sum(p); os[h] *= scl; ms[h] = mn; }
            WFENCE();
            const bf16* vb = Y + ((size_t)b * S_ + 64 * j) * YP + Y_AVS + g * 64 + lane;
            for (int kk = 0; kk < 64; ++kk) { const float vv = bf2f(vb[(size_t)kk * YP]);
#pragma unroll
                for (int h = 0; h < 4; ++h) os[h] += s2[h * 64 + kk] * vv; }
        }
        float mw[4] = {-1e30f, -1e30f, -1e30f, -1e30f}, lw[4] = {0.f, 0.f, 0.f, 0.f}, ow[4] = {0.f, 0.f, 0.f, 0.f};
        for (int c = 0; c < 8; ++c) {
            if (q - 64 * c < 0) break;
            const int dist = 64 * c + lane, kpos = q - dist; const bool valid = kpos >= 0;
            float d[4]; dot4(qs, Y + ((size_t)b * S_ + (valid ? kpos : 0)) * YP + Y_AKW + g * 64, d);
            const int bk = t5_bucket(dist);
            WFENCE();
#pragma unroll
            for (int h = 0; h < 4; ++h) { const float s = valid ? d[h] + rel[bk * 16 + g * 4 + h] * LOG2E : -1e30f;
                const float mn = fmaxf(mw[h], wave_max(s)); const float p = valid ? exp2f(s - mn) : 0.f; s2[h * 64 + lane] = p;
                const float scl = exp2f(mw[h] - mn); lw[h] = lw[h] * scl + wave_sum(p); ow[h] *= scl; mw[h] = mn; }
            WFENCE();
            for (int kk = 0; kk < 64; ++kk) { const int kp = q - 64 * c - kk; if (kp < 0) break;
                const float vv = bf2f(Y[((size_t)b * S_ + kp) * YP + Y_AVW + g * 64 + lane]);
#pragma unroll
                for (int h = 0; h < 4; ++h) ow[h] += s2[h * 64 + kk] * vv; }
        }
        WFENCE();
#pragma unroll
        for (int h = 0; h < 4; ++h) { const float o = gt[h][0] * oc[h] + gt[h][1] * os[h] / fmaxf(lsel[h], 1e-20f) + gt[h][2] * ow[h] / fmaxf(lw[h], 1e-20f);
            Yr[Y_AQ + (g * 4 + h) * 64 + lane] = (bf16)f2bf(o); }
    }
}
__device__ __forceinline__ void moba_naive(Frame& F, const Args& a) {
    const int gw = blockIdx.x * NWAVES + F.wave, NGW = F.G * NWAVES, lane = F.lane;
    bf16* Y = (bf16*)(a.ws + WS_Y); const float* rel = a.in[1]; const float* KM = (const float*)(a.ws + WS_KMEAN);
    LAS float* scr = (LAS float*)(F.lds + RING_OFF + F.wave * 16384);
    LAS float* qs = scr; LAS float* s2 = scr + 64;
    for (int task = gw; task < 32 * S_; task += NGW) {
        const int q = task & (S_ - 1), bh = task >> 13, h = bh & 7, b = bh >> 3;
        const size_t row = (size_t)b * S_ + q; bf16* Yr = Y + row * YP;
        WFENCE();
        qs[lane] = bf2f(Yr[Y_CQ + h * 64 + lane]);
        WFENCE();
        const int cur = q >> 8;
        float gs = -1e30f;
        if (lane < 32 && lane < cur) { const float* km = KM + ((size_t)bh * 32 + lane) * 64; float d = 0.f;
            for (int dd = 0; dd < 64; ++dd) d += qs[dd] * km[dd];
            gs = d; }
        if (lane >= 32) gs = -INFINITY;
        bool sel = false;
        for (int it = 0; it < 3; ++it) { const float c = sel ? -INFINITY : gs; const float mxv = wave_max(c);
            const unsigned long long m0 = __ballot(!sel && lane < 32 && gs == mxv); const int idx = m0 ? __builtin_ctzll(m0) : -1; if (lane == idx) sel = true; }
        sel = sel && (lane < cur);
        const unsigned smask = (unsigned)__ballot(sel);
        float mr = -1e30f, lr = 0.f, o = 0.f;
        for (int j = 0; j <= cur; ++j) {
            const bool own = (j == cur);
            if (!own && !((smask >> j) & 1u)) continue;
            for (int c = 0; c < 4; ++c) {
                const int kpos = 256 * j + 64 * c + lane; const bool valid = kpos <= q;
                if (256 * j + 64 * c > q) break;
                const float d = dot1(qs, Y + ((size_t)b * S_ + kpos) * YP + Y_CK + h * 64);
                const int bk = t5_bucket(q - kpos);
                const float s = valid ? d + rel[bk * 16 + 8 + h] * LOG2E : -1e30f;
                const float mn = fmaxf(mr, wave_max(s)); const float p = valid ? exp2f(s - mn) : 0.f;
                WFENCE(); s2[lane] = p; WFENCE();
                const float scl = exp2f(mr - mn); lr = lr * scl + wave_sum(p); o *= scl; mr = mn;
                const bf16* vb = Y + ((size_t)b * S_ + 256 * j + 64 * c) * YP + Y_CV + h * 64 + lane;
                for (int kk = 0; kk < 64; ++kk) o += s2[kk] * bf2f(vb[(size_t)kk * YP]);
            }
        }
        Yr[Y_CQ + h * 64 + lane] = (bf16)f2bf(o / fmaxf(lr, 1e-20f));
    }
}
constexpr int CW_Q = 8192;
__device__ __forceinline__ int next_unit(Frame& F, int k) {
    __syncthreads();
    if (F.tid == 0) F.MISC[16] = __hip_atomic_fetch_add(F.ctl + CW_Q + 64 * k, 1u, RLX_AGENT);
    __syncthreads();
    return (int)F.MISC[16];
}
__device__ __forceinline__ int next_unit_x(Frame& F, int qs, int nper, int x0, int& xo, int& xq) {
    for (;;) { if (xo >= 8) return -1; xq = (x0 + xo) & 7; const int i = next_unit(F, qs * 8 + xq); if (i < nper) return i; ++xo; }
}
__device__ __forceinline__ void moba_fast(Frame& F, const Args& a, int qk) {
    bf16* Y = (bf16*)(a.ws + WS_Y); const float* KM = (const float*)(a.ws + WS_KMEAN);
    const int x0 = (int)(xb_xcc_id() & 7u); int xo = 0, xq = 0;
    for (;;) {
        const int i = next_unit_x(F, qk, 128, x0, xo, xq); if (i < 0) break;
        const int qb = 31 - (i & 31), bh = xq + 8 * (i >> 5), b = bh >> 3, h = bh & 7; const long rowbase = (long)b * S_;
        attn::UArgs U{};
        U.Qb = Y + (rowbase + qb * 256) * YP + Y_CQ + h * 64; U.Kh = Y + rowbase * YP + Y_CK + h * 64; U.Vh = Y + rowbase * YP + Y_CV + h * 64; U.Ob = Y + (rowbase + qb * 256) * YP + Y_CQ + h * 64;
        U.NT = 4 * (qb + 1); U.q0 = qb * 256; U.kt0 = 0; U.hc = 8 + h; U.rel = a.in[1]; U.km = KM + (size_t)bh * 32 * 64; U.qb = qb;
        attn::attn_unit<0, 0, 8>(U, (char*)F.lds + RING_OFF);
    }
}
__device__ __forceinline__ void nsa_fast(Frame& F, const Args& a, int qk) {
    bf16* Y = (bf16*)(a.ws + WS_Y);
    const int x0 = (int)(xb_xcc_id() & 7u); int xo = 0, xq = 0;
    for (;;) {
        const int i = next_unit_x(F, qk, 128, x0, xo, xq); if (i < 0) break;
        const int qb = 31 - (i & 31), b = xq >> 1, g = xq & 1, h = g * 4 + (i >> 5); const long rowbase = (long)b * S_; const int q0 = qb * 256;
        attn::UArgs U{};
        U.Qb = Y + (rowbase + q0) * YP + Y_AQ + h * 64; U.Ob = Y + (rowbase + q0) * YP + Y_AQ + h * 64; U.q0 = q0; U.hc = h; U.rel = a.in[1]; U.gate = Y + (rowbase + q0) * YP;
        { const int T0 = 4 * qb - 8 > 0 ? 4 * qb - 8 : 0;
          U.Kh = Y + (rowbase + 64 * T0) * YP + Y_AKW + g * 64; U.Vh = Y + (rowbase + 64 * T0) * YP + Y_AVW + g * 64; U.NT = 4 * qb + 4 - T0; U.kt0 = 64 * T0; U.gcol = Y_AG + h * 3 + 2;
          attn::attn_unit<2, 1, 8>(U, (char*)F.lds + RING_OFF); }
        { U.Kh = Y + rowbase * YP + Y_AKS + g * 64; U.Vh = Y + rowbase * YP + Y_AVS + g * 64; U.NT = 4 * (qb + 1); U.kt0 = 0; U.gcol = Y_AG + h * 3 + 1;
          U.selg = (const unsigned*)(a.ws + WS_MASK) + ((size_t)(b * 2 + g) * S_ + q0) * 4; U.tmp = (const bf16*)(a.ws + WS_OATMP) + (rowbase + q0) * 512 + h * 64;
          attn::attn_unit<1, 2, 8>(U, (char*)F.lds + RING_OFF); }
    }
}
typedef float f32x16g __attribute__((ext_vector_type(16)));
constexpr int GP = 72;
constexpr int GL_GS = 0;
constexpr int GL_VT = 16640 + 0;
constexpr int GL_A0 = GL_VT + 128 * GP * 2;
constexpr int GL_A1 = GL_A0 + 64 * GP * 2;
constexpr int GL_A2 = GL_A1 + 64 * GP * 2;
constexpr int GL_SS = GL_A2 + 64 * GP * 2;
constexpr int GL_END = GL_SS + 1024;
static_assert(GL_END <= RING_BYTES, "GLA LDS map");
__device__ __forceinline__ int crow32(int r, int hi) { return (r & 3) + 8 * (r >> 2) + 4 * hi; }
__device__ __forceinline__ bf16x8 lds_frag(const LAS bf16* X, int row, int kk) { return *(const LAS bf16x8*)(X + row * GP + kk); }
__device__ __forceinline__ float sum16(float v) {
    v += __int_as_float(__builtin_amdgcn_update_dpp(0, __float_as_int(v), 0xB1, 0xf, 0xf, true));
    v += __int_as_float(__builtin_amdgcn_update_dpp(0, __float_as_int(v), 0x4E, 0xf, 0xf, true));
    v += __int_as_float(__builtin_amdgcn_update_dpp(0, __float_as_int(v), 0x141, 0xf, 0xf, true));
    v += __int_as_float(__builtin_amdgcn_update_dpp(0, __float_as_int(v), 0x140, 0xf, 0xf, true));
    return v;
}
__device__ __forceinline__ void gla_put_vT(LAS bf16* vT, const v4u w0, const v4u w1, int w, int lane) {
    const unsigned ww[8] = {w0.x, w0.y, w0.z, w0.w, w1.x, w1.y, w1.z, w1.w};
#pragma unroll
    for (int i = 0; i < 8; ++i) { vT[(w * 16 + 2 * i) * GP + lane] = (bf16)(ww[i] & 0xffffu); vT[(w * 16 + 2 * i + 1) * GP + lane] = (bf16)(ww[i] >> 16); }
}
__device__ __forceinline__ void gla_g1(Frame& F, const Args& a, int l) {
    const bf16* Y = (const bf16*)(a.ws + WS_Y); bf16* GST = (bf16*)(a.ws + WS_GST); float* DEC = (float*)(a.ws + WS_GDEC); float* BC = (float*)(a.ws + WS_BCUM);
    LAS bf16* vT = (LAS bf16*)(F.lds + RING_OFF + GL_VT); LAS bf16* kT = (LAS bf16*)(F.lds + RING_OFF + GL_A0);
    const int lane = F.lane, r32 = lane & 31, hi = lane >> 5, w = F.wave;
    for (int u = blockIdx.x; u < 2048; u += F.G) {
        const int c = u & 127, bh = u >> 7, h = bh & 3, b = bh >> 2; const size_t row = (size_t)b * S_ + c * 64 + lane; const bf16* Yt = Y + row * YP;
        const v4u bl0 = *(const v4u*)(Yt + Y_BLR), bl1 = *(const v4u*)(Yt + Y_BLR + 8), kw = *(const v4u*)(Yt + Y_BK + h * 64 + 8 * w);
        const v4u vw0 = *(const v4u*)(Yt + Y_BV + h * 128 + 16 * w), vw1 = *(const v4u*)(Yt + Y_BV + h * 128 + 16 * w + 8);
        const float* w2 = a.in[13] + (size_t)l * 16 * 256 + h * 64 + 8 * w; const float* bias = a.in[14] + (size_t)l * 256 + h * 64 + 8 * w;
        float blr[16]; { float k0[8], k1[8]; unpack8(bl0, k0); unpack8(bl1, k1);
#pragma unroll
            for (int i = 0; i < 8; ++i) { blr[i] = k0[i]; blr[8 + i] = k1[i]; } }
        float bc[8];
#pragma unroll
        for (int i = 0; i < 8; ++i) { float z = bias[i];
#pragma unroll
            for (int r = 0; r < 16; ++r) z += blr[r] * w2[r * 256 + i];
            float v = -(fmaxf(-z, 0.f) + __logf(1.f + __expf(-fabsf(z)))) * (1.f / 16.f);
#pragma unroll
            for (int o = 1; o < 64; o <<= 1) { const float n = __shfl_up(v, o); v += lane >= o ? n : 0.f; }
            bc[i] = v; }
        { float* bcp = BC + row * 256 + h * 64 + 8 * w; *(f32x4*)bcp = (f32x4){bc[0], bc[1], bc[2], bc[3]}; *(f32x4*)(bcp + 4) = (f32x4){bc[4], bc[5], bc[6], bc[7]}; }
        { float kk[8]; unpack8(kw, kk);
#pragma unroll
          for (int i = 0; i < 8; ++i) { const float bl = __shfl(bc[i], 63); kT[(8 * w + i) * GP + lane] = (bf16)f2bf(kk[i] * __expf(bl - bc[i])); if (lane == i) DEC[(size_t)u * 64 + 8 * w + i] = __expf(bl); } }
        gla_put_vT(vT, vw0, vw1, w, lane);
        __syncthreads();
        { const int et = w >> 1, dt = w & 1; f32x16g acc = {};
#pragma unroll
          for (int ks = 0; ks < 4; ++ks) acc = __builtin_amdgcn_mfma_f32_32x32x16_bf16(lds_frag(vT, et * 32 + r32, ks * 16 + hi * 8), lds_frag(kT, dt * 32 + r32, ks * 16 + hi * 8), acc, 0, 0, 0);
          bf16* slot = GST + (size_t)u * 8192;
#pragma unroll
          for (int r = 0; r < 16; ++r) slot[(et * 32 + crow32(r, hi)) * 64 + dt * 32 + r32] = (bf16)f2bf(acc[r]); }
        __syncthreads();
    }
}
__device__ __forceinline__ void gla_g2(Frame& F, const Args& a) {
    unsigned* GST = (unsigned*)(a.ws + WS_GST); const float* DEC = (const float*)(a.ws + WS_GDEC);
    for (int i = blockIdx.x * 512 + F.tid; i < 16 * 128 * 32; i += F.G * 512) {
        const int dp = i & 31, bh = i >> 12; const int eo = (i >> 5) & 127;
        float s0 = 0.f, s1 = 0.f;
        for (int c0 = 0; c0 < 128; c0 += 8) {
            unsigned uu[8]; float d0[8], d1[8];
#pragma unroll
            for (int j = 0; j < 8; ++j) { const size_t sl = (size_t)(bh * 128 + c0 + j); uu[j] = GST[sl * 4096 + eo * 32 + dp]; d0[j] = DEC[sl * 64 + 2 * dp]; d1[j] = DEC[sl * 64 + 2 * dp + 1]; }
#pragma unroll
            for (int j = 0; j < 8; ++j) { const size_t sl = (size_t)(bh * 128 + c0 + j); GST[sl * 4096 + eo * 32 + dp] = pk2(s0, s1);
                s0 = s0 * d0[j] + __uint_as_float(uu[j] << 16); s1 = s1 * d1[j] + __uint_as_float(uu[j] & 0xffff0000u); }
        }
    }
}
__device__ __forceinline__ void gla_g3(Frame& F, const Args& a, int l, int qk) {
    bf16* Y = (bf16*)(a.ws + WS_Y); const bf16* GST = (const bf16*)(a.ws + WS_GST); const float* nw = a.in[15] + (size_t)l * 128; const float* BC = (const float*)(a.ws + WS_BCUM);
    LAS bf16* vT = (LAS bf16*)(F.lds + RING_OFF + GL_VT);
    LAS bf16* qd = (LAS bf16*)(F.lds + RING_OFF + GL_A0); LAS bf16* kd = (LAS bf16*)(F.lds + RING_OFF + GL_A1); LAS bf16* at = (LAS bf16*)(F.lds + RING_OFF + GL_A2);
    LAS float* ssq = (LAS float*)(F.lds + RING_OFF + GL_SS);
    const int lane = F.lane, r32 = lane & 31, hi = lane >> 5, w = F.wave, rb = w >> 2, et = w & 3;
    const int x0 = (int)(xb_xcc_id() & 7u); int xo = 0, xq = 0;
    for (;;) {
        const int i3 = next_unit_x(F, qk, 256, x0, xo, xq); if (i3 < 0) break;
        const int u = xq * 256 + i3;
        const int c = u & 127, bh = u >> 7, h = bh & 3, b = bh >> 2; bf16* Yc = Y + ((size_t)b * S_ + c * 64) * YP; const bf16* Yt = Yc + (size_t)lane * YP;
        const v4u qw = *(const v4u*)(Yt + Y_BQ + h * 64 + 8 * w), kw = *(const v4u*)(Yt + Y_BK + h * 64 + 8 * w);
        const v4u vw0 = *(const v4u*)(Yt + Y_BV + h * 128 + 16 * w), vw1 = *(const v4u*)(Yt + Y_BV + h * 128 + 16 * w + 8);
        const float* bcp = BC + ((size_t)b * S_ + c * 64 + lane) * 256 + h * 64 + 8 * w; const f32x4 bc0 = *(const f32x4*)bcp, bc1 = *(const f32x4*)(bcp + 4);
        bf16x8 sb[4]; { const bf16* slot = GST + (size_t)u * 8192 + (size_t)(et * 32 + r32) * 64 + hi * 8;
#pragma unroll
            for (int ks = 0; ks < 4; ++ks) sb[ks] = *(const bf16x8*)(slot + ks * 16); }
        bf16 rr[16];
#pragma unroll
        for (int r = 0; r < 16; ++r) rr[r] = Yc[(size_t)(rb * 32 + crow32(r, hi)) * YP + Y_BR + h * 128 + et * 32 + r32];
        const float nwe = nw[et * 32 + r32];
        { float qq[8], kk[8]; unpack8(qw, qq); unpack8(kw, kk); const float bc[8] = {bc0.x, bc0.y, bc0.z, bc0.w, bc1.x, bc1.y, bc1.z, bc1.w}; unsigned qa[4], ka[4];
#pragma unroll
          for (int i = 0; i < 4; ++i) { qa[i] = pk2(qq[2 * i] * __expf(bc[2 * i]), qq[2 * i + 1] * __expf(bc[2 * i + 1])); ka[i] = pk2(kk[2 * i] * __expf(-bc[2 * i]), kk[2 * i + 1] * __expf(-bc[2 * i + 1])); }
          v4u qo, ko; qo.x = qa[0]; qo.y = qa[1]; qo.z = qa[2]; qo.w = qa[3]; ko.x = ka[0]; ko.y = ka[1]; ko.z = ka[2]; ko.w = ka[3];
          *(LAS v4u*)(qd + lane * GP + 8 * w) = qo; *(LAS v4u*)(kd + lane * GP + 8 * w) = ko; }
        gla_put_vT(vT, vw0, vw1, w, lane);
        __syncthreads();
        if (w < 4) { const int ib = w >> 1, jb = w & 1;
            if (jb <= ib) { f32x16g acc = {};
#pragma unroll
                for (int ks = 0; ks < 4; ++ks) acc = __builtin_amdgcn_mfma_f32_32x32x16_bf16(lds_frag(qd, ib * 32 + r32, ks * 16 + hi * 8), lds_frag(kd, jb * 32 + r32, ks * 16 + hi * 8), acc, 0, 0, 0);
#pragma unroll
                for (int r = 0; r < 16; ++r) { const int i = ib * 32 + crow32(r, hi), j = jb * 32 + r32; at[i * GP + j] = (bf16)f2bf(j <= i ? acc[r] : 0.f); } } }
        __syncthreads();
        { f32x16g acc = {};
#pragma unroll
          for (int ks = 0; ks < 4; ++ks) acc = __builtin_amdgcn_mfma_f32_32x32x16_bf16(lds_frag(qd, rb * 32 + r32, ks * 16 + hi * 8), sb[ks], acc, 0, 0, 0);
          for (int ks = 0; ks < 2 * (rb + 1); ++ks) acc = __builtin_amdgcn_mfma_f32_32x32x16_bf16(lds_frag(at, rb * 32 + r32, ks * 16 + hi * 8), lds_frag(vT, et * 32 + r32, ks * 16 + hi * 8), acc, 0, 0, 0);
          float sq[16];
#pragma unroll
          for (int r = 0; r < 16; ++r) { float v = sum16(acc[r] * acc[r]); v += __shfl_xor(v, 16); sq[r] = v; }
          if (r32 == 0) {
#pragma unroll
              for (int r = 0; r < 16; ++r) ssq[w * 32 + crow32(r, hi)] = sq[r]; }
          __syncthreads();
#pragma unroll
          for (int r = 0; r < 16; ++r) { const int tr = crow32(r, hi); const float tot = ssq[(rb * 4 + 0) * 32 + tr] + ssq[(rb * 4 + 1) * 32 + tr] + ssq[(rb * 4 + 2) * 32 + tr] + ssq[(rb * 4 + 3) * 32 + tr];
              const float rv = bf2f(rr[r]);
              Yc[(size_t)(rb * 32 + tr) * YP + Y_BR + h * 128 + et * 32 + r32] = (bf16)f2bf(acc[r] * rsqrtf(tot * (1.f / 128.f) + NORM_EPS) * nwe * (rv * sigm(rv))); } }
    }
}
constexpr int CL_IMP = 0, CL_BIAS = 64 * 129 * 4, CL_K = CL_BIAS + 2048, CL_GATE = CL_K + 512 * GP * 2, CL_END = CL_GATE + 1024;
static_assert(CL_END <= RING_BYTES && (CL_K % 16) == 0, "cmp LDS map");
__device__ __forceinline__ int red8(int v) {
    v += __builtin_amdgcn_update_dpp(0, v, 0xB1, 0xf, 0xf, true);
    v += __builtin_amdgcn_update_dpp(0, v, 0x4E, 0xf, 0xf, true);
    v += __builtin_amdgcn_update_dpp(0, v, 0x141, 0xf, 0xf, true);
    return v;
}
typedef unsigned u32x2g __attribute__((ext_vector_type(2)));
struct VFrag { u32x2g a[8]; };
__device__ __forceinline__ void cmp_load_v(VFrag& f, const bf16* VT, int nt, int r32, int hi) {
#pragma unroll
    for (int dt = 0; dt < 2; ++dt)
#pragma unroll
        for (int kk = 0; kk < 2; ++kk) { const bf16* vp = VT + (size_t)(dt * 32 + r32) * 512 + nt * 32 + kk * 16 + 4 * hi; f.a[(dt * 2 + kk) * 2] = *(const u32x2g*)vp; f.a[(dt * 2 + kk) * 2 + 1] = *(const u32x2g*)(vp + 8); }
}
__device__ __forceinline__ void nsa_cmp_fast(Frame& F, const Args& a, int qk) {
    const bf16* Y = (const bf16*)(a.ws + WS_Y); const float* rel = a.in[1];
    LAS unsigned* impI = (LAS unsigned*)(F.lds + RING_OFF + CL_IMP); LAS float* biasT = (LAS float*)(F.lds + RING_OFF + CL_BIAS); LAS bf16* Ks = (LAS bf16*)(F.lds + RING_OFF + CL_K);
    const int lane = F.lane, r32 = lane & 31, hi = lane >> 5, w = F.wave, hr = w >> 1, qh = w & 1;
    const int x0 = (int)(xb_xcc_id() & 7u); int xo = 0, xq = 0;
    for (;;) {
        const int i = next_unit_x(F, qk, 128, x0, xo, xq); if (i < 0) break;
        const int c = 127 - i, bg = xq, g = bg & 1, b = bg >> 1, q0 = 64 * c; const size_t rowbase = (size_t)b * S_;
        const bf16* KC = (const bf16*)(a.ws + WS_KCMP) + (size_t)bg * 512 * 64; const bf16* VT = (const bf16*)(a.ws + WS_VCMPT) + (size_t)bg * 64 * 512;
        const int head = g * 4 + hr, qw0 = q0 + qh * 32, qpos = qw0 + r32;
        const int NTw = (qw0 / 16 + 1 + 31) >> 5;
        const int nrows = (((q0 + 32) / 16 + 1 + 31) >> 5) * 32;
        { v4u kv[8]; int tl = F.tid; asm volatile("" : "+v"(tl));
          const unsigned o0_ = (unsigned)((tl >> 3) * 64 + (tl & 7) * 8);
#pragma unroll
          for (int j = 0; j < 8; ++j) { const int p = tl + 512 * j; if (p < nrows * 8) kv[j] = *(const v4u*)(KC + o0_ + 4096u * j); }
          for (int ii = F.tid; ii < 64 * 129; ii += 512) impI[ii] = 0u;
          { const int hh = F.tid >> 7, dd = F.tid & 127; biasT[F.tid] = (rel[t5_bucket(dd) * 16 + g * 4 + hh] - rel[31 * 16 + g * 4 + hh]) * LOG2E; }
#pragma unroll
          for (int j = 0; j < 8; ++j) { const int p = tl + 512 * j; if (p < nrows * 8) *(LAS v4u*)(Ks + ((tl >> 3) + 64 * j) * GP + (tl & 7) * 8) = kv[j]; } }
        const bf16* Qw = Y + (rowbase + qw0) * YP + Y_AQ + head * 64;
        bf16x8 qr[4];
#pragma unroll
        for (int ks = 0; ks < 4; ++ks) qr[ks] = *(const bf16x8*)(Qw + (size_t)r32 * YP + ks * 16 + hi * 8);
        if (hi == 0) ((LAS float*)(F.lds + RING_OFF + CL_GATE))[w * 32 + r32] = sigm(bf2f(Y[(rowbase + qw0 + r32) * YP + Y_AG + head * 3]));
        __syncthreads();
        const LAS float* bT = biasT + hr * 128;
        float lsum = 0.f;
#pragma unroll 1
        for (int nt = 0; nt < NTw; ++nt) { f32x16g C = {};
#pragma unroll
            for (int ks = 0; ks < 4; ++ks) C = __builtin_amdgcn_mfma_f32_32x32x16_bf16(lds_frag(Ks, nt * 32 + r32, ks * 16 + hi * 8), qr[ks], C, 0, 0, 0);
#pragma unroll
            for (int r = 0; r < 16; ++r) { const int dist = qpos - (16 * (nt * 32 + crow32(r, hi)) + 31); lsum += dist >= 0 ? __builtin_amdgcn_exp2f(fminf(C[r] + bT[dist > 127 ? 127 : (dist < 0 ? 0 : dist)], 100.f)) : 0.f; } }
        { auto rr = __builtin_amdgcn_permlane32_swap(__float_as_uint(lsum), __float_as_uint(lsum), false, false); lsum = __uint_as_float(rr[0]) + __uint_as_float(rr[1]); }
        const float inv = 1.f / fmaxf(lsum, 1e-30f);
        f32x16g o0 = {}, o1 = {};
#pragma unroll 1
        for (int nt = 0; nt < NTw; ++nt) {
            VFrag vcur; cmp_load_v(vcur, VT, nt, r32, hi);
            f32x16g C = {};
#pragma unroll
            for (int ks = 0; ks < 4; ++ks) C = __builtin_amdgcn_mfma_f32_32x32x16_bf16(lds_frag(Ks, nt * 32 + r32, ks * 16 + hi * 8), qr[ks], C, 0, 0, 0);
            float p[16];
#pragma unroll
            for (int r = 0; r < 16; ++r) { const int dist = qpos - (16 * (nt * 32 + crow32(r, hi)) + 31); p[r] = dist >= 0 ? __builtin_amdgcn_exp2f(fminf(C[r] + bT[dist > 127 ? 127 : (dist < 0 ? 0 : dist)], 100.f)) * inv : 0.f; }
#pragma unroll
            for (int m = 0; m < 4; ++m) { const float G = (p[4 * m] + p[4 * m + 1]) + (p[4 * m + 2] + p[4 * m + 3]); const int j = nt * 8 + 2 * m + hi;
                LAS unsigned* ip = impI + (qh * 32 + r32) * 129 + j;
                __hip_atomic_fetch_add(ip, (unsigned)(G * 67108864.f + 0.5f), __ATOMIC_RELAXED, __HIP_MEMORY_SCOPE_WORKGROUP);
                if (j + 1 < 128) __hip_atomic_fetch_add(ip + 1, (unsigned)(p[4 * m + 3] * 67108864.f + 0.5f), __ATOMIC_RELAXED, __HIP_MEMORY_SCOPE_WORKGROUP); }
            v4u pw0, pw1; pw0.x = pk2(p[0], p[1]); pw0.y = pk2(p[2], p[3]); pw0.z = pk2(p[4], p[5]); pw0.w = pk2(p[6], p[7]); pw1.x = pk2(p[8], p[9]); pw1.y = pk2(p[10], p[11]); pw1.z = pk2(p[12], p[13]); pw1.w = pk2(p[14], p[15]);
            const bf16x8 pa0 = __builtin_bit_cast(bf16x8, pw0), pa1 = __builtin_bit_cast(bf16x8, pw1);
#pragma unroll
            for (int dt = 0; dt < 2; ++dt)
#pragma unroll
                for (int kk = 0; kk < 2; ++kk) { v4u vv; vv.x = vcur.a[(dt * 2 + kk) * 2].x; vv.y = vcur.a[(dt * 2 + kk) * 2].y; vv.z = vcur.a[(dt * 2 + kk) * 2 + 1].x; vv.w = vcur.a[(dt * 2 + kk) * 2 + 1].y;
                    if (dt == 0) o0 = __builtin_amdgcn_mfma_f32_32x32x16_bf16(kk ? pa1 : pa0, __builtin_bit_cast(bf16x8, vv), o0, 0, 0, 0);
                    else o1 = __builtin_amdgcn_mfma_f32_32x32x16_bf16(kk ? pa1 : pa0, __builtin_bit_cast(bf16x8, vv), o1, 0, 0, 0); }
            }
        { bf16* T = (bf16*)(a.ws + WS_OATMP);
#pragma unroll
          for (int r = 0; r < 16; ++r) { const size_t row = rowbase + qw0 + crow32(r, hi); const float gs = ((const LAS float*)(F.lds + RING_OFF + CL_GATE))[w * 32 + crow32(r, hi)];
              T[row * 512 + head * 64 + r32] = (bf16)f2bf(gs * o0[r]); T[row * 512 + head * 64 + 32 + r32] = (bf16)f2bf(gs * o1[r]); } }
        __syncthreads();
        { const int qi = F.tid >> 3, part = F.tid & 7, cur = c; unsigned key[16];
#pragma unroll
          for (int i2 = 0; i2 < 16; ++i2) { const int j = part * 16 + i2; const unsigned raw = impI[qi * 129 + j] >> 6; const bool forced = (j == 0) || (j == cur) || (j == cur - 1);
              key[i2] = forced ? (0xFFFFFF80u | (unsigned)(127 - j)) : (j <= cur ? ((((raw > 33554430u ? 33554430u : raw) + 1u) << 7) | (unsigned)(127 - j)) : (unsigned)(127 - j)); }
          unsigned T = 0u;
          for (int bit = 31; bit >= 0; --bit) { const unsigned Tt = T | (1u << bit); int cnt = 0;
#pragma unroll
              for (int i2 = 0; i2 < 16; ++i2) cnt += key[i2] >= Tt ? 1 : 0;
              cnt = red8(cnt); if (cnt >= 16) T = Tt; }
          unsigned bits = 0u;
#pragma unroll
          for (int i2 = 0; i2 < 16; ++i2) bits |= (key[i2] >= T && (part * 16 + i2) <= cur) ? (1u << i2) : 0u;
          ((unsigned short*)(a.ws + WS_MASK))[((size_t)bg * S_ + q0 + qi) * 8 + part] = (unsigned short)bits; }
    }
}
constexpr int CP_RED = 0, CP_HS = 8 * 32 * 64 * 4, CP_END = CP_HS + 32 * GP * 2;
static_assert(CP_END <= RING_BYTES, "compress LDS map");
__device__ __forceinline__ void compress_fast(Frame& F, const Args& a) {
    const bf16* Y = (const bf16*)(a.ws + WS_Y);
    LAS float* red = (LAS float*)(F.lds + RING_OFF + CP_RED); LAS bf16* hs = (LAS bf16*)(F.lds + RING_OFF + CP_HS);
    const int lane = F.lane, r32 = lane & 31, hi = lane >> 5, w = F.wave;
    for (int u = blockIdx.x; u < 256; u += F.G) {
        const int nt = u & 15, bg = (u >> 4) & 7, kv = u >> 7, g = bg & 1, b = bg >> 1;
        const int n = nt * 32 + r32, nn = n > 510 ? 510 : n;
        const bf16* xrow = Y + ((size_t)b * S_ + 16 * nn) * YP + (kv ? Y_AVC : Y_AKC) + g * 64 + hi * 8;
        const bf16* W1T = (const bf16*)(a.ws + WS_CW1T) + (size_t)kv * 64 * 2048;
        f32x16g acc0 = {}, acc1 = {};
#pragma unroll 4
        for (int s = 0; s < 16; ++s) { const int ks = w * 16 + s, pos = ks >> 2;
            const bf16x8 af = *(const bf16x8*)(xrow + (size_t)pos * YP + (ks & 3) * 16);
            const bf16x8 b0 = *(const bf16x8*)(W1T + (size_t)r32 * 2048 + ks * 16 + hi * 8), b1 = *(const bf16x8*)(W1T + (size_t)(32 + r32) * 2048 + ks * 16 + hi * 8);
            acc0 = __builtin_amdgcn_mfma_f32_32x32x16_bf16(af, b0, acc0, 0, 0, 0); acc1 = __builtin_amdgcn_mfma_f32_32x32x16_bf16(af, b1, acc1, 0, 0, 0); }
#pragma unroll
        for (int r = 0; r < 16; ++r) { red[(w * 32 + crow32(r, hi)) * 64 + r32] = acc0[r]; red[(w * 32 + crow32(r, hi)) * 64 + 32 + r32] = acc1[r]; }
        __syncthreads();
        { const float* c0 = (const float*)(a.ws + WS_CC0) + kv * 64;
#pragma unroll
          for (int i = 0; i < 4; ++i) { const int e = F.tid * 4 + i, rn = e >> 6, j = e & 63; float v = c0[j];
#pragma unroll
              for (int ww = 0; ww < 8; ++ww) v += red[(ww * 32 + rn) * 64 + j];
              hs[rn * GP + j] = (bf16)f2bf(gelu_tanh(v)); } }
        __syncthreads();
        if (w < 2) { const bf16* W2T = (const bf16*)(a.ws + WS_CW2T) + (size_t)kv * 64 * 64; f32x16g o = {};
#pragma unroll
            for (int ks = 0; ks < 4; ++ks) { const bf16x8 bf = *(const bf16x8*)(W2T + (size_t)(w * 32 + r32) * 64 + ks * 16 + hi * 8);
                o = __builtin_amdgcn_mfma_f32_32x32x16_bf16(lds_frag(hs, r32, ks * 16 + hi * 8), bf, o, 0, 0, 0); }
#pragma unroll
            for (int r = 0; r < 16; ++r) { const int rn = nt * 32 + crow32(r, hi), jp = w * 32 + r32;
                if (kv == 0) ((bf16*)(a.ws + WS_KCMP))[((size_t)bg * 512 + rn) * 64 + jp] = (bf16)f2bf(o[r]);
                else ((bf16*)(a.ws + WS_VCMPT))[((size_t)bg * 64 + jp) * 512 + rn] = (bf16)f2bf(o[r]); } }
        __syncthreads();
    }
}
__device__ __forceinline__ void gla_out_naive(Frame& F, const Args& a, int l) {
    const int gw = blockIdx.x * NWAVES + F.wave, NGW = F.G * NWAVES, lane = F.lane;
    bf16* Y = (bf16*)(a.ws + WS_Y); const bf16* O16 = (const bf16*)(a.ws + WS_O16); const float* nw = a.in[15] + (size_t)l * 128;
    for (int t = gw; t < M_ * 4; t += NGW) {
        const int h = t & 3; const size_t row = (size_t)(t >> 2);
        const float o0 = bf2f(O16[row * 512 + h * 128 + lane]), o1 = bf2f(O16[row * 512 + h * 128 + 64 + lane]);
        const float r = rsqrtf(wave_sum(o0 * o0 + o1 * o1) * (1.f / 128.f) + NORM_EPS);
        bf16* yr = Y + row * YP + Y_BR + h * 128;
        const float r0 = bf2f(yr[lane]), r1 = bf2f(yr[64 + lane]);
        yr[lane] = (bf16)f2bf(o0 * r * nw[lane] * (r0 * sigm(r0))); yr[64 + lane] = (bf16)f2bf(o1 * r * nw[64 + lane] * (r1 * sigm(r1)));
    }
}

__device__ __forceinline__ Frame fresh(const Frame& F) { Frame f = F; int t = threadIdx.x; asm volatile("" : "+v"(t)); f.tid = t; f.lane = t & 63; return f; }
constexpr int PPL = 11, NPH = NL * PPL;
#define IN(k) (lo <= (k) && (k) < hi)
#define SEAM(k) do { if (IN(k) && IN((k) + 1)) xcd_barrier(bar); } while (0)
template <int l> __device__ __forceinline__ void layer_body(Frame& F0, const Args& args, const XcdBarrier& bar, const int lo, const int hi) {
    unsigned char* ws = args.ws;
    bf16* H = (bf16*)(ws + WS_H); bf16* Y = (bf16*)(ws + WS_Y); unsigned char* G8 = ws + WS_G8;
    float* Yf = (float*)(ws + WS_Y); bf16* ACT = (bf16*)(ws + WS_ACT);
    constexpr int p0 = l * PPL;
    const float* xin = l == 0 ? args.in[0] : args.out;
    if (IN(p0 + 0)) { Frame F = fresh(F0); phase_weights(F, args, l); if (l == 0) phase_norm0(F, args.in[0], args.in[2], H); SEAM(p0 + 0); }
    if (IN(p0 + 1)) { Frame F = fresh(F0);
        pg8::Gemm g{H, (const bf16*)(ws + WS_WIN), M_, NIN, DM, DM}; pg8::StaticOrder So; So.init(M_, NIN, F.G, (int)blockIdx.x);
        pg8::EpiInProj E{Y, G8};
        pg8::gemm_phase<pg8::EpiInProj, pg8::StaticOrder, true, true>(F.lds + RING_OFF, g, So, E);
        SEAM(p0 + 1);
    }
    if (IN(p0 + 2)) { { Frame F = fresh(F0); compress_fast(F, args); } { Frame F = fresh(F0); phase2_naive(F, args, l); } { Frame F = fresh(F0); gla_g1(F, args, l); } SEAM(p0 + 2); }
    if (IN(p0 + 3)) { { Frame F = fresh(F0); gla_g2(F, args); } { Frame F = fresh(F0); moba_fast(F, args, l * 4 + 0); } { Frame F = fresh(F0); nsa_cmp_fast(F, args, l * 4 + 1); } SEAM(p0 + 3); }
    if (IN(p0 + 4)) { { Frame F = fresh(F0); nsa_fast(F, args, l * 4 + 2); } { Frame F = fresh(F0); gla_g3(F, args, l, l * 4 + 3); } SEAM(p0 + 4); }
    if (IN(p0 + 5)) { Frame F = fresh(F0);
        pg8::StaticOrder So; So.init(M_, DM, F.G, (int)blockIdx.x);
        { pg8::Gemm g{Y + Y_AQ, (const bf16*)(ws + WS_WA), M_, DM, 512, YP}; pg8::EpiMerge<0> E{H, G8}; pg8::gemm_phase<pg8::EpiMerge<0>, pg8::StaticOrder, true, true>(F.lds + RING_OFF, g, So, E); }
        __syncthreads();
        { pg8::Gemm g{Y + Y_BR, (const bf16*)(ws + WS_WB), M_, DM, 512, YP}; pg8::EpiMerge<1> E{H, G8}; pg8::gemm_phase<pg8::EpiMerge<1>, pg8::StaticOrder, true, true>(F.lds + RING_OFF, g, So, E); }
        __syncthreads();
        { pg8::Gemm g{Y + Y_CQ, (const bf16*)(ws + WS_WC), M_, DM, 512, YP}; pg8::EpiMerge<2> E{H, G8}; pg8::gemm_phase<pg8::EpiMerge<2>, pg8::StaticOrder, true, true>(F.lds + RING_OFF, g, So, E); }
        SEAM(p0 + 5);
    }
    if (IN(p0 + 6)) { Frame F = fresh(F0);
        pg8::Gemm g{H, (const bf16*)(ws + WS_WO), M_, DM, DM, DM}; pg8::StaticOrder So; So.init(M_, DM, F.G, (int)blockIdx.x);
        pg8::EpiB16 E{(bf16*)Yf, DM}; pg8::gemm_phase<pg8::EpiB16, pg8::StaticOrder, true, true>(F.lds + RING_OFF, g, So, E);
        SEAM(p0 + 6);
    }
    if (IN(p0 + 7)) { Frame F = fresh(F0); phase_resid(F, Yf, xin, args.out, args.in[3] + (size_t)l * DM, args.in[4] + (size_t)l * DM, H); SEAM(p0 + 7); }
    if (IN(p0 + 8)) { Frame F = fresh(F0);
        pg8::Gemm g{H, (const bf16*)(ws + WS_WF1), M_, 2 * FF, DM, DM}; pg8::StaticOrder So; So.init(M_, 2 * FF, F.G, (int)blockIdx.x);
        pg8::EpiSwiglu E{ACT, FF}; pg8::gemm_phase<pg8::EpiSwiglu, pg8::StaticOrder, true, true>(F.lds + RING_OFF, g, So, E);
        SEAM(p0 + 8);
    }
    if (IN(p0 + 9)) { Frame F = fresh(F0);
        pg8::Gemm g{ACT, (const bf16*)(ws + WS_WF2), M_, DM, FF, FF}; pg8::StaticOrder So; So.init(M_, DM, F.G, (int)blockIdx.x);
        pg8::EpiB16 E{(bf16*)Yf, DM}; pg8::gemm_phase<pg8::EpiB16, pg8::StaticOrder, true, true>(F.lds + RING_OFF, g, So, E);
        SEAM(p0 + 9);
    }
    if (IN(p0 + 10)) { Frame F = fresh(F0); phase_resid(F, Yf, args.out, args.out, args.in[5] + (size_t)l * DM, l + 1 < NL ? args.in[2] + (size_t)(l + 1) * DM : nullptr, l + 1 < NL ? H : nullptr); SEAM(p0 + 10); }
}
__global__ void __launch_bounds__(NWAVES * 64, 2) mk_fwd(Args args) {
    extern __shared__ __attribute__((aligned(16))) unsigned char lds[];
    Frame F;
    F.lds = (LAS unsigned char*)lds; F.MISC = (volatile LAS unsigned*)(F.lds + MISC_OFF);
    F.tid = threadIdx.x; F.lane = F.tid & 63; F.wave = __builtin_amdgcn_readfirstlane(F.tid >> 6); F.G = gridDim.x;
    F.ctl = (gu32*)(args.ws + WS_CTL);
    for (int u = F.tid; u < (LDS_BYTES - LDSCTL_OFF) / 4; u += NWAVES * 64) ((LAS unsigned*)(F.lds + LDSCTL_OFF))[u] = 0u;
    __syncthreads();
    const int lo = args.ph_lo, hi = args.ph_hi;
    XcdBarrier bar; bar.bar = (unsigned*)(F.ctl + CW_BAR); bar.x = 0; bar.st = nullptr;
    if (hi - lo > 1) bar = xcd_barrier_post((unsigned*)(F.ctl + CW_BAR), F.MISC + 8);
    layer_body<0>(F, args, bar, lo, hi);
    layer_body<1>(F, args, bar, lo, hi);
}
#undef IN
#undef SEAM

#ifndef MK_ONE_LAUNCH
#define MK_ONE_LAUNCH 1
#endif
extern "C" void kernel_launch(void* const* d_in, const int* in_sizes, int n_in, void* d_out, int out_size, void* d_ws, size_t ws_size, hipStream_t stream) {
    static int grid = 0;
    if (grid == 0) {
        if (n_in != 22 || out_size != M_ * DM || ws_size < WS_END) { fprintf(stderr, "kernel_launch: unexpected sizes (n_in %d out %d ws %zu)\n", n_in, out_size, ws_size); grid = -1; return; }
        int dev = 0, cus = 0;
        if (hipGetDevice(&dev) != hipSuccess || hipDeviceGetAttribute(&cus, hipDeviceAttributeMultiprocessorCount, dev) != hipSuccess) { grid = -1; return; }
        if (hipFuncSetAttribute((const void*)mk_fwd, hipFuncAttributeMaxDynamicSharedMemorySize, LDS_BYTES) != hipSuccess) { grid = -1; return; }
        (void)hipGetLastError();
        grid = cus;
    }
    if (grid < 0) return;
    if (hipMemsetAsync((char*)d_ws + WS_CTL, 0, CTL_ZERO_BYTES, stream) != hipSuccess) return;
    Args a{};
    for (int i = 0; i < 22; ++i) a.in[i] = (const float*)d_in[i];
    a.out = (float*)d_out; a.ws = (unsigned char*)d_ws;
#if MK_ONE_LAUNCH
    a.ph_lo = 0; a.ph_hi = NPH;
    hipLaunchKernelGGL(mk_fwd, dim3(grid), dim3(NWAVES * 64), LDS_BYTES, stream, a);
#else
    for (int p = 0; p < NPH; ++p) { a.ph_lo = p; a.ph_hi = p + 1; hipLaunchKernelGGL(mk_fwd, dim3(grid), dim3(NWAVES * 64), LDS_BYTES, stream, a); }
#endif
}
```

```cpp
#include <hip/hip_runtime.h>
#include <cstdio>
#include <cstdint>
#include <cmath>
namespace pg8 {
#define PG8_LAS __attribute__((address_space(3)))
typedef unsigned short bf16_t;
typedef short bf16x8 __attribute__((ext_vector_type(8)));
typedef float f32x4 __attribute__((ext_vector_type(4)));
typedef unsigned u32x4 __attribute__((ext_vector_type(4)));
constexpr int BM = 256, BK = 64, HALF = 128, HTB = HALF * BK * 2  , STAGE_BYTES = 8 * HTB, NXCD = 8, WGM = 8;

__host__ __device__ __forceinline__ int lds_byte(int r, int c) { const int st = (r >> 4) * 2 + (c >> 5), rr = r & 15, cc = c & 31, ob = rr * 64 + cc * 2; return st * 1024 + (ob ^ (((ob >> 9) & 1) << 5)); }
__host__ __device__ __forceinline__ void stage_rc(int b, int& R, int& C) { const int st = b / 1024, sb = b % 1024, swz = sb ^ (((sb >> 9) & 1) << 5); R = (st >> 1) * 16 + swz / 64; C = (st & 1) * 32 + (swz % 64) / 2; }
__host__ __device__ __forceinline__ int perm32(int rho) { const int n = rho >> 4, i = rho & 15; return 8 * (i >> 2) + 4 * n + (i & 3); }

struct Unit { int pm, pn, pnb, k; };
struct Gemm { const bf16_t* A; const bf16_t* Bt; int M, N, K, lda; int ac0, ac1, ac2;
    __host__ __device__ __forceinline__ int acol(int k) const { return ac0 + (k & 1) * (ac1 - ac0) + (k >> 1) * (ac2 - ac0);   } };

struct StaticOrder {
    int nM, nN, nwg, G, c;
    __host__ __device__ void init(int M, int N, int G_, int c_) { nM = M / BM; nN = N / BM; nwg = nM * nN; G = G_; c = c_; }
    __host__ __device__ __forceinline__ bool next(int i, Unit& u) const {
        const long L = (long)i * G + c; if (L >= nwg) return false;
        int wgid = (int)L; { const int q = nwg / NXCD, r = nwg % NXCD, xcd = wgid % NXCD, off = wgid / NXCD; wgid = (xcd < r ? xcd * (q + 1) : r * (q + 1) + (xcd - r) * q) + off; }
        const int nig = WGM * nN, gid = wgid / nig, fm = gid * WGM, gsz = (nM - fm) < WGM ? (nM - fm) : WGM;
        u.pm = fm + ((wgid % nig) % gsz); u.pn = (wgid % nig) / gsz; u.pnb = u.pn; u.k = 0; return true;
    }
    __device__ __forceinline__ void a_ready(const Unit&) const {}
    __device__ __forceinline__ void done(const Unit&) const {}
};

__device__ __forceinline__ unsigned cvt_pk_bf16(float lo, float hi) { unsigned r; asm volatile("v_cvt_pk_bf16_f32 %0, %1, %2" : "=v"(r) : "v"(lo), "v"(hi)); return r; }
typedef float f32x2 __attribute__((ext_vector_type(2)));
constexpr int YP_ = 4392;
constexpr float C2_ = 0.125f * 1.4426950408889634f;
__device__ __forceinline__ float sigmoidf_(float v) { return 1.f / (1.f + __expf(-v)); }
struct EpiInProj {
    static constexpr bool PERM = true, AFTER_DRAIN = false, FUSE3 = false;
    bf16_t* Y; unsigned char* G8;
    __device__ __forceinline__ void operator()(const f32x4 (&acc)[2][2][4][2], const Unit& u, int wr, int wc, int fr, int fq) const {
        const int row0 = u.pm * BM + wr * 64 + fr, colt = u.pn * BM, cin = wc * 32 + 8 * fq;
        if (u.pn < 18) {
            float sc = 1.f; if (u.pn < 2 || u.pn == 5 || u.pn == 6) sc = C2_; else if (u.pn == 11) sc = 0.125f;
#pragma unroll
            for (int ai = 0; ai < 2; ++ai)
#pragma unroll
                for (int m = 0; m < 4; ++m) { bf16_t* rowp = Y + (size_t)(row0 + ai * HALF + m * 16) * YP_;
#pragma unroll
                    for (int bj = 0; bj < 2; ++bj) { const int col = colt + cin + bj * HALF;
                        if (col + 8 <= YP_) { const f32x4 v0 = acc[ai][bj][m][0] * sc, v1 = acc[ai][bj][m][1] * sc; u32x4 w;
                            w.x = cvt_pk_bf16(v0[0], v0[1]); w.y = cvt_pk_bf16(v0[2], v0[3]); w.z = cvt_pk_bf16(v1[0], v1[1]); w.w = cvt_pk_bf16(v1[2], v1[3]);
                            *(u32x4*)(rowp + col) = w; } } }
        } else {
#pragma unroll
            for (int ai = 0; ai < 2; ++ai)
#pragma unroll
                for (int m = 0; m < 4; ++m) { unsigned char* rowp = G8 + (size_t)(row0 + ai * HALF + m * 16) * 3072 + (colt - 4608) + cin;
#pragma unroll
                    for (int bj = 0; bj < 2; ++bj) { const f32x4 v0 = acc[ai][bj][m][0], v1 = acc[ai][bj][m][1]; unsigned lo = 0u, hi = 0u;
#pragma unroll
                        for (int e = 0; e < 4; ++e) { lo |= (unsigned)(sigmoidf_(v0[e]) * 255.f + 0.5f) << (8 * e); hi |= (unsigned)(sigmoidf_(v1[e]) * 255.f + 0.5f) << (8 * e); }
                        typedef unsigned u32x2 __attribute__((ext_vector_type(2))); u32x2 w; w.x = lo; w.y = hi; *(u32x2*)(rowp + bj * HALF) = w; } }
        }
    }
};
template <int I> struct EpiMerge {
    static constexpr bool PERM = true, AFTER_DRAIN = false, FUSE3 = false;
    bf16_t* Mg; const unsigned char* G8;
    __device__ __forceinline__ void operator()(const f32x4 (&acc)[2][2][4][2], const Unit& u, int wr, int wc, int fr, int fq) const {
        const int row0 = u.pm * BM + wr * 64 + fr, col0 = u.pn * BM + wc * 32 + 8 * fq;
#pragma unroll
        for (int ai = 0; ai < 2; ++ai)
#pragma unroll
            for (int m = 0; m < 4; ++m) { const size_t row = (size_t)(row0 + ai * HALF + m * 16);
#pragma unroll
                for (int bj = 0; bj < 2; ++bj) { const int col = col0 + bj * HALF;
                    typedef unsigned u32x2 __attribute__((ext_vector_type(2)));
                    const u32x2 gw = *(const u32x2*)(G8 + row * 3072 + I * 1024 + col);
                    float v[8];
#pragma unroll
                    for (int e = 0; e < 4; ++e) { v[e] = acc[ai][bj][m][0][e] * ((float)((gw.x >> (8 * e)) & 255u) * (1.f / 255.f)); v[4 + e] = acc[ai][bj][m][1][e] * ((float)((gw.y >> (8 * e)) & 255u) * (1.f / 255.f)); }
                    bf16_t* p = Mg + row * 1024 + col;
                    if (I > 0) { const u32x4 o = *(const u32x4*)p;
                        v[0] += __uint_as_float(o.x << 16); v[1] += __uint_as_float(o.x & 0xffff0000u); v[2] += __uint_as_float(o.y << 16); v[3] += __uint_as_float(o.y & 0xffff0000u);
                        v[4] += __uint_as_float(o.z << 16); v[5] += __uint_as_float(o.z & 0xffff0000u); v[6] += __uint_as_float(o.w << 16); v[7] += __uint_as_float(o.w & 0xffff0000u); }
                    u32x4 w; w.x = cvt_pk_bf16(v[0], v[1]); w.y = cvt_pk_bf16(v[2], v[3]); w.z = cvt_pk_bf16(v[4], v[5]); w.w = cvt_pk_bf16(v[6], v[7]);
                    *(u32x4*)p = w; } }
    }
};
struct Fuse3Order {
    StaticOrder So;
    __host__ __device__ __forceinline__ bool next(int i, Unit& u) const { const int su = i / 3, k = i - 3 * su; if (!So.next(su, u)) return false; u.k = k; u.pnb = u.pn + 4 * k; return true; }
    __device__ __forceinline__ void a_ready(const Unit&) const {}
    __device__ __forceinline__ void done(const Unit&) const {}
};
struct EpiMerge3 {
    static constexpr bool PERM = true, AFTER_DRAIN = false, FUSE3 = true;
    bf16_t* Mg; const unsigned char* G8;
    typedef unsigned u32x2 __attribute__((ext_vector_type(2)));
    __device__ __forceinline__ void scale(f32x4 (&acc)[2][2][4][2], const Unit& u, int wr, int wc, int fr, int fq) const {
        const int row0 = u.pm * BM + wr * 64 + fr, col0 = u.pn * BM + wc * 32 + 8 * fq;
#pragma unroll
        for (int ai = 0; ai < 2; ++ai)
#pragma unroll
            for (int m = 0; m < 4; ++m) { const unsigned char* gp = G8 + (size_t)(row0 + ai * HALF + m * 16) * 3072 + u.k * 1024 + col0;
#pragma unroll
                for (int bj = 0; bj < 2; ++bj) { const u32x2 ga = *(const u32x2*)(gp + bj * HALF), gb = *(const u32x2*)(gp + bj * HALF + 1024);
#pragma unroll
                    for (int e = 0; e < 4; ++e) {
                        const float na = (float)((ga.x >> (8 * e)) & 255u), nb = fmaxf((float)((gb.x >> (8 * e)) & 255u), 0.5f);
                        const float nc = (float)((ga.y >> (8 * e)) & 255u), nd = fmaxf((float)((gb.y >> (8 * e)) & 255u), 0.5f);
                        const float fa = u.k == 0 ? na : fmaxf(na, 0.5f), fc = u.k == 0 ? nc : fmaxf(nc, 0.5f);
                        acc[ai][bj][m][0][e] *= fa * __builtin_amdgcn_rcpf(nb); acc[ai][bj][m][1][e] *= fc * __builtin_amdgcn_rcpf(nd); } } }
    }
    __device__ __forceinline__ void operator()(const f32x4 (&acc)[2][2][4][2], const Unit& u, int wr, int wc, int fr, int fq) const {
        const int row0 = u.pm * BM + wr * 64 + fr, col0 = u.pn * BM + wc * 32 + 8 * fq;
#pragma unroll
        for (int ai = 0; ai < 2; ++ai)
#pragma unroll
            for (int m = 0; m < 4; ++m) { const size_t row = (size_t)(row0 + ai * HALF + m * 16);
#pragma unroll
                for (int bj = 0; bj < 2; ++bj) { const int col = col0 + bj * HALF; const u32x2 gw = *(const u32x2*)(G8 + row * 3072 + 2048 + col); float v[8];
#pragma unroll
                    for (int e = 0; e < 4; ++e) { v[e] = acc[ai][bj][m][0][e] * (fmaxf((float)((gw.x >> (8 * e)) & 255u), 0.5f) * (1.f / 255.f)); v[4 + e] = acc[ai][bj][m][1][e] * (fmaxf((float)((gw.y >> (8 * e)) & 255u), 0.5f) * (1.f / 255.f)); }
                    u32x4 w; w.x = cvt_pk_bf16(v[0], v[1]); w.y = cvt_pk_bf16(v[2], v[3]); w.z = cvt_pk_bf16(v[4], v[5]); w.w = cvt_pk_bf16(v[6], v[7]);
                    *(u32x4*)(Mg + row * 1024 + col) = w; } }
    }
};
struct EpiB16 {
    static constexpr bool PERM = true, AFTER_DRAIN = false, FUSE3 = false;
    bf16_t* O; int ldc;
    __device__ __forceinline__ void operator()(const f32x4 (&acc)[2][2][4][2], const Unit& u, int wr, int wc, int fr, int fq) const {
        const int row0 = u.pm * BM + wr * 64 + fr, col0 = u.pn * BM + wc * 32 + 8 * fq;
#pragma unroll
        for (int ai = 0; ai < 2; ++ai)
#pragma unroll
            for (int m = 0; m < 4; ++m) { bf16_t* rowp = O + (size_t)(row0 + ai * HALF + m * 16) * ldc + col0;
#pragma unroll
                for (int bj = 0; bj < 2; ++bj) { const f32x4 v0 = acc[ai][bj][m][0], v1 = acc[ai][bj][m][1]; u32x4 w;
                    w.x = cvt_pk_bf16(v0[0], v0[1]); w.y = cvt_pk_bf16(v0[2], v0[3]); w.z = cvt_pk_bf16(v1[0], v1[1]); w.w = cvt_pk_bf16(v1[2], v1[3]);
                    *(u32x4*)(rowp + bj * HALF) = w; } }
    }
};
struct EpiF32 {
    static constexpr bool PERM = true, AFTER_DRAIN = false, FUSE3 = false;
    float* O; int ldc;
    __device__ __forceinline__ void operator()(const f32x4 (&acc)[2][2][4][2], const Unit& u, int wr, int wc, int fr, int fq) const {
        const int row0 = u.pm * BM + wr * 64 + fr, col0 = u.pn * BM + wc * 32 + 8 * fq;
#pragma unroll
        for (int ai = 0; ai < 2; ++ai)
#pragma unroll
            for (int m = 0; m < 4; ++m) { float* rowp = O + (size_t)(row0 + ai * HALF + m * 16) * ldc + col0;
#pragma unroll
                for (int bj = 0; bj < 2; ++bj) { *(f32x4*)(rowp + bj * HALF) = acc[ai][bj][m][0]; *(f32x4*)(rowp + bj * HALF + 4) = acc[ai][bj][m][1]; } }
    }
};
struct EpiSwiglu {
    static constexpr bool PERM = true, AFTER_DRAIN = false, FUSE3 = false;
    bf16_t* Act; int ldc;
    __device__ __forceinline__ void operator()(const f32x4 (&acc)[2][2][4][2], const Unit& u, int wr, int wc, int fr, int fq) const {
        const int row0 = u.pm * BM + wr * 64 + fr, col0 = u.pn * HALF + wc * 32 + 8 * fq;
#pragma unroll
        for (int ai = 0; ai < 2; ++ai)
#pragma unroll
            for (int m = 0; m < 4; ++m) { bf16_t* p = Act + (size_t)(row0 + ai * HALF + m * 16) * ldc + col0; float v[8];
#pragma unroll
                for (int e = 0; e < 4; ++e) { const float g0 = acc[ai][0][m][0][e], g1 = acc[ai][0][m][1][e];
                    v[e] = g0 * sigmoidf_(g0) * acc[ai][1][m][0][e]; v[4 + e] = g1 * sigmoidf_(g1) * acc[ai][1][m][1][e]; }
                u32x4 w; w.x = cvt_pk_bf16(v[0], v[1]); w.y = cvt_pk_bf16(v[2], v[3]); w.z = cvt_pk_bf16(v[4], v[5]); w.w = cvt_pk_bf16(v[6], v[7]);
                *(u32x4*)p = w; }
    }
};
template <class Epi, class Sched, bool ALIGN_EPI = false, bool SP2 = false>
__device__ __forceinline__ void gemm_phase(PG8_LAS unsigned char* lds, const Gemm g, const Sched& S, const Epi& E) {
    int tid_l = threadIdx.x; asm volatile("" : "+v"(tid_l));
    const int tid = tid_l, wid = __builtin_amdgcn_readfirstlane(tid >> 6), lane = tid & 63, wr = wid >> 2, wc = wid & 3, fr = lane & 15, fq = lane >> 4;
    const int K = g.K, nt = K / BK;
    unsigned voffA[2], voffB[2];
#pragma unroll
    for (int i = 0; i < 2; ++i) { int R, C; stage_rc(tid * 16 + i * 8192, R, C); const int Rb = Epi::PERM ? ((R & ~31) + perm32(R & 31)) : R;
        voffA[i] = (unsigned)(R * g.lda + C) * 2u; voffB[i] = (unsigned)(Rb * K + C) * 2u; }
    const size_t kstep = (size_t)(BK * 2);
    const size_t hstepB = (size_t)HALF * K * 2, hstepA = (size_t)HALF * g.lda * 2;
    const size_t tstepA = 2 * hstepA, tstepB = 2 * hstepB;
    const unsigned ldsw = (unsigned)wid * 1024u;
    const int aoff = lds_byte(wr * 64 + fr, fq * 8), boff = lds_byte(wc * 32 + fr, fq * 8);
#define PG8_SA(b, h) (((b) * 2 + (h)) * HTB)
#define PG8_SB(b, h) ((4 + (b) * 2 + (h)) * HTB)
#define PG8_STAGE(bufoff, gbase, voff) do { _Pragma("unroll") for (int _i = 0; _i < 2; ++_i) \
        __builtin_amdgcn_global_load_lds((const unsigned*)((const char*)(gbase) + (voff)[_i]), (PG8_LAS unsigned*)(lds + (bufoff) + ldsw + _i * 8192), 16, 0, 0); } while (0)
#define PG8_LDA(dst, b, h) do { _Pragma("unroll") for (int m = 0; m < 4; ++m) _Pragma("unroll") for (int k = 0; k < 2; ++k) dst[m][k] = *(const PG8_LAS bf16x8*)(lds + PG8_SA(b, h) + aoff + m * 2048 + k * 1024); } while (0)
#define PG8_LDB(dst, b, h) do { _Pragma("unroll") for (int n = 0; n < 2; ++n) _Pragma("unroll") for (int k = 0; k < 2; ++k) dst[n][k] = *(const PG8_LAS bf16x8*)(lds + PG8_SB(b, h) + boff + n * 2048 + k * 1024); } while (0)
#define PG8_MMA(ai, bj, At, Bt) do { __builtin_amdgcn_s_setprio(1); _Pragma("unroll") for (int m = 0; m < 4; ++m) _Pragma("unroll") for (int n = 0; n < 2; ++n) _Pragma("unroll") for (int k = 0; k < 2; ++k) \
        acc[ai][bj][m][n] = __builtin_amdgcn_mfma_f32_16x16x32_bf16(Bt[n][k], At[m][k], acc[ai][bj][m][n], 0, 0, 0); __builtin_amdgcn_s_setprio(0); } while (0)
#define PG8_WAIT_V(n) asm volatile("s_waitcnt vmcnt(" #n ")" ::: "memory")
#define PG8_WAIT_L(n) asm volatile("s_waitcnt lgkmcnt(" #n ")" ::: "memory")
#define PG8_BAR __builtin_amdgcn_s_barrier()
#define PG8_SCHED __builtin_amdgcn_sched_barrier(0)
    Unit cur, nxt; int ui = 0;
    if (!S.next(0, cur)) return;
    f32x4 acc[2][2][4][2];
#pragma unroll
    for (int a = 0; a < 2; ++a)
#pragma unroll
        for (int b = 0; b < 2; ++b)
#pragma unroll
            for (int m = 0; m < 4; ++m)
#pragma unroll
                for (int n = 0; n < 2; ++n) acc[a][b][m][n] = (f32x4){0.f, 0.f, 0.f, 0.f};
    bf16x8 At[4][2], B0[2][2], B1[2][2];
    const char* cA = (const char*)g.A + (size_t)g.acol(cur.k) * 2 + (size_t)cur.pm * tstepA; const char* cB = (const char*)g.Bt + (size_t)cur.pnb * tstepB;
    S.a_ready(cur);
    if constexpr (SP2) {
        PG8_STAGE(PG8_SB(0, 0), cB, voffB); PG8_STAGE(PG8_SB(0, 1), cB + hstepB, voffB); PG8_STAGE(PG8_SA(0, 0), cA, voffA); PG8_STAGE(PG8_SA(0, 1), cA + hstepA, voffA);
        if (wr == 1) PG8_BAR;
        PG8_WAIT_V(2); PG8_BAR;
        PG8_STAGE(PG8_SB(1, 0), cB + kstep, voffB); PG8_STAGE(PG8_SA(1, 0), cA + kstep, voffA); PG8_STAGE(PG8_SB(1, 1), cB + hstepB + kstep, voffB);
        PG8_WAIT_V(6); PG8_BAR;
    } else {
        PG8_STAGE(PG8_SB(0, 0), cB, voffB); PG8_STAGE(PG8_SA(0, 0), cA, voffA); PG8_STAGE(PG8_SB(0, 1), cB + hstepB, voffB); PG8_STAGE(PG8_SA(0, 1), cA + hstepA, voffA);
        if (wr == 1) PG8_BAR;
        PG8_WAIT_V(4); PG8_BAR;
        PG8_STAGE(PG8_SB(1, 0), cB + kstep, voffB); PG8_STAGE(PG8_SA(1, 0), cA + kstep, voffA); PG8_STAGE(PG8_SB(1, 1), cB + hstepB + kstep, voffB);
        PG8_WAIT_V(6); PG8_BAR;
    }
    for (;;) {
        const bool has_next = S.next(ui + 1, nxt);
        const char* nA = has_next ? (const char*)g.A + (size_t)g.acol(nxt.k) * 2 + (size_t)nxt.pm * tstepA : cA; const char* nB = has_next ? (const char*)g.Bt + (size_t)nxt.pnb * tstepB : cB;
        for (int t = 0; t < nt; t += 2) {
            const bool last = (t == nt - 2);
            const char* a1 = cA + (size_t)(t + 1) * kstep;
            const char* a2 = last ? nA : cA + (size_t)(t + 2) * kstep; const char* b2 = last ? nB : cB + (size_t)(t + 2) * kstep;
            const char* a3 = a2 + kstep; const char* b3 = b2 + kstep;
            if (last && has_next) S.a_ready(nxt);
            if constexpr (SP2) {
            PG8_LDB(B0, 0, 0); PG8_LDB(B1, 0, 1); PG8_SCHED; PG8_LDA(At, 0, 0); PG8_STAGE(PG8_SA(1, 1), a1 + hstepA, voffA);
            PG8_WAIT_V(8); PG8_WAIT_L(0); PG8_BAR; PG8_MMA(0, 0, At, B0); PG8_MMA(0, 1, At, B1); PG8_BAR; PG8_SCHED;
            PG8_LDA(At, 0, 1); PG8_STAGE(PG8_SB(0, 0), b2, voffB); PG8_STAGE(PG8_SB(0, 1), b2 + hstepB, voffB); PG8_STAGE(PG8_SA(0, 0), a2, voffA);
            PG8_WAIT_V(8); PG8_WAIT_L(0); PG8_BAR; PG8_MMA(1, 0, At, B0); PG8_MMA(1, 1, At, B1); PG8_BAR; PG8_SCHED;
            PG8_LDB(B0, 1, 0); PG8_LDB(B1, 1, 1); PG8_SCHED; PG8_LDA(At, 1, 0); PG8_STAGE(PG8_SA(0, 1), a2 + hstepA, voffA);
            PG8_WAIT_V(8); PG8_WAIT_L(0); PG8_BAR; PG8_MMA(0, 0, At, B0); PG8_MMA(0, 1, At, B1); PG8_BAR; PG8_SCHED;
            PG8_LDA(At, 1, 1); PG8_STAGE(PG8_SB(1, 0), b3, voffB); PG8_STAGE(PG8_SB(1, 1), b3 + hstepB, voffB); PG8_STAGE(PG8_SA(1, 0), a3, voffA);
            PG8_WAIT_V(8); PG8_WAIT_L(0); PG8_BAR; PG8_MMA(1, 0, At, B0); PG8_MMA(1, 1, At, B1); PG8_BAR; PG8_SCHED;
            } else {
            PG8_LDB(B0, 0, 0); PG8_SCHED; PG8_LDA(At, 0, 0); PG8_STAGE(PG8_SA(1, 1), a1 + hstepA, voffA);
            PG8_WAIT_L(8); PG8_BAR; PG8_WAIT_L(0); PG8_MMA(0, 0, At, B0); PG8_BAR; PG8_SCHED;
            PG8_LDB(B1, 0, 1); PG8_STAGE(PG8_SB(0, 0), b2, voffB);
            PG8_BAR; PG8_WAIT_L(0); PG8_MMA(0, 1, At, B1); PG8_BAR;
            PG8_LDA(At, 0, 1); PG8_STAGE(PG8_SA(0, 0), a2, voffA);
            PG8_BAR; PG8_WAIT_L(0); PG8_MMA(1, 0, At, B0); PG8_BAR; PG8_SCHED;
            PG8_STAGE(PG8_SB(0, 1), b2 + hstepB, voffB);
            PG8_WAIT_V(6); PG8_BAR; PG8_MMA(1, 1, At, B1); PG8_BAR;
            PG8_LDB(B0, 1, 0); PG8_SCHED; PG8_LDA(At, 1, 0); PG8_STAGE(PG8_SA(0, 1), a2 + hstepA, voffA);
            PG8_WAIT_L(8); PG8_BAR; PG8_WAIT_L(0); PG8_MMA(0, 0, At, B0); PG8_BAR; PG8_SCHED;
            PG8_LDB(B1, 1, 1); PG8_STAGE(PG8_SB(1, 0), b3, voffB);
            PG8_BAR; PG8_WAIT_L(0); PG8_MMA(0, 1, At, B1); PG8_BAR;
            PG8_LDA(At, 1, 1); PG8_STAGE(PG8_SA(1, 0), a3, voffA);
            PG8_BAR; PG8_WAIT_L(0); PG8_MMA(1, 0, At, B0); PG8_BAR; PG8_SCHED;
            PG8_STAGE(PG8_SB(1, 1), b3 + hstepB, voffB);
            PG8_WAIT_V(6); PG8_BAR; PG8_MMA(1, 1, At, B1); PG8_BAR;
            }
        }
        if constexpr (ALIGN_EPI) { if (wr == 0) PG8_BAR; }
        if constexpr (Epi::FUSE3) { if (cur.k < 2) E.scale(acc, cur, wr, wc, fr, fq); else E(acc, cur, wr, wc, fr, fq); }
        else if constexpr (!Epi::AFTER_DRAIN) { E(acc, cur, wr, wc, fr, fq); S.done(cur); }
        if (!has_next) break;
        if (!Epi::FUSE3 || cur.k == 2) {
#pragma unroll
        for (int a = 0; a < 2; ++a)
#pragma unroll
            for (int b = 0; b < 2; ++b)
#pragma unroll
                for (int m = 0; m < 4; ++m)
#pragma unroll
                    for (int n = 0; n < 2; ++n) acc[a][b][m][n] = (f32x4){0.f, 0.f, 0.f, 0.f};
        }
        cur = nxt; cA = nA; cB = nB; ++ui;
        if constexpr (ALIGN_EPI) { if (wr == 1) PG8_BAR; }
    }
    PG8_WAIT_V(0);
    if constexpr (!ALIGN_EPI) { if (wr == 0) PG8_BAR; }
    PG8_BAR;
    if constexpr (Epi::AFTER_DRAIN) { E.fused(acc, cur, wr, wc, fr, fq, lds, wid, lane); S.done(cur); }
#undef PG8_SA
#undef PG8_SB
#undef PG8_STAGE
#undef PG8_LDA
#undef PG8_LDB
#undef PG8_MMA
#undef PG8_WAIT_V
#undef PG8_WAIT_L
#undef PG8_BAR
#undef PG8_SCHED
}
}
namespace attn {
using bf16=unsigned short;
using bf16x8=__attribute__((ext_vector_type(8)))short;
using s16x4=__attribute__((ext_vector_type(4)))short;
using f32x16=__attribute__((ext_vector_type(16)))float;
using u32x4=__attribute__((ext_vector_type(4)))unsigned;
constexpr int D=64, PITCH=4392, SEQ=8192;
constexpr int NW=8,QBLK=32,QB=QBLK*NW,KVBLK=64;
__device__ __forceinline__ int crow(int r,int hi){return (r&3)+8*(r>>2)+4*hi;}
#define SBAR() __builtin_amdgcn_sched_barrier(0)
using f32x4_=__attribute__((ext_vector_type(4)))float;
__device__ __forceinline__ float bfs(short v){ return __uint_as_float(((unsigned)(unsigned short)v)<<16); }
__device__ __forceinline__ float lo16(unsigned w){ return __uint_as_float(w<<16); }
__device__ __forceinline__ float hi16(unsigned w){ return __uint_as_float(w&0xffff0000u); }
__device__ __forceinline__ bf16 f2b(float f){ unsigned u=__float_as_uint(f); return (bf16)((u+0x7fffu+((u>>16)&1u))>>16); }
__device__ __forceinline__ unsigned pk2b(float lo,float hi){ return (unsigned)f2b(lo)|((unsigned)f2b(hi)<<16); }
constexpr int NSLOT=3, SLOTB=8192;
constexpr int LDS_K=0, LDS_V=NSLOT*SLOTB, LDS_WS=2*NSLOT*SLOTB, LDS_OST=LDS_WS+NW*128*4, LDS_BIAS=LDS_OST+NW*4096, LDS_MSK=LDS_BIAS+512, LDS_KM=LDS_MSK+NW*512, LDS_BYTES=LDS_KM+8192;
constexpr float LOG2E_=1.4426950408889634f;
__device__ __forceinline__ void glds16(const void*gsrc,unsigned lds_dst){unsigned keep;
  asm volatile("s_mov_b32 %0, m0\n\ts_mov_b32 m0, %2\n\ts_nop 0\n\tglobal_load_lds_dwordx4 %1, off\n\ts_mov_b32 m0, %0":"=&s"(keep):"v"(gsrc),"s"(lds_dst):"memory");}
__device__ __forceinline__ float max3f(float a,float b,float c){float r;asm("v_max3_f32 %0, %1, %2, %3":"=v"(r):"v"(a),"v"(b),"v"(c));return r;}
__device__ __forceinline__ float max2f(float a,float b){float r;asm("v_max_f32_e32 %0, %1, %2":"=v"(r):"v"(a),"v"(b));return r;}
__device__ __forceinline__ float fadd_s(float a,float b){float r;asm("v_add_f32_e32 %0, %1, %2":"=v"(r):"v"(a),"v"(b));return r;}
__device__ __forceinline__ float fsub_s(float a,float b){float r;asm("v_sub_f32_e32 %0, %1, %2":"=v"(r):"v"(a),"v"(b));return r;}
typedef float f32x2_t __attribute__((ext_vector_type(2))); typedef __bf16 bf16x2_t __attribute__((ext_vector_type(2)));
__device__ __forceinline__ unsigned cvtpk_s(float lo,float hi){f32x2_t v={lo,hi};bf16x2_t b=__builtin_convertvector(v,bf16x2_t);return __builtin_bit_cast(unsigned,b);}
#define WAIT_BAR(N) asm volatile("s_waitcnt vmcnt(" #N ") lgkmcnt(0)\n\ts_barrier":::"memory")

__device__ __forceinline__ void qkt(f32x16&p0,f32x16&p1,const char*Kslot,const bf16x8*qr,const f32x16&negm,int r32,int hi){
  const char*kb=Kslot+hi*1024+r32*16;
  #pragma unroll
  for(int d0=0;d0<4;++d0){
    const bf16x8 b0=*reinterpret_cast<const bf16x8*>(kb+d0*2048);
    const bf16x8 b1=*reinterpret_cast<const bf16x8*>(kb+d0*2048+512);
    if(d0==0){p0=__builtin_amdgcn_mfma_f32_32x32x16_bf16(b0,qr[0],negm,0,0,0);p1=__builtin_amdgcn_mfma_f32_32x32x16_bf16(b1,qr[0],negm,0,0,0);}
    else{p0=__builtin_amdgcn_mfma_f32_32x32x16_bf16(b0,qr[d0],p0,0,0,0);p1=__builtin_amdgcn_mfma_f32_32x32x16_bf16(b1,qr[d0],p1,0,0,0);}}
}
typedef __attribute__((address_space(3))) const char* lds_cptr;
typedef short v4i16_t __attribute__((ext_vector_type(4)));
__device__ __forceinline__ void kload8(bf16x8*kf,lds_cptr kp){
  kf[0]=*(const __attribute__((address_space(3))) bf16x8*)(kp);      kf[1]=*(const __attribute__((address_space(3))) bf16x8*)(kp+512);
  kf[2]=*(const __attribute__((address_space(3))) bf16x8*)(kp+2048); kf[3]=*(const __attribute__((address_space(3))) bf16x8*)(kp+2560);
  kf[4]=*(const __attribute__((address_space(3))) bf16x8*)(kp+4096); kf[5]=*(const __attribute__((address_space(3))) bf16x8*)(kp+4608);
  kf[6]=*(const __attribute__((address_space(3))) bf16x8*)(kp+6144); kf[7]=*(const __attribute__((address_space(3))) bf16x8*)(kp+6656);
}
__device__ __forceinline__ void kload2(bf16x8*kf,lds_cptr kp,int j){ kf[2*j]=*(const __attribute__((address_space(3))) bf16x8*)(kp+j*2048); kf[2*j+1]=*(const __attribute__((address_space(3))) bf16x8*)(kp+j*2048+512); }
__device__ __forceinline__ s16x4 vtr(lds_cptr p){ return __builtin_bit_cast(s16x4,__builtin_amdgcn_ds_read_tr16_b64_v4i16((__attribute__((address_space(3))) v4i16_t*)p)); }
__device__ __forceinline__ float rowmax(const f32x16&p0,const f32x16&p1){
  float a=max3f(p0[0],p0[1],p1[0]),b=max3f(p0[2],p0[3],p1[1]);a=max3f(a,p1[2],p1[3]);
  #pragma unroll
  for(int r=4;r<16;r+=4){a=max3f(a,p0[r],p0[r+1]);b=max3f(b,p0[r+2],p0[r+3]);a=max3f(a,p1[r],p1[r+1]);b=max3f(b,p1[r+2],p1[r+3]);}
  const float m=max2f(a,b);
  auto rr=__builtin_amdgcn_permlane32_swap(__float_as_uint(m),__float_as_uint(m),false,false);
  return max2f(__uint_as_float(rr[0]),__uint_as_float(rr[1]));
}
__device__ __forceinline__ void pv(f32x16*o,int vb,bf16x8 pa0,bf16x8 pa1,bf16x8 pa2,bf16x8 pa3){
  #pragma unroll
  for(int d0=0;d0<2;++d0){s16x4 lo[4],hi[4];
    #pragma unroll
    for(int ks=0;ks<4;++ks){
      asm volatile("ds_read_b64_tr_b16 %0,%1 offset:%c2":"=&v"(lo[ks]):"v"(vb),"i"(d0*4096+ks*1024):"memory");
      asm volatile("ds_read_b64_tr_b16 %0,%1 offset:%c2":"=&v"(hi[ks]):"v"(vb),"i"(d0*4096+ks*1024+512):"memory");}
    asm volatile("s_waitcnt lgkmcnt(0)":::"memory");SBAR();
    #define PK(k) (bf16x8){lo[k][0],lo[k][1],lo[k][2],lo[k][3],hi[k][0],hi[k][1],hi[k][2],hi[k][3]}
    o[d0]=__builtin_amdgcn_mfma_f32_32x32x16_bf16(pa0,PK(0),o[d0],0,0,0);
    o[d0]=__builtin_amdgcn_mfma_f32_32x32x16_bf16(pa1,PK(1),o[d0],0,0,0);
    o[d0]=__builtin_amdgcn_mfma_f32_32x32x16_bf16(pa2,PK(2),o[d0],0,0,0);
    o[d0]=__builtin_amdgcn_mfma_f32_32x32x16_bf16(pa3,PK(3),o[d0],0,0,0);
    #undef PK
  }
}

#ifndef ATTN_STORE16
#define ATTN_STORE16(p,v) (*(u32x4*)(p)=(v))
#endif
struct UArgs {
  const bf16* Qb; const bf16* Kh; const bf16* Vh; bf16* Ob;
  int NT, q0, kt0, hc;
  const float* rel;
  const float* km; int qb;
  const unsigned* selg;
  const bf16* gate; int gcol;
  const bf16* tmp;
};
__device__ __forceinline__ int t5b(int d){ if(d<16)return d<0?0:d; int b=16; b+=(d>=19);b+=(d>=21);b+=(d>=24);b+=(d>=27);b+=(d>=31);b+=(d>=35);b+=(d>=40);b+=(d>=46);b+=(d>=52);b+=(d>=59);b+=(d>=67);b+=(d>=77);b+=(d>=87);b+=(d>=99);b+=(d>=113); return b; }
template<int MODE,int EPI,int THRL> __device__ __forceinline__ void attn_unit(const UArgs&U,char*shm){
  int tid_l=threadIdx.x; asm volatile("":"+v"(tid_l));
  const int tid=tid_l,lane=tid&63,r32=lane&31,hi=lane>>5; const int wid=__builtin_amdgcn_readfirstlane(tid>>6);
  const bf16*Qw=U.Qb+(long)(wid*QBLK)*PITCH;
  const bf16*Kh=U.Kh,*Vh=U.Vh;
  const unsigned lds0=(unsigned)(uintptr_t)shm;
  float*wsf=(float*)(shm+LDS_WS)+wid*128;
  const bf16*ksrc=Kh+(long)lane*PITCH+wid*8;
  const bf16*vsrc=Vh+(long)(16*(wid&3)+(lane>>2))*PITCH+(wid>>2)*32+(lane&3)*8;
  const unsigned kdst=lds0+LDS_K+wid*1024, vdst=lds0+LDS_V+wid*1024;
  #define DMA_K(t,slot) glds16(ksrc+(long)(t)*KVBLK*PITCH,(unsigned)__builtin_amdgcn_readfirstlane(kdst+(slot)))
  #define DMA_V(t,slot) glds16(vsrc+(long)(t)*KVBLK*PITCH,(unsigned)__builtin_amdgcn_readfirstlane(vdst+(slot)))
  const int vb0=(int)(lds0+LDS_V)+((lane>>4)&1)*32+(lane&3)*8+(4*hi+((lane&15)>>2))*64;
  const char*Kbase=shm+LDS_K; bf16x8 kf[8];
  const lds_cptr shm3=(lds_cptr)shm; const lds_cptr kp0=shm3+LDS_K+hi*1024+r32*16; const lds_cptr vp0=shm3+LDS_V+((lane>>4)&1)*32+(lane&3)*8+(4*hi+((lane&15)>>2))*64;
  const int NT=U.NT;
  const int qpos=U.q0+wid*QBLK+r32;
  float*biasT=(float*)(shm+LDS_BIAS);
  if(tid<128) biasT[tid]=(U.rel[t5b(tid)*16+U.hc]-U.rel[31*16+U.hc])*LOG2E_;
  unsigned selw=0u,cw=0u; const unsigned*mskp=(const unsigned*)(shm+LDS_MSK)+wid*128+r32*4;
  if(MODE==0){ ((u32x4*)(shm+LDS_KM))[tid]=((const u32x4*)U.km)[tid]; }
  if(MODE==1){ if(hi==0){ const u32x4 w=*(const u32x4*)(U.selg+(long)(wid*QBLK+r32)*4); *(u32x4*)((unsigned*)(shm+LDS_MSK)+wid*128+r32*4)=w; } }
  asm volatile("s_waitcnt vmcnt(0) lgkmcnt(0)\n\ts_barrier":::"memory");
  bf16x8 qr[4];
  #pragma unroll
  for(int d0=0;d0<4;++d0)qr[d0]=*reinterpret_cast<const bf16x8*>(&Qw[(long)r32*PITCH+d0*16+hi*8]);
  if(MODE==0){
    float v1=-INFINITY,v2=-INFINITY,v3=-INFINITY; int i1=-1,i2=-1,i3=-1;
    for(int n=0;n<U.qb;++n){ const float*km=(const float*)(shm+LDS_KM)+n*64+hi*8; float p=0.f;
      #pragma unroll
      for(int d0=0;d0<4;++d0){ const f32x4_ a=*(const f32x4_*)(km+d0*16), c=*(const f32x4_*)(km+d0*16+4);
        p+=bfs(qr[d0][0])*a[0]+bfs(qr[d0][1])*a[1]+bfs(qr[d0][2])*a[2]+bfs(qr[d0][3])*a[3]+bfs(qr[d0][4])*c[0]+bfs(qr[d0][5])*c[1]+bfs(qr[d0][6])*c[2]+bfs(qr[d0][7])*c[3]; }
      auto rr=__builtin_amdgcn_permlane32_swap(__float_as_uint(p),__float_as_uint(p),false,false); const float sc_=__uint_as_float(rr[0])+__uint_as_float(rr[1]);
      if(sc_>v1){v3=v2;i3=i2;v2=v1;i2=i1;v1=sc_;i1=n;} else if(sc_>v2){v3=v2;i3=i2;v2=sc_;i2=n;} else if(sc_>v3){v3=sc_;i3=n;} }
    if(i1>=0)selw|=1u<<i1; if(i2>=0)selw|=1u<<i2; if(i3>=0)selw|=1u<<i3; selw|=1u<<U.qb; }
  DMA_K(0,0);DMA_V(0,0);DMA_K(1,SLOTB);
  float mhat=0.f,l_reg=0.f;f32x16 o[2];o[0]=f32x16{};o[1]=f32x16{};f32x16 negm=f32x16{};asm volatile("":"+v"(negm));
  #define MASK_FAR(P0,P1,t) do{ bool on_=true; if(MODE==0)on_=((selw>>((t)>>2))&1u)!=0u; if(MODE==1){ if(((t)&31)==0)cw=mskp[(t)>>5]; on_=((cw>>((t)&31))&1u)!=0u; } \
      _Pragma("unroll") for(int r=0;r<16;++r){ P0[r]=on_?P0[r]:-INFINITY; P1[r]=on_?P1[r]:-INFINITY; } }while(0)
  #define MASK_BAND(P0,P1,t) do{ bool on_=true; if(MODE==0)on_=((selw>>((t)>>2))&1u)!=0u; if(MODE==1){ if(((t)&31)==0)cw=mskp[(t)>>5]; on_=((cw>>((t)&31))&1u)!=0u; } \
      const int kb_=U.kt0+64*(t), qw_=U.q0+wid*QBLK; \
      if((qw_-(kb_+63))<128||(MODE==2&&(qw_+31-kb_)>=512)){            \
      const int d0_=qpos-(kb_+4*hi); \
      _Pragma("unroll") for(int r=0;r<16;++r){ const int da_=d0_-((r&3)+8*(r>>2)), db_=da_-32; \
        const bool oka_=on_&&da_>=0&&(MODE!=2||da_<512), okb_=on_&&db_>=0&&(MODE!=2||db_<512); \
        const float ba_=biasT[da_<0?0:(da_>127?127:da_)], bb_=biasT[db_<0?0:(db_>127?127:db_)]; \
        P0[r]=oka_?P0[r]+ba_:-INFINITY; P1[r]=okb_?P1[r]+bb_:-INFINITY; \
        if((r&1)==1){ asm volatile("s_waitcnt lgkmcnt(0)":"+v"(P0),"+v"(P1)::"memory"); } } \
      } else if(MODE!=2){ _Pragma("unroll") for(int r=0;r<16;++r){ P0[r]=on_?P0[r]:-INFINITY; P1[r]=on_?P1[r]:-INFINITY; } } }while(0)
  #define CMASK(P0,P1,t) MASK_BAND(P0,P1,t)
  bool resc=false;
  #define START(P0,P1) do{ const float rm=rowmax(P0,P1); resc=false; \
    { const float dl=rm>-1e30f?rm:0.f; mhat=fadd_s(mhat,dl); \
      _Pragma("unroll") for(int r=0;r<16;++r){P0[r]=fsub_s(P0[r],dl);P1[r]=fsub_s(P1[r],dl);} \
      _Pragma("unroll") for(int r=0;r<16;++r)negm[r]=-mhat; asm volatile("":"+v"(negm)); } \
    _Pragma("unroll") for(int r=0;r<16;++r)P0[r]=__builtin_amdgcn_exp2f(P0[r]); }while(0)
  #define RESC() do{ if(resc){ asm volatile("s_waitcnt lgkmcnt(0)":::"memory"); \
      _Pragma("unroll") for(int d_=0;d_<2;++d_) _Pragma("unroll") for(int r=0;r<16;++r)o[d_][r]*=wsf[crow(r,hi)]; } }while(0)
  f32x16 pA0,pA1,pB0,pB1;
  int sl_prev=0,sl_cur=0,sl_next=SLOTB;
  #define ROT() do{sl_prev=sl_cur;sl_cur=sl_next;sl_next=(sl_next==(NSLOT-1)*SLOTB)?0:sl_next+SLOTB;}while(0)
  DMA_K(2,2*SLOTB);
  WAIT_BAR(3);
  qkt(pA0,pA1,Kbase,qr,negm,r32,hi);asm volatile("s_nop 15\n\ts_nop 7":"+v"(pA0),"+v"(pA1));CMASK(pA0,pA1,0);
  START(pA0,pA1);
  _Pragma("unroll") for(int r=0;r<16;++r)pA1[r]=__builtin_amdgcn_exp2f(pA1[r]);
  WAIT_BAR(0);
  DMA_K(3,0);DMA_V(1,SLOTB);
  ROT();
  kload8(kf,kp0+sl_cur);
  WAIT_BAR(2);
  s16x4 vlo[8],vhi[8]; u32x4 pw0,pw1,pw2,pw3;
  #define PKW(P,B) cvtpk_s(P[B],P[B+1])
  #define PAF(k) __builtin_bit_cast(bf16x8,pw##k)
  #define VFR(i) (bf16x8){vlo[i][0],vlo[i][1],vlo[i][2],vlo[i][3],vhi[i][0],vhi[i][1],vhi[i][2],vhi[i][3]}
  #define PIN(x) asm volatile("":"+v"(x))
  #define MX3(a,b,c) __builtin_fmaxf(__builtin_fmaxf((a),(b)),(c))
  #define GAPA(MF,A0,A1,A2,A3,W0,W1,PW) do{ MF; sacc+=A0; sacc+=A1; sacc+=A2; sacc+=A3; PIN(sacc); W0; W1; PIN(PW); SBAR(); }while(0)
  #define EX(v) __builtin_amdgcn_exp2f(v)
  #define GAPB(MF,X,B) do{ MF; X[B]=EX(X[B]); X[B+1]=EX(X[B+1]); X[B+2]=EX(X[B+2]); X[B+3]=EX(X[B+3]); PIN(X); SBAR(); }while(0)
  #define VRD(i) do{ vlo[i]=vtr(vp_+(((i)>>2)*4096+((i)&3)*1024)); vhi[i]=vtr(vp_+(((i)>>2)*4096+((i)&3)*1024+512)); }while(0)
  #define KRD(G,j) do{ if(G){ kload2(kf,kp0+sl_next,j); SBAR(); } }while(0)
  #define STEP(C0,C1,P0,P1,t,GK,GV,GL) do{ SBAR(); \
    const lds_cptr vp_=vp0+sl_prev; \
    VRD(0); SBAR(); float sacc=(P0[0]+P0[1]); \
    GAPA(C0=__builtin_amdgcn_mfma_f32_32x32x16_bf16(kf[0],qr[0],negm,0,0,0), P0[2],P0[3],P0[4],P0[5],     pw0[0]=PKW(P0,0), pw0[1]=PKW(P0,2), pw0); \
    VRD(4); SBAR(); GAPA(C1=__builtin_amdgcn_mfma_f32_32x32x16_bf16(kf[1],qr[0],negm,0,0,0), P0[6],P0[7],P0[8],P0[9],     pw0[2]=PKW(P0,4), pw0[3]=PKW(P0,6), pw0); \
    VRD(1); SBAR(); GAPA(C0=__builtin_amdgcn_mfma_f32_32x32x16_bf16(kf[2],qr[1],C0,0,0,0),   P0[10],P0[11],P0[12],P0[13], pw1[0]=PKW(P0,8), pw1[1]=PKW(P0,10), pw1); \
    VRD(5); SBAR(); GAPA(C1=__builtin_amdgcn_mfma_f32_32x32x16_bf16(kf[3],qr[1],C1,0,0,0),   P0[14],P0[15],P1[0],P1[1],   pw1[2]=PKW(P0,12),pw1[3]=PKW(P0,14), pw1); \
    VRD(2); SBAR(); GAPA(C0=__builtin_amdgcn_mfma_f32_32x32x16_bf16(kf[4],qr[2],C0,0,0,0),   P1[2],P1[3],P1[4],P1[5],     pw2[0]=PKW(P1,0), pw2[1]=PKW(P1,2), pw2); \
    VRD(6); SBAR(); GAPA(C1=__builtin_amdgcn_mfma_f32_32x32x16_bf16(kf[5],qr[2],C1,0,0,0),   P1[6],P1[7],P1[8],P1[9],     pw2[2]=PKW(P1,4), pw2[3]=PKW(P1,6), pw2); \
    VRD(3); SBAR(); GAPA(C0=__builtin_amdgcn_mfma_f32_32x32x16_bf16(kf[6],qr[3],C0,0,0,0),   P1[10],P1[11],P1[12],P1[13], pw3[0]=PKW(P1,8), pw3[1]=PKW(P1,10), pw3); \
    VRD(7); SBAR(); GAPA(C1=__builtin_amdgcn_mfma_f32_32x32x16_bf16(kf[7],qr[3],C1,0,0,0),   P1[14],P1[15],0.f,0.f,       pw3[2]=PKW(P1,12),pw3[3]=PKW(P1,14), pw3); \
    l_reg+=sacc; \
    if(GK){DMA_K((t)+3,sl_cur);} if(GV){DMA_V((t)+1,sl_next);} \
    CMASK(C0,C1,t); \
    { float a=MX3(C0[0],C0[1],C1[0]),b=MX3(C0[2],C0[3],C1[1]); a=MX3(a,C1[2],C1[3]); \
      _Pragma("unroll") for(int r=4;r<16;r+=4){a=MX3(a,C0[r],C0[r+1]);b=MX3(b,C0[r+2],C0[r+3]);a=MX3(a,C1[r],C1[r+1]);b=MX3(b,C1[r+2],C1[r+3]);} \
      float rm=__builtin_fmaxf(a,b); { auto rr=__builtin_amdgcn_permlane32_swap(__float_as_uint(rm),__float_as_uint(rm),false,false); rm=__builtin_fmaxf(__uint_as_float(rr[0]),__uint_as_float(rr[1])); } \
      resc=false; \
      if(__builtin_expect(__any(rm>(float)THRL),0)){ const float dl=__builtin_fmaxf(rm,0.f); mhat+=dl; \
        _Pragma("unroll") for(int r=0;r<16;++r){C0[r]-=dl;C1[r]-=dl;} \
        _Pragma("unroll") for(int r=0;r<16;++r)negm[r]=-mhat; asm volatile("":"+v"(negm)); \
        const float f=__builtin_amdgcn_exp2f(-dl); l_reg*=f; if(hi==0)wsf[r32]=f; resc=true; } } \
    SBAR(); \
    GAPB(o[0]=__builtin_amdgcn_mfma_f32_32x32x16_bf16(PAF(0),VFR(0),o[0],0,0,0), C0,0); \
    GAPB(o[1]=__builtin_amdgcn_mfma_f32_32x32x16_bf16(PAF(0),VFR(4),o[1],0,0,0), C0,4); \
    KRD(GL,0); GAPB(o[0]=__builtin_amdgcn_mfma_f32_32x32x16_bf16(PAF(1),VFR(1),o[0],0,0,0), C0,8); \
    KRD(GL,1); GAPB(o[1]=__builtin_amdgcn_mfma_f32_32x32x16_bf16(PAF(1),VFR(5),o[1],0,0,0), C0,12); \
    KRD(GL,2); GAPB(o[0]=__builtin_amdgcn_mfma_f32_32x32x16_bf16(PAF(2),VFR(2),o[0],0,0,0), C1,0); \
    KRD(GL,3); GAPB(o[1]=__builtin_amdgcn_mfma_f32_32x32x16_bf16(PAF(2),VFR(6),o[1],0,0,0), C1,4); \
    GAPB(o[0]=__builtin_amdgcn_mfma_f32_32x32x16_bf16(PAF(3),VFR(3),o[0],0,0,0), C1,8); \
    GAPB(o[1]=__builtin_amdgcn_mfma_f32_32x32x16_bf16(PAF(3),VFR(7),o[1],0,0,0), C1,12); \
    }while(0)
  int t=1;
  #undef CMASK
  #define CMASK(P0,P1,t) MASK_FAR(P0,P1,t)
  for(;MODE!=2&&t+7<NT;t+=2){
    STEP(pB0,pB1,pA0,pA1,t,true,true,true);     WAIT_BAR(2); RESC(); ROT();
    STEP(pA0,pA1,pB0,pB1,t+1,true,true,true);   WAIT_BAR(2); RESC(); ROT();
  }
  #undef CMASK
  #define CMASK(P0,P1,t) MASK_BAND(P0,P1,t)
  #define ENDW(tt) do{ if((tt)+3<NT){WAIT_BAR(2);} else if((tt)+2<NT){WAIT_BAR(1);} else {WAIT_BAR(0);} }while(0)
  for(;t+1<NT;t+=2){
    STEP(pB0,pB1,pA0,pA1,t,(t+3<NT),(t+1<NT),(t+1<NT));       ENDW(t);   RESC(); ROT();
    STEP(pA0,pA1,pB0,pB1,t+1,(t+4<NT),(t+2<NT),(t+2<NT));     ENDW(t+1); RESC(); ROT();
  }
  STEP(pB0,pB1,pA0,pA1,NT-1,false,false,false); RESC();
  { float sacc=pB0[0]+pB0[1]; _Pragma("unroll") for(int r=2;r<16;++r)sacc+=pB0[r]; _Pragma("unroll") for(int r=0;r<16;++r)sacc+=pB1[r]; l_reg+=sacc;
    pw0=(u32x4){PKW(pB0,0),PKW(pB0,2),PKW(pB0,4),PKW(pB0,6)};pw1=(u32x4){PKW(pB0,8),PKW(pB0,10),PKW(pB0,12),PKW(pB0,14)};pw2=(u32x4){PKW(pB1,0),PKW(pB1,2),PKW(pB1,4),PKW(pB1,6)};pw3=(u32x4){PKW(pB1,8),PKW(pB1,10),PKW(pB1,12),PKW(pB1,14)};
    SBAR(); pv(o,vb0+sl_cur,PAF(0),PAF(1),PAF(2),PAF(3)); }
  #undef PKW
  #undef PAF
  #undef VFR
  #undef PIN
  #undef MX3
  #undef GAPA
  #undef GAPB
  #undef EX
  #undef VRD
  #undef KRD
  #undef STEP
  #undef ENDW
  {auto rr=__builtin_amdgcn_permlane32_swap(__float_as_uint(l_reg),__float_as_uint(l_reg),false,false);l_reg=__uint_as_float(rr[0])+__uint_as_float(rr[1]);}
  int lane_e=lane; asm volatile("":"+v"(lane_e)); const int r32e=lane_e&31, hie=lane_e>>5;
  float*wsfe=(float*)(shm+LDS_WS)+wid*128;
  if(hie==0){ wsfe[32+r32e]=l_reg; if(EPI!=0){ const float gl=bfs((short)U.gate[(long)(wid*QBLK+r32e)*PITCH+U.gcol]); wsfe[64+r32e]=1.f/(1.f+__expf(-gl)); } }
  asm volatile("s_waitcnt lgkmcnt(0)":::"memory");
  float rli[16];
  #pragma unroll
  for(int r=0;r<16;++r){ rli[r]=__builtin_amdgcn_rcpf(fmaxf(wsfe[32+crow(r,hie)],1e-30f)); if(EPI!=0)rli[r]*=wsfe[64+crow(r,hie)]; }
  bf16*Ow=U.Ob+(long)(wid*QBLK)*PITCH;
  { bf16*stg=(bf16*)(shm+LDS_OST)+wid*2048;
    #pragma unroll
    for(int r=0;r<16;++r){const int orow=crow(r,hie);
      #pragma unroll
      for(int d0=0;d0<2;++d0){ float v=o[d0][r]*rli[r]; if(EPI==2)v+=bfs((short)stg[orow*64+d0*32+r32e]); stg[orow*64+d0*32+r32e]=f2b(v);} }
    asm volatile("s_waitcnt lgkmcnt(0)":::"memory");
    if(EPI!=1){
    #pragma unroll
    for(int i=0;i<4;++i){const int row=i*8+(lane_e>>3),ch=lane_e&7; u32x4 v=*(const u32x4*)(stg+row*64+ch*8);
      if(EPI==2){ const u32x4 t=*(const u32x4*)(U.tmp+(long)(wid*QBLK+row)*512+ch*8);
        v.x=pk2b(lo16(v.x)+lo16(t.x),hi16(v.x)+hi16(t.x)); v.y=pk2b(lo16(v.y)+lo16(t.y),hi16(v.y)+hi16(t.y)); v.z=pk2b(lo16(v.z)+lo16(t.z),hi16(v.z)+hi16(t.z)); v.w=pk2b(lo16(v.w)+lo16(t.w),hi16(v.w)+hi16(t.w)); }
      ATTN_STORE16(Ow+(long)row*PITCH+ch*8,v);} } }
  asm volatile("s_waitcnt lgkmcnt(0)\n\ts_barrier":::"memory");
  #undef DMA_K
  #undef DMA_V
  #undef CMASK
  #undef START
  #undef RESC
  #undef ROT
}
constexpr int ATTN_LDS_BYTES=LDS_BYTES;
#undef SBAR
#undef WAIT_BAR
}

constexpr int NWAVES = 8;
constexpr int B_ = 4, S_ = 8192, DM = 1024, M_ = B_ * S_, DIN = 7464, FF = 2816, NL = 2;
constexpr int YP = pg8::YP_;
constexpr float C2 = pg8::C2_, LOG2E = 1.4426950408889634f;
constexpr float NORM_EPS = 1e-6f;
constexpr int Y_AQ = 0, Y_AKC = 512, Y_AVC = 640, Y_AKS = 768, Y_AVS = 896, Y_AKW = 1024, Y_AVW = 1152, Y_CQ = 1280, Y_CK = 1792, Y_CV = 2304,
              Y_BQ = 2816, Y_BK = 3072, Y_BV = 3328, Y_BR = 3840, Y_AG = 4352, Y_BLR = 4376;
constexpr int NIN = 7680;
constexpr size_t MiB = 1u << 20;
constexpr size_t WS_CTL = 0, CTL_ZERO_BYTES = 1 * MiB;
constexpr size_t WS_WIN = 1 * MiB, WS_WA = 16 * MiB, WS_WB = 17 * MiB, WS_WC = 18 * MiB, WS_WO = 19 * MiB, WS_WF1 = 21 * MiB, WS_WF2 = 32 * MiB;
constexpr size_t WS_H = 40 * MiB;
constexpr size_t WS_Y = 104 * MiB;
constexpr size_t WS_G8 = 379 * MiB;
constexpr size_t WS_ACT = WS_Y + 128 * MiB;
constexpr size_t WS_SM = 475 * MiB;
constexpr size_t WS_KCMP = WS_SM, WS_VCMP = WS_SM + 1 * MiB, WS_KMEAN = WS_SM + 2 * MiB;
constexpr size_t WS_GA = WS_SM + 3 * MiB;
constexpr size_t WS_MASK = 38 * MiB;
constexpr size_t WS_OATMP = WS_H;
constexpr size_t WS_O16 = WS_H + 32 * MiB;
constexpr size_t WS_VCMPT = WS_VCMP + 512 * 1024;
constexpr size_t WS_CW1T = 39 * MiB;
constexpr size_t WS_CW2T = WS_CW1T + 512 * 1024;
constexpr size_t WS_CC0 = WS_CW2T + 16 * 1024;
constexpr size_t WS_GST = WS_H + 32 * MiB;
constexpr size_t WS_GDEC = WS_SM + 3 * MiB;
constexpr size_t WS_BCUM = WS_SM + 4 * MiB;
constexpr size_t WS_END = 512 * MiB;
static_assert(WS_BCUM + (size_t)M_ * 256 * 4 <= WS_END, "ws map 3");
static_assert(WS_GA + (size_t)M_ * 256 * 4 <= WS_END && WS_Y + (size_t)M_ * YP * 2 <= WS_G8 && WS_G8 + (size_t)M_ * 3072 <= WS_SM, "ws map");
static_assert(WS_ACT + (size_t)M_ * FF * 2 <= WS_SM && WS_WF2 + (size_t)DM * FF * 2 <= WS_H, "ws map 2");
constexpr int CW_BAR = 4096;
constexpr int RING_OFF = 0, RING_BYTES = 131072;
constexpr int LDSCTL_OFF = RING_BYTES, MISC_OFF = LDSCTL_OFF + 320;
constexpr int LDS_BYTES = 147456;

#define GAS __attribute__((address_space(1)))
#define LAS __attribute__((address_space(3)))
typedef unsigned short bf16;
typedef unsigned v4u __attribute__((ext_vector_type(4)));
typedef float f32x4 __attribute__((ext_vector_type(4)));
typedef short bf16x8 __attribute__((ext_vector_type(8)));
typedef GAS unsigned gu32;
typedef GAS unsigned long long gu64;
#define RLX_AGENT __ATOMIC_RELAXED, __HIP_MEMORY_SCOPE_AGENT
#define LDS_WAIT() asm volatile("s_waitcnt lgkmcnt(0)" ::: "memory")
#define VM_WAIT() asm volatile("s_waitcnt vmcnt(0)" ::: "memory")
__device__ __forceinline__ unsigned long long rt() { return __builtin_amdgcn_s_memrealtime(); }
__device__ __forceinline__ unsigned f2bf(float f) { unsigned u = __builtin_bit_cast(unsigned, f); return (u + 0x7fffu + ((u >> 16) & 1u)) >> 16; }
__device__ __forceinline__ unsigned pk2(float lo, float hi) { return f2bf(lo) | (f2bf(hi) << 16); }

__device__ __forceinline__ float bf2f(bf16 h) { return __uint_as_float((unsigned)h << 16); }
__device__ __forceinline__ float sigm(float v) { return 1.f / (1.f + __expf(-v)); }
#define WFENCE() asm volatile("s_waitcnt lgkmcnt(0)" ::: "memory")

#define XB_TMO      128
#define XB_XCNT(j)  (256  + 64 * (j))
#define XB_XSUB(j)  (1280 + 64 * (j))
#define XB_XGEN(j)  (2304 + 64 * (j))
#define XB_TOP      3328
#define XB_TOPGEN   3392
#define XCD_BAR_WORDS 3456
#define XB_SPIN_CAP (1u << 18)

__device__ __forceinline__ unsigned xb_ld(unsigned* p)              { return __hip_atomic_load(p, __ATOMIC_RELAXED, __HIP_MEMORY_SCOPE_AGENT); }
__device__ __forceinline__ unsigned xb_add(unsigned* p, unsigned v) { return __hip_atomic_fetch_add(p, v, __ATOMIC_RELAXED, __HIP_MEMORY_SCOPE_AGENT); }
__device__ __forceinline__ unsigned xb_xcc_id() { return (unsigned)__builtin_amdgcn_s_getreg((3 << 11) | 20) & 0xFu; }
#define XB_SPIN(cond, bar) do { unsigned _sp = 0; while (cond) { __builtin_amdgcn_s_sleep(1); \
    if ((++_sp & 255u) == 0u) { if (xb_ld(&(bar)[XB_TMO])) break; if (_sp > XB_SPIN_CAP) { atomicAdd(&(bar)[XB_TMO], 1u); break; } } } } while (0)

struct XcdBarrier {
    unsigned* bar; unsigned x;
    volatile LAS unsigned* st;
};

__device__ __forceinline__ XcdBarrier xcd_barrier_post(unsigned* bar, volatile LAS unsigned* st) {
    XcdBarrier b; b.bar = bar; b.x = xb_xcc_id(); b.st = st;
    if (threadIdx.x == 0) (void)xb_add(&bar[XB_XCNT(b.x)], 1u);
    return b;
}
__device__ __forceinline__ void xcd_barrier_complete(unsigned* bar, unsigned x, unsigned& nloc, unsigned& nx) {
    const unsigned G = gridDim.x * gridDim.y * gridDim.z;
    unsigned sum, cnt, mine, sp = 0u;
    for (;;) {
        sum = 0u; cnt = 0u; mine = 0u;
#pragma unroll
        for (unsigned j = 0; j < 16; ++j) { const unsigned c = xb_ld(&bar[XB_XCNT(j)]); sum += c; cnt += (c > 0u) ? 1u : 0u; mine = (j == x) ? c : mine; }
        if (sum == G) break;
        __builtin_amdgcn_s_sleep(1);
        if ((++sp & 255u) == 0u) { if (xb_ld(&bar[XB_TMO])) break; if (sp > XB_SPIN_CAP) { atomicAdd(&bar[XB_TMO], 1u); break; } }
    }
    nloc = mine > 0u ? mine : 1u; nx = cnt > 0u ? cnt : 1u;
}

__device__ __forceinline__ void xcd_barrier(const XcdBarrier& b) {
    asm volatile("s_waitcnt vmcnt(0)" ::: "memory");
    __syncthreads();
    if (threadIdx.x == 0) {
        unsigned* bar = b.bar;
        __builtin_amdgcn_s_waitcnt(0);
        unsigned nloc = b.st[0], nx = b.st[1];
        if (nloc == 0u) { xcd_barrier_complete(bar, b.x, nloc, nx); b.st[0] = nloc; b.st[1] = nx; }
        const unsigned old = xb_add(&bar[XB_XSUB(b.x)], 1u);
        const unsigned gen = old / nloc;
        if (old + 1u == (gen + 1u) * nloc) {
            __builtin_amdgcn_fence(__ATOMIC_RELEASE, "agent");
            asm volatile("s_waitcnt vmcnt(0)" ::: "memory");
            const unsigned og = xb_add(&bar[XB_TOP], 1u);
            const unsigned tg = og / nx;
            if (og + 1u == (tg + 1u) * nx) xb_add(&bar[XB_TOPGEN], 1u);
            else XB_SPIN(xb_ld(&bar[XB_TOPGEN]) == tg, bar);
            __builtin_amdgcn_fence(__ATOMIC_ACQUIRE, "agent");
            xb_add(&bar[XB_XGEN(b.x)], 1u);
            asm volatile("s_waitcnt vmcnt(0)" ::: "memory");
        } else {
            XB_SPIN(xb_ld(&bar[XB_XGEN(b.x)]) == gen, bar);
            __builtin_amdgcn_fence(__ATOMIC_ACQUIRE, "agent");
            asm volatile("s_waitcnt vmcnt(0)" ::: "memory");
        }
    }
    __syncthreads();
}


struct Frame {
    LAS unsigned char* lds;
    volatile LAS unsigned* MISC;
    gu32* ctl;
    int tid, lane, wave, G;
};
__device__ __forceinline__ float wave_sum(float v) {
#pragma unroll
    for (int o = 1; o < 64; o <<= 1) v += __shfl_xor(v, o);
    return v;
}
__device__ __forceinline__ float wave_max(float v) {
#pragma unroll
    for (int o = 1; o < 64; o <<= 1) v = fmaxf(v, __shfl_xor(v, o));
    return v;
}
__device__ __forceinline__ int t5_bucket(int d) {
    if (d < 16) return d < 0 ? 0 : d;
    int b = 16;
    b += (d >= 19); b += (d >= 21); b += (d >= 24); b += (d >= 27); b += (d >= 31); b += (d >= 35); b += (d >= 40); b += (d >= 46);
    b += (d >= 52); b += (d >= 59); b += (d >= 67); b += (d >= 77); b += (d >= 87); b += (d >= 99); b += (d >= 113);
    return b;
}
template <class CM> __device__ __forceinline__ void tr_item(const float* W, int Nsrc, int K, bf16* WT, int item, int nblk, CM cm, LAS float* scr, int lane) {
    const int kb = item / nblk, nb = item % nblk, k0 = 64 * kb, n0 = 32 * nb;
    const int sc = cm(n0 + (lane & 31));
    float tv[32];
#pragma unroll
    for (int i = 0; i < 32; ++i) { const int kk = 2 * i + (lane >> 5); tv[i] = sc >= 0 ? W[(size_t)(k0 + kk) * Nsrc + sc] : 0.f; }
#pragma unroll
    for (int i = 0; i < 32; ++i) { const int kk = 2 * i + (lane >> 5); scr[kk * 33 + (lane & 31)] = tv[i]; }
    LDS_WAIT(); asm volatile("" ::: "memory");
    const int c = lane & 7;
#pragma unroll
    for (int j = 0; j < 4; ++j) { const int n = (lane >> 3) + 8 * j; const LAS float* s = scr + (8 * c) * 33 + n;
        v4u o; o.x = pk2(s[0 * 33], s[1 * 33]); o.y = pk2(s[2 * 33], s[3 * 33]); o.z = pk2(s[4 * 33], s[5 * 33]); o.w = pk2(s[6 * 33], s[7 * 33]);
        *(GAS v4u*)(WT + (size_t)(n0 + n) * K + k0 + 8 * c) = o; }
    LDS_WAIT(); asm volatile("" ::: "memory");
}
struct CmId { __device__ __forceinline__ int operator()(int n) const { return n; } };
struct CmWin { __device__ __forceinline__ int operator()(int n) const {
    if (n < 1280) return n;
    if (n < 2816) return n - 1280 + 2856;
    if (n < 4352) return n - 2816 + 1304;
    if (n < 4376) return n - 4352 + 1280;
    if (n < 4392) return n - 4376 + 2840;
    if (n < 4608) return -1;
    return n - 4608 + 4392; } };
struct CmFfn { __device__ __forceinline__ int operator()(int c) const { const int p = c >> 8, r = c & 255; return r < 128 ? 128 * p + r : FF + 128 * p + (r - 128); } };

struct Args { const float* in[22]; float* out; unsigned char* ws; int ph_lo, ph_hi; };

__device__ __forceinline__ void phase_weights(Frame& F, const Args& a, int l) {
    LAS float* scr = (LAS float*)(F.lds + RING_OFF + F.wave * 16384);
    const int gw = blockIdx.x * NWAVES + F.wave, NGW = F.G * NWAVES;
    unsigned char* ws = a.ws;
    constexpr int I_IN = 16 * (NIN / 32), I_BR = 8 * 32, I_O = 16 * 32, I_F1 = 16 * (2 * FF / 32), I_F2 = (FF / 64) * 32;
    constexpr int NIT = I_IN + 3 * I_BR + I_O + I_F1 + I_F2;
    for (int it = gw; it < NIT; it += NGW) {
        int r = it;
        if (r < I_IN) { tr_item(a.in[6] + (size_t)l * DM * DIN, DIN, DM, (bf16*)(ws + WS_WIN), r, NIN / 32, CmWin(), scr, F.lane); continue; } r -= I_IN;
        if (r < I_BR) { tr_item(a.in[16] + (size_t)l * 512 * DM, DM, 512, (bf16*)(ws + WS_WA), r, 32, CmId(), scr, F.lane); continue; } r -= I_BR;
        if (r < I_BR) { tr_item(a.in[17] + (size_t)l * 512 * DM, DM, 512, (bf16*)(ws + WS_WB), r, 32, CmId(), scr, F.lane); continue; } r -= I_BR;
        if (r < I_BR) { tr_item(a.in[18] + (size_t)l * 512 * DM, DM, 512, (bf16*)(ws + WS_WC), r, 32, CmId(), scr, F.lane); continue; } r -= I_BR;
        if (r < I_O) { tr_item(a.in[19] + (size_t)l * DM * DM, DM, DM, (bf16*)(ws + WS_WO), r, 32, CmId(), scr, F.lane); continue; } r -= I_O;
        if (r < I_F1) { tr_item(a.in[20] + (size_t)l * DM * 2 * FF, 2 * FF, DM, (bf16*)(ws + WS_WF1), r, 2 * FF / 32, CmFfn(), scr, F.lane); continue; } r -= I_F1;
        tr_item(a.in[21] + (size_t)l * FF * DM, DM, FF, (bf16*)(ws + WS_WF2), r, 32, CmId(), scr, F.lane);
    }
    for (int it = gw; it < 2 * 66 + 2; it += NGW) {
        if (it < 132) { const int kv = it / 66, r = it % 66;
            if (r < 64) tr_item(a.in[kv ? 11 : 9] + (size_t)l * 2048 * 64, 64, 2048, (bf16*)(ws + WS_CW1T) + (size_t)kv * 64 * 2048, r, 2, CmId(), scr, F.lane);
            else tr_item(a.in[kv ? 12 : 10] + (size_t)l * 64 * 64, 64, 64, (bf16*)(ws + WS_CW2T) + (size_t)kv * 64 * 64, r - 64, 2, CmId(), scr, F.lane); }
        else { const int kv = it - 132; const float* pe = a.in[kv ? 8 : 7] + (size_t)l * 2048; const float* w1 = a.in[kv ? 11 : 9] + (size_t)l * 2048 * 64; float acc = 0.f;
            for (int k = 0; k < 2048; ++k) acc += pe[k] * w1[(size_t)k * 64 + F.lane];
            ((float*)(ws + WS_CC0))[kv * 64 + F.lane] = acc; }
    }
}
__device__ __forceinline__ void phase_norm0(Frame& F, const float* x, const float* w, bf16* H) {
    const int gw = blockIdx.x * NWAVES + F.wave, NGW = F.G * NWAVES;
    for (int m = gw; m < M_; m += NGW) {
        const f32x4* xr = (const f32x4*)(x + (size_t)m * DM) + F.lane; f32x4 v[4]; float s = 0.f;
#pragma unroll
        for (int j = 0; j < 4; ++j) { v[j] = xr[64 * j]; s += v[j].x * v[j].x + v[j].y * v[j].y + v[j].z * v[j].z + v[j].w * v[j].w; }
        const float r = rsqrtf(wave_sum(s) * (1.f / DM) + NORM_EPS);
        unsigned long long* o8 = (unsigned long long*)(H + (size_t)m * DM) + F.lane;
#pragma unroll
        for (int j = 0; j < 4; ++j) { const f32x4 wv = ((const f32x4*)w)[F.lane + 64 * j];
            o8[64 * j] = (unsigned long long)pk2(v[j].x * r * wv.x, v[j].y * r * wv.y) | ((unsigned long long)pk2(v[j].z * r * wv.z, v[j].w * r * wv.w) << 32); }
    }
}
__device__ __forceinline__ void phase_resid(Frame& F, const float* y_, const float* xin, float* xout, const float* wpost, const float* wpre, bf16* hout) {
    const int gw = blockIdx.x * NWAVES + F.wave, NGW = F.G * NWAVES; const bf16* y = (const bf16*)y_;
    for (int m = gw; m < M_; m += NGW) {
        typedef unsigned u32x2r __attribute__((ext_vector_type(2)));
        const u32x2r* yr = (const u32x2r*)(y + (size_t)m * DM) + F.lane; const f32x4* xr = (const f32x4*)(xin + (size_t)m * DM) + F.lane;
        f32x4 v[4], xv[4]; float s = 0.f;
#pragma unroll
        for (int j = 0; j < 4; ++j) { const u32x2r yw = yr[64 * j]; v[j].x = __uint_as_float(yw.x << 16); v[j].y = __uint_as_float(yw.x & 0xffff0000u); v[j].z = __uint_as_float(yw.y << 16); v[j].w = __uint_as_float(yw.y & 0xffff0000u);
            xv[j] = xr[64 * j]; s += v[j].x * v[j].x + v[j].y * v[j].y + v[j].z * v[j].z + v[j].w * v[j].w; }
        const float r = rsqrtf(wave_sum(s) * (1.f / DM) + NORM_EPS); float s2 = 0.f;
        f32x4* xo = (f32x4*)(xout + (size_t)m * DM) + F.lane;
#pragma unroll
        for (int j = 0; j < 4; ++j) { const f32x4 wv = ((const f32x4*)wpost)[F.lane + 64 * j]; f32x4 n;
            n.x = xv[j].x + v[j].x * r * wv.x; n.y = xv[j].y + v[j].y * r * wv.y; n.z = xv[j].z + v[j].z * r * wv.z; n.w = xv[j].w + v[j].w * r * wv.w;
            xo[64 * j] = n; v[j] = n; s2 += n.x * n.x + n.y * n.y + n.z * n.z + n.w * n.w; }
        if (hout) { const float r2 = rsqrtf(wave_sum(s2) * (1.f / DM) + NORM_EPS);
            unsigned long long* o8 = (unsigned long long*)(hout + (size_t)m * DM) + F.lane;
#pragma unroll
            for (int j = 0; j < 4; ++j) { const f32x4 wv = ((const f32x4*)wpre)[F.lane + 64 * j];
                o8[64 * j] = (unsigned long long)pk2(v[j].x * r2 * wv.x, v[j].y * r2 * wv.y) | ((unsigned long long)pk2(v[j].z * r2 * wv.z, v[j].w * r2 * wv.w) << 32); } }
    }
}
__device__ __forceinline__ void unpack8(const v4u w, float (&k)[8]) {
    k[0] = __uint_as_float(w.x << 16); k[1] = __uint_as_float(w.x & 0xffff0000u); k[2] = __uint_as_float(w.y << 16); k[3] = __uint_as_float(w.y & 0xffff0000u);
    k[4] = __uint_as_float(w.z << 16); k[5] = __uint_as_float(w.z & 0xffff0000u); k[6] = __uint_as_float(w.w << 16); k[7] = __uint_as_float(w.w & 0xffff0000u);
}
__device__ __forceinline__ void dot4(const LAS float* qs, const bf16* kr, float (&d)[4]) {
    d[0] = d[1] = d[2] = d[3] = 0.f;
#pragma unroll 1
    for (int c = 0; c < 8; ++c) { asm volatile("" ::: "memory"); const v4u w = ((const v4u*)kr)[c]; float k[8]; unpack8(w, k);
#pragma unroll
        for (int e = 0; e < 8; ++e) { const int dd = c * 8 + e;
#pragma unroll
            for (int h = 0; h < 4; ++h) d[h] += qs[h * 64 + dd] * k[e]; } }
}
__device__ __forceinline__ float dot1(const LAS float* qs, const bf16* kr) {
    float d = 0.f;
#pragma unroll
    for (int c = 0; c < 8; ++c) { const v4u w = ((const v4u*)kr)[c]; float k[8]; unpack8(w, k);
#pragma unroll
        for (int e = 0; e < 8; ++e) d += qs[c * 8 + e] * k[e]; }
    return d;
}
__device__ __forceinline__ float gelu_tanh(float x) { const float u = 0.7978845608028654f * (x + 0.044715f * x * x * x); return 0.5f * x * (1.f + tanhf(u)); }

__device__ __forceinline__ void phase2_naive(Frame& F, const Args& a, int l) {
    const int gw = blockIdx.x * NWAVES + F.wave, NGW = F.G * NWAVES, lane = F.lane;
    const bf16* Y = (const bf16*)(a.ws + WS_Y);
    LAS float* scr = (LAS float*)(F.lds + RING_OFF + F.wave * 16384);
    for (int t = gw; t < 4 * 8 * 32; t += NGW) {
        const int blk = t & 31, h = (t >> 5) & 7, b = t >> 8;
        const bf16* src = Y + ((size_t)b * S_ + blk * 256) * YP + Y_CK + h * 64 + lane; float s = 0.f;
        for (int i = 0; i < 256; ++i) s += bf2f(src[(size_t)i * YP]);
        ((float*)(a.ws + WS_KMEAN))[(size_t)t * 64 + lane] = s * (1.f / 256.f);
    }
}
__device__ __forceinline__ void gla_scan_naive(Frame& F, const Args& a) {
    const bf16* Y = (const bf16*)(a.ws + WS_Y); const float* GA = (const float*)(a.ws + WS_GA); bf16* O16 = (bf16*)(a.ws + WS_O16);
    const int lane = F.lane;
    for (int task = blockIdx.x; task < 256; task += F.G) {
        const int eg = task & 15, h = (task >> 4) & 3, b = task >> 6, e = eg * 8 + F.wave;
        float Sst = 0.f;
        for (int t0 = 0; t0 < S_; t0 += 8) {
            float av[8], kv[8], qv[8], vv[8];
#pragma unroll
            for (int j = 0; j < 8; ++j) { const size_t row = (size_t)b * S_ + t0 + j;
                av[j] = GA[row * 256 + h * 64 + lane]; kv[j] = bf2f(Y[row * YP + Y_BK + h * 64 + lane]); qv[j] = bf2f(Y[row * YP + Y_BQ + h * 64 + lane]); vv[j] = bf2f(Y[row * YP + Y_BV + h * 128 + e]); }
#pragma unroll
            for (int j = 0; j < 8; ++j) { Sst = av[j] * Sst + kv[j] * vv[j]; const float o = wave_sum(qv[j] * Sst);
                if (lane == 0) O16[((size_t)b * S_ + t0 + j) * 512 + h * 128 + e] = (bf16)f2bf(o); }
        }
    }
}
__device__ __forceinline__ void nsa_cmp_naive(Frame& F, const Args& a) {
    const int gw = blockIdx.x * NWAVES + F.wave, NGW = F.G * NWAVES, lane = F.lane;
    bf16* Y = (bf16*)(a.ws + WS_Y); const float* rel = a.in[1];
    LAS float* scr = (LAS float*)(F.lds + RING_OFF + F.wave * 16384);
    LAS float* qs = scr; LAS float* sc = scr + 256; LAS float* s2 = scr + 256 + 2048;
    for (int task = gw; task < 8 * S_; task += NGW) {
        const int q = task & (S_ - 1), bg = task >> 13, g = bg & 1, b = bg >> 1;
        const size_t row = (size_t)b * S_ + q; bf16* Yr = Y + row * YP;
#pragma unroll
        for (int h = 0; h < 4; ++h) qs[h * 64 + lane] = bf2f(Yr[Y_AQ + (g * 4 + h) * 64 + lane]);
        float gt[4][3];
#pragma unroll
        for (int h = 0; h < 4; ++h)
#pragma unroll
            for (int br = 0; br < 3; ++br) gt[h][br] = sigm(bf2f(Yr[Y_AG + (g * 4 + h) * 3 + br]));
        WFENCE();
        const int cur = q >> 6, ncv = q >= 31 ? ((q - 31) >> 4) + 1 : 0;
        const bf16* KC = (const bf16*)(a.ws + WS_KCMP) + (size_t)bg * 512 * 64; const bf16* VC = (const bf16*)(a.ws + WS_VCMP) + (size_t)bg * 512 * 64;
        float mx[4] = {-1e30f, -1e30f, -1e30f, -1e30f};
        for (int i = 0; i < 8; ++i) { const int n = lane + 64 * i;
            if (n < ncv) { float d[4]; dot4(qs, KC + (size_t)n * 64, d); const int bk = t5_bucket(q - (16 * n + 31));
#pragma unroll
                for (int h = 0; h < 4; ++h) { const float s = d[h] + rel[bk * 16 + g * 4 + h] * LOG2E; sc[h * 512 + n] = s; mx[h] = fmaxf(mx[h], s); } }
            else {
#pragma unroll
                for (int h = 0; h < 4; ++h) sc[h * 512 + n] = 0.f; } }
        float ls[4] = {0.f, 0.f, 0.f, 0.f};
#pragma unroll
        for (int h = 0; h < 4; ++h) mx[h] = wave_max(mx[h]);
        WFENCE();
        for (int i = 0; i < 8; ++i) { const int n = lane + 64 * i;
            if (n < ncv) {
#pragma unroll
                for (int h = 0; h < 4; ++h) { const float e = exp2f(sc[h * 512 + n] - mx[h]); sc[h * 512 + n] = e; ls[h] += e; } } }
#pragma unroll
        for (int h = 0; h < 4; ++h) ls[h] = 1.f / fmaxf(wave_sum(ls[h]), 1e-20f);
        for (int i = 0; i < 8; ++i) { const int n = lane + 64 * i;
            if (n < ncv) {
#pragma unroll
                for (int h = 0; h < 4; ++h) sc[h * 512 + n] *= ls[h]; } }
        WFENCE();
        float v0, v1;
        { float t[2];
#pragma unroll
          for (int jj = 0; jj < 2; ++jj) { const int j = lane + 64 * jj; float v = 0.f;
              for (int n = 4 * j - 1; n <= 4 * j + 3; ++n) if (n >= 0 && n < 511) v += (sc[n] + sc[512 + n]) + (sc[1024 + n] + sc[1536 + n]);
              const bool forced = (j == 0) || (j == cur) || (j == cur - 1);
              t[jj] = forced ? 1e9f : (j <= cur ? v : -1e30f); }
          v0 = t[0]; v1 = t[1]; }
        bool sel0 = false, sel1 = false;
        for (int it = 0; it < 16; ++it) {
            const float c0 = sel0 ? -INFINITY : v0, c1 = sel1 ? -INFINITY : v1;
            const float mxv = wave_max(fmaxf(c0, c1));
            const unsigned long long m0 = __ballot(!sel0 && v0 == mxv);
            if (m0) { const int idx = __builtin_ctzll(m0); if (lane == idx) sel0 = true; }
            else { const unsigned long long m1 = __ballot(!sel1 && v1 == mxv); const int idx = m1 ? __builtin_ctzll(m1) : -1; if (lane == idx) sel1 = true; }
        }
        sel0 = sel0 && (lane <= cur); sel1 = sel1 && (lane + 64 <= cur);
        const unsigned long long sm0 = __ballot(sel0), sm1 = __ballot(sel1);
        float oc[4] = {0.f, 0.f, 0.f, 0.f};
        for (int n = 0; n < ncv; ++n) { const float vv = bf2f(VC[(size_t)n * 64 + lane]);
#pragma unroll
            for (int h = 0; h < 4; ++h) oc[h] += sc[h * 512 + n] * vv; }
        { unsigned* MK = (unsigned*)(a.ws + WS_MASK) + ((size_t)bg * S_ + q) * 4;
          if (lane == 0) { MK[0] = (unsigned)sm0; MK[1] = (unsigned)(sm0 >> 32); MK[2] = (unsigned)sm1; MK[3] = (unsigned)(sm1 >> 32); }
          bf16* T = (bf16*)(a.ws + WS_OATMP) + row * 512;
#pragma unroll
          for (int h = 0; h < 4; ++h) T[(g * 4 + h) * 64 + lane] = (bf16)f2bf(gt[h][0] * oc[h]); }
        WFENCE();
    }
}
__device__ __forceinline__ void nsa_naive(Frame& F, const Args& a) {
    const int gw = blockIdx.x * NWAVES + F.wave, NGW = F.G * NWAVES, lane = F.lane;
    bf16* Y = (bf16*)(a.ws + WS_Y); const float* rel = a.in[1];
    LAS float* scr = (LAS float*)(F.lds + RING_OFF + F.wave * 16384);
    LAS float* qs = scr; LAS float* sc = scr + 256; LAS float* s2 = scr + 256 + 2048;
    for (int task = gw; task < 8 * S_; task += NGW) {
        const int q = task & (S_ - 1), bg = task >> 13, g = bg & 1, b = bg >> 1;
        const size_t row = (size_t)b * S_ + q; bf16* Yr = Y + row * YP;
#pragma unroll
        for (int h = 0; h < 4; ++h) qs[h * 64 + lane] = bf2f(Yr[Y_AQ + (g * 4 + h) * 64 + lane]);
        float gt[4][3];
#pragma unroll
        for (int h = 0; h < 4; ++h)
#pragma unroll
            for (int br = 0; br < 3; ++br) gt[h][br] = sigm(bf2f(Yr[Y_AG + (g * 4 + h) * 3 + br]));
        WFENCE();
        const int cur = q >> 6, ncv = q >= 31 ? ((q - 31) >> 4) + 1 : 0;
        const bf16* KC = (const bf16*)(a.ws + WS_KCMP) + (size_t)bg * 512 * 64; const bf16* VC = (const bf16*)(a.ws + WS_VCMP) + (size_t)bg * 512 * 64;
        float mx[4] = {-1e30f, -1e30f, -1e30f, -1e30f};
        for (int i = 0; i < 8; ++i) { const int n = lane + 64 * i;
            if (n < ncv) { float d[4]; dot4(qs, KC + (size_t)n * 64, d); const int bk = t5_bucket(q - (16 * n + 31));
#pragma unroll
                for (int h = 0; h < 4; ++h) { const float s = d[h] + rel[bk * 16 + g * 4 + h] * LOG2E; sc[h * 512 + n] = s; mx[h] = fmaxf(mx[h], s); } }
            else {
#pragma unroll
                for (int h = 0; h < 4; ++h) sc[h * 512 + n] = 0.f; } }
        float ls[4] = {0.f, 0.f, 0.f, 0.f};
#pragma unroll
        for (int h = 0; h < 4; ++h) mx[h] = wave_max(mx[h]);
        WFENCE();
        for (int i = 0; i < 8; ++i) { const int n = lane + 64 * i;
            if (n < ncv) {
#pragma unroll
                for (int h = 0; h < 4; ++h) { const float e = exp2f(sc[h * 512 + n] - mx[h]); sc[h * 512 + n] = e; ls[h] += e; } } }
#pragma unroll
        for (int h = 0; h < 4; ++h) ls[h] = 1.f / fmaxf(wave_sum(ls[h]), 1e-20f);
        for (int i = 0; i < 8; ++i) { const int n = lane + 64 * i;
            if (n < ncv) {
#pragma unroll
                for (int h = 0; h < 4; ++h) sc[h * 512 + n] *= ls[h]; } }
        WFENCE();
        float v0, v1;
        { float t[2];
#pragma unroll
          for (int jj = 0; jj < 2; ++jj) { const int j = lane + 64 * jj; float v = 0.f;
              for (int n = 4 * j - 1; n <= 4 * j + 3; ++n) if (n >= 0 && n < 511) v += (sc[n] + sc[512 + n]) + (sc[1024 + n] + sc[1536 + n]);
              const bool forced = (j == 0) || (j == cur) || (j == cur - 1);
              t[jj] = forced ? 1e9f : (j <= cur ? v : -1e30f); }
          v0 = t[0]; v1 = t[1]; }
        bool sel0 = false, sel1 = false;
        for (int it = 0; it < 16; ++it) {
            const float c0 = sel0 ? -INFINITY : v0, c1 = sel1 ? -INFINITY : v1;
            const float mxv = wave_max(fmaxf(c0, c1));
            const unsigned long long m0 = __ballot(!sel0 && v0 == mxv);
            if (m0) { const int idx = __builtin_ctzll(m0); if (lane == idx) sel0 = true; }
            else { const unsigned long long m1 = __ballot(!sel1 && v1 == mxv); const int idx = m1 ? __builtin_ctzll(m1) : -1; if (lane == idx) sel1 = true; }
        }
        sel0 = sel0 && (lane <= cur); sel1 = sel1 && (lane + 64 <= cur);
        const unsigned long long sm0 = __ballot(sel0), sm1 = __ballot(sel1);
        float oc[4] = {0.f, 0.f, 0.f, 0.f};
        for (int n = 0; n < ncv; ++n) { const float vv = bf2f(VC[(size_t)n * 64 + lane]);
#pragma unroll
            for (int h = 0; h < 4; ++h) oc[h] += sc[h * 512 + n] * vv; }
        float ms[4] = {-1e30f, -1e30f, -1e30f, -1e30f}, lsel[4] = {0.f, 0.f, 0.f, 0.f}, os[4] = {0.f, 0.f, 0.f, 0.f};
        for (int j = 0; j <= cur; ++j) {
            const bool on = j < 64 ? ((sm0 >> j) & 1ull) : ((sm1 >> (j - 64)) & 1ull);
            if (!on) continue;
            const int kpos = 64 * j + lane; const bool valid = kpos <= q;
            float d[4]; dot4(qs, Y + ((size_t)b * S_ + kpos) * YP + Y_AKS + g * 64, d);
            const int bk = t5_bucket(q - kpos);
            WFENCE();
#pragma unroll
            for (int h = 0; h < 4; ++h) { const float s = valid ? d[h] + rel[bk * 16 + g * 4 + h] * LOG2E : -1e30f;
                const float mn = fmaxf(ms[h], wave_max(s)); const float p = valid ? exp2f(s - mn) : 0.f; s2[h * 64 + lane] = p;
                const float scl = exp2f(ms[h] - mn); lsel[h] = lsel[h] * scl + wave_sum(p); os[h] *= scl; ms[h] = mn; }
            WFENCE();
            const bf16* vb = Y + ((size_t)b * S_ + 64 * j) * YP + Y_AVS + g * 64 + lane;
            for (int kk = 0; kk < 64; ++kk) { const float vv = bf2f(vb[(size_t)kk * YP]);
#pragma unroll
                for (int h = 0; h < 4; ++h) os[h] += s2[h * 64 + kk] * vv; }
        }
        float mw[4] = {-1e30f, -1e30f, -1e30f, -1e30f}, lw[4] = {0.f, 0.f, 0.f, 0.f}, ow[4] = {0.f, 0.f, 0.f, 0.f};
        for (int c = 0; c < 8; ++c) {
            if (q - 64 * c < 0) break;
            const int dist = 64 * c + lane, kpos = q - dist; const bool valid = kpos >= 0;
            float d[4]; dot4(qs, Y + ((size_t)b * S_ + (valid ? kpos : 0)) * YP + Y_AKW + g * 64, d);
            const int bk = t5_bucket(dist);
            WFENCE();
#pragma unroll
            for (int h = 0; h < 4; ++h) { const float s = valid ? d[h] + rel[bk * 16 + g * 4 + h] * LOG2E : -1e30f;
                const float mn = fmaxf(mw[h], wave_max(s)); const float p = valid ? exp2f(s - mn) : 0.f; s2[h * 64 + lane] = p;
                const float scl = exp2f(mw[h] - mn); lw[h] = lw[h] * scl + wave_sum(p); ow[h] *= scl; mw[h] = mn; }
            WFENCE();
            for (int kk = 0; kk < 64; ++kk) { const int kp = q - 64 * c - kk; if (kp < 0) break;
                const float vv = bf2f(Y[((size_t)b * S_ + kp) * YP + Y_AVW + g * 64 + lane]);
#pragma unroll
                for (int h = 0; h < 4; ++h) ow[h] += s2[h * 64 + kk] * vv; }
        }
        WFENCE();
#pragma unroll
        for (int h = 0; h < 4; ++h) { const float o = gt[h][0] * oc[h] + gt[h][1] * os[h] / fmaxf(lsel[h], 1e-20f) + gt[h][2] * ow[h] / fmaxf(lw[h], 1e-20f);
            Yr[Y_AQ + (g * 4 + h) * 64 + lane] = (bf16)f2bf(o); }
    }
}
__device__ __forceinline__ void moba_naive(Frame& F, const Args& a) {
    const int gw = blockIdx.x * NWAVES + F.wave, NGW = F.G * NWAVES, lane = F.lane;
    bf16* Y = (bf16*)(a.ws + WS_Y); const float* rel = a.in[1]; const float* KM = (const float*)(a.ws + WS_KMEAN);
    LAS float* scr = (LAS float*)(F.lds + RING_OFF + F.wave * 16384);
    LAS float* qs = scr; LAS float* s2 = scr + 64;
    for (int task = gw; task < 32 * S_; task += NGW) {
        const int q = task & (S_ - 1), bh = task >> 13, h = bh & 7, b = bh >> 3;
        const size_t row = (size_t)b * S_ + q; bf16* Yr = Y + row * YP;
        WFENCE();
        qs[lane] = bf2f(Yr[Y_CQ + h * 64 + lane]);
        WFENCE();
        const int cur = q >> 8;
        float gs = -1e30f;
        if (lane < 32 && lane < cur) { const float* km = KM + ((size_t)bh * 32 + lane) * 64; float d = 0.f;
            for (int dd = 0; dd < 64; ++dd) d += qs[dd] * km[dd];
            gs = d; }
        if (lane >= 32) gs = -INFINITY;
        bool sel = false;
        for (int it = 0; it < 3; ++it) { const float c = sel ? -INFINITY : gs; const float mxv = wave_max(c);
            const unsigned long long m0 = __ballot(!sel && lane < 32 && gs == mxv); const int idx = m0 ? __builtin_ctzll(m0) : -1; if (lane == idx) sel = true; }
        sel = sel && (lane < cur);
        const unsigned smask = (unsigned)__ballot(sel);
        float mr = -1e30f, lr = 0.f, o = 0.f;
        for (int j = 0; j <= cur; ++j) {
            const bool own = (j == cur);
            if (!own && !((smask >> j) & 1u)) continue;
            for (int c = 0; c < 4; ++c) {
                const int kpos = 256 * j + 64 * c + lane; const bool valid = kpos <= q;
                if (256 * j + 64 * c > q) break;
                const float d = dot1(qs, Y + ((size_t)b * S_ + kpos) * YP + Y_CK + h * 64);
                const int bk = t5_bucket(q - kpos);
                const float s = valid ? d + rel[bk * 16 + 8 + h] * LOG2E : -1e30f;
                const float mn = fmaxf(mr, wave_max(s)); const float p = valid ? exp2f(s - mn) : 0.f;
                WFENCE(); s2[lane] = p; WFENCE();
                const float scl = exp2f(mr - mn); lr = lr * scl + wave_sum(p); o *= scl; mr = mn;
                const bf16* vb = Y + ((size_t)b * S_ + 256 * j + 64 * c) * YP + Y_CV + h * 64 + lane;
                for (int kk = 0; kk < 64; ++kk) o += s2[kk] * bf2f(vb[(size_t)kk * YP]);
            }
        }
        Yr[Y_CQ + h * 64 + lane] = (bf16)f2bf(o / fmaxf(lr, 1e-20f));
    }
}
constexpr int CW_Q = 8192;
__device__ __forceinline__ int next_unit(Frame& F, int k) {
    __syncthreads();
    if (F.tid == 0) F.MISC[16] = __hip_atomic_fetch_add(F.ctl + CW_Q + 64 * k, 1u, RLX_AGENT);
    __syncthreads();
    return (int)F.MISC[16];
}
__device__ __forceinline__ int next_unit_x(Frame& F, int qs, int nper, int x0, int& xo, int& xq) {
    for (;;) { if (xo >= 8) return -1; xq = (x0 + xo) & 7; const int i = next_unit(F, qs * 8 + xq); if (i < nper) return i; ++xo; }
}
__device__ __forceinline__ void moba_fast(Frame& F, const Args& a, int qk) {
    bf16* Y = (bf16*)(a.ws + WS_Y); const float* KM = (const float*)(a.ws + WS_KMEAN);
    const int x0 = (int)(xb_xcc_id() & 7u); int xo = 0, xq = 0;
    for (;;) {
        const int i = next_unit_x(F, qk, 128, x0, xo, xq); if (i < 0) break;
        const int qb = 31 - (i & 31), bh = xq + 8 * (i >> 5), b = bh >> 3, h = bh & 7; const long rowbase = (long)b * S_;
        attn::UArgs U{};
        U.Qb = Y + (rowbase + qb * 256) * YP + Y_CQ + h * 64; U.Kh = Y + rowbase * YP + Y_CK + h * 64; U.Vh = Y + rowbase * YP + Y_CV + h * 64; U.Ob = Y + (rowbase + qb * 256) * YP + Y_CQ + h * 64;
        U.NT = 4 * (qb + 1); U.q0 = qb * 256; U.kt0 = 0; U.hc = 8 + h; U.rel = a.in[1]; U.km = KM + (size_t)bh * 32 * 64; U.qb = qb;
        attn::attn_unit<0, 0, 8>(U, (char*)F.lds + RING_OFF);
    }
}
__device__ __forceinline__ void nsa_fast(Frame& F, const Args& a, int qk) {
    bf16* Y = (bf16*)(a.ws + WS_Y);
    const int x0 = (int)(xb_xcc_id() & 7u); int xo = 0, xq = 0;
    for (;;) {
        const int i = next_unit_x(F, qk, 128, x0, xo, xq); if (i < 0) break;
        const int qb = 31 - (i & 31), b = xq >> 1, g = xq & 1, h = g * 4 + (i >> 5); const long rowbase = (long)b * S_; const int q0 = qb * 256;
        attn::UArgs U{};
        U.Qb = Y + (rowbase + q0) * YP + Y_AQ + h * 64; U.Ob = Y + (rowbase + q0) * YP + Y_AQ + h * 64; U.q0 = q0; U.hc = h; U.rel = a.in[1]; U.gate = Y + (rowbase + q0) * YP;
        { const int T0 = 4 * qb - 8 > 0 ? 4 * qb - 8 : 0;
          U.Kh = Y + (rowbase + 64 * T0) * YP + Y_AKW + g * 64; U.Vh = Y + (rowbase + 64 * T0) * YP + Y_AVW + g * 64; U.NT = 4 * qb + 4 - T0; U.kt0 = 64 * T0; U.gcol = Y_AG + h * 3 + 2;
          attn::attn_unit<2, 1, 8>(U, (char*)F.lds + RING_OFF); }
        { U.Kh = Y + rowbase * YP + Y_AKS + g * 64; U.Vh = Y + rowbase * YP + Y_AVS + g * 64; U.NT = 4 * (qb + 1); U.kt0 = 0; U.gcol = Y_AG + h * 3 + 1;
          U.selg = (const unsigned*)(a.ws + WS_MASK) + ((size_t)(b * 2 + g) * S_ + q0) * 4; U.tmp = (const bf16*)(a.ws + WS_OATMP) + (rowbase + q0) * 512 + h * 64;
          attn::attn_unit<1, 2, 8>(U, (char*)F.lds + RING_OFF); }
    }
}
typedef float f32x16g __attribute__((ext_vector_type(16)));
constexpr int GP = 72;
constexpr int GL_GS = 0;
constexpr int GL_VT = 16640 + 0;
constexpr int GL_A0 = GL_VT + 128 * GP * 2;
constexpr int GL_A1 = GL_A0 + 64 * GP * 2;
constexpr int GL_A2 = GL_A1 + 64 * GP * 2;
constexpr int GL_SS = GL_A2 + 64 * GP * 2;
constexpr int GL_END = GL_SS + 1024;
static_assert(GL_END <= RING_BYTES, "GLA LDS map");
__device__ __forceinline__ int crow32(int r, int hi) { return (r & 3) + 8 * (r >> 2) + 4 * hi; }
__device__ __forceinline__ bf16x8 lds_frag(const LAS bf16* X, int row, int kk) { return *(const LAS bf16x8*)(X + row * GP + kk); }
__device__ __forceinline__ float sum16(float v) {
    v += __int_as_float(__builtin_amdgcn_update_dpp(0, __float_as_int(v), 0xB1, 0xf, 0xf, true));
    v += __int_as_float(__builtin_amdgcn_update_dpp(0, __float_as_int(v), 0x4E, 0xf, 0xf, true));
    v += __int_as_float(__builtin_amdgcn_update_dpp(0, __float_as_int(v), 0x141, 0xf, 0xf, true));
    v += __int_as_float(__builtin_amdgcn_update_dpp(0, __float_as_int(v), 0x140, 0xf, 0xf, true));
    return v;
}
__device__ __forceinline__ void gla_put_vT(LAS bf16* vT, const v4u w0, const v4u w1, int w, int lane) {
    const unsigned ww[8] = {w0.x, w0.y, w0.z, w0.w, w1.x, w1.y, w1.z, w1.w};
#pragma unroll
    for (int i = 0; i < 8; ++i) { vT[(w * 16 + 2 * i) * GP + lane] = (bf16)(ww[i] & 0xffffu); vT[(w * 16 + 2 * i + 1) * GP + lane] = (bf16)(ww[i] >> 16); }
}
__device__ __forceinline__ void gla_g1(Frame& F, const Args& a, int l) {
    const bf16* Y = (const bf16*)(a.ws + WS_Y); bf16* GST = (bf16*)(a.ws + WS_GST); float* DEC = (float*)(a.ws + WS_GDEC); float* BC = (float*)(a.ws + WS_BCUM);
    LAS bf16* vT = (LAS bf16*)(F.lds + RING_OFF + GL_VT); LAS bf16* kT = (LAS bf16*)(F.lds + RING_OFF + GL_A0);
    const int lane = F.lane, r32 = lane & 31, hi = lane >> 5, w = F.wave;
    for (int u = blockIdx.x; u < 2048; u += F.G) {
        const int c = u & 127, bh = u >> 7, h = bh & 3, b = bh >> 2; const size_t row = (size_t)b * S_ + c * 64 + lane; const bf16* Yt = Y + row * YP;
        const v4u bl0 = *(const v4u*)(Yt + Y_BLR), bl1 = *(const v4u*)(Yt + Y_BLR + 8), kw = *(const v4u*)(Yt + Y_BK + h * 64 + 8 * w);
        const v4u vw0 = *(const v4u*)(Yt + Y_BV + h * 128 + 16 * w), vw1 = *(const v4u*)(Yt + Y_BV + h * 128 + 16 * w + 8);
        const float* w2 = a.in[13] + (size_t)l * 16 * 256 + h * 64 + 8 * w; const float* bias = a.in[14] + (size_t)l * 256 + h * 64 + 8 * w;
        float blr[16]; { float k0[8], k1[8]; unpack8(bl0, k0); unpack8(bl1, k1);
#pragma unroll
            for (int i = 0; i < 8; ++i) { blr[i] = k0[i]; blr[8 + i] = k1[i]; } }
        float bc[8];
#pragma unroll
        for (int i = 0; i < 8; ++i) { float z = bias[i];
#pragma unroll
            for (int r = 0; r < 16; ++r) z += blr[r] * w2[r * 256 + i];
            float v = -(fmaxf(-z, 0.f) + __logf(1.f + __expf(-fabsf(z)))) * (1.f / 16.f);
#pragma unroll
            for (int o = 1; o < 64; o <<= 1) { const float n = __shfl_up(v, o); v += lane >= o ? n : 0.f; }
            bc[i] = v; }
        { float* bcp = BC + row * 256 + h * 64 + 8 * w; *(f32x4*)bcp = (f32x4){bc[0], bc[1], bc[2], bc[3]}; *(f32x4*)(bcp + 4) = (f32x4){bc[4], bc[5], bc[6], bc[7]}; }
        { float kk[8]; unpack8(kw, kk);
#pragma unroll
          for (int i = 0; i < 8; ++i) { const float bl = __shfl(bc[i], 63); kT[(8 * w + i) * GP + lane] = (bf16)f2bf(kk[i] * __expf(bl - bc[i])); if (lane == i) DEC[(size_t)u * 64 + 8 * w + i] = __expf(bl); } }
        gla_put_vT(vT, vw0, vw1, w, lane);
        __syncthreads();
        { const int et = w >> 1, dt = w & 1; f32x16g acc = {};
#pragma unroll
          for (int ks = 0; ks < 4; ++ks) acc = __builtin_amdgcn_mfma_f32_32x32x16_bf16(lds_frag(vT, et * 32 + r32, ks * 16 + hi * 8), lds_frag(kT, dt * 32 + r32, ks * 16 + hi * 8), acc, 0, 0, 0);
          bf16* slot = GST + (size_t)u * 8192;
#pragma unroll
          for (int r = 0; r < 16; ++r) slot[(et * 32 + crow32(r, hi)) * 64 + dt * 32 + r32] = (bf16)f2bf(acc[r]); }
        __syncthreads();
    }
}
__device__ __forceinline__ void gla_g2(Frame& F, const Args& a) {
    unsigned* GST = (unsigned*)(a.ws + WS_GST); const float* DEC = (const float*)(a.ws + WS_GDEC);
    for (int i = blockIdx.x * 512 + F.tid; i < 16 * 128 * 32; i += F.G * 512) {
        const int dp = i & 31, bh = i >> 12; const int eo = (i >> 5) & 127;
        float s0 = 0.f, s1 = 0.f;
        for (int c0 = 0; c0 < 128; c0 += 8) {
            unsigned uu[8]; float d0[8], d1[8];
#pragma unroll
            for (int j = 0; j < 8; ++j) { const size_t sl = (size_t)(bh * 128 + c0 + j); uu[j] = GST[sl * 4096 + eo * 32 + dp]; d0[j] = DEC[sl * 64 + 2 * dp]; d1[j] = DEC[sl * 64 + 2 * dp + 1]; }
#pragma unroll
            for (int j = 0; j < 8; ++j) { const size_t sl = (size_t)(bh * 128 + c0 + j); GST[sl * 4096 + eo * 32 + dp] = pk2(s0, s1);
                s0 = s0 * d0[j] + __uint_as_float(uu[j] << 16); s1 = s1 * d1[j] + __uint_as_float(uu[j] & 0xffff0000u); }
        }
    }
}
__device__ __forceinline__ void gla_g3(Frame& F, const Args& a, int l, int qk) {
    bf16* Y = (bf16*)(a.ws + WS_Y); const bf16* GST = (const bf16*)(a.ws + WS_GST); const float* nw = a.in[15] + (size_t)l * 128; const float* BC = (const float*)(a.ws + WS_BCUM);
    LAS bf16* vT = (LAS bf16*)(F.lds + RING_OFF + GL_VT);
    LAS bf16* qd = (LAS bf16*)(F.lds + RING_OFF + GL_A0); LAS bf16* kd = (LAS bf16*)(F.lds + RING_OFF + GL_A1); LAS bf16* at = (LAS bf16*)(F.lds + RING_OFF + GL_A2);
    LAS float* ssq = (LAS float*)(F.lds + RING_OFF + GL_SS);
    const int lane = F.lane, r32 = lane & 31, hi = lane >> 5, w = F.wave, rb = w >> 2, et = w & 3;
    const int x0 = (int)(xb_xcc_id() & 7u); int xo = 0, xq = 0;
    for (;;) {
        const int i3 = next_unit_x(F, qk, 256, x0, xo, xq); if (i3 < 0) break;
        const int u = xq * 256 + i3;
        const int c = u & 127, bh = u >> 7, h = bh & 3, b = bh >> 2; bf16* Yc = Y + ((size_t)b * S_ + c * 64) * YP; const bf16* Yt = Yc + (size_t)lane * YP;
        const v4u qw = *(const v4u*)(Yt + Y_BQ + h * 64 + 8 * w), kw = *(const v4u*)(Yt + Y_BK + h * 64 + 8 * w);
        const v4u vw0 = *(const v4u*)(Yt + Y_BV + h * 128 + 16 * w), vw1 = *(const v4u*)(Yt + Y_BV + h * 128 + 16 * w + 8);
        const float* bcp = BC + ((size_t)b * S_ + c * 64 + lane) * 256 + h * 64 + 8 * w; const f32x4 bc0 = *(const f32x4*)bcp, bc1 = *(const f32x4*)(bcp + 4);
        bf16x8 sb[4]; { const bf16* slot = GST + (size_t)u * 8192 + (size_t)(et * 32 + r32) * 64 + hi * 8;
#pragma unroll
            for (int ks = 0; ks < 4; ++ks) sb[ks] = *(const bf16x8*)(slot + ks * 16); }
        bf16 rr[16];
#pragma unroll
        for (int r = 0; r < 16; ++r) rr[r] = Yc[(size_t)(rb * 32 + crow32(r, hi)) * YP + Y_BR + h * 128 + et * 32 + r32];
        const float nwe = nw[et * 32 + r32];
        { float qq[8], kk[8]; unpack8(qw, qq); unpack8(kw, kk); const float bc[8] = {bc0.x, bc0.y, bc0.z, bc0.w, bc1.x, bc1.y, bc1.z, bc1.w}; unsigned qa[4], ka[4];
#pragma unroll
          for (int i = 0; i < 4; ++i) { qa[i] = pk2(qq[2 * i] * __expf(bc[2 * i]), qq[2 * i + 1] * __expf(bc[2 * i + 1])); ka[i] = pk2(kk[2 * i] * __expf(-bc[2 * i]), kk[2 * i + 1] * __expf(-bc[2 * i + 1])); }
          v4u qo, ko; qo.x = qa[0]; qo.y = qa[1]; qo.z = qa[2]; qo.w = qa[3]; ko.x = ka[0]; ko.y = ka[1]; ko.z = ka[2]; ko.w = ka[3];
          *(LAS v4u*)(qd + lane * GP + 8 * w) = qo; *(LAS v4u*)(kd + lane * GP + 8 * w) = ko; }
        gla_put_vT(vT, vw0, vw1, w, lane);
        __syncthreads();
        if (w < 4) { const int ib = w >> 1, jb = w & 1;
            if (jb <= ib) { f32x16g acc = {};
#pragma unroll
                for (int ks = 0; ks < 4; ++ks) acc = __builtin_amdgcn_mfma_f32_32x32x16_bf16(lds_frag(qd, ib * 32 + r32, ks * 16 + hi * 8), lds_frag(kd, jb * 32 + r32, ks * 16 + hi * 8), acc, 0, 0, 0);
#pragma unroll
                for (int r = 0; r < 16; ++r) { const int i = ib * 32 + crow32(r, hi), j = jb * 32 + r32; at[i * GP + j] = (bf16)f2bf(j <= i ? acc[r] : 0.f); } } }
        __syncthreads();
        { f32x16g acc = {};
#pragma unroll
          for (int ks = 0; ks < 4; ++ks) acc = __builtin_amdgcn_mfma_f32_32x32x16_bf16(lds_frag(qd, rb * 32 + r32, ks * 16 + hi * 8), sb[ks], acc, 0, 0, 0);
          for (int ks = 0; ks < 2 * (rb + 1); ++ks) acc = __builtin_amdgcn_mfma_f32_32x32x16_bf16(lds_frag(at, rb * 32 + r32, ks * 16 + hi * 8), lds_frag(vT, et * 32 + r32, ks * 16 + hi * 8), acc, 0, 0, 0);
          float sq[16];
#pragma unroll
          for (int r = 0; r < 16; ++r) { float v = sum16(acc[r] * acc[r]); v += __shfl_xor(v, 16); sq[r] = v; }
          if (r32 == 0) {
#pragma unroll
              for (int r = 0; r < 16; ++r) ssq[w * 32 + crow32(r, hi)] = sq[r]; }
          __syncthreads();
#pragma unroll
          for (int r = 0; r < 16; ++r) { const int tr = crow32(r, hi); const float tot = ssq[(rb * 4 + 0) * 32 + tr] + ssq[(rb * 4 + 1) * 32 + tr] + ssq[(rb * 4 + 2) * 32 + tr] + ssq[(rb * 4 + 3) * 32 + tr];
              const float rv = bf2f(rr[r]);
              Yc[(size_t)(rb * 32 + tr) * YP + Y_BR + h * 128 + et * 32 + r32] = (bf16)f2bf(acc[r] * rsqrtf(tot * (1.f / 128.f) + NORM_EPS) * nwe * (rv * sigm(rv))); } }
    }
}
constexpr int CL_IMP = 0, CL_BIAS = 64 * 129 * 4, CL_K = CL_BIAS + 2048, CL_GATE = CL_K + 512 * GP * 2, CL_END = CL_GATE + 1024;
static_assert(CL_END <= RING_BYTES && (CL_K % 16) == 0, "cmp LDS map");
__device__ __forceinline__ int red8(int v) {
    v += __builtin_amdgcn_update_dpp(0, v, 0xB1, 0xf, 0xf, true);
    v += __builtin_amdgcn_update_dpp(0, v, 0x4E, 0xf, 0xf, true);
    v += __builtin_amdgcn_update_dpp(0, v, 0x141, 0xf, 0xf, true);
    return v;
}
typedef unsigned u32x2g __attribute__((ext_vector_type(2)));
struct VFrag { u32x2g a[8]; };
__device__ __forceinline__ void cmp_load_v(VFrag& f, const bf16* VT, int nt, int r32, int hi) {
#pragma unroll
    for (int dt = 0; dt < 2; ++dt)
#pragma unroll
        for (int kk = 0; kk < 2; ++kk) { const bf16* vp = VT + (size_t)(dt * 32 + r32) * 512 + nt * 32 + kk * 16 + 4 * hi; f.a[(dt * 2 + kk) * 2] = *(const u32x2g*)vp; f.a[(dt * 2 + kk) * 2 + 1] = *(const u32x2g*)(vp + 8); }
}
__device__ __forceinline__ void nsa_cmp_fast(Frame& F, const Args& a, int qk) {
    const bf16* Y = (const bf16*)(a.ws + WS_Y); const float* rel = a.in[1];
    LAS unsigned* impI = (LAS unsigned*)(F.lds + RING_OFF + CL_IMP); LAS float* biasT = (LAS float*)(F.lds + RING_OFF + CL_BIAS); LAS bf16* Ks = (LAS bf16*)(F.lds + RING_OFF + CL_K);
    const int lane = F.lane, r32 = lane & 31, hi = lane >> 5, w = F.wave, hr = w >> 1, qh = w & 1;
    const int x0 = (int)(xb_xcc_id() & 7u); int xo = 0, xq = 0;
    for (;;) {
        const int i = next_unit_x(F, qk, 128, x0, xo, xq); if (i < 0) break;
        const int c = 127 - i, bg = xq, g = bg & 1, b = bg >> 1, q0 = 64 * c; const size_t rowbase = (size_t)b * S_;
        const bf16* KC = (const bf16*)(a.ws + WS_KCMP) + (size_t)bg * 512 * 64; const bf16* VT = (const bf16*)(a.ws + WS_VCMPT) + (size_t)bg * 64 * 512;
        const int head = g * 4 + hr, qw0 = q0 + qh * 32, qpos = qw0 + r32;
        const int NTw = (qw0 / 16 + 1 + 31) >> 5;
        const int nrows = (((q0 + 32) / 16 + 1 + 31) >> 5) * 32;
        { v4u kv[8]; int tl = F.tid; asm volatile("" : "+v"(tl));
          const unsigned o0_ = (unsigned)((tl >> 3) * 64 + (tl & 7) * 8);
#pragma unroll
          for (int j = 0; j < 8; ++j) { const int p = tl + 512 * j; if (p < nrows * 8) kv[j] = *(const v4u*)(KC + o0_ + 4096u * j); }
          for (int ii = F.tid; ii < 64 * 129; ii += 512) impI[ii] = 0u;
          { const int hh = F.tid >> 7, dd = F.tid & 127; biasT[F.tid] = (rel[t5_bucket(dd) * 16 + g * 4 + hh] - rel[31 * 16 + g * 4 + hh]) * LOG2E; }
#pragma unroll
          for (int j = 0; j < 8; ++j) { const int p = tl + 512 * j; if (p < nrows * 8) *(LAS v4u*)(Ks + ((tl >> 3) + 64 * j) * GP + (tl & 7) * 8) = kv[j]; } }
        const bf16* Qw = Y + (rowbase + qw0) * YP + Y_AQ + head * 64;
        bf16x8 qr[4];
#pragma unroll
        for (int ks = 0; ks < 4; ++ks) qr[ks] = *(const bf16x8*)(Qw + (size_t)r32 * YP + ks * 16 + hi * 8);
        if (hi == 0) ((LAS float*)(F.lds + RING_OFF + CL_GATE))[w * 32 + r32] = sigm(bf2f(Y[(rowbase + qw0 + r32) * YP + Y_AG + head * 3]));
        __syncthreads();
        const LAS float* bT = biasT + hr * 128;
        float lsum = 0.f;
#pragma unroll 1
        for (int nt = 0; nt < NTw; ++nt) { f32x16g C = {};
#pragma unroll
            for (int ks = 0; ks < 4; ++ks) C = __builtin_amdgcn_mfma_f32_32x32x16_bf16(lds_frag(Ks, nt * 32 + r32, ks * 16 + hi * 8), qr[ks], C, 0, 0, 0);
#pragma unroll
            for (int r = 0; r < 16; ++r) { const int dist = qpos - (16 * (nt * 32 + crow32(r, hi)) + 31); lsum += dist >= 0 ? __builtin_amdgcn_exp2f(fminf(C[r] + bT[dist > 127 ? 127 : (dist < 0 ? 0 : dist)], 100.f)) : 0.f; } }
        { auto rr = __builtin_amdgcn_permlane32_swap(__float_as_uint(lsum), __float_as_uint(lsum), false, false); lsum = __uint_as_float(rr[0]) + __uint_as_float(rr[1]); }
        const float inv = 1.f / fmaxf(lsum, 1e-30f);
        f32x16g o0 = {}, o1 = {};
#pragma unroll 1
        for (int nt = 0; nt < NTw; ++nt) {
            VFrag vcur; cmp_load_v(vcur, VT, nt, r32, hi);
            f32x16g C = {};
#pragma unroll
            for (int ks = 0; ks < 4; ++ks) C = __builtin_amdgcn_mfma_f32_32x32x16_bf16(lds_frag(Ks, nt * 32 + r32, ks * 16 + hi * 8), qr[ks], C, 0, 0, 0);
            float p[16];
#pragma unroll
            for (int r = 0; r < 16; ++r) { const int dist = qpos - (16 * (nt * 32 + crow32(r, hi)) + 31); p[r] = dist >= 0 ? __builtin_amdgcn_exp2f(fminf(C[r] + bT[dist > 127 ? 127 : (dist < 0 ? 0 : dist)], 100.f)) * inv : 0.f; }
#pragma unroll
            for (int m = 0; m < 4; ++m) { const float G = (p[4 * m] + p[4 * m + 1]) + (p[4 * m + 2] + p[4 * m + 3]); const int j = nt * 8 + 2 * m + hi;
                LAS unsigned* ip = impI + (qh * 32 + r32) * 129 + j;
                __hip_atomic_fetch_add(ip, (unsigned)(G * 67108864.f + 0.5f), __ATOMIC_RELAXED, __HIP_MEMORY_SCOPE_WORKGROUP);
                if (j + 1 < 128) __hip_atomic_fetch_add(ip + 1, (unsigned)(p[4 * m + 3] * 67108864.f + 0.5f), __ATOMIC_RELAXED, __HIP_MEMORY_SCOPE_WORKGROUP); }
            v4u pw0, pw1; pw0.x = pk2(p[0], p[1]); pw0.y = pk2(p[2], p[3]); pw0.z = pk2(p[4], p[5]); pw0.w = pk2(p[6], p[7]); pw1.x = pk2(p[8], p[9]); pw1.y = pk2(p[10], p[11]); pw1.z = pk2(p[12], p[13]); pw1.w = pk2(p[14], p[15]);
            const bf16x8 pa0 = __builtin_bit_cast(bf16x8, pw0), pa1 = __builtin_bit_cast(bf16x8, pw1);
#pragma unroll
            for (int dt = 0; dt < 2; ++dt)
#pragma unroll
                for (int kk = 0; kk < 2; ++kk) { v4u vv; vv.x = vcur.a[(dt * 2 + kk) * 2].x; vv.y = vcur.a[(dt * 2 + kk) * 2].y; vv.z = vcur.a[(dt * 2 + kk) * 2 + 1].x; vv.w = vcur.a[(dt * 2 + kk) * 2 + 1].y;
                    if (dt == 0) o0 = __builtin_amdgcn_mfma_f32_32x32x16_bf16(kk ? pa1 : pa0, __builtin_bit_cast(bf16x8, vv), o0, 0, 0, 0);
                    else o1 = __builtin_amdgcn_mfma_f32_32x32x16_bf16(kk ? pa1 : pa0, __builtin_bit_cast(bf16x8, vv), o1, 0, 0, 0); }
            }
        { bf16* T = (bf16*)(a.ws + WS_OATMP);
#pragma unroll
          for (int r = 0; r < 16; ++r) { const size_t row = rowbase + qw0 + crow32(r, hi); const float gs = ((const LAS float*)(F.lds + RING_OFF + CL_GATE))[w * 32 + crow32(r, hi)];
              T[row * 512 + head * 64 + r32] = (bf16)f2bf(gs * o0[r]); T[row * 512 + head * 64 + 32 + r32] = (bf16)f2bf(gs * o1[r]); } }
        __syncthreads();
        { const int qi = F.tid >> 3, part = F.tid & 7, cur = c; unsigned key[16];
#pragma unroll
          for (int i2 = 0; i2 < 16; ++i2) { const int j = part * 16 + i2; const unsigned raw = impI[qi * 129 + j] >> 6; const bool forced = (j == 0) || (j == cur) || (j == cur - 1);
              key[i2] = forced ? (0xFFFFFF80u | (unsigned)(127 - j)) : (j <= cur ? ((((raw > 33554430u ? 33554430u : raw) + 1u) << 7) | (unsigned)(127 - j)) : (unsigned)(127 - j)); }
          unsigned T = 0u;
          for (int bit = 31; bit >= 0; --bit) { const unsigned Tt = T | (1u << bit); int cnt = 0;
#pragma unroll
              for (int i2 = 0; i2 < 16; ++i2) cnt += key[i2] >= Tt ? 1 : 0;
              cnt = red8(cnt); if (cnt >= 16) T = Tt; }
          unsigned bits = 0u;
#pragma unroll
          for (int i2 = 0; i2 < 16; ++i2) bits |= (key[i2] >= T && (part * 16 + i2) <= cur) ? (1u << i2) : 0u;
          ((unsigned short*)(a.ws + WS_MASK))[((size_t)bg * S_ + q0 + qi) * 8 + part] = (unsigned short)bits; }
    }
}
constexpr int CP_RED = 0, CP_HS = 8 * 32 * 64 * 4, CP_END = CP_HS + 32 * GP * 2;
static_assert(CP_END <= RING_BYTES, "compress LDS map");
__device__ __forceinline__ void compress_fast(Frame& F, const Args& a) {
    const bf16* Y = (const bf16*)(a.ws + WS_Y);
    LAS float* red = (LAS float*)(F.lds + RING_OFF + CP_RED); LAS bf16* hs = (LAS bf16*)(F.lds + RING_OFF + CP_HS);
    const int lane = F.lane, r32 = lane & 31, hi = lane >> 5, w = F.wave;
    for (int u = blockIdx.x; u < 256; u += F.G) {
        const int nt = u & 15, bg = (u >> 4) & 7, kv = u >> 7, g = bg & 1, b = bg >> 1;
        const int n = nt * 32 + r32, nn = n > 510 ? 510 : n;
        const bf16* xrow = Y + ((size_t)b * S_ + 16 * nn) * YP + (kv ? Y_AVC : Y_AKC) + g * 64 + hi * 8;
        const bf16* W1T = (const bf16*)(a.ws + WS_CW1T) + (size_t)kv * 64 * 2048;
        f32x16g acc0 = {}, acc1 = {};
#pragma unroll 4
        for (int s = 0; s < 16; ++s) { const int ks = w * 16 + s, pos = ks >> 2;
            const bf16x8 af = *(const bf16x8*)(xrow + (size_t)pos * YP + (ks & 3) * 16);
            const bf16x8 b0 = *(const bf16x8*)(W1T + (size_t)r32 * 2048 + ks * 16 + hi * 8), b1 = *(const bf16x8*)(W1T + (size_t)(32 + r32) * 2048 + ks * 16 + hi * 8);
            acc0 = __builtin_amdgcn_mfma_f32_32x32x16_bf16(af, b0, acc0, 0, 0, 0); acc1 = __builtin_amdgcn_mfma_f32_32x32x16_bf16(af, b1, acc1, 0, 0, 0); }
#pragma unroll
        for (int r = 0; r < 16; ++r) { red[(w * 32 + crow32(r, hi)) * 64 + r32] = acc0[r]; red[(w * 32 + crow32(r, hi)) * 64 + 32 + r32] = acc1[r]; }
        __syncthreads();
        { const float* c0 = (const float*)(a.ws + WS_CC0) + kv * 64;
#pragma unroll
          for (int i = 0; i < 4; ++i) { const int e = F.tid * 4 + i, rn = e >> 6, j = e & 63; float v = c0[j];
#pragma unroll
              for (int ww = 0; ww < 8; ++ww) v += red[(ww * 32 + rn) * 64 + j];
              hs[rn * GP + j] = (bf16)f2bf(gelu_tanh(v)); } }
        __syncthreads();
        if (w < 2) { const bf16* W2T = (const bf16*)(a.ws + WS_CW2T) + (size_t)kv * 64 * 64; f32x16g o = {};
#pragma unroll
            for (int ks = 0; ks < 4; ++ks) { const bf16x8 bf = *(const bf16x8*)(W2T + (size_t)(w * 32 + r32) * 64 + ks * 16 + hi * 8);
                o = __builtin_amdgcn_mfma_f32_32x32x16_bf16(lds_frag(hs, r32, ks * 16 + hi * 8), bf, o, 0, 0, 0); }
#pragma unroll
            for (int r = 0; r < 16; ++r) { const int rn = nt * 32 + crow32(r, hi), jp = w * 32 + r32;
                if (kv == 0) ((bf16*)(a.ws + WS_KCMP))[((size_t)bg * 512 + rn) * 64 + jp] = (bf16)f2bf(o[r]);
                else ((bf16*)(a.ws + WS_VCMPT))[((size_t)bg * 64 + jp) * 512 + rn] = (bf16)f2bf(o[r]); } }
        __syncthreads();
    }
}
__device__ __forceinline__ void gla_out_naive(Frame& F, const Args& a, int l) {
    const int gw = blockIdx.x * NWAVES + F.wave, NGW = F.G * NWAVES, lane = F.lane;
    bf16* Y = (bf16*)(a.ws + WS_Y); const bf16* O16 = (const bf16*)(a.ws + WS_O16); const float* nw = a.in[15] + (size_t)l * 128;
    for (int t = gw; t < M_ * 4; t += NGW) {
        const int h = t & 3; const size_t row = (size_t)(t >> 2);
        const float o0 = bf2f(O16[row * 512 + h * 128 + lane]), o1 = bf2f(O16[row * 512 + h * 128 + 64 + lane]);
        const float r = rsqrtf(wave_sum(o0 * o0 + o1 * o1) * (1.f / 128.f) + NORM_EPS);
        bf16* yr = Y + row * YP + Y_BR + h * 128;
        const float r0 = bf2f(yr[lane]), r1 = bf2f(yr[64 + lane]);
        yr[lane] = (bf16)f2bf(o0 * r * nw[lane] * (r0 * sigm(r0))); yr[64 + lane] = (bf16)f2bf(o1 * r * nw[64 + lane] * (r1 * sigm(r1)));
    }
}

__device__ __forceinline__ Frame fresh(const Frame& F) { Frame f = F; int t = threadIdx.x; asm volatile("" : "+v"(t)); f.tid = t; f.lane = t & 63; return f; }
constexpr int PPL = 11, NPH = NL * PPL;
#define IN(k) (lo <= (k) && (k) < hi)
#define SEAM(k) do { if (IN(k) && IN((k) + 1)) xcd_barrier(bar); } while (0)
template <int l> __device__ __forceinline__ void layer_body(Frame& F0, const Args& args, const XcdBarrier& bar, const int lo, const int hi) {
    unsigned char* ws = args.ws;
    bf16* H = (bf16*)(ws + WS_H); bf16* Y = (bf16*)(ws + WS_Y); unsigned char* G8 = ws + WS_G8;
    float* Yf = (float*)(ws + WS_Y); bf16* ACT = (bf16*)(ws + WS_ACT);
    constexpr int p0 = l * PPL;
    const float* xin = l == 0 ? args.in[0] : args.out;
    if (IN(p0 + 0)) { Frame F = fresh(F0); phase_weights(F, args, l); if (l == 0) phase_norm0(F, args.in[0], args.in[2], H); SEAM(p0 + 0); }
    if (IN(p0 + 1)) { Frame F = fresh(F0);
        pg8::Gemm g{H, (const bf16*)(ws + WS_WIN), M_, NIN, DM, DM}; pg8::StaticOrder So; So.init(M_, NIN, F.G, (int)blockIdx.x);
        pg8::EpiInProj E{Y, G8};
        pg8::gemm_phase<pg8::EpiInProj, pg8::StaticOrder, true, true>(F.lds + RING_OFF, g, So, E);
        SEAM(p0 + 1);
    }
    if (IN(p0 + 2)) { { Frame F = fresh(F0); compress_fast(F, args); } { Frame F = fresh(F0); phase2_naive(F, args, l); } { Frame F = fresh(F0); gla_g1(F, args, l); } SEAM(p0 + 2); }
    if (IN(p0 + 3)) { { Frame F = fresh(F0); gla_g2(F, args); } { Frame F = fresh(F0); moba_fast(F, args, l * 4 + 0); } { Frame F = fresh(F0); nsa_cmp_fast(F, args, l * 4 + 1); } SEAM(p0 + 3); }
    if (IN(p0 + 4)) { { Frame F = fresh(F0); nsa_fast(F, args, l * 4 + 2); } { Frame F = fresh(F0); gla_g3(F, args, l, l * 4 + 3); } SEAM(p0 + 4); }
    if (IN(p0 + 5)) { Frame F = fresh(F0);
        pg8::Fuse3Order So; So.So.init(M_, DM, F.G, (int)blockIdx.x);
        pg8::Gemm g{Y, (const bf16*)(ws + WS_WA), M_, DM, 512, YP, Y_AQ, Y_BR, Y_CQ}; pg8::EpiMerge3 E{H, G8};
        pg8::gemm_phase<pg8::EpiMerge3, pg8::Fuse3Order, true, true>(F.lds + RING_OFF, g, So, E);
        SEAM(p0 + 5);
    }
    if (IN(p0 + 6)) { Frame F = fresh(F0);
        pg8::Gemm g{H, (const bf16*)(ws + WS_WO), M_, DM, DM, DM}; pg8::StaticOrder So; So.init(M_, DM, F.G, (int)blockIdx.x);
        pg8::EpiB16 E{(bf16*)Yf, DM}; pg8::gemm_phase<pg8::EpiB16, pg8::StaticOrder, true, true>(F.lds + RING_OFF, g, So, E);
        SEAM(p0 + 6);
    }
    if (IN(p0 + 7)) { Frame F = fresh(F0); phase_resid(F, Yf, xin, args.out, args.in[3] + (size_t)l * DM, args.in[4] + (size_t)l * DM, H); SEAM(p0 + 7); }
    if (IN(p0 + 8)) { Frame F = fresh(F0);
        pg8::Gemm g{H, (const bf16*)(ws + WS_WF1), M_, 2 * FF, DM, DM}; pg8::StaticOrder So; So.init(M_, 2 * FF, F.G, (int)blockIdx.x);
        pg8::EpiSwiglu E{ACT, FF}; pg8::gemm_phase<pg8::EpiSwiglu, pg8::StaticOrder, true, true>(F.lds + RING_OFF, g, So, E);
        SEAM(p0 + 8);
    }
    if (IN(p0 + 9)) { Frame F = fresh(F0);
        pg8::Gemm g{ACT, (const bf16*)(ws + WS_WF2), M_, DM, FF, FF}; pg8::StaticOrder So; So.init(M_, DM, F.G, (int)blockIdx.x);
        pg8::EpiB16 E{(bf16*)Yf, DM}; pg8::gemm_phase<pg8::EpiB16, pg8::StaticOrder, true, true>(F.lds + RING_OFF, g, So, E);
        SEAM(p0 + 9);
    }
    if (IN(p0 + 10)) { Frame F = fresh(F0); phase_resid(F, Yf, args.out, args.out, args.in[5] + (size_t)l * DM, l + 1 < NL ? args.in[2] + (size_t)(l + 1) * DM : nullptr, l + 1 < NL ? H : nullptr); SEAM(p0 + 10); }
}
__global__ void __launch_bounds__(NWAVES * 64, 2) mk_fwd(Args args) {
    extern __shared__ __attribute__((aligned(16))) unsigned char lds[];
    Frame F;
    F.lds = (LAS unsigned char*)lds; F.MISC = (volatile LAS unsigned*)(F.lds + MISC_OFF);
    F.tid = threadIdx.x; F.lane = F.tid & 63; F.wave = __builtin_amdgcn_readfirstlane(F.tid >> 6); F.G = gridDim.x;
    F.ctl = (gu32*)(args.ws + WS_CTL);
    for (int u = F.tid; u < (LDS_BYTES - LDSCTL_OFF) / 4; u += NWAVES * 64) ((LAS unsigned*)(F.lds + LDSCTL_OFF))[u] = 0u;
    __syncthreads();
    const int lo = args.ph_lo, hi = args.ph_hi;
    XcdBarrier bar; bar.bar = (unsigned*)(F.ctl + CW_BAR); bar.x = 0; bar.st = nullptr;
    if (hi - lo > 1) bar = xcd_barrier_post((unsigned*)(F.ctl + CW_BAR), F.MISC + 8);
    layer_body<0>(F, args, bar, lo, hi);
    layer_body<1>(F, args, bar, lo, hi);
}
#undef IN
#undef SEAM

#ifndef MK_ONE_LAUNCH
#define MK_ONE_LAUNCH 1
#endif
extern "C" void kernel_launch(void* const* d_in, const int* in_sizes, int n_in, void* d_out, int out_size, void* d_ws, size_t ws_size, hipStream_t stream) {
    static int grid = 0;
    if (grid == 0) {
        if (n_in != 22 || out_size != M_ * DM || ws_size < WS_END) { fprintf(stderr, "kernel_launch: unexpected sizes (n_in %d out %d ws %zu)\n", n_in, out_size, ws_size); grid = -1; return; }
        int dev = 0, cus = 0;
        if (hipGetDevice(&dev) != hipSuccess || hipDeviceGetAttribute(&cus, hipDeviceAttributeMultiprocessorCount, dev) != hipSuccess) { grid = -1; return; }
        if (hipFuncSetAttribute((const void*)mk_fwd, hipFuncAttributeMaxDynamicSharedMemorySize, LDS_BYTES) != hipSuccess) { grid = -1; return; }
        (void)hipGetLastError();
        grid = cus;
    }
    if (grid < 0) return;
    if (hipMemsetAsync((char*)d_ws + WS_CTL, 0, CTL_ZERO_BYTES, stream) != hipSuccess) return;
    Args a{};
    for (int i = 0; i < 22; ++i) a.in[i] = (const float*)d_in[i];
    a.out = (float*)d_out; a.ws = (unsigned char*)d_ws;
#if MK_ONE_LAUNCH
    a.ph_lo = 0; a.ph_hi = NPH;
    hipLaunchKernelGGL(mk_fwd, dim3(grid), dim3(NWAVES * 64), LDS_BYTES, stream, a);
#else
    for (int p = 0; p < NPH; ++p) { a.ph_lo = p; a.ph_hi = p + 1; hipLaunchKernelGGL(mk_fwd, dim3(grid), dim3(NWAVES * 64), LDS_BYTES, stream, a); }
#endif
}
```

```cpp
#include <hip/hip_runtime.h>
#include <cstdio>
#include <cstdint>
#include <cmath>
namespace pg8 {
#define PG8_LAS __attribute__((address_space(3)))
typedef unsigned short bf16_t;
typedef short bf16x8 __attribute__((ext_vector_type(8)));
typedef float f32x4 __attribute__((ext_vector_type(4)));
typedef unsigned u32x4 __attribute__((ext_vector_type(4)));
constexpr int BM = 256, BK = 64, HALF = 128, HTB = HALF * BK * 2  , STAGE_BYTES = 8 * HTB, NXCD = 8, WGM = 8;

__host__ __device__ __forceinline__ int lds_byte(int r, int c) { const int st = (r >> 4) * 2 + (c >> 5), rr = r & 15, cc = c & 31, ob = rr * 64 + cc * 2; return st * 1024 + (ob ^ (((ob >> 9) & 1) << 5)); }
__host__ __device__ __forceinline__ void stage_rc(int b, int& R, int& C) { const int st = b / 1024, sb = b % 1024, swz = sb ^ (((sb >> 9) & 1) << 5); R = (st >> 1) * 16 + swz / 64; C = (st & 1) * 32 + (swz % 64) / 2; }
__host__ __device__ __forceinline__ int perm32(int rho) { const int n = rho >> 4, i = rho & 15; return 8 * (i >> 2) + 4 * n + (i & 3); }

struct Unit { int pm, pn, pnb, k; };
struct Gemm { const bf16_t* A; const bf16_t* Bt; int M, N, K, lda; int ac0, ac1, ac2;
    __host__ __device__ __forceinline__ int acol(int k) const { return ac0 + (k & 1) * (ac1 - ac0) + (k >> 1) * (ac2 - ac0);   } };

struct StaticOrder {
    int nM, nN, nwg, G, c;
    __host__ __device__ void init(int M, int N, int G_, int c_) { nM = M / BM; nN = N / BM; nwg = nM * nN; G = G_; c = c_; }
    __host__ __device__ __forceinline__ bool next(int i, Unit& u) const {
        const long L = (long)i * G + c; if (L >= nwg) return false;
        int wgid = (int)L; { const int q = nwg / NXCD, r = nwg % NXCD, xcd = wgid % NXCD, off = wgid / NXCD; wgid = (xcd < r ? xcd * (q + 1) : r * (q + 1) + (xcd - r) * q) + off; }
        const int nig = WGM * nN, gid = wgid / nig, fm = gid * WGM, gsz = (nM - fm) < WGM ? (nM - fm) : WGM;
        u.pm = fm + ((wgid % nig) % gsz); u.pn = (wgid % nig) / gsz; u.pnb = u.pn; u.k = 0; return true;
    }
    __device__ __forceinline__ void a_ready(const Unit&) const {}
    __device__ __forceinline__ void done(const Unit&) const {}
};

__device__ __forceinline__ unsigned cvt_pk_bf16(float lo, float hi) { unsigned r; asm volatile("v_cvt_pk_bf16_f32 %0, %1, %2" : "=v"(r) : "v"(lo), "v"(hi)); return r; }
typedef float f32x2 __attribute__((ext_vector_type(2)));
constexpr int YP_ = 4392;
constexpr float C2_ = 0.125f * 1.4426950408889634f;
__device__ __forceinline__ float sigmoidf_(float v) { return 1.f / (1.f + __expf(-v)); }
struct EpiInProj {
    static constexpr bool PERM = true, AFTER_DRAIN = false, FUSE3 = false;
    bf16_t* Y; unsigned char* G8;
    __device__ __forceinline__ void operator()(const f32x4 (&acc)[2][2][4][2], const Unit& u, int wr, int wc, int fr, int fq) const {
        const int row0 = u.pm * BM + wr * 64 + fr, colt = u.pn * BM, cin = wc * 32 + 8 * fq;
        if (u.pn < 18) {
            float sc = 1.f; if (u.pn < 2 || u.pn == 5 || u.pn == 6) sc = C2_; else if (u.pn == 11) sc = 0.125f;
#pragma unroll
            for (int ai = 0; ai < 2; ++ai)
#pragma unroll
                for (int m = 0; m < 4; ++m) { bf16_t* rowp = Y + (size_t)(row0 + ai * HALF + m * 16) * YP_;
#pragma unroll
                    for (int bj = 0; bj < 2; ++bj) { const int col = colt + cin + bj * HALF;
                        if (col + 8 <= YP_) { const f32x4 v0 = acc[ai][bj][m][0] * sc, v1 = acc[ai][bj][m][1] * sc; u32x4 w;
                            w.x = cvt_pk_bf16(v0[0], v0[1]); w.y = cvt_pk_bf16(v0[2], v0[3]); w.z = cvt_pk_bf16(v1[0], v1[1]); w.w = cvt_pk_bf16(v1[2], v1[3]);
                            *(u32x4*)(rowp + col) = w; } } }
        } else {
#pragma unroll
            for (int ai = 0; ai < 2; ++ai)
#pragma unroll
                for (int m = 0; m < 4; ++m) { unsigned char* rowp = G8 + (size_t)(row0 + ai * HALF + m * 16) * 3072 + (colt - 4608) + cin;
#pragma unroll
                    for (int bj = 0; bj < 2; ++bj) { const f32x4 v0 = acc[ai][bj][m][0], v1 = acc[ai][bj][m][1]; unsigned lo = 0u, hi = 0u;
#pragma unroll
                        for (int e = 0; e < 4; ++e) { lo |= (unsigned)(sigmoidf_(v0[e]) * 255.f + 0.5f) << (8 * e); hi |= (unsigned)(sigmoidf_(v1[e]) * 255.f + 0.5f) << (8 * e); }
                        typedef unsigned u32x2 __attribute__((ext_vector_type(2))); u32x2 w; w.x = lo; w.y = hi; *(u32x2*)(rowp + bj * HALF) = w; } }
        }
    }
};
template <int I> struct EpiMerge {
    static constexpr bool PERM = true, AFTER_DRAIN = false, FUSE3 = false;
    bf16_t* Mg; const unsigned char* G8;
    __device__ __forceinline__ void operator()(const f32x4 (&acc)[2][2][4][2], const Unit& u, int wr, int wc, int fr, int fq) const {
        const int row0 = u.pm * BM + wr * 64 + fr, col0 = u.pn * BM + wc * 32 + 8 * fq;
#pragma unroll
        for (int ai = 0; ai < 2; ++ai)
#pragma unroll
            for (int m = 0; m < 4; ++m) { const size_t row = (size_t)(row0 + ai * HALF + m * 16);
#pragma unroll
                for (int bj = 0; bj < 2; ++bj) { const int col = col0 + bj * HALF;
                    typedef unsigned u32x2 __attribute__((ext_vector_type(2)));
                    const u32x2 gw = *(const u32x2*)(G8 + row * 3072 + I * 1024 + col);
                    float v[8];
#pragma unroll
                    for (int e = 0; e < 4; ++e) { v[e] = acc[ai][bj][m][0][e] * ((float)((gw.x >> (8 * e)) & 255u) * (1.f / 255.f)); v[4 + e] = acc[ai][bj][m][1][e] * ((float)((gw.y >> (8 * e)) & 255u) * (1.f / 255.f)); }
                    bf16_t* p = Mg + row * 1024 + col;
                    if (I > 0) { const u32x4 o = *(const u32x4*)p;
                        v[0] += __uint_as_float(o.x << 16); v[1] += __uint_as_float(o.x & 0xffff0000u); v[2] += __uint_as_float(o.y << 16); v[3] += __uint_as_float(o.y & 0xffff0000u);
                        v[4] += __uint_as_float(o.z << 16); v[5] += __uint_as_float(o.z & 0xffff0000u); v[6] += __uint_as_float(o.w << 16); v[7] += __uint_as_float(o.w & 0xffff0000u); }
                    u32x4 w; w.x = cvt_pk_bf16(v[0], v[1]); w.y = cvt_pk_bf16(v[2], v[3]); w.z = cvt_pk_bf16(v[4], v[5]); w.w = cvt_pk_bf16(v[6], v[7]);
                    *(u32x4*)p = w; } }
    }
};
struct Fuse3Order {
    StaticOrder So;
    __host__ __device__ __forceinline__ bool next(int i, Unit& u) const { const int su = i / 3, k = i - 3 * su; if (!So.next(su, u)) return false; u.k = k; u.pnb = u.pn + 4 * k; return true; }
    __device__ __forceinline__ void a_ready(const Unit&) const {}
    __device__ __forceinline__ void done(const Unit&) const {}
};
struct EpiMerge3 {
    static constexpr bool PERM = true, AFTER_DRAIN = false, FUSE3 = true;
    bf16_t* Mg; const unsigned char* G8;
    typedef unsigned u32x2 __attribute__((ext_vector_type(2)));
    __device__ __forceinline__ void scale(f32x4 (&acc)[2][2][4][2], const Unit& u, int wr, int wc, int fr, int fq) const {
        const int row0 = u.pm * BM + wr * 64 + fr, col0 = u.pn * BM + wc * 32 + 8 * fq;
#pragma unroll
        for (int ai = 0; ai < 2; ++ai)
#pragma unroll
            for (int m = 0; m < 4; ++m) { const unsigned char* gp = G8 + (size_t)(row0 + ai * HALF + m * 16) * 3072 + u.k * 1024 + col0;
#pragma unroll
                for (int bj = 0; bj < 2; ++bj) { const u32x2 ga = *(const u32x2*)(gp + bj * HALF), gb = *(const u32x2*)(gp + bj * HALF + 1024);
#pragma unroll
                    for (int e = 0; e < 4; ++e) {
                        const float na = (float)((ga.x >> (8 * e)) & 255u), nb = fmaxf((float)((gb.x >> (8 * e)) & 255u), 0.5f);
                        const float nc = (float)((ga.y >> (8 * e)) & 255u), nd = fmaxf((float)((gb.y >> (8 * e)) & 255u), 0.5f);
                        const float fa = u.k == 0 ? na : fmaxf(na, 0.5f), fc = u.k == 0 ? nc : fmaxf(nc, 0.5f);
                        acc[ai][bj][m][0][e] *= fa * __builtin_amdgcn_rcpf(nb); acc[ai][bj][m][1][e] *= fc * __builtin_amdgcn_rcpf(nd); } } }
    }
    __device__ __forceinline__ void operator()(const f32x4 (&acc)[2][2][4][2], const Unit& u, int wr, int wc, int fr, int fq) const {
        const int row0 = u.pm * BM + wr * 64 + fr, col0 = u.pn * BM + wc * 32 + 8 * fq;
#pragma unroll
        for (int ai = 0; ai < 2; ++ai)
#pragma unroll
            for (int m = 0; m < 4; ++m) { const size_t row = (size_t)(row0 + ai * HALF + m * 16);
#pragma unroll
                for (int bj = 0; bj < 2; ++bj) { const int col = col0 + bj * HALF; const u32x2 gw = *(const u32x2*)(G8 + row * 3072 + 2048 + col); float v[8];
#pragma unroll
                    for (int e = 0; e < 4; ++e) { v[e] = acc[ai][bj][m][0][e] * (fmaxf((float)((gw.x >> (8 * e)) & 255u), 0.5f) * (1.f / 255.f)); v[4 + e] = acc[ai][bj][m][1][e] * (fmaxf((float)((gw.y >> (8 * e)) & 255u), 0.5f) * (1.f / 255.f)); }
                    u32x4 w; w.x = cvt_pk_bf16(v[0], v[1]); w.y = cvt_pk_bf16(v[2], v[3]); w.z = cvt_pk_bf16(v[4], v[5]); w.w = cvt_pk_bf16(v[6], v[7]);
                    *(u32x4*)(Mg + row * 1024 + col) = w; } }
    }
};
struct EpiB16 {
    static constexpr bool PERM = true, AFTER_DRAIN = false, FUSE3 = false;
    bf16_t* O; int ldc;
    __device__ __forceinline__ void operator()(const f32x4 (&acc)[2][2][4][2], const Unit& u, int wr, int wc, int fr, int fq) const {
        const int row0 = u.pm * BM + wr * 64 + fr, col0 = u.pn * BM + wc * 32 + 8 * fq;
#pragma unroll
        for (int ai = 0; ai < 2; ++ai)
#pragma unroll
            for (int m = 0; m < 4; ++m) { bf16_t* rowp = O + (size_t)(row0 + ai * HALF + m * 16) * ldc + col0;
#pragma unroll
                for (int bj = 0; bj < 2; ++bj) { const f32x4 v0 = acc[ai][bj][m][0], v1 = acc[ai][bj][m][1]; u32x4 w;
                    w.x = cvt_pk_bf16(v0[0], v0[1]); w.y = cvt_pk_bf16(v0[2], v0[3]); w.z = cvt_pk_bf16(v1[0], v1[1]); w.w = cvt_pk_bf16(v1[2], v1[3]);
                    *(u32x4*)(rowp + bj * HALF) = w; } }
    }
};
struct EpiF32 {
    static constexpr bool PERM = true, AFTER_DRAIN = false, FUSE3 = false;
    float* O; int ldc;
    __device__ __forceinline__ void operator()(const f32x4 (&acc)[2][2][4][2], const Unit& u, int wr, int wc, int fr, int fq) const {
        const int row0 = u.pm * BM + wr * 64 + fr, col0 = u.pn * BM + wc * 32 + 8 * fq;
#pragma unroll
        for (int ai = 0; ai < 2; ++ai)
#pragma unroll
            for (int m = 0; m < 4; ++m) { float* rowp = O + (size_t)(row0 + ai * HALF + m * 16) * ldc + col0;
#pragma unroll
                for (int bj = 0; bj < 2; ++bj) { *(f32x4*)(rowp + bj * HALF) = acc[ai][bj][m][0]; *(f32x4*)(rowp + bj * HALF + 4) = acc[ai][bj][m][1]; } }
    }
};
struct EpiSwiglu {
    static constexpr bool PERM = true, AFTER_DRAIN = false, FUSE3 = false;
    bf16_t* Act; int ldc;
    __device__ __forceinline__ void operator()(const f32x4 (&acc)[2][2][4][2], const Unit& u, int wr, int wc, int fr, int fq) const {
        const int row0 = u.pm * BM + wr * 64 + fr, col0 = u.pn * HALF + wc * 32 + 8 * fq;
#pragma unroll
        for (int ai = 0; ai < 2; ++ai)
#pragma unroll
            for (int m = 0; m < 4; ++m) { bf16_t* p = Act + (size_t)(row0 + ai * HALF + m * 16) * ldc + col0; float v[8];
#pragma unroll
                for (int e = 0; e < 4; ++e) { const float g0 = acc[ai][0][m][0][e], g1 = acc[ai][0][m][1][e];
                    v[e] = g0 * sigmoidf_(g0) * acc[ai][1][m][0][e]; v[4 + e] = g1 * sigmoidf_(g1) * acc[ai][1][m][1][e]; }
                u32x4 w; w.x = cvt_pk_bf16(v[0], v[1]); w.y = cvt_pk_bf16(v[2], v[3]); w.z = cvt_pk_bf16(v[4], v[5]); w.w = cvt_pk_bf16(v[6], v[7]);
                *(u32x4*)p = w; }
    }
};
template <class Epi, class Sched, bool ALIGN_EPI = false, bool SP2 = false>
__device__ __forceinline__ void gemm_phase(PG8_LAS unsigned char* lds, const Gemm g, const Sched& S, const Epi& E) {
    int tid_l = threadIdx.x; asm volatile("" : "+v"(tid_l));
    const int tid = tid_l, wid = __builtin_amdgcn_readfirstlane(tid >> 6), lane = tid & 63, wr = wid >> 2, wc = wid & 3, fr = lane & 15, fq = lane >> 4;
    const int K = g.K, nt = K / BK;
    unsigned voffA[2], voffB[2];
#pragma unroll
    for (int i = 0; i < 2; ++i) { int R, C; stage_rc(tid * 16 + i * 8192, R, C); const int Rb = Epi::PERM ? ((R & ~31) + perm32(R & 31)) : R;
        voffA[i] = (unsigned)(R * g.lda + C) * 2u; voffB[i] = (unsigned)(Rb * K + C) * 2u; }
    const size_t kstep = (size_t)(BK * 2);
    const size_t hstepB = (size_t)HALF * K * 2, hstepA = (size_t)HALF * g.lda * 2;
    const size_t tstepA = 2 * hstepA, tstepB = 2 * hstepB;
    const unsigned ldsw = (unsigned)wid * 1024u;
    const int aoff = lds_byte(wr * 64 + fr, fq * 8), boff = lds_byte(wc * 32 + fr, fq * 8);
#define PG8_SA(b, h) (((b) * 2 + (h)) * HTB)
#define PG8_SB(b, h) ((4 + (b) * 2 + (h)) * HTB)
#define PG8_STAGE(bufoff, gbase, voff) do { _Pragma("unroll") for (int _i = 0; _i < 2; ++_i) \
        __builtin_amdgcn_global_load_lds((const unsigned*)((const char*)(gbase) + (voff)[_i]), (PG8_LAS unsigned*)(lds + (bufoff) + ldsw + _i * 8192), 16, 0, 0); } while (0)
#define PG8_LDA(dst, b, h) do { _Pragma("unroll") for (int m = 0; m < 4; ++m) _Pragma("unroll") for (int k = 0; k < 2; ++k) dst[m][k] = *(const PG8_LAS bf16x8*)(lds + PG8_SA(b, h) + aoff + m * 2048 + k * 1024); } while (0)
#define PG8_LDB(dst, b, h) do { _Pragma("unroll") for (int n = 0; n < 2; ++n) _Pragma("unroll") for (int k = 0; k < 2; ++k) dst[n][k] = *(const PG8_LAS bf16x8*)(lds + PG8_SB(b, h) + boff + n * 2048 + k * 1024); } while (0)
#define PG8_MMA(ai, bj, At, Bt) do { __builtin_amdgcn_s_setprio(1); _Pragma("unroll") for (int m = 0; m < 4; ++m) _Pragma("unroll") for (int n = 0; n < 2; ++n) _Pragma("unroll") for (int k = 0; k < 2; ++k) \
        acc[ai][bj][m][n] = __builtin_amdgcn_mfma_f32_16x16x32_bf16(Bt[n][k], At[m][k], acc[ai][bj][m][n], 0, 0, 0); __builtin_amdgcn_s_setprio(0); } while (0)
#define PG8_WAIT_V(n) asm volatile("s_waitcnt vmcnt(" #n ")" ::: "memory")
#define PG8_WAIT_L(n) asm volatile("s_waitcnt lgkmcnt(" #n ")" ::: "memory")
#define PG8_BAR __builtin_amdgcn_s_barrier()
#define PG8_SCHED __builtin_amdgcn_sched_barrier(0)
    Unit cur, nxt; int ui = 0;
    if (!S.next(0, cur)) return;
    f32x4 acc[2][2][4][2];
#pragma unroll
    for (int a = 0; a < 2; ++a)
#pragma unroll
        for (int b = 0; b < 2; ++b)
#pragma unroll
            for (int m = 0; m < 4; ++m)
#pragma unroll
                for (int n = 0; n < 2; ++n) acc[a][b][m][n] = (f32x4){0.f, 0.f, 0.f, 0.f};
    bf16x8 At[4][2], B0[2][2], B1[2][2];
    const char* cA = (const char*)g.A + (size_t)g.acol(cur.k) * 2 + (size_t)cur.pm * tstepA; const char* cB = (const char*)g.Bt + (size_t)cur.pnb * tstepB;
    S.a_ready(cur);
    if constexpr (SP2) {
        PG8_STAGE(PG8_SB(0, 0), cB, voffB); PG8_STAGE(PG8_SB(0, 1), cB + hstepB, voffB); PG8_STAGE(PG8_SA(0, 0), cA, voffA); PG8_STAGE(PG8_SA(0, 1), cA + hstepA, voffA);
        if (wr == 1) PG8_BAR;
        PG8_WAIT_V(2); PG8_BAR;
        PG8_STAGE(PG8_SB(1, 0), cB + kstep, voffB); PG8_STAGE(PG8_SA(1, 0), cA + kstep, voffA); PG8_STAGE(PG8_SB(1, 1), cB + hstepB + kstep, voffB);
        PG8_WAIT_V(6); PG8_BAR;
    } else {
        PG8_STAGE(PG8_SB(0, 0), cB, voffB); PG8_STAGE(PG8_SA(0, 0), cA, voffA); PG8_STAGE(PG8_SB(0, 1), cB + hstepB, voffB); PG8_STAGE(PG8_SA(0, 1), cA + hstepA, voffA);
        if (wr == 1) PG8_BAR;
        PG8_WAIT_V(4); PG8_BAR;
        PG8_STAGE(PG8_SB(1, 0), cB + kstep, voffB); PG8_STAGE(PG8_SA(1, 0), cA + kstep, voffA); PG8_STAGE(PG8_SB(1, 1), cB + hstepB + kstep, voffB);
        PG8_WAIT_V(6); PG8_BAR;
    }
    for (;;) {
        const bool has_next = S.next(ui + 1, nxt);
        const char* nA = has_next ? (const char*)g.A + (size_t)g.acol(nxt.k) * 2 + (size_t)nxt.pm * tstepA : cA; const char* nB = has_next ? (const char*)g.Bt + (size_t)nxt.pnb * tstepB : cB;
        for (int t = 0; t < nt; t += 2) {
            const bool last = (t == nt - 2);
            const char* a1 = cA + (size_t)(t + 1) * kstep;
            const char* a2 = last ? nA : cA + (size_t)(t + 2) * kstep; const char* b2 = last ? nB : cB + (size_t)(t + 2) * kstep;
            const char* a3 = a2 + kstep; const char* b3 = b2 + kstep;
            if (last && has_next) S.a_ready(nxt);
            if constexpr (SP2) {
            PG8_LDB(B0, 0, 0); PG8_LDB(B1, 0, 1); PG8_SCHED; PG8_LDA(At, 0, 0); PG8_STAGE(PG8_SA(1, 1), a1 + hstepA, voffA);
            PG8_WAIT_V(8); PG8_WAIT_L(0); PG8_BAR; PG8_MMA(0, 0, At, B0); PG8_MMA(0, 1, At, B1); PG8_BAR; PG8_SCHED;
            PG8_LDA(At, 0, 1); PG8_STAGE(PG8_SB(0, 0), b2, voffB); PG8_STAGE(PG8_SB(0, 1), b2 + hstepB, voffB); PG8_STAGE(PG8_SA(0, 0), a2, voffA);
            PG8_WAIT_V(8); PG8_WAIT_L(0); PG8_BAR; PG8_MMA(1, 0, At, B0); PG8_MMA(1, 1, At, B1); PG8_BAR; PG8_SCHED;
            PG8_LDB(B0, 1, 0); PG8_LDB(B1, 1, 1); PG8_SCHED; PG8_LDA(At, 1, 0); PG8_STAGE(PG8_SA(0, 1), a2 + hstepA, voffA);
            PG8_WAIT_V(8); PG8_WAIT_L(0); PG8_BAR; PG8_MMA(0, 0, At, B0); PG8_MMA(0, 1, At, B1); PG8_BAR; PG8_SCHED;
            PG8_LDA(At, 1, 1); PG8_STAGE(PG8_SB(1, 0), b3, voffB); PG8_STAGE(PG8_SB(1, 1), b3 + hstepB, voffB); PG8_STAGE(PG8_SA(1, 0), a3, voffA);
            PG8_WAIT_V(8); PG8_WAIT_L(0); PG8_BAR; PG8_MMA(1, 0, At, B0); PG8_MMA(1, 1, At, B1); PG8_BAR; PG8_SCHED;
            } else {
            PG8_LDB(B0, 0, 0); PG8_SCHED; PG8_LDA(At, 0, 0); PG8_STAGE(PG8_SA(1, 1), a1 + hstepA, voffA);
            PG8_WAIT_L(8); PG8_BAR; PG8_WAIT_L(0); PG8_MMA(0, 0, At, B0); PG8_BAR; PG8_SCHED;
            PG8_LDB(B1, 0, 1); PG8_STAGE(PG8_SB(0, 0), b2, voffB);
            PG8_BAR; PG8_WAIT_L(0); PG8_MMA(0, 1, At, B1); PG8_BAR;
            PG8_LDA(At, 0, 1); PG8_STAGE(PG8_SA(0, 0), a2, voffA);
            PG8_BAR; PG8_WAIT_L(0); PG8_MMA(1, 0, At, B0); PG8_BAR; PG8_SCHED;
            PG8_STAGE(PG8_SB(0, 1), b2 + hstepB, voffB);
            PG8_WAIT_V(6); PG8_BAR; PG8_MMA(1, 1, At, B1); PG8_BAR;
            PG8_LDB(B0, 1, 0); PG8_SCHED; PG8_LDA(At, 1, 0); PG8_STAGE(PG8_SA(0, 1), a2 + hstepA, voffA);
            PG8_WAIT_L(8); PG8_BAR; PG8_WAIT_L(0); PG8_MMA(0, 0, At, B0); PG8_BAR; PG8_SCHED;
            PG8_LDB(B1, 1, 1); PG8_STAGE(PG8_SB(1, 0), b3, voffB);
            PG8_BAR; PG8_WAIT_L(0); PG8_MMA(0, 1, At, B1); PG8_BAR;
            PG8_LDA(At, 1, 1); PG8_STAGE(PG8_SA(1, 0), a3, voffA);
            PG8_BAR; PG8_WAIT_L(0); PG8_MMA(1, 0, At, B0); PG8_BAR; PG8_SCHED;
            PG8_STAGE(PG8_SB(1, 1), b3 + hstepB, voffB);
            PG8_WAIT_V(6); PG8_BAR; PG8_MMA(1, 1, At, B1); PG8_BAR;
            }
        }
        if constexpr (ALIGN_EPI) { if (wr == 0) PG8_BAR; }
        if constexpr (Epi::FUSE3) { if (cur.k < 2) E.scale(acc, cur, wr, wc, fr, fq); else E(acc, cur, wr, wc, fr, fq); }
        else if constexpr (!Epi::AFTER_DRAIN) { E(acc, cur, wr, wc, fr, fq); S.done(cur); }
        if (!has_next) break;
        if (!Epi::FUSE3 || cur.k == 2) {
#pragma unroll
        for (int a = 0; a < 2; ++a)
#pragma unroll
            for (int b = 0; b < 2; ++b)
#pragma unroll
                for (int m = 0; m < 4; ++m)
#pragma unroll
                    for (int n = 0; n < 2; ++n) acc[a][b][m][n] = (f32x4){0.f, 0.f, 0.f, 0.f};
        }
        cur = nxt; cA = nA; cB = nB; ++ui;
        if constexpr (ALIGN_EPI) { if (wr == 1) PG8_BAR; }
    }
    PG8_WAIT_V(0);
    if constexpr (!ALIGN_EPI) { if (wr == 0) PG8_BAR; }
    PG8_BAR;
    if constexpr (Epi::AFTER_DRAIN) { E.fused(acc, cur, wr, wc, fr, fq, lds, wid, lane); S.done(cur); }
#undef PG8_SA
#undef PG8_SB
#undef PG8_STAGE
#undef PG8_LDA
#undef PG8_LDB
#undef PG8_MMA
#undef PG8_WAIT_V
#undef PG8_WAIT_L
#undef PG8_BAR
#undef PG8_SCHED
}
}
namespace attn {
using bf16=unsigned short;
using bf16x8=__attribute__((ext_vector_type(8)))short;
using s16x4=__attribute__((ext_vector_type(4)))short;
using f32x16=__attribute__((ext_vector_type(16)))float;
using u32x4=__attribute__((ext_vector_type(4)))unsigned;
constexpr int D=64, PITCH=4392, SEQ=8192;
constexpr int NW=8,QBLK=32,QB=QBLK*NW,KVBLK=64;
__device__ __forceinline__ int crow(int r,int hi){return (r&3)+8*(r>>2)+4*hi;}
#define SBAR() __builtin_amdgcn_sched_barrier(0)
using f32x4_=__attribute__((ext_vector_type(4)))float;
__device__ __forceinline__ float bfs(short v){ return __uint_as_float(((unsigned)(unsigned short)v)<<16); }
__device__ __forceinline__ float lo16(unsigned w){ return __uint_as_float(w<<16); }
__device__ __forceinline__ float hi16(unsigned w){ return __uint_as_float(w&0xffff0000u); }
__device__ __forceinline__ bf16 f2b(float f){ unsigned u=__float_as_uint(f); return (bf16)((u+0x7fffu+((u>>16)&1u))>>16); }
__device__ __forceinline__ unsigned pk2b(float lo,float hi){ return (unsigned)f2b(lo)|((unsigned)f2b(hi)<<16); }
constexpr int NSLOT=3, SLOTB=8192;
constexpr int LDS_K=0, LDS_V=NSLOT*SLOTB, LDS_WS=2*NSLOT*SLOTB, LDS_OST=LDS_WS+NW*128*4, LDS_BIAS=LDS_OST+NW*4096, LDS_MSK=LDS_BIAS+512, LDS_KM=LDS_MSK+NW*512, LDS_BYTES=LDS_KM+8192;
constexpr float LOG2E_=1.4426950408889634f;
__device__ __forceinline__ void glds16(const void*gsrc,unsigned lds_dst){unsigned keep;
  asm volatile("s_mov_b32 %0, m0\n\ts_mov_b32 m0, %2\n\ts_nop 0\n\tglobal_load_lds_dwordx4 %1, off\n\ts_mov_b32 m0, %0":"=&s"(keep):"v"(gsrc),"s"(lds_dst):"memory");}
__device__ __forceinline__ float max3f(float a,float b,float c){float r;asm("v_max3_f32 %0, %1, %2, %3":"=v"(r):"v"(a),"v"(b),"v"(c));return r;}
__device__ __forceinline__ float max2f(float a,float b){float r;asm("v_max_f32_e32 %0, %1, %2":"=v"(r):"v"(a),"v"(b));return r;}
__device__ __forceinline__ float fadd_s(float a,float b){float r;asm("v_add_f32_e32 %0, %1, %2":"=v"(r):"v"(a),"v"(b));return r;}
__device__ __forceinline__ float fsub_s(float a,float b){float r;asm("v_sub_f32_e32 %0, %1, %2":"=v"(r):"v"(a),"v"(b));return r;}
typedef float f32x2_t __attribute__((ext_vector_type(2))); typedef __bf16 bf16x2_t __attribute__((ext_vector_type(2)));
__device__ __forceinline__ unsigned cvtpk_s(float lo,float hi){f32x2_t v={lo,hi};bf16x2_t b=__builtin_convertvector(v,bf16x2_t);return __builtin_bit_cast(unsigned,b);}
#define WAIT_BAR(N) asm volatile("s_waitcnt vmcnt(" #N ") lgkmcnt(0)\n\ts_barrier":::"memory")

__device__ __forceinline__ void qkt(f32x16&p0,f32x16&p1,const char*Kslot,const bf16x8*qr,const f32x16&negm,int r32,int hi){
  const char*kb=Kslot+hi*1024+r32*16;
  #pragma unroll
  for(int d0=0;d0<4;++d0){
    const bf16x8 b0=*reinterpret_cast<const bf16x8*>(kb+d0*2048);
    const bf16x8 b1=*reinterpret_cast<const bf16x8*>(kb+d0*2048+512);
    if(d0==0){p0=__builtin_amdgcn_mfma_f32_32x32x16_bf16(b0,qr[0],negm,0,0,0);p1=__builtin_amdgcn_mfma_f32_32x32x16_bf16(b1,qr[0],negm,0,0,0);}
    else{p0=__builtin_amdgcn_mfma_f32_32x32x16_bf16(b0,qr[d0],p0,0,0,0);p1=__builtin_amdgcn_mfma_f32_32x32x16_bf16(b1,qr[d0],p1,0,0,0);}}
}
typedef __attribute__((address_space(3))) const char* lds_cptr;
typedef short v4i16_t __attribute__((ext_vector_type(4)));
__device__ __forceinline__ void kload8(bf16x8*kf,lds_cptr kp){
  kf[0]=*(const __attribute__((address_space(3))) bf16x8*)(kp);      kf[1]=*(const __attribute__((address_space(3))) bf16x8*)(kp+512);
  kf[2]=*(const __attribute__((address_space(3))) bf16x8*)(kp+2048); kf[3]=*(const __attribute__((address_space(3))) bf16x8*)(kp+2560);
  kf[4]=*(const __attribute__((address_space(3))) bf16x8*)(kp+4096); kf[5]=*(const __attribute__((address_space(3))) bf16x8*)(kp+4608);
  kf[6]=*(const __attribute__((address_space(3))) bf16x8*)(kp+6144); kf[7]=*(const __attribute__((address_space(3))) bf16x8*)(kp+6656);
}
__device__ __forceinline__ void kload2(bf16x8*kf,lds_cptr kp,int j){ kf[2*j]=*(const __attribute__((address_space(3))) bf16x8*)(kp+j*2048); kf[2*j+1]=*(const __attribute__((address_space(3))) bf16x8*)(kp+j*2048+512); }
__device__ __forceinline__ s16x4 vtr(lds_cptr p){ return __builtin_bit_cast(s16x4,__builtin_amdgcn_ds_read_tr16_b64_v4i16((__attribute__((address_space(3))) v4i16_t*)p)); }
__device__ __forceinline__ float rowmax(const f32x16&p0,const f32x16&p1){
  float a=max3f(p0[0],p0[1],p1[0]),b=max3f(p0[2],p0[3],p1[1]);a=max3f(a,p1[2],p1[3]);
  #pragma unroll
  for(int r=4;r<16;r+=4){a=max3f(a,p0[r],p0[r+1]);b=max3f(b,p0[r+2],p0[r+3]);a=max3f(a,p1[r],p1[r+1]);b=max3f(b,p1[r+2],p1[r+3]);}
  const float m=max2f(a,b);
  auto rr=__builtin_amdgcn_permlane32_swap(__float_as_uint(m),__float_as_uint(m),false,false);
  return max2f(__uint_as_float(rr[0]),__uint_as_float(rr[1]));
}
__device__ __forceinline__ void pv(f32x16*o,int vb,bf16x8 pa0,bf16x8 pa1,bf16x8 pa2,bf16x8 pa3){
  #pragma unroll
  for(int d0=0;d0<2;++d0){s16x4 lo[4],hi[4];
    #pragma unroll
    for(int ks=0;ks<4;++ks){
      asm volatile("ds_read_b64_tr_b16 %0,%1 offset:%c2":"=&v"(lo[ks]):"v"(vb),"i"(d0*4096+ks*1024):"memory");
      asm volatile("ds_read_b64_tr_b16 %0,%1 offset:%c2":"=&v"(hi[ks]):"v"(vb),"i"(d0*4096+ks*1024+512):"memory");}
    asm volatile("s_waitcnt lgkmcnt(0)":::"memory");SBAR();
    #define PK(k) (bf16x8){lo[k][0],lo[k][1],lo[k][2],lo[k][3],hi[k][0],hi[k][1],hi[k][2],hi[k][3]}
    o[d0]=__builtin_amdgcn_mfma_f32_32x32x16_bf16(pa0,PK(0),o[d0],0,0,0);
    o[d0]=__builtin_amdgcn_mfma_f32_32x32x16_bf16(pa1,PK(1),o[d0],0,0,0);
    o[d0]=__builtin_amdgcn_mfma_f32_32x32x16_bf16(pa2,PK(2),o[d0],0,0,0);
    o[d0]=__builtin_amdgcn_mfma_f32_32x32x16_bf16(pa3,PK(3),o[d0],0,0,0);
    #undef PK
  }
}

#ifndef ATTN_STORE16
#define ATTN_STORE16(p,v) (*(u32x4*)(p)=(v))
#endif
struct UArgs {
  const bf16* Qb; const bf16* Kh; const bf16* Vh; bf16* Ob;
  int NT, q0, kt0, hc;
  const float* rel;
  const float* km; int qb;
  const unsigned* selg;
  const bf16* gate; int gcol;
  const bf16* tmp;
};
__device__ __forceinline__ int t5b(int d){ if(d<16)return d<0?0:d; int b=16; b+=(d>=19);b+=(d>=21);b+=(d>=24);b+=(d>=27);b+=(d>=31);b+=(d>=35);b+=(d>=40);b+=(d>=46);b+=(d>=52);b+=(d>=59);b+=(d>=67);b+=(d>=77);b+=(d>=87);b+=(d>=99);b+=(d>=113); return b; }
template<int MODE,int EPI,int THRL> __device__ __forceinline__ void attn_unit(const UArgs&U,char*shm){
  int tid_l=threadIdx.x; asm volatile("":"+v"(tid_l));
  const int tid=tid_l,lane=tid&63,r32=lane&31,hi=lane>>5; const int wid=__builtin_amdgcn_readfirstlane(tid>>6);
  const bf16*Qw=U.Qb+(long)(wid*QBLK)*PITCH;
  const bf16*Kh=U.Kh,*Vh=U.Vh;
  const unsigned lds0=(unsigned)(uintptr_t)shm;
  float*wsf=(float*)(shm+LDS_WS)+wid*128;
  const bf16*ksrc=Kh+(long)lane*PITCH+wid*8;
  const bf16*vsrc=Vh+(long)(16*(wid&3)+(lane>>2))*PITCH+(wid>>2)*32+(lane&3)*8;
  const unsigned kdst=lds0+LDS_K+wid*1024, vdst=lds0+LDS_V+wid*1024;
  #define DMA_K(t,slot) glds16(ksrc+(long)(t)*KVBLK*PITCH,(unsigned)__builtin_amdgcn_readfirstlane(kdst+(slot)))
  #define DMA_V(t,slot) glds16(vsrc+(long)(t)*KVBLK*PITCH,(unsigned)__builtin_amdgcn_readfirstlane(vdst+(slot)))
  const int vb0=(int)(lds0+LDS_V)+((lane>>4)&1)*32+(lane&3)*8+(4*hi+((lane&15)>>2))*64;
  const char*Kbase=shm+LDS_K; bf16x8 kf[8];
  const lds_cptr shm3=(lds_cptr)shm; const lds_cptr kp0=shm3+LDS_K+hi*1024+r32*16; const lds_cptr vp0=shm3+LDS_V+((lane>>4)&1)*32+(lane&3)*8+(4*hi+((lane&15)>>2))*64;
  const int NT=U.NT;
  const int qpos=U.q0+wid*QBLK+r32;
  float*biasT=(float*)(shm+LDS_BIAS);
  if(tid<128) biasT[tid]=(U.rel[t5b(tid)*16+U.hc]-U.rel[31*16+U.hc])*LOG2E_;
  unsigned selw=0u,cw=0u; const unsigned*mskp=(const unsigned*)(shm+LDS_MSK)+wid*128+r32*4;
  if(MODE==0){ ((u32x4*)(shm+LDS_KM))[tid]=((const u32x4*)U.km)[tid]; }
  if(MODE==1){ if(hi==0){ const u32x4 w=*(const u32x4*)(U.selg+(long)(wid*QBLK+r32)*4); *(u32x4*)((unsigned*)(shm+LDS_MSK)+wid*128+r32*4)=w; } }
  asm volatile("s_waitcnt vmcnt(0) lgkmcnt(0)\n\ts_barrier":::"memory");
  bf16x8 qr[4];
  #pragma unroll
  for(int d0=0;d0<4;++d0)qr[d0]=*reinterpret_cast<const bf16x8*>(&Qw[(long)r32*PITCH+d0*16+hi*8]);
  if(MODE==0){
    float v1=-INFINITY,v2=-INFINITY,v3=-INFINITY; int i1=-1,i2=-1,i3=-1;
    for(int n=0;n<U.qb;++n){ const float*km=(const float*)(shm+LDS_KM)+n*64+hi*8; float p=0.f;
      #pragma unroll
      for(int d0=0;d0<4;++d0){ const f32x4_ a=*(const f32x4_*)(km+d0*16), c=*(const f32x4_*)(km+d0*16+4);
        p+=bfs(qr[d0][0])*a[0]+bfs(qr[d0][1])*a[1]+bfs(qr[d0][2])*a[2]+bfs(qr[d0][3])*a[3]+bfs(qr[d0][4])*c[0]+bfs(qr[d0][5])*c[1]+bfs(qr[d0][6])*c[2]+bfs(qr[d0][7])*c[3]; }
      auto rr=__builtin_amdgcn_permlane32_swap(__float_as_uint(p),__float_as_uint(p),false,false); const float sc_=__uint_as_float(rr[0])+__uint_as_float(rr[1]);
      if(sc_>v1){v3=v2;i3=i2;v2=v1;i2=i1;v1=sc_;i1=n;} else if(sc_>v2){v3=v2;i3=i2;v2=sc_;i2=n;} else if(sc_>v3){v3=sc_;i3=n;} }
    if(i1>=0)selw|=1u<<i1; if(i2>=0)selw|=1u<<i2; if(i3>=0)selw|=1u<<i3; selw|=1u<<U.qb; }
  DMA_K(0,0);DMA_V(0,0);DMA_K(1,SLOTB);
  float mhat=0.f,l_reg=0.f;f32x16 o[2];o[0]=f32x16{};o[1]=f32x16{};
  #define MASK_FAR(P0,P1,t) do{ bool on_=true; if(MODE==0)on_=((selw>>((t)>>2))&1u)!=0u; if(MODE==1){ if(((t)&31)==0)cw=mskp[(t)>>5]; on_=((cw>>((t)&31))&1u)!=0u; } \
      _Pragma("unroll") for(int r=0;r<16;++r){ P0[r]=on_?P0[r]:-INFINITY; P1[r]=on_?P1[r]:-INFINITY; } }while(0)
  #define MASK_BAND(P0,P1,t) do{ bool on_=true; if(MODE==0)on_=((selw>>((t)>>2))&1u)!=0u; if(MODE==1){ if(((t)&31)==0)cw=mskp[(t)>>5]; on_=((cw>>((t)&31))&1u)!=0u; } \
      const int kb_=U.kt0+64*(t), qw_=U.q0+wid*QBLK; \
      if((qw_-(kb_+63))<128||(MODE==2&&(qw_+31-kb_)>=512)){            \
      const int d0_=qpos-(kb_+4*hi); \
      _Pragma("unroll") for(int r=0;r<16;++r){ const int da_=d0_-((r&3)+8*(r>>2)), db_=da_-32; \
        const bool oka_=on_&&da_>=0&&(MODE!=2||da_<512), okb_=on_&&db_>=0&&(MODE!=2||db_<512); \
        const float ba_=biasT[da_<0?0:(da_>127?127:da_)], bb_=biasT[db_<0?0:(db_>127?127:db_)]; \
        P0[r]=oka_?P0[r]+ba_:-INFINITY; P1[r]=okb_?P1[r]+bb_:-INFINITY; \
        if((r&1)==1){ asm volatile("s_waitcnt lgkmcnt(0)":"+v"(P0),"+v"(P1)::"memory"); } } \
      } else if(MODE!=2){ _Pragma("unroll") for(int r=0;r<16;++r){ P0[r]=on_?P0[r]:-INFINITY; P1[r]=on_?P1[r]:-INFINITY; } } }while(0)
  #define CMASK(P0,P1,t) MASK_BAND(P0,P1,t)
  bool resc=false;
  #define START(P0,P1) do{ const float rm=rowmax(P0,P1); resc=false; \
    { const float dl=rm>-1e30f?rm:0.f; mhat=fadd_s(mhat,dl); \
      _Pragma("unroll") for(int r=0;r<16;++r){P0[r]=fsub_s(P0[r],dl);P1[r]=fsub_s(P1[r],dl);} \
      } \
    _Pragma("unroll") for(int r=0;r<16;++r)P0[r]=__builtin_amdgcn_exp2f(P0[r]); }while(0)
  #define RESC() do{ if(resc){ asm volatile("s_waitcnt lgkmcnt(0)":::"memory"); \
      _Pragma("unroll") for(int d_=0;d_<2;++d_) _Pragma("unroll") for(int r=0;r<16;++r)o[d_][r]*=wsf[crow(r,hi)]; } }while(0)
  f32x16 pA0,pA1,pB0,pB1;
  int sl_prev=0,sl_cur=0,sl_next=SLOTB;
  #define ROT() do{sl_prev=sl_cur;sl_cur=sl_next;sl_next=(sl_next==(NSLOT-1)*SLOTB)?0:sl_next+SLOTB;}while(0)
  DMA_K(2,2*SLOTB);
  WAIT_BAR(3);
  { f32x16 z0_=f32x16{}; asm volatile("":"+v"(z0_)); qkt(pA0,pA1,Kbase,qr,z0_,r32,hi); }asm volatile("s_nop 15\n\ts_nop 7":"+v"(pA0),"+v"(pA1));CMASK(pA0,pA1,0);
  START(pA0,pA1);
  _Pragma("unroll") for(int r=0;r<16;++r)pA1[r]=__builtin_amdgcn_exp2f(pA1[r]);
  WAIT_BAR(0);
  DMA_K(3,0);DMA_V(1,SLOTB);
  ROT();
  kload8(kf,kp0+sl_cur);
  WAIT_BAR(2);
  s16x4 vlo[8],vhi[8]; u32x4 pw0,pw1,pw2,pw3;
  #define PKW(P,B) cvtpk_s(P[B],P[B+1])
  #define PAF(k) __builtin_bit_cast(bf16x8,pw##k)
  #define VFR(i) (bf16x8){vlo[i][0],vlo[i][1],vlo[i][2],vlo[i][3],vhi[i][0],vhi[i][1],vhi[i][2],vhi[i][3]}
  #define PIN(x) asm volatile("":"+v"(x))
  #define MX3(a,b,c) __builtin_fmaxf(__builtin_fmaxf((a),(b)),(c))
  #define GAPA(MF,A0,A1,A2,A3,W0,W1,PW) do{ MF; sacc+=A0; sacc+=A1; sacc+=A2; sacc+=A3; PIN(sacc); W0; W1; PIN(PW); SBAR(); }while(0)
  #define EX(v) __builtin_amdgcn_exp2f(v)
  #define GAPB(MF,X,B) do{ MF; X[B]=EX(X[B]); X[B+1]=EX(X[B+1]); X[B+2]=EX(X[B+2]); X[B+3]=EX(X[B+3]); PIN(X); SBAR(); }while(0)
  #define VRD(i) do{ vlo[i]=vtr(vp_+(((i)>>2)*4096+((i)&3)*1024)); vhi[i]=vtr(vp_+(((i)>>2)*4096+((i)&3)*1024+512)); }while(0)
  #define KRD(G,j) do{ if(G){ kload2(kf,kp0+sl_next,j); SBAR(); } }while(0)
  #define STEP(C0,C1,P0,P1,t,GK,GV,GL) do{ SBAR(); \
    f32x16 negx; NEGC(negx,t); \
    const lds_cptr vp_=vp0+sl_prev; \
    VRD(0); SBAR(); float sacc=(P0[0]+P0[1]); \
    GAPA(C0=__builtin_amdgcn_mfma_f32_32x32x16_bf16(kf[0],qr[0],negx,0,0,0), P0[2],P0[3],P0[4],P0[5],     pw0[0]=PKW(P0,0), pw0[1]=PKW(P0,2), pw0); \
    VRD(4); SBAR(); GAPA(C1=__builtin_amdgcn_mfma_f32_32x32x16_bf16(kf[1],qr[0],negx,0,0,0), P0[6],P0[7],P0[8],P0[9],     pw0[2]=PKW(P0,4), pw0[3]=PKW(P0,6), pw0); \
    VRD(1); SBAR(); GAPA(C0=__builtin_amdgcn_mfma_f32_32x32x16_bf16(kf[2],qr[1],C0,0,0,0),   P0[10],P0[11],P0[12],P0[13], pw1[0]=PKW(P0,8), pw1[1]=PKW(P0,10), pw1); \
    VRD(5); SBAR(); GAPA(C1=__builtin_amdgcn_mfma_f32_32x32x16_bf16(kf[3],qr[1],C1,0,0,0),   P0[14],P0[15],P1[0],P1[1],   pw1[2]=PKW(P0,12),pw1[3]=PKW(P0,14), pw1); \
    VRD(2); SBAR(); GAPA(C0=__builtin_amdgcn_mfma_f32_32x32x16_bf16(kf[4],qr[2],C0,0,0,0),   P1[2],P1[3],P1[4],P1[5],     pw2[0]=PKW(P1,0), pw2[1]=PKW(P1,2), pw2); \
    VRD(6); SBAR(); GAPA(C1=__builtin_amdgcn_mfma_f32_32x32x16_bf16(kf[5],qr[2],C1,0,0,0),   P1[6],P1[7],P1[8],P1[9],     pw2[2]=PKW(P1,4), pw2[3]=PKW(P1,6), pw2); \
    VRD(3); SBAR(); GAPA(C0=__builtin_amdgcn_mfma_f32_32x32x16_bf16(kf[6],qr[3],C0,0,0,0),   P1[10],P1[11],P1[12],P1[13], pw3[0]=PKW(P1,8), pw3[1]=PKW(P1,10), pw3); \
    VRD(7); SBAR(); GAPA(C1=__builtin_amdgcn_mfma_f32_32x32x16_bf16(kf[7],qr[3],C1,0,0,0),   P1[14],P1[15],0.f,0.f,       pw3[2]=PKW(P1,12),pw3[3]=PKW(P1,14), pw3); \
    l_reg+=sacc; \
    if(GK){DMA_K((t)+3,sl_cur);} if(GV){DMA_V((t)+1,sl_next);} \
    CMASK(C0,C1,t); \
    { float a=MX3(C0[0],C0[1],C1[0]),b=MX3(C0[2],C0[3],C1[1]); a=MX3(a,C1[2],C1[3]); \
      _Pragma("unroll") for(int r=4;r<16;r+=4){a=MX3(a,C0[r],C0[r+1]);b=MX3(b,C0[r+2],C0[r+3]);a=MX3(a,C1[r],C1[r+1]);b=MX3(b,C1[r+2],C1[r+3]);} \
      float rm=__builtin_fmaxf(a,b); { auto rr=__builtin_amdgcn_permlane32_swap(__float_as_uint(rm),__float_as_uint(rm),false,false); rm=__builtin_fmaxf(__uint_as_float(rr[0]),__uint_as_float(rr[1])); } \
      resc=false; \
      if(__builtin_expect(__any(rm>(float)THRL),0)){ const float dl=__builtin_fmaxf(rm,0.f); mhat+=dl; \
        _Pragma("unroll") for(int r=0;r<16;++r){C0[r]-=dl;C1[r]-=dl;} \
        const float f=__builtin_amdgcn_exp2f(-dl); l_reg*=f; if(hi==0)wsf[r32]=f; resc=true; } } \
    SBAR(); \
    GAPB(o[0]=__builtin_amdgcn_mfma_f32_32x32x16_bf16(PAF(0),VFR(0),o[0],0,0,0), C0,0); \
    GAPB(o[1]=__builtin_amdgcn_mfma_f32_32x32x16_bf16(PAF(0),VFR(4),o[1],0,0,0), C0,4); \
    KRD(GL,0); GAPB(o[0]=__builtin_amdgcn_mfma_f32_32x32x16_bf16(PAF(1),VFR(1),o[0],0,0,0), C0,8); \
    KRD(GL,1); GAPB(o[1]=__builtin_amdgcn_mfma_f32_32x32x16_bf16(PAF(1),VFR(5),o[1],0,0,0), C0,12); \
    KRD(GL,2); GAPB(o[0]=__builtin_amdgcn_mfma_f32_32x32x16_bf16(PAF(2),VFR(2),o[0],0,0,0), C1,0); \
    KRD(GL,3); GAPB(o[1]=__builtin_amdgcn_mfma_f32_32x32x16_bf16(PAF(2),VFR(6),o[1],0,0,0), C1,4); \
    GAPB(o[0]=__builtin_amdgcn_mfma_f32_32x32x16_bf16(PAF(3),VFR(3),o[0],0,0,0), C1,8); \
    GAPB(o[1]=__builtin_amdgcn_mfma_f32_32x32x16_bf16(PAF(3),VFR(7),o[1],0,0,0), C1,12); \
    }while(0)
  int t=1;
  #undef CMASK
  #define CMASK(P0,P1,t) do{}while(0)
  #define NEGC(X,t) do{ bool on_=true; if(MODE==0)on_=((selw>>((t)>>2))&1u)!=0u; if(MODE==1){ if(((t)&31)==0)cw=mskp[(t)>>5]; on_=((cw>>((t)&31))&1u)!=0u; } \
      const float nm_=-mhat; _Pragma("unroll") for(int r=0;r<16;++r)X[r]=on_?nm_:-INFINITY; asm volatile("":"+v"(X)); }while(0)
  for(;MODE!=2&&t+7<NT;t+=2){
    STEP(pB0,pB1,pA0,pA1,t,true,true,true);     WAIT_BAR(2); RESC(); ROT();
    STEP(pA0,pA1,pB0,pB1,t+1,true,true,true);   WAIT_BAR(2); RESC(); ROT();
  }
  #undef CMASK
  #define CMASK(P0,P1,t) MASK_BAND(P0,P1,t)
  #undef NEGC
  #define NEGC(X,t) do{ const float nm_=-mhat; _Pragma("unroll") for(int r=0;r<16;++r)X[r]=nm_; asm volatile("":"+v"(X)); }while(0)
  #define ENDW(tt) do{ if((tt)+3<NT){WAIT_BAR(2);} else if((tt)+2<NT){WAIT_BAR(1);} else {WAIT_BAR(0);} }while(0)
  for(;t+1<NT;t+=2){
    STEP(pB0,pB1,pA0,pA1,t,(t+3<NT),(t+1<NT),(t+1<NT));       ENDW(t);   RESC(); ROT();
    STEP(pA0,pA1,pB0,pB1,t+1,(t+4<NT),(t+2<NT),(t+2<NT));     ENDW(t+1); RESC(); ROT();
  }
  STEP(pB0,pB1,pA0,pA1,NT-1,false,false,false); RESC();
  { float sacc=pB0[0]+pB0[1]; _Pragma("unroll") for(int r=2;r<16;++r)sacc+=pB0[r]; _Pragma("unroll") for(int r=0;r<16;++r)sacc+=pB1[r]; l_reg+=sacc;
    pw0=(u32x4){PKW(pB0,0),PKW(pB0,2),PKW(pB0,4),PKW(pB0,6)};pw1=(u32x4){PKW(pB0,8),PKW(pB0,10),PKW(pB0,12),PKW(pB0,14)};pw2=(u32x4){PKW(pB1,0),PKW(pB1,2),PKW(pB1,4),PKW(pB1,6)};pw3=(u32x4){PKW(pB1,8),PKW(pB1,10),PKW(pB1,12),PKW(pB1,14)};
    SBAR(); pv(o,vb0+sl_cur,PAF(0),PAF(1),PAF(2),PAF(3)); }
  #undef PKW
  #undef PAF
  #undef VFR
  #undef PIN
  #undef MX3
  #undef GAPA
  #undef GAPB
  #undef EX
  #undef VRD
  #undef KRD
  #undef STEP
  #undef NEGC
  #undef ENDW
  {auto rr=__builtin_amdgcn_permlane32_swap(__float_as_uint(l_reg),__float_as_uint(l_reg),false,false);l_reg=__uint_as_float(rr[0])+__uint_as_float(rr[1]);}
  int lane_e=lane; asm volatile("":"+v"(lane_e)); const int r32e=lane_e&31, hie=lane_e>>5;
  float*wsfe=(float*)(shm+LDS_WS)+wid*128;
  if(hie==0){ wsfe[32+r32e]=l_reg; if(EPI!=0){ const float gl=bfs((short)U.gate[(long)(wid*QBLK+r32e)*PITCH+U.gcol]); wsfe[64+r32e]=1.f/(1.f+__expf(-gl)); } }
  asm volatile("s_waitcnt lgkmcnt(0)":::"memory");
  float rli[16];
  #pragma unroll
  for(int r=0;r<16;++r){ rli[r]=__builtin_amdgcn_rcpf(fmaxf(wsfe[32+crow(r,hie)],1e-30f)); if(EPI!=0)rli[r]*=wsfe[64+crow(r,hie)]; }
  bf16*Ow=U.Ob+(long)(wid*QBLK)*PITCH;
  { bf16*stg=(bf16*)(shm+LDS_OST)+wid*2048;
    #pragma unroll
    for(int r=0;r<16;++r){const int orow=crow(r,hie);
      #pragma unroll
      for(int d0=0;d0<2;++d0){ float v=o[d0][r]*rli[r]; if(EPI==2)v+=bfs((short)stg[orow*64+d0*32+r32e]); stg[orow*64+d0*32+r32e]=f2b(v);} }
    asm volatile("s_waitcnt lgkmcnt(0)":::"memory");
    if(EPI!=1){
    #pragma unroll
    for(int i=0;i<4;++i){const int row=i*8+(lane_e>>3),ch=lane_e&7; u32x4 v=*(const u32x4*)(stg+row*64+ch*8);
      if(EPI==2){ const u32x4 t=*(const u32x4*)(U.tmp+(long)(wid*QBLK+row)*512+ch*8);
        v.x=pk2b(lo16(v.x)+lo16(t.x),hi16(v.x)+hi16(t.x)); v.y=pk2b(lo16(v.y)+lo16(t.y),hi16(v.y)+hi16(t.y)); v.z=pk2b(lo16(v.z)+lo16(t.z),hi16(v.z)+hi16(t.z)); v.w=pk2b(lo16(v.w)+lo16(t.w),hi16(v.w)+hi16(t.w)); }
      ATTN_STORE16(Ow+(long)row*PITCH+ch*8,v);} } }
  asm volatile("s_waitcnt lgkmcnt(0)\n\ts_barrier":::"memory");
  #undef DMA_K
  #undef DMA_V
  #undef CMASK
  #undef START
  #undef RESC
  #undef ROT
}
constexpr int ATTN_LDS_BYTES=LDS_BYTES;
#undef SBAR
#undef WAIT_BAR
}

constexpr int NWAVES = 8;
constexpr int B_ = 4, S_ = 8192, DM = 1024, M_ = B_ * S_, DIN = 7464, FF = 2816, NL = 2;
constexpr int YP = pg8::YP_;
constexpr float C2 = pg8::C2_, LOG2E = 1.4426950408889634f;
constexpr float NORM_EPS = 1e-6f;
constexpr int Y_AQ = 0, Y_AKC = 512, Y_AVC = 640, Y_AKS = 768, Y_AVS = 896, Y_AKW = 1024, Y_AVW = 1152, Y_CQ = 1280, Y_CK = 1792, Y_CV = 2304,
              Y_BQ = 2816, Y_BK = 3072, Y_BV = 3328, Y_BR = 3840, Y_AG = 4352, Y_BLR = 4376;
constexpr int NIN = 7680;
constexpr size_t MiB = 1u << 20;
constexpr size_t WS_CTL = 0, CTL_ZERO_BYTES = 1 * MiB;
constexpr size_t WS_WIN = 1 * MiB, WS_WA = 16 * MiB, WS_WB = 17 * MiB, WS_WC = 18 * MiB, WS_WO = 19 * MiB, WS_WF1 = 21 * MiB, WS_WF2 = 32 * MiB;
constexpr size_t WS_H = 40 * MiB;
constexpr size_t WS_Y = 104 * MiB;
constexpr size_t WS_G8 = 379 * MiB;
constexpr size_t WS_ACT = WS_Y + 128 * MiB;
constexpr size_t WS_SM = 475 * MiB;
constexpr size_t WS_KCMP = WS_SM, WS_VCMP = WS_SM + 1 * MiB, WS_KMEAN = WS_SM + 2 * MiB;
constexpr size_t WS_GA = WS_SM + 3 * MiB;
constexpr size_t WS_MASK = 38 * MiB;
constexpr size_t WS_OATMP = WS_H;
constexpr size_t WS_O16 = WS_H + 32 * MiB;
constexpr size_t WS_VCMPT = WS_VCMP + 512 * 1024;
constexpr size_t WS_CW1T = 39 * MiB;
constexpr size_t WS_CW2T = WS_CW1T + 512 * 1024;
constexpr size_t WS_CC0 = WS_CW2T + 16 * 1024;
constexpr size_t WS_GST = WS_H + 32 * MiB;
constexpr size_t WS_GDEC = WS_SM + 3 * MiB;
constexpr size_t WS_BCUM = WS_SM + 4 * MiB;
constexpr size_t WS_END = 512 * MiB;
static_assert(WS_BCUM + (size_t)M_ * 256 * 4 <= WS_END, "ws map 3");
static_assert(WS_GA + (size_t)M_ * 256 * 4 <= WS_END && WS_Y + (size_t)M_ * YP * 2 <= WS_G8 && WS_G8 + (size_t)M_ * 3072 <= WS_SM, "ws map");
static_assert(WS_ACT + (size_t)M_ * FF * 2 <= WS_SM && WS_WF2 + (size_t)DM * FF * 2 <= WS_H, "ws map 2");
constexpr int CW_BAR = 4096;
constexpr int RING_OFF = 0, RING_BYTES = 131072;
constexpr int LDSCTL_OFF = RING_BYTES, MISC_OFF = LDSCTL_OFF + 320;
constexpr int LDS_BYTES = 147456;

#define GAS __attribute__((address_space(1)))
#define LAS __attribute__((address_space(3)))
typedef unsigned short bf16;
typedef unsigned v4u __attribute__((ext_vector_type(4)));
typedef float f32x4 __attribute__((ext_vector_type(4)));
typedef short bf16x8 __attribute__((ext_vector_type(8)));
typedef GAS unsigned gu32;
typedef GAS unsigned long long gu64;
#define RLX_AGENT __ATOMIC_RELAXED, __HIP_MEMORY_SCOPE_AGENT
#define LDS_WAIT() asm volatile("s_waitcnt lgkmcnt(0)" ::: "memory")
#define VM_WAIT() asm volatile("s_waitcnt vmcnt(0)" ::: "memory")
__device__ __forceinline__ unsigned long long rt() { return __builtin_amdgcn_s_memrealtime(); }
__device__ __forceinline__ unsigned f2bf(float f) { unsigned u = __builtin_bit_cast(unsigned, f); return (u + 0x7fffu + ((u >> 16) & 1u)) >> 16; }
__device__ __forceinline__ unsigned pk2(float lo, float hi) { return f2bf(lo) | (f2bf(hi) << 16); }

__device__ __forceinline__ float bf2f(bf16 h) { return __uint_as_float((unsigned)h << 16); }
__device__ __forceinline__ float sigm(float v) { return 1.f / (1.f + __expf(-v)); }
#define WFENCE() asm volatile("s_waitcnt lgkmcnt(0)" ::: "memory")

#define XB_TMO      128
#define XB_XCNT(j)  (256  + 64 * (j))
#define XB_XSUB(j)  (1280 + 64 * (j))
#define XB_XGEN(j)  (2304 + 64 * (j))
#define XB_TOP      3328
#define XB_TOPGEN   3392
#define XCD_BAR_WORDS 3456
#define XB_SPIN_CAP (1u << 18)

__device__ __forceinline__ unsigned xb_ld(unsigned* p)              { return __hip_atomic_load(p, __ATOMIC_RELAXED, __HIP_MEMORY_SCOPE_AGENT); }
__device__ __forceinline__ unsigned xb_add(unsigned* p, unsigned v) { return __hip_atomic_fetch_add(p, v, __ATOMIC_RELAXED, __HIP_MEMORY_SCOPE_AGENT); }
__device__ __forceinline__ unsigned xb_xcc_id() { return (unsigned)__builtin_amdgcn_s_getreg((3 << 11) | 20) & 0xFu; }
#define XB_SPIN(cond, bar) do { unsigned _sp = 0; while (cond) { __builtin_amdgcn_s_sleep(1); \
    if ((++_sp & 255u) == 0u) { if (xb_ld(&(bar)[XB_TMO])) break; if (_sp > XB_SPIN_CAP) { atomicAdd(&(bar)[XB_TMO], 1u); break; } } } } while (0)

struct XcdBarrier {
    unsigned* bar; unsigned x;
    volatile LAS unsigned* st;
};

__device__ __forceinline__ XcdBarrier xcd_barrier_post(unsigned* bar, volatile LAS unsigned* st) {
    XcdBarrier b; b.bar = bar; b.x = xb_xcc_id(); b.st = st;
    if (threadIdx.x == 0) (void)xb_add(&bar[XB_XCNT(b.x)], 1u);
    return b;
}
__device__ __forceinline__ void xcd_barrier_complete(unsigned* bar, unsigned x, unsigned& nloc, unsigned& nx) {
    const unsigned G = gridDim.x * gridDim.y * gridDim.z;
    unsigned sum, cnt, mine, sp = 0u;
    for (;;) {
        sum = 0u; cnt = 0u; mine = 0u;
#pragma unroll
        for (unsigned j = 0; j < 16; ++j) { const unsigned c = xb_ld(&bar[XB_XCNT(j)]); sum += c; cnt += (c > 0u) ? 1u : 0u; mine = (j == x) ? c : mine; }
        if (sum == G) break;
        __builtin_amdgcn_s_sleep(1);
        if ((++sp & 255u) == 0u) { if (xb_ld(&bar[XB_TMO])) break; if (sp > XB_SPIN_CAP) { atomicAdd(&bar[XB_TMO], 1u); break; } }
    }
    nloc = mine > 0u ? mine : 1u; nx = cnt > 0u ? cnt : 1u;
}

__device__ __forceinline__ void xcd_barrier(const XcdBarrier& b) {
    asm volatile("s_waitcnt vmcnt(0)" ::: "memory");
    __syncthreads();
    if (threadIdx.x == 0) {
        unsigned* bar = b.bar;
        __builtin_amdgcn_s_waitcnt(0);
        unsigned nloc = b.st[0], nx = b.st[1];
        if (nloc == 0u) { xcd_barrier_complete(bar, b.x, nloc, nx); b.st[0] = nloc; b.st[1] = nx; }
        const unsigned old = xb_add(&bar[XB_XSUB(b.x)], 1u);
        const unsigned gen = old / nloc;
        if (old + 1u == (gen + 1u) * nloc) {
            __builtin_amdgcn_fence(__ATOMIC_RELEASE, "agent");
            asm volatile("s_waitcnt vmcnt(0)" ::: "memory");
            const unsigned og = xb_add(&bar[XB_TOP], 1u);
            const unsigned tg = og / nx;
            if (og + 1u == (tg + 1u) * nx) xb_add(&bar[XB_TOPGEN], 1u);
            else XB_SPIN(xb_ld(&bar[XB_TOPGEN]) == tg, bar);
            __builtin_amdgcn_fence(__ATOMIC_ACQUIRE, "agent");
            xb_add(&bar[XB_XGEN(b.x)], 1u);
            asm volatile("s_waitcnt vmcnt(0)" ::: "memory");
        } else {
            XB_SPIN(xb_ld(&bar[XB_XGEN(b.x)]) == gen, bar);
            __builtin_amdgcn_fence(__ATOMIC_ACQUIRE, "agent");
            asm volatile("s_waitcnt vmcnt(0)" ::: "memory");
        }
    }
    __syncthreads();
}


struct Frame {
    LAS unsigned char* lds;
    volatile LAS unsigned* MISC;
    gu32* ctl;
    int tid, lane, wave, G;
};
__device__ __forceinline__ float wave_sum(float v) {
#pragma unroll
    for (int o = 1; o < 64; o <<= 1) v += __shfl_xor(v, o);
    return v;
}
__device__ __forceinline__ float wave_max(float v) {
#pragma unroll
    for (int o = 1; o < 64; o <<= 1) v = fmaxf(v, __shfl_xor(v, o));
    return v;
}
__device__ __forceinline__ int t5_bucket(int d) {
    if (d < 16) return d < 0 ? 0 : d;
    int b = 16;
    b += (d >= 19); b += (d >= 21); b += (d >= 24); b += (d >= 27); b += (d >= 31); b += (d >= 35); b += (d >= 40); b += (d >= 46);
    b += (d >= 52); b += (d >= 59); b += (d >= 67); b += (d >= 77); b += (d >= 87); b += (d >= 99); b += (d >= 113);
    return b;
}
template <class CM> __device__ __forceinline__ void tr_item(const float* W, int Nsrc, int K, bf16* WT, int item, int nblk, CM cm, LAS float* scr, int lane) {
    const int kb = item / nblk, nb = item % nblk, k0 = 64 * kb, n0 = 32 * nb;
    const int sc = cm(n0 + (lane & 31));
    float tv[32];
#pragma unroll
    for (int i = 0; i < 32; ++i) { const int kk = 2 * i + (lane >> 5); tv[i] = sc >= 0 ? W[(size_t)(k0 + kk) * Nsrc + sc] : 0.f; }
#pragma unroll
    for (int i = 0; i < 32; ++i) { const int kk = 2 * i + (lane >> 5); scr[kk * 33 + (lane & 31)] = tv[i]; }
    LDS_WAIT(); asm volatile("" ::: "memory");
    const int c = lane & 7;
#pragma unroll
    for (int j = 0; j < 4; ++j) { const int n = (lane >> 3) + 8 * j; const LAS float* s = scr + (8 * c) * 33 + n;
        v4u o; o.x = pk2(s[0 * 33], s[1 * 33]); o.y = pk2(s[2 * 33], s[3 * 33]); o.z = pk2(s[4 * 33], s[5 * 33]); o.w = pk2(s[6 * 33], s[7 * 33]);
        *(GAS v4u*)(WT + (size_t)(n0 + n) * K + k0 + 8 * c) = o; }
    LDS_WAIT(); asm volatile("" ::: "memory");
}
struct CmId { __device__ __forceinline__ int operator()(int n) const { return n; } };
struct CmWin { __device__ __forceinline__ int operator()(int n) const {
    if (n < 1280) return n;
    if (n < 2816) return n - 1280 + 2856;
    if (n < 4352) return n - 2816 + 1304;
    if (n < 4376) return n - 4352 + 1280;
    if (n < 4392) return n - 4376 + 2840;
    if (n < 4608) return -1;
    return n - 4608 + 4392; } };
struct CmFfn { __device__ __forceinline__ int operator()(int c) const { const int p = c >> 8, r = c & 255; return r < 128 ? 128 * p + r : FF + 128 * p + (r - 128); } };

struct Args { const float* in[22]; float* out; unsigned char* ws; int ph_lo, ph_hi; };

__device__ __forceinline__ void phase_weights(Frame& F, const Args& a, int l) {
    LAS float* scr = (LAS float*)(F.lds + RING_OFF + F.wave * 16384);
    const int gw = blockIdx.x * NWAVES + F.wave, NGW = F.G * NWAVES;
    unsigned char* ws = a.ws;
    constexpr int I_IN = 16 * (NIN / 32), I_BR = 8 * 32, I_O = 16 * 32, I_F1 = 16 * (2 * FF / 32), I_F2 = (FF / 64) * 32;
    constexpr int NIT = I_IN + 3 * I_BR + I_O + I_F1 + I_F2;
    for (int it = gw; it < NIT; it += NGW) {
        int r = it;
        if (r < I_IN) { tr_item(a.in[6] + (size_t)l * DM * DIN, DIN, DM, (bf16*)(ws + WS_WIN), r, NIN / 32, CmWin(), scr, F.lane); continue; } r -= I_IN;
        if (r < I_BR) { tr_item(a.in[16] + (size_t)l * 512 * DM, DM, 512, (bf16*)(ws + WS_WA), r, 32, CmId(), scr, F.lane); continue; } r -= I_BR;
        if (r < I_BR) { tr_item(a.in[17] + (size_t)l * 512 * DM, DM, 512, (bf16*)(ws + WS_WB), r, 32, CmId(), scr, F.lane); continue; } r -= I_BR;
        if (r < I_BR) { tr_item(a.in[18] + (size_t)l * 512 * DM, DM, 512, (bf16*)(ws + WS_WC), r, 32, CmId(), scr, F.lane); continue; } r -= I_BR;
        if (r < I_O) { tr_item(a.in[19] + (size_t)l * DM * DM, DM, DM, (bf16*)(ws + WS_WO), r, 32, CmId(), scr, F.lane); continue; } r -= I_O;
        if (r < I_F1) { tr_item(a.in[20] + (size_t)l * DM * 2 * FF, 2 * FF, DM, (bf16*)(ws + WS_WF1), r, 2 * FF / 32, CmFfn(), scr, F.lane); continue; } r -= I_F1;
        tr_item(a.in[21] + (size_t)l * FF * DM, DM, FF, (bf16*)(ws + WS_WF2), r, 32, CmId(), scr, F.lane);
    }
    for (int it = gw; it < 2 * 66 + 2; it += NGW) {
        if (it < 132) { const int kv = it / 66, r = it % 66;
            if (r < 64) tr_item(a.in[kv ? 11 : 9] + (size_t)l * 2048 * 64, 64, 2048, (bf16*)(ws + WS_CW1T) + (size_t)kv * 64 * 2048, r, 2, CmId(), scr, F.lane);
            else tr_item(a.in[kv ? 12 : 10] + (size_t)l * 64 * 64, 64, 64, (bf16*)(ws + WS_CW2T) + (size_t)kv * 64 * 64, r - 64, 2, CmId(), scr, F.lane); }
        else { const int kv = it - 132; const float* pe = a.in[kv ? 8 : 7] + (size_t)l * 2048; const float* w1 = a.in[kv ? 11 : 9] + (size_t)l * 2048 * 64; float acc = 0.f;
            for (int k = 0; k < 2048; ++k) acc += pe[k] * w1[(size_t)k * 64 + F.lane];
            ((float*)(ws + WS_CC0))[kv * 64 + F.lane] = acc; }
    }
}
__device__ __forceinline__ void phase_norm0(Frame& F, const float* x, const float* w, bf16* H) {
    const int gw = blockIdx.x * NWAVES + F.wave, NGW = F.G * NWAVES;
    for (int m = gw; m < M_; m += NGW) {
        const f32x4* xr = (const f32x4*)(x + (size_t)m * DM) + F.lane; f32x4 v[4]; float s = 0.f;
#pragma unroll
        for (int j = 0; j < 4; ++j) { v[j] = xr[64 * j]; s += v[j].x * v[j].x + v[j].y * v[j].y + v[j].z * v[j].z + v[j].w * v[j].w; }
        const float r = rsqrtf(wave_sum(s) * (1.f / DM) + NORM_EPS);
        unsigned long long* o8 = (unsigned long long*)(H + (size_t)m * DM) + F.lane;
#pragma unroll
        for (int j = 0; j < 4; ++j) { const f32x4 wv = ((const f32x4*)w)[F.lane + 64 * j];
            o8[64 * j] = (unsigned long long)pk2(v[j].x * r * wv.x, v[j].y * r * wv.y) | ((unsigned long long)pk2(v[j].z * r * wv.z, v[j].w * r * wv.w) << 32); }
    }
}
__device__ __forceinline__ void phase_resid(Frame& F, const float* y_, const float* xin, float* xout, const float* wpost, const float* wpre, bf16* hout) {
    const int gw = blockIdx.x * NWAVES + F.wave, NGW = F.G * NWAVES; const bf16* y = (const bf16*)y_;
    for (int m = gw; m < M_; m += NGW) {
        typedef unsigned u32x2r __attribute__((ext_vector_type(2)));
        const u32x2r* yr = (const u32x2r*)(y + (size_t)m * DM) + F.lane; const f32x4* xr = (const f32x4*)(xin + (size_t)m * DM) + F.lane;
        f32x4 v[4], xv[4]; float s = 0.f;
#pragma unroll
        for (int j = 0; j < 4; ++j) { const u32x2r yw = yr[64 * j]; v[j].x = __uint_as_float(yw.x << 16); v[j].y = __uint_as_float(yw.x & 0xffff0000u); v[j].z = __uint_as_float(yw.y << 16); v[j].w = __uint_as_float(yw.y & 0xffff0000u);
            xv[j] = xr[64 * j]; s += v[j].x * v[j].x + v[j].y * v[j].y + v[j].z * v[j].z + v[j].w * v[j].w; }
        const float r = rsqrtf(wave_sum(s) * (1.f / DM) + NORM_EPS); float s2 = 0.f;
        f32x4* xo = (f32x4*)(xout + (size_t)m * DM) + F.lane;
#pragma unroll
        for (int j = 0; j < 4; ++j) { const f32x4 wv = ((const f32x4*)wpost)[F.lane + 64 * j]; f32x4 n;
            n.x = xv[j].x + v[j].x * r * wv.x; n.y = xv[j].y + v[j].y * r * wv.y; n.z = xv[j].z + v[j].z * r * wv.z; n.w = xv[j].w + v[j].w * r * wv.w;
            xo[64 * j] = n; v[j] = n; s2 += n.x * n.x + n.y * n.y + n.z * n.z + n.w * n.w; }
        if (hout) { const float r2 = rsqrtf(wave_sum(s2) * (1.f / DM) + NORM_EPS);
            unsigned long long* o8 = (unsigned long long*)(hout + (size_t)m * DM) + F.lane;
#pragma unroll
            for (int j = 0; j < 4; ++j) { const f32x4 wv = ((const f32x4*)wpre)[F.lane + 64 * j];
                o8[64 * j] = (unsigned long long)pk2(v[j].x * r2 * wv.x, v[j].y * r2 * wv.y) | ((unsigned long long)pk2(v[j].z * r2 * wv.z, v[j].w * r2 * wv.w) << 32); } }
    }
}
__device__ __forceinline__ void unpack8(const v4u w, float (&k)[8]) {
    k[0] = __uint_as_float(w.x << 16); k[1] = __uint_as_float(w.x & 0xffff0000u); k[2] = __uint_as_float(w.y << 16); k[3] = __uint_as_float(w.y & 0xffff0000u);
    k[4] = __uint_as_float(w.z << 16); k[5] = __uint_as_float(w.z & 0xffff0000u); k[6] = __uint_as_float(w.w << 16); k[7] = __uint_as_float(w.w & 0xffff0000u);
}
__device__ __forceinline__ void dot4(const LAS float* qs, const bf16* kr, float (&d)[4]) {
    d[0] = d[1] = d[2] = d[3] = 0.f;
#pragma unroll 1
    for (int c = 0; c < 8; ++c) { asm volatile("" ::: "memory"); const v4u w = ((const v4u*)kr)[c]; float k[8]; unpack8(w, k);
#pragma unroll
        for (int e = 0; e < 8; ++e) { const int dd = c * 8 + e;
#pragma unroll
            for (int h = 0; h < 4; ++h) d[h] += qs[h * 64 + dd] * k[e]; } }
}
__device__ __forceinline__ float dot1(const LAS float* qs, const bf16* kr) {
    float d = 0.f;
#pragma unroll
    for (int c = 0; c < 8; ++c) { const v4u w = ((const v4u*)kr)[c]; float k[8]; unpack8(w, k);
#pragma unroll
        for (int e = 0; e < 8; ++e) d += qs[c * 8 + e] * k[e]; }
    return d;
}
__device__ __forceinline__ float gelu_tanh(float x) { const float u = 0.7978845608028654f * (x + 0.044715f * x * x * x); return 0.5f * x * (1.f + tanhf(u)); }

__device__ __forceinline__ void phase2_naive(Frame& F, const Args& a, int l) {
    const int gw = blockIdx.x * NWAVES + F.wave, NGW = F.G * NWAVES, lane = F.lane;
    const bf16* Y = (const bf16*)(a.ws + WS_Y);
    LAS float* scr = (LAS float*)(F.lds + RING_OFF + F.wave * 16384);
    for (int t = gw; t < 4 * 8 * 32; t += NGW) {
        const int blk = t & 31, h = (t >> 5) & 7, b = t >> 8;
        const bf16* src = Y + ((size_t)b * S_ + blk * 256) * YP + Y_CK + h * 64 + lane; float s = 0.f;
        for (int i = 0; i < 256; ++i) s += bf2f(src[(size_t)i * YP]);
        ((float*)(a.ws + WS_KMEAN))[(size_t)t * 64 + lane] = s * (1.f / 256.f);
    }
}
__device__ __forceinline__ void gla_scan_naive(Frame& F, const Args& a) {
    const bf16* Y = (const bf16*)(a.ws + WS_Y); const float* GA = (const float*)(a.ws + WS_GA); bf16* O16 = (bf16*)(a.ws + WS_O16);
    const int lane = F.lane;
    for (int task = blockIdx.x; task < 256; task += F.G) {
        const int eg = task & 15, h = (task >> 4) & 3, b = task >> 6, e = eg * 8 + F.wave;
        float Sst = 0.f;
        for (int t0 = 0; t0 < S_; t0 += 8) {
            float av[8], kv[8], qv[8], vv[8];
#pragma unroll
            for (int j = 0; j < 8; ++j) { const size_t row = (size_t)b * S_ + t0 + j;
                av[j] = GA[row * 256 + h * 64 + lane]; kv[j] = bf2f(Y[row * YP + Y_BK + h * 64 + lane]); qv[j] = bf2f(Y[row * YP + Y_BQ + h * 64 + lane]); vv[j] = bf2f(Y[row * YP + Y_BV + h * 128 + e]); }
#pragma unroll
            for (int j = 0; j < 8; ++j) { Sst = av[j] * Sst + kv[j] * vv[j]; const float o = wave_sum(qv[j] * Sst);
                if (lane == 0) O16[((size_t)b * S_ + t0 + j) * 512 + h * 128 + e] = (bf16)f2bf(o); }
        }
    }
}
__device__ __forceinline__ void nsa_cmp_naive(Frame& F, const Args& a) {
    const int gw = blockIdx.x * NWAVES + F.wave, NGW = F.G * NWAVES, lane = F.lane;
    bf16* Y = (bf16*)(a.ws + WS_Y); const float* rel = a.in[1];
    LAS float* scr = (LAS float*)(F.lds + RING_OFF + F.wave * 16384);
    LAS float* qs = scr; LAS float* sc = scr + 256; LAS float* s2 = scr + 256 + 2048;
    for (int task = gw; task < 8 * S_; task += NGW) {
        const int q = task & (S_ - 1), bg = task >> 13, g = bg & 1, b = bg >> 1;
        const size_t row = (size_t)b * S_ + q; bf16* Yr = Y + row * YP;
#pragma unroll
        for (int h = 0; h < 4; ++h) qs[h * 64 + lane] = bf2f(Yr[Y_AQ + (g * 4 + h) * 64 + lane]);
        float gt[4][3];
#pragma unroll
        for (int h = 0; h < 4; ++h)
#pragma unroll
            for (int br = 0; br < 3; ++br) gt[h][br] = sigm(bf2f(Yr[Y_AG + (g * 4 + h) * 3 + br]));
        WFENCE();
        const int cur = q >> 6, ncv = q >= 31 ? ((q - 31) >> 4) + 1 : 0;
        const bf16* KC = (const bf16*)(a.ws + WS_KCMP) + (size_t)bg * 512 * 64; const bf16* VC = (const bf16*)(a.ws + WS_VCMP) + (size_t)bg * 512 * 64;
        float mx[4] = {-1e30f, -1e30f, -1e30f, -1e30f};
        for (int i = 0; i < 8; ++i) { const int n = lane + 64 * i;
            if (n < ncv) { float d[4]; dot4(qs, KC + (size_t)n * 64, d); const int bk = t5_bucket(q - (16 * n + 31));
#pragma unroll
                for (int h = 0; h < 4; ++h) { const float s = d[h] + rel[bk * 16 + g * 4 + h] * LOG2E; sc[h * 512 + n] = s; mx[h] = fmaxf(mx[h], s); } }
            else {
#pragma unroll
                for (int h = 0; h < 4; ++h) sc[h * 512 + n] = 0.f; } }
        float ls[4] = {0.f, 0.f, 0.f, 0.f};
#pragma unroll
        for (int h = 0; h < 4; ++h) mx[h] = wave_max(mx[h]);
        WFENCE();
        for (int i = 0; i < 8; ++i) { const int n = lane + 64 * i;
            if (n < ncv) {
#pragma unroll
                for (int h = 0; h < 4; ++h) { const float e = exp2f(sc[h * 512 + n] - mx[h]); sc[h * 512 + n] = e; ls[h] += e; } } }
#pragma unroll
        for (int h = 0; h < 4; ++h) ls[h] = 1.f / fmaxf(wave_sum(ls[h]), 1e-20f);
        for (int i = 0; i < 8; ++i) { const int n = lane + 64 * i;
            if (n < ncv) {
#pragma unroll
                for (int h = 0; h < 4; ++h) sc[h * 512 + n] *= ls[h]; } }
        WFENCE();
        float v0, v1;
        { float t[2];
#pragma unroll
          for (int jj = 0; jj < 2; ++jj) { const int j = lane + 64 * jj; float v = 0.f;
              for (int n = 4 * j - 1; n <= 4 * j + 3; ++n) if (n >= 0 && n < 511) v += (sc[n] + sc[512 + n]) + (sc[1024 + n] + sc[1536 + n]);
              const bool forced = (j == 0) || (j == cur) || (j == cur - 1);
              t[jj] = forced ? 1e9f : (j <= cur ? v : -1e30f); }
          v0 = t[0]; v1 = t[1]; }
        bool sel0 = false, sel1 = false;
        for (int it = 0; it < 16; ++it) {
            const float c0 = sel0 ? -INFINITY : v0, c1 = sel1 ? -INFINITY : v1;
            const float mxv = wave_max(fmaxf(c0, c1));
            const unsigned long long m0 = __ballot(!sel0 && v0 == mxv);
            if (m0) { const int idx = __builtin_ctzll(m0); if (lane == idx) sel0 = true; }
            else { const unsigned long long m1 = __ballot(!sel1 && v1 == mxv); const int idx = m1 ? __builtin_ctzll(m1) : -1; if (lane == idx) sel1 = true; }
        }
        sel0 = sel0 && (lane <= cur); sel1 = sel1 && (lane + 64 <= cur);
        const unsigned long long sm0 = __ballot(sel0), sm1 = __ballot(sel1);
        float oc[4] = {0.f, 0.f, 0.f, 0.f};
        for (int n = 0; n < ncv; ++n) { const float vv = bf2f(VC[(size_t)n * 64 + lane]);
#pragma unroll
            for (int h = 0; h < 4; ++h) oc[h] += sc[h * 512 + n] * vv; }
        { unsigned* MK = (unsigned*)(a.ws + WS_MASK) + ((size_t)bg * S_ + q) * 4;
          if (lane == 0) { MK[0] = (unsigned)sm0; MK[1] = (unsigned)(sm0 >> 32); MK[2] = (unsigned)sm1; MK[3] = (unsigned)(sm1 >> 32); }
          bf16* T = (bf16*)(a.ws + WS_OATMP) + row * 512;
#pragma unroll
          for (int h = 0; h < 4; ++h) T[(g * 4 + h) * 64 + lane] = (bf16)f2bf(gt[h][0] * oc[h]); }
        WFENCE();
    }
}
__device__ __forceinline__ void nsa_naive(Frame& F, const Args& a) {
    const int gw = blockIdx.x * NWAVES + F.wave, NGW = F.G * NWAVES, lane = F.lane;
    bf16* Y = (bf16*)(a.ws + WS_Y); const float* rel = a.in[1];
    LAS float* scr = (LAS float*)(F.lds + RING_OFF + F.wave * 16384);
    LAS float* qs = scr; LAS float* sc = scr + 256; LAS float* s2 = scr + 256 + 2048;
    for (int task = gw; task < 8 * S_; task += NGW) {
        const int q = task & (S_ - 1), bg = task >> 13, g = bg & 1, b = bg >> 1;
        const size_t row = (size_t)b * S_ + q; bf16* Yr = Y + row * YP;
#pragma unroll
        for (int h = 0; h < 4; ++h) qs[h * 64 + lane] = bf2f(Yr[Y_AQ + (g * 4 + h) * 64 + lane]);
        float gt[4][3];
#pragma unroll
        for (int h = 0; h < 4; ++h)
#pragma unroll
            for (int br = 0; br < 3; ++br) gt[h][br] = sigm(bf2f(Yr[Y_AG + (g * 4 + h) * 3 + br]));
        WFENCE();
        const int cur = q >> 6, ncv = q >= 31 ? ((q - 31) >> 4) + 1 : 0;
        const bf16* KC = (const bf16*)(a.ws + WS_KCMP) + (size_t)bg * 512 * 64; const bf16* VC = (const bf16*)(a.ws + WS_VCMP) + (size_t)bg * 512 * 64;
        float mx[4] = {-1e30f, -1e30f, -1e30f, -1e30f};
        for (int i = 0; i < 8; ++i) { const int n = lane + 64 * i;
            if (n < ncv) { float d[4]; dot4(qs, KC + (size_t)n * 64, d); const int bk = t5_bucket(q - (16 * n + 31));
#pragma unroll
                for (int h = 0; h < 4; ++h) { const float s = d[h] + rel[bk * 16 + g * 4 + h] * LOG2E; sc[h * 512 + n] = s; mx[h] = fmaxf(mx[h], s); } }
            else {
#pragma unroll
                for (int h = 0; h < 4; ++h) sc[h * 512 + n] = 0.f; } }
        float ls[4] = {0.f, 0.f, 0.f, 0.f};
#pragma unroll
        for (int h = 0; h < 4; ++h) mx[h] = wave_max(mx[h]);
        WFENCE();
        for (int i = 0; i < 8; ++i) { const int n = lane + 64 * i;
            if (n < ncv) {
#pragma unroll
                for (int h = 0; h < 4; ++h) { const float e = exp2f(sc[h * 512 + n] - mx[h]); sc[h * 512 + n] = e; ls[h] += e; } } }
#pragma unroll
        for (int h = 0; h < 4; ++h) ls[h] = 1.f / fmaxf(wave_sum(ls[h]), 1e-20f);
        for (int i = 0; i < 8; ++i) { const int n = lane + 64 * i;
            if (n < ncv) {
#pragma unroll
                for (int h = 0; h < 4; ++h) sc[h * 512 + n] *= ls[h]; } }
        WFENCE();
        float v0, v1;
        { float t[2];
#pragma unroll
          for (int jj = 0; jj < 2; ++jj) { const int j = lane + 64 * jj; float v = 0.f;
              for (int n = 4 * j - 1; n <= 4 * j + 3; ++n) if (n >= 0 && n < 511) v += (sc[n] + sc[512 + n]) + (sc[1024 + n] + sc[1536 + n]);
              const bool forced = (j == 0) || (j == cur) || (j == cur - 1);
              t[jj] = forced ? 1e9f : (j <= cur ? v : -1e30f); }
          v0 = t[0]; v1 = t[1]; }
        bool sel0 = false, sel1 = false;
        for (int it = 0; it < 16; ++it) {
            const float c0 = sel0 ? -INFINITY : v0, c1 = sel1 ? -INFINITY : v1;
            const float mxv = wave_max(fmaxf(c0, c1));
            const unsigned long long m0 = __ballot(!sel0 && v0 == mxv);
            if (m0) { const int idx = __builtin_ctzll(m0); if (lane == idx) sel0 = true; }
            else { const unsigned long long m1 = __ballot(!sel1 && v1 == mxv); const int idx = m1 ? __builtin_ctzll(m1) : -1; if (lane == idx) sel1 = true; }
        }
        sel0 = sel0 && (lane <= cur); sel1 = sel1 && (lane + 64 <= cur);
        const unsigned long long sm0 = __ballot(sel0), sm1 = __ballot(sel1);
        float oc[4] = {0.f, 0.f, 0.f, 0.f};
        for (int n = 0; n < ncv; ++n) { const float vv = bf2f(VC[(size_t)n * 64 + lane]);
#pragma unroll
            for (int h = 0; h < 4; ++h) oc[h] += sc[h * 512 + n] * vv; }
        float ms[4] = {-1e30f, -1e30f, -1e30f, -1e30f}, lsel[4] = {0.f, 0.f, 0.f, 0.f}, os[4] = {0.f, 0.f, 0.f, 0.f};
        for (int j = 0; j <= cur; ++j) {
            const bool on = j < 64 ? ((sm0 >> j) & 1ull) : ((sm1 >> (j - 64)) & 1ull);
            if (!on) continue;
            const int kpos = 64 * j + lane; const bool valid = kpos <= q;
            float d[4]; dot4(qs, Y + ((size_t)b * S_ + kpos) * YP + Y_AKS + g * 64, d);
            const int bk = t5_bucket(q - kpos);
            WFENCE();
#pragma unroll
            for (int h = 0; h < 4; ++h) { const float s = valid ? d[h] + rel[bk * 16 + g * 4 + h] * LOG2E : -1e30f;
                const float mn = fmaxf(ms[h], wave_max(s)); const float p = valid ? exp2f(s - mn) : 0.f; s2[h * 64 + lane] = p;
                const float scl = exp2f(ms[h] - mn); lsel[h] = lsel[h] * scl + wave_sum(p); os[h] *= scl; ms[h] = mn; }
            WFENCE();
            const bf16* vb = Y + ((size_t)b * S_ + 64 * j) * YP + Y_AVS + g * 64 + lane;
            for (int kk = 0; kk < 64; ++kk) { const float vv = bf2f(vb[(size_t)kk * YP]);
#pragma unroll
                for (int h = 0; h < 4; ++h) os[h] += s2[h * 64 + kk] * vv; }
        }
        float mw[4] = {-1e30f, -1e30f, -1e30f, -1e30f}, lw[4] = {0.f, 0.f, 0.f, 0.f}, ow[4] = {0.f, 0.f, 0.f, 0.f};
        for (int c = 0; c < 8; ++c) {
            if (q - 64 * c < 0) break;
            const int dist = 64 * c + lane, kpos = q - dist; const bool valid = kpos >= 0;
            float d[4]; dot4(qs, Y + ((size_t)b * S_ + (valid ? kpos : 0)) * YP + Y_AKW + g * 64, d);
            const int bk = t5_bucket(dist);
            WFENCE();
#pragma unroll
            for (int h = 0; h < 4; ++h) { const float s = valid ? d[h] + rel[bk * 16 + g * 4 + h] * LOG2E : -1e30f;
                const float mn = fmaxf(mw[h], wave_max(s)); const float p = valid ? exp2f(s - mn) : 0.f; s2[h * 64 + lane] = p;
                const float scl = exp2f(mw[h] - mn); lw[h] = lw[h] * scl + wave_sum(p); ow[h] *= scl; mw[h] = mn; }
            WFENCE();
            for (int kk = 0; kk < 64; ++kk) { const int kp = q - 64 * c - kk; if (kp < 0) break;
                const float vv = bf2f(Y[((size_t)b * S_ + kp) * YP + Y_AVW + g * 64 + lane]);
#pragma unroll
                for (int h = 0; h < 4; ++h) ow[h] += s2[h * 64 + kk] * vv; }
        }
        WFENCE();
#pragma unroll
        for (int h = 0; h < 4; ++h) { const float o = gt[h][0] * oc[h] + gt[h][1] * os[h] / fmaxf(lsel[h], 1e-20f) + gt[h][2] * ow[h] / fmaxf(lw[h], 1e-20f);
            Yr[Y_AQ + (g * 4 + h) * 64 + lane] = (bf16)f2bf(o); }
    }
}
__device__ __forceinline__ void moba_naive(Frame& F, const Args& a) {
    const int gw = blockIdx.x * NWAVES + F.wave, NGW = F.G * NWAVES, lane = F.lane;
    bf16* Y = (bf16*)(a.ws + WS_Y); const float* rel = a.in[1]; const float* KM = (const float*)(a.ws + WS_KMEAN);
    LAS float* scr = (LAS float*)(F.lds + RING_OFF + F.wave * 16384);
    LAS float* qs = scr; LAS float* s2 = scr + 64;
    for (int task = gw; task < 32 * S_; task += NGW) {
        const int q = task & (S_ - 1), bh = task >> 13, h = bh & 7, b = bh >> 3;
        const size_t row = (size_t)b * S_ + q; bf16* Yr = Y + row * YP;
        WFENCE();
        qs[lane] = bf2f(Yr[Y_CQ + h * 64 + lane]);
        WFENCE();
        const int cur = q >> 8;
        float gs = -1e30f;
        if (lane < 32 && lane < cur) { const float* km = KM + ((size_t)bh * 32 + lane) * 64; float d = 0.f;
            for (int dd = 0; dd < 64; ++dd) d += qs[dd] * km[dd];
            gs = d; }
        if (lane >= 32) gs = -INFINITY;
        bool sel = false;
        for (int it = 0; it < 3; ++it) { const float c = sel ? -INFINITY : gs; const float mxv = wave_max(c);
            const unsigned long long m0 = __ballot(!sel && lane < 32 && gs == mxv); const int idx = m0 ? __builtin_ctzll(m0) : -1; if (lane == idx) sel = true; }
        sel = sel && (lane < cur);
        const unsigned smask = (unsigned)__ballot(sel);
        float mr = -1e30f, lr = 0.f, o = 0.f;
        for (int j = 0; j <= cur; ++j) {
            const bool own = (j == cur);
            if (!own && !((smask >> j) & 1u)) continue;
            for (int c = 0; c < 4; ++c) {
                const int kpos = 256 * j + 64 * c + lane; const bool valid = kpos <= q;
                if (256 * j + 64 * c > q) break;
                const float d = dot1(qs, Y + ((size_t)b * S_ + kpos) * YP + Y_CK + h * 64);
                const int bk = t5_bucket(q - kpos);
                const float s = valid ? d + rel[bk * 16 + 8 + h] * LOG2E : -1e30f;
                const float mn = fmaxf(mr, wave_max(s)); const float p = valid ? exp2f(s - mn) : 0.f;
                WFENCE(); s2[lane] = p; WFENCE();
                const float scl = exp2f(mr - mn); lr = lr * scl + wave_sum(p); o *= scl; mr = mn;
                const bf16* vb = Y + ((size_t)b * S_ + 256 * j + 64 * c) * YP + Y_CV + h * 64 + lane;
                for (int kk = 0; kk < 64; ++kk) o += s2[kk] * bf2f(vb[(size_t)kk * YP]);
            }
        }
        Yr[Y_CQ + h * 64 + lane] = (bf16)f2bf(o / fmaxf(lr, 1e-20f));
    }
}
constexpr int CW_Q = 8192;
__device__ __forceinline__ int next_unit(Frame& F, int k) {
    __syncthreads();
    if (F.tid == 0) F.MISC[16] = __hip_atomic_fetch_add(F.ctl + CW_Q + 64 * k, 1u, RLX_AGENT);
    __syncthreads();
    return (int)F.MISC[16];
}
__device__ __forceinline__ int next_unit_x(Frame& F, int qs, int nper, int x0, int& xo, int& xq) {
    for (;;) { if (xo >= 8) return -1; xq = (x0 + xo) & 7; const int i = next_unit(F, qs * 8 + xq); if (i < nper) return i; ++xo; }
}
__device__ __forceinline__ void moba_fast(Frame& F, const Args& a, int qk) {
    bf16* Y = (bf16*)(a.ws + WS_Y); const float* KM = (const float*)(a.ws + WS_KMEAN);
    const int x0 = (int)(xb_xcc_id() & 7u); int xo = 0, xq = 0;
    for (;;) {
        const int i = next_unit_x(F, qk, 128, x0, xo, xq); if (i < 0) break;
        const int qb = 31 - (i & 31), bh = xq + 8 * (i >> 5), b = bh >> 3, h = bh & 7; const long rowbase = (long)b * S_;
        attn::UArgs U{};
        U.Qb = Y + (rowbase + qb * 256) * YP + Y_CQ + h * 64; U.Kh = Y + rowbase * YP + Y_CK + h * 64; U.Vh = Y + rowbase * YP + Y_CV + h * 64; U.Ob = Y + (rowbase + qb * 256) * YP + Y_CQ + h * 64;
        U.NT = 4 * (qb + 1); U.q0 = qb * 256; U.kt0 = 0; U.hc = 8 + h; U.rel = a.in[1]; U.km = KM + (size_t)bh * 32 * 64; U.qb = qb;
        attn::attn_unit<0, 0, 8>(U, (char*)F.lds + RING_OFF);
    }
}
__device__ __forceinline__ void nsa_fast(Frame& F, const Args& a, int qk) {
    bf16* Y = (bf16*)(a.ws + WS_Y);
    const int x0 = (int)(xb_xcc_id() & 7u); int xo = 0, xq = 0;
    for (;;) {
        const int i = next_unit_x(F, qk, 128, x0, xo, xq); if (i < 0) break;
        const int qb = 31 - (i & 31), b = xq >> 1, g = xq & 1, h = g * 4 + (i >> 5); const long rowbase = (long)b * S_; const int q0 = qb * 256;
        attn::UArgs U{};
        U.Qb = Y + (rowbase + q0) * YP + Y_AQ + h * 64; U.Ob = Y + (rowbase + q0) * YP + Y_AQ + h * 64; U.q0 = q0; U.hc = h; U.rel = a.in[1]; U.gate = Y + (rowbase + q0) * YP;
        { const int T0 = 4 * qb - 8 > 0 ? 4 * qb - 8 : 0;
          U.Kh = Y + (rowbase + 64 * T0) * YP + Y_AKW + g * 64; U.Vh = Y + (rowbase + 64 * T0) * YP + Y_AVW + g * 64; U.NT = 4 * qb + 4 - T0; U.kt0 = 64 * T0; U.gcol = Y_AG + h * 3 + 2;
          attn::attn_unit<2, 1, 8>(U, (char*)F.lds + RING_OFF); }
        { U.Kh = Y + rowbase * YP + Y_AKS + g * 64; U.Vh = Y + rowbase * YP + Y_AVS + g * 64; U.NT = 4 * (qb + 1); U.kt0 = 0; U.gcol = Y_AG + h * 3 + 1;
          U.selg = (const unsigned*)(a.ws + WS_MASK) + ((size_t)(b * 2 + g) * S_ + q0) * 4; U.tmp = (const bf16*)(a.ws + WS_OATMP) + (rowbase + q0) * 512 + h * 64;
          attn::attn_unit<1, 2, 8>(U, (char*)F.lds + RING_OFF); }
    }
}
typedef float f32x16g __attribute__((ext_vector_type(16)));
constexpr int GP = 72;
constexpr int GL_GS = 0;
constexpr int GL_VT = 16640 + 0;
constexpr int GL_A0 = GL_VT + 128 * GP * 2;
constexpr int GL_A1 = GL_A0 + 64 * GP * 2;
constexpr int GL_A2 = GL_A1 + 64 * GP * 2;
constexpr int GL_SS = GL_A2 + 64 * GP * 2;
constexpr int GL_END = GL_SS + 1024;
static_assert(GL_END <= RING_BYTES, "GLA LDS map");
__device__ __forceinline__ int crow32(int r, int hi) { return (r & 3) + 8 * (r >> 2) + 4 * hi; }
__device__ __forceinline__ bf16x8 lds_frag(const LAS bf16* X, int row, int kk) { return *(const LAS bf16x8*)(X + row * GP + kk); }
__device__ __forceinline__ float sum16(float v) {
    v += __int_as_float(__builtin_amdgcn_update_dpp(0, __float_as_int(v), 0xB1, 0xf, 0xf, true));
    v += __int_as_float(__builtin_amdgcn_update_dpp(0, __float_as_int(v), 0x4E, 0xf, 0xf, true));
    v += __int_as_float(__builtin_amdgcn_update_dpp(0, __float_as_int(v), 0x141, 0xf, 0xf, true));
    v += __int_as_float(__builtin_amdgcn_update_dpp(0, __float_as_int(v), 0x140, 0xf, 0xf, true));
    return v;
}
__device__ __forceinline__ void gla_put_vT(LAS bf16* vT, const v4u w0, const v4u w1, int w, int lane) {
    const unsigned ww[8] = {w0.x, w0.y, w0.z, w0.w, w1.x, w1.y, w1.z, w1.w};
#pragma unroll
    for (int i = 0; i < 8; ++i) { vT[(w * 16 + 2 * i) * GP + lane] = (bf16)(ww[i] & 0xffffu); vT[(w * 16 + 2 * i + 1) * GP + lane] = (bf16)(ww[i] >> 16); }
}
__device__ __forceinline__ void gla_g1(Frame& F, const Args& a, int l) {
    const bf16* Y = (const bf16*)(a.ws + WS_Y); bf16* GST = (bf16*)(a.ws + WS_GST); float* DEC = (float*)(a.ws + WS_GDEC); float* BC = (float*)(a.ws + WS_BCUM);
    LAS bf16* vT = (LAS bf16*)(F.lds + RING_OFF + GL_VT); LAS bf16* kT = (LAS bf16*)(F.lds + RING_OFF + GL_A0);
    const int lane = F.lane, r32 = lane & 31, hi = lane >> 5, w = F.wave;
    for (int u = blockIdx.x; u < 2048; u += F.G) {
        const int c = u & 127, bh = u >> 7, h = bh & 3, b = bh >> 2; const size_t row = (size_t)b * S_ + c * 64 + lane; const bf16* Yt = Y + row * YP;
        const v4u bl0 = *(const v4u*)(Yt + Y_BLR), bl1 = *(const v4u*)(Yt + Y_BLR + 8), kw = *(const v4u*)(Yt + Y_BK + h * 64 + 8 * w);
        const v4u vw0 = *(const v4u*)(Yt + Y_BV + h * 128 + 16 * w), vw1 = *(const v4u*)(Yt + Y_BV + h * 128 + 16 * w + 8);
        const float* w2 = a.in[13] + (size_t)l * 16 * 256 + h * 64 + 8 * w; const float* bias = a.in[14] + (size_t)l * 256 + h * 64 + 8 * w;
        float blr[16]; { float k0[8], k1[8]; unpack8(bl0, k0); unpack8(bl1, k1);
#pragma unroll
            for (int i = 0; i < 8; ++i) { blr[i] = k0[i]; blr[8 + i] = k1[i]; } }
        float bc[8];
#pragma unroll
        for (int i = 0; i < 8; ++i) { float z = bias[i];
#pragma unroll
            for (int r = 0; r < 16; ++r) z += blr[r] * w2[r * 256 + i];
            float v = -(fmaxf(-z, 0.f) + __logf(1.f + __expf(-fabsf(z)))) * (1.f / 16.f);
#pragma unroll
            for (int o = 1; o < 64; o <<= 1) { const float n = __shfl_up(v, o); v += lane >= o ? n : 0.f; }
            bc[i] = v; }
        { float* bcp = BC + row * 256 + h * 64 + 8 * w; *(f32x4*)bcp = (f32x4){bc[0], bc[1], bc[2], bc[3]}; *(f32x4*)(bcp + 4) = (f32x4){bc[4], bc[5], bc[6], bc[7]}; }
        { float kk[8]; unpack8(kw, kk);
#pragma unroll
          for (int i = 0; i < 8; ++i) { const float bl = __shfl(bc[i], 63); kT[(8 * w + i) * GP + lane] = (bf16)f2bf(kk[i] * __expf(bl - bc[i])); if (lane == i) DEC[(size_t)u * 64 + 8 * w + i] = __expf(bl); } }
        gla_put_vT(vT, vw0, vw1, w, lane);
        __syncthreads();
        { const int et = w >> 1, dt = w & 1; f32x16g acc = {};
#pragma unroll
          for (int ks = 0; ks < 4; ++ks) acc = __builtin_amdgcn_mfma_f32_32x32x16_bf16(lds_frag(vT, et * 32 + r32, ks * 16 + hi * 8), lds_frag(kT, dt * 32 + r32, ks * 16 + hi * 8), acc, 0, 0, 0);
          bf16* slot = GST + (size_t)u * 8192;
#pragma unroll
          for (int r = 0; r < 16; ++r) slot[(et * 32 + crow32(r, hi)) * 64 + dt * 32 + r32] = (bf16)f2bf(acc[r]); }
        __syncthreads();
    }
}
__device__ __forceinline__ void gla_g2(Frame& F, const Args& a) {
    unsigned* GST = (unsigned*)(a.ws + WS_GST); const float* DEC = (const float*)(a.ws + WS_GDEC);
    for (int i = blockIdx.x * 512 + F.tid; i < 16 * 128 * 32; i += F.G * 512) {
        const int dp = i & 31, bh = i >> 12; const int eo = (i >> 5) & 127;
        float s0 = 0.f, s1 = 0.f;
        for (int c0 = 0; c0 < 128; c0 += 8) {
            unsigned uu[8]; float d0[8], d1[8];
#pragma unroll
            for (int j = 0; j < 8; ++j) { const size_t sl = (size_t)(bh * 128 + c0 + j); uu[j] = GST[sl * 4096 + eo * 32 + dp]; d0[j] = DEC[sl * 64 + 2 * dp]; d1[j] = DEC[sl * 64 + 2 * dp + 1]; }
#pragma unroll
            for (int j = 0; j < 8; ++j) { const size_t sl = (size_t)(bh * 128 + c0 + j); GST[sl * 4096 + eo * 32 + dp] = pk2(s0, s1);
                s0 = s0 * d0[j] + __uint_as_float(uu[j] << 16); s1 = s1 * d1[j] + __uint_as_float(uu[j] & 0xffff0000u); }
        }
    }
}
__device__ __forceinline__ void gla_g3(Frame& F, const Args& a, int l, int qk) {
    bf16* Y = (bf16*)(a.ws + WS_Y); const bf16* GST = (const bf16*)(a.ws + WS_GST); const float* nw = a.in[15] + (size_t)l * 128; const float* BC = (const float*)(a.ws + WS_BCUM);
    LAS bf16* vT = (LAS bf16*)(F.lds + RING_OFF + GL_VT);
    LAS bf16* qd = (LAS bf16*)(F.lds + RING_OFF + GL_A0); LAS bf16* kd = (LAS bf16*)(F.lds + RING_OFF + GL_A1); LAS bf16* at = (LAS bf16*)(F.lds + RING_OFF + GL_A2);
    LAS float* ssq = (LAS float*)(F.lds + RING_OFF + GL_SS);
    const int lane = F.lane, r32 = lane & 31, hi = lane >> 5, w = F.wave, rb = w >> 2, et = w & 3;
    const int x0 = (int)(xb_xcc_id() & 7u); int xo = 0, xq = 0;
    for (;;) {
        const int i3 = next_unit_x(F, qk, 256, x0, xo, xq); if (i3 < 0) break;
        const int u = xq * 256 + i3;
        const int c = u & 127, bh = u >> 7, h = bh & 3, b = bh >> 2; bf16* Yc = Y + ((size_t)b * S_ + c * 64) * YP; const bf16* Yt = Yc + (size_t)lane * YP;
        const v4u qw = *(const v4u*)(Yt + Y_BQ + h * 64 + 8 * w), kw = *(const v4u*)(Yt + Y_BK + h * 64 + 8 * w);
        const v4u vw0 = *(const v4u*)(Yt + Y_BV + h * 128 + 16 * w), vw1 = *(const v4u*)(Yt + Y_BV + h * 128 + 16 * w + 8);
        const float* bcp = BC + ((size_t)b * S_ + c * 64 + lane) * 256 + h * 64 + 8 * w; const f32x4 bc0 = *(const f32x4*)bcp, bc1 = *(const f32x4*)(bcp + 4);
        bf16x8 sb[4]; { const bf16* slot = GST + (size_t)u * 8192 + (size_t)(et * 32 + r32) * 64 + hi * 8;
#pragma unroll
            for (int ks = 0; ks < 4; ++ks) sb[ks] = *(const bf16x8*)(slot + ks * 16); }
        bf16 rr[16];
#pragma unroll
        for (int r = 0; r < 16; ++r) rr[r] = Yc[(size_t)(rb * 32 + crow32(r, hi)) * YP + Y_BR + h * 128 + et * 32 + r32];
        const float nwe = nw[et * 32 + r32];
        { float qq[8], kk[8]; unpack8(qw, qq); unpack8(kw, kk); const float bc[8] = {bc0.x, bc0.y, bc0.z, bc0.w, bc1.x, bc1.y, bc1.z, bc1.w}; unsigned qa[4], ka[4];
#pragma unroll
          for (int i = 0; i < 4; ++i) { qa[i] = pk2(qq[2 * i] * __expf(bc[2 * i]), qq[2 * i + 1] * __expf(bc[2 * i + 1])); ka[i] = pk2(kk[2 * i] * __expf(-bc[2 * i]), kk[2 * i + 1] * __expf(-bc[2 * i + 1])); }
          v4u qo, ko; qo.x = qa[0]; qo.y = qa[1]; qo.z = qa[2]; qo.w = qa[3]; ko.x = ka[0]; ko.y = ka[1]; ko.z = ka[2]; ko.w = ka[3];
          *(LAS v4u*)(qd + lane * GP + 8 * w) = qo; *(LAS v4u*)(kd + lane * GP + 8 * w) = ko; }
        gla_put_vT(vT, vw0, vw1, w, lane);
        __syncthreads();
        if (w < 4) { const int ib = w >> 1, jb = w & 1;
            if (jb <= ib) { f32x16g acc = {};
#pragma unroll
                for (int ks = 0; ks < 4; ++ks) acc = __builtin_amdgcn_mfma_f32_32x32x16_bf16(lds_frag(qd, ib * 32 + r32, ks * 16 + hi * 8), lds_frag(kd, jb * 32 + r32, ks * 16 + hi * 8), acc, 0, 0, 0);
#pragma unroll
                for (int r = 0; r < 16; ++r) { const int i = ib * 32 + crow32(r, hi), j = jb * 32 + r32; at[i * GP + j] = (bf16)f2bf(j <= i ? acc[r] : 0.f); } } }
        __syncthreads();
        { f32x16g acc = {};
#pragma unroll
          for (int ks = 0; ks < 4; ++ks) acc = __builtin_amdgcn_mfma_f32_32x32x16_bf16(lds_frag(qd, rb * 32 + r32, ks * 16 + hi * 8), sb[ks], acc, 0, 0, 0);
          for (int ks = 0; ks < 2 * (rb + 1); ++ks) acc = __builtin_amdgcn_mfma_f32_32x32x16_bf16(lds_frag(at, rb * 32 + r32, ks * 16 + hi * 8), lds_frag(vT, et * 32 + r32, ks * 16 + hi * 8), acc, 0, 0, 0);
          float sq[16];
#pragma unroll
          for (int r = 0; r < 16; ++r) { float v = sum16(acc[r] * acc[r]); v += __shfl_xor(v, 16); sq[r] = v; }
          if (r32 == 0) {
#pragma unroll
              for (int r = 0; r < 16; ++r) ssq[w * 32 + crow32(r, hi)] = sq[r]; }
          __syncthreads();
#pragma unroll
          for (int r = 0; r < 16; ++r) { const int tr = crow32(r, hi); const float tot = ssq[(rb * 4 + 0) * 32 + tr] + ssq[(rb * 4 + 1) * 32 + tr] + ssq[(rb * 4 + 2) * 32 + tr] + ssq[(rb * 4 + 3) * 32 + tr];
              const float rv = bf2f(rr[r]);
              Yc[(size_t)(rb * 32 + tr) * YP + Y_BR + h * 128 + et * 32 + r32] = (bf16)f2bf(acc[r] * rsqrtf(tot * (1.f / 128.f) + NORM_EPS) * nwe * (rv * sigm(rv))); } }
    }
}
constexpr int CL_IMP = 0, CL_BIAS = 64 * 129 * 4, CL_K = CL_BIAS + 2048, CL_GATE = CL_K + 512 * GP * 2, CL_END = CL_GATE + 1024;
static_assert(CL_END <= RING_BYTES && (CL_K % 16) == 0, "cmp LDS map");
__device__ __forceinline__ int red8(int v) {
    v += __builtin_amdgcn_update_dpp(0, v, 0xB1, 0xf, 0xf, true);
    v += __builtin_amdgcn_update_dpp(0, v, 0x4E, 0xf, 0xf, true);
    v += __builtin_amdgcn_update_dpp(0, v, 0x141, 0xf, 0xf, true);
    return v;
}
typedef unsigned u32x2g __attribute__((ext_vector_type(2)));
struct VFrag { u32x2g a[8]; };
__device__ __forceinline__ void cmp_load_v(VFrag& f, const bf16* VT, int nt, int r32, int hi) {
#pragma unroll
    for (int dt = 0; dt < 2; ++dt)
#pragma unroll
        for (int kk = 0; kk < 2; ++kk) { const bf16* vp = VT + (size_t)(dt * 32 + r32) * 512 + nt * 32 + kk * 16 + 4 * hi; f.a[(dt * 2 + kk) * 2] = *(const u32x2g*)vp; f.a[(dt * 2 + kk) * 2 + 1] = *(const u32x2g*)(vp + 8); }
}
__device__ __forceinline__ void nsa_cmp_fast(Frame& F, const Args& a, int qk) {
    const bf16* Y = (const bf16*)(a.ws + WS_Y); const float* rel = a.in[1];
    LAS unsigned* impI = (LAS unsigned*)(F.lds + RING_OFF + CL_IMP); LAS float* biasT = (LAS float*)(F.lds + RING_OFF + CL_BIAS); LAS bf16* Ks = (LAS bf16*)(F.lds + RING_OFF + CL_K);
    const int lane = F.lane, r32 = lane & 31, hi = lane >> 5, w = F.wave, hr = w >> 1, qh = w & 1;
    const int x0 = (int)(xb_xcc_id() & 7u); int xo = 0, xq = 0;
    for (;;) {
        const int i = next_unit_x(F, qk, 128, x0, xo, xq); if (i < 0) break;
        const int c = 127 - i, bg = xq, g = bg & 1, b = bg >> 1, q0 = 64 * c; const size_t rowbase = (size_t)b * S_;
        const bf16* KC = (const bf16*)(a.ws + WS_KCMP) + (size_t)bg * 512 * 64; const bf16* VT = (const bf16*)(a.ws + WS_VCMPT) + (size_t)bg * 64 * 512;
        const int head = g * 4 + hr, qw0 = q0 + qh * 32, qpos = qw0 + r32;
        const int NTw = (qw0 / 16 + 1 + 31) >> 5;
        const int nrows = (((q0 + 32) / 16 + 1 + 31) >> 5) * 32;
        { v4u kv[8]; int tl = F.tid; asm volatile("" : "+v"(tl));
          const unsigned o0_ = (unsigned)((tl >> 3) * 64 + (tl & 7) * 8);
#pragma unroll
          for (int j = 0; j < 8; ++j) { const int p = tl + 512 * j; if (p < nrows * 8) kv[j] = *(const v4u*)(KC + o0_ + 4096u * j); }
          for (int ii = F.tid; ii < 64 * 129; ii += 512) impI[ii] = 0u;
          { const int hh = F.tid >> 7, dd = F.tid & 127; biasT[F.tid] = (rel[t5_bucket(dd) * 16 + g * 4 + hh] - rel[31 * 16 + g * 4 + hh]) * LOG2E; }
#pragma unroll
          for (int j = 0; j < 8; ++j) { const int p = tl + 512 * j; if (p < nrows * 8) *(LAS v4u*)(Ks + ((tl >> 3) + 64 * j) * GP + (tl & 7) * 8) = kv[j]; } }
        const bf16* Qw = Y + (rowbase + qw0) * YP + Y_AQ + head * 64;
        bf16x8 qr[4];
#pragma unroll
        for (int ks = 0; ks < 4; ++ks) qr[ks] = *(const bf16x8*)(Qw + (size_t)r32 * YP + ks * 16 + hi * 8);
        if (hi == 0) ((LAS float*)(F.lds + RING_OFF + CL_GATE))[w * 32 + r32] = sigm(bf2f(Y[(rowbase + qw0 + r32) * YP + Y_AG + head * 3]));
        __syncthreads();
        const LAS float* bT = biasT + hr * 128;
        float lsum = 0.f;
#pragma unroll 1
        for (int nt = 0; nt < NTw; ++nt) { f32x16g C = {};
#pragma unroll
            for (int ks = 0; ks < 4; ++ks) C = __builtin_amdgcn_mfma_f32_32x32x16_bf16(lds_frag(Ks, nt * 32 + r32, ks * 16 + hi * 8), qr[ks], C, 0, 0, 0);
#pragma unroll
            for (int r = 0; r < 16; ++r) { const int dist = qpos - (16 * (nt * 32 + crow32(r, hi)) + 31); lsum += dist >= 0 ? __builtin_amdgcn_exp2f(fminf(C[r] + bT[dist > 127 ? 127 : (dist < 0 ? 0 : dist)], 100.f)) : 0.f; } }
        { auto rr = __builtin_amdgcn_permlane32_swap(__float_as_uint(lsum), __float_as_uint(lsum), false, false); lsum = __uint_as_float(rr[0]) + __uint_as_float(rr[1]); }
        const float inv = 1.f / fmaxf(lsum, 1e-30f);
        f32x16g o0 = {}, o1 = {};
#pragma unroll 1
        for (int nt = 0; nt < NTw; ++nt) {
            VFrag vcur; cmp_load_v(vcur, VT, nt, r32, hi);
            f32x16g C = {};
#pragma unroll
            for (int ks = 0; ks < 4; ++ks) C = __builtin_amdgcn_mfma_f32_32x32x16_bf16(lds_frag(Ks, nt * 32 + r32, ks * 16 + hi * 8), qr[ks], C, 0, 0, 0);
            float p[16];
#pragma unroll
            for (int r = 0; r < 16; ++r) { const int dist = qpos - (16 * (nt * 32 + crow32(r, hi)) + 31); p[r] = dist >= 0 ? __builtin_amdgcn_exp2f(fminf(C[r] + bT[dist > 127 ? 127 : (dist < 0 ? 0 : dist)], 100.f)) * inv : 0.f; }
#pragma unroll
            for (int m = 0; m < 4; ++m) { const float G = (p[4 * m] + p[4 * m + 1]) + (p[4 * m + 2] + p[4 * m + 3]); const int j = nt * 8 + 2 * m + hi;
                LAS unsigned* ip = impI + (qh * 32 + r32) * 129 + j;
                __hip_atomic_fetch_add(ip, (unsigned)(G * 67108864.f + 0.5f), __ATOMIC_RELAXED, __HIP_MEMORY_SCOPE_WORKGROUP);
                if (j + 1 < 128) __hip_atomic_fetch_add(ip + 1, (unsigned)(p[4 * m + 3] * 67108864.f + 0.5f), __ATOMIC_RELAXED, __HIP_MEMORY_SCOPE_WORKGROUP); }
            v4u pw0, pw1; pw0.x = pk2(p[0], p[1]); pw0.y = pk2(p[2], p[3]); pw0.z = pk2(p[4], p[5]); pw0.w = pk2(p[6], p[7]); pw1.x = pk2(p[8], p[9]); pw1.y = pk2(p[10], p[11]); pw1.z = pk2(p[12], p[13]); pw1.w = pk2(p[14], p[15]);
            const bf16x8 pa0 = __builtin_bit_cast(bf16x8, pw0), pa1 = __builtin_bit_cast(bf16x8, pw1);
#pragma unroll
            for (int dt = 0; dt < 2; ++dt)
#pragma unroll
                for (int kk = 0; kk < 2; ++kk) { v4u vv; vv.x = vcur.a[(dt * 2 + kk) * 2].x; vv.y = vcur.a[(dt * 2 + kk) * 2].y; vv.z = vcur.a[(dt * 2 + kk) * 2 + 1].x; vv.w = vcur.a[(dt * 2 + kk) * 2 + 1].y;
                    if (dt == 0) o0 = __builtin_amdgcn_mfma_f32_32x32x16_bf16(kk ? pa1 : pa0, __builtin_bit_cast(bf16x8, vv), o0, 0, 0, 0);
                    else o1 = __builtin_amdgcn_mfma_f32_32x32x16_bf16(kk ? pa1 : pa0, __builtin_bit_cast(bf16x8, vv), o1, 0, 0, 0); }
            }
        { bf16* T = (bf16*)(a.ws + WS_OATMP);
#pragma unroll
          for (int r = 0; r < 16; ++r) { const size_t row = rowbase + qw0 + crow32(r, hi); const float gs = ((const LAS float*)(F.lds + RING_OFF + CL_GATE))[w * 32 + crow32(r, hi)];
              T[row * 512 + head * 64 + r32] = (bf16)f2bf(gs * o0[r]); T[row * 512 + head * 64 + 32 + r32] = (bf16)f2bf(gs * o1[r]); } }
        __syncthreads();
        { const int qi = F.tid >> 3, part = F.tid & 7, cur = c; unsigned key[16];
#pragma unroll
          for (int i2 = 0; i2 < 16; ++i2) { const int j = part * 16 + i2; const unsigned raw = impI[qi * 129 + j] >> 6; const bool forced = (j == 0) || (j == cur) || (j == cur - 1);
              key[i2] = forced ? (0xFFFFFF80u | (unsigned)(127 - j)) : (j <= cur ? ((((raw > 33554430u ? 33554430u : raw) + 1u) << 7) | (unsigned)(127 - j)) : (unsigned)(127 - j)); }
          unsigned T = 0u;
          for (int bit = 31; bit >= 0; --bit) { const unsigned Tt = T | (1u << bit); int cnt = 0;
#pragma unroll
              for (int i2 = 0; i2 < 16; ++i2) cnt += key[i2] >= Tt ? 1 : 0;
              cnt = red8(cnt); if (cnt >= 16) T = Tt; }
          unsigned bits = 0u;
#pragma unroll
          for (int i2 = 0; i2 < 16; ++i2) bits |= (key[i2] >= T && (part * 16 + i2) <= cur) ? (1u << i2) : 0u;
          ((unsigned short*)(a.ws + WS_MASK))[((size_t)bg * S_ + q0 + qi) * 8 + part] = (unsigned short)bits; }
    }
}
constexpr int CP_RED = 0, CP_HS = 8 * 32 * 64 * 4, CP_END = CP_HS + 32 * GP * 2;
static_assert(CP_END <= RING_BYTES, "compress LDS map");
__device__ __forceinline__ void compress_fast(Frame& F, const Args& a) {
    const bf16* Y = (const bf16*)(a.ws + WS_Y);
    LAS float* red = (LAS float*)(F.lds + RING_OFF + CP_RED); LAS bf16* hs = (LAS bf16*)(F.lds + RING_OFF + CP_HS);
    const int lane = F.lane, r32 = lane & 31, hi = lane >> 5, w = F.wave;
    for (int u = blockIdx.x; u < 256; u += F.G) {
        const int nt = u & 15, bg = (u >> 4) & 7, kv = u >> 7, g = bg & 1, b = bg >> 1;
        const int n = nt * 32 + r32, nn = n > 510 ? 510 : n;
        const bf16* xrow = Y + ((size_t)b * S_ + 16 * nn) * YP + (kv ? Y_AVC : Y_AKC) + g * 64 + hi * 8;
        const bf16* W1T = (const bf16*)(a.ws + WS_CW1T) + (size_t)kv * 64 * 2048;
        f32x16g acc0 = {}, acc1 = {};
#pragma unroll 4
        for (int s = 0; s < 16; ++s) { const int ks = w * 16 + s, pos = ks >> 2;
            const bf16x8 af = *(const bf16x8*)(xrow + (size_t)pos * YP + (ks & 3) * 16);
            const bf16x8 b0 = *(const bf16x8*)(W1T + (size_t)r32 * 2048 + ks * 16 + hi * 8), b1 = *(const bf16x8*)(W1T + (size_t)(32 + r32) * 2048 + ks * 16 + hi * 8);
            acc0 = __builtin_amdgcn_mfma_f32_32x32x16_bf16(af, b0, acc0, 0, 0, 0); acc1 = __builtin_amdgcn_mfma_f32_32x32x16_bf16(af, b1, acc1, 0, 0, 0); }
#pragma unroll
        for (int r = 0; r < 16; ++r) { red[(w * 32 + crow32(r, hi)) * 64 + r32] = acc0[r]; red[(w * 32 + crow32(r, hi)) * 64 + 32 + r32] = acc1[r]; }
        __syncthreads();
        { const float* c0 = (const float*)(a.ws + WS_CC0) + kv * 64;
#pragma unroll
          for (int i = 0; i < 4; ++i) { const int e = F.tid * 4 + i, rn = e >> 6, j = e & 63; float v = c0[j];
#pragma unroll
              for (int ww = 0; ww < 8; ++ww) v += red[(ww * 32 + rn) * 64 + j];
              hs[rn * GP + j] = (bf16)f2bf(gelu_tanh(v)); } }
        __syncthreads();
        if (w < 2) { const bf16* W2T = (const bf16*)(a.ws + WS_CW2T) + (size_t)kv * 64 * 64; f32x16g o = {};
#pragma unroll
            for (int ks = 0; ks < 4; ++ks) { const bf16x8 bf = *(const bf16x8*)(W2T + (size_t)(w * 32 + r32) * 64 + ks * 16 + hi * 8);
                o = __builtin_amdgcn_mfma_f32_32x32x16_bf16(lds_frag(hs, r32, ks * 16 + hi * 8), bf, o, 0, 0, 0); }
#pragma unroll
            for (int r = 0; r < 16; ++r) { const int rn = nt * 32 + crow32(r, hi), jp = w * 32 + r32;
                if (kv == 0) ((bf16*)(a.ws + WS_KCMP))[((size_t)bg * 512 + rn) * 64 + jp] = (bf16)f2bf(o[r]);
                else ((bf16*)(a.ws + WS_VCMPT))[((size_t)bg * 64 + jp) * 512 + rn] = (bf16)f2bf(o[r]); } }
        __syncthreads();
    }
}
__device__ __forceinline__ void gla_out_naive(Frame& F, const Args& a, int l) {
    const int gw = blockIdx.x * NWAVES + F.wave, NGW = F.G * NWAVES, lane = F.lane;
    bf16* Y = (bf16*)(a.ws + WS_Y); const bf16* O16 = (const bf16*)(a.ws + WS_O16); const float* nw = a.in[15] + (size_t)l * 128;
    for (int t = gw; t < M_ * 4; t += NGW) {
        const int h = t & 3; const size_t row = (size_t)(t >> 2);
        const float o0 = bf2f(O16[row * 512 + h * 128 + lane]), o1 = bf2f(O16[row * 512 + h * 128 + 64 + lane]);
        const float r = rsqrtf(wave_sum(o0 * o0 + o1 * o1) * (1.f / 128.f) + NORM_EPS);
        bf16* yr = Y + row * YP + Y_BR + h * 128;
        const float r0 = bf2f(yr[lane]), r1 = bf2f(yr[64 + lane]);
        yr[lane] = (bf16)f2bf(o0 * r * nw[lane] * (r0 * sigm(r0))); yr[64 + lane] = (bf16)f2bf(o1 * r * nw[64 + lane] * (r1 * sigm(r1)));
    }
}

__device__ __forceinline__ Frame fresh(const Frame& F) { Frame f = F; int t = threadIdx.x; asm volatile("" : "+v"(t)); f.tid = t; f.lane = t & 63; return f; }
constexpr int PPL = 11, NPH = NL * PPL;
#define IN(k) (lo <= (k) && (k) < hi)
#define SEAM(k) do { if (IN(k) && IN((k) + 1)) xcd_barrier(bar); } while (0)
template <int l> __device__ __forceinline__ void layer_body(Frame& F0, const Args& args, const XcdBarrier& bar, const int lo, const int hi) {
    unsigned char* ws = args.ws;
    bf16* H = (bf16*)(ws + WS_H); bf16* Y = (bf16*)(ws + WS_Y); unsigned char* G8 = ws + WS_G8;
    float* Yf = (float*)(ws + WS_Y); bf16* ACT = (bf16*)(ws + WS_ACT);
    constexpr int p0 = l * PPL;
    const float* xin = l == 0 ? args.in[0] : args.out;
    if (IN(p0 + 0)) { Frame F = fresh(F0); phase_weights(F, args, l); if (l == 0) phase_norm0(F, args.in[0], args.in[2], H); SEAM(p0 + 0); }
    if (IN(p0 + 1)) { Frame F = fresh(F0);
        pg8::Gemm g{H, (const bf16*)(ws + WS_WIN), M_, NIN, DM, DM}; pg8::StaticOrder So; So.init(M_, NIN, F.G, (int)blockIdx.x);
        pg8::EpiInProj E{Y, G8};
        pg8::gemm_phase<pg8::EpiInProj, pg8::StaticOrder, true, true>(F.lds + RING_OFF, g, So, E);
        SEAM(p0 + 1);
    }
    if (IN(p0 + 2)) { { Frame F = fresh(F0); compress_fast(F, args); } { Frame F = fresh(F0); phase2_naive(F, args, l); } { Frame F = fresh(F0); gla_g1(F, args, l); } SEAM(p0 + 2); }
    if (IN(p0 + 3)) { { Frame F = fresh(F0); gla_g2(F, args); } { Frame F = fresh(F0); moba_fast(F, args, l * 4 + 0); } { Frame F = fresh(F0); nsa_cmp_fast(F, args, l * 4 + 1); } SEAM(p0 + 3); }
    if (IN(p0 + 4)) { { Frame F = fresh(F0); nsa_fast(F, args, l * 4 + 2); } { Frame F = fresh(F0); gla_g3(F, args, l, l * 4 + 3); } SEAM(p0 + 4); }
    if (IN(p0 + 5)) { Frame F = fresh(F0);
        pg8::Fuse3Order So; So.So.init(M_, DM, F.G, (int)blockIdx.x);
        pg8::Gemm g{Y, (const bf16*)(ws + WS_WA), M_, DM, 512, YP, Y_AQ, Y_BR, Y_CQ}; pg8::EpiMerge3 E{H, G8};
        pg8::gemm_phase<pg8::EpiMerge3, pg8::Fuse3Order, true, true>(F.lds + RING_OFF, g, So, E);
        SEAM(p0 + 5);
    }
    if (IN(p0 + 6)) { Frame F = fresh(F0);
        pg8::Gemm g{H, (const bf16*)(ws + WS_WO), M_, DM, DM, DM}; pg8::StaticOrder So; So.init(M_, DM, F.G, (int)blockIdx.x);
        pg8::EpiB16 E{(bf16*)Yf, DM}; pg8::gemm_phase<pg8::EpiB16, pg8::StaticOrder, true, true>(F.lds + RING_OFF, g, So, E);
        SEAM(p0 + 6);
    }
    if (IN(p0 + 7)) { Frame F = fresh(F0); phase_resid(F, Yf, xin, args.out, args.in[3] + (size_t)l * DM, args.in[4] + (size_t)l * DM, H); SEAM(p0 + 7); }
    if (IN(p0 + 8)) { Frame F = fresh(F0);
        pg8::Gemm g{H, (const bf16*)(ws + WS_WF1), M_, 2 * FF, DM, DM}; pg8::StaticOrder So; So.init(M_, 2 * FF, F.G, (int)blockIdx.x);
        pg8::EpiSwiglu E{ACT, FF}; pg8::gemm_phase<pg8::EpiSwiglu, pg8::StaticOrder, true, true>(F.lds + RING_OFF, g, So, E);
        SEAM(p0 + 8);
    }
    if (IN(p0 + 9)) { Frame F = fresh(F0);
        pg8::Gemm g{ACT, (const bf16*)(ws + WS_WF2), M_, DM, FF, FF}; pg8::StaticOrder So; So.init(M_, DM, F.G, (int)blockIdx.x);
        pg8::EpiB16 E{(bf16*)Yf, DM}; pg8::gemm_phase<pg8::EpiB16, pg8::StaticOrder, true, true>(F.lds + RING_OFF, g, So, E);
        SEAM(p0 + 9);
    }
    if (IN(p0 + 10)) { Frame F = fresh(F0); phase_resid(F, Yf, args.out, args.out, args.in[5] + (size_t)l * DM, l + 1 < NL ? args.in[2] + (size_t)(l + 1) * DM : nullptr, l + 1 < NL ? H : nullptr); SEAM(p0 + 10); }
}
__global__ void __launch_bounds__(NWAVES * 64, 2) mk_fwd(Args args) {
    extern __shared__ __attribute__((aligned(16))) unsigned char lds[];
    Frame F;
    F.lds = (LAS unsigned char*)lds; F.MISC = (volatile LAS unsigned*)(F.lds + MISC_OFF);
    F.tid = threadIdx.x; F.lane = F.tid & 63; F.wave = __builtin_amdgcn_readfirstlane(F.tid >> 6); F.G = gridDim.x;
    F.ctl = (gu32*)(args.ws + WS_CTL);
    for (int u = F.tid; u < (LDS_BYTES - LDSCTL_OFF) / 4; u += NWAVES * 64) ((LAS unsigned*)(F.lds + LDSCTL_OFF))[u] = 0u;
    __syncthreads();
    const int lo = args.ph_lo, hi = args.ph_hi;
    XcdBarrier bar; bar.bar = (unsigned*)(F.ctl + CW_BAR); bar.x = 0; bar.st = nullptr;
    if (hi - lo > 1) bar = xcd_barrier_post((unsigned*)(F.ctl + CW_BAR), F.MISC + 8);
    layer_body<0>(F, args, bar, lo, hi);
    layer_body<1>(F, args, bar, lo, hi);
}
#undef IN
#undef SEAM

#ifndef MK_ONE_LAUNCH
#define MK_ONE_LAUNCH 1
#endif
extern "C" void kernel_launch(void* const* d_in, const int* in_sizes, int n_in, void* d_out, int out_size, void* d_ws, size_t ws_size, hipStream_t stream) {
    static int grid = 0;
    if (grid == 0) {
        if (n_in != 22 || out_size != M_ * DM || ws_size < WS_END) { fprintf(stderr, "kernel_launch: unexpected sizes (n_in %d out %d ws %zu)\n", n_in, out_size, ws_size); grid = -1; return; }
        int dev = 0, cus = 0;
        if (hipGetDevice(&dev) != hipSuccess || hipDeviceGetAttribute(&cus, hipDeviceAttributeMultiprocessorCount, dev) != hipSuccess) { grid = -1; return; }
        if (hipFuncSetAttribute((const void*)mk_fwd, hipFuncAttributeMaxDynamicSharedMemorySize, LDS_BYTES) != hipSuccess) { grid = -1; return; }
        (void)hipGetLastError();
        grid = cus;
    }
    if (grid < 0) return;
    if (hipMemsetAsync((char*)d_ws + WS_CTL, 0, CTL_ZERO_BYTES, stream) != hipSuccess) return;
    Args a{};
    for (int i = 0; i < 22; ++i) a.in[i] = (const float*)d_in[i];
    a.out = (float*)d_out; a.ws = (unsigned char*)d_ws;
#if MK_ONE_LAUNCH
    a.ph_lo = 0; a.ph_hi = NPH;
    hipLaunchKernelGGL(mk_fwd, dim3(grid), dim3(NWAVES * 64), LDS_BYTES, stream, a);
#else
    for (int p = 0; p < NPH; ++p) { a.ph_lo = p; a.ph_hi = p + 1; hipLaunchKernelGGL(mk_fwd, dim3(grid), dim3(NWAVES * 64), LDS_BYTES, stream, a); }
#endif
}
```
